# Optimizing an MI355X kernel written in HIP

```python
import jax, jax.numpy as jnp
from jax import lax
import numpy as np

D_MODEL = 1024
BATCH = 16
SEQ = 4096
DEPTH = 4

GRID_W = 64
CTX_LEN = 256
N_MIXERS = 2
N_MLSTM_LAYERS = (DEPTH + 1) // 2
N_ATT_LAYERS = DEPTH // 2
NORM_EPS = 1e-6

MLSTM_HEADS = 4
MLSTM_QK_DIM = D_MODEL // 2
MLSTM_V_DIM = D_MODEL
MLSTM_DK = MLSTM_QK_DIM // MLSTM_HEADS
MLSTM_DV = MLSTM_V_DIM // MLSTM_HEADS
MLSTM_CHUNK = 64
MLSTM_GATE_CAP = 15.0
MLSTM_N_GATES = 4
MLSTM_IN_DIM = 2 * MLSTM_QK_DIM + 2 * MLSTM_V_DIM + MLSTM_N_GATES * MLSTM_HEADS

ATT_HEADS = 16
ATT_KV_HEADS = 4
ATT_GROUP = ATT_HEADS // ATT_KV_HEADS
ATT_HEAD_DIM = D_MODEL // ATT_HEADS
ATT_Q_BLOCK = 128
ATT_IN_DIM = (ATT_HEADS + 2 * ATT_KV_HEADS) * ATT_HEAD_DIM
ROPE_THETA = 10000.0
ROPE_PAIRS_PER_AXIS = ATT_HEAD_DIM // 4

N_EXPERTS = 16
EC_CAPACITY = 2
D_EXPERT = D_MODEL

kernel_name = 'hybrid_mlstm_gqa_ec_moe_dit'


def _rmsnorm(x, g):
    xf = x.astype(jnp.float32)
    y = xf * lax.rsqrt(jnp.mean(xf * xf, axis=-1, keepdims=True) + NORM_EPS)
    return (y * g.astype(jnp.float32)).astype(x.dtype)


def _modulate(h, shift, scale):
    return h * (1 + scale) + shift


def _axial_rope(n_tok):
    rows = n_tok // GRID_W
    row = jnp.repeat(jnp.arange(rows, dtype=jnp.float32), GRID_W)
    col = jnp.tile(jnp.arange(GRID_W, dtype=jnp.float32), rows)
    inv = ROPE_THETA ** (-jnp.arange(ROPE_PAIRS_PER_AXIS, dtype=jnp.float32) / ROPE_PAIRS_PER_AXIS)
    ang = jnp.concatenate([row[:, None] * inv, col[:, None] * inv], axis=-1)
    return jnp.cos(ang), jnp.sin(ang)


def _apply_rope(x, cos, sin):
    shape = (x.shape[1],) + (1,) * (x.ndim - 3) + (cos.shape[-1],)
    cos = cos.reshape(shape).astype(x.dtype)
    sin = sin.reshape(shape).astype(x.dtype)
    x1, x2 = jnp.split(x, 2, axis=-1)
    return jnp.concatenate([x1 * cos - x2 * sin, x1 * sin + x2 * cos], axis=-1)


def _mlstm_zero_state(bsz):
    return (jnp.zeros((bsz, MLSTM_HEADS, MLSTM_DK, MLSTM_DV), jnp.float32),
            jnp.zeros((bsz, MLSTM_HEADS, MLSTM_DK), jnp.float32),
            jnp.zeros((bsz, MLSTM_HEADS), jnp.float32))


def _mlstm_scan(q, k, v, ig, lf, state):
    bsz, nh, n_tok, _ = q.shape
    n_chunks = n_tok // MLSTM_CHUNK
    causal = jnp.tril(jnp.ones((MLSTM_CHUNK, MLSTM_CHUNK), dtype=bool))

    def to_chunks(a):
        a = a.reshape(a.shape[:2] + (n_chunks, MLSTM_CHUNK) + a.shape[3:])
        return jnp.moveaxis(a, 2, 0)

    def step(carry, inp):
        c_mat, n_vec, m_st = carry
        qc, kc, vc, igc, lfc = inp
        b = jnp.cumsum(lfc, axis=-1)
        log_d = jnp.where(causal, b[..., :, None] - b[..., None, :] + igc[..., None, :], -jnp.inf)
        m_inter = b + m_st[..., None]
        m_q = jnp.maximum(m_inter, jnp.max(log_d, axis=-1))
        w_intra = jnp.exp(log_d - m_q[..., None])
        w_inter = jnp.exp(m_inter - m_q)
        s = jnp.einsum('bhjd,bhsd->bhjs', qc, kc) * w_intra
        num = jnp.einsum('bhjs,bhsv->bhjv', s, vc) + w_inter[..., None] * jnp.einsum('bhjd,bhdv->bhjv', qc, c_mat)
        den = jnp.sum(s, axis=-1) + w_inter * jnp.einsum('bhjd,bhd->bhj', qc, n_vec)
        h = num / jnp.maximum(jnp.abs(den), jnp.exp(-m_q))[..., None]
        b_last = b[..., -1]
        log_w = b_last[..., None] - b + igc
        m_new = jnp.maximum(b_last + m_st, jnp.max(log_w, axis=-1))
        w_key = jnp.exp(log_w - m_new[..., None])
        decay = jnp.exp(b_last + m_st - m_new)
        c_new = decay[..., None, None] * c_mat + jnp.einsum('bhsd,bhsv->bhdv', kc * w_key[..., None], vc)
        n_new = decay[..., None] * n_vec + jnp.einsum('bhs,bhsd->bhd', w_key, kc)
        return (c_new, n_new, m_new), h

    state, h = lax.scan(step, state, tuple(to_chunks(a) for a in (q, k, v, ig, lf)))
    h = jnp.moveaxis(h, 0, 2).reshape(bsz, nh, n_tok, MLSTM_DV)
    return h, state


def _bidir_mlstm(qkv, fwd, bwd, state_f, state_b):
    flip = lambda a: jnp.flip(a, axis=2)
    h_f, state_f = _mlstm_scan(*qkv, *fwd, state_f)
    h_b, state_b = _mlstm_scan(*(flip(a) for a in qkv), *(flip(a) for a in bwd), state_b)
    return h_f + flip(h_b), state_f, state_b


def _mlstm_mixer(h_ctx, h_lat, w_in, b_gate, w_norm, w_out, ctx_out):
    splits = [MLSTM_QK_DIM, 2 * MLSTM_QK_DIM, 2 * MLSTM_QK_DIM + MLSTM_V_DIM, 2 * MLSTM_QK_DIM + 2 * MLSTM_V_DIM]

    def project(h):
        bsz, n_tok, _ = h.shape
        q, k, v, o, g = jnp.split(h @ w_in, splits, axis=-1)

        def heads(a, d):
            return a.reshape(bsz, n_tok, MLSTM_HEADS, d).transpose(0, 2, 1, 3).astype(jnp.float32)

        q = heads(q, MLSTM_DK) * (MLSTM_DK ** -0.5)
        k = heads(k, MLSTM_DK)
        v = heads(v, MLSTM_DV)
        g = (g + b_gate).astype(jnp.float32)
        g = MLSTM_GATE_CAP * jnp.tanh(g / MLSTM_GATE_CAP)
        g = g.reshape(bsz, n_tok, MLSTM_N_GATES, MLSTM_HEADS).transpose(2, 0, 3, 1)
        fwd = (g[0], jax.nn.log_sigmoid(g[1]))
        bwd = (g[2], jax.nn.log_sigmoid(g[3]))
        return (q, k, v), o, fwd, bwd

    def readout(hh, o):
        bsz, _, n_tok, _ = hh.shape
        hh = _rmsnorm(hh, w_norm.reshape(MLSTM_HEADS, 1, MLSTM_DV))
        hh = hh.transpose(0, 2, 1, 3).reshape(bsz, n_tok, MLSTM_V_DIM).astype(o.dtype)
        return (hh * jax.nn.sigmoid(o)) @ w_out

    qkv_c, o_c, fwd_c, bwd_c = project(h_ctx)
    qkv_l, o_l, fwd_l, bwd_l = project(h_lat)
    zero = _mlstm_zero_state(h_ctx.shape[0])
    hh_c, st_f, st_b = _bidir_mlstm(qkv_c, fwd_c, bwd_c, zero, zero)
    hh_l, _, _ = _bidir_mlstm(qkv_l, fwd_l, bwd_l, st_f, st_b)
    y_lat = readout(hh_l, o_l)
    y_ctx = readout(hh_c, o_c) if ctx_out else None
    return y_ctx, y_lat


def _gqa_mixer(h_ctx, h_lat, w_in, q_norm, k_norm, w_out, cos, sin, ctx_out):
    scale = ATT_HEAD_DIM ** -0.5

    def project(h):
        bsz, n_tok, _ = h.shape
        q, k, v = jnp.split(h @ w_in, [ATT_HEADS * ATT_HEAD_DIM, (ATT_HEADS + ATT_KV_HEADS) * ATT_HEAD_DIM], axis=-1)
        q = _rmsnorm(q.reshape(bsz, n_tok, ATT_KV_HEADS, ATT_GROUP, ATT_HEAD_DIM), q_norm)
        k = _rmsnorm(k.reshape(bsz, n_tok, ATT_KV_HEADS, ATT_HEAD_DIM), k_norm)
        v = v.reshape(bsz, n_tok, ATT_KV_HEADS, ATT_HEAD_DIM)
        return q, k, v

    def attend(q, k, v):
        s = jnp.einsum('bqgrd,bkgd->bgrqk', q, k).astype(jnp.float32) * scale
        p = jax.nn.softmax(s, axis=-1).astype(v.dtype)
        return jnp.einsum('bgrqk,bkgd->bqgrd', p, v)

    bsz, n_lat, _ = h_lat.shape
    q_c, k_c, v_c = project(h_ctx)
    q_l, k_l, v_l = project(h_lat)
    q_l = _apply_rope(q_l, cos, sin)
    k_l = _apply_rope(k_l, cos, sin)
    k_all = jnp.concatenate([k_c, k_l], axis=1)
    v_all = jnp.concatenate([v_c, v_l], axis=1)
    n_blocks = n_lat // ATT_Q_BLOCK
    q_blocks = jnp.moveaxis(q_l.reshape(bsz, n_blocks, ATT_Q_BLOCK, ATT_KV_HEADS, ATT_GROUP, ATT_HEAD_DIM), 1, 0)
    o_l = lax.map(lambda qb: attend(qb, k_all, v_all), q_blocks)
    o_l = jnp.moveaxis(o_l, 0, 1).reshape(bsz, n_lat, ATT_HEADS * ATT_HEAD_DIM)
    y_lat = o_l @ w_out
    y_ctx = attend(q_c, k_c, v_c).reshape(bsz, h_ctx.shape[1], ATT_HEADS * ATT_HEAD_DIM) @ w_out if ctx_out else None
    return y_ctx, y_lat


def _ec_moe(h, w_router, w_gate, w_up, w_down):
    bsz, n_tok, d = h.shape
    cap = max(1, EC_CAPACITY * n_tok // N_EXPERTS)
    aff = jax.nn.softmax((h @ w_router).astype(jnp.float32), axis=-1)
    g, idx = lax.top_k(jnp.swapaxes(aff, 1, 2), cap)
    xg = jax.vmap(lambda hb, ib: hb[ib])(h, idx)
    a = jnp.einsum('becd,edf->becf', xg, w_gate)
    u = jnp.einsum('becd,edf->becf', xg, w_up)
    y = jnp.einsum('becf,efd->becd', jax.nn.silu(a) * u, w_down) * g[..., None].astype(h.dtype)
    return jax.vmap(lambda ib, yb: jnp.zeros((n_tok, d), yb.dtype).at[ib.reshape(-1)].add(yb.reshape(-1, d)))(idx, y)


def setup_inputs(seed: int = 0) -> dict:
    key = jax.random.key(seed)
    ks = iter(jax.random.split(key, 24))

    def nrm(shape, scale):
        return scale * jax.random.normal(next(ks), shape, jnp.float32)

    def gain(shape):
        return 1.0 + nrm(shape, 0.05)

    inv_d = D_MODEL ** -0.5
    att_w = ATT_HEADS * ATT_HEAD_DIM
    b_gate_base = jnp.tile(jnp.array([0.0, 3.0, 0.0, 3.0], jnp.float32)[:, None], (1, MLSTM_HEADS)).reshape(-1)
    return {
        'x': nrm((BATCH, SEQ, D_MODEL), 1.0),
        'c': nrm((BATCH, D_MODEL), 1.0),
        'ctx': nrm((BATCH, CTX_LEN, D_MODEL), 1.0),
        'c_ctx': nrm((D_MODEL,), 1.0),
        'w_mod': nrm((DEPTH, D_MODEL, 6 * D_MODEL), 0.5 * inv_d),
        'b_mod': nrm((DEPTH, 6 * D_MODEL), 0.02),
        'norm_mix': gain((DEPTH, D_MODEL)),
        'norm_ffn': gain((DEPTH, D_MODEL)),
        'mlstm_w_in': nrm((N_MLSTM_LAYERS, D_MODEL, MLSTM_IN_DIM), inv_d),
        'mlstm_b_gate': b_gate_base + nrm((N_MLSTM_LAYERS, MLSTM_N_GATES * MLSTM_HEADS), 0.1),
        'mlstm_norm': gain((N_MLSTM_LAYERS, MLSTM_V_DIM)),
        'mlstm_w_out': nrm((N_MLSTM_LAYERS, MLSTM_V_DIM, D_MODEL), MLSTM_V_DIM ** -0.5),
        'attn_w_in': nrm((N_ATT_LAYERS, D_MODEL, ATT_IN_DIM), inv_d),
        'attn_q_norm': gain((N_ATT_LAYERS, ATT_HEAD_DIM)),
        'attn_k_norm': gain((N_ATT_LAYERS, ATT_HEAD_DIM)),
        'attn_w_out': nrm((N_ATT_LAYERS, att_w, D_MODEL), att_w ** -0.5),
        'moe_router': nrm((DEPTH, D_MODEL, N_EXPERTS), inv_d),
        'moe_w_gate': nrm((DEPTH, N_EXPERTS, D_MODEL, D_EXPERT), inv_d),
        'moe_w_up': nrm((DEPTH, N_EXPERTS, D_MODEL, D_EXPERT), inv_d),
        'moe_w_down': nrm((DEPTH, N_EXPERTS, D_EXPERT, D_MODEL), D_EXPERT ** -0.5),
        'norm_final': gain((D_MODEL,)),
    }


def reference(x, c, ctx, c_ctx, w_mod, b_mod, norm_mix, norm_ffn, mlstm_w_in, mlstm_b_gate, mlstm_norm, mlstm_w_out,
              attn_w_in, attn_q_norm, attn_k_norm, attn_w_out, moe_router, moe_w_gate, moe_w_up, moe_w_down, norm_final):
    n_lat = x.shape[1]
    cos, sin = _axial_rope(n_lat)
    silu_c = jax.nn.silu(c)
    silu_cc = jax.nn.silu(c_ctx)
    xc = ctx
    for i in range(DEPTH):
        last = i == DEPTH - 1
        mod_l = (silu_c @ w_mod[i] + b_mod[i])[:, None, :]
        mod_c = silu_cc @ w_mod[i] + b_mod[i]
        sh1_l, sc1_l, g1_l, sh2_l, sc2_l, g2_l = jnp.split(mod_l, 6, axis=-1)
        sh1_c, sc1_c, g1_c, sh2_c, sc2_c, g2_c = jnp.split(mod_c, 6, axis=-1)
        h_l = _modulate(_rmsnorm(x, norm_mix[i]), sh1_l, sc1_l)
        h_c = _modulate(_rmsnorm(xc, norm_mix[i]), sh1_c, sc1_c)
        j = i // N_MIXERS
        if i % N_MIXERS == 0:
            y_c, y_l = _mlstm_mixer(h_c, h_l, mlstm_w_in[j], mlstm_b_gate[j], mlstm_norm[j], mlstm_w_out[j], not last)
        else:
            y_c, y_l = _gqa_mixer(h_c, h_l, attn_w_in[j], attn_q_norm[j], attn_k_norm[j], attn_w_out[j], cos, sin, not last)
        x = x + g1_l * y_l
        h_l = _modulate(_rmsnorm(x, norm_ffn[i]), sh2_l, sc2_l)
        x = x + g2_l * _ec_moe(h_l, moe_router[i], moe_w_gate[i], moe_w_up[i], moe_w_down[i])
        if not last:
            xc = xc + g1_c * y_c
            h_c = _modulate(_rmsnorm(xc, norm_ffn[i]), sh2_c, sc2_c)
            xc = xc + g2_c * _ec_moe(h_c, moe_router[i], moe_w_gate[i], moe_w_up[i], moe_w_down[i])
    return _rmsnorm(x, norm_final)
```

```cpp
#include <hip/hip_runtime.h>
#include <cstdio>
#include <cstdint>

#define GAS __attribute__((address_space(1)))
#define LAS __attribute__((address_space(3)))
typedef unsigned short bf16_t;
typedef short bf16x8 __attribute__((ext_vector_type(8)));
typedef short s16x4 __attribute__((ext_vector_type(4)));
typedef float f32x4 __attribute__((ext_vector_type(4)));
typedef float f32x2 __attribute__((ext_vector_type(2)));
typedef float f32x16 __attribute__((ext_vector_type(16)));
typedef unsigned u32x4 __attribute__((ext_vector_type(4)));
typedef unsigned u32x2 __attribute__((ext_vector_type(2)));

constexpr int D = 1024, NB = 16, SEQ = 4096, CTXL = 256, DEPTH = 4;
constexpr int RL = NB * SEQ, RC = NB * CTXL, RT = RL + RC;
constexpr int NE = 16, CAP_L = 512, CAP_C = 32, SLOTS_E = NB * CAP_L + NB * CAP_C;
constexpr int NMI = NB + 1;
constexpr int MW_IN = 3088;
constexpr int KVLEN = CTXL + SEQ;
constexpr int NWAVES = 8, NTHREADS = 512;
constexpr float NORM_EPS = 1e-6f;

constexpr size_t al256(size_t x) { return (x + 255) & ~(size_t)255; }
constexpr size_t WS_CTL   = 0;
constexpr size_t CTL_BYTES = 16384;
constexpr size_t WS_MODV  = WS_CTL + CTL_BYTES;
constexpr size_t WS_ROPE  = al256(WS_MODV + (size_t)DEPTH * NMI * 6 * D * 4);
constexpr size_t WS_XC    = al256(WS_ROPE + (size_t)2 * SEQ * 32 * 4);
constexpr size_t WS_GATES = al256(WS_XC + (size_t)RC * D * 4);
constexpr size_t WS_AFF   = al256(WS_GATES + (size_t)RT * 16 * 4);
constexpr size_t WS_INV   = al256(WS_AFF + (size_t)RT * 16 * 4);
constexpr size_t WS_SLROW = al256(WS_INV + (size_t)RT * 16 * 4);
constexpr size_t WS_SLG   = al256(WS_SLROW + (size_t)NE * SLOTS_E * 4);
constexpr size_t WS_WMI   = al256(WS_SLG + (size_t)NE * SLOTS_E * 4);
constexpr size_t WS_WMO   = al256(WS_WMI + (size_t)2 * 3072 * D * 2);
constexpr size_t WS_WAI   = al256(WS_WMO + (size_t)2 * D * D * 2);
constexpr size_t WS_WAO   = al256(WS_WAI + (size_t)2 * 1536 * D * 2);
constexpr size_t WS_W1    = al256(WS_WAO + (size_t)2 * D * D * 2);
constexpr size_t WS_W2    = al256(WS_W1 + (size_t)NE * 2048 * D * 2);
constexpr size_t WS_H     = al256(WS_W2 + (size_t)NE * D * D * 2);
constexpr size_t WS_MIX   = al256(WS_H + (size_t)RT * D * 2);
constexpr size_t WS_BIG0  = al256(WS_MIX + (size_t)RT * D * 2);
constexpr size_t BIG_HALF = (size_t)NE * SLOTS_E * D * 2;
constexpr size_t WS_BIG1  = al256(WS_BIG0 + BIG_HALF);
constexpr size_t WS_END   = al256(WS_BIG1 + BIG_HALF);
static_assert((size_t)RT * 3072 * 2 <= 2 * BIG_HALF, "qkvo fits");

#define LDS_WAIT() asm volatile("s_waitcnt lgkmcnt(0)" ::: "memory")
#define VM_WAIT() asm volatile("s_waitcnt vmcnt(0)" ::: "memory")
__device__ __forceinline__ unsigned f2bf(float f) { unsigned u = __builtin_bit_cast(unsigned, f); return (u + 0x7fffu + ((u >> 16) & 1u)) >> 16; }
__device__ __forceinline__ unsigned pk2(float lo, float hi) { return f2bf(lo) | (f2bf(hi) << 16); }
__device__ __forceinline__ float bf_lo(unsigned u) { return __builtin_bit_cast(float, u << 16); }
__device__ __forceinline__ float bf_hi(unsigned u) { return __builtin_bit_cast(float, u & 0xffff0000u); }
__device__ __forceinline__ float bf2f(bf16_t b) { return __builtin_bit_cast(float, ((unsigned)b) << 16); }
__device__ __forceinline__ float wave_sum(float v) {
#pragma unroll
    for (int o = 1; o < 64; o <<= 1) v += __shfl_xor(v, o);
    return v;
}
__device__ __forceinline__ float fast_exp(float x) { return __builtin_amdgcn_exp2f(x * 1.4426950408889634f); }
__device__ __forceinline__ float fast_rcp(float x) { return __builtin_amdgcn_rcpf(x); }
__device__ __forceinline__ float silu_f(float x) { return x / (1.f + __expf(-x)); }

#define XB_TMO      128
#define XB_XCNT(j)  (256  + 64 * (j))
#define XB_XSUB(j)  (1280 + 64 * (j))
#define XB_XGEN(j)  (2304 + 64 * (j))
#define XB_TOP      3328
#define XB_TOPGEN   3392
#define XCD_BAR_WORDS 3456
#define XB_SPIN_CAP (1u << 21)
static_assert(XCD_BAR_WORDS * 4 <= CTL_BYTES, "ctl");

__device__ __forceinline__ unsigned xb_ld(unsigned* p)              { return __hip_atomic_load(p, __ATOMIC_RELAXED, __HIP_MEMORY_SCOPE_AGENT); }
__device__ __forceinline__ unsigned xb_add(unsigned* p, unsigned v) { return __hip_atomic_fetch_add(p, v, __ATOMIC_RELAXED, __HIP_MEMORY_SCOPE_AGENT); }
__device__ __forceinline__ unsigned xb_xcc_id() { return (unsigned)__builtin_amdgcn_s_getreg((3 << 11) | 20) & 0xFu; }
#define XB_SPIN(cond, bar) do { unsigned _sp = 0; while (cond) { __builtin_amdgcn_s_sleep(1); \
    if ((++_sp & 255u) == 0u) { if (xb_ld(&(bar)[XB_TMO])) break; if (_sp > XB_SPIN_CAP) { atomicAdd(&(bar)[XB_TMO], 1u); break; } } } } while (0)

struct XcdBarrier { unsigned* bar; unsigned x; volatile LAS unsigned* st; };

__device__ __forceinline__ XcdBarrier xcd_barrier_post(unsigned* bar, volatile LAS unsigned* st) {
    XcdBarrier b; b.bar = bar; b.x = xb_xcc_id(); b.st = st;
    if (threadIdx.x == 0) (void)xb_add(&bar[XB_XCNT(b.x)], 1u);
    return b;
}
__device__ __forceinline__ void xcd_barrier_complete(unsigned* bar, unsigned x, unsigned& nloc, unsigned& nx) {
    const unsigned G = gridDim.x * gridDim.y * gridDim.z;
    unsigned sum, cnt, mine, sp = 0u;
    for (;;) {
        sum = 0u; cnt = 0u; mine = 0u;
#pragma unroll
        for (unsigned j = 0; j < 16; ++j) { const unsigned c = xb_ld(&bar[XB_XCNT(j)]); sum += c; cnt += (c > 0u) ? 1u : 0u; mine = (j == x) ? c : mine; }
        if (sum == G) break;
        __builtin_amdgcn_s_sleep(1);
        if ((++sp & 255u) == 0u) { if (xb_ld(&bar[XB_TMO])) break; if (sp > XB_SPIN_CAP) { atomicAdd(&bar[XB_TMO], 1u); break; } }
    }
    nloc = mine > 0u ? mine : 1u; nx = cnt > 0u ? cnt : 1u;
}
__device__ __forceinline__ void xcd_barrier(const XcdBarrier& b) {
    asm volatile("s_waitcnt vmcnt(0)" ::: "memory");
    __syncthreads();
    if (threadIdx.x == 0) {
        unsigned* bar = b.bar;
        __builtin_amdgcn_s_waitcnt(0);
        unsigned nloc = b.st[0], nx = b.st[1];
        if (nloc == 0u) { xcd_barrier_complete(bar, b.x, nloc, nx); b.st[0] = nloc; b.st[1] = nx; }
        const unsigned old = xb_add(&bar[XB_XSUB(b.x)], 1u);
        const unsigned gen = old / nloc;
        if (old + 1u == (gen + 1u) * nloc) {
            __builtin_amdgcn_fence(__ATOMIC_RELEASE, "agent");
            asm volatile("s_waitcnt vmcnt(0)" ::: "memory");
            const unsigned og = xb_add(&bar[XB_TOP], 1u);
            const unsigned tg = og / nx;
            if (og + 1u == (tg + 1u) * nx) xb_add(&bar[XB_TOPGEN], 1u);
            else XB_SPIN(xb_ld(&bar[XB_TOPGEN]) == tg, bar);
            __builtin_amdgcn_fence(__ATOMIC_ACQUIRE, "agent");
            xb_add(&bar[XB_XGEN(b.x)], 1u);
            asm volatile("s_waitcnt vmcnt(0)" ::: "memory");
        } else {
            XB_SPIN(xb_ld(&bar[XB_XGEN(b.x)]) == gen, bar);
            __builtin_amdgcn_fence(__ATOMIC_ACQUIRE, "agent");
            asm volatile("s_waitcnt vmcnt(0)" ::: "memory");
        }
    }
    __syncthreads();
}
namespace pg8 {
constexpr int BM = 256, BK = 64, HALF = 128, HTB = HALF * BK * 2, STAGE_BYTES = 8 * HTB, NXCD = 8, WGM = 8;

__host__ __device__ __forceinline__ int lds_byte(int r, int c) { const int st = (r >> 4) * 2 + (c >> 5), rr = r & 15, cc = c & 31, ob = rr * 64 + cc * 2; return st * 1024 + (ob ^ (((ob >> 9) & 1) << 5)); }
__host__ __device__ __forceinline__ void stage_rc(int b, int& R, int& C) { const int st = b / 1024, sb = b % 1024, swz = sb ^ (((sb >> 9) & 1) << 5); R = (st >> 1) * 16 + swz / 64; C = (st & 1) * 32 + (swz % 64) / 2; }
__host__ __device__ __forceinline__ int perm32(int rho) { const int n = rho >> 4, i = rho & 15; return 8 * (i >> 2) + 4 * n + (i & 3); }

struct Unit { const char* A; const char* B; int pm, pn; };

__device__ __forceinline__ bool static_tile(int i, int G, int c, int nM, int nN, int& pm, int& pn) {
    const int nwg = nM * nN; const long L = (long)i * G + c; if (L >= nwg) return false;
    int wgid = (int)L; { const int q = nwg / NXCD, r = nwg % NXCD, xcd = wgid % NXCD, off = wgid / NXCD; wgid = (xcd < r ? xcd * (q + 1) : r * (q + 1) + (xcd - r) * q) + off; }
    const int nig = WGM * nN, gid = wgid / nig, fm = gid * WGM, gsz = (nM - fm) < WGM ? (nM - fm) : WGM;
    pm = fm + ((wgid % nig) % gsz); pn = (wgid % nig) / gsz; return true;
}
struct PlainSched {
    const char* A; const char* Bt; int nM, nN, K, G, c;
    __device__ __forceinline__ bool next(int i, Unit& u) const {
        int pm, pn; if (!static_tile(i, G, c, nM, nN, pm, pn)) return false;
        u.pm = pm; u.pn = pn; u.A = A + (size_t)pm * 256 * K * 2; u.B = Bt + (size_t)pn * 256 * K * 2; return true;
    }
};
struct MoeSched {
    const char* A; const char* W; int tpe, nN, K, bN, G, c;
    __device__ __forceinline__ bool next(int i, Unit& u) const {
        int pm, pn; if (!static_tile(i, G, c, NE * tpe, nN, pm, pn)) return false;
        const int e = pm / tpe, rt = pm - e * tpe;
        u.pm = e * (SLOTS_E / 256) + rt; u.pn = pn;
        u.A = A + (size_t)u.pm * 256 * K * 2; u.B = W + ((size_t)e * bN + (size_t)pn * 256) * K * 2; return true;
    }
};

__device__ __forceinline__ unsigned cvt_pk_bf16(float lo, float hi) { unsigned r; asm volatile("v_cvt_pk_bf16_f32 %0, %1, %2" : "=v"(r) : "v"(lo), "v"(hi)); return r; }


struct EpiBf16 {
    static constexpr bool PERM = true;
    bf16_t* O; int ldc; int nscale; float scale;
    __device__ __forceinline__ void operator()(const f32x4 (&acc)[2][2][4][2], const Unit& u, int wr, int wc, int fr, int fq) const {
        const int row0 = u.pm * BM + wr * 64 + fr, col0 = u.pn * BM + wc * 32 + 8 * fq;
        const float s = (u.pn < nscale) ? scale : 1.f;
#pragma unroll
        for (int ai = 0; ai < 2; ++ai)
#pragma unroll
            for (int m = 0; m < 4; ++m) { bf16_t* rowp = O + (size_t)(row0 + ai * HALF + m * 16) * ldc + col0;
#pragma unroll
                for (int bj = 0; bj < 2; ++bj) { const f32x4 v0 = acc[ai][bj][m][0] * s, v1 = acc[ai][bj][m][1] * s;
                    u32x4 o; o.x = cvt_pk_bf16(v0[0], v0[1]); o.y = cvt_pk_bf16(v0[2], v0[3]); o.z = cvt_pk_bf16(v1[0], v1[1]); o.w = cvt_pk_bf16(v1[2], v1[3]);
                    *(u32x4*)(rowp + bj * HALF) = o; } }
    }
};
struct EpiResid {
    static constexpr bool PERM = false;
    const float* srcL; const float* srcC; float* dstL; float* dstC; const float* gate;
    __device__ __forceinline__ void operator()(const f32x4 (&acc)[2][2][4][2], const Unit& u, int wr, int wc, int fr, int fq) const {
        const bool isc = u.pm >= RL / 256;
        const int mi = isc ? NB : (u.pm >> 4);
        const int rbase = (isc ? (u.pm - RL / 256) : u.pm) * BM + wr * 64 + fr, col0 = u.pn * BM + wc * 32 + 4 * fq;
        const float* src = isc ? srcC : srcL; float* dst = isc ? dstC : dstL;
        const float* gp = gate + (size_t)mi * 6 * D + col0;
        f32x4 gv[2][2];
#pragma unroll
        for (int bj = 0; bj < 2; ++bj)
#pragma unroll
            for (int n = 0; n < 2; ++n) gv[bj][n] = *(const f32x4*)(gp + bj * HALF + n * 16);
#pragma unroll
        for (int ai = 0; ai < 2; ++ai)
#pragma unroll
            for (int m = 0; m < 4; ++m) { const size_t ro = (size_t)(rbase + ai * HALF + m * 16) * D + col0;
#pragma unroll
                for (int bj = 0; bj < 2; ++bj)
#pragma unroll
                    for (int n = 0; n < 2; ++n) { const f32x4 xv = *(const f32x4*)(src + ro + bj * HALF + n * 16);
                        *(f32x4*)(dst + ro + bj * HALF + n * 16) = xv + gv[bj][n] * acc[ai][bj][m][n]; } }
    }
};
struct EpiSwiglu {
    static constexpr bool PERM = true;
    bf16_t* O;
    __device__ __forceinline__ void operator()(const f32x4 (&acc)[2][2][4][2], const Unit& u, int wr, int wc, int fr, int fq) const {
        const int row0 = u.pm * BM + wr * 64 + fr, col0 = u.pn * HALF + wc * 32 + 8 * fq;
#pragma unroll
        for (int ai = 0; ai < 2; ++ai)
#pragma unroll
            for (int m = 0; m < 4; ++m) { bf16_t* rowp = O + (size_t)(row0 + ai * HALF + m * 16) * D + col0;
                float r[8];
#pragma unroll
                for (int n = 0; n < 2; ++n)
#pragma unroll
                    for (int j = 0; j < 4; ++j) { const float g = acc[ai][0][m][n][j], up = acc[ai][1][m][n][j]; r[n * 4 + j] = g * fast_rcp(1.f + fast_exp(-g)) * up; }
                u32x4 o; o.x = cvt_pk_bf16(r[0], r[1]); o.y = cvt_pk_bf16(r[2], r[3]); o.z = cvt_pk_bf16(r[4], r[5]); o.w = cvt_pk_bf16(r[6], r[7]);
                *(u32x4*)rowp = o; }
    }
};
struct EpiRowScale {
    static constexpr bool PERM = true;
    bf16_t* O; const float* g;
    __device__ __forceinline__ void operator()(const f32x4 (&acc)[2][2][4][2], const Unit& u, int wr, int wc, int fr, int fq) const {
        const int row0 = u.pm * BM + wr * 64 + fr, col0 = u.pn * BM + wc * 32 + 8 * fq;
#pragma unroll
        for (int ai = 0; ai < 2; ++ai)
#pragma unroll
            for (int m = 0; m < 4; ++m) { const int row = row0 + ai * HALF + m * 16; const float s = g[row]; bf16_t* rowp = O + (size_t)row * D + col0;
#pragma unroll
                for (int bj = 0; bj < 2; ++bj) { const f32x4 v0 = acc[ai][bj][m][0] * s, v1 = acc[ai][bj][m][1] * s;
                    u32x4 o; o.x = cvt_pk_bf16(v0[0], v0[1]); o.y = cvt_pk_bf16(v0[2], v0[3]); o.z = cvt_pk_bf16(v1[0], v1[1]); o.w = cvt_pk_bf16(v1[2], v1[3]);
                    *(u32x4*)(rowp + bj * HALF) = o; } }
    }
};

template <class Epi, class Sched>
__device__ __forceinline__ void gemm_phase(LAS unsigned char* lds, const int tid, const int K, const Sched& S, const Epi& E) {
    const int wid = __builtin_amdgcn_readfirstlane(tid >> 6), lane = tid & 63, wr = wid >> 2, wc = wid & 3, fr = lane & 15, fq = lane >> 4;
    const int nt = K / BK;
    unsigned voffA[2], voffB[2];
#pragma unroll
    for (int i = 0; i < 2; ++i) { int R, C; stage_rc(tid * 16 + i * 8192, R, C); const int Rb = Epi::PERM ? ((R & ~31) + perm32(R & 31)) : R;
        voffA[i] = (unsigned)(R * K + C) * 2u; voffB[i] = (unsigned)(Rb * K + C) * 2u; }
    const size_t kstep = (size_t)(BK * 2);
    const size_t hstep = (size_t)HALF * K * 2;
    const unsigned ldsw = (unsigned)wid * 1024u;
    const int aoff = lds_byte(wr * 64 + fr, fq * 8), boff = lds_byte(wc * 32 + fr, fq * 8);
#define PG8_SA(b, h) (((b) * 2 + (h)) * HTB)
#define PG8_SB(b, h) ((4 + (b) * 2 + (h)) * HTB)
#define PG8_STAGE(bufoff, gbase, voff) do { _Pragma("unroll") for (int _i = 0; _i < 2; ++_i) \
        __builtin_amdgcn_global_load_lds((const unsigned*)((const char*)(gbase) + (voff)[_i]), (LAS unsigned*)(lds + (bufoff) + ldsw + _i * 8192), 16, 0, 0); } while (0)
#define PG8_LDA(dst, b, h) do { _Pragma("unroll") for (int m = 0; m < 4; ++m) _Pragma("unroll") for (int k = 0; k < 2; ++k) dst[m][k] = *(const LAS bf16x8*)(lds + PG8_SA(b, h) + aoff + m * 2048 + k * 1024); } while (0)
#define PG8_LDB(dst, b, h) do { _Pragma("unroll") for (int n = 0; n < 2; ++n) _Pragma("unroll") for (int k = 0; k < 2; ++k) dst[n][k] = *(const LAS bf16x8*)(lds + PG8_SB(b, h) + boff + n * 2048 + k * 1024); } while (0)
#define PG8_MMA(ai, bj, At, Bt) do { __builtin_amdgcn_s_setprio(1); _Pragma("unroll") for (int m = 0; m < 4; ++m) _Pragma("unroll") for (int n = 0; n < 2; ++n) _Pragma("unroll") for (int k = 0; k < 2; ++k) \
        acc[ai][bj][m][n] = __builtin_amdgcn_mfma_f32_16x16x32_bf16(Bt[n][k], At[m][k], acc[ai][bj][m][n], 0, 0, 0); __builtin_amdgcn_s_setprio(0); } while (0)
#define PG8_WAIT_V(n) asm volatile("s_waitcnt vmcnt(" #n ")" ::: "memory")
#define PG8_WAIT_L(n) asm volatile("s_waitcnt lgkmcnt(" #n ")" ::: "memory")
#define PG8_BAR __builtin_amdgcn_s_barrier()
#define PG8_SCHED __builtin_amdgcn_sched_barrier(0)
    Unit cur, nxt; int ui = 0;
    if (!S.next(0, cur)) return;
    f32x4 acc[2][2][4][2];
#pragma unroll
    for (int a = 0; a < 2; ++a)
#pragma unroll
        for (int b = 0; b < 2; ++b)
#pragma unroll
            for (int m = 0; m < 4; ++m)
#pragma unroll
                for (int n = 0; n < 2; ++n) acc[a][b][m][n] = (f32x4){0.f, 0.f, 0.f, 0.f};
    bf16x8 At[4][2], B0[2][2], B1[2][2];
    const char* cA = cur.A; const char* cB = cur.B;
    PG8_STAGE(PG8_SB(0, 0), cB, voffB); PG8_STAGE(PG8_SB(0, 1), cB + hstep, voffB); PG8_STAGE(PG8_SA(0, 0), cA, voffA); PG8_STAGE(PG8_SA(0, 1), cA + hstep, voffA);
    if (wr == 1) PG8_BAR;
    PG8_WAIT_V(2); PG8_BAR;
    PG8_STAGE(PG8_SB(1, 0), cB + kstep, voffB); PG8_STAGE(PG8_SA(1, 0), cA + kstep, voffA); PG8_STAGE(PG8_SB(1, 1), cB + hstep + kstep, voffB);
    PG8_WAIT_V(6); PG8_BAR;
    for (;;) {
        const bool has_next = S.next(ui + 1, nxt);
        const char* nA = has_next ? nxt.A : cA; const char* nB = has_next ? nxt.B : cB;
        for (int t = 0; t < nt; t += 2) {
            const bool last = (t == nt - 2);
            const char* a1 = cA + (size_t)(t + 1) * kstep;
            const char* a2 = last ? nA : cA + (size_t)(t + 2) * kstep; const char* b2 = last ? nB : cB + (size_t)(t + 2) * kstep;
            const char* a3 = a2 + kstep; const char* b3 = b2 + kstep;
            PG8_LDB(B0, 0, 0); PG8_LDB(B1, 0, 1); PG8_SCHED; PG8_LDA(At, 0, 0); PG8_STAGE(PG8_SA(1, 1), a1 + hstep, voffA);
            PG8_WAIT_V(8); PG8_WAIT_L(0); PG8_BAR; PG8_MMA(0, 0, At, B0); PG8_MMA(0, 1, At, B1); PG8_BAR; PG8_SCHED;
            PG8_LDA(At, 0, 1); PG8_STAGE(PG8_SB(0, 0), b2, voffB); PG8_STAGE(PG8_SB(0, 1), b2 + hstep, voffB); PG8_STAGE(PG8_SA(0, 0), a2, voffA);
            PG8_WAIT_V(8); PG8_WAIT_L(0); PG8_BAR; PG8_MMA(1, 0, At, B0); PG8_MMA(1, 1, At, B1); PG8_BAR; PG8_SCHED;
            PG8_LDB(B0, 1, 0); PG8_LDB(B1, 1, 1); PG8_SCHED; PG8_LDA(At, 1, 0); PG8_STAGE(PG8_SA(0, 1), a2 + hstep, voffA);
            PG8_WAIT_V(8); PG8_WAIT_L(0); PG8_BAR; PG8_MMA(0, 0, At, B0); PG8_MMA(0, 1, At, B1); PG8_BAR; PG8_SCHED;
            PG8_LDA(At, 1, 1); PG8_STAGE(PG8_SB(1, 0), b3, voffB); PG8_STAGE(PG8_SB(1, 1), b3 + hstep, voffB); PG8_STAGE(PG8_SA(1, 0), a3, voffA);
            PG8_WAIT_V(8); PG8_WAIT_L(0); PG8_BAR; PG8_MMA(1, 0, At, B0); PG8_MMA(1, 1, At, B1); PG8_BAR; PG8_SCHED;
        }
        if (wr == 0) PG8_BAR;
        E(acc, cur, wr, wc, fr, fq);
        if (!has_next) break;
#pragma unroll
        for (int a = 0; a < 2; ++a)
#pragma unroll
            for (int b = 0; b < 2; ++b)
#pragma unroll
                for (int m = 0; m < 4; ++m)
#pragma unroll
                    for (int n = 0; n < 2; ++n) acc[a][b][m][n] = (f32x4){0.f, 0.f, 0.f, 0.f};
        cur = nxt; cA = nA; cB = nB; ++ui;
        if (wr == 1) PG8_BAR;
    }
    PG8_WAIT_V(0);
    PG8_BAR;
#undef PG8_SA
#undef PG8_SB
#undef PG8_STAGE
#undef PG8_LDA
#undef PG8_LDB
#undef PG8_MMA
#undef PG8_WAIT_V
#undef PG8_WAIT_L
#undef PG8_BAR
#undef PG8_SCHED
}
}
namespace attn_body {
constexpr int NW = 8, QBLK = 32, QB = QBLK * NW, KVBLK = 64;
__device__ __forceinline__ int crow(int r, int hi) { return (r & 3) + 8 * (r >> 2) + 4 * hi; }
#define SBAR() __builtin_amdgcn_sched_barrier(0)
constexpr int NSLOT = 3, SLOTB = 8192;
constexpr int LDS_K = 0, LDS_V = NSLOT * SLOTB, LDS_WS = 2 * NSLOT * SLOTB, LDS_OST = LDS_WS + NW * 64 * 4, LDS_BYTES = LDS_OST + NW * 4096;
constexpr float C2 = 0.125f * 1.4426950408889634f;
__device__ __forceinline__ void glds16(const void* gsrc, unsigned lds_dst) { unsigned keep;
  asm volatile("s_mov_b32 %0, m0\n\ts_mov_b32 m0, %2\n\ts_nop 0\n\tglobal_load_lds_dwordx4 %1, off\n\ts_mov_b32 m0, %0" : "=&s"(keep) : "v"(gsrc), "s"(lds_dst) : "memory"); }
__device__ __forceinline__ float max3f(float a, float b, float c) { float r; asm("v_max3_f32 %0, %1, %2, %3" : "=v"(r) : "v"(a), "v"(b), "v"(c)); return r; }
__device__ __forceinline__ float max2f(float a, float b) { float r; asm("v_max_f32_e32 %0, %1, %2" : "=v"(r) : "v"(a), "v"(b)); return r; }
__device__ __forceinline__ float fadd_s(float a, float b) { float r; asm("v_add_f32_e32 %0, %1, %2" : "=v"(r) : "v"(a), "v"(b)); return r; }
__device__ __forceinline__ float fsub_s(float a, float b) { float r; asm("v_sub_f32_e32 %0, %1, %2" : "=v"(r) : "v"(a), "v"(b)); return r; }
typedef __bf16 bf16x2_t __attribute__((ext_vector_type(2)));
__device__ __forceinline__ unsigned cvtpk_s(float lo, float hi) { f32x2 v = {lo, hi}; bf16x2_t b = __builtin_convertvector(v, bf16x2_t); return __builtin_bit_cast(unsigned, b); }
#define WAIT_BAR(N) asm volatile("s_waitcnt vmcnt(" #N ") lgkmcnt(0)\n\ts_barrier" ::: "memory")

__device__ __forceinline__ void qkt(f32x16& p0, f32x16& p1, const char* Kslot, const bf16x8* qr, const f32x16& negm, int r32, int hi) {
  const char* kb = Kslot + hi * 1024 + r32 * 16;
  #pragma unroll
  for (int d0 = 0; d0 < 4; ++d0) {
    const bf16x8 b0 = *reinterpret_cast<const bf16x8*>(kb + d0 * 2048);
    const bf16x8 b1 = *reinterpret_cast<const bf16x8*>(kb + d0 * 2048 + 512);
    if (d0 == 0) { p0 = __builtin_amdgcn_mfma_f32_32x32x16_bf16(b0, qr[0], negm, 0, 0, 0); p1 = __builtin_amdgcn_mfma_f32_32x32x16_bf16(b1, qr[0], negm, 0, 0, 0); }
    else { p0 = __builtin_amdgcn_mfma_f32_32x32x16_bf16(b0, qr[d0], p0, 0, 0, 0); p1 = __builtin_amdgcn_mfma_f32_32x32x16_bf16(b1, qr[d0], p1, 0, 0, 0); } }
}
typedef __attribute__((address_space(3))) const char* lds_cptr;
typedef short v4i16_t __attribute__((ext_vector_type(4)));
__device__ __forceinline__ void kload8(bf16x8* kf, lds_cptr kp) {
  kf[0] = *(const LAS bf16x8*)(kp);        kf[1] = *(const LAS bf16x8*)(kp + 512);
  kf[2] = *(const LAS bf16x8*)(kp + 2048); kf[3] = *(const LAS bf16x8*)(kp + 2560);
  kf[4] = *(const LAS bf16x8*)(kp + 4096); kf[5] = *(const LAS bf16x8*)(kp + 4608);
  kf[6] = *(const LAS bf16x8*)(kp + 6144); kf[7] = *(const LAS bf16x8*)(kp + 6656);
}
__device__ __forceinline__ void kload2(bf16x8* kf, lds_cptr kp, int j) { kf[2 * j] = *(const LAS bf16x8*)(kp + j * 2048); kf[2 * j + 1] = *(const LAS bf16x8*)(kp + j * 2048 + 512); }
__device__ __forceinline__ s16x4 vtr(lds_cptr p) { return __builtin_bit_cast(s16x4, __builtin_amdgcn_ds_read_tr16_b64_v4i16((LAS v4i16_t*)p)); }
__device__ __forceinline__ float rowmax(const f32x16& p0, const f32x16& p1) {
  float a = max3f(p0[0], p0[1], p1[0]), b = max3f(p0[2], p0[3], p1[1]); a = max3f(a, p1[2], p1[3]);
  #pragma unroll
  for (int r = 4; r < 16; r += 4) { a = max3f(a, p0[r], p0[r + 1]); b = max3f(b, p0[r + 2], p0[r + 3]); a = max3f(a, p1[r], p1[r + 1]); b = max3f(b, p1[r + 2], p1[r + 3]); }
  const float m = max2f(a, b);
  auto rr = __builtin_amdgcn_permlane32_swap(__float_as_uint(m), __float_as_uint(m), false, false);
  return max2f(__uint_as_float(rr[0]), __uint_as_float(rr[1]));
}
__device__ __forceinline__ void pv(f32x16* o, int vb, bf16x8 pa0, bf16x8 pa1, bf16x8 pa2, bf16x8 pa3) {
  #pragma unroll
  for (int d0 = 0; d0 < 2; ++d0) { s16x4 lo[4], hi[4];
    #pragma unroll
    for (int ks = 0; ks < 4; ++ks) {
      asm volatile("ds_read_b64_tr_b16 %0,%1 offset:%c2" : "=&v"(lo[ks]) : "v"(vb), "i"(d0 * 4096 + ks * 1024) : "memory");
      asm volatile("ds_read_b64_tr_b16 %0,%1 offset:%c2" : "=&v"(hi[ks]) : "v"(vb), "i"(d0 * 4096 + ks * 1024 + 512) : "memory"); }
    asm volatile("s_waitcnt lgkmcnt(0)" ::: "memory"); SBAR();
    #define PK(k) (bf16x8){lo[k][0], lo[k][1], lo[k][2], lo[k][3], hi[k][0], hi[k][1], hi[k][2], hi[k][3]}
    o[d0] = __builtin_amdgcn_mfma_f32_32x32x16_bf16(pa0, PK(0), o[d0], 0, 0, 0);
    o[d0] = __builtin_amdgcn_mfma_f32_32x32x16_bf16(pa1, PK(1), o[d0], 0, 0, 0);
    o[d0] = __builtin_amdgcn_mfma_f32_32x32x16_bf16(pa2, PK(2), o[d0], 0, 0, 0);
    o[d0] = __builtin_amdgcn_mfma_f32_32x32x16_bf16(pa3, PK(3), o[d0], 0, 0, 0);
    #undef PK
  }
}

template <int THRL> __device__ __forceinline__ void attn_unit(const bf16_t* Qrow0, int QP, const bf16_t* __restrict__ Kh, const bf16_t* __restrict__ Vh, int KVP, int NT, bf16_t* Orow0, int OP, char* shm, const int tid) {
  const int lane = tid & 63, r32 = lane & 31, hi = lane >> 5; const int wid = __builtin_amdgcn_readfirstlane(tid >> 6);
  const bf16_t* Qw = Qrow0 + (long)(wid * QBLK) * QP;
  const unsigned lds0 = (unsigned)(uintptr_t)shm;
  float* wsf = (float*)(shm + LDS_WS) + wid * 64;
  const bf16_t* ksrc = Kh + (long)lane * KVP + wid * 8;
  const bf16_t* vsrc = Vh + (long)(16 * (wid & 3) + (lane >> 2)) * KVP + (wid >> 2) * 32 + (lane & 3) * 8;
  const unsigned kdst = lds0 + LDS_K + wid * 1024, vdst = lds0 + LDS_V + wid * 1024;
  #define DMA_K(t, slot) glds16(ksrc + (long)(t) * KVBLK * KVP, (unsigned)__builtin_amdgcn_readfirstlane(kdst + (slot)))
  #define DMA_V(t, slot) glds16(vsrc + (long)(t) * KVBLK * KVP, (unsigned)__builtin_amdgcn_readfirstlane(vdst + (slot)))
  const int vb0 = (int)(lds0 + LDS_V) + ((lane >> 4) & 1) * 32 + (lane & 3) * 8 + (4 * hi + ((lane & 15) >> 2)) * 64;
  const char* Kbase = shm + LDS_K; bf16x8 kf[8];
  const lds_cptr shm3 = (lds_cptr)shm; const lds_cptr kp0 = shm3 + LDS_K + hi * 1024 + r32 * 16; const lds_cptr vp0 = shm3 + LDS_V + ((lane >> 4) & 1) * 32 + (lane & 3) * 8 + (4 * hi + ((lane & 15) >> 2)) * 64;
  DMA_K(0, 0); DMA_V(0, 0); DMA_K(1, SLOTB);
  bf16x8 qr[4];
  #pragma unroll
  for (int d0 = 0; d0 < 4; ++d0) qr[d0] = *reinterpret_cast<const bf16x8*>(&Qw[(long)r32 * QP + d0 * 16 + hi * 8]);
  float mhat = 0.f, l_reg = 0.f; f32x16 o[2]; o[0] = f32x16{}; o[1] = f32x16{}; f32x16 negm = f32x16{}; asm volatile("" : "+v"(negm));
  bool resc = false;
  #define START(P0, P1) do { const float rm = rowmax(P0, P1); resc = false; \
    { const float dl = rm; mhat = fadd_s(mhat, dl); \
      _Pragma("unroll") for (int r = 0; r < 16; ++r) { P0[r] = fsub_s(P0[r], dl); P1[r] = fsub_s(P1[r], dl); } \
      _Pragma("unroll") for (int r = 0; r < 16; ++r) negm[r] = -mhat; asm volatile("" : "+v"(negm)); } \
    _Pragma("unroll") for (int r = 0; r < 16; ++r) P0[r] = __builtin_amdgcn_exp2f(P0[r]); } while (0)
  #define RESC() do { if (resc) { asm volatile("s_waitcnt lgkmcnt(0)" ::: "memory"); \
      _Pragma("unroll") for (int d_ = 0; d_ < 2; ++d_) _Pragma("unroll") for (int r = 0; r < 16; ++r) o[d_][r] *= wsf[crow(r, hi)]; } } while (0)
  f32x16 pA0, pA1, pB0, pB1;
  int sl_prev = 0, sl_cur = 0, sl_next = SLOTB;
  #define ROT() do { sl_prev = sl_cur; sl_cur = sl_next; sl_next = (sl_next == (NSLOT - 1) * SLOTB) ? 0 : sl_next + SLOTB; } while (0)
  DMA_K(2, 2 * SLOTB);
  WAIT_BAR(3);
  qkt(pA0, pA1, Kbase, qr, negm, r32, hi); asm volatile("s_nop 15\n\ts_nop 7" : "+v"(pA0), "+v"(pA1));
  START(pA0, pA1);
  _Pragma("unroll") for (int r = 0; r < 16; ++r) pA1[r] = __builtin_amdgcn_exp2f(pA1[r]);
  WAIT_BAR(0);
  DMA_K(3, 0); DMA_V(1, SLOTB);
  ROT();
  kload8(kf, kp0 + sl_cur);
  WAIT_BAR(2);
  s16x4 vlo[8], vhi[8]; u32x4 pw0, pw1, pw2, pw3;
  #define PKW(P, B) cvtpk_s(P[B], P[B + 1])
  #define PAF(k) __builtin_bit_cast(bf16x8, pw##k)
  #define VFR(i) (bf16x8){vlo[i][0], vlo[i][1], vlo[i][2], vlo[i][3], vhi[i][0], vhi[i][1], vhi[i][2], vhi[i][3]}
  #define PIN(x) asm volatile("" : "+v"(x))
  #define MX3(a, b, c) __builtin_fmaxf(__builtin_fmaxf((a), (b)), (c))
  #define GAPA(MF, A0, A1, A2, A3, W0, W1, PW) do { MF; sacc += A0; sacc += A1; sacc += A2; sacc += A3; PIN(sacc); W0; W1; PIN(PW); SBAR(); } while (0)
  #define EX(v) __builtin_amdgcn_exp2f(v)
  #define GAPB(MF, X, B) do { MF; X[B] = EX(X[B]); X[B + 1] = EX(X[B + 1]); X[B + 2] = EX(X[B + 2]); X[B + 3] = EX(X[B + 3]); PIN(X); SBAR(); } while (0)
  #define VRD(i) do { vlo[i] = vtr(vp_ + (((i) >> 2) * 4096 + ((i) & 3) * 1024)); vhi[i] = vtr(vp_ + (((i) >> 2) * 4096 + ((i) & 3) * 1024 + 512)); } while (0)
  #define KRD(G, j) do { if (G) { kload2(kf, kp0 + sl_next, j); SBAR(); } } while (0)
  #define STEP(C0, C1, P0, P1, t, GK, GV, GL) do { SBAR(); \
    const lds_cptr vp_ = vp0 + sl_prev; \
    VRD(0); SBAR(); float sacc = (P0[0] + P0[1]); \
    GAPA(C0 = __builtin_amdgcn_mfma_f32_32x32x16_bf16(kf[0], qr[0], negm, 0, 0, 0), P0[2], P0[3], P0[4], P0[5],     pw0[0] = PKW(P0, 0), pw0[1] = PKW(P0, 2), pw0); \
    VRD(4); SBAR(); GAPA(C1 = __builtin_amdgcn_mfma_f32_32x32x16_bf16(kf[1], qr[0], negm, 0, 0, 0), P0[6], P0[7], P0[8], P0[9],     pw0[2] = PKW(P0, 4), pw0[3] = PKW(P0, 6), pw0); \
    VRD(1); SBAR(); GAPA(C0 = __builtin_amdgcn_mfma_f32_32x32x16_bf16(kf[2], qr[1], C0, 0, 0, 0),   P0[10], P0[11], P0[12], P0[13], pw1[0] = PKW(P0, 8), pw1[1] = PKW(P0, 10), pw1); \
    VRD(5); SBAR(); GAPA(C1 = __builtin_amdgcn_mfma_f32_32x32x16_bf16(kf[3], qr[1], C1, 0, 0, 0),   P0[14], P0[15], P1[0], P1[1],   pw1[2] = PKW(P0, 12), pw1[3] = PKW(P0, 14), pw1); \
    VRD(2); SBAR(); GAPA(C0 = __builtin_amdgcn_mfma_f32_32x32x16_bf16(kf[4], qr[2], C0, 0, 0, 0),   P1[2], P1[3], P1[4], P1[5],     pw2[0] = PKW(P1, 0), pw2[1] = PKW(P1, 2), pw2); \
    VRD(6); SBAR(); GAPA(C1 = __builtin_amdgcn_mfma_f32_32x32x16_bf16(kf[5], qr[2], C1, 0, 0, 0),   P1[6], P1[7], P1[8], P1[9],     pw2[2] = PKW(P1, 4), pw2[3] = PKW(P1, 6), pw2); \
    VRD(3); SBAR(); GAPA(C0 = __builtin_amdgcn_mfma_f32_32x32x16_bf16(kf[6], qr[3], C0, 0, 0, 0),   P1[10], P1[11], P1[12], P1[13], pw3[0] = PKW(P1, 8), pw3[1] = PKW(P1, 10), pw3); \
    VRD(7); SBAR(); GAPA(C1 = __builtin_amdgcn_mfma_f32_32x32x16_bf16(kf[7], qr[3], C1, 0, 0, 0),   P1[14], P1[15], 0.f, 0.f,       pw3[2] = PKW(P1, 12), pw3[3] = PKW(P1, 14), pw3); \
    l_reg += sacc; \
    if (GK) { DMA_K((t) + 3, sl_cur); } if (GV) { DMA_V((t) + 1, sl_next); } \
    { float a = MX3(C0[0], C0[1], C1[0]), b = MX3(C0[2], C0[3], C1[1]); a = MX3(a, C1[2], C1[3]); \
      _Pragma("unroll") for (int r = 4; r < 16; r += 4) { a = MX3(a, C0[r], C0[r + 1]); b = MX3(b, C0[r + 2], C0[r + 3]); a = MX3(a, C1[r], C1[r + 1]); b = MX3(b, C1[r + 2], C1[r + 3]); } \
      float rm = __builtin_fmaxf(a, b); { auto rr = __builtin_amdgcn_permlane32_swap(__float_as_uint(rm), __float_as_uint(rm), false, false); rm = __builtin_fmaxf(__uint_as_float(rr[0]), __uint_as_float(rr[1])); } \
      resc = false; \
      if (__builtin_expect(__any(rm > (float)THRL), 0)) { const float dl = __builtin_fmaxf(rm, 0.f); mhat += dl; \
        _Pragma("unroll") for (int r = 0; r < 16; ++r) { C0[r] -= dl; C1[r] -= dl; } \
        _Pragma("unroll") for (int r = 0; r < 16; ++r) negm[r] = -mhat; asm volatile("" : "+v"(negm)); \
        const float f = __builtin_amdgcn_exp2f(-dl); l_reg *= f; if (hi == 0) wsf[r32] = f; resc = true; } } \
    SBAR(); \
    GAPB(o[0] = __builtin_amdgcn_mfma_f32_32x32x16_bf16(PAF(0), VFR(0), o[0], 0, 0, 0), C0, 0); \
    GAPB(o[1] = __builtin_amdgcn_mfma_f32_32x32x16_bf16(PAF(0), VFR(4), o[1], 0, 0, 0), C0, 4); \
    KRD(GL, 0); GAPB(o[0] = __builtin_amdgcn_mfma_f32_32x32x16_bf16(PAF(1), VFR(1), o[0], 0, 0, 0), C0, 8); \
    KRD(GL, 1); GAPB(o[1] = __builtin_amdgcn_mfma_f32_32x32x16_bf16(PAF(1), VFR(5), o[1], 0, 0, 0), C0, 12); \
    KRD(GL, 2); GAPB(o[0] = __builtin_amdgcn_mfma_f32_32x32x16_bf16(PAF(2), VFR(2), o[0], 0, 0, 0), C1, 0); \
    KRD(GL, 3); GAPB(o[1] = __builtin_amdgcn_mfma_f32_32x32x16_bf16(PAF(2), VFR(6), o[1], 0, 0, 0), C1, 4); \
    GAPB(o[0] = __builtin_amdgcn_mfma_f32_32x32x16_bf16(PAF(3), VFR(3), o[0], 0, 0, 0), C1, 8); \
    GAPB(o[1] = __builtin_amdgcn_mfma_f32_32x32x16_bf16(PAF(3), VFR(7), o[1], 0, 0, 0), C1, 12); \
    } while (0)
  int t = 1;
  for (; t + 5 < NT; t += 2) {
    STEP(pB0, pB1, pA0, pA1, t, true, true, true);     WAIT_BAR(2); RESC(); ROT();
    STEP(pA0, pA1, pB0, pB1, t + 1, true, true, true); WAIT_BAR(2); RESC(); ROT();
  }
  #define ENDW(tt) do { if ((tt) + 3 < NT) { WAIT_BAR(2); } else if ((tt) + 2 < NT) { WAIT_BAR(1); } else { WAIT_BAR(0); } } while (0)
  for (; t + 1 < NT; t += 2) {
    STEP(pB0, pB1, pA0, pA1, t, (t + 3 < NT), (t + 1 < NT), (t + 1 < NT));         ENDW(t);     RESC(); ROT();
    STEP(pA0, pA1, pB0, pB1, t + 1, (t + 4 < NT), (t + 2 < NT), (t + 2 < NT));     ENDW(t + 1); RESC(); ROT();
  }
  STEP(pB0, pB1, pA0, pA1, NT - 1, false, false, false); RESC();
  { float sacc = pB0[0] + pB0[1]; _Pragma("unroll") for (int r = 2; r < 16; ++r) sacc += pB0[r]; _Pragma("unroll") for (int r = 0; r < 16; ++r) sacc += pB1[r]; l_reg += sacc;
    pw0 = (u32x4){PKW(pB0, 0), PKW(pB0, 2), PKW(pB0, 4), PKW(pB0, 6)}; pw1 = (u32x4){PKW(pB0, 8), PKW(pB0, 10), PKW(pB0, 12), PKW(pB0, 14)}; pw2 = (u32x4){PKW(pB1, 0), PKW(pB1, 2), PKW(pB1, 4), PKW(pB1, 6)}; pw3 = (u32x4){PKW(pB1, 8), PKW(pB1, 10), PKW(pB1, 12), PKW(pB1, 14)};
    SBAR(); pv(o, vb0 + sl_cur, PAF(0), PAF(1), PAF(2), PAF(3)); }
  #undef PKW
  #undef PAF
  #undef VFR
  #undef PIN
  #undef MX3
  #undef GAPA
  #undef GAPB
  #undef EX
  #undef VRD
  #undef KRD
  #undef STEP
  #undef ENDW
  { auto rr = __builtin_amdgcn_permlane32_swap(__float_as_uint(l_reg), __float_as_uint(l_reg), false, false); l_reg = __uint_as_float(rr[0]) + __uint_as_float(rr[1]); }
  if (hi == 0) wsf[32 + r32] = l_reg; asm volatile("s_waitcnt lgkmcnt(0)" ::: "memory");
  float rli[16];
  #pragma unroll
  for (int r = 0; r < 16; ++r) rli[r] = __builtin_amdgcn_rcpf(wsf[32 + crow(r, hi)]);
  bf16_t* Ow = Orow0 + (long)(wid * QBLK) * OP;
  { bf16_t* stg = (bf16_t*)(shm + LDS_OST) + wid * 2048;
    #pragma unroll
    for (int r = 0; r < 16; ++r) { const int orow = crow(r, hi);
      #pragma unroll
      for (int d0 = 0; d0 < 2; ++d0) stg[orow * 64 + d0 * 32 + r32] = (bf16_t)f2bf(o[d0][r] * rli[r]); }
    asm volatile("s_waitcnt lgkmcnt(0)" ::: "memory");
    #pragma unroll
    for (int i = 0; i < 4; ++i) { const int row = i * 8 + (lane >> 3), ch = lane & 7; const u32x4 v = *(const u32x4*)(stg + row * 64 + ch * 8); *(u32x4*)(Ow + (long)row * OP + ch * 8) = v; } }
  asm volatile("s_waitcnt lgkmcnt(0)\n\ts_barrier" ::: "memory");
  #undef DMA_K
  #undef DMA_V
  #undef START
  #undef RESC
  #undef ROT
}
#undef SBAR
#undef WAIT_BAR
}
struct Frame {
    LAS unsigned char* lds;
    int tid, lane, wave;
    int vcu, G, gw, NGW, bid;
};

__device__ __forceinline__ void transpose_item(const float* W, int ldw, int K, bf16_t* WT, int k0, int n0, int dst_row0, LAS float* scr, int lane) {
#pragma unroll 8
    for (int i = 0; i < 32; ++i) { const int kk = 2 * i + (lane >> 5); scr[kk * 33 + (lane & 31)] = W[(size_t)(k0 + kk) * ldw + n0 + (lane & 31)]; }
    LDS_WAIT(); asm volatile("" ::: "memory");
    const int c = lane & 7;
#pragma unroll
    for (int j = 0; j < 4; ++j) { const int n = (lane >> 3) + 8 * j; const LAS float* s = scr + (8 * c) * 33 + n;
        u32x4 o; o.x = pk2(s[0 * 33], s[1 * 33]); o.y = pk2(s[2 * 33], s[3 * 33]); o.z = pk2(s[4 * 33], s[5 * 33]); o.w = pk2(s[6 * 33], s[7 * 33]);
        *(u32x4*)(WT + (size_t)(dst_row0 + n) * K + k0 + 8 * c) = o; }
    LDS_WAIT(); asm volatile("" ::: "memory");
}

__device__ __forceinline__ void sincos_acc(float x, float& s, float& c) {
    const float k = rintf(x * 0.63661977236758134f);
    float r = fmaf(k, -1.5703125f, x); r = fmaf(k, -4.837512969970703125e-4f, r); r = fmaf(k, -7.54978995489188e-8f, r);
    const float z = r * r;
    const float sp = r + r * z * fmaf(z, fmaf(z, -1.9515295891e-4f, 8.3321608736e-3f), -1.6666654611e-1f);
    const float cp = fmaf(z * z, fmaf(z, fmaf(z, 2.443315711809948e-5f, -1.388731625493765e-3f), 4.166664568298827e-2f), fmaf(z, -0.5f, 1.0f));
    const int q = ((int)k) & 3;
    const float ss = (q & 1) ? cp : sp, cc = (q & 1) ? sp : cp;
    s = (q & 2) ? -ss : ss; c = ((q + 1) & 2) ? -cc : cc;
}

__device__ __forceinline__ void p0_prologue(Frame& F, const float* const* in, unsigned char* ws) {
    const float* c_lat = in[1]; const float* c_ctx = in[3]; const float* w_mod = in[4]; const float* b_mod = in[5];
    LAS float* sil = (LAS float*)F.lds;
    for (int i = F.tid; i < NMI * D; i += NTHREADS) { const int mi = i >> 10, k = i & 1023; const float v = (mi < NB) ? c_lat[mi * D + k] : c_ctx[k]; sil[i] = silu_f(v); }
    __syncthreads();
    {
        float* modv = (float*)(ws + WS_MODV);
        const int NT16 = 6 * D / 16;
        for (int task = F.gw; task < DEPTH * NT16; task += F.NGW) {
            const int layer = task / NT16, j0 = (task % NT16) * 16, jj = F.lane & 15, kq = F.lane >> 4;
            const float* wp = w_mod + (size_t)layer * D * 6 * D + j0 + jj;
            float acc[NMI];
#pragma unroll
            for (int m = 0; m < NMI; ++m) acc[m] = 0.f;
            for (int k = kq; k < D; k += 4) { const float w = wp[(size_t)k * 6 * D];
#pragma unroll
                for (int m = 0; m < NMI; ++m) acc[m] = fmaf(sil[m * D + k], w, acc[m]); }
#pragma unroll
            for (int m = 0; m < NMI; ++m) { float v = acc[m]; v += __shfl_xor(v, 16); v += __shfl_xor(v, 32); acc[m] = v; }
            if (kq == 0) { const float bb = b_mod[layer * 6 * D + j0 + jj];
#pragma unroll
                for (int m = 0; m < NMI; ++m) modv[((size_t)layer * NMI + m) * 6 * D + j0 + jj] = acc[m] + bb; }
        }
    }
    __syncthreads();
    {
        LAS float* scr = (LAS float*)(F.lds) + F.wave * (64 * 33);
        constexpr int I_MI = 16 * 96, I_MO = 16 * 32, I_AI = 16 * 48, I_AO = 16 * 32;
        constexpr int PER_J = I_MI + I_MO + I_AI + I_AO;
        for (int it = F.gw; it < 2 * PER_J; it += F.NGW) {
            const int j = it / PER_J; int r = it % PER_J;
            if (r < I_MI) { const int kb = r / 96, nb = r % 96; transpose_item(in[8] + (size_t)j * D * MW_IN, MW_IN, D, (bf16_t*)(ws + WS_WMI) + (size_t)j * 3072 * D, 64 * kb, 32 * nb, 32 * nb, scr, F.lane); continue; } r -= I_MI;
            if (r < I_MO) { const int kb = r / 32, nb = r % 32; transpose_item(in[11] + (size_t)j * D * D, D, D, (bf16_t*)(ws + WS_WMO) + (size_t)j * D * D, 64 * kb, 32 * nb, 32 * nb, scr, F.lane); continue; } r -= I_MO;
            if (r < I_AI) { const int kb = r / 48, nb = r % 48; transpose_item(in[12] + (size_t)j * D * 1536, 1536, D, (bf16_t*)(ws + WS_WAI) + (size_t)j * 1536 * D, 64 * kb, 32 * nb, 32 * nb, scr, F.lane); continue; } r -= I_AI;
            { const int kb = r / 32, nb = r % 32; transpose_item(in[15] + (size_t)j * D * D, D, D, (bf16_t*)(ws + WS_WAO) + (size_t)j * D * D, 64 * kb, 32 * nb, 32 * nb, scr, F.lane); }
        }
    }
    {
        float* rc = (float*)(ws + WS_ROPE); float* rs = rc + SEQ * 32;
        for (int i = F.bid * NTHREADS + F.tid; i < SEQ * 32; i += F.G * NTHREADS) {
            const int t = i >> 5, p = i & 31; const float pos = (p < 16) ? (float)(t >> 6) : (float)(t & 63);
            const float inv = exp2f(-(float)(p & 15) * (13.287712379549449f / 16.f));
            float s, c; sincos_acc(pos * inv, s, c); rc[i] = c; rs[i] = s; }
    }
    __syncthreads();
}

__device__ __forceinline__ void moe_weights(Frame& F, const float* wg, const float* wu, const float* wd, unsigned char* ws) {
    LAS float* scr = (LAS float*)(F.lds) + F.wave * (64 * 33);
    constexpr int IPM = 16 * 32;
    bf16_t* W1 = (bf16_t*)(ws + WS_W1); bf16_t* W2 = (bf16_t*)(ws + WS_W2);
    for (int it = F.gw; it < NE * 3 * IPM; it += F.NGW) {
        const int e = it / (3 * IPM); int r = it % (3 * IPM); const int which = r / IPM; r %= IPM;
        const int kb = r / 32, nb = r % 32, n0 = 32 * nb;
        if (which == 0)      transpose_item(wg + (size_t)e * D * D, D, D, W1 + (size_t)e * 2048 * D, 64 * kb, n0, 256 * (n0 >> 7) + (n0 & 127), scr, F.lane);
        else if (which == 1) transpose_item(wu + (size_t)e * D * D, D, D, W1 + (size_t)e * 2048 * D, 64 * kb, n0, 256 * (n0 >> 7) + 128 + (n0 & 127), scr, F.lane);
        else                 transpose_item(wd + (size_t)e * D * D, D, D, W2 + (size_t)e * D * D, 64 * kb, n0, n0, scr, F.lane);
    }
    __syncthreads();
}

template <int MODE>
__device__ __forceinline__ void norm_pass(Frame& F, const float* xL, const float* xC, int nrows, const float* gain, const float* shiftv, const float* scalev  ,
                                          bf16_t* H, const float* W16, int ldw16, const float* bias16, float* out16) {
    LAS float* wl = (LAS float*)F.lds;
    if (MODE != 0) {
        for (int i = F.tid; i < D * 16; i += NTHREADS) { const int c = i >> 4, e = i & 15; const int l = (c & 255) >> 2, q = (c & 3) + 4 * (c >> 8);
            wl[(q * 64 + l) * 20 + e] = W16[(size_t)c * ldw16 + e]; }
        __syncthreads();
    }
    const int lane = F.lane;
    f32x4 gv[4];
#pragma unroll
    for (int j = 0; j < 4; ++j) gv[j] = *(const f32x4*)(gain + 4 * lane + 256 * j);
    for (int r = F.gw; r < nrows; r += F.NGW) {
        asm volatile("" ::: "memory");
        const bool isc = r >= RL; const int mi = isc ? NB : (r >> 12);
        const float* xr = isc ? (xC + (size_t)(r - RL) * D) : (xL + (size_t)r * D);
        f32x4 v[4]; float ss = 0.f;
#pragma unroll
        for (int j = 0; j < 4; ++j) { v[j] = *(const f32x4*)(xr + 4 * lane + 256 * j); ss += (v[j].x * v[j].x + v[j].y * v[j].y) + (v[j].z * v[j].z + v[j].w * v[j].w); }
        const float rstd = rsqrtf(wave_sum(ss) * (1.f / D) + NORM_EPS);
        const float* shp = shiftv + (size_t)mi * 6 * D; const float* scp = scalev + (size_t)mi * 6 * D;
        unsigned long long* o8 = (unsigned long long*)(H + (size_t)r * D) + lane;
#pragma unroll
        for (int j = 0; j < 4; ++j) { const f32x4 sh = *(const f32x4*)(shp + 4 * lane + 256 * j), sc = *(const f32x4*)(scp + 4 * lane + 256 * j);
            v[j] = (v[j] * rstd * gv[j]) * (sc + 1.f) + sh;
            o8[64 * j] = (unsigned long long)pk2(v[j].x, v[j].y) | ((unsigned long long)pk2(v[j].z, v[j].w) << 32); }
        if (MODE != 0) {
            float p[16];
#pragma unroll
            for (int e = 0; e < 16; ++e) p[e] = 0.f;
#pragma unroll
            for (int j = 0; j < 4; ++j)
#pragma unroll
                for (int i = 0; i < 4; ++i) { const LAS f32x4* wp = (const LAS f32x4*)(wl + ((4 * j + i) * 64 + lane) * 20); const float xv = v[j][i];
#pragma unroll
                    for (int e4 = 0; e4 < 4; ++e4) { const f32x4 w = wp[e4]; p[4 * e4 + 0] = fmaf(xv, w.x, p[4 * e4 + 0]); p[4 * e4 + 1] = fmaf(xv, w.y, p[4 * e4 + 1]); p[4 * e4 + 2] = fmaf(xv, w.z, p[4 * e4 + 2]); p[4 * e4 + 3] = fmaf(xv, w.w, p[4 * e4 + 3]); } }
            float q8[8], q4[4], q2[2], q1;
            { const bool up = (lane & 32) != 0;
#pragma unroll
              for (int i = 0; i < 8; ++i) { const float send = up ? p[i] : p[i + 8]; const float recv = __shfl_xor(send, 32); q8[i] = (up ? p[i + 8] : p[i]) + recv; } }
            { const bool up = (lane & 16) != 0;
#pragma unroll
              for (int i = 0; i < 4; ++i) { const float send = up ? q8[i] : q8[i + 4]; const float recv = __shfl_xor(send, 16); q4[i] = (up ? q8[i + 4] : q8[i]) + recv; } }
            { const bool up = (lane & 8) != 0;
#pragma unroll
              for (int i = 0; i < 2; ++i) { const float send = up ? q4[i] : q4[i + 2]; const float recv = __shfl_xor(send, 8); q2[i] = (up ? q4[i + 2] : q4[i]) + recv; } }
            { const bool up = (lane & 4) != 0; const float send = up ? q2[0] : q2[1]; const float recv = __shfl_xor(send, 4); q1 = (up ? q2[1] : q2[0]) + recv; }
            q1 += __shfl_xor(q1, 1); q1 += __shfl_xor(q1, 2);
            const int e = ((lane >> 5) & 1) * 8 + ((lane >> 4) & 1) * 4 + ((lane >> 3) & 1) * 2 + ((lane >> 2) & 1);
            if (MODE == 1) {
                float g = q1 + bias16[e];
                g = 15.f * tanhf(g * (1.f / 15.f));
                const int gate = e >> 2;
                if (gate & 1) g = fminf(g, 0.f) - log1pf(__expf(-fabsf(g)));
                if ((lane & 3) == 0) out16[(size_t)r * 16 + e] = g;
            } else {
                float mx = q1;
#pragma unroll
                for (int o = 4; o < 64; o <<= 1) mx = fmaxf(mx, __shfl_xor(mx, o));
                const float ex = __expf(q1 - mx); float sm = ex;
#pragma unroll
                for (int o = 4; o < 64; o <<= 1) sm += __shfl_xor(sm, o);
                if ((lane & 3) == 0) out16[(size_t)r * 16 + e] = ex / sm;
            }
        }
    }
    if (MODE != 0) __syncthreads();
}

__device__ __forceinline__ void moe_select(Frame& F, const float* AFF, int* INV, int* SLROW, float* SLG, int nunits) {
    LAS unsigned* keys = (LAS unsigned*)F.lds;
    LAS unsigned* wsum = (LAS unsigned*)(F.lds + 16384);
    const int tid = F.tid, lane = F.lane, wave = F.wave;
    for (int u = F.vcu; u < nunits; u += F.G) {
        const int set = u >> 4, e = u & 15; const bool isc = set >= NB; const int b = isc ? set - NB : set;
        const int N = isc ? CTXL : SEQ, k = isc ? CAP_C : CAP_L, PER = isc ? 1 : 8;
        const int row0 = isc ? RL + b * CTXL : b * SEQ;
        const int nmine = (tid * PER < N) ? PER : 0;
        unsigned kv[8];
#pragma unroll
        for (int i = 0; i < 8; ++i) { kv[i] = 0u; if (i < nmine) kv[i] = __float_as_uint(AFF[(size_t)(row0 + tid * PER + i) * 16 + e]); }
        unsigned T = 0u;
        for (int bit = 30; bit >= 0; --bit) {
            const unsigned cand = T | (1u << bit); unsigned c = 0u;
#pragma unroll
            for (int i = 0; i < 8; ++i) c += (i < nmine && kv[i] >= cand) ? 1u : 0u;
#pragma unroll
            for (int o = 1; o < 64; o <<= 1) c += __shfl_xor(c, o);
            LAS unsigned* wsb = wsum + (bit & 1) * 8;
            if (lane == 0) wsb[wave] = c;
            __syncthreads();
            unsigned tot = 0u;
#pragma unroll
            for (int w = 0; w < 8; ++w) tot += wsb[w];
            if (tot >= (unsigned)k) T = cand;
        }
        unsigned ngt = 0u, neq = 0u;
#pragma unroll
        for (int i = 0; i < 8; ++i) { if (i < nmine) { ngt += kv[i] > T ? 1u : 0u; neq += kv[i] == T ? 1u : 0u; } }
        unsigned sgt = ngt, seq = neq;
#pragma unroll
        for (int o = 1; o < 64; o <<= 1) { const unsigned a = __shfl_up(sgt, o), c2 = __shfl_up(seq, o); if (lane >= o) { sgt += a; seq += c2; } }
        LAS unsigned* sc = wsum + 16;
        __syncthreads();
        if (lane == 63) { sc[wave] = sgt; sc[8 + wave] = seq; }
        __syncthreads();
        unsigned bgt = 0u, beq = 0u, tgt = 0u;
#pragma unroll
        for (int w = 0; w < 8; ++w) { const unsigned a = sc[w], c2 = sc[8 + w]; if (w < wave) { bgt += a; beq += c2; } tgt += a; }
        const unsigned need = (unsigned)k - tgt;
        unsigned pgt = bgt + sgt - ngt, peq = beq + seq - neq;
        const int sbase = isc ? NB * CAP_L + b * CAP_C : b * CAP_L;
#pragma unroll
        for (int i = 0; i < 8; ++i) { if (i < nmine) {
            const int row = row0 + tid * PER + i; int slot = -1;
            if (kv[i] > T) { slot = (int)(pgt + (peq < need ? peq : need)); ++pgt; }
            else if (kv[i] == T) { if (peq < need) slot = (int)(pgt + peq); ++peq; }
            if (slot >= 0) { SLROW[e * SLOTS_E + sbase + slot] = row; SLG[e * SLOTS_E + sbase + slot] = __uint_as_float(kv[i]); }
            INV[(size_t)row * 16 + e] = slot >= 0 ? sbase + slot : -1; } }
        __syncthreads();
    }
    (void)keys;
}

__device__ __forceinline__ void moe_gather(Frame& F, const bf16_t* H, const int* SLROW, bf16_t* XG, bool with_ctx) {
    const int per_e = with_ctx ? SLOTS_E : NB * CAP_L;
    for (int i = F.gw; i < NE * per_e; i += F.NGW) {
        const int e = i / per_e, s = i - e * per_e; const int row = SLROW[e * SLOTS_E + s];
        const u32x4* src = (const u32x4*)(H + (size_t)row * D) + F.lane; u32x4* dst = (u32x4*)(XG + ((size_t)e * SLOTS_E + s) * D) + F.lane;
        const u32x4 a = src[0], b2 = src[64]; dst[0] = a; dst[64] = b2;
    }
}

__device__ __forceinline__ void moe_combine(Frame& F, const bf16_t* Y, const int* INV, float* xL, float* xC, const float* gatev  , int nrows) {
    const int lane = F.lane;
    for (int r = F.gw; r < nrows; r += F.NGW) {
        const bool isc = r >= RL; const int mi = isc ? NB : (r >> 12);
        float* xr = isc ? (xC + (size_t)(r - RL) * D) : (xL + (size_t)r * D);
        const int myinv = (lane < 16) ? INV[(size_t)r * 16 + lane] : -1;
        f32x4 a[4];
#pragma unroll
        for (int j = 0; j < 4; ++j) a[j] = (f32x4){0.f, 0.f, 0.f, 0.f};
        for (int e = 0; e < NE; ++e) { const int s = __shfl(myinv, e); if (s < 0) continue;
            const u32x2* yp = (const u32x2*)(Y + ((size_t)e * SLOTS_E + s) * D) + lane;
#pragma unroll
            for (int j = 0; j < 4; ++j) { const u32x2 y = yp[64 * j]; a[j].x += bf_lo(y.x); a[j].y += bf_hi(y.x); a[j].z += bf_lo(y.y); a[j].w += bf_hi(y.y); } }
        const float* gp = gatev + (size_t)mi * 6 * D;
#pragma unroll
        for (int j = 0; j < 4; ++j) { const f32x4 g = *(const f32x4*)(gp + 4 * lane + 256 * j); f32x4* xp = (f32x4*)(xr + 4 * lane + 256 * j); *xp = *xp + g * a[j]; }
    }
}

__device__ __forceinline__ void final_norm(Frame& F, float* x, const float* gain) {
    const int lane = F.lane;
    for (int r = F.gw; r < RL; r += F.NGW) { float* xr = x + (size_t)r * D; f32x4 v[4]; float ss = 0.f;
#pragma unroll
        for (int j = 0; j < 4; ++j) { v[j] = *(const f32x4*)(xr + 4 * lane + 256 * j); ss += (v[j].x * v[j].x + v[j].y * v[j].y) + (v[j].z * v[j].z + v[j].w * v[j].w); }
        const float rstd = rsqrtf(wave_sum(ss) * (1.f / D) + NORM_EPS);
#pragma unroll
        for (int j = 0; j < 4; ++j) { const f32x4 g = *(const f32x4*)(gain + 4 * lane + 256 * j); *(f32x4*)(xr + 4 * lane + 256 * j) = v[j] * rstd * g; } }
}

__device__ __forceinline__ void qk_pass(Frame& F, bf16_t* QKV, const float* qn, const float* kn, const float* ropec, const float* ropes, bf16_t* KALL, bf16_t* VALL) {
    const int lane = F.lane, p = lane & 3;
    float gq1[8], gq2[8], gk1[8], gk2[8];
#pragma unroll
    for (int t = 0; t < 8; ++t) { gq1[t] = qn[8 * p + t]; gq2[t] = qn[32 + 8 * p + t]; gk1[t] = kn[8 * p + t]; gk2[t] = kn[32 + 8 * p + t]; }
    for (int r = F.gw; r < RT; r += F.NGW) {
        const bool isc = r >= RL; const int b = isc ? (r - RL) >> 8 : r >> 12; const int t = isc ? (r - RL) & 255 : r & 4095;
        const int pos = isc ? t : CTXL + t;
        bf16_t* row = QKV + (size_t)r * 1536;
        float cs[8], sn[8];
#pragma unroll
        for (int i = 0; i < 8; ++i) { cs[i] = 1.f; sn[i] = 0.f; }
        if (!isc) { const f32x4 c0 = *(const f32x4*)(ropec + t * 32 + 8 * p), c1 = *(const f32x4*)(ropec + t * 32 + 8 * p + 4), s0 = *(const f32x4*)(ropes + t * 32 + 8 * p), s1 = *(const f32x4*)(ropes + t * 32 + 8 * p + 4);
            cs[0] = c0.x; cs[1] = c0.y; cs[2] = c0.z; cs[3] = c0.w; cs[4] = c1.x; cs[5] = c1.y; cs[6] = c1.z; cs[7] = c1.w;
            sn[0] = s0.x; sn[1] = s0.y; sn[2] = s0.z; sn[3] = s0.w; sn[4] = s1.x; sn[5] = s1.y; sn[6] = s1.z; sn[7] = s1.w; }
        {
            bf16_t* hp = row + (lane >> 2) * 64 + 8 * p;
            const u32x4 u1 = *(const u32x4*)hp, u2 = *(const u32x4*)(hp + 32);
            float x1[8], x2[8];
            x1[0] = bf_lo(u1.x); x1[1] = bf_hi(u1.x); x1[2] = bf_lo(u1.y); x1[3] = bf_hi(u1.y); x1[4] = bf_lo(u1.z); x1[5] = bf_hi(u1.z); x1[6] = bf_lo(u1.w); x1[7] = bf_hi(u1.w);
            x2[0] = bf_lo(u2.x); x2[1] = bf_hi(u2.x); x2[2] = bf_lo(u2.y); x2[3] = bf_hi(u2.y); x2[4] = bf_lo(u2.z); x2[5] = bf_hi(u2.z); x2[6] = bf_lo(u2.w); x2[7] = bf_hi(u2.w);
            float ss = 0.f;
#pragma unroll
            for (int i = 0; i < 8; ++i) ss += x1[i] * x1[i] + x2[i] * x2[i];
            ss += __shfl_xor(ss, 1); ss += __shfl_xor(ss, 2);
            const float rstd = rsqrtf(ss * (1.f / 64.f) + NORM_EPS) * attn_body::C2;
            float y1[8], y2[8];
#pragma unroll
            for (int i = 0; i < 8; ++i) { const float a = x1[i] * rstd * gq1[i], c = x2[i] * rstd * gq2[i]; y1[i] = a * cs[i] - c * sn[i]; y2[i] = a * sn[i] + c * cs[i]; }
            u32x4 o1, o2; o1.x = pk2(y1[0], y1[1]); o1.y = pk2(y1[2], y1[3]); o1.z = pk2(y1[4], y1[5]); o1.w = pk2(y1[6], y1[7]);
            o2.x = pk2(y2[0], y2[1]); o2.y = pk2(y2[2], y2[3]); o2.z = pk2(y2[4], y2[5]); o2.w = pk2(y2[6], y2[7]);
            *(u32x4*)hp = o1; *(u32x4*)(hp + 32) = o2;
        }
        {
            const int kh = (lane >> 2) & 3;
            const bf16_t* hp = row + 1024 + kh * 64 + 8 * p;
            const u32x4 u1 = *(const u32x4*)hp, u2 = *(const u32x4*)(hp + 32);
            float x1[8], x2[8];
            x1[0] = bf_lo(u1.x); x1[1] = bf_hi(u1.x); x1[2] = bf_lo(u1.y); x1[3] = bf_hi(u1.y); x1[4] = bf_lo(u1.z); x1[5] = bf_hi(u1.z); x1[6] = bf_lo(u1.w); x1[7] = bf_hi(u1.w);
            x2[0] = bf_lo(u2.x); x2[1] = bf_hi(u2.x); x2[2] = bf_lo(u2.y); x2[3] = bf_hi(u2.y); x2[4] = bf_lo(u2.z); x2[5] = bf_hi(u2.z); x2[6] = bf_lo(u2.w); x2[7] = bf_hi(u2.w);
            float ss = 0.f;
#pragma unroll
            for (int i = 0; i < 8; ++i) ss += x1[i] * x1[i] + x2[i] * x2[i];
            ss += __shfl_xor(ss, 1); ss += __shfl_xor(ss, 2);
            const float rstd = rsqrtf(ss * (1.f / 64.f) + NORM_EPS);
            float y1[8], y2[8];
#pragma unroll
            for (int i = 0; i < 8; ++i) { const float a = x1[i] * rstd * gk1[i], c = x2[i] * rstd * gk2[i]; y1[i] = a * cs[i] - c * sn[i]; y2[i] = a * sn[i] + c * cs[i]; }
            if (lane < 16) {
                bf16_t* kp = KALL + ((size_t)b * KVLEN + pos) * 256 + kh * 64 + 8 * p;
                u32x4 o1, o2; o1.x = pk2(y1[0], y1[1]); o1.y = pk2(y1[2], y1[3]); o1.z = pk2(y1[4], y1[5]); o1.w = pk2(y1[6], y1[7]);
                o2.x = pk2(y2[0], y2[1]); o2.y = pk2(y2[2], y2[3]); o2.z = pk2(y2[4], y2[5]); o2.w = pk2(y2[6], y2[7]);
                *(u32x4*)kp = o1; *(u32x4*)(kp + 32) = o2;
            } else if (lane < 48) {
                const int c8 = (lane - 16) * 8;
                *(u32x4*)(VALL + ((size_t)b * KVLEN + pos) * 256 + c8) = *(const u32x4*)(row + 1280 + c8);
            }
        }
    }
}

__device__ __forceinline__ void mlstm_readout(Frame& F, const bf16_t* HF, const bf16_t* HB, const bf16_t* QKVO, const float* wnorm, bf16_t* MIX) {
    const int lane = F.lane;
    f32x4 gv[4];
#pragma unroll
    for (int j = 0; j < 4; ++j) gv[j] = *(const f32x4*)(wnorm + 4 * lane + 256 * j);
    for (int r = F.gw; r < RT; r += F.NGW) {
        const u32x2* pf = (const u32x2*)(HF + (size_t)r * D) + lane; const u32x2* pb = (const u32x2*)(HB + (size_t)r * D) + lane;
        const u32x2* po = (const u32x2*)(QKVO + (size_t)r * 3072 + 2048) + lane;
        u32x2 uf[4], ub[4], uo[4];
#pragma unroll
        for (int j = 0; j < 4; ++j) { uf[j] = pf[64 * j]; ub[j] = pb[64 * j]; uo[j] = po[64 * j]; }
        unsigned long long* o8 = (unsigned long long*)(MIX + (size_t)r * D) + lane;
#pragma unroll
        for (int j = 0; j < 4; ++j) {
            f32x4 h; h.x = bf_lo(uf[j].x) + bf_lo(ub[j].x); h.y = bf_hi(uf[j].x) + bf_hi(ub[j].x); h.z = bf_lo(uf[j].y) + bf_lo(ub[j].y); h.w = bf_hi(uf[j].y) + bf_hi(ub[j].y);
            const float ss = wave_sum((h.x * h.x + h.y * h.y) + (h.z * h.z + h.w * h.w));
            const float rstd = rsqrtf(ss * (1.f / 256.f) + NORM_EPS);
            f32x4 og; og.x = bf_lo(uo[j].x); og.y = bf_hi(uo[j].x); og.z = bf_lo(uo[j].y); og.w = bf_hi(uo[j].y);
            f32x4 y;
            y.x = h.x * rstd * gv[j].x * fast_rcp(1.f + __expf(-og.x)); y.y = h.y * rstd * gv[j].y * fast_rcp(1.f + __expf(-og.y));
            y.z = h.z * rstd * gv[j].z * fast_rcp(1.f + __expf(-og.z)); y.w = h.w * rstd * gv[j].w * fast_rcp(1.f + __expf(-og.w));
            o8[64 * j] = (unsigned long long)pk2(y.x, y.y) | ((unsigned long long)pk2(y.z, y.w) << 32);
        }
    }
}
namespace mls {
constexpr int XS = 272, PS = 144, NCH = 68;
constexpr int O_XQ = 0, O_XK = 17408, O_XKP = 34816, O_XV = 52224, O_P = 69632, O_CT = 78848, O_OT = 113664, O_GB = 131072;
constexpr int O_RD = O_GB + 2 * 5 * 64 * 4, O_NV = O_RD + 256, O_DEC = O_NV + 1024, O_PRE = O_DEC + 64;
constexpr int LDS_BYTES = O_PRE + 3 * 72 * 4;

__device__ __forceinline__ int row_of(int b, int dir, int c, int p) {
    const int base = (c < 4) ? (RL + b * CTXL + (dir ? 192 - 64 * c : 64 * c)) : (b * SEQ + (dir ? 4032 - 64 * (c - 4) : 64 * (c - 4)));
    return base + (dir ? 63 - p : p);
}
__device__ __forceinline__ bf16x8 tr8(const LAS unsigned char* p0, const LAS unsigned char* p1) {
    typedef short v4i16_t __attribute__((ext_vector_type(4)));
    const s16x4 lo = __builtin_bit_cast(s16x4, __builtin_amdgcn_ds_read_tr16_b64_v4i16((LAS v4i16_t*)p0));
    const s16x4 hi = __builtin_bit_cast(s16x4, __builtin_amdgcn_ds_read_tr16_b64_v4i16((LAS v4i16_t*)p1));
    return (bf16x8){lo[0], lo[1], lo[2], lo[3], hi[0], hi[1], hi[2], hi[3]};
}

__device__ __forceinline__ void gate_arrays(LAS unsigned char* L, const float* GATES, int b, int dir, int c, int gi, int gf, int lane) {
    const int par = c & 1; const int row = row_of(b, dir, c, lane);
    const float lf = GATES[(size_t)row * 16 + gf], ig = GATES[(size_t)row * 16 + gi];
    float bs = lf;
#pragma unroll
    for (int o = 1; o < 64; o <<= 1) { const float t = __shfl_up(bs, o); if (lane >= o) bs += t; }
    const float a = ig - bs; float pm = a;
#pragma unroll
    for (int o = 1; o < 64; o <<= 1) { const float t = __shfl_up(pm, o); if (lane >= o) pm = fmaxf(pm, t); }
    const float mst = ((const LAS float*)(L + O_PRE))[144 + c];
    const float M = fmaxf(mst, pm), M63 = __shfl(M, 63);
    LAS float* gb = (LAS float*)(L + O_GB) + par * 320;
    gb[lane] = a; gb[64 + lane] = M; gb[128 + lane] = __expf(mst - M); gb[192 + lane] = __expf(-bs - M); gb[256 + lane] = __expf(a - M63);
    if (lane == 0) ((LAS float*)(L + O_DEC))[par] = __expf(mst - M63);
}

__device__ __forceinline__ void mlstm_unit(Frame& F, int b, int hd, int dir, int half, const bf16_t* QKVO, const float* GATES, bf16_t* HOUT) {
    LAS unsigned char* L = F.lds;
    const int tid = F.tid, lane = F.lane, w = F.wave, fr = lane & 15, g = lane >> 4;
    const int gi = (dir * 2) * 4 + hd, gf = (dir * 2 + 1) * 4 + hd;
    LAS float* pre = (LAS float*)(L + O_PRE);
    __syncthreads();
    if (tid < NCH) { float bs = 0.f, am = -INFINITY;
        for (int p = 0; p < 64; ++p) { const int row = row_of(b, dir, tid, p); const float lf = GATES[(size_t)row * 16 + gf], ig = GATES[(size_t)row * 16 + gi]; bs += lf; am = fmaxf(am, ig - bs); }
        pre[tid] = bs; pre[72 + tid] = am; }
    for (int i = tid; i < (O_OT - O_CT) / 4; i += NTHREADS) ((LAS unsigned*)(L + O_CT))[i] = 0u;
    for (int i = tid; i < 256; i += NTHREADS) ((LAS float*)(L + O_NV))[i] = 0.f;
    __syncthreads();
    if (tid == 0) { float m = 0.f; for (int c = 0; c < NCH; ++c) { pre[144 + c] = m; m = pre[c] + fmaxf(m, pre[72 + c]); } }
    __syncthreads();
    if (w == 0) gate_arrays(L, GATES, b, dir, 0, gi, gf, lane);
    __syncthreads();
    const int qcol = hd * 128, kcol = 512 + hd * 128, vcol = 1024 + hd * 256 + half * 128;
    u32x4 rq[2], rk[2], rv[2];
#define MLS_LOAD(c) do { _Pragma("unroll") for (int i_ = 0; i_ < 2; ++i_) { const int pi_ = tid + 512 * i_, p_ = pi_ >> 4, c16_ = pi_ & 15; \
        const bf16_t* rp_ = QKVO + (size_t)row_of(b, dir, (c), p_) * 3072 + c16_ * 8; \
        rq[i_] = *(const u32x4*)(rp_ + qcol); rk[i_] = *(const u32x4*)(rp_ + kcol); rv[i_] = *(const u32x4*)(rp_ + vcol); } } while (0)
#define MLS_STAGE(c) do { const LAS float* wk_ = (const LAS float*)(L + O_GB) + ((c) & 1) * 320 + 256; \
        _Pragma("unroll") for (int i_ = 0; i_ < 2; ++i_) { const int pi_ = tid + 512 * i_, p_ = pi_ >> 4, c16_ = pi_ & 15; const int o_ = p_ * XS + c16_ * 16; \
        *(LAS u32x4*)(L + O_XQ + o_) = rq[i_]; *(LAS u32x4*)(L + O_XK + o_) = rk[i_]; *(LAS u32x4*)(L + O_XV + o_) = rv[i_]; \
        const float s_ = wk_[p_]; u32x4 kk_; \
        kk_.x = pk2(bf_lo(rk[i_].x) * s_, bf_hi(rk[i_].x) * s_); kk_.y = pk2(bf_lo(rk[i_].y) * s_, bf_hi(rk[i_].y) * s_); \
        kk_.z = pk2(bf_lo(rk[i_].z) * s_, bf_hi(rk[i_].z) * s_); kk_.w = pk2(bf_lo(rk[i_].w) * s_, bf_hi(rk[i_].w) * s_); \
        *(LAS u32x4*)(L + O_XKP + o_) = kk_; } } while (0)
    MLS_LOAD(0); MLS_STAGE(0);
    __syncthreads();
    f32x4 C[8];
#pragma unroll
    for (int i = 0; i < 8; ++i) C[i] = (f32x4){0.f, 0.f, 0.f, 0.f};
    LAS unsigned char* CTw = L + O_CT + w * (16 * XS);
    for (int c = 0; c < NCH; ++c) {
        const int par = c & 1; const bool more = (c + 1 < NCH);
        const LAS float* gb = (const LAS float*)(L + O_GB) + par * 320;
        if (more) MLS_LOAD(c + 1);
        if (more && w == 0) gate_arrays(L, GATES, b, dir, c + 1, gi, gf, lane);
        {
            const int mt = w >> 1;
            bf16x8 aq[4];
#pragma unroll
            for (int ks = 0; ks < 4; ++ks) aq[ks] = *(const LAS bf16x8*)(L + O_XQ + (16 * mt + fr) * XS + (32 * ks + 8 * g) * 2);
            const f32x4 Mj = *(const LAS f32x4*)(gb + 64 + 16 * mt + 4 * g);
#pragma unroll
            for (int n2 = 0; n2 < 2; ++n2) { const int nt = 2 * (w & 1) + n2;
                f32x4 s4 = (f32x4){0.f, 0.f, 0.f, 0.f};
#pragma unroll
                for (int ks = 0; ks < 4; ++ks) { const bf16x8 bk = *(const LAS bf16x8*)(L + O_XK + (16 * nt + fr) * XS + (32 * ks + 8 * g) * 2);
                    s4 = __builtin_amdgcn_mfma_f32_16x16x32_bf16(aq[ks], bk, s4, 0, 0, 0); }
                const int s = 16 * nt + fr; const float as = gb[s];
#pragma unroll
                for (int reg = 0; reg < 4; ++reg) { const int j = 16 * mt + 4 * g + reg;
                    const float pv = (s <= j) ? s4[reg] * __expf(as - Mj[reg]) : 0.f;
                    *(LAS bf16_t*)(L + O_P + j * PS + s * 2) = (bf16_t)f2bf(pv); } }
        }
        f32x4 acc[4];
        {
            bf16x8 ct[4];
#pragma unroll
            for (int ks = 0; ks < 4; ++ks) ct[ks] = *(const LAS bf16x8*)(CTw + fr * XS + (32 * ks + 8 * g) * 2);
#pragma unroll
            for (int mt = 0; mt < 4; ++mt) { f32x4 a4 = (f32x4){0.f, 0.f, 0.f, 0.f};
#pragma unroll
                for (int ks = 0; ks < 4; ++ks) { const bf16x8 q = *(const LAS bf16x8*)(L + O_XQ + (16 * mt + fr) * XS + (32 * ks + 8 * g) * 2);
                    a4 = __builtin_amdgcn_mfma_f32_16x16x32_bf16(q, ct[ks], a4, 0, 0, 0); }
                const f32x4 wi = *(const LAS f32x4*)(gb + 128 + 16 * mt + 4 * g);
                acc[mt] = a4 * wi; }
        }
        __syncthreads();
        bf16x8 vf[2];
        {
            const LAS unsigned char* vb = L + O_XV + (8 * g + (fr >> 2)) * XS + (16 * w + (lane & 3) * 4) * 2;
#pragma unroll
            for (int k2 = 0; k2 < 2; ++k2) vf[k2] = tr8(vb + 32 * k2 * XS, vb + (32 * k2 + 4) * XS);
#pragma unroll
            for (int mt = 0; mt < 4; ++mt)
#pragma unroll
                for (int k2 = 0; k2 < 2; ++k2) { const bf16x8 ap = *(const LAS bf16x8*)(L + O_P + (16 * mt + fr) * PS + (32 * k2 + 8 * g) * 2);
                    acc[mt] = __builtin_amdgcn_mfma_f32_16x16x32_bf16(ap, vf[k2], acc[mt], 0, 0, 0); }
        }
        {
            const int j = tid >> 3, part = tid & 7;
            const u32x4 pu = *(const LAS u32x4*)(L + O_P + j * PS + part * 16);
            float rs = (bf_lo(pu.x) + bf_hi(pu.x)) + (bf_lo(pu.y) + bf_hi(pu.y)) + (bf_lo(pu.z) + bf_hi(pu.z)) + (bf_lo(pu.w) + bf_hi(pu.w));
            const u32x4 q0 = *(const LAS u32x4*)(L + O_XQ + j * XS + part * 32), q1 = *(const LAS u32x4*)(L + O_XQ + j * XS + part * 32 + 16);
            const LAS f32x4* np = (const LAS f32x4*)(L + O_NV + par * 512 + part * 64);
            const f32x4 n0 = np[0], n1 = np[1], n2 = np[2], n3 = np[3];
            float qn = bf_lo(q0.x) * n0.x + bf_hi(q0.x) * n0.y + bf_lo(q0.y) * n0.z + bf_hi(q0.y) * n0.w
                     + bf_lo(q0.z) * n1.x + bf_hi(q0.z) * n1.y + bf_lo(q0.w) * n1.z + bf_hi(q0.w) * n1.w
                     + bf_lo(q1.x) * n2.x + bf_hi(q1.x) * n2.y + bf_lo(q1.y) * n2.z + bf_hi(q1.y) * n2.w
                     + bf_lo(q1.z) * n3.x + bf_hi(q1.z) * n3.y + bf_lo(q1.w) * n3.z + bf_hi(q1.w) * n3.w;
            rs += __shfl_xor(rs, 1); qn += __shfl_xor(qn, 1); rs += __shfl_xor(rs, 2); qn += __shfl_xor(qn, 2); rs += __shfl_xor(rs, 4); qn += __shfl_xor(qn, 4);
            const float den = rs + gb[128 + j] * qn;
            if (part == 0) ((LAS float*)(L + O_RD))[j] = 1.f / fmaxf(fabsf(den), gb[192 + j]);
        }
        {
            const float decay = ((const LAS float*)(L + O_DEC))[par];
            const LAS unsigned char* kb = L + O_XKP + (8 * g + (fr >> 2)) * XS + ((lane & 3) * 4) * 2;
#pragma unroll
            for (int mt = 0; mt < 8; ++mt) { f32x4 c4 = C[mt] * decay;
#pragma unroll
                for (int k2 = 0; k2 < 2; ++k2) { const bf16x8 ak = tr8(kb + 32 * k2 * XS + 32 * mt, kb + (32 * k2 + 4) * XS + 32 * mt);
                    c4 = __builtin_amdgcn_mfma_f32_16x16x32_bf16(ak, vf[k2], c4, 0, 0, 0); }
                C[mt] = c4;
                u32x2 o; o.x = pk2(c4[0], c4[1]); o.y = pk2(c4[2], c4[3]);
                *(LAS u32x2*)(CTw + fr * XS + (16 * mt + 4 * g) * 2) = o; }
            const int dk = tid >> 2, part = tid & 3; float sm = 0.f;
#pragma unroll
            for (int t = 0; t < 16; ++t) sm += bf2f(*(const LAS bf16_t*)(L + O_XKP + (16 * part + t) * XS + dk * 2));
            sm += __shfl_xor(sm, 1); sm += __shfl_xor(sm, 2);
            if (part == 0) { const LAS float* nv = (const LAS float*)(L + O_NV); ((LAS float*)(L + O_NV))[(par ^ 1) * 128 + dk] = decay * nv[par * 128 + dk] + sm; }
        }
        __syncthreads();
        {
#pragma unroll
            for (int mt = 0; mt < 4; ++mt) { const f32x4 rd = *(const LAS f32x4*)(L + O_RD + (16 * mt + 4 * g) * 4);
#pragma unroll
                for (int reg = 0; reg < 4; ++reg) *(LAS bf16_t*)(L + O_OT + (16 * mt + 4 * g + reg) * XS + (16 * w + fr) * 2) = (bf16_t)f2bf(acc[mt][reg] * rd[reg]); }
            if (more) MLS_STAGE(c + 1);
        }
        __syncthreads();
        {
            const int j = tid >> 3, ch = tid & 7;
            const u32x4 o0 = *(const LAS u32x4*)(L + O_OT + j * XS + ch * 32), o1 = *(const LAS u32x4*)(L + O_OT + j * XS + ch * 32 + 16);
            bf16_t* op = HOUT + (size_t)row_of(b, dir, c, j) * D + hd * 256 + half * 128 + ch * 16;
            *(u32x4*)op = o0; *(u32x4*)(op + 8) = o1;
        }
    }
#undef MLS_LOAD
#undef MLS_STAGE
}
}
constexpr int MISC_OFF = 135936, LDS_TOTAL = 136192;
static_assert(mls::LDS_BYTES <= MISC_OFF && pg8::STAGE_BYTES <= MISC_OFF && attn_body::LDS_BYTES <= MISC_OFF, "lds");
#ifndef EN_MASK
#define EN_MASK 0xFFFFFFFFu
#endif
#define PH_ON(k) (((EN_MASK) >> (k)) & 1u)
#ifndef PH_LIMIT
#define PH_LIMIT 1000
#endif
#ifndef N_LAUNCH_SPLIT
#define N_LAUNCH_SPLIT 0
#endif
constexpr int N_PHASES = 1 + DEPTH * 11 + 1;

struct Args { const float* in[21]; float* out; unsigned char* ws; int ph_lo, ph_hi; };
static_assert(sizeof(Args) == 23 * 8 + 8, "no padding");

__device__ __forceinline__ Frame make_frame(unsigned char* lds_gen) {
    Frame F; int t = threadIdx.x; asm volatile("" : "+v"(t));
    int bx = blockIdx.x; asm volatile("" : "+s"(bx));
    F.lds = (LAS unsigned char*)lds_gen; F.tid = t; F.lane = t & 63; F.wave = __builtin_amdgcn_readfirstlane(t >> 6);
    F.G = gridDim.x; F.bid = bx; F.vcu = (F.G % 8 == 0) ? (bx % 8) * (F.G / 8) + bx / 8 : bx;
    F.gw = F.vcu * NWAVES + F.wave; F.NGW = F.G * NWAVES; return F;
}
__global__ void __launch_bounds__(NTHREADS, 2) fwd(Args a) {
    extern __shared__ __attribute__((aligned(16))) unsigned char lds_raw[];
    unsigned char* const lds_gen = lds_raw;
    unsigned char* ws = a.ws;
    if (threadIdx.x < 4) ((LAS unsigned*)((LAS unsigned char*)lds_raw + MISC_OFF))[threadIdx.x] = 0u;
    __syncthreads();
    XcdBarrier bar = xcd_barrier_post((unsigned*)(ws + WS_CTL), (volatile LAS unsigned*)((LAS unsigned char*)lds_raw + MISC_OFF));
    int cur = 0; const int lo = a.ph_lo, hi = a.ph_hi & 0xffff; const bool fin = (a.ph_hi & 0x10000) != 0; bool ran = false;
#define PHASE_BEGIN if ((cur >= lo && cur < hi) || (fin && cur == N_PHASES - 1)) { if (ran) xcd_barrier(bar); ran = true; Frame F = make_frame(lds_gen);
#define PHASE_END   } ++cur;

    float* XL = a.out; float* XC = (float*)(ws + WS_XC);
    bf16_t* H = (bf16_t*)(ws + WS_H); bf16_t* MIX = (bf16_t*)(ws + WS_MIX);
    bf16_t* BIG0 = (bf16_t*)(ws + WS_BIG0); bf16_t* BIG1 = (bf16_t*)(ws + WS_BIG1);
    float* GATES = (float*)(ws + WS_GATES); float* AFF = (float*)(ws + WS_AFF); int* INV = (int*)(ws + WS_INV);
    int* SLROW = (int*)(ws + WS_SLROW); float* SLG = (float*)(ws + WS_SLG);

    PHASE_BEGIN if (PH_ON(0)) { p0_prologue(F, a.in, ws); } PHASE_END

    for (int layer = 0; layer < DEPTH; ++layer) {
        const bool last = (layer == DEPTH - 1); const int j = layer >> 1;
        const float* modv = (const float*)(ws + WS_MODV) + (size_t)layer * NMI * 6 * D;
        const float* xLs = (layer == 0) ? a.in[0] : XL; const float* xCs = (layer == 0) ? a.in[2] : XC;
        if ((layer & 1) == 0) {
            PHASE_BEGIN if (PH_ON(1)) { norm_pass<1>(F, xLs, xCs, RT, a.in[6] + layer * D, modv + 0 * D, modv + 1 * D, H, a.in[8] + (size_t)j * D * MW_IN + 3072, MW_IN, a.in[9] + j * 16, GATES); } PHASE_END
            PHASE_BEGIN if (PH_ON(2)) { { pg8::PlainSched S{(const char*)H, (const char*)((bf16_t*)(ws + WS_WMI) + (size_t)j * 3072 * D), RT / 256, 12, D, F.G, F.bid};
                pg8::EpiBf16 E{BIG0, 3072, 2, 0.08838834764831845f}; pg8::gemm_phase(F.lds, F.tid, D, S, E); } } PHASE_END
            PHASE_BEGIN if (PH_ON(3)) { for (int u = F.vcu; u < 256; u += F.G) { const int half = u & 1, dir = (u >> 1) & 1, hd = (u >> 2) & 3, b = u >> 4;
                mls::mlstm_unit(F, b, hd, dir, half, BIG0, GATES, dir ? MIX : H); } } PHASE_END
            PHASE_BEGIN if (PH_ON(4)) { mlstm_readout(F, H, MIX, BIG0, a.in[10] + j * D, MIX); } PHASE_END
            PHASE_BEGIN if (PH_ON(5)) { { pg8::PlainSched S{(const char*)MIX, (const char*)((bf16_t*)(ws + WS_WMO) + (size_t)j * D * D), RT / 256, 4, D, F.G, F.bid};
                pg8::EpiResid E{xLs, xCs, XL, XC, modv + 2 * D}; pg8::gemm_phase(F.lds, F.tid, D, S, E); } } PHASE_END
        } else {
            bf16_t* KALL = BIG1; bf16_t* VALL = BIG1 + (size_t)NB * KVLEN * 256;
            PHASE_BEGIN if (PH_ON(6)) { norm_pass<0>(F, xLs, xCs, RT, a.in[6] + layer * D, modv + 0 * D, modv + 1 * D, H, nullptr, 0, nullptr, nullptr); } PHASE_END
            PHASE_BEGIN if (PH_ON(7)) { { pg8::PlainSched S{(const char*)H, (const char*)((bf16_t*)(ws + WS_WAI) + (size_t)j * 1536 * D), RT / 256, 6, D, F.G, F.bid};
                pg8::EpiBf16 E{BIG0, 1536, 0, 1.f}; pg8::gemm_phase(F.lds, F.tid, D, S, E); } } PHASE_END
            PHASE_BEGIN if (PH_ON(8)) { qk_pass(F, BIG0, a.in[13] + j * 64, a.in[14] + j * 64, (const float*)(ws + WS_ROPE), (const float*)(ws + WS_ROPE) + SEQ * 32, KALL, VALL); } PHASE_END
            PHASE_BEGIN if (PH_ON(9)) { { const int nun = last ? 4096 : 4096 + 256;
                for (int L = F.vcu; L < nun; L += F.G) {
                    if (L < 4096) { const int grp = L >> 6, wi = L & 63, hq = (grp & 3) * 4 + (wi >> 4), qb = wi & 15, b = grp >> 2;
                        const size_t row0 = (size_t)b * SEQ + qb * 256;
                        attn_body::attn_unit<8>(BIG0 + row0 * 1536 + hq * 64, 1536, KALL + (size_t)b * KVLEN * 256 + (hq >> 2) * 64, VALL + (size_t)b * KVLEN * 256 + (hq >> 2) * 64, 256, KVLEN / 64,
                                                MIX + row0 * D + hq * 64, D, (char*)lds_gen, F.tid);
                    } else { const int Lc = L - 4096, b = Lc >> 4, hq = Lc & 15; const size_t row0 = (size_t)RL + b * CTXL;
                        attn_body::attn_unit<8>(BIG0 + row0 * 1536 + hq * 64, 1536, KALL + (size_t)b * KVLEN * 256 + (hq >> 2) * 64, VALL + (size_t)b * KVLEN * 256 + (hq >> 2) * 64, 256, CTXL / 64,
                                                MIX + row0 * D + hq * 64, D, (char*)lds_gen, F.tid); } } } } PHASE_END
            PHASE_BEGIN if (PH_ON(10)) { { pg8::PlainSched S{(const char*)MIX, (const char*)((bf16_t*)(ws + WS_WAO) + (size_t)j * D * D), (last ? RL : RT) / 256, 4, D, F.G, F.bid};
                pg8::EpiResid E{xLs, xCs, XL, XC, modv + 2 * D}; pg8::gemm_phase(F.lds, F.tid, D, S, E); } } PHASE_END
        }
        const int nrows = last ? RL : RT;
        PHASE_BEGIN if (PH_ON(11)) { moe_weights(F, a.in[17] + (size_t)layer * NE * D * D, a.in[18] + (size_t)layer * NE * D * D, a.in[19] + (size_t)layer * NE * D * D, ws);
            norm_pass<2>(F, XL, XC, nrows, a.in[7] + layer * D, modv + 3 * D, modv + 4 * D, H, a.in[16] + (size_t)layer * D * 16, 16, nullptr, AFF); } PHASE_END
        PHASE_BEGIN if (PH_ON(12)) { moe_select(F, AFF, INV, SLROW, SLG, last ? NB * NE : 2 * NB * NE); } PHASE_END
        PHASE_BEGIN if (PH_ON(13)) { moe_gather(F, H, SLROW, BIG0, !last); } PHASE_END
        PHASE_BEGIN if (PH_ON(14)) { { pg8::MoeSched S{(const char*)BIG0, (const char*)(ws + WS_W1), last ? 32 : 34, 8, D, 2048, F.G, F.bid};
            pg8::EpiSwiglu E{BIG1}; pg8::gemm_phase(F.lds, F.tid, D, S, E); } } PHASE_END
        PHASE_BEGIN if (PH_ON(15)) { { pg8::MoeSched S{(const char*)BIG1, (const char*)(ws + WS_W2), last ? 32 : 34, 4, D, 1024, F.G, F.bid};
            pg8::EpiRowScale E{BIG0, SLG}; pg8::gemm_phase(F.lds, F.tid, D, S, E); } } PHASE_END
        PHASE_BEGIN if (PH_ON(16)) { moe_combine(F, BIG0, INV, XL, XC, modv + 5 * D, nrows); } PHASE_END
    }
    PHASE_BEGIN if (PH_ON(17)) { final_norm(F, XL, a.in[20]); } PHASE_END
#undef PHASE_BEGIN
#undef PHASE_END
}

extern "C" void kernel_launch(void* const* d_in, const int* in_sizes, int n_in, void* d_out, int out_size, void* d_ws, size_t ws_size, hipStream_t stream) {
    static int grid = 0;
    if (grid == 0) {
        if (n_in != 21 || out_size != RL * D || ws_size < WS_END) { fprintf(stderr, "kernel_launch: unexpected shapes: n_in %d out %d ws %zu (need %zu)\n", n_in, out_size, ws_size, (size_t)WS_END); grid = -1; return; }
        int dev = 0, cus = 0, per_cu = 0;
        if (hipGetDevice(&dev) != hipSuccess || hipDeviceGetAttribute(&cus, hipDeviceAttributeMultiprocessorCount, dev) != hipSuccess) { grid = -1; return; }
        if (hipFuncSetAttribute((const void*)fwd, hipFuncAttributeMaxDynamicSharedMemorySize, LDS_TOTAL) != hipSuccess) { fprintf(stderr, "kernel_launch: hipFuncSetAttribute failed\n"); grid = -1; return; }
        if (hipOccupancyMaxActiveBlocksPerMultiprocessor(&per_cu, (const void*)fwd, NTHREADS, LDS_TOTAL) != hipSuccess || per_cu < 1) fprintf(stderr, "kernel_launch: occupancy query says %d\n", per_cu);
        (void)hipGetLastError();
        grid = cus;
    }
    if (grid < 0) return;
    (void)in_sizes;
    if (hipMemsetAsync((char*)d_ws + WS_CTL, 0, CTL_BYTES, stream) != hipSuccess) return;
    Args a{};
    for (int i = 0; i < 21; ++i) a.in[i] = (const float*)d_in[i];
    a.out = (float*)d_out; a.ws = (unsigned char*)d_ws;
    const int nph = N_PHASES < PH_LIMIT ? N_PHASES : PH_LIMIT;
    if (nph < N_PHASES) (void)hipMemcpyAsync(d_out, d_in[0], (size_t)RL * D * 4, hipMemcpyDeviceToDevice, stream);
#if N_LAUNCH_SPLIT
    for (int p = 0; p < nph; ++p) { a.ph_lo = p; a.ph_hi = p + 1; hipLaunchKernelGGL(fwd, dim3(grid), dim3(NTHREADS), LDS_TOTAL, stream, a); }
    if (nph < N_PHASES) { a.ph_lo = N_PHASES - 1; a.ph_hi = N_PHASES; hipLaunchKernelGGL(fwd, dim3(grid), dim3(NTHREADS), LDS_TOTAL, stream, a); }
#else
    a.ph_lo = 0; a.ph_hi = nph | (nph < N_PHASES ? 0x10000 : 0);
    hipLaunchKernelGGL(fwd, dim3(grid), dim3(NTHREADS), LDS_TOTAL, stream, a);
#endif
    const hipError_t le = hipPeekAtLastError();
    if (le != hipSuccess) fprintf(stderr, "kernel_launch: launch failed: %s\n", hipGetErrorName(le));
}
```

```cpp
#include <hip/hip_runtime.h>
#include <cstdio>
#include <cstdint>

#define GAS __attribute__((address_space(1)))
#define LAS __attribute__((address_space(3)))
typedef unsigned short bf16_t;
typedef short bf16x8 __attribute__((ext_vector_type(8)));
typedef short s16x4 __attribute__((ext_vector_type(4)));
typedef float f32x4 __attribute__((ext_vector_type(4)));
typedef float f32x2 __attribute__((ext_vector_type(2)));
typedef float f32x16 __attribute__((ext_vector_type(16)));
typedef unsigned u32x4 __attribute__((ext_vector_type(4)));
typedef unsigned u32x2 __attribute__((ext_vector_type(2)));

constexpr int D = 1024, NB = 16, SEQ = 4096, CTXL = 256, DEPTH = 4;
constexpr int RL = NB * SEQ, RC = NB * CTXL, RT = RL + RC;
constexpr int NE = 16, CAP_L = 512, CAP_C = 32, SLOTS_E = NB * CAP_L + NB * CAP_C;
constexpr int NMI = NB + 1;
constexpr int MW_IN = 3088;
constexpr int KVLEN = CTXL + SEQ;
constexpr int NWAVES = 8, NTHREADS = 512;
constexpr float NORM_EPS = 1e-6f;

constexpr size_t al256(size_t x) { return (x + 255) & ~(size_t)255; }
constexpr size_t WS_CTL   = 0;
constexpr size_t CTL_BYTES = 16384;
constexpr size_t WS_PTRS  = WS_CTL + CTL_BYTES;
constexpr size_t WS_MODV  = WS_PTRS + 256;
constexpr size_t WS_ROPE  = al256(WS_MODV + (size_t)DEPTH * NMI * 6 * D * 4);
constexpr size_t WS_XC    = al256(WS_ROPE + (size_t)2 * SEQ * 32 * 4);
constexpr size_t WS_GATES = al256(WS_XC + (size_t)RC * D * 4);
constexpr size_t WS_AFF   = al256(WS_GATES + (size_t)RT * 16 * 4);
constexpr size_t WS_INV   = al256(WS_AFF + (size_t)RT * 16 * 4);
constexpr size_t WS_SLROW = al256(WS_INV + (size_t)RT * 16 * 4);
constexpr size_t WS_SLG   = al256(WS_SLROW + (size_t)NE * SLOTS_E * 4);
constexpr size_t WS_WMI   = al256(WS_SLG + (size_t)NE * SLOTS_E * 4);
constexpr size_t WS_WMO   = al256(WS_WMI + (size_t)2 * 3072 * D * 2);
constexpr size_t WS_WAI   = al256(WS_WMO + (size_t)2 * D * D * 2);
constexpr size_t WS_WAO   = al256(WS_WAI + (size_t)2 * 1536 * D * 2);
constexpr size_t WS_W1    = al256(WS_WAO + (size_t)2 * D * D * 2);
constexpr size_t WS_W2    = al256(WS_W1 + (size_t)NE * 2048 * D * 2);
constexpr size_t WS_H     = al256(WS_W2 + (size_t)NE * D * D * 2);
constexpr size_t WS_MIX   = al256(WS_H + (size_t)RT * D * 2);
constexpr size_t WS_BIG0  = al256(WS_MIX + (size_t)RT * D * 2);
constexpr size_t BIG_HALF = (size_t)NE * SLOTS_E * D * 2;
constexpr size_t WS_BIG1  = al256(WS_BIG0 + BIG_HALF);
constexpr size_t WS_END   = al256(WS_BIG1 + BIG_HALF);
static_assert((size_t)RT * 3072 * 2 <= 2 * BIG_HALF, "qkvo fits");

#define LDS_WAIT() asm volatile("s_waitcnt lgkmcnt(0)" ::: "memory")
#define VM_WAIT() asm volatile("s_waitcnt vmcnt(0)" ::: "memory")
__device__ __forceinline__ unsigned f2bf(float f) { unsigned u = __builtin_bit_cast(unsigned, f); return (u + 0x7fffu + ((u >> 16) & 1u)) >> 16; }
__device__ __forceinline__ unsigned pk2(float lo, float hi) { return f2bf(lo) | (f2bf(hi) << 16); }
__device__ __forceinline__ float bf_lo(unsigned u) { return __builtin_bit_cast(float, u << 16); }
__device__ __forceinline__ float bf_hi(unsigned u) { return __builtin_bit_cast(float, u & 0xffff0000u); }
__device__ __forceinline__ float bf2f(bf16_t b) { return __builtin_bit_cast(float, ((unsigned)b) << 16); }
__device__ __forceinline__ float wave_sum(float v) {
#pragma unroll
    for (int o = 1; o < 64; o <<= 1) v += __shfl_xor(v, o);
    return v;
}
__device__ __forceinline__ float fast_exp(float x) { return __builtin_amdgcn_exp2f(x * 1.4426950408889634f); }
__device__ __forceinline__ float fast_rcp(float x) { return __builtin_amdgcn_rcpf(x); }
__device__ __forceinline__ float silu_f(float x) { return x / (1.f + __expf(-x)); }

#define XB_TMO      128
#define XB_XCNT(j)  (256  + 64 * (j))
#define XB_XSUB(j)  (1280 + 64 * (j))
#define XB_XGEN(j)  (2304 + 64 * (j))
#define XB_TOP      3328
#define XB_TOPGEN   3392
#define XCD_BAR_WORDS 3456
#define XB_SPIN_CAP (1u << 21)
static_assert(XCD_BAR_WORDS * 4 <= CTL_BYTES, "ctl");

__device__ __forceinline__ unsigned xb_ld(unsigned* p)              { return __hip_atomic_load(p, __ATOMIC_RELAXED, __HIP_MEMORY_SCOPE_AGENT); }
__device__ __forceinline__ unsigned xb_add(unsigned* p, unsigned v) { return __hip_atomic_fetch_add(p, v, __ATOMIC_RELAXED, __HIP_MEMORY_SCOPE_AGENT); }
__device__ __forceinline__ unsigned xb_xcc_id() { return (unsigned)__builtin_amdgcn_s_getreg((3 << 11) | 20) & 0xFu; }
#define XB_SPIN(cond, bar) do { unsigned _sp = 0; while (cond) { __builtin_amdgcn_s_sleep(1); \
    if ((++_sp & 255u) == 0u) { if (xb_ld(&(bar)[XB_TMO])) break; if (_sp > XB_SPIN_CAP) { atomicAdd(&(bar)[XB_TMO], 1u); break; } } } } while (0)

struct XcdBarrier { unsigned* bar; unsigned x; volatile LAS unsigned* st; };

__device__ __forceinline__ XcdBarrier xcd_barrier_post(unsigned* bar, volatile LAS unsigned* st) {
    XcdBarrier b; b.bar = bar; b.x = xb_xcc_id(); b.st = st;
    if (threadIdx.x == 0) (void)xb_add(&bar[XB_XCNT(b.x)], 1u);
    return b;
}
__device__ __forceinline__ void xcd_barrier_complete(unsigned* bar, unsigned x, unsigned& nloc, unsigned& nx) {
    const unsigned G = gridDim.x * gridDim.y * gridDim.z;
    unsigned sum, cnt, mine, sp = 0u;
    for (;;) {
        sum = 0u; cnt = 0u; mine = 0u;
#pragma unroll
        for (unsigned j = 0; j < 16; ++j) { const unsigned c = xb_ld(&bar[XB_XCNT(j)]); sum += c; cnt += (c > 0u) ? 1u : 0u; mine = (j == x) ? c : mine; }
        if (sum == G) break;
        __builtin_amdgcn_s_sleep(1);
        if ((++sp & 255u) == 0u) { if (xb_ld(&bar[XB_TMO])) break; if (sp > XB_SPIN_CAP) { atomicAdd(&bar[XB_TMO], 1u); break; } }
    }
    nloc = mine > 0u ? mine : 1u; nx = cnt > 0u ? cnt : 1u;
}
__device__ __forceinline__ void xcd_barrier(const XcdBarrier& b) {
    asm volatile("s_waitcnt vmcnt(0)" ::: "memory");
    __syncthreads();
    if (threadIdx.x == 0) {
        unsigned* bar = b.bar;
        __builtin_amdgcn_s_waitcnt(0);
        unsigned nloc = b.st[0], nx = b.st[1];
        if (nloc == 0u) { xcd_barrier_complete(bar, b.x, nloc, nx); b.st[0] = nloc; b.st[1] = nx; }
        const unsigned old = xb_add(&bar[XB_XSUB(b.x)], 1u);
        const unsigned gen = old / nloc;
        if (old + 1u == (gen + 1u) * nloc) {
            __builtin_amdgcn_fence(__ATOMIC_RELEASE, "agent");
            asm volatile("s_waitcnt vmcnt(0)" ::: "memory");
            const unsigned og = xb_add(&bar[XB_TOP], 1u);
            const unsigned tg = og / nx;
            if (og + 1u == (tg + 1u) * nx) xb_add(&bar[XB_TOPGEN], 1u);
            else XB_SPIN(xb_ld(&bar[XB_TOPGEN]) == tg, bar);
            __builtin_amdgcn_fence(__ATOMIC_ACQUIRE, "agent");
            xb_add(&bar[XB_XGEN(b.x)], 1u);
            asm volatile("s_waitcnt vmcnt(0)" ::: "memory");
        } else {
            XB_SPIN(xb_ld(&bar[XB_XGEN(b.x)]) == gen, bar);
            __builtin_amdgcn_fence(__ATOMIC_ACQUIRE, "agent");
            asm volatile("s_waitcnt vmcnt(0)" ::: "memory");
        }
    }
    __syncthreads();
}
namespace pg8 {
constexpr int BM = 256, BK = 64, HALF = 128, HTB = HALF * BK * 2, STAGE_BYTES = 8 * HTB, NXCD = 8, WGM = 8;

__host__ __device__ __forceinline__ int lds_byte(int r, int c) { const int st = (r >> 4) * 2 + (c >> 5), rr = r & 15, cc = c & 31, ob = rr * 64 + cc * 2; return st * 1024 + (ob ^ (((ob >> 9) & 1) << 5)); }
__host__ __device__ __forceinline__ void stage_rc(int b, int& R, int& C) { const int st = b / 1024, sb = b % 1024, swz = sb ^ (((sb >> 9) & 1) << 5); R = (st >> 1) * 16 + swz / 64; C = (st & 1) * 32 + (swz % 64) / 2; }
__host__ __device__ __forceinline__ int perm32(int rho) { const int n = rho >> 4, i = rho & 15; return 8 * (i >> 2) + 4 * n + (i & 3); }

struct Unit { const char* A; const char* B; int pm, pn; };

__device__ __forceinline__ bool static_tile(int i, int G, int c, int nM, int nN, int& pm, int& pn) {
    const int nwg = nM * nN; const long L = (long)i * G + c; if (L >= nwg) return false;
    int wgid = (int)L; { const int q = nwg / NXCD, r = nwg % NXCD, xcd = wgid % NXCD, off = wgid / NXCD; wgid = (xcd < r ? xcd * (q + 1) : r * (q + 1) + (xcd - r) * q) + off; }
    const int nig = WGM * nN, gid = wgid / nig, fm = gid * WGM, gsz = (nM - fm) < WGM ? (nM - fm) : WGM;
    pm = fm + ((wgid % nig) % gsz); pn = (wgid % nig) / gsz; return true;
}
struct PlainSched {
    const char* A; const char* Bt; int nM, nN, K, G, c;
    __device__ __forceinline__ bool next(int i, Unit& u) const {
        int pm, pn; if (!static_tile(i, G, c, nM, nN, pm, pn)) return false;
        u.pm = pm; u.pn = pn; u.A = A + (size_t)pm * 256 * K * 2; u.B = Bt + (size_t)pn * 256 * K * 2; return true;
    }
};
struct MoeSched {
    const char* A; const char* W; int tpe, nN, K, bN, G, c;
    __device__ __forceinline__ bool next(int i, Unit& u) const {
        int pm, pn; if (!static_tile(i, G, c, NE * tpe, nN, pm, pn)) return false;
        const int e = pm / tpe, rt = pm - e * tpe;
        u.pm = e * (SLOTS_E / 256) + rt; u.pn = pn;
        u.A = A + (size_t)u.pm * 256 * K * 2; u.B = W + ((size_t)e * bN + (size_t)pn * 256) * K * 2; return true;
    }
};

__device__ __forceinline__ unsigned cvt_pk_bf16(float lo, float hi) { unsigned r; asm volatile("v_cvt_pk_bf16_f32 %0, %1, %2" : "=v"(r) : "v"(lo), "v"(hi)); return r; }


struct EpiBf16 {
    static constexpr bool PERM = true;
    bf16_t* O; int ldc; int nscale; float scale;
    __device__ __forceinline__ void operator()(const f32x4 (&acc)[2][2][4][2], const Unit& u, int wr, int wc, int fr, int fq) const {
        const int row0 = u.pm * BM + wr * 64 + fr, col0 = u.pn * BM + wc * 32 + 8 * fq;
        const float s = (u.pn < nscale) ? scale : 1.f;
#pragma unroll
        for (int ai = 0; ai < 2; ++ai)
#pragma unroll
            for (int m = 0; m < 4; ++m) { bf16_t* rowp = O + (size_t)(row0 + ai * HALF + m * 16) * ldc + col0;
#pragma unroll
                for (int bj = 0; bj < 2; ++bj) { const f32x4 v0 = acc[ai][bj][m][0] * s, v1 = acc[ai][bj][m][1] * s;
                    u32x4 o; o.x = cvt_pk_bf16(v0[0], v0[1]); o.y = cvt_pk_bf16(v0[2], v0[3]); o.z = cvt_pk_bf16(v1[0], v1[1]); o.w = cvt_pk_bf16(v1[2], v1[3]);
                    *(u32x4*)(rowp + bj * HALF) = o; } }
    }
};
struct EpiResid {
    static constexpr bool PERM = false;
    const float* srcL; const float* srcC; float* dstL; float* dstC; const float* gate;
    __device__ __forceinline__ void operator()(const f32x4 (&acc)[2][2][4][2], const Unit& u, int wr, int wc, int fr, int fq) const {
        const bool isc = u.pm >= RL / 256;
        const int mi = isc ? NB : (u.pm >> 4);
        const int rbase = (isc ? (u.pm - RL / 256) : u.pm) * BM + wr * 64 + fr, col0 = u.pn * BM + wc * 32 + 4 * fq;
        const float* src = isc ? srcC : srcL; float* dst = isc ? dstC : dstL;
        const float* gp = gate + (size_t)mi * 6 * D + col0;
        f32x4 gv[2][2];
#pragma unroll
        for (int bj = 0; bj < 2; ++bj)
#pragma unroll
            for (int n = 0; n < 2; ++n) gv[bj][n] = *(const f32x4*)(gp + bj * HALF + n * 16);
#pragma unroll
        for (int ai = 0; ai < 2; ++ai)
#pragma unroll
            for (int m = 0; m < 4; ++m) { const size_t ro = (size_t)(rbase + ai * HALF + m * 16) * D + col0;
#pragma unroll
                for (int bj = 0; bj < 2; ++bj)
#pragma unroll
                    for (int n = 0; n < 2; ++n) { const f32x4 xv = *(const f32x4*)(src + ro + bj * HALF + n * 16);
                        *(f32x4*)(dst + ro + bj * HALF + n * 16) = xv + gv[bj][n] * acc[ai][bj][m][n]; } }
    }
};
struct EpiSwiglu {
    static constexpr bool PERM = true;
    bf16_t* O;
    __device__ __forceinline__ void operator()(const f32x4 (&acc)[2][2][4][2], const Unit& u, int wr, int wc, int fr, int fq) const {
        const int row0 = u.pm * BM + wr * 64 + fr, col0 = u.pn * HALF + wc * 32 + 8 * fq;
#pragma unroll
        for (int ai = 0; ai < 2; ++ai)
#pragma unroll
            for (int m = 0; m < 4; ++m) { bf16_t* rowp = O + (size_t)(row0 + ai * HALF + m * 16) * D + col0;
                float r[8];
#pragma unroll
                for (int n = 0; n < 2; ++n)
#pragma unroll
                    for (int j = 0; j < 4; ++j) { const float g = acc[ai][0][m][n][j], up = acc[ai][1][m][n][j]; r[n * 4 + j] = g * fast_rcp(1.f + fast_exp(-g)) * up; }
                u32x4 o; o.x = cvt_pk_bf16(r[0], r[1]); o.y = cvt_pk_bf16(r[2], r[3]); o.z = cvt_pk_bf16(r[4], r[5]); o.w = cvt_pk_bf16(r[6], r[7]);
                *(u32x4*)rowp = o; }
    }
};
struct EpiRowScale {
    static constexpr bool PERM = true;
    bf16_t* O; const float* g;
    __device__ __forceinline__ void operator()(const f32x4 (&acc)[2][2][4][2], const Unit& u, int wr, int wc, int fr, int fq) const {
        const int row0 = u.pm * BM + wr * 64 + fr, col0 = u.pn * BM + wc * 32 + 8 * fq;
#pragma unroll
        for (int ai = 0; ai < 2; ++ai)
#pragma unroll
            for (int m = 0; m < 4; ++m) { const int row = row0 + ai * HALF + m * 16; const float s = g[row]; bf16_t* rowp = O + (size_t)row * D + col0;
#pragma unroll
                for (int bj = 0; bj < 2; ++bj) { const f32x4 v0 = acc[ai][bj][m][0] * s, v1 = acc[ai][bj][m][1] * s;
                    u32x4 o; o.x = cvt_pk_bf16(v0[0], v0[1]); o.y = cvt_pk_bf16(v0[2], v0[3]); o.z = cvt_pk_bf16(v1[0], v1[1]); o.w = cvt_pk_bf16(v1[2], v1[3]);
                    *(u32x4*)(rowp + bj * HALF) = o; } }
    }
};

template <class Epi, class Sched>
__device__ __forceinline__ void gemm_phase(LAS unsigned char* lds, const int tid, const int K, const Sched& S, const Epi& E) {
    const int wid = __builtin_amdgcn_readfirstlane(tid >> 6), lane = tid & 63, wr = wid >> 2, wc = wid & 3, fr = lane & 15, fq = lane >> 4;
    const int nt = K / BK;
    unsigned voffA[2], voffB[2];
#pragma unroll
    for (int i = 0; i < 2; ++i) { int R, C; stage_rc(tid * 16 + i * 8192, R, C); const int Rb = Epi::PERM ? ((R & ~31) + perm32(R & 31)) : R;
        voffA[i] = (unsigned)(R * K + C) * 2u; voffB[i] = (unsigned)(Rb * K + C) * 2u; }
    const size_t kstep = (size_t)(BK * 2);
    const size_t hstep = (size_t)HALF * K * 2;
    const unsigned ldsw = (unsigned)wid * 1024u;
    const int aoff = lds_byte(wr * 64 + fr, fq * 8), boff = lds_byte(wc * 32 + fr, fq * 8);
#define PG8_SA(b, h) (((b) * 2 + (h)) * HTB)
#define PG8_SB(b, h) ((4 + (b) * 2 + (h)) * HTB)
#define PG8_STAGE(bufoff, gbase, voff) do { _Pragma("unroll") for (int _i = 0; _i < 2; ++_i) \
        __builtin_amdgcn_global_load_lds((const unsigned*)((const char*)(gbase) + (voff)[_i]), (LAS unsigned*)(lds + (bufoff) + ldsw + _i * 8192), 16, 0, 0); } while (0)
#define PG8_LDA(dst, b, h) do { _Pragma("unroll") for (int m = 0; m < 4; ++m) _Pragma("unroll") for (int k = 0; k < 2; ++k) dst[m][k] = *(const LAS bf16x8*)(lds + PG8_SA(b, h) + aoff + m * 2048 + k * 1024); } while (0)
#define PG8_LDB(dst, b, h) do { _Pragma("unroll") for (int n = 0; n < 2; ++n) _Pragma("unroll") for (int k = 0; k < 2; ++k) dst[n][k] = *(const LAS bf16x8*)(lds + PG8_SB(b, h) + boff + n * 2048 + k * 1024); } while (0)
#define PG8_MMA(ai, bj, At, Bt) do { __builtin_amdgcn_s_setprio(1); _Pragma("unroll") for (int m = 0; m < 4; ++m) _Pragma("unroll") for (int n = 0; n < 2; ++n) _Pragma("unroll") for (int k = 0; k < 2; ++k) \
        acc[ai][bj][m][n] = __builtin_amdgcn_mfma_f32_16x16x32_bf16(Bt[n][k], At[m][k], acc[ai][bj][m][n], 0, 0, 0); __builtin_amdgcn_s_setprio(0); } while (0)
#define PG8_WAIT_V(n) asm volatile("s_waitcnt vmcnt(" #n ")" ::: "memory")
#define PG8_WAIT_L(n) asm volatile("s_waitcnt lgkmcnt(" #n ")" ::: "memory")
#define PG8_BAR __builtin_amdgcn_s_barrier()
#define PG8_SCHED __builtin_amdgcn_sched_barrier(0)
    Unit cur, nxt; int ui = 0;
    if (!S.next(0, cur)) return;
    f32x4 acc[2][2][4][2];
#pragma unroll
    for (int a = 0; a < 2; ++a)
#pragma unroll
        for (int b = 0; b < 2; ++b)
#pragma unroll
            for (int m = 0; m < 4; ++m)
#pragma unroll
                for (int n = 0; n < 2; ++n) acc[a][b][m][n] = (f32x4){0.f, 0.f, 0.f, 0.f};
    bf16x8 At[4][2], B0[2][2], B1[2][2];
    const char* cA = cur.A; const char* cB = cur.B;
    PG8_STAGE(PG8_SB(0, 0), cB, voffB); PG8_STAGE(PG8_SB(0, 1), cB + hstep, voffB); PG8_STAGE(PG8_SA(0, 0), cA, voffA); PG8_STAGE(PG8_SA(0, 1), cA + hstep, voffA);
    if (wr == 1) PG8_BAR;
    PG8_WAIT_V(2); PG8_BAR;
    PG8_STAGE(PG8_SB(1, 0), cB + kstep, voffB); PG8_STAGE(PG8_SA(1, 0), cA + kstep, voffA); PG8_STAGE(PG8_SB(1, 1), cB + hstep + kstep, voffB);
    PG8_WAIT_V(6); PG8_BAR;
    for (;;) {
        const bool has_next = S.next(ui + 1, nxt);
        const char* nA = has_next ? nxt.A : cA; const char* nB = has_next ? nxt.B : cB;
        for (int t = 0; t < nt; t += 2) {
            const bool last = (t == nt - 2);
            const char* a1 = cA + (size_t)(t + 1) * kstep;
            const char* a2 = last ? nA : cA + (size_t)(t + 2) * kstep; const char* b2 = last ? nB : cB + (size_t)(t + 2) * kstep;
            const char* a3 = a2 + kstep; const char* b3 = b2 + kstep;
            PG8_LDB(B0, 0, 0); PG8_LDB(B1, 0, 1); PG8_SCHED; PG8_LDA(At, 0, 0); PG8_STAGE(PG8_SA(1, 1), a1 + hstep, voffA);
            PG8_WAIT_V(8); PG8_WAIT_L(0); PG8_BAR; PG8_MMA(0, 0, At, B0); PG8_MMA(0, 1, At, B1); PG8_BAR; PG8_SCHED;
            PG8_LDA(At, 0, 1); PG8_STAGE(PG8_SB(0, 0), b2, voffB); PG8_STAGE(PG8_SB(0, 1), b2 + hstep, voffB); PG8_STAGE(PG8_SA(0, 0), a2, voffA);
            PG8_WAIT_V(8); PG8_WAIT_L(0); PG8_BAR; PG8_MMA(1, 0, At, B0); PG8_MMA(1, 1, At, B1); PG8_BAR; PG8_SCHED;
            PG8_LDB(B0, 1, 0); PG8_LDB(B1, 1, 1); PG8_SCHED; PG8_LDA(At, 1, 0); PG8_STAGE(PG8_SA(0, 1), a2 + hstep, voffA);
            PG8_WAIT_V(8); PG8_WAIT_L(0); PG8_BAR; PG8_MMA(0, 0, At, B0); PG8_MMA(0, 1, At, B1); PG8_BAR; PG8_SCHED;
            PG8_LDA(At, 1, 1); PG8_STAGE(PG8_SB(1, 0), b3, voffB); PG8_STAGE(PG8_SB(1, 1), b3 + hstep, voffB); PG8_STAGE(PG8_SA(1, 0), a3, voffA);
            PG8_WAIT_V(8); PG8_WAIT_L(0); PG8_BAR; PG8_MMA(1, 0, At, B0); PG8_MMA(1, 1, At, B1); PG8_BAR; PG8_SCHED;
        }
        if (wr == 0) PG8_BAR;
        E(acc, cur, wr, wc, fr, fq);
        if (!has_next) break;
#pragma unroll
        for (int a = 0; a < 2; ++a)
#pragma unroll
            for (int b = 0; b < 2; ++b)
#pragma unroll
                for (int m = 0; m < 4; ++m)
#pragma unroll
                    for (int n = 0; n < 2; ++n) acc[a][b][m][n] = (f32x4){0.f, 0.f, 0.f, 0.f};
        cur = nxt; cA = nA; cB = nB; ++ui;
        if (wr == 1) PG8_BAR;
    }
    PG8_WAIT_V(0);
    PG8_BAR;
#undef PG8_SA
#undef PG8_SB
#undef PG8_STAGE
#undef PG8_LDA
#undef PG8_LDB
#undef PG8_MMA
#undef PG8_WAIT_V
#undef PG8_WAIT_L
#undef PG8_BAR
#undef PG8_SCHED
}
}
namespace attn_body {
constexpr int NW = 8, QBLK = 32, QB = QBLK * NW, KVBLK = 64;
__device__ __forceinline__ int crow(int r, int hi) { return (r & 3) + 8 * (r >> 2) + 4 * hi; }
#define SBAR() __builtin_amdgcn_sched_barrier(0)
constexpr int NSLOT = 3, SLOTB = 8192;
constexpr int LDS_K = 0, LDS_V = NSLOT * SLOTB, LDS_WS = 2 * NSLOT * SLOTB, LDS_OST = LDS_WS + NW * 64 * 4, LDS_BYTES = LDS_OST + NW * 4096;
constexpr float C2 = 0.125f * 1.4426950408889634f;
__device__ __forceinline__ void glds16(const void* gsrc, unsigned lds_dst) { unsigned keep;
  asm volatile("s_mov_b32 %0, m0\n\ts_mov_b32 m0, %2\n\ts_nop 0\n\tglobal_load_lds_dwordx4 %1, off\n\ts_mov_b32 m0, %0" : "=&s"(keep) : "v"(gsrc), "s"(lds_dst) : "memory"); }
__device__ __forceinline__ float max3f(float a, float b, float c) { float r; asm("v_max3_f32 %0, %1, %2, %3" : "=v"(r) : "v"(a), "v"(b), "v"(c)); return r; }
__device__ __forceinline__ float max2f(float a, float b) { float r; asm("v_max_f32_e32 %0, %1, %2" : "=v"(r) : "v"(a), "v"(b)); return r; }
__device__ __forceinline__ float fadd_s(float a, float b) { float r; asm("v_add_f32_e32 %0, %1, %2" : "=v"(r) : "v"(a), "v"(b)); return r; }
__device__ __forceinline__ float fsub_s(float a, float b) { float r; asm("v_sub_f32_e32 %0, %1, %2" : "=v"(r) : "v"(a), "v"(b)); return r; }
typedef __bf16 bf16x2_t __attribute__((ext_vector_type(2)));
__device__ __forceinline__ unsigned cvtpk_s(float lo, float hi) { f32x2 v = {lo, hi}; bf16x2_t b = __builtin_convertvector(v, bf16x2_t); return __builtin_bit_cast(unsigned, b); }
#define WAIT_BAR(N) asm volatile("s_waitcnt vmcnt(" #N ") lgkmcnt(0)\n\ts_barrier" ::: "memory")

__device__ __forceinline__ void qkt(f32x16& p0, f32x16& p1, const char* Kslot, const bf16x8* qr, const f32x16& negm, int r32, int hi) {
  const char* kb = Kslot + hi * 1024 + r32 * 16;
  #pragma unroll
  for (int d0 = 0; d0 < 4; ++d0) {
    const bf16x8 b0 = *reinterpret_cast<const bf16x8*>(kb + d0 * 2048);
    const bf16x8 b1 = *reinterpret_cast<const bf16x8*>(kb + d0 * 2048 + 512);
    if (d0 == 0) { p0 = __builtin_amdgcn_mfma_f32_32x32x16_bf16(b0, qr[0], negm, 0, 0, 0); p1 = __builtin_amdgcn_mfma_f32_32x32x16_bf16(b1, qr[0], negm, 0, 0, 0); }
    else { p0 = __builtin_amdgcn_mfma_f32_32x32x16_bf16(b0, qr[d0], p0, 0, 0, 0); p1 = __builtin_amdgcn_mfma_f32_32x32x16_bf16(b1, qr[d0], p1, 0, 0, 0); } }
}
typedef __attribute__((address_space(3))) const char* lds_cptr;
typedef short v4i16_t __attribute__((ext_vector_type(4)));
__device__ __forceinline__ void kload8(bf16x8* kf, lds_cptr kp) {
  kf[0] = *(const LAS bf16x8*)(kp);        kf[1] = *(const LAS bf16x8*)(kp + 512);
  kf[2] = *(const LAS bf16x8*)(kp + 2048); kf[3] = *(const LAS bf16x8*)(kp + 2560);
  kf[4] = *(const LAS bf16x8*)(kp + 4096); kf[5] = *(const LAS bf16x8*)(kp + 4608);
  kf[6] = *(const LAS bf16x8*)(kp + 6144); kf[7] = *(const LAS bf16x8*)(kp + 6656);
}
__device__ __forceinline__ void kload2(bf16x8* kf, lds_cptr kp, int j) { kf[2 * j] = *(const LAS bf16x8*)(kp + j * 2048); kf[2 * j + 1] = *(const LAS bf16x8*)(kp + j * 2048 + 512); }
__device__ __forceinline__ s16x4 vtr(lds_cptr p) { return __builtin_bit_cast(s16x4, __builtin_amdgcn_ds_read_tr16_b64_v4i16((LAS v4i16_t*)p)); }
__device__ __forceinline__ float rowmax(const f32x16& p0, const f32x16& p1) {
  float a = max3f(p0[0], p0[1], p1[0]), b = max3f(p0[2], p0[3], p1[1]); a = max3f(a, p1[2], p1[3]);
  #pragma unroll
  for (int r = 4; r < 16; r += 4) { a = max3f(a, p0[r], p0[r + 1]); b = max3f(b, p0[r + 2], p0[r + 3]); a = max3f(a, p1[r], p1[r + 1]); b = max3f(b, p1[r + 2], p1[r + 3]); }
  const float m = max2f(a, b);
  auto rr = __builtin_amdgcn_permlane32_swap(__float_as_uint(m), __float_as_uint(m), false, false);
  return max2f(__uint_as_float(rr[0]), __uint_as_float(rr[1]));
}
__device__ __forceinline__ void pv(f32x16* o, int vb, bf16x8 pa0, bf16x8 pa1, bf16x8 pa2, bf16x8 pa3) {
  #pragma unroll
  for (int d0 = 0; d0 < 2; ++d0) { s16x4 lo[4], hi[4];
    #pragma unroll
    for (int ks = 0; ks < 4; ++ks) {
      asm volatile("ds_read_b64_tr_b16 %0,%1 offset:%c2" : "=&v"(lo[ks]) : "v"(vb), "i"(d0 * 4096 + ks * 1024) : "memory");
      asm volatile("ds_read_b64_tr_b16 %0,%1 offset:%c2" : "=&v"(hi[ks]) : "v"(vb), "i"(d0 * 4096 + ks * 1024 + 512) : "memory"); }
    asm volatile("s_waitcnt lgkmcnt(0)" ::: "memory"); SBAR();
    #define PK(k) (bf16x8){lo[k][0], lo[k][1], lo[k][2], lo[k][3], hi[k][0], hi[k][1], hi[k][2], hi[k][3]}
    o[d0] = __builtin_amdgcn_mfma_f32_32x32x16_bf16(pa0, PK(0), o[d0], 0, 0, 0);
    o[d0] = __builtin_amdgcn_mfma_f32_32x32x16_bf16(pa1, PK(1), o[d0], 0, 0, 0);
    o[d0] = __builtin_amdgcn_mfma_f32_32x32x16_bf16(pa2, PK(2), o[d0], 0, 0, 0);
    o[d0] = __builtin_amdgcn_mfma_f32_32x32x16_bf16(pa3, PK(3), o[d0], 0, 0, 0);
    #undef PK
  }
}

template <int THRL> __device__ __forceinline__ void attn_unit(const bf16_t* Qrow0, int QP, const bf16_t* __restrict__ Kh, const bf16_t* __restrict__ Vh, int KVP, int NT, bf16_t* Orow0, int OP, char* shm, const int tid) {
  const int lane = tid & 63, r32 = lane & 31, hi = lane >> 5; const int wid = __builtin_amdgcn_readfirstlane(tid >> 6);
  const bf16_t* Qw = Qrow0 + (long)(wid * QBLK) * QP;
  const unsigned lds0 = (unsigned)(uintptr_t)shm;
  float* wsf = (float*)(shm + LDS_WS) + wid * 64;
  const bf16_t* ksrc = Kh + (long)lane * KVP + wid * 8;
  const bf16_t* vsrc = Vh + (long)(16 * (wid & 3) + (lane >> 2)) * KVP + (wid >> 2) * 32 + (lane & 3) * 8;
  const unsigned kdst = lds0 + LDS_K + wid * 1024, vdst = lds0 + LDS_V + wid * 1024;
  #define DMA_K(t, slot) glds16(ksrc + (long)(t) * KVBLK * KVP, (unsigned)__builtin_amdgcn_readfirstlane(kdst + (slot)))
  #define DMA_V(t, slot) glds16(vsrc + (long)(t) * KVBLK * KVP, (unsigned)__builtin_amdgcn_readfirstlane(vdst + (slot)))
  const int vb0 = (int)(lds0 + LDS_V) + ((lane >> 4) & 1) * 32 + (lane & 3) * 8 + (4 * hi + ((lane & 15) >> 2)) * 64;
  const char* Kbase = shm + LDS_K; bf16x8 kf[8];
  const lds_cptr shm3 = (lds_cptr)shm; const lds_cptr kp0 = shm3 + LDS_K + hi * 1024 + r32 * 16; const lds_cptr vp0 = shm3 + LDS_V + ((lane >> 4) & 1) * 32 + (lane & 3) * 8 + (4 * hi + ((lane & 15) >> 2)) * 64;
  DMA_K(0, 0); DMA_V(0, 0); DMA_K(1, SLOTB);
  bf16x8 qr[4];
  #pragma unroll
  for (int d0 = 0; d0 < 4; ++d0) qr[d0] = *reinterpret_cast<const bf16x8*>(&Qw[(long)r32 * QP + d0 * 16 + hi * 8]);
  float mhat = 0.f, l_reg = 0.f; f32x16 o[2]; o[0] = f32x16{}; o[1] = f32x16{}; f32x16 negm = f32x16{}; asm volatile("" : "+v"(negm));
  bool resc = false;
  #define START(P0, P1) do { const float rm = rowmax(P0, P1); resc = false; \
    { const float dl = rm; mhat = fadd_s(mhat, dl); \
      _Pragma("unroll") for (int r = 0; r < 16; ++r) { P0[r] = fsub_s(P0[r], dl); P1[r] = fsub_s(P1[r], dl); } \
      _Pragma("unroll") for (int r = 0; r < 16; ++r) negm[r] = -mhat; asm volatile("" : "+v"(negm)); } \
    _Pragma("unroll") for (int r = 0; r < 16; ++r) P0[r] = __builtin_amdgcn_exp2f(P0[r]); } while (0)
  #define RESC() do { if (resc) { asm volatile("s_waitcnt lgkmcnt(0)" ::: "memory"); \
      _Pragma("unroll") for (int d_ = 0; d_ < 2; ++d_) _Pragma("unroll") for (int r = 0; r < 16; ++r) o[d_][r] *= wsf[crow(r, hi)]; } } while (0)
  f32x16 pA0, pA1, pB0, pB1;
  int sl_prev = 0, sl_cur = 0, sl_next = SLOTB;
  #define ROT() do { sl_prev = sl_cur; sl_cur = sl_next; sl_next = (sl_next == (NSLOT - 1) * SLOTB) ? 0 : sl_next + SLOTB; } while (0)
  DMA_K(2, 2 * SLOTB);
  WAIT_BAR(3);
  qkt(pA0, pA1, Kbase, qr, negm, r32, hi); asm volatile("s_nop 15\n\ts_nop 7" : "+v"(pA0), "+v"(pA1));
  START(pA0, pA1);
  _Pragma("unroll") for (int r = 0; r < 16; ++r) pA1[r] = __builtin_amdgcn_exp2f(pA1[r]);
  WAIT_BAR(0);
  DMA_K(3, 0); DMA_V(1, SLOTB);
  ROT();
  kload8(kf, kp0 + sl_cur);
  WAIT_BAR(2);
  s16x4 vlo[8], vhi[8]; u32x4 pw0, pw1, pw2, pw3;
  #define PKW(P, B) cvtpk_s(P[B], P[B + 1])
  #define PAF(k) __builtin_bit_cast(bf16x8, pw##k)
  #define VFR(i) (bf16x8){vlo[i][0], vlo[i][1], vlo[i][2], vlo[i][3], vhi[i][0], vhi[i][1], vhi[i][2], vhi[i][3]}
  #define PIN(x) asm volatile("" : "+v"(x))
  #define MX3(a, b, c) __builtin_fmaxf(__builtin_fmaxf((a), (b)), (c))
  #define GAPA(MF, A0, A1, A2, A3, W0, W1, PW) do { MF; sacc += A0; sacc += A1; sacc += A2; sacc += A3; PIN(sacc); W0; W1; PIN(PW); SBAR(); } while (0)
  #define EX(v) __builtin_amdgcn_exp2f(v)
  #define GAPB(MF, X, B) do { MF; X[B] = EX(X[B]); X[B + 1] = EX(X[B + 1]); X[B + 2] = EX(X[B + 2]); X[B + 3] = EX(X[B + 3]); PIN(X); SBAR(); } while (0)
  #define VRD(i) do { vlo[i] = vtr(vp_ + (((i) >> 2) * 4096 + ((i) & 3) * 1024)); vhi[i] = vtr(vp_ + (((i) >> 2) * 4096 + ((i) & 3) * 1024 + 512)); } while (0)
  #define KRD(G, j) do { if (G) { kload2(kf, kp0 + sl_next, j); SBAR(); } } while (0)
  #define STEP(C0, C1, P0, P1, t, GK, GV, GL) do { SBAR(); \
    const lds_cptr vp_ = vp0 + sl_prev; \
    VRD(0); SBAR(); float sacc = (P0[0] + P0[1]); \
    GAPA(C0 = __builtin_amdgcn_mfma_f32_32x32x16_bf16(kf[0], qr[0], negm, 0, 0, 0), P0[2], P0[3], P0[4], P0[5],     pw0[0] = PKW(P0, 0), pw0[1] = PKW(P0, 2), pw0); \
    VRD(4); SBAR(); GAPA(C1 = __builtin_amdgcn_mfma_f32_32x32x16_bf16(kf[1], qr[0], negm, 0, 0, 0), P0[6], P0[7], P0[8], P0[9],     pw0[2] = PKW(P0, 4), pw0[3] = PKW(P0, 6), pw0); \
    VRD(1); SBAR(); GAPA(C0 = __builtin_amdgcn_mfma_f32_32x32x16_bf16(kf[2], qr[1], C0, 0, 0, 0),   P0[10], P0[11], P0[12], P0[13], pw1[0] = PKW(P0, 8), pw1[1] = PKW(P0, 10), pw1); \
    VRD(5); SBAR(); GAPA(C1 = __builtin_amdgcn_mfma_f32_32x32x16_bf16(kf[3], qr[1], C1, 0, 0, 0),   P0[14], P0[15], P1[0], P1[1],   pw1[2] = PKW(P0, 12), pw1[3] = PKW(P0, 14), pw1); \
    VRD(2); SBAR(); GAPA(C0 = __builtin_amdgcn_mfma_f32_32x32x16_bf16(kf[4], qr[2], C0, 0, 0, 0),   P1[2], P1[3], P1[4], P1[5],     pw2[0] = PKW(P1, 0), pw2[1] = PKW(P1, 2), pw2); \
    VRD(6); SBAR(); GAPA(C1 = __builtin_amdgcn_mfma_f32_32x32x16_bf16(kf[5], qr[2], C1, 0, 0, 0),   P1[6], P1[7], P1[8], P1[9],     pw2[2] = PKW(P1, 4), pw2[3] = PKW(P1, 6), pw2); \
    VRD(3); SBAR(); GAPA(C0 = __builtin_amdgcn_mfma_f32_32x32x16_bf16(kf[6], qr[3], C0, 0, 0, 0),   P1[10], P1[11], P1[12], P1[13], pw3[0] = PKW(P1, 8), pw3[1] = PKW(P1, 10), pw3); \
    VRD(7); SBAR(); GAPA(C1 = __builtin_amdgcn_mfma_f32_32x32x16_bf16(kf[7], qr[3], C1, 0, 0, 0),   P1[14], P1[15], 0.f, 0.f,       pw3[2] = PKW(P1, 12), pw3[3] = PKW(P1, 14), pw3); \
    l_reg += sacc; \
    if (GK) { DMA_K((t) + 3, sl_cur); } if (GV) { DMA_V((t) + 1, sl_next); } \
    { float a = MX3(C0[0], C0[1], C1[0]), b = MX3(C0[2], C0[3], C1[1]); a = MX3(a, C1[2], C1[3]); \
      _Pragma("unroll") for (int r = 4; r < 16; r += 4) { a = MX3(a, C0[r], C0[r + 1]); b = MX3(b, C0[r + 2], C0[r + 3]); a = MX3(a, C1[r], C1[r + 1]); b = MX3(b, C1[r + 2], C1[r + 3]); } \
      float rm = __builtin_fmaxf(a, b); { auto rr = __builtin_amdgcn_permlane32_swap(__float_as_uint(rm), __float_as_uint(rm), false, false); rm = __builtin_fmaxf(__uint_as_float(rr[0]), __uint_as_float(rr[1])); } \
      resc = false; \
      if (__builtin_expect(__any(rm > (float)THRL), 0)) { const float dl = __builtin_fmaxf(rm, 0.f); mhat += dl; \
        _Pragma("unroll") for (int r = 0; r < 16; ++r) { C0[r] -= dl; C1[r] -= dl; } \
        _Pragma("unroll") for (int r = 0; r < 16; ++r) negm[r] = -mhat; asm volatile("" : "+v"(negm)); \
        const float f = __builtin_amdgcn_exp2f(-dl); l_reg *= f; if (hi == 0) wsf[r32] = f; resc = true; } } \
    SBAR(); \
    GAPB(o[0] = __builtin_amdgcn_mfma_f32_32x32x16_bf16(PAF(0), VFR(0), o[0], 0, 0, 0), C0, 0); \
    GAPB(o[1] = __builtin_amdgcn_mfma_f32_32x32x16_bf16(PAF(0), VFR(4), o[1], 0, 0, 0), C0, 4); \
    KRD(GL, 0); GAPB(o[0] = __builtin_amdgcn_mfma_f32_32x32x16_bf16(PAF(1), VFR(1), o[0], 0, 0, 0), C0, 8); \
    KRD(GL, 1); GAPB(o[1] = __builtin_amdgcn_mfma_f32_32x32x16_bf16(PAF(1), VFR(5), o[1], 0, 0, 0), C0, 12); \
    KRD(GL, 2); GAPB(o[0] = __builtin_amdgcn_mfma_f32_32x32x16_bf16(PAF(2), VFR(2), o[0], 0, 0, 0), C1, 0); \
    KRD(GL, 3); GAPB(o[1] = __builtin_amdgcn_mfma_f32_32x32x16_bf16(PAF(2), VFR(6), o[1], 0, 0, 0), C1, 4); \
    GAPB(o[0] = __builtin_amdgcn_mfma_f32_32x32x16_bf16(PAF(3), VFR(3), o[0], 0, 0, 0), C1, 8); \
    GAPB(o[1] = __builtin_amdgcn_mfma_f32_32x32x16_bf16(PAF(3), VFR(7), o[1], 0, 0, 0), C1, 12); \
    } while (0)
  int t = 1;
  for (; t + 5 < NT; t += 2) {
    STEP(pB0, pB1, pA0, pA1, t, true, true, true);     WAIT_BAR(2); RESC(); ROT();
    STEP(pA0, pA1, pB0, pB1, t + 1, true, true, true); WAIT_BAR(2); RESC(); ROT();
  }
  #define ENDW(tt) do { if ((tt) + 3 < NT) { WAIT_BAR(2); } else if ((tt) + 2 < NT) { WAIT_BAR(1); } else { WAIT_BAR(0); } } while (0)
  for (; t + 1 < NT; t += 2) {
    STEP(pB0, pB1, pA0, pA1, t, (t + 3 < NT), (t + 1 < NT), (t + 1 < NT));         ENDW(t);     RESC(); ROT();
    STEP(pA0, pA1, pB0, pB1, t + 1, (t + 4 < NT), (t + 2 < NT), (t + 2 < NT));     ENDW(t + 1); RESC(); ROT();
  }
  STEP(pB0, pB1, pA0, pA1, NT - 1, false, false, false); RESC();
  { float sacc = pB0[0] + pB0[1]; _Pragma("unroll") for (int r = 2; r < 16; ++r) sacc += pB0[r]; _Pragma("unroll") for (int r = 0; r < 16; ++r) sacc += pB1[r]; l_reg += sacc;
    pw0 = (u32x4){PKW(pB0, 0), PKW(pB0, 2), PKW(pB0, 4), PKW(pB0, 6)}; pw1 = (u32x4){PKW(pB0, 8), PKW(pB0, 10), PKW(pB0, 12), PKW(pB0, 14)}; pw2 = (u32x4){PKW(pB1, 0), PKW(pB1, 2), PKW(pB1, 4), PKW(pB1, 6)}; pw3 = (u32x4){PKW(pB1, 8), PKW(pB1, 10), PKW(pB1, 12), PKW(pB1, 14)};
    SBAR(); pv(o, vb0 + sl_cur, PAF(0), PAF(1), PAF(2), PAF(3)); }
  #undef PKW
  #undef PAF
  #undef VFR
  #undef PIN
  #undef MX3
  #undef GAPA
  #undef GAPB
  #undef EX
  #undef VRD
  #undef KRD
  #undef STEP
  #undef ENDW
  { auto rr = __builtin_amdgcn_permlane32_swap(__float_as_uint(l_reg), __float_as_uint(l_reg), false, false); l_reg = __uint_as_float(rr[0]) + __uint_as_float(rr[1]); }
  if (hi == 0) wsf[32 + r32] = l_reg; asm volatile("s_waitcnt lgkmcnt(0)" ::: "memory");
  float rli[16];
  #pragma unroll
  for (int r = 0; r < 16; ++r) rli[r] = __builtin_amdgcn_rcpf(wsf[32 + crow(r, hi)]);
  bf16_t* Ow = Orow0 + (long)(wid * QBLK) * OP;
  { bf16_t* stg = (bf16_t*)(shm + LDS_OST) + wid * 2048;
    #pragma unroll
    for (int r = 0; r < 16; ++r) { const int orow = crow(r, hi);
      #pragma unroll
      for (int d0 = 0; d0 < 2; ++d0) stg[orow * 64 + d0 * 32 + r32] = (bf16_t)f2bf(o[d0][r] * rli[r]); }
    asm volatile("s_waitcnt lgkmcnt(0)" ::: "memory");
    #pragma unroll
    for (int i = 0; i < 4; ++i) { const int row = i * 8 + (lane >> 3), ch = lane & 7; const u32x4 v = *(const u32x4*)(stg + row * 64 + ch * 8); *(u32x4*)(Ow + (long)row * OP + ch * 8) = v; } }
  asm volatile("s_waitcnt lgkmcnt(0)\n\ts_barrier" ::: "memory");
  #undef DMA_K
  #undef DMA_V
  #undef START
  #undef RESC
  #undef ROT
}
#undef SBAR
#undef WAIT_BAR
}
struct Frame {
    LAS unsigned char* lds;
    int tid, lane, wave;
    int vcu, G, gw, NGW, bid;
    unsigned char* ws; const float* const* in;
};

__device__ __forceinline__ void transpose_item(const float* W, int ldw, int K, bf16_t* WT, int k0, int n0, int dst_row0, LAS float* scr, int lane) {
    float tv[32];
#pragma unroll
    for (int i = 0; i < 32; ++i) tv[i] = W[(size_t)(k0 + 2 * i + (lane >> 5)) * ldw + n0 + (lane & 31)];
#pragma unroll
    for (int i = 0; i < 32; ++i) scr[(2 * i + (lane >> 5)) * 33 + (lane & 31)] = tv[i];
    LDS_WAIT(); asm volatile("" ::: "memory");
    const int c = lane & 7;
#pragma unroll
    for (int j = 0; j < 4; ++j) { const int n = (lane >> 3) + 8 * j; const LAS float* s = scr + (8 * c) * 33 + n;
        u32x4 o; o.x = pk2(s[0 * 33], s[1 * 33]); o.y = pk2(s[2 * 33], s[3 * 33]); o.z = pk2(s[4 * 33], s[5 * 33]); o.w = pk2(s[6 * 33], s[7 * 33]);
        *(u32x4*)(WT + (size_t)(dst_row0 + n) * K + k0 + 8 * c) = o; }
    LDS_WAIT(); asm volatile("" ::: "memory");
}

__device__ __forceinline__ void sincos_acc(float x, float& s, float& c) {
    const float k = rintf(x * 0.63661977236758134f);
    float r = fmaf(k, -1.5703125f, x); r = fmaf(k, -4.837512969970703125e-4f, r); r = fmaf(k, -7.54978995489188e-8f, r);
    const float z = r * r;
    const float sp = r + r * z * fmaf(z, fmaf(z, -1.9515295891e-4f, 8.3321608736e-3f), -1.6666654611e-1f);
    const float cp = fmaf(z * z, fmaf(z, fmaf(z, 2.443315711809948e-5f, -1.388731625493765e-3f), 4.166664568298827e-2f), fmaf(z, -0.5f, 1.0f));
    const int q = ((int)k) & 3;
    const float ss = (q & 1) ? cp : sp, cc = (q & 1) ? sp : cp;
    s = (q & 2) ? -ss : ss; c = ((q + 1) & 2) ? -cc : cc;
}

__device__ __forceinline__ void p0_prologue(Frame& F, const float* const* in, unsigned char* ws) {
    const float* c_lat = in[1]; const float* c_ctx = in[3]; const float* w_mod = in[4]; const float* b_mod = in[5];
    LAS float* sil = (LAS float*)F.lds;
    for (int i = F.tid; i < NMI * D; i += NTHREADS) { const int mi = i >> 10, k = i & 1023; const float v = (mi < NB) ? c_lat[mi * D + k] : c_ctx[k]; sil[i] = silu_f(v); }
    __syncthreads();
    {
        float* modv = (float*)(ws + WS_MODV);
        const int NT16 = 6 * D / 16;
        for (int task = F.gw; task < DEPTH * NT16; task += F.NGW) {
            const int layer = task / NT16, j0 = (task % NT16) * 16, jj = F.lane & 15, kq = F.lane >> 4;
            const float* wp = w_mod + (size_t)layer * D * 6 * D + j0 + jj;
            float acc[NMI];
#pragma unroll
            for (int m = 0; m < NMI; ++m) acc[m] = 0.f;
            for (int k = kq; k < D; k += 4) { const float w = wp[(size_t)k * 6 * D];
#pragma unroll
                for (int m = 0; m < NMI; ++m) acc[m] = fmaf(sil[m * D + k], w, acc[m]); }
#pragma unroll
            for (int m = 0; m < NMI; ++m) { float v = acc[m]; v += __shfl_xor(v, 16); v += __shfl_xor(v, 32); acc[m] = v; }
            if (kq == 0) { const float bb = b_mod[layer * 6 * D + j0 + jj];
#pragma unroll
                for (int m = 0; m < NMI; ++m) modv[((size_t)layer * NMI + m) * 6 * D + j0 + jj] = acc[m] + bb; }
        }
    }
    __syncthreads();
    {
        LAS float* scr = (LAS float*)(F.lds) + F.wave * (64 * 33);
        constexpr int I_MI = 16 * 96, I_MO = 16 * 32, I_AI = 16 * 48, I_AO = 16 * 32;
        constexpr int PER_J = I_MI + I_MO + I_AI + I_AO;
        for (int it = F.gw; it < 2 * PER_J; it += F.NGW) {
            const int j = it / PER_J; int r = it % PER_J;
            if (r < I_MI) { const int kb = r / 96, nb = r % 96; transpose_item(in[8] + (size_t)j * D * MW_IN, MW_IN, D, (bf16_t*)(ws + WS_WMI) + (size_t)j * 3072 * D, 64 * kb, 32 * nb, 32 * nb, scr, F.lane); continue; } r -= I_MI;
            if (r < I_MO) { const int kb = r / 32, nb = r % 32; transpose_item(in[11] + (size_t)j * D * D, D, D, (bf16_t*)(ws + WS_WMO) + (size_t)j * D * D, 64 * kb, 32 * nb, 32 * nb, scr, F.lane); continue; } r -= I_MO;
            if (r < I_AI) { const int kb = r / 48, nb = r % 48; transpose_item(in[12] + (size_t)j * D * 1536, 1536, D, (bf16_t*)(ws + WS_WAI) + (size_t)j * 1536 * D, 64 * kb, 32 * nb, 32 * nb, scr, F.lane); continue; } r -= I_AI;
            { const int kb = r / 32, nb = r % 32; transpose_item(in[15] + (size_t)j * D * D, D, D, (bf16_t*)(ws + WS_WAO) + (size_t)j * D * D, 64 * kb, 32 * nb, 32 * nb, scr, F.lane); }
        }
    }
    {
        float* rc = (float*)(ws + WS_ROPE); float* rs = rc + SEQ * 32;
        for (int i = F.bid * NTHREADS + F.tid; i < SEQ * 32; i += F.G * NTHREADS) {
            const int t = i >> 5, p = i & 31; const float pos = (p < 16) ? (float)(t >> 6) : (float)(t & 63);
            const float inv = exp2f(-(float)(p & 15) * (13.287712379549449f / 16.f));
            float s, c; sincos_acc(pos * inv, s, c); rc[i] = c; rs[i] = s; }
    }
    __syncthreads();
}

__device__ __forceinline__ void moe_weights(Frame& F, const float* wg, const float* wu, const float* wd, unsigned char* ws) {
    LAS float* scr = (LAS float*)(F.lds) + F.wave * (64 * 33);
    constexpr int IPM = 16 * 32;
    bf16_t* W1 = (bf16_t*)(ws + WS_W1); bf16_t* W2 = (bf16_t*)(ws + WS_W2);
    for (int it = F.gw; it < NE * 3 * IPM; it += F.NGW) {
        const int e = it / (3 * IPM); int r = it % (3 * IPM); const int which = r / IPM; r %= IPM;
        const int kb = r / 32, nb = r % 32, n0 = 32 * nb;
        if (which == 0)      transpose_item(wg + (size_t)e * D * D, D, D, W1 + (size_t)e * 2048 * D, 64 * kb, n0, 256 * (n0 >> 7) + (n0 & 127), scr, F.lane);
        else if (which == 1) transpose_item(wu + (size_t)e * D * D, D, D, W1 + (size_t)e * 2048 * D, 64 * kb, n0, 256 * (n0 >> 7) + 128 + (n0 & 127), scr, F.lane);
        else                 transpose_item(wd + (size_t)e * D * D, D, D, W2 + (size_t)e * D * D, 64 * kb, n0, n0, scr, F.lane);
    }
    __syncthreads();
}

__device__ __forceinline__ void load_w16(Frame& F, const float* W16, int ldw16) {
    LAS float* wl = (LAS float*)F.lds;
    for (int i = F.tid; i < D * 16; i += NTHREADS) { const int c = i >> 4, e = i & 15; const int l = (c & 255) >> 2, q = (c & 3) + 4 * (c >> 8);
        wl[(q * 64 + l) * 20 + e] = W16[(size_t)c * ldw16 + e]; }
    __syncthreads();
}
template <int MODE>
__device__ __forceinline__ void norm_core(LAS float* wl, const int lane, f32x4 (&v)[4], const int r, const f32x4 (&gv)[4], const float* shp, const float* scp, bf16_t* H, const float* bias16, float* out16) {
    float ss = 0.f;
#pragma unroll
    for (int j = 0; j < 4; ++j) ss += (v[j].x * v[j].x + v[j].y * v[j].y) + (v[j].z * v[j].z + v[j].w * v[j].w);
    const float rstd = rsqrtf(wave_sum(ss) * (1.f / D) + NORM_EPS);
    unsigned long long* o8 = (unsigned long long*)(H + (size_t)r * D) + lane;
#pragma unroll
    for (int j = 0; j < 4; ++j) { const f32x4 sh = *(const f32x4*)(shp + 4 * lane + 256 * j), sc = *(const f32x4*)(scp + 4 * lane + 256 * j);
        v[j] = (v[j] * rstd * gv[j]) * (sc + 1.f) + sh;
        o8[64 * j] = (unsigned long long)pk2(v[j].x, v[j].y) | ((unsigned long long)pk2(v[j].z, v[j].w) << 32); }
    if (MODE != 0) {
        float p[16];
#pragma unroll
        for (int e = 0; e < 16; ++e) p[e] = 0.f;
#pragma unroll
        for (int j = 0; j < 4; ++j)
#pragma unroll
            for (int i = 0; i < 4; ++i) { const LAS f32x4* wp = (const LAS f32x4*)(wl + ((4 * j + i) * 64 + lane) * 20); const float xv = v[j][i];
#pragma unroll
                for (int e4 = 0; e4 < 4; ++e4) { const f32x4 w = wp[e4]; p[4 * e4 + 0] = fmaf(xv, w.x, p[4 * e4 + 0]); p[4 * e4 + 1] = fmaf(xv, w.y, p[4 * e4 + 1]); p[4 * e4 + 2] = fmaf(xv, w.z, p[4 * e4 + 2]); p[4 * e4 + 3] = fmaf(xv, w.w, p[4 * e4 + 3]); } }
        float q8[8], q4[4], q2[2], q1;
        { const bool up = (lane & 32) != 0;
#pragma unroll
          for (int i = 0; i < 8; ++i) { const float send = up ? p[i] : p[i + 8]; const float recv = __shfl_xor(send, 32); q8[i] = (up ? p[i + 8] : p[i]) + recv; } }
        { const bool up = (lane & 16) != 0;
#pragma unroll
          for (int i = 0; i < 4; ++i) { const float send = up ? q8[i] : q8[i + 4]; const float recv = __shfl_xor(send, 16); q4[i] = (up ? q8[i + 4] : q8[i]) + recv; } }
        { const bool up = (lane & 8) != 0;
#pragma unroll
          for (int i = 0; i < 2; ++i) { const float send = up ? q4[i] : q4[i + 2]; const float recv = __shfl_xor(send, 8); q2[i] = (up ? q4[i + 2] : q4[i]) + recv; } }
        { const bool up = (lane & 4) != 0; const float send = up ? q2[0] : q2[1]; const float recv = __shfl_xor(send, 4); q1 = (up ? q2[1] : q2[0]) + recv; }
        q1 += __shfl_xor(q1, 1); q1 += __shfl_xor(q1, 2);
        const int e = ((lane >> 5) & 1) * 8 + ((lane >> 4) & 1) * 4 + ((lane >> 3) & 1) * 2 + ((lane >> 2) & 1);
        if (MODE == 1) {
            float g = q1 + bias16[e];
            g = 15.f * tanhf(g * (1.f / 15.f));
            const int gate = e >> 2;
            if (gate & 1) g = fminf(g, 0.f) - log1pf(__expf(-fabsf(g)));
            if ((lane & 3) == 0) out16[(size_t)r * 16 + e] = g;
        } else {
            float mx = q1;
#pragma unroll
            for (int o = 4; o < 64; o <<= 1) mx = fmaxf(mx, __shfl_xor(mx, o));
            const float ex = __expf(q1 - mx); float sm = ex;
#pragma unroll
            for (int o = 4; o < 64; o <<= 1) sm += __shfl_xor(sm, o);
            if ((lane & 3) == 0) out16[(size_t)r * 16 + e] = ex / sm;
        }
    }
}
template <int MODE>
__device__ __forceinline__ void norm_pass(Frame& F, const float* xL, const float* xC, int nrows, const float* gain, const float* shiftv, const float* scalev  ,
                                          bf16_t* H, const float* W16, int ldw16, const float* bias16, float* out16) {
    LAS float* wl = (LAS float*)F.lds;
    if (MODE != 0) load_w16(F, W16, ldw16);
    const int lane = F.lane;
    f32x4 gv[4];
#pragma unroll
    for (int j = 0; j < 4; ++j) gv[j] = *(const f32x4*)(gain + 4 * lane + 256 * j);
    const int per = (nrows + F.NGW - 1) / F.NGW; const int r0 = F.gw * per, r1 = (r0 + per < nrows) ? r0 + per : nrows;
    f32x4 vn[4];
    if (r0 < r1) { const float* xr = (r0 >= RL) ? (xC + (size_t)(r0 - RL) * D) : (xL + (size_t)r0 * D);
#pragma unroll
        for (int j = 0; j < 4; ++j) vn[j] = *(const f32x4*)(xr + 4 * lane + 256 * j); }
    for (int r = r0; r < r1; ++r) {
        asm volatile("" ::: "memory");
        f32x4 v[4];
#pragma unroll
        for (int j = 0; j < 4; ++j) v[j] = vn[j];
        if (r + 1 < r1) { const int rn = r + 1; const float* xr = (rn >= RL) ? (xC + (size_t)(rn - RL) * D) : (xL + (size_t)rn * D);
#pragma unroll
            for (int j = 0; j < 4; ++j) vn[j] = *(const f32x4*)(xr + 4 * lane + 256 * j); }
        const int mi = (r >= RL) ? NB : (r >> 12);
        norm_core<MODE>(wl, lane, v, r, gv, shiftv + (size_t)mi * 6 * D, scalev + (size_t)mi * 6 * D, H, bias16, out16);
    }
    if (MODE != 0) __syncthreads();
}

__device__ __forceinline__ void moe_select(Frame& F, const float* AFF, int* INV, int* SLROW, float* SLG, int nunits) {
    LAS unsigned* keys = (LAS unsigned*)F.lds;
    LAS unsigned* wsum = (LAS unsigned*)(F.lds + 16384);
    const int tid = F.tid, lane = F.lane, wave = F.wave;
    for (int u = F.vcu; u < nunits; u += F.G) {
        const int set = u >> 4, e = u & 15; const bool isc = set >= NB; const int b = isc ? set - NB : set;
        const int N = isc ? CTXL : SEQ, k = isc ? CAP_C : CAP_L, PER = isc ? 1 : 8;
        const int row0 = isc ? RL + b * CTXL : b * SEQ;
        const int nmine = (tid * PER < N) ? PER : 0;
        unsigned kv[8];
#pragma unroll
        for (int i = 0; i < 8; ++i) { kv[i] = 0u; if (i < nmine) kv[i] = __float_as_uint(AFF[(size_t)(row0 + tid * PER + i) * 16 + e]); }
        unsigned T = 0u;
        for (int bit = 30; bit >= 0; --bit) {
            const unsigned cand = T | (1u << bit); unsigned c = 0u;
#pragma unroll
            for (int i = 0; i < 8; ++i) c += (i < nmine && kv[i] >= cand) ? 1u : 0u;
#pragma unroll
            for (int o = 1; o < 64; o <<= 1) c += __shfl_xor(c, o);
            LAS unsigned* wsb = wsum + (bit & 1) * 8;
            if (lane == 0) wsb[wave] = c;
            __syncthreads();
            unsigned tot = 0u;
#pragma unroll
            for (int w = 0; w < 8; ++w) tot += wsb[w];
            if (tot >= (unsigned)k) T = cand;
        }
        unsigned ngt = 0u, neq = 0u;
#pragma unroll
        for (int i = 0; i < 8; ++i) { if (i < nmine) { ngt += kv[i] > T ? 1u : 0u; neq += kv[i] == T ? 1u : 0u; } }
        unsigned sgt = ngt, seq = neq;
#pragma unroll
        for (int o = 1; o < 64; o <<= 1) { const unsigned a = __shfl_up(sgt, o), c2 = __shfl_up(seq, o); if (lane >= o) { sgt += a; seq += c2; } }
        LAS unsigned* sc = wsum + 16;
        __syncthreads();
        if (lane == 63) { sc[wave] = sgt; sc[8 + wave] = seq; }
        __syncthreads();
        unsigned bgt = 0u, beq = 0u, tgt = 0u;
#pragma unroll
        for (int w = 0; w < 8; ++w) { const unsigned a = sc[w], c2 = sc[8 + w]; if (w < wave) { bgt += a; beq += c2; } tgt += a; }
        const unsigned need = (unsigned)k - tgt;
        unsigned pgt = bgt + sgt - ngt, peq = beq + seq - neq;
        const int sbase = isc ? NB * CAP_L + b * CAP_C : b * CAP_L;
#pragma unroll
        for (int i = 0; i < 8; ++i) { if (i < nmine) {
            const int row = row0 + tid * PER + i; int slot = -1;
            if (kv[i] > T) { slot = (int)(pgt + (peq < need ? peq : need)); ++pgt; }
            else if (kv[i] == T) { if (peq < need) slot = (int)(pgt + peq); ++peq; }
            if (slot >= 0) { SLROW[e * SLOTS_E + sbase + slot] = row; SLG[e * SLOTS_E + sbase + slot] = __uint_as_float(kv[i]); }
            INV[(size_t)row * 16 + e] = slot >= 0 ? sbase + slot : -1; } }
        __syncthreads();
    }
    (void)keys;
}

__device__ __forceinline__ void moe_gather(Frame& F, const bf16_t* H, const int* SLROW, bf16_t* XG, bool with_ctx) {
    const int per_e = with_ctx ? SLOTS_E : NB * CAP_L; const int total = NE * per_e;
    const int per = (total + F.NGW - 1) / F.NGW; const int i0 = F.gw * per, i1 = (i0 + per < total) ? i0 + per : total;
    for (int i = i0; i < i1; i += 4) {
        u32x4 a[4], b2[4]; size_t dsto[4];
#pragma unroll
        for (int q = 0; q < 4; ++q) { const int ii = (i + q < i1) ? i + q : i1 - 1; const int e = ii / per_e, sl = ii - e * per_e; const int row = SLROW[e * SLOTS_E + sl];
            const u32x4* src = (const u32x4*)(H + (size_t)row * D) + F.lane; a[q] = src[0]; b2[q] = src[64]; dsto[q] = ((size_t)e * SLOTS_E + sl) * D; }
#pragma unroll
        for (int q = 0; q < 4; ++q) { u32x4* dst = (u32x4*)(XG + dsto[q]) + F.lane; dst[0] = a[q]; dst[64] = b2[q]; }
    }
}

template <int MODE>
__device__ __forceinline__ void combine_norm(Frame& F, const bf16_t* Y, const int* INV, float* xL, float* xC, const float* g2v  , int nrows,
                                             const float* gain, const float* shiftv, const float* scalev, bf16_t* H, const float* W16, int ldw16, const float* bias16, float* out16) {
    LAS float* wl = (LAS float*)F.lds;
    if (MODE == 1) load_w16(F, W16, ldw16);
    const int lane = F.lane;
    f32x4 gv[4];
#pragma unroll
    for (int j = 0; j < 4; ++j) gv[j] = *(const f32x4*)(gain + 4 * lane + 256 * j);
    const int per = (nrows + F.NGW - 1) / F.NGW; const int r0 = F.gw * per, r1 = (r0 + per < nrows) ? r0 + per : nrows;
#define CN_XPTR(rr) (((rr) >= RL) ? (xC + (size_t)((rr) - RL) * D) : (xL + (size_t)(rr) * D))
#define CN_INV(rr) (((rr) < r1 && lane < 16) ? INV[(size_t)(rr) * 16 + lane] : -1)
#define CN_YLOAD(dst, e_, s_) do { const u32x2* yp_ = (const u32x2*)(Y + ((size_t)(e_) * SLOTS_E + (s_)) * D) + lane; _Pragma("unroll") for (int j = 0; j < 4; ++j) dst[j] = yp_[64 * j]; } while (0)
#define CN_YACC(src) do { _Pragma("unroll") for (int j = 0; j < 4; ++j) { a[j].x += bf_lo(src[j].x); a[j].y += bf_hi(src[j].x); a[j].z += bf_lo(src[j].y); a[j].w += bf_hi(src[j].y); } } while (0)
    f32x4 vn[4]; u32x2 pn0[4], pn1[4];
    int invA = CN_INV(r0), invB = CN_INV(r0 + 1);
#pragma unroll
    for (int j = 0; j < 4; ++j) { vn[j] = (f32x4){0.f, 0.f, 0.f, 0.f}; pn0[j] = (u32x2){0u, 0u}; pn1[j] = (u32x2){0u, 0u}; }
    if (r0 < r1) { const float* xr = CN_XPTR(r0);
#pragma unroll
        for (int j = 0; j < 4; ++j) vn[j] = *(const f32x4*)(xr + 4 * lane + 256 * j);
        unsigned long long m = __ballot(invA >= 0);
        if (m) { const int e0 = __builtin_ctzll(m); m &= m - 1; CN_YLOAD(pn0, e0, __shfl(invA, e0)); if (m) { const int e1 = __builtin_ctzll(m); CN_YLOAD(pn1, e1, __shfl(invA, e1)); } } }
    for (int r = r0; r < r1; ++r) {
        asm volatile("" ::: "memory");
        f32x4 v[4]; u32x2 pc0[4], pc1[4];
#pragma unroll
        for (int j = 0; j < 4; ++j) { v[j] = vn[j]; pc0[j] = pn0[j]; pc1[j] = pn1[j]; }
        const int invC = CN_INV(r + 2);
        if (r + 1 < r1) { const float* xr = CN_XPTR(r + 1);
#pragma unroll
            for (int j = 0; j < 4; ++j) vn[j] = *(const f32x4*)(xr + 4 * lane + 256 * j);
            unsigned long long m = __ballot(invB >= 0);
            if (m) { const int e0 = __builtin_ctzll(m); m &= m - 1; CN_YLOAD(pn0, e0, __shfl(invB, e0)); if (m) { const int e1 = __builtin_ctzll(m); CN_YLOAD(pn1, e1, __shfl(invB, e1)); } } }
        f32x4 a[4];
#pragma unroll
        for (int j = 0; j < 4; ++j) a[j] = (f32x4){0.f, 0.f, 0.f, 0.f};
        { unsigned long long m = __ballot(invA >= 0);
          if (m) { m &= m - 1; CN_YACC(pc0);
            if (m) { m &= m - 1; CN_YACC(pc1);
              while (m) { const int e2 = __builtin_ctzll(m); m &= m - 1; u32x2 t2[4]; CN_YLOAD(t2, e2, __shfl(invA, e2)); CN_YACC(t2); } } } }
        const int mi = (r >= RL) ? NB : (r >> 12);
        const float* gp = g2v + (size_t)mi * 6 * D;
#pragma unroll
        for (int j = 0; j < 4; ++j) { const f32x4 g = *(const f32x4*)(gp + 4 * lane + 256 * j); v[j] = v[j] + g * a[j]; }
        float* xw = CN_XPTR(r);
        if (MODE == 3) {
            float ss = 0.f;
#pragma unroll
            for (int j = 0; j < 4; ++j) ss += (v[j].x * v[j].x + v[j].y * v[j].y) + (v[j].z * v[j].z + v[j].w * v[j].w);
            const float rstd = rsqrtf(wave_sum(ss) * (1.f / D) + NORM_EPS);
#pragma unroll
            for (int j = 0; j < 4; ++j) *(f32x4*)(xw + 4 * lane + 256 * j) = v[j] * rstd * gv[j];
        } else {
#pragma unroll
            for (int j = 0; j < 4; ++j) *(f32x4*)(xw + 4 * lane + 256 * j) = v[j];
            norm_core<MODE>(wl, lane, v, r, gv, shiftv + (size_t)mi * 6 * D, scalev + (size_t)mi * 6 * D, H, bias16, out16);
        }
        invA = invB; invB = invC;
    }
#undef CN_XPTR
#undef CN_INV
#undef CN_YLOAD
#undef CN_YACC
    if (MODE == 1) __syncthreads();
}

__device__ __forceinline__ void final_norm(Frame& F, float* x, const float* gain) {
    const int lane = F.lane;
    for (int r = F.gw; r < RL; r += F.NGW) { float* xr = x + (size_t)r * D; f32x4 v[4]; float ss = 0.f;
#pragma unroll
        for (int j = 0; j < 4; ++j) { v[j] = *(const f32x4*)(xr + 4 * lane + 256 * j); ss += (v[j].x * v[j].x + v[j].y * v[j].y) + (v[j].z * v[j].z + v[j].w * v[j].w); }
        const float rstd = rsqrtf(wave_sum(ss) * (1.f / D) + NORM_EPS);
#pragma unroll
        for (int j = 0; j < 4; ++j) { const f32x4 g = *(const f32x4*)(gain + 4 * lane + 256 * j); *(f32x4*)(xr + 4 * lane + 256 * j) = v[j] * rstd * g; } }
}

__device__ __forceinline__ void qk_pass(Frame& F, bf16_t* QKV, const float* qn, const float* kn, const float* ropec, const float* ropes, bf16_t* KALL, bf16_t* VALL) {
    const int lane = F.lane, p = lane & 3;
    float gq1[8], gq2[8], gk1[8], gk2[8];
#pragma unroll
    for (int t = 0; t < 8; ++t) { gq1[t] = qn[8 * p + t]; gq2[t] = qn[32 + 8 * p + t]; gk1[t] = kn[8 * p + t]; gk2[t] = kn[32 + 8 * p + t]; }
    for (int r = F.gw; r < RT; r += F.NGW) {
        const bool isc = r >= RL; const int b = isc ? (r - RL) >> 8 : r >> 12; const int t = isc ? (r - RL) & 255 : r & 4095;
        const int pos = isc ? t : CTXL + t;
        bf16_t* row = QKV + (size_t)r * 1536;
        float cs[8], sn[8];
#pragma unroll
        for (int i = 0; i < 8; ++i) { cs[i] = 1.f; sn[i] = 0.f; }
        if (!isc) { const f32x4 c0 = *(const f32x4*)(ropec + t * 32 + 8 * p), c1 = *(const f32x4*)(ropec + t * 32 + 8 * p + 4), s0 = *(const f32x4*)(ropes + t * 32 + 8 * p), s1 = *(const f32x4*)(ropes + t * 32 + 8 * p + 4);
            cs[0] = c0.x; cs[1] = c0.y; cs[2] = c0.z; cs[3] = c0.w; cs[4] = c1.x; cs[5] = c1.y; cs[6] = c1.z; cs[7] = c1.w;
            sn[0] = s0.x; sn[1] = s0.y; sn[2] = s0.z; sn[3] = s0.w; sn[4] = s1.x; sn[5] = s1.y; sn[6] = s1.z; sn[7] = s1.w; }
        {
            bf16_t* hp = row + (lane >> 2) * 64 + 8 * p;
            const u32x4 u1 = *(const u32x4*)hp, u2 = *(const u32x4*)(hp + 32);
            float x1[8], x2[8];
            x1[0] = bf_lo(u1.x); x1[1] = bf_hi(u1.x); x1[2] = bf_lo(u1.y); x1[3] = bf_hi(u1.y); x1[4] = bf_lo(u1.z); x1[5] = bf_hi(u1.z); x1[6] = bf_lo(u1.w); x1[7] = bf_hi(u1.w);
            x2[0] = bf_lo(u2.x); x2[1] = bf_hi(u2.x); x2[2] = bf_lo(u2.y); x2[3] = bf_hi(u2.y); x2[4] = bf_lo(u2.z); x2[5] = bf_hi(u2.z); x2[6] = bf_lo(u2.w); x2[7] = bf_hi(u2.w);
            float ss = 0.f;
#pragma unroll
            for (int i = 0; i < 8; ++i) ss += x1[i] * x1[i] + x2[i] * x2[i];
            ss += __shfl_xor(ss, 1); ss += __shfl_xor(ss, 2);
            const float rstd = rsqrtf(ss * (1.f / 64.f) + NORM_EPS) * attn_body::C2;
            float y1[8], y2[8];
#pragma unroll
            for (int i = 0; i < 8; ++i) { const float a = x1[i] * rstd * gq1[i], c = x2[i] * rstd * gq2[i]; y1[i] = a * cs[i] - c * sn[i]; y2[i] = a * sn[i] + c * cs[i]; }
            u32x4 o1, o2; o1.x = pk2(y1[0], y1[1]); o1.y = pk2(y1[2], y1[3]); o1.z = pk2(y1[4], y1[5]); o1.w = pk2(y1[6], y1[7]);
            o2.x = pk2(y2[0], y2[1]); o2.y = pk2(y2[2], y2[3]); o2.z = pk2(y2[4], y2[5]); o2.w = pk2(y2[6], y2[7]);
            *(u32x4*)hp = o1; *(u32x4*)(hp + 32) = o2;
        }
        {
            const int kh = (lane >> 2) & 3;
            const bf16_t* hp = row + 1024 + kh * 64 + 8 * p;
            const u32x4 u1 = *(const u32x4*)hp, u2 = *(const u32x4*)(hp + 32);
            float x1[8], x2[8];
            x1[0] = bf_lo(u1.x); x1[1] = bf_hi(u1.x); x1[2] = bf_lo(u1.y); x1[3] = bf_hi(u1.y); x1[4] = bf_lo(u1.z); x1[5] = bf_hi(u1.z); x1[6] = bf_lo(u1.w); x1[7] = bf_hi(u1.w);
            x2[0] = bf_lo(u2.x); x2[1] = bf_hi(u2.x); x2[2] = bf_lo(u2.y); x2[3] = bf_hi(u2.y); x2[4] = bf_lo(u2.z); x2[5] = bf_hi(u2.z); x2[6] = bf_lo(u2.w); x2[7] = bf_hi(u2.w);
            float ss = 0.f;
#pragma unroll
            for (int i = 0; i < 8; ++i) ss += x1[i] * x1[i] + x2[i] * x2[i];
            ss += __shfl_xor(ss, 1); ss += __shfl_xor(ss, 2);
            const float rstd = rsqrtf(ss * (1.f / 64.f) + NORM_EPS);
            float y1[8], y2[8];
#pragma unroll
            for (int i = 0; i < 8; ++i) { const float a = x1[i] * rstd * gk1[i], c = x2[i] * rstd * gk2[i]; y1[i] = a * cs[i] - c * sn[i]; y2[i] = a * sn[i] + c * cs[i]; }
            if (lane < 16) {
                bf16_t* kp = KALL + ((size_t)b * KVLEN + pos) * 256 + kh * 64 + 8 * p;
                u32x4 o1, o2; o1.x = pk2(y1[0], y1[1]); o1.y = pk2(y1[2], y1[3]); o1.z = pk2(y1[4], y1[5]); o1.w = pk2(y1[6], y1[7]);
                o2.x = pk2(y2[0], y2[1]); o2.y = pk2(y2[2], y2[3]); o2.z = pk2(y2[4], y2[5]); o2.w = pk2(y2[6], y2[7]);
                *(u32x4*)kp = o1; *(u32x4*)(kp + 32) = o2;
            } else if (lane < 48) {
                const int c8 = (lane - 16) * 8;
                *(u32x4*)(VALL + ((size_t)b * KVLEN + pos) * 256 + c8) = *(const u32x4*)(row + 1280 + c8);
            }
        }
    }
}

__device__ __forceinline__ void mlstm_readout(Frame& F, const bf16_t* HF, const bf16_t* HB, const bf16_t* QKVO, const float* wnorm, bf16_t* MIX) {
    const int lane = F.lane;
    f32x4 gv[4];
#pragma unroll
    for (int j = 0; j < 4; ++j) gv[j] = *(const f32x4*)(wnorm + 4 * lane + 256 * j);
    for (int r = F.gw; r < RT; r += F.NGW) {
        const u32x2* pf = (const u32x2*)(HF + (size_t)r * D) + lane; const u32x2* pb = (const u32x2*)(HB + (size_t)r * D) + lane;
        const u32x2* po = (const u32x2*)(QKVO + (size_t)r * 3072 + 2048) + lane;
        u32x2 uf[4], ub[4], uo[4];
#pragma unroll
        for (int j = 0; j < 4; ++j) { uf[j] = pf[64 * j]; ub[j] = pb[64 * j]; uo[j] = po[64 * j]; }
        unsigned long long* o8 = (unsigned long long*)(MIX + (size_t)r * D) + lane;
#pragma unroll
        for (int j = 0; j < 4; ++j) {
            f32x4 h; h.x = bf_lo(uf[j].x) + bf_lo(ub[j].x); h.y = bf_hi(uf[j].x) + bf_hi(ub[j].x); h.z = bf_lo(uf[j].y) + bf_lo(ub[j].y); h.w = bf_hi(uf[j].y) + bf_hi(ub[j].y);
            const float ss = wave_sum((h.x * h.x + h.y * h.y) + (h.z * h.z + h.w * h.w));
            const float rstd = rsqrtf(ss * (1.f / 256.f) + NORM_EPS);
            f32x4 og; og.x = bf_lo(uo[j].x); og.y = bf_hi(uo[j].x); og.z = bf_lo(uo[j].y); og.w = bf_hi(uo[j].y);
            f32x4 y;
            y.x = h.x * rstd * gv[j].x * fast_rcp(1.f + __expf(-og.x)); y.y = h.y * rstd * gv[j].y * fast_rcp(1.f + __expf(-og.y));
            y.z = h.z * rstd * gv[j].z * fast_rcp(1.f + __expf(-og.z)); y.w = h.w * rstd * gv[j].w * fast_rcp(1.f + __expf(-og.w));
            o8[64 * j] = (unsigned long long)pk2(y.x, y.y) | ((unsigned long long)pk2(y.z, y.w) << 32);
        }
    }
}
namespace mls {
constexpr int XS = 272, PS = 144, NCH = 68;
constexpr int O_XQ = 0, O_XK = 17408, O_XKP = 34816, O_XV = 52224, O_P = 69632, O_CT = 78848, O_OT = 113664, O_GB = 131072;
constexpr int O_RD = O_GB + 2 * 5 * 64 * 4, O_NV = O_RD + 256, O_DEC = O_NV + 1024, O_PRE = O_DEC + 64;
constexpr int LDS_BYTES = O_PRE + 3 * 72 * 4;

__device__ __forceinline__ int row_of(int b, int dir, int c, int p) {
    const int base = (c < 4) ? (RL + b * CTXL + (dir ? 192 - 64 * c : 64 * c)) : (b * SEQ + (dir ? 4032 - 64 * (c - 4) : 64 * (c - 4)));
    return base + (dir ? 63 - p : p);
}
__device__ __forceinline__ bf16x8 tr8(const LAS unsigned char* p0, const LAS unsigned char* p1) {
    typedef short v4i16_t __attribute__((ext_vector_type(4)));
    const s16x4 lo = __builtin_bit_cast(s16x4, __builtin_amdgcn_ds_read_tr16_b64_v4i16((LAS v4i16_t*)p0));
    const s16x4 hi = __builtin_bit_cast(s16x4, __builtin_amdgcn_ds_read_tr16_b64_v4i16((LAS v4i16_t*)p1));
    return (bf16x8){lo[0], lo[1], lo[2], lo[3], hi[0], hi[1], hi[2], hi[3]};
}

__device__ __forceinline__ void gate_arrays(LAS unsigned char* L, const float lf, const float ig, int c, int lane) {
    const int par = c & 1;
    float bs = lf;
#pragma unroll
    for (int o = 1; o < 64; o <<= 1) { const float t = __shfl_up(bs, o); if (lane >= o) bs += t; }
    const float a = ig - bs; float pm = a;
#pragma unroll
    for (int o = 1; o < 64; o <<= 1) { const float t = __shfl_up(pm, o); if (lane >= o) pm = fmaxf(pm, t); }
    const float mst = ((const LAS float*)(L + O_PRE))[144 + c];
    const float M = fmaxf(mst, pm), M63 = __shfl(M, 63);
    LAS float* gb = (LAS float*)(L + O_GB) + par * 320;
    gb[lane] = a; gb[64 + lane] = M; gb[128 + lane] = __expf(mst - M); gb[192 + lane] = __expf(-bs - M); gb[256 + lane] = __expf(a - M63);
    if (lane == 0) ((LAS float*)(L + O_DEC))[par] = __expf(mst - M63);
}

__device__ __forceinline__ void mlstm_unit(Frame& F, int b, int hd, int dir, int half, const bf16_t* QKVO, const float* GATES, bf16_t* HOUT) {
    LAS unsigned char* L = F.lds;
    const int tid = F.tid, lane = F.lane, w = F.wave, fr = lane & 15, g = lane >> 4;
    const int gi = (dir * 2) * 4 + hd, gf = (dir * 2 + 1) * 4 + hd;
    LAS float* pre = (LAS float*)(L + O_PRE);
    __syncthreads();
    if (tid < NCH) { float bs = 0.f, am = -INFINITY;
        for (int p = 0; p < 64; ++p) { const int row = row_of(b, dir, tid, p); const float lf = GATES[(size_t)row * 16 + gf], ig = GATES[(size_t)row * 16 + gi]; bs += lf; am = fmaxf(am, ig - bs); }
        pre[tid] = bs; pre[72 + tid] = am; }
    for (int i = tid; i < (O_OT - O_CT) / 4; i += NTHREADS) ((LAS unsigned*)(L + O_CT))[i] = 0u;
    for (int i = tid; i < 256; i += NTHREADS) ((LAS float*)(L + O_NV))[i] = 0.f;
    __syncthreads();
    if (tid == 0) { float m = 0.f; for (int c = 0; c < NCH; ++c) { pre[144 + c] = m; m = pre[c] + fmaxf(m, pre[72 + c]); } }
    __syncthreads();
    if (w == 0) { const int row = row_of(b, dir, 0, lane); gate_arrays(L, GATES[(size_t)row * 16 + gf], GATES[(size_t)row * 16 + gi], 0, lane); }
    __syncthreads();
    const int qcol = hd * 128, kcol = 512 + hd * 128, vcol = 1024 + hd * 256 + half * 128;
    u32x4 rq[2], rk[2], rv[2];
#define MLS_BAR() do { asm volatile("s_waitcnt lgkmcnt(0)" ::: "memory"); __builtin_amdgcn_s_barrier(); asm volatile("" ::: "memory"); } while (0)
#define MLS_LOAD(c) do { _Pragma("unroll") for (int i_ = 0; i_ < 2; ++i_) { const int pi_ = tid + 512 * i_, p_ = pi_ >> 4, c16_ = pi_ & 15; \
        const bf16_t* rp_ = QKVO + (size_t)row_of(b, dir, (c), p_) * 3072 + c16_ * 8; \
        rq[i_] = *(const u32x4*)(rp_ + qcol); rk[i_] = *(const u32x4*)(rp_ + kcol); rv[i_] = *(const u32x4*)(rp_ + vcol); } } while (0)
#define MLS_STAGE(c) do { const LAS float* wk_ = (const LAS float*)(L + O_GB) + ((c) & 1) * 320 + 256; \
        _Pragma("unroll") for (int i_ = 0; i_ < 2; ++i_) { const int pi_ = tid + 512 * i_, p_ = pi_ >> 4, c16_ = pi_ & 15; const int o_ = p_ * XS + c16_ * 16; \
        *(LAS u32x4*)(L + O_XQ + o_) = rq[i_]; *(LAS u32x4*)(L + O_XK + o_) = rk[i_]; *(LAS u32x4*)(L + O_XV + o_) = rv[i_]; \
        const float s_ = wk_[p_]; u32x4 kk_; \
        kk_.x = pk2(bf_lo(rk[i_].x) * s_, bf_hi(rk[i_].x) * s_); kk_.y = pk2(bf_lo(rk[i_].y) * s_, bf_hi(rk[i_].y) * s_); \
        kk_.z = pk2(bf_lo(rk[i_].z) * s_, bf_hi(rk[i_].z) * s_); kk_.w = pk2(bf_lo(rk[i_].w) * s_, bf_hi(rk[i_].w) * s_); \
        *(LAS u32x4*)(L + O_XKP + o_) = kk_; } } while (0)
    MLS_LOAD(0); MLS_STAGE(0);
    __syncthreads();
    f32x4 C[8];
#pragma unroll
    for (int i = 0; i < 8; ++i) C[i] = (f32x4){0.f, 0.f, 0.f, 0.f};
    LAS unsigned char* CTw = L + O_CT + w * (16 * XS);
    for (int c = 0; c < NCH; ++c) {
        const int par = c & 1; const bool more = (c + 1 < NCH);
        const LAS float* gb = (const LAS float*)(L + O_GB) + par * 320;
        float glf = 0.f, gig = 0.f;
        if (more && w == 0) { const int row = row_of(b, dir, c + 1, lane); glf = GATES[(size_t)row * 16 + gf]; gig = GATES[(size_t)row * 16 + gi]; }
        if (more) MLS_LOAD(c + 1);
        if (more && w == 0) gate_arrays(L, glf, gig, c + 1, lane);
        {
            const int mt = w >> 1;
            bf16x8 aq[4];
#pragma unroll
            for (int ks = 0; ks < 4; ++ks) aq[ks] = *(const LAS bf16x8*)(L + O_XQ + (16 * mt + fr) * XS + (32 * ks + 8 * g) * 2);
            const f32x4 Mj = *(const LAS f32x4*)(gb + 64 + 16 * mt + 4 * g);
#pragma unroll
            for (int n2 = 0; n2 < 2; ++n2) { const int nt = 2 * (w & 1) + n2;
                f32x4 s4 = (f32x4){0.f, 0.f, 0.f, 0.f};
#pragma unroll
                for (int ks = 0; ks < 4; ++ks) { const bf16x8 bk = *(const LAS bf16x8*)(L + O_XK + (16 * nt + fr) * XS + (32 * ks + 8 * g) * 2);
                    s4 = __builtin_amdgcn_mfma_f32_16x16x32_bf16(aq[ks], bk, s4, 0, 0, 0); }
                const int s = 16 * nt + fr; const float as = gb[s];
#pragma unroll
                for (int reg = 0; reg < 4; ++reg) { const int j = 16 * mt + 4 * g + reg;
                    const float pv = (s <= j) ? s4[reg] * __expf(as - Mj[reg]) : 0.f;
                    *(LAS bf16_t*)(L + O_P + j * PS + s * 2) = (bf16_t)f2bf(pv); } }
        }
        f32x4 acc[4];
        {
            bf16x8 ct[4];
#pragma unroll
            for (int ks = 0; ks < 4; ++ks) ct[ks] = *(const LAS bf16x8*)(CTw + fr * XS + (32 * ks + 8 * g) * 2);
#pragma unroll
            for (int mt = 0; mt < 4; ++mt) { f32x4 a4 = (f32x4){0.f, 0.f, 0.f, 0.f};
#pragma unroll
                for (int ks = 0; ks < 4; ++ks) { const bf16x8 q = *(const LAS bf16x8*)(L + O_XQ + (16 * mt + fr) * XS + (32 * ks + 8 * g) * 2);
                    a4 = __builtin_amdgcn_mfma_f32_16x16x32_bf16(q, ct[ks], a4, 0, 0, 0); }
                const f32x4 wi = *(const LAS f32x4*)(gb + 128 + 16 * mt + 4 * g);
                acc[mt] = a4 * wi; }
        }
        MLS_BAR();
        bf16x8 vf[2];
        {
            const LAS unsigned char* vb = L + O_XV + (8 * g + (fr >> 2)) * XS + (16 * w + (lane & 3) * 4) * 2;
#pragma unroll
            for (int k2 = 0; k2 < 2; ++k2) vf[k2] = tr8(vb + 32 * k2 * XS, vb + (32 * k2 + 4) * XS);
#pragma unroll
            for (int mt = 0; mt < 4; ++mt)
#pragma unroll
                for (int k2 = 0; k2 < 2; ++k2) { const bf16x8 ap = *(const LAS bf16x8*)(L + O_P + (16 * mt + fr) * PS + (32 * k2 + 8 * g) * 2);
                    acc[mt] = __builtin_amdgcn_mfma_f32_16x16x32_bf16(ap, vf[k2], acc[mt], 0, 0, 0); }
        }
        {
            const int j = tid >> 3, part = tid & 7;
            const u32x4 pu = *(const LAS u32x4*)(L + O_P + j * PS + part * 16);
            float rs = (bf_lo(pu.x) + bf_hi(pu.x)) + (bf_lo(pu.y) + bf_hi(pu.y)) + (bf_lo(pu.z) + bf_hi(pu.z)) + (bf_lo(pu.w) + bf_hi(pu.w));
            const u32x4 q0 = *(const LAS u32x4*)(L + O_XQ + j * XS + part * 32), q1 = *(const LAS u32x4*)(L + O_XQ + j * XS + part * 32 + 16);
            const LAS f32x4* np = (const LAS f32x4*)(L + O_NV + par * 512 + part * 64);
            const f32x4 n0 = np[0], n1 = np[1], n2 = np[2], n3 = np[3];
            float qn = bf_lo(q0.x) * n0.x + bf_hi(q0.x) * n0.y + bf_lo(q0.y) * n0.z + bf_hi(q0.y) * n0.w
                     + bf_lo(q0.z) * n1.x + bf_hi(q0.z) * n1.y + bf_lo(q0.w) * n1.z + bf_hi(q0.w) * n1.w
                     + bf_lo(q1.x) * n2.x + bf_hi(q1.x) * n2.y + bf_lo(q1.y) * n2.z + bf_hi(q1.y) * n2.w
                     + bf_lo(q1.z) * n3.x + bf_hi(q1.z) * n3.y + bf_lo(q1.w) * n3.z + bf_hi(q1.w) * n3.w;
            rs += __shfl_xor(rs, 1); qn += __shfl_xor(qn, 1); rs += __shfl_xor(rs, 2); qn += __shfl_xor(qn, 2); rs += __shfl_xor(rs, 4); qn += __shfl_xor(qn, 4);
            const float den = rs + gb[128 + j] * qn;
            if (part == 0) ((LAS float*)(L + O_RD))[j] = 1.f / fmaxf(fabsf(den), gb[192 + j]);
        }
        {
            const float decay = ((const LAS float*)(L + O_DEC))[par];
            const LAS unsigned char* kb = L + O_XKP + (8 * g + (fr >> 2)) * XS + ((lane & 3) * 4) * 2;
#pragma unroll
            for (int mt = 0; mt < 8; ++mt) { f32x4 c4 = C[mt] * decay;
#pragma unroll
                for (int k2 = 0; k2 < 2; ++k2) { const bf16x8 ak = tr8(kb + 32 * k2 * XS + 32 * mt, kb + (32 * k2 + 4) * XS + 32 * mt);
                    c4 = __builtin_amdgcn_mfma_f32_16x16x32_bf16(ak, vf[k2], c4, 0, 0, 0); }
                C[mt] = c4;
                u32x2 o; o.x = pk2(c4[0], c4[1]); o.y = pk2(c4[2], c4[3]);
                *(LAS u32x2*)(CTw + fr * XS + (16 * mt + 4 * g) * 2) = o; }
            const int dk = tid >> 2, part = tid & 3; float sm = 0.f;
#pragma unroll
            for (int t = 0; t < 16; ++t) sm += bf2f(*(const LAS bf16_t*)(L + O_XKP + (16 * part + t) * XS + dk * 2));
            sm += __shfl_xor(sm, 1); sm += __shfl_xor(sm, 2);
            if (part == 0) { const LAS float* nv = (const LAS float*)(L + O_NV); ((LAS float*)(L + O_NV))[(par ^ 1) * 128 + dk] = decay * nv[par * 128 + dk] + sm; }
        }
        MLS_BAR();
        {
#pragma unroll
            for (int mt = 0; mt < 4; ++mt) { const f32x4 rd = *(const LAS f32x4*)(L + O_RD + (16 * mt + 4 * g) * 4);
#pragma unroll
                for (int reg = 0; reg < 4; ++reg) *(LAS bf16_t*)(L + O_OT + (16 * mt + 4 * g + reg) * XS + (16 * w + fr) * 2) = (bf16_t)f2bf(acc[mt][reg] * rd[reg]); }
            if (more) MLS_STAGE(c + 1);
        }
        MLS_BAR();
        {
            const int j = tid >> 3, ch = tid & 7;
            const u32x4 o0 = *(const LAS u32x4*)(L + O_OT + j * XS + ch * 32), o1 = *(const LAS u32x4*)(L + O_OT + j * XS + ch * 32 + 16);
            bf16_t* op = HOUT + (size_t)row_of(b, dir, c, j) * D + hd * 256 + half * 128 + ch * 16;
            *(u32x4*)op = o0; *(u32x4*)(op + 8) = o1;
        }
    }
#undef MLS_BAR
#undef MLS_LOAD
#undef MLS_STAGE
}
}
constexpr int MISC_OFF = 135936, LDS_TOTAL = 136192;
static_assert(mls::LDS_BYTES <= MISC_OFF && pg8::STAGE_BYTES <= MISC_OFF && attn_body::LDS_BYTES <= MISC_OFF, "lds");
#ifndef EN_MASK
#define EN_MASK 0xFFFFFFFFu
#endif
#define PH_ON(k) (((EN_MASK) >> (k)) & 1u)
#ifndef REP_MASK
#define REP_MASK 0u
#endif
#define REP_ON(k) (((REP_MASK) >> (k)) & 1u)
#ifndef PH_LIMIT
#define PH_LIMIT 1000
#endif
#ifndef N_LAUNCH_SPLIT
#define N_LAUNCH_SPLIT 0
#endif
constexpr int N_PHASES = 1 + 11 + 10 + 10 + 10;

struct Args { const float* in[21]; float* out; unsigned char* ws; int ph_lo, ph_hi; };
static_assert(sizeof(Args) == 23 * 8 + 8, "no padding");

__device__ __forceinline__ Frame make_frame(unsigned char* lds_gen, unsigned char* ws_) {
    Frame F; int t = threadIdx.x; asm volatile("" : "+v"(t));
    int bx = blockIdx.x; asm volatile("" : "+s"(bx));
    F.lds = (LAS unsigned char*)lds_gen; F.tid = t; F.lane = t & 63; F.wave = __builtin_amdgcn_readfirstlane(t >> 6);
    F.G = gridDim.x; F.bid = bx; F.vcu = (F.G % 8 == 0) ? (bx % 8) * (F.G / 8) + bx / 8 : bx;
    F.gw = F.vcu * NWAVES + F.wave; F.NGW = F.G * NWAVES;
    unsigned char* w = ws_; asm volatile("" : "+s"(w)); F.ws = w; F.in = (const float* const*)(w + WS_PTRS); return F;
}
__global__ void __launch_bounds__(NTHREADS, 2) fwd(Args a) {
    extern __shared__ __attribute__((aligned(16))) unsigned char lds_raw[];
    unsigned char* const lds_gen = lds_raw;
    unsigned char* ws = a.ws;
    if (threadIdx.x < 4) ((LAS unsigned*)((LAS unsigned char*)lds_raw + MISC_OFF))[threadIdx.x] = 0u;
    __syncthreads();
    XcdBarrier bar = xcd_barrier_post((unsigned*)(ws + WS_CTL), (volatile LAS unsigned*)((LAS unsigned char*)lds_raw + MISC_OFF));
    int cur = 0; const int lo = a.ph_lo, hi = a.ph_hi & 0xffff; bool ran = false;
#define PHASE_BEGIN if (cur >= lo && cur < hi) { if (ran) xcd_barrier(bar); ran = true;
#define PHASE_END   } ++cur;

    if (blockIdx.x == 0 && threadIdx.x < 22) ((const float**)(ws + WS_PTRS))[threadIdx.x] = (threadIdx.x < 21) ? a.in[threadIdx.x] : (const float*)a.out;
#define XL ((float*)F.in[21])
#define XC ((float*)(F.ws + WS_XC))
#define H ((bf16_t*)(F.ws + WS_H))
#define MIX ((bf16_t*)(F.ws + WS_MIX))
#define BIG0 ((bf16_t*)(F.ws + WS_BIG0))
#define BIG1 ((bf16_t*)(F.ws + WS_BIG1))
#define GATES ((float*)(F.ws + WS_GATES))
#define AFF ((float*)(F.ws + WS_AFF))
#define INV ((int*)(F.ws + WS_INV))
#define SLROW ((int*)(F.ws + WS_SLROW))
#define SLG ((float*)(F.ws + WS_SLG))
#define IN(k) (F.in[k])

    PHASE_BEGIN if (PH_ON(0)) for (int rep_ = 0; rep_ < (REP_ON(0) ? 2 : 1); ++rep_) { if (rep_) xcd_barrier(bar); Frame F = make_frame(lds_gen, a.ws); p0_prologue(F, a.in, F.ws); } PHASE_END

    for (int layer = 0; layer < DEPTH; ++layer) {
        const bool last = (layer == DEPTH - 1); const int j = layer >> 1;
#define modv ((const float*)(F.ws + WS_MODV) + (size_t)layer * NMI * 6 * D)
#define xLs ((layer == 0) ? IN(0) : (const float*)XL)
#define xCs ((layer == 0) ? IN(2) : (const float*)XC)
        if ((layer & 1) == 0) {
            if (layer == 0) { PHASE_BEGIN if (PH_ON(1)) for (int rep_ = 0; rep_ < (REP_ON(1) ? 2 : 1); ++rep_) { if (rep_) xcd_barrier(bar); Frame F = make_frame(lds_gen, a.ws); norm_pass<1>(F, xLs, xCs, RT, IN(6) + layer * D, modv + 0 * D, modv + 1 * D, H, IN(8) + (size_t)j * D * MW_IN + 3072, MW_IN, IN(9) + j * 16, GATES); } PHASE_END }
            PHASE_BEGIN if (PH_ON(2)) for (int rep_ = 0; rep_ < (REP_ON(2) ? 2 : 1); ++rep_) { if (rep_) xcd_barrier(bar); Frame F = make_frame(lds_gen, a.ws); { pg8::PlainSched S{(const char*)H, (const char*)((bf16_t*)(F.ws + WS_WMI) + (size_t)j * 3072 * D), RT / 256, 12, D, F.G, F.bid};
                pg8::EpiBf16 E{BIG0, 3072, 2, 0.08838834764831845f}; pg8::gemm_phase(F.lds, F.tid, D, S, E); } } PHASE_END
            PHASE_BEGIN if (PH_ON(3)) for (int rep_ = 0; rep_ < (REP_ON(3) ? 2 : 1); ++rep_) { if (rep_) xcd_barrier(bar); Frame F = make_frame(lds_gen, a.ws); for (int u = F.vcu; u < 256; u += F.G) { const int half = u & 1, dir = (u >> 1) & 1, hd = (u >> 2) & 3, b = u >> 4;
                mls::mlstm_unit(F, b, hd, dir, half, BIG0, GATES, dir ? MIX : H); } } PHASE_END
            PHASE_BEGIN if (PH_ON(4)) for (int rep_ = 0; rep_ < (REP_ON(4) ? 2 : 1); ++rep_) { if (rep_) xcd_barrier(bar); Frame F = make_frame(lds_gen, a.ws); mlstm_readout(F, H, MIX, BIG0, IN(10) + j * D, MIX); } PHASE_END
            PHASE_BEGIN if (PH_ON(5)) for (int rep_ = 0; rep_ < (REP_ON(5) ? 2 : 1); ++rep_) { if (rep_) xcd_barrier(bar); Frame F = make_frame(lds_gen, a.ws); { pg8::PlainSched S{(const char*)MIX, (const char*)((bf16_t*)(F.ws + WS_WMO) + (size_t)j * D * D), RT / 256, 4, D, F.G, F.bid};
                pg8::EpiResid E{xLs, xCs, XL, XC, modv + 2 * D}; pg8::gemm_phase(F.lds, F.tid, D, S, E); } } PHASE_END
        } else {
#define KALL BIG1
#define VALL (BIG1 + (size_t)NB * KVLEN * 256)
            PHASE_BEGIN if (PH_ON(7)) for (int rep_ = 0; rep_ < (REP_ON(7) ? 2 : 1); ++rep_) { if (rep_) xcd_barrier(bar); Frame F = make_frame(lds_gen, a.ws); { pg8::PlainSched S{(const char*)H, (const char*)((bf16_t*)(F.ws + WS_WAI) + (size_t)j * 1536 * D), RT / 256, 6, D, F.G, F.bid};
                pg8::EpiBf16 E{BIG0, 1536, 0, 1.f}; pg8::gemm_phase(F.lds, F.tid, D, S, E); } } PHASE_END
            PHASE_BEGIN if (PH_ON(8)) for (int rep_ = 0; rep_ < (REP_ON(8) ? 2 : 1); ++rep_) { if (rep_) xcd_barrier(bar); Frame F = make_frame(lds_gen, a.ws); qk_pass(F, BIG0, IN(13) + j * 64, IN(14) + j * 64, (const float*)(F.ws + WS_ROPE), (const float*)(F.ws + WS_ROPE) + SEQ * 32, KALL, VALL); } PHASE_END
            PHASE_BEGIN if (PH_ON(9)) for (int rep_ = 0; rep_ < (REP_ON(9) ? 2 : 1); ++rep_) { if (rep_) xcd_barrier(bar); Frame F = make_frame(lds_gen, a.ws); { const int nun = last ? 4096 : 4096 + 256;
                for (int L = F.vcu; L < nun; L += F.G) {
                    const bool isc = L >= 4096; const int Lc = L - 4096;
                    const int grp = L >> 6, wi = L & 63;
                    const int b = isc ? (Lc >> 4) : (grp >> 2), hq = isc ? (Lc & 15) : ((grp & 3) * 4 + (wi >> 4));
                    const size_t row0 = isc ? ((size_t)RL + b * CTXL) : ((size_t)b * SEQ + (wi & 15) * 256);
                    attn_body::attn_unit<8>(BIG0 + row0 * 1536 + hq * 64, 1536, KALL + (size_t)b * KVLEN * 256 + (hq >> 2) * 64, VALL + (size_t)b * KVLEN * 256 + (hq >> 2) * 64, 256, isc ? CTXL / 64 : KVLEN / 64,
                                            MIX + row0 * D + hq * 64, D, (char*)lds_gen, F.tid); } } } PHASE_END
            PHASE_BEGIN if (PH_ON(10)) for (int rep_ = 0; rep_ < (REP_ON(10) ? 2 : 1); ++rep_) { if (rep_) xcd_barrier(bar); Frame F = make_frame(lds_gen, a.ws); { pg8::PlainSched S{(const char*)MIX, (const char*)((bf16_t*)(F.ws + WS_WAO) + (size_t)j * D * D), (last ? RL : RT) / 256, 4, D, F.G, F.bid};
                pg8::EpiResid E{xLs, xCs, XL, XC, modv + 2 * D}; pg8::gemm_phase(F.lds, F.tid, D, S, E); } } PHASE_END
        }
        const int nrows = last ? RL : RT;
        PHASE_BEGIN if (PH_ON(11)) for (int rep_ = 0; rep_ < (REP_ON(11) ? 2 : 1); ++rep_) { if (rep_) xcd_barrier(bar); Frame F = make_frame(lds_gen, a.ws); moe_weights(F, IN(17) + (size_t)layer * NE * D * D, IN(18) + (size_t)layer * NE * D * D, IN(19) + (size_t)layer * NE * D * D, F.ws);
            norm_pass<2>(F, XL, XC, nrows, IN(7) + layer * D, modv + 3 * D, modv + 4 * D, H, IN(16) + (size_t)layer * D * 16, 16, nullptr, AFF); } PHASE_END
        PHASE_BEGIN if (PH_ON(12)) for (int rep_ = 0; rep_ < (REP_ON(12) ? 2 : 1); ++rep_) { if (rep_) xcd_barrier(bar); Frame F = make_frame(lds_gen, a.ws); moe_select(F, AFF, INV, SLROW, SLG, last ? NB * NE : 2 * NB * NE); } PHASE_END
        PHASE_BEGIN if (PH_ON(13)) for (int rep_ = 0; rep_ < (REP_ON(13) ? 2 : 1); ++rep_) { if (rep_) xcd_barrier(bar); Frame F = make_frame(lds_gen, a.ws); moe_gather(F, H, SLROW, BIG0, !last); } PHASE_END
        PHASE_BEGIN if (PH_ON(14)) for (int rep_ = 0; rep_ < (REP_ON(14) ? 2 : 1); ++rep_) { if (rep_) xcd_barrier(bar); Frame F = make_frame(lds_gen, a.ws); { pg8::MoeSched S{(const char*)BIG0, (const char*)(F.ws + WS_W1), last ? 32 : 34, 8, D, 2048, F.G, F.bid};
            pg8::EpiSwiglu E{BIG1}; pg8::gemm_phase(F.lds, F.tid, D, S, E); } } PHASE_END
        PHASE_BEGIN if (PH_ON(15)) for (int rep_ = 0; rep_ < (REP_ON(15) ? 2 : 1); ++rep_) { if (rep_) xcd_barrier(bar); Frame F = make_frame(lds_gen, a.ws); { pg8::MoeSched S{(const char*)BIG1, (const char*)(F.ws + WS_W2), last ? 32 : 34, 4, D, 1024, F.G, F.bid};
            pg8::EpiRowScale E{BIG0, SLG}; pg8::gemm_phase(F.lds, F.tid, D, S, E); } } PHASE_END
        PHASE_BEGIN if (PH_ON(16)) for (int rep_ = 0; rep_ < (REP_ON(16) ? 2 : 1); ++rep_) { if (rep_) xcd_barrier(bar); Frame F = make_frame(lds_gen, a.ws);
            const int nl = layer + 1; const float* modn = (const float*)(F.ws + WS_MODV) + (size_t)nl * NMI * 6 * D;
            if (last) combine_norm<3>(F, BIG0, INV, XL, XC, modv + 5 * D, RL, IN(20), nullptr, nullptr, nullptr, nullptr, 0, nullptr, nullptr);
            else if (nl & 1) combine_norm<0>(F, BIG0, INV, XL, XC, modv + 5 * D, RT, IN(6) + nl * D, modn + 0 * D, modn + 1 * D, H, nullptr, 0, nullptr, nullptr);
            else combine_norm<1>(F, BIG0, INV, XL, XC, modv + 5 * D, RT, IN(6) + nl * D, modn + 0 * D, modn + 1 * D, H, IN(8) + (size_t)(nl >> 1) * D * MW_IN + 3072, MW_IN, IN(9) + (nl >> 1) * 16, GATES); } PHASE_END
    }
#undef XL
#undef XC
#undef H
#undef MIX
#undef BIG0
#undef BIG1
#undef GATES
#undef AFF
#undef INV
#undef SLROW
#undef SLG
#undef IN
#undef modv
#undef xLs
#undef xCs
#undef KALL
#undef VALL
#undef PHASE_BEGIN
#undef PHASE_END
}

extern "C" void kernel_launch(void* const* d_in, const int* in_sizes, int n_in, void* d_out, int out_size, void* d_ws, size_t ws_size, hipStream_t stream) {
    static int grid = 0;
    if (grid == 0) {
        if (n_in != 21 || out_size != RL * D || ws_size < WS_END) { fprintf(stderr, "kernel_launch: unexpected shapes: n_in %d out %d ws %zu (need %zu)\n", n_in, out_size, ws_size, (size_t)WS_END); grid = -1; return; }
        int dev = 0, cus = 0, per_cu = 0;
        if (hipGetDevice(&dev) != hipSuccess || hipDeviceGetAttribute(&cus, hipDeviceAttributeMultiprocessorCount, dev) != hipSuccess) { grid = -1; return; }
        if (hipFuncSetAttribute((const void*)fwd, hipFuncAttributeMaxDynamicSharedMemorySize, LDS_TOTAL) != hipSuccess) { fprintf(stderr, "kernel_launch: hipFuncSetAttribute failed\n"); grid = -1; return; }
        if (hipOccupancyMaxActiveBlocksPerMultiprocessor(&per_cu, (const void*)fwd, NTHREADS, LDS_TOTAL) != hipSuccess || per_cu < 1) fprintf(stderr, "kernel_launch: occupancy query says %d\n", per_cu);
        (void)hipGetLastError();
        grid = cus;
    }
    if (grid < 0) return;
    (void)in_sizes;
    if (hipMemsetAsync((char*)d_ws + WS_CTL, 0, CTL_BYTES, stream) != hipSuccess) return;
    Args a{};
    for (int i = 0; i < 21; ++i) a.in[i] = (const float*)d_in[i];
    a.out = (float*)d_out; a.ws = (unsigned char*)d_ws;
    const int nph = N_PHASES < PH_LIMIT ? N_PHASES : PH_LIMIT;
#if N_LAUNCH_SPLIT
    for (int p = 0; p < nph; ++p) { a.ph_lo = p; a.ph_hi = p + 1; hipLaunchKernelGGL(fwd, dim3(grid), dim3(NTHREADS), LDS_TOTAL, stream, a); }
#else
    a.ph_lo = 0; a.ph_hi = nph;
    hipLaunchKernelGGL(fwd, dim3(grid), dim3(NTHREADS), LDS_TOTAL, stream, a);
#endif
    const hipError_t le = hipPeekAtLastError();
    if (le != hipSuccess) fprintf(stderr, "kernel_launch: launch failed: %s\n", hipGetErrorName(le));
}
```

```cpp
#include <hip/hip_runtime.h>
#include <cstdio>
#include <cstdint>

#define GAS __attribute__((address_space(1)))
#define LAS __attribute__((address_space(3)))
typedef unsigned short bf16_t;
typedef short bf16x8 __attribute__((ext_vector_type(8)));
typedef short s16x4 __attribute__((ext_vector_type(4)));
typedef float f32x4 __attribute__((ext_vector_type(4)));
typedef float f32x2 __attribute__((ext_vector_type(2)));
typedef float f32x16 __attribute__((ext_vector_type(16)));
typedef unsigned u32x4 __attribute__((ext_vector_type(4)));
typedef unsigned u32x2 __attribute__((ext_vector_type(2)));

constexpr int D = 1024, NB = 16, SEQ = 4096, CTXL = 256, DEPTH = 4;
constexpr int RL = NB * SEQ, RC = NB * CTXL, RT = RL + RC;
constexpr int NE = 16, CAP_L = 512, CAP_C = 32, SLOTS_E = NB * CAP_L + NB * CAP_C;
constexpr int NMI = NB + 1;
constexpr int MW_IN = 3088;
constexpr int KVLEN = CTXL + SEQ;
constexpr int NWAVES = 8, NTHREADS = 512;
constexpr float NORM_EPS = 1e-6f;

constexpr size_t al256(size_t x) { return (x + 255) & ~(size_t)255; }
constexpr size_t WS_CTL   = 0;
constexpr size_t CTL_BYTES = 16384;
constexpr size_t WS_PTRS  = WS_CTL + CTL_BYTES;
constexpr size_t WS_MODV  = WS_PTRS + 256;
constexpr size_t WS_ROPE  = al256(WS_MODV + (size_t)DEPTH * NMI * 6 * D * 4);
constexpr size_t WS_XC    = al256(WS_ROPE + (size_t)2 * SEQ * 32 * 4);
constexpr size_t WS_GATES = al256(WS_XC + (size_t)RC * D * 4);
constexpr size_t WS_AFF   = al256(WS_GATES + (size_t)RT * 16 * 4);
constexpr size_t WS_INV   = al256(WS_AFF + (size_t)RT * 16 * 4);
constexpr size_t WS_SLROW = al256(WS_INV + (size_t)RT * 16 * 4);
constexpr size_t WS_SLG   = al256(WS_SLROW + (size_t)NE * SLOTS_E * 4);
constexpr size_t WS_WMI   = al256(WS_SLG + (size_t)NE * SLOTS_E * 4);
constexpr size_t WS_WMO   = al256(WS_WMI + (size_t)2 * 3072 * D * 2);
constexpr size_t WS_WAI   = al256(WS_WMO + (size_t)2 * D * D * 2);
constexpr size_t WS_WAO   = al256(WS_WAI + (size_t)2 * 1536 * D * 2);
constexpr size_t WS_W1    = al256(WS_WAO + (size_t)2 * D * D * 2);
constexpr size_t WS_W2    = al256(WS_W1 + (size_t)NE * 2048 * D * 2);
constexpr size_t WS_H     = al256(WS_W2 + (size_t)NE * D * D * 2);
constexpr size_t WS_MIX   = al256(WS_H + (size_t)RT * D * 2);
constexpr size_t WS_BIG0  = al256(WS_MIX + (size_t)RT * D * 2);
constexpr size_t BIG_HALF = (size_t)NE * SLOTS_E * D * 2;
constexpr size_t WS_BIG1  = al256(WS_BIG0 + BIG_HALF);
constexpr size_t WS_END   = al256(WS_BIG1 + BIG_HALF);
static_assert((size_t)RT * 3072 * 2 <= 2 * BIG_HALF, "qkvo fits");

#define LDS_WAIT() asm volatile("s_waitcnt lgkmcnt(0)" ::: "memory")
#define VM_WAIT() asm volatile("s_waitcnt vmcnt(0)" ::: "memory")
typedef __bf16 bf16x2_t __attribute__((ext_vector_type(2)));
__device__ __forceinline__ unsigned pk2(float lo, float hi) { f32x2 v = {lo, hi}; bf16x2_t b = __builtin_convertvector(v, bf16x2_t); return __builtin_bit_cast(unsigned, b); }
__device__ __forceinline__ unsigned f2bf(float f) { return pk2(f, f) & 0xffffu; }
__device__ __forceinline__ float bf_lo(unsigned u) { return __builtin_bit_cast(float, u << 16); }
__device__ __forceinline__ float bf_hi(unsigned u) { return __builtin_bit_cast(float, u & 0xffff0000u); }
__device__ __forceinline__ float bf2f(bf16_t b) { return __builtin_bit_cast(float, ((unsigned)b) << 16); }
template <int CTRL> __device__ __forceinline__ float dpp_f(float old, float v) { return __builtin_bit_cast(float, __builtin_amdgcn_update_dpp(__builtin_bit_cast(int, old), __builtin_bit_cast(int, v), CTRL, 0xf, 0xf, false)); }
__device__ __forceinline__ float rdlane(float v, int l) { return __builtin_bit_cast(float, __builtin_amdgcn_readlane(__builtin_bit_cast(int, v), l)); }
__device__ __forceinline__ float row16_sum(float v) {
    v += dpp_f<0xB1>(0.f, v); v += dpp_f<0x4E>(0.f, v); v += dpp_f<0x141>(0.f, v); v += dpp_f<0x140>(0.f, v); return v; }
__device__ __forceinline__ float oct_sum(float v) {
    v += dpp_f<0xB1>(0.f, v); v += dpp_f<0x4E>(0.f, v); v += dpp_f<0x141>(0.f, v); return v; }
__device__ __forceinline__ float quad_sum(float v) { v += dpp_f<0xB1>(0.f, v); v += dpp_f<0x4E>(0.f, v); return v; }
__device__ __forceinline__ float wave_sum(float v) {
    v = row16_sum(v); return (rdlane(v, 0) + rdlane(v, 16)) + (rdlane(v, 32) + rdlane(v, 48)); }
__device__ __forceinline__ float wave_scan_add(float v, int lane) {
    v += dpp_f<0x111>(0.f, v); v += dpp_f<0x112>(0.f, v); v += dpp_f<0x114>(0.f, v); v += dpp_f<0x118>(0.f, v);
    const float t0 = rdlane(v, 15), t1 = rdlane(v, 31), t2 = rdlane(v, 47);
    const int row = lane >> 4; return v + (row == 0 ? 0.f : row == 1 ? t0 : row == 2 ? t0 + t1 : (t0 + t1) + t2); }
__device__ __forceinline__ float wave_scan_max(float v, int lane) {
    const float NI = -INFINITY;
    v = fmaxf(v, dpp_f<0x111>(NI, v)); v = fmaxf(v, dpp_f<0x112>(NI, v)); v = fmaxf(v, dpp_f<0x114>(NI, v)); v = fmaxf(v, dpp_f<0x118>(NI, v));
    const float t0 = rdlane(v, 15), t1 = rdlane(v, 31), t2 = rdlane(v, 47);
    const int row = lane >> 4; return fmaxf(v, row == 0 ? NI : row == 1 ? t0 : row == 2 ? fmaxf(t0, t1) : fmaxf(fmaxf(t0, t1), t2)); }
__device__ __forceinline__ float fast_exp(float x) { return __builtin_amdgcn_exp2f(x * 1.4426950408889634f); }
__device__ __forceinline__ float fast_rcp(float x) { return __builtin_amdgcn_rcpf(x); }
__device__ __forceinline__ float silu_f(float x) { return x / (1.f + __expf(-x)); }

#define XB_TMO      128
#define XB_XCNT(j)  (256  + 64 * (j))
#define XB_XSUB(j)  (1280 + 64 * (j))
#define XB_XGEN(j)  (2304 + 64 * (j))
#define XB_TOP      3328
#define XB_TOPGEN   3392
#define XCD_BAR_WORDS 3456
#define XB_SPIN_CAP (1u << 21)
static_assert(XCD_BAR_WORDS * 4 <= CTL_BYTES, "ctl");

__device__ __forceinline__ unsigned xb_ld(unsigned* p)              { return __hip_atomic_load(p, __ATOMIC_RELAXED, __HIP_MEMORY_SCOPE_AGENT); }
__device__ __forceinline__ unsigned xb_add(unsigned* p, unsigned v) { return __hip_atomic_fetch_add(p, v, __ATOMIC_RELAXED, __HIP_MEMORY_SCOPE_AGENT); }
__device__ __forceinline__ unsigned xb_xcc_id() { return (unsigned)__builtin_amdgcn_s_getreg((3 << 11) | 20) & 0xFu; }
#define XB_SPIN(cond, bar) do { unsigned _sp = 0; while (cond) { __builtin_amdgcn_s_sleep(1); \
    if ((++_sp & 255u) == 0u) { if (xb_ld(&(bar)[XB_TMO])) break; if (_sp > XB_SPIN_CAP) { atomicAdd(&(bar)[XB_TMO], 1u); break; } } } } while (0)

struct XcdBarrier { unsigned* bar; unsigned x; volatile LAS unsigned* st; };

__device__ __forceinline__ XcdBarrier xcd_barrier_post(unsigned* bar, volatile LAS unsigned* st) {
    XcdBarrier b; b.bar = bar; b.x = xb_xcc_id(); b.st = st;
    if (threadIdx.x == 0) (void)xb_add(&bar[XB_XCNT(b.x)], 1u);
    return b;
}
__device__ __forceinline__ void xcd_barrier_complete(unsigned* bar, unsigned x, unsigned& nloc, unsigned& nx) {
    const unsigned G = gridDim.x * gridDim.y * gridDim.z;
    unsigned sum, cnt, mine, sp = 0u;
    for (;;) {
        sum = 0u; cnt = 0u; mine = 0u;
#pragma unroll
        for (unsigned j = 0; j < 16; ++j) { const unsigned c = xb_ld(&bar[XB_XCNT(j)]); sum += c; cnt += (c > 0u) ? 1u : 0u; mine = (j == x) ? c : mine; }
        if (sum == G) break;
        __builtin_amdgcn_s_sleep(1);
        if ((++sp & 255u) == 0u) { if (xb_ld(&bar[XB_TMO])) break; if (sp > XB_SPIN_CAP) { atomicAdd(&bar[XB_TMO], 1u); break; } }
    }
    nloc = mine > 0u ? mine : 1u; nx = cnt > 0u ? cnt : 1u;
}
__device__ __forceinline__ void xcd_barrier(const XcdBarrier& b) {
    asm volatile("s_waitcnt vmcnt(0)" ::: "memory");
    __syncthreads();
    if (threadIdx.x == 0) {
        unsigned* bar = b.bar;
        __builtin_amdgcn_s_waitcnt(0);
        unsigned nloc = b.st[0], nx = b.st[1];
        if (nloc == 0u) { xcd_barrier_complete(bar, b.x, nloc, nx); b.st[0] = nloc; b.st[1] = nx; }
        const unsigned old = xb_add(&bar[XB_XSUB(b.x)], 1u);
        const unsigned gen = old / nloc;
        if (old + 1u == (gen + 1u) * nloc) {
            __builtin_amdgcn_fence(__ATOMIC_RELEASE, "agent");
            asm volatile("s_waitcnt vmcnt(0)" ::: "memory");
            const unsigned og = xb_add(&bar[XB_TOP], 1u);
            const unsigned tg = og / nx;
            if (og + 1u == (tg + 1u) * nx) xb_add(&bar[XB_TOPGEN], 1u);
            else XB_SPIN(xb_ld(&bar[XB_TOPGEN]) == tg, bar);
            __builtin_amdgcn_fence(__ATOMIC_ACQUIRE, "agent");
            xb_add(&bar[XB_XGEN(b.x)], 1u);
            asm volatile("s_waitcnt vmcnt(0)" ::: "memory");
        } else {
            XB_SPIN(xb_ld(&bar[XB_XGEN(b.x)]) == gen, bar);
            __builtin_amdgcn_fence(__ATOMIC_ACQUIRE, "agent");
            asm volatile("s_waitcnt vmcnt(0)" ::: "memory");
        }
    }
    __syncthreads();
}
namespace pg8 {
constexpr int BM = 256, BK = 64, HALF = 128, HTB = HALF * BK * 2, STAGE_BYTES = 8 * HTB, NXCD = 8, WGM = 8;

__host__ __device__ __forceinline__ int lds_byte(int r, int c) { const int st = (r >> 4) * 2 + (c >> 5), rr = r & 15, cc = c & 31, ob = rr * 64 + cc * 2; return st * 1024 + (ob ^ (((ob >> 9) & 1) << 5)); }
__host__ __device__ __forceinline__ void stage_rc(int b, int& R, int& C) { const int st = b / 1024, sb = b % 1024, swz = sb ^ (((sb >> 9) & 1) << 5); R = (st >> 1) * 16 + swz / 64; C = (st & 1) * 32 + (swz % 64) / 2; }
__host__ __device__ __forceinline__ int perm32(int rho) { const int n = rho >> 4, i = rho & 15; return 8 * (i >> 2) + 4 * n + (i & 3); }

struct Unit { const char* A; const char* B; int pm, pn; };

__device__ __forceinline__ bool static_tile(int i, int G, int c, int nM, int nN, int& pm, int& pn) {
    const int nwg = nM * nN; const long L = (long)i * G + c; if (L >= nwg) return false;
    int wgid = (int)L; { const int q = nwg / NXCD, r = nwg % NXCD, xcd = wgid % NXCD, off = wgid / NXCD; wgid = (xcd < r ? xcd * (q + 1) : r * (q + 1) + (xcd - r) * q) + off; }
    const int nig = WGM * nN, gid = wgid / nig, fm = gid * WGM, gsz = (nM - fm) < WGM ? (nM - fm) : WGM;
    pm = fm + ((wgid % nig) % gsz); pn = (wgid % nig) / gsz; return true;
}
struct PlainSched {
    const char* A; const char* Bt; int nM, nN, K, G, c;
    __device__ __forceinline__ bool next(int i, Unit& u) const {
        int pm, pn; if (!static_tile(i, G, c, nM, nN, pm, pn)) return false;
        u.pm = pm; u.pn = pn; u.A = A + (size_t)pm * 256 * K * 2; u.B = Bt + (size_t)pn * 256 * K * 2; return true;
    }
};
struct MoeSched {
    const char* A; const char* W; int tpe, nN, K, bN, G, c;
    __device__ __forceinline__ bool next(int i, Unit& u) const {
        int pm, pn; if (!static_tile(i, G, c, NE * tpe, nN, pm, pn)) return false;
        const int e = pm / tpe, rt = pm - e * tpe;
        u.pm = e * (SLOTS_E / 256) + rt; u.pn = pn;
        u.A = A + (size_t)u.pm * 256 * K * 2; u.B = W + ((size_t)e * bN + (size_t)pn * 256) * K * 2; return true;
    }
};

__device__ __forceinline__ unsigned cvt_pk_bf16(float lo, float hi) { return pk2(lo, hi); }


struct EpiBf16 {
    static constexpr bool PERM = true;
    bf16_t* O; int ldc; int nscale; float scale;
    __device__ __forceinline__ void operator()(const f32x4 (&acc)[2][2][4][2], const Unit& u, int wr, int wc, int fr, int fq) const {
        const int row0 = u.pm * BM + wr * 64 + fr, col0 = u.pn * BM + wc * 32 + 8 * fq;
        const float s = (u.pn < nscale) ? scale : 1.f;
#pragma unroll
        for (int ai = 0; ai < 2; ++ai)
#pragma unroll
            for (int m = 0; m < 4; ++m) { bf16_t* rowp = O + (size_t)(row0 + ai * HALF + m * 16) * ldc + col0;
#pragma unroll
                for (int bj = 0; bj < 2; ++bj) { const f32x4 v0 = acc[ai][bj][m][0] * s, v1 = acc[ai][bj][m][1] * s;
                    u32x4 o; o.x = cvt_pk_bf16(v0[0], v0[1]); o.y = cvt_pk_bf16(v0[2], v0[3]); o.z = cvt_pk_bf16(v1[0], v1[1]); o.w = cvt_pk_bf16(v1[2], v1[3]);
                    *(u32x4*)(rowp + bj * HALF) = o; } }
    }
};
struct EpiResid {
    static constexpr bool PERM = false;
    const float* srcL; const float* srcC; float* dstL; float* dstC; const float* gate;
    __device__ __forceinline__ void operator()(const f32x4 (&acc)[2][2][4][2], const Unit& u, int wr, int wc, int fr, int fq) const {
        const bool isc = u.pm >= RL / 256;
        const int mi = isc ? NB : (u.pm >> 4);
        const int rbase = (isc ? (u.pm - RL / 256) : u.pm) * BM + wr * 64 + fr, col0 = u.pn * BM + wc * 32 + 4 * fq;
        const float* src = isc ? srcC : srcL; float* dst = isc ? dstC : dstL;
        const float* gp = gate + (size_t)mi * 6 * D + col0;
        f32x4 gv[2][2];
#pragma unroll
        for (int bj = 0; bj < 2; ++bj)
#pragma unroll
            for (int n = 0; n < 2; ++n) gv[bj][n] = *(const f32x4*)(gp + bj * HALF + n * 16);
#pragma unroll
        for (int ai = 0; ai < 2; ++ai)
#pragma unroll
            for (int m = 0; m < 4; ++m) { const size_t ro = (size_t)(rbase + ai * HALF + m * 16) * D + col0;
#pragma unroll
                for (int bj = 0; bj < 2; ++bj)
#pragma unroll
                    for (int n = 0; n < 2; ++n) { const f32x4 xv = *(const f32x4*)(src + ro + bj * HALF + n * 16);
                        *(f32x4*)(dst + ro + bj * HALF + n * 16) = xv + gv[bj][n] * acc[ai][bj][m][n]; } }
    }
};
struct EpiSwiglu {
    static constexpr bool PERM = true;
    bf16_t* O;
    __device__ __forceinline__ void operator()(const f32x4 (&acc)[2][2][4][2], const Unit& u, int wr, int wc, int fr, int fq) const {
        const int row0 = u.pm * BM + wr * 64 + fr, col0 = u.pn * HALF + wc * 32 + 8 * fq;
#pragma unroll
        for (int ai = 0; ai < 2; ++ai)
#pragma unroll
            for (int m = 0; m < 4; ++m) { bf16_t* rowp = O + (size_t)(row0 + ai * HALF + m * 16) * D + col0;
                float r[8];
#pragma unroll
                for (int n = 0; n < 2; ++n)
#pragma unroll
                    for (int j = 0; j < 4; ++j) { const float g = acc[ai][0][m][n][j], up = acc[ai][1][m][n][j]; r[n * 4 + j] = g * fast_rcp(1.f + fast_exp(-g)) * up; }
                u32x4 o; o.x = cvt_pk_bf16(r[0], r[1]); o.y = cvt_pk_bf16(r[2], r[3]); o.z = cvt_pk_bf16(r[4], r[5]); o.w = cvt_pk_bf16(r[6], r[7]);
                *(u32x4*)rowp = o; }
    }
};
struct EpiRowScale {
    static constexpr bool PERM = true;
    bf16_t* O; const float* g;
    __device__ __forceinline__ void operator()(const f32x4 (&acc)[2][2][4][2], const Unit& u, int wr, int wc, int fr, int fq) const {
        const int row0 = u.pm * BM + wr * 64 + fr, col0 = u.pn * BM + wc * 32 + 8 * fq;
#pragma unroll
        for (int ai = 0; ai < 2; ++ai)
#pragma unroll
            for (int m = 0; m < 4; ++m) { const int row = row0 + ai * HALF + m * 16; const float s = g[row]; bf16_t* rowp = O + (size_t)row * D + col0;
#pragma unroll
                for (int bj = 0; bj < 2; ++bj) { const f32x4 v0 = acc[ai][bj][m][0] * s, v1 = acc[ai][bj][m][1] * s;
                    u32x4 o; o.x = cvt_pk_bf16(v0[0], v0[1]); o.y = cvt_pk_bf16(v0[2], v0[3]); o.z = cvt_pk_bf16(v1[0], v1[1]); o.w = cvt_pk_bf16(v1[2], v1[3]);
                    *(u32x4*)(rowp + bj * HALF) = o; } }
    }
};

template <class Epi, class Sched, bool GATHER = false>
__device__ __forceinline__ void gemm_phase(LAS unsigned char* lds, const int tid, const int K, const Sched& S, const Epi& E, const int* rowidx = nullptr) {
    const int wid = __builtin_amdgcn_readfirstlane(tid >> 6), lane = tid & 63, wr = wid >> 2, wc = wid & 3, fr = lane & 15, fq = lane >> 4;
    const int nt = K / BK;
    unsigned voffA[2], voffB[2]; int gR[2], gC[2];
#pragma unroll
    for (int i = 0; i < 2; ++i) { int R, C; stage_rc(tid * 16 + i * 8192, R, C); const int Rb = Epi::PERM ? ((R & ~31) + perm32(R & 31)) : R;
        voffA[i] = (unsigned)(R * K + C) * 2u; voffB[i] = (unsigned)(Rb * K + C) * 2u; gR[i] = R; gC[i] = C * 2; }
    unsigned gcur[2][2], gnxt[2][2];
#define PG8_GIDX(dst, unit) do { if (GATHER) { _Pragma("unroll") for (int h_ = 0; h_ < 2; ++h_) _Pragma("unroll") for (int i_ = 0; i_ < 2; ++i_) \
        dst[h_][i_] = (unsigned)rowidx[(unit).pm * 256 + h_ * 128 + gR[i_]] * (unsigned)(K * 2) + (unsigned)gC[i_]; } } while (0)
    const size_t kstep = (size_t)(BK * 2);
    const size_t hstep = (size_t)HALF * K * 2;
    const unsigned ldsw = (unsigned)wid * 1024u;
    const int aoff = lds_byte(wr * 64 + fr, fq * 8), boff = lds_byte(wc * 32 + fr, fq * 8);
#define PG8_SA(b, h) (((b) * 2 + (h)) * HTB)
#define PG8_SB(b, h) ((4 + (b) * 2 + (h)) * HTB)
#define PG8_STAGE(bufoff, gbase, voff) do { _Pragma("unroll") for (int _i = 0; _i < 2; ++_i) \
        __builtin_amdgcn_global_load_lds((const unsigned*)((const char*)(gbase) + (voff)[_i]), (LAS unsigned*)(lds + (bufoff) + ldsw + _i * 8192), 16, 0, 0); } while (0)
#define PG8_STAGE_A(b, h, gbase, NX) do { if (GATHER) { unsigned go_[2]; go_[0] = (NX) ? gnxt[h][0] : gcur[h][0]; go_[1] = (NX) ? gnxt[h][1] : gcur[h][1]; PG8_STAGE(PG8_SA(b, h), (gbase), go_); } \
        else { PG8_STAGE(PG8_SA(b, h), (gbase) + (h) * hstep, voffA); } } while (0)
#define PG8_LDA(dst, b, h) do { _Pragma("unroll") for (int m = 0; m < 4; ++m) _Pragma("unroll") for (int k = 0; k < 2; ++k) dst[m][k] = *(const LAS bf16x8*)(lds + PG8_SA(b, h) + aoff + m * 2048 + k * 1024); } while (0)
#define PG8_LDB(dst, b, h) do { _Pragma("unroll") for (int n = 0; n < 2; ++n) _Pragma("unroll") for (int k = 0; k < 2; ++k) dst[n][k] = *(const LAS bf16x8*)(lds + PG8_SB(b, h) + boff + n * 2048 + k * 1024); } while (0)
#define PG8_MMA(ai, bj, At, Bt) do { __builtin_amdgcn_s_setprio(1); _Pragma("unroll") for (int m = 0; m < 4; ++m) _Pragma("unroll") for (int n = 0; n < 2; ++n) _Pragma("unroll") for (int k = 0; k < 2; ++k) \
        acc[ai][bj][m][n] = __builtin_amdgcn_mfma_f32_16x16x32_bf16(Bt[n][k], At[m][k], acc[ai][bj][m][n], 0, 0, 0); __builtin_amdgcn_s_setprio(0); } while (0)
#define PG8_WAIT_V(n) asm volatile("s_waitcnt vmcnt(" #n ")" ::: "memory")
#define PG8_WAIT_L(n) asm volatile("s_waitcnt lgkmcnt(" #n ")" ::: "memory")
#define PG8_BAR __builtin_amdgcn_s_barrier()
#define PG8_SCHED __builtin_amdgcn_sched_barrier(0)
    Unit cur, nxt; int ui = 0;
    if (!S.next(0, cur)) return;
    f32x4 acc[2][2][4][2];
#pragma unroll
    for (int a = 0; a < 2; ++a)
#pragma unroll
        for (int b = 0; b < 2; ++b)
#pragma unroll
            for (int m = 0; m < 4; ++m)
#pragma unroll
                for (int n = 0; n < 2; ++n) acc[a][b][m][n] = (f32x4){0.f, 0.f, 0.f, 0.f};
    bf16x8 At[4][2], B0[2][2], B1[2][2];
    const char* cA = GATHER ? S.A : cur.A; const char* cB = cur.B;
    PG8_GIDX(gcur, cur);
    PG8_STAGE(PG8_SB(0, 0), cB, voffB); PG8_STAGE(PG8_SB(0, 1), cB + hstep, voffB); PG8_STAGE_A(0, 0, cA, false); PG8_STAGE_A(0, 1, cA, false);
    if (wr == 1) PG8_BAR;
    PG8_WAIT_V(2); PG8_BAR;
    PG8_STAGE(PG8_SB(1, 0), cB + kstep, voffB); PG8_STAGE_A(1, 0, cA + kstep, false); PG8_STAGE(PG8_SB(1, 1), cB + hstep + kstep, voffB);
    PG8_WAIT_V(6); PG8_BAR;
    for (;;) {
        const bool has_next = S.next(ui + 1, nxt);
        const char* nA = (has_next && !GATHER) ? nxt.A : cA; const char* nB = has_next ? nxt.B : cB;
        if (GATHER) { if (has_next) { PG8_GIDX(gnxt, nxt); } else { _Pragma("unroll") for (int h_ = 0; h_ < 2; ++h_) { gnxt[h_][0] = gcur[h_][0]; gnxt[h_][1] = gcur[h_][1]; } } }
        for (int t = 0; t < nt; t += 2) {
            const bool last = (t == nt - 2);
            const char* a1 = cA + (size_t)(t + 1) * kstep;
            const char* a2 = last ? nA : cA + (size_t)(t + 2) * kstep; const char* b2 = last ? nB : cB + (size_t)(t + 2) * kstep;
            const char* a3 = a2 + kstep; const char* b3 = b2 + kstep;
            PG8_LDB(B0, 0, 0); PG8_LDB(B1, 0, 1); PG8_SCHED; PG8_LDA(At, 0, 0); PG8_STAGE_A(1, 1, a1, false);
            PG8_WAIT_V(8); PG8_WAIT_L(0); PG8_BAR; PG8_MMA(0, 0, At, B0); PG8_MMA(0, 1, At, B1); PG8_BAR; PG8_SCHED;
            PG8_LDA(At, 0, 1); PG8_STAGE(PG8_SB(0, 0), b2, voffB); PG8_STAGE(PG8_SB(0, 1), b2 + hstep, voffB); PG8_STAGE_A(0, 0, a2, last);
            PG8_WAIT_V(8); PG8_WAIT_L(0); PG8_BAR; PG8_MMA(1, 0, At, B0); PG8_MMA(1, 1, At, B1); PG8_BAR; PG8_SCHED;
            PG8_LDB(B0, 1, 0); PG8_LDB(B1, 1, 1); PG8_SCHED; PG8_LDA(At, 1, 0); PG8_STAGE_A(0, 1, a2, last);
            PG8_WAIT_V(8); PG8_WAIT_L(0); PG8_BAR; PG8_MMA(0, 0, At, B0); PG8_MMA(0, 1, At, B1); PG8_BAR; PG8_SCHED;
            PG8_LDA(At, 1, 1); PG8_STAGE(PG8_SB(1, 0), b3, voffB); PG8_STAGE(PG8_SB(1, 1), b3 + hstep, voffB); PG8_STAGE_A(1, 0, a3, last);
            PG8_WAIT_V(8); PG8_WAIT_L(0); PG8_BAR; PG8_MMA(1, 0, At, B0); PG8_MMA(1, 1, At, B1); PG8_BAR; PG8_SCHED;
        }
        if (wr == 0) PG8_BAR;
        E(acc, cur, wr, wc, fr, fq);
        if (!has_next) break;
#pragma unroll
        for (int a = 0; a < 2; ++a)
#pragma unroll
            for (int b = 0; b < 2; ++b)
#pragma unroll
                for (int m = 0; m < 4; ++m)
#pragma unroll
                    for (int n = 0; n < 2; ++n) acc[a][b][m][n] = (f32x4){0.f, 0.f, 0.f, 0.f};
        cur = nxt; cA = nA; cB = nB; ++ui;
        if (GATHER) { _Pragma("unroll") for (int h_ = 0; h_ < 2; ++h_) { gcur[h_][0] = gnxt[h_][0]; gcur[h_][1] = gnxt[h_][1]; } }
        if (wr == 1) PG8_BAR;
    }
    PG8_WAIT_V(0);
    PG8_BAR;
#undef PG8_SA
#undef PG8_SB
#undef PG8_STAGE
#undef PG8_STAGE_A
#undef PG8_GIDX
#undef PG8_LDA
#undef PG8_LDB
#undef PG8_MMA
#undef PG8_WAIT_V
#undef PG8_WAIT_L
#undef PG8_BAR
#undef PG8_SCHED
}
}
namespace attn_body {
constexpr int NW = 8, QBLK = 32, QB = QBLK * NW, KVBLK = 64;
__device__ __forceinline__ int crow(int r, int hi) { return (r & 3) + 8 * (r >> 2) + 4 * hi; }
#define SBAR() __builtin_amdgcn_sched_barrier(0)
constexpr int NSLOT = 3, SLOTB = 8192;
constexpr int LDS_K = 0, LDS_V = NSLOT * SLOTB, LDS_WS = 2 * NSLOT * SLOTB, LDS_OST = LDS_WS + NW * 64 * 4, LDS_BYTES = LDS_OST + NW * 4096;
constexpr float C2 = 0.125f * 1.4426950408889634f;
__device__ __forceinline__ void glds16(const void* gsrc, unsigned lds_dst) { unsigned keep;
  asm volatile("s_mov_b32 %0, m0\n\ts_mov_b32 m0, %2\n\ts_nop 0\n\tglobal_load_lds_dwordx4 %1, off\n\ts_mov_b32 m0, %0" : "=&s"(keep) : "v"(gsrc), "s"(lds_dst) : "memory"); }
__device__ __forceinline__ float max3f(float a, float b, float c) { float r; asm("v_max3_f32 %0, %1, %2, %3" : "=v"(r) : "v"(a), "v"(b), "v"(c)); return r; }
__device__ __forceinline__ float max2f(float a, float b) { float r; asm("v_max_f32_e32 %0, %1, %2" : "=v"(r) : "v"(a), "v"(b)); return r; }
__device__ __forceinline__ float fadd_s(float a, float b) { float r; asm("v_add_f32_e32 %0, %1, %2" : "=v"(r) : "v"(a), "v"(b)); return r; }
__device__ __forceinline__ float fsub_s(float a, float b) { float r; asm("v_sub_f32_e32 %0, %1, %2" : "=v"(r) : "v"(a), "v"(b)); return r; }
__device__ __forceinline__ unsigned cvtpk_s(float lo, float hi) { f32x2 v = {lo, hi}; bf16x2_t b = __builtin_convertvector(v, bf16x2_t); return __builtin_bit_cast(unsigned, b); }
#define WAIT_BAR(N) asm volatile("s_waitcnt vmcnt(" #N ") lgkmcnt(0)\n\ts_barrier" ::: "memory")

__device__ __forceinline__ void qkt(f32x16& p0, f32x16& p1, const char* Kslot, const bf16x8* qr, const f32x16& negm, int r32, int hi) {
  const char* kb = Kslot + hi * 1024 + r32 * 16;
  #pragma unroll
  for (int d0 = 0; d0 < 4; ++d0) {
    const bf16x8 b0 = *reinterpret_cast<const bf16x8*>(kb + d0 * 2048);
    const bf16x8 b1 = *reinterpret_cast<const bf16x8*>(kb + d0 * 2048 + 512);
    if (d0 == 0) { p0 = __builtin_amdgcn_mfma_f32_32x32x16_bf16(b0, qr[0], negm, 0, 0, 0); p1 = __builtin_amdgcn_mfma_f32_32x32x16_bf16(b1, qr[0], negm, 0, 0, 0); }
    else { p0 = __builtin_amdgcn_mfma_f32_32x32x16_bf16(b0, qr[d0], p0, 0, 0, 0); p1 = __builtin_amdgcn_mfma_f32_32x32x16_bf16(b1, qr[d0], p1, 0, 0, 0); } }
}
typedef __attribute__((address_space(3))) const char* lds_cptr;
typedef short v4i16_t __attribute__((ext_vector_type(4)));
__device__ __forceinline__ void kload8(bf16x8* kf, lds_cptr kp) {
  kf[0] = *(const LAS bf16x8*)(kp);        kf[1] = *(const LAS bf16x8*)(kp + 512);
  kf[2] = *(const LAS bf16x8*)(kp + 2048); kf[3] = *(const LAS bf16x8*)(kp + 2560);
  kf[4] = *(const LAS bf16x8*)(kp + 4096); kf[5] = *(const LAS bf16x8*)(kp + 4608);
  kf[6] = *(const LAS bf16x8*)(kp + 6144); kf[7] = *(const LAS bf16x8*)(kp + 6656);
}
__device__ __forceinline__ void kload2(bf16x8* kf, lds_cptr kp, int j) { kf[2 * j] = *(const LAS bf16x8*)(kp + j * 2048); kf[2 * j + 1] = *(const LAS bf16x8*)(kp + j * 2048 + 512); }
__device__ __forceinline__ s16x4 vtr(lds_cptr p) { return __builtin_bit_cast(s16x4, __builtin_amdgcn_ds_read_tr16_b64_v4i16((LAS v4i16_t*)p)); }
__device__ __forceinline__ float rowmax(const f32x16& p0, const f32x16& p1) {
  float a = max3f(p0[0], p0[1], p1[0]), b = max3f(p0[2], p0[3], p1[1]); a = max3f(a, p1[2], p1[3]);
  #pragma unroll
  for (int r = 4; r < 16; r += 4) { a = max3f(a, p0[r], p0[r + 1]); b = max3f(b, p0[r + 2], p0[r + 3]); a = max3f(a, p1[r], p1[r + 1]); b = max3f(b, p1[r + 2], p1[r + 3]); }
  const float m = max2f(a, b);
  auto rr = __builtin_amdgcn_permlane32_swap(__float_as_uint(m), __float_as_uint(m), false, false);
  return max2f(__uint_as_float(rr[0]), __uint_as_float(rr[1]));
}
__device__ __forceinline__ void pv(f32x16* o, int vb, bf16x8 pa0, bf16x8 pa1, bf16x8 pa2, bf16x8 pa3) {
  #pragma unroll
  for (int d0 = 0; d0 < 2; ++d0) { s16x4 lo[4], hi[4];
    #pragma unroll
    for (int ks = 0; ks < 4; ++ks) {
      asm volatile("ds_read_b64_tr_b16 %0,%1 offset:%c2" : "=&v"(lo[ks]) : "v"(vb), "i"(d0 * 4096 + ks * 1024) : "memory");
      asm volatile("ds_read_b64_tr_b16 %0,%1 offset:%c2" : "=&v"(hi[ks]) : "v"(vb), "i"(d0 * 4096 + ks * 1024 + 512) : "memory"); }
    asm volatile("s_waitcnt lgkmcnt(0)" ::: "memory"); SBAR();
    #define PK(k) (bf16x8){lo[k][0], lo[k][1], lo[k][2], lo[k][3], hi[k][0], hi[k][1], hi[k][2], hi[k][3]}
    o[d0] = __builtin_amdgcn_mfma_f32_32x32x16_bf16(pa0, PK(0), o[d0], 0, 0, 0);
    o[d0] = __builtin_amdgcn_mfma_f32_32x32x16_bf16(pa1, PK(1), o[d0], 0, 0, 0);
    o[d0] = __builtin_amdgcn_mfma_f32_32x32x16_bf16(pa2, PK(2), o[d0], 0, 0, 0);
    o[d0] = __builtin_amdgcn_mfma_f32_32x32x16_bf16(pa3, PK(3), o[d0], 0, 0, 0);
    #undef PK
  }
}

template <int THRL> __device__ __forceinline__ void attn_unit(const bf16_t* Qrow0, int QP, const bf16_t* __restrict__ Kh, const bf16_t* __restrict__ Vh, int KVP, int NT, bf16_t* Orow0, int OP, char* shm, const int tid) {
  const int lane = tid & 63, r32 = lane & 31, hi = lane >> 5; const int wid = __builtin_amdgcn_readfirstlane(tid >> 6);
  const bf16_t* Qw = Qrow0 + (long)(wid * QBLK) * QP;
  const unsigned lds0 = (unsigned)(uintptr_t)shm;
  float* wsf = (float*)(shm + LDS_WS) + wid * 64;
  const bf16_t* ksrc = Kh + (long)lane * KVP + wid * 8;
  const bf16_t* vsrc = Vh + (long)(16 * (wid & 3) + (lane >> 2)) * KVP + (wid >> 2) * 32 + (lane & 3) * 8;
  const unsigned kdst = lds0 + LDS_K + wid * 1024, vdst = lds0 + LDS_V + wid * 1024;
  #define DMA_K(t, slot) glds16(ksrc + (long)(t) * KVBLK * KVP, (unsigned)__builtin_amdgcn_readfirstlane(kdst + (slot)))
  #define DMA_V(t, slot) glds16(vsrc + (long)(t) * KVBLK * KVP, (unsigned)__builtin_amdgcn_readfirstlane(vdst + (slot)))
  const int vb0 = (int)(lds0 + LDS_V) + ((lane >> 4) & 1) * 32 + (lane & 3) * 8 + (4 * hi + ((lane & 15) >> 2)) * 64;
  const char* Kbase = shm + LDS_K; bf16x8 kf[8];
  const lds_cptr shm3 = (lds_cptr)shm; const lds_cptr kp0 = shm3 + LDS_K + hi * 1024 + r32 * 16; const lds_cptr vp0 = shm3 + LDS_V + ((lane >> 4) & 1) * 32 + (lane & 3) * 8 + (4 * hi + ((lane & 15) >> 2)) * 64;
  DMA_K(0, 0); DMA_V(0, 0); DMA_K(1, SLOTB);
  bf16x8 qr[4];
  #pragma unroll
  for (int d0 = 0; d0 < 4; ++d0) qr[d0] = *reinterpret_cast<const bf16x8*>(&Qw[(long)r32 * QP + d0 * 16 + hi * 8]);
  float mhat = 0.f, l_reg = 0.f; f32x16 o[2]; o[0] = f32x16{}; o[1] = f32x16{}; f32x16 negm = f32x16{}; asm volatile("" : "+v"(negm));
  bool resc = false;
  #define START(P0, P1) do { const float rm = rowmax(P0, P1); resc = false; \
    { const float dl = rm; mhat = fadd_s(mhat, dl); \
      _Pragma("unroll") for (int r = 0; r < 16; ++r) { P0[r] = fsub_s(P0[r], dl); P1[r] = fsub_s(P1[r], dl); } \
      _Pragma("unroll") for (int r = 0; r < 16; ++r) negm[r] = -mhat; asm volatile("" : "+v"(negm)); } \
    _Pragma("unroll") for (int r = 0; r < 16; ++r) P0[r] = __builtin_amdgcn_exp2f(P0[r]); } while (0)
  #define RESC() do { if (resc) { asm volatile("s_waitcnt lgkmcnt(0)" ::: "memory"); \
      _Pragma("unroll") for (int d_ = 0; d_ < 2; ++d_) _Pragma("unroll") for (int r = 0; r < 16; ++r) o[d_][r] *= wsf[crow(r, hi)]; } } while (0)
  f32x16 pA0, pA1, pB0, pB1;
  int sl_prev = 0, sl_cur = 0, sl_next = SLOTB;
  #define ROT() do { sl_prev = sl_cur; sl_cur = sl_next; sl_next = (sl_next == (NSLOT - 1) * SLOTB) ? 0 : sl_next + SLOTB; } while (0)
  DMA_K(2, 2 * SLOTB);
  WAIT_BAR(3);
  qkt(pA0, pA1, Kbase, qr, negm, r32, hi); asm volatile("s_nop 15\n\ts_nop 7" : "+v"(pA0), "+v"(pA1));
  START(pA0, pA1);
  _Pragma("unroll") for (int r = 0; r < 16; ++r) pA1[r] = __builtin_amdgcn_exp2f(pA1[r]);
  WAIT_BAR(0);
  DMA_K(3, 0); DMA_V(1, SLOTB);
  ROT();
  kload8(kf, kp0 + sl_cur);
  WAIT_BAR(2);
  s16x4 vlo[8], vhi[8]; u32x4 pw0, pw1, pw2, pw3;
  #define PKW(P, B) cvtpk_s(P[B], P[B + 1])
  #define PAF(k) __builtin_bit_cast(bf16x8, pw##k)
  #define VFR(i) (bf16x8){vlo[i][0], vlo[i][1], vlo[i][2], vlo[i][3], vhi[i][0], vhi[i][1], vhi[i][2], vhi[i][3]}
  #define PIN(x) asm volatile("" : "+v"(x))
  #define MX3(a, b, c) __builtin_fmaxf(__builtin_fmaxf((a), (b)), (c))
  #define GAPA(MF, A0, A1, A2, A3, W0, W1, PW) do { MF; sacc += A0; sacc += A1; sacc += A2; sacc += A3; PIN(sacc); W0; W1; PIN(PW); SBAR(); } while (0)
  #define EX(v) __builtin_amdgcn_exp2f(v)
  #define GAPB(MF, X, B) do { MF; X[B] = EX(X[B]); X[B + 1] = EX(X[B + 1]); X[B + 2] = EX(X[B + 2]); X[B + 3] = EX(X[B + 3]); PIN(X); SBAR(); } while (0)
  #define VRD(i) do { vlo[i] = vtr(vp_ + (((i) >> 2) * 4096 + ((i) & 3) * 1024)); vhi[i] = vtr(vp_ + (((i) >> 2) * 4096 + ((i) & 3) * 1024 + 512)); } while (0)
  #define KRD(G, j) do { if (G) { kload2(kf, kp0 + sl_next, j); SBAR(); } } while (0)
  #define STEP(C0, C1, P0, P1, t, GK, GV, GL) do { SBAR(); \
    const lds_cptr vp_ = vp0 + sl_prev; \
    VRD(0); SBAR(); float sacc = (P0[0] + P0[1]); \
    GAPA(C0 = __builtin_amdgcn_mfma_f32_32x32x16_bf16(kf[0], qr[0], negm, 0, 0, 0), P0[2], P0[3], P0[4], P0[5],     pw0[0] = PKW(P0, 0), pw0[1] = PKW(P0, 2), pw0); \
    VRD(4); SBAR(); GAPA(C1 = __builtin_amdgcn_mfma_f32_32x32x16_bf16(kf[1], qr[0], negm, 0, 0, 0), P0[6], P0[7], P0[8], P0[9],     pw0[2] = PKW(P0, 4), pw0[3] = PKW(P0, 6), pw0); \
    VRD(1); SBAR(); GAPA(C0 = __builtin_amdgcn_mfma_f32_32x32x16_bf16(kf[2], qr[1], C0, 0, 0, 0),   P0[10], P0[11], P0[12], P0[13], pw1[0] = PKW(P0, 8), pw1[1] = PKW(P0, 10), pw1); \
    VRD(5); SBAR(); GAPA(C1 = __builtin_amdgcn_mfma_f32_32x32x16_bf16(kf[3], qr[1], C1, 0, 0, 0),   P0[14], P0[15], P1[0], P1[1],   pw1[2] = PKW(P0, 12), pw1[3] = PKW(P0, 14), pw1); \
    VRD(2); SBAR(); GAPA(C0 = __builtin_amdgcn_mfma_f32_32x32x16_bf16(kf[4], qr[2], C0, 0, 0, 0),   P1[2], P1[3], P1[4], P1[5],     pw2[0] = PKW(P1, 0), pw2[1] = PKW(P1, 2), pw2); \
    VRD(6); SBAR(); GAPA(C1 = __builtin_amdgcn_mfma_f32_32x32x16_bf16(kf[5], qr[2], C1, 0, 0, 0),   P1[6], P1[7], P1[8], P1[9],     pw2[2] = PKW(P1, 4), pw2[3] = PKW(P1, 6), pw2); \
    VRD(3); SBAR(); GAPA(C0 = __builtin_amdgcn_mfma_f32_32x32x16_bf16(kf[6], qr[3], C0, 0, 0, 0),   P1[10], P1[11], P1[12], P1[13], pw3[0] = PKW(P1, 8), pw3[1] = PKW(P1, 10), pw3); \
    VRD(7); SBAR(); GAPA(C1 = __builtin_amdgcn_mfma_f32_32x32x16_bf16(kf[7], qr[3], C1, 0, 0, 0),   P1[14], P1[15], 0.f, 0.f,       pw3[2] = PKW(P1, 12), pw3[3] = PKW(P1, 14), pw3); \
    l_reg += sacc; \
    if (GK) { DMA_K((t) + 3, sl_cur); } if (GV) { DMA_V((t) + 1, sl_next); } \
    { float a = MX3(C0[0], C0[1], C1[0]), b = MX3(C0[2], C0[3], C1[1]); a = MX3(a, C1[2], C1[3]); \
      _Pragma("unroll") for (int r = 4; r < 16; r += 4) { a = MX3(a, C0[r], C0[r + 1]); b = MX3(b, C0[r + 2], C0[r + 3]); a = MX3(a, C1[r], C1[r + 1]); b = MX3(b, C1[r + 2], C1[r + 3]); } \
      float rm = __builtin_fmaxf(a, b); { auto rr = __builtin_amdgcn_permlane32_swap(__float_as_uint(rm), __float_as_uint(rm), false, false); rm = __builtin_fmaxf(__uint_as_float(rr[0]), __uint_as_float(rr[1])); } \
      resc = false; \
      if (__builtin_expect(__any(rm > (float)THRL), 0)) { const float dl = __builtin_fmaxf(rm, 0.f); mhat += dl; \
        _Pragma("unroll") for (int r = 0; r < 16; ++r) { C0[r] -= dl; C1[r] -= dl; } \
        _Pragma("unroll") for (int r = 0; r < 16; ++r) negm[r] = -mhat; asm volatile("" : "+v"(negm)); \
        const float f = __builtin_amdgcn_exp2f(-dl); l_reg *= f; if (hi == 0) wsf[r32] = f; resc = true; } } \
    SBAR(); \
    GAPB(o[0] = __builtin_amdgcn_mfma_f32_32x32x16_bf16(PAF(0), VFR(0), o[0], 0, 0, 0), C0, 0); \
    GAPB(o[1] = __builtin_amdgcn_mfma_f32_32x32x16_bf16(PAF(0), VFR(4), o[1], 0, 0, 0), C0, 4); \
    KRD(GL, 0); GAPB(o[0] = __builtin_amdgcn_mfma_f32_32x32x16_bf16(PAF(1), VFR(1), o[0], 0, 0, 0), C0, 8); \
    KRD(GL, 1); GAPB(o[1] = __builtin_amdgcn_mfma_f32_32x32x16_bf16(PAF(1), VFR(5), o[1], 0, 0, 0), C0, 12); \
    KRD(GL, 2); GAPB(o[0] = __builtin_amdgcn_mfma_f32_32x32x16_bf16(PAF(2), VFR(2), o[0], 0, 0, 0), C1, 0); \
    KRD(GL, 3); GAPB(o[1] = __builtin_amdgcn_mfma_f32_32x32x16_bf16(PAF(2), VFR(6), o[1], 0, 0, 0), C1, 4); \
    GAPB(o[0] = __builtin_amdgcn_mfma_f32_32x32x16_bf16(PAF(3), VFR(3), o[0], 0, 0, 0), C1, 8); \
    GAPB(o[1] = __builtin_amdgcn_mfma_f32_32x32x16_bf16(PAF(3), VFR(7), o[1], 0, 0, 0), C1, 12); \
    } while (0)
  int t = 1;
  for (; t + 5 < NT; t += 2) {
    STEP(pB0, pB1, pA0, pA1, t, true, true, true);     WAIT_BAR(2); RESC(); ROT();
    STEP(pA0, pA1, pB0, pB1, t + 1, true, true, true); WAIT_BAR(2); RESC(); ROT();
  }
  #define ENDW(tt) do { if ((tt) + 3 < NT) { WAIT_BAR(2); } else if ((tt) + 2 < NT) { WAIT_BAR(1); } else { WAIT_BAR(0); } } while (0)
  for (; t + 1 < NT; t += 2) {
    STEP(pB0, pB1, pA0, pA1, t, (t + 3 < NT), (t + 1 < NT), (t + 1 < NT));         ENDW(t);     RESC(); ROT();
    STEP(pA0, pA1, pB0, pB1, t + 1, (t + 4 < NT), (t + 2 < NT), (t + 2 < NT));     ENDW(t + 1); RESC(); ROT();
  }
  STEP(pB0, pB1, pA0, pA1, NT - 1, false, false, false); RESC();
  { float sacc = pB0[0] + pB0[1]; _Pragma("unroll") for (int r = 2; r < 16; ++r) sacc += pB0[r]; _Pragma("unroll") for (int r = 0; r < 16; ++r) sacc += pB1[r]; l_reg += sacc;
    pw0 = (u32x4){PKW(pB0, 0), PKW(pB0, 2), PKW(pB0, 4), PKW(pB0, 6)}; pw1 = (u32x4){PKW(pB0, 8), PKW(pB0, 10), PKW(pB0, 12), PKW(pB0, 14)}; pw2 = (u32x4){PKW(pB1, 0), PKW(pB1, 2), PKW(pB1, 4), PKW(pB1, 6)}; pw3 = (u32x4){PKW(pB1, 8), PKW(pB1, 10), PKW(pB1, 12), PKW(pB1, 14)};
    SBAR(); pv(o, vb0 + sl_cur, PAF(0), PAF(1), PAF(2), PAF(3)); }
  #undef PKW
  #undef PAF
  #undef VFR
  #undef PIN
  #undef MX3
  #undef GAPA
  #undef GAPB
  #undef EX
  #undef VRD
  #undef KRD
  #undef STEP
  #undef ENDW
  { auto rr = __builtin_amdgcn_permlane32_swap(__float_as_uint(l_reg), __float_as_uint(l_reg), false, false); l_reg = __uint_as_float(rr[0]) + __uint_as_float(rr[1]); }
  if (hi == 0) wsf[32 + r32] = l_reg; asm volatile("s_waitcnt lgkmcnt(0)" ::: "memory");
  float rli[16];
  #pragma unroll
  for (int r = 0; r < 16; ++r) rli[r] = __builtin_amdgcn_rcpf(wsf[32 + crow(r, hi)]);
  bf16_t* Ow = Orow0 + (long)(wid * QBLK) * OP;
  { bf16_t* stg = (bf16_t*)(shm + LDS_OST) + wid * 2048;
    #pragma unroll
    for (int r = 0; r < 16; ++r) { const int orow = crow(r, hi);
      #pragma unroll
      for (int d0 = 0; d0 < 2; ++d0) stg[orow * 64 + d0 * 32 + r32] = (bf16_t)f2bf(o[d0][r] * rli[r]); }
    asm volatile("s_waitcnt lgkmcnt(0)" ::: "memory");
    #pragma unroll
    for (int i = 0; i < 4; ++i) { const int row = i * 8 + (lane >> 3), ch = lane & 7; const u32x4 v = *(const u32x4*)(stg + row * 64 + ch * 8); *(u32x4*)(Ow + (long)row * OP + ch * 8) = v; } }
  asm volatile("s_waitcnt lgkmcnt(0)\n\ts_barrier" ::: "memory");
  #undef DMA_K
  #undef DMA_V
  #undef START
  #undef RESC
  #undef ROT
}
#undef SBAR
#undef WAIT_BAR
}
struct Frame {
    LAS unsigned char* lds;
    int tid, lane, wave;
    int vcu, G, gw, NGW, bid;
    unsigned char* ws; const float* const* in;
};

__device__ __forceinline__ void transpose_item(const float* W, int ldw, int K, bf16_t* WT, int k0, int n0, int dst_row0, LAS float* scr, int lane) {
    float tv[32];
#pragma unroll
    for (int i = 0; i < 32; ++i) tv[i] = W[(size_t)(k0 + 2 * i + (lane >> 5)) * ldw + n0 + (lane & 31)];
#pragma unroll
    for (int i = 0; i < 32; ++i) scr[(2 * i + (lane >> 5)) * 33 + (lane & 31)] = tv[i];
    LDS_WAIT(); asm volatile("" ::: "memory");
    const int c = lane & 7;
#pragma unroll
    for (int j = 0; j < 4; ++j) { const int n = (lane >> 3) + 8 * j; const LAS float* s = scr + (8 * c) * 33 + n;
        u32x4 o; o.x = pk2(s[0 * 33], s[1 * 33]); o.y = pk2(s[2 * 33], s[3 * 33]); o.z = pk2(s[4 * 33], s[5 * 33]); o.w = pk2(s[6 * 33], s[7 * 33]);
        *(u32x4*)(WT + (size_t)(dst_row0 + n) * K + k0 + 8 * c) = o; }
    LDS_WAIT(); asm volatile("" ::: "memory");
}

__device__ __forceinline__ void sincos_acc(float x, float& s, float& c) {
    const float k = rintf(x * 0.63661977236758134f);
    float r = fmaf(k, -1.5703125f, x); r = fmaf(k, -4.837512969970703125e-4f, r); r = fmaf(k, -7.54978995489188e-8f, r);
    const float z = r * r;
    const float sp = r + r * z * fmaf(z, fmaf(z, -1.9515295891e-4f, 8.3321608736e-3f), -1.6666654611e-1f);
    const float cp = fmaf(z * z, fmaf(z, fmaf(z, 2.443315711809948e-5f, -1.388731625493765e-3f), 4.166664568298827e-2f), fmaf(z, -0.5f, 1.0f));
    const int q = ((int)k) & 3;
    const float ss = (q & 1) ? cp : sp, cc = (q & 1) ? sp : cp;
    s = (q & 2) ? -ss : ss; c = ((q + 1) & 2) ? -cc : cc;
}

__device__ __forceinline__ void p0_prologue(Frame& F, const float* const* in, unsigned char* ws) {
    const float* c_lat = in[1]; const float* c_ctx = in[3]; const float* w_mod = in[4]; const float* b_mod = in[5];
    LAS float* sil = (LAS float*)F.lds;
    for (int i = F.tid; i < NMI * D; i += NTHREADS) { const int mi = i >> 10, k = i & 1023; const float v = (mi < NB) ? c_lat[mi * D + k] : c_ctx[k]; sil[i] = silu_f(v); }
    __syncthreads();
    {
        float* modv = (float*)(ws + WS_MODV);
        const int NT16 = 6 * D / 16;
        for (int task = F.gw; task < DEPTH * NT16; task += F.NGW) {
            const int layer = task / NT16, j0 = (task % NT16) * 16, jj = F.lane & 15, kq = F.lane >> 4;
            const float* wp = w_mod + (size_t)layer * D * 6 * D + j0 + jj;
            float acc[NMI];
#pragma unroll
            for (int m = 0; m < NMI; ++m) acc[m] = 0.f;
            for (int k = kq; k < D; k += 4) { const float w = wp[(size_t)k * 6 * D];
#pragma unroll
                for (int m = 0; m < NMI; ++m) acc[m] = fmaf(sil[m * D + k], w, acc[m]); }
#pragma unroll
            for (int m = 0; m < NMI; ++m) { float v = acc[m]; v += __shfl_xor(v, 16); v += __shfl_xor(v, 32); acc[m] = v; }
            if (kq == 0) { const float bb = b_mod[layer * 6 * D + j0 + jj];
#pragma unroll
                for (int m = 0; m < NMI; ++m) modv[((size_t)layer * NMI + m) * 6 * D + j0 + jj] = acc[m] + bb; }
        }
    }
    __syncthreads();
    {
        LAS float* scr = (LAS float*)(F.lds) + F.wave * (64 * 33);
        constexpr int I_MI = 16 * 96, I_MO = 16 * 32, I_AI = 16 * 48, I_AO = 16 * 32;
        constexpr int PER_J = I_MI + I_MO + I_AI + I_AO;
        for (int it = F.gw; it < 2 * PER_J; it += F.NGW) {
            const int j = it / PER_J; int r = it % PER_J;
            if (r < I_MI) { const int kb = r / 96, nb = r % 96; transpose_item(in[8] + (size_t)j * D * MW_IN, MW_IN, D, (bf16_t*)(ws + WS_WMI) + (size_t)j * 3072 * D, 64 * kb, 32 * nb, 32 * nb, scr, F.lane); continue; } r -= I_MI;
            if (r < I_MO) { const int kb = r / 32, nb = r % 32; transpose_item(in[11] + (size_t)j * D * D, D, D, (bf16_t*)(ws + WS_WMO) + (size_t)j * D * D, 64 * kb, 32 * nb, 32 * nb, scr, F.lane); continue; } r -= I_MO;
            if (r < I_AI) { const int kb = r / 48, nb = r % 48; transpose_item(in[12] + (size_t)j * D * 1536, 1536, D, (bf16_t*)(ws + WS_WAI) + (size_t)j * 1536 * D, 64 * kb, 32 * nb, 32 * nb, scr, F.lane); continue; } r -= I_AI;
            { const int kb = r / 32, nb = r % 32; transpose_item(in[15] + (size_t)j * D * D, D, D, (bf16_t*)(ws + WS_WAO) + (size_t)j * D * D, 64 * kb, 32 * nb, 32 * nb, scr, F.lane); }
        }
    }
    {
        float* rc = (float*)(ws + WS_ROPE); float* rs = rc + SEQ * 32;
        for (int i = F.bid * NTHREADS + F.tid; i < SEQ * 32; i += F.G * NTHREADS) {
            const int t = i >> 5, p = i & 31; const float pos = (p < 16) ? (float)(t >> 6) : (float)(t & 63);
            const float inv = exp2f(-(float)(p & 15) * (13.287712379549449f / 16.f));
            float s, c; sincos_acc(pos * inv, s, c); rc[i] = c; rs[i] = s; }
    }
    __syncthreads();
}

__device__ __forceinline__ void moe_weights(Frame& F, const float* wg, const float* wu, const float* wd, unsigned char* ws) {
    LAS float* T = (LAS float*)F.lds;
    const int lane = F.lane, w = F.wave;
    bf16_t* W1 = (bf16_t*)(ws + WS_W1); bf16_t* W2 = (bf16_t*)(ws + WS_W2);
    constexpr int NIT = NE * 3 * 16 * 4;
#define MW_SRC(it_) (((((it_) % 192) / 64) == 0 ? wg : ((((it_) % 192) / 64) == 1 ? wu : wd)) + (size_t)((it_) / 192) * D * D + (size_t)(64 * ((((it_) % 192) % 64) >> 2)) * D + 256 * ((((it_) % 192) % 64) & 3))
    f32x4 v[8];
    int it = F.vcu;
    if (it < NIT) { const float* src = MW_SRC(it);
#pragma unroll
        for (int i = 0; i < 8; ++i) v[i] = *(const f32x4*)(src + (size_t)(8 * w + i) * D + 4 * lane); }
    for (; it < NIT; it += F.G) {
        __syncthreads();
#pragma unroll
        for (int i = 0; i < 8; ++i) *(LAS f32x4*)(T + (8 * w + i) * 256 + ((4 * lane) ^ (8 * (w & 3)))) = v[i];
        if (it + F.G < NIT) { const float* src = MW_SRC(it + F.G);
#pragma unroll
            for (int i = 0; i < 8; ++i) v[i] = *(const f32x4*)(src + (size_t)(8 * w + i) * D + 4 * lane); }
        __syncthreads();
        const int e = it / 192, r = it % 192, which = r / 64, kb = (r % 64) >> 2, nq = (r % 64) & 3;
        const int nl = lane & 7, c = lane >> 3;
        bf16_t* base = (which == 2) ? (W2 + (size_t)e * D * D) : (W1 + (size_t)e * 2048 * D);
#pragma unroll
        for (int j = 0; j < 4; ++j) { const int n = 32 * w + 8 * j + nl; const LAS float* tp = T + (8 * c) * 256 + (n ^ (8 * (c & 3)));
            float t[8];
#pragma unroll
            for (int i = 0; i < 8; ++i) t[i] = tp[i * 256];
            u32x4 o; o.x = pk2(t[0], t[1]); o.y = pk2(t[2], t[3]); o.z = pk2(t[4], t[5]); o.w = pk2(t[6], t[7]);
            const int ng = 256 * nq + n; const int drow = (which == 2) ? ng : (256 * (ng >> 7) + (which == 1 ? 128 : 0) + (ng & 127));
            *(u32x4*)(base + (size_t)drow * D + 64 * kb + 8 * c) = o; }
    }
#undef MW_SRC
    __syncthreads();
}

__device__ __forceinline__ void load_w16(Frame& F, const float* W16, int ldw16) {
    LAS float* wl = (LAS float*)F.lds;
    for (int i = F.tid; i < D * 16; i += NTHREADS) { const int c = i >> 4, e = i & 15; const int l = (c & 255) >> 2, q = (c & 3) + 4 * (c >> 8);
        wl[(q * 64 + l) * 20 + e] = W16[(size_t)c * ldw16 + e]; }
    __syncthreads();
}
template <int MODE>
__device__ __forceinline__ void norm_core(LAS float* wl, const int lane, f32x4 (&v)[4], const int r, const f32x4 (&gv)[4], const float* shp, const float* scp, bf16_t* H, const float* bias16, float* out16) {
    float ss = 0.f;
#pragma unroll
    for (int j = 0; j < 4; ++j) ss += (v[j].x * v[j].x + v[j].y * v[j].y) + (v[j].z * v[j].z + v[j].w * v[j].w);
    const float rstd = rsqrtf(wave_sum(ss) * (1.f / D) + NORM_EPS);
    unsigned long long* o8 = (unsigned long long*)(H + (size_t)r * D) + lane;
#pragma unroll
    for (int j = 0; j < 4; ++j) { const f32x4 sh = *(const f32x4*)(shp + 4 * lane + 256 * j), sc = *(const f32x4*)(scp + 4 * lane + 256 * j);
        v[j] = (v[j] * rstd * gv[j]) * (sc + 1.f) + sh;
        o8[64 * j] = (unsigned long long)pk2(v[j].x, v[j].y) | ((unsigned long long)pk2(v[j].z, v[j].w) << 32); }
    if (MODE != 0) {
        float p[16];
#pragma unroll
        for (int e = 0; e < 16; ++e) p[e] = 0.f;
#pragma unroll
        for (int j = 0; j < 4; ++j)
#pragma unroll
            for (int i = 0; i < 4; ++i) { const LAS f32x4* wp = (const LAS f32x4*)(wl + ((4 * j + i) * 64 + lane) * 20); const float xv = v[j][i];
#pragma unroll
                for (int e4 = 0; e4 < 4; ++e4) { const f32x4 w = wp[e4]; p[4 * e4 + 0] = fmaf(xv, w.x, p[4 * e4 + 0]); p[4 * e4 + 1] = fmaf(xv, w.y, p[4 * e4 + 1]); p[4 * e4 + 2] = fmaf(xv, w.z, p[4 * e4 + 2]); p[4 * e4 + 3] = fmaf(xv, w.w, p[4 * e4 + 3]); } }
        float q8[8], q4[4], q2[2], q1;
        { const bool up = (lane & 32) != 0;
#pragma unroll
          for (int i = 0; i < 8; ++i) { const float send = up ? p[i] : p[i + 8]; const float recv = __shfl_xor(send, 32); q8[i] = (up ? p[i + 8] : p[i]) + recv; } }
        { const bool up = (lane & 16) != 0;
#pragma unroll
          for (int i = 0; i < 4; ++i) { const float send = up ? q8[i] : q8[i + 4]; const float recv = __shfl_xor(send, 16); q4[i] = (up ? q8[i + 4] : q8[i]) + recv; } }
        { const bool up = (lane & 8) != 0;
#pragma unroll
          for (int i = 0; i < 2; ++i) { const float send = up ? q4[i] : q4[i + 2]; const float recv = __shfl_xor(send, 8); q2[i] = (up ? q4[i + 2] : q4[i]) + recv; } }
        { const bool up = (lane & 4) != 0; const float send = up ? q2[0] : q2[1]; const float recv = __shfl_xor(send, 4); q1 = (up ? q2[1] : q2[0]) + recv; }
        q1 = quad_sum(q1);
        const int e = ((lane >> 5) & 1) * 8 + ((lane >> 4) & 1) * 4 + ((lane >> 3) & 1) * 2 + ((lane >> 2) & 1);
        if (MODE == 1) {
            float g = q1 + bias16[e];
            g = 15.f * tanhf(g * (1.f / 15.f));
            const int gate = e >> 2;
            if (gate & 1) g = fminf(g, 0.f) - log1pf(__expf(-fabsf(g)));
            if ((lane & 3) == 0) out16[(size_t)r * 16 + e] = g;
        } else {
            float mx = q1;
#pragma unroll
            for (int o = 4; o < 64; o <<= 1) mx = fmaxf(mx, __shfl_xor(mx, o));
            const float ex = __expf(q1 - mx); float sm = ex;
#pragma unroll
            for (int o = 4; o < 64; o <<= 1) sm += __shfl_xor(sm, o);
            if ((lane & 3) == 0) out16[(size_t)e * RT + r] = ex / sm;
        }
    }
}
template <int MODE>
__device__ __forceinline__ void norm_pass(Frame& F, const float* xL, const float* xC, int nrows, const float* gain, const float* shiftv, const float* scalev  ,
                                          bf16_t* H, const float* W16, int ldw16, const float* bias16, float* out16) {
    LAS float* wl = (LAS float*)F.lds;
    if (MODE != 0) load_w16(F, W16, ldw16);
    const int lane = F.lane;
    f32x4 gv[4];
#pragma unroll
    for (int j = 0; j < 4; ++j) gv[j] = *(const f32x4*)(gain + 4 * lane + 256 * j);
    const int per = (nrows + F.NGW - 1) / F.NGW; const int r0 = F.gw * per, r1 = (r0 + per < nrows) ? r0 + per : nrows;
    f32x4 vn[4];
    if (r0 < r1) { const float* xr = (r0 >= RL) ? (xC + (size_t)(r0 - RL) * D) : (xL + (size_t)r0 * D);
#pragma unroll
        for (int j = 0; j < 4; ++j) vn[j] = *(const f32x4*)(xr + 4 * lane + 256 * j); }
    for (int r = r0; r < r1; ++r) {
        asm volatile("" ::: "memory");
        f32x4 v[4];
#pragma unroll
        for (int j = 0; j < 4; ++j) v[j] = vn[j];
        if (r + 1 < r1) { const int rn = r + 1; const float* xr = (rn >= RL) ? (xC + (size_t)(rn - RL) * D) : (xL + (size_t)rn * D);
#pragma unroll
            for (int j = 0; j < 4; ++j) vn[j] = *(const f32x4*)(xr + 4 * lane + 256 * j); }
        const int mi = (r >= RL) ? NB : (r >> 12);
        norm_core<MODE>(wl, lane, v, r, gv, shiftv + (size_t)mi * 6 * D, scalev + (size_t)mi * 6 * D, H, bias16, out16);
    }
    if (MODE != 0) __syncthreads();
}

__device__ __forceinline__ void moe_select(Frame& F, const float* AFF, int* INV, int* SLROW, float* SLG, int nunits) {
    LAS unsigned* keys = (LAS unsigned*)F.lds;
    LAS unsigned* wsum = (LAS unsigned*)(F.lds + 16384);
    const int tid = F.tid, lane = F.lane, wave = F.wave;
    for (int u = F.vcu; u < nunits; u += F.G) {
        const int set = u >> 4, e = u & 15; const bool isc = set >= NB; const int b = isc ? set - NB : set;
        const int N = isc ? CTXL : SEQ, k = isc ? CAP_C : CAP_L, PER = isc ? 1 : 8;
        const int row0 = isc ? RL + b * CTXL : b * SEQ;
        const int nmine = (tid * PER < N) ? PER : 0;
        unsigned kv[8];
        if (tid < 32) wsum[tid] = 0u;
#pragma unroll
        for (int i = 0; i < 8; ++i) { kv[i] = 0u; if (i < nmine) kv[i] = __float_as_uint(AFF[(size_t)e * RT + row0 + tid * PER + i]); }
        __syncthreads();
        unsigned T = 0u; { unsigned kk = (unsigned)k;
        for (int pass = 0; pass < 8; ++pass) {
            const int shift = 28 - 4 * pass; LAS unsigned* hist = wsum + (pass & 1) * 16;
            if (tid < 16) wsum[((pass + 1) & 1) * 16 + tid] = 0u;
#pragma unroll
            for (int i = 0; i < 8; ++i) if (i < nmine && (pass == 0 || (kv[i] >> (shift + 4)) == (T >> (shift + 4)))) (void)__hip_atomic_fetch_add(&hist[(kv[i] >> shift) & 15u], 1u, __ATOMIC_RELAXED, __HIP_MEMORY_SCOPE_WORKGROUP);
            __syncthreads();
            unsigned cum = 0u, digit = 0u; bool found = false;
#pragma unroll
            for (int d = 15; d >= 0; --d) { const unsigned c = hist[d]; if (!found) { if (cum + c >= kk) { digit = (unsigned)d; found = true; } else cum += c; } }
            kk -= cum; T |= digit << shift;
            __syncthreads();
        } }
        unsigned ngt = 0u, neq = 0u;
#pragma unroll
        for (int i = 0; i < 8; ++i) { if (i < nmine) { ngt += kv[i] > T ? 1u : 0u; neq += kv[i] == T ? 1u : 0u; } }
        unsigned sgt = ngt, seq = neq;
#pragma unroll
        for (int o = 1; o < 64; o <<= 1) { const unsigned a = __shfl_up(sgt, o), c2 = __shfl_up(seq, o); if (lane >= o) { sgt += a; seq += c2; } }
        LAS unsigned* sc = wsum + 32;
        __syncthreads();
        if (lane == 63) { sc[wave] = sgt; sc[8 + wave] = seq; }
        __syncthreads();
        unsigned bgt = 0u, beq = 0u, tgt = 0u;
#pragma unroll
        for (int w = 0; w < 8; ++w) { const unsigned a = sc[w], c2 = sc[8 + w]; if (w < wave) { bgt += a; beq += c2; } tgt += a; }
        const unsigned need = (unsigned)k - tgt;
        unsigned pgt = bgt + sgt - ngt, peq = beq + seq - neq;
        const int sbase = isc ? NB * CAP_L + b * CAP_C : b * CAP_L;
#pragma unroll
        for (int i = 0; i < 8; ++i) { if (i < nmine) {
            const int row = row0 + tid * PER + i; int slot = -1;
            if (kv[i] > T) { slot = (int)(pgt + (peq < need ? peq : need)); ++pgt; }
            else if (kv[i] == T) { if (peq < need) slot = (int)(pgt + peq); ++peq; }
            if (slot >= 0) { SLROW[e * SLOTS_E + sbase + slot] = row; SLG[e * SLOTS_E + sbase + slot] = __uint_as_float(kv[i]); }
            INV[(size_t)e * RT + row] = slot >= 0 ? sbase + slot : -1; } }
        __syncthreads();
    }
    (void)keys;
}

__device__ __forceinline__ void moe_gather(Frame& F, const bf16_t* H, const int* SLROW, bf16_t* XG, bool with_ctx) {
    const int per_e = with_ctx ? SLOTS_E : NB * CAP_L; const int total = NE * per_e;
    const int per = (total + F.NGW - 1) / F.NGW; const int i0 = F.gw * per, i1 = (i0 + per < total) ? i0 + per : total;
    for (int i = i0; i < i1; i += 4) {
        u32x4 a[4], b2[4]; size_t dsto[4];
#pragma unroll
        for (int q = 0; q < 4; ++q) { const int ii = (i + q < i1) ? i + q : i1 - 1; const int e = ii / per_e, sl = ii - e * per_e; const int row = SLROW[e * SLOTS_E + sl];
            const u32x4* src = (const u32x4*)(H + (size_t)row * D) + F.lane; a[q] = src[0]; b2[q] = src[64]; dsto[q] = ((size_t)e * SLOTS_E + sl) * D; }
#pragma unroll
        for (int q = 0; q < 4; ++q) { u32x4* dst = (u32x4*)(XG + dsto[q]) + F.lane; dst[0] = a[q]; dst[64] = b2[q]; }
    }
}

template <int MODE>
__device__ __forceinline__ void combine_norm(Frame& F, const bf16_t* Y, const int* INV, float* xL, float* xC, const float* g2v  , int nrows,
                                             const float* gain, const float* shiftv, const float* scalev, bf16_t* H, const float* W16, int ldw16, const float* bias16, float* out16) {
    LAS float* wl = (LAS float*)F.lds;
    if (MODE == 1) load_w16(F, W16, ldw16);
    const int lane = F.lane;
    f32x4 gv[4];
#pragma unroll
    for (int j = 0; j < 4; ++j) gv[j] = *(const f32x4*)(gain + 4 * lane + 256 * j);
    const int per = (nrows + F.NGW - 1) / F.NGW; const int r0 = F.gw * per, r1 = (r0 + per < nrows) ? r0 + per : nrows;
#define CN_XPTR(rr) (((rr) >= RL) ? (xC + (size_t)((rr) - RL) * D) : (xL + (size_t)(rr) * D))
#define CN_INV(rr) (((rr) < r1 && lane < 16) ? INV[(size_t)lane * RT + (rr)] : -1)
#define CN_YLOAD(dst, e_, s_) do { const u32x2* yp_ = (const u32x2*)(Y + ((size_t)(e_) * SLOTS_E + (s_)) * D) + lane; _Pragma("unroll") for (int j = 0; j < 4; ++j) dst[j] = yp_[64 * j]; } while (0)
#define CN_YACC(src) do { _Pragma("unroll") for (int j = 0; j < 4; ++j) { a[j].x += bf_lo(src[j].x); a[j].y += bf_hi(src[j].x); a[j].z += bf_lo(src[j].y); a[j].w += bf_hi(src[j].y); } } while (0)
    f32x4 vn[4]; u32x2 pn0[4], pn1[4];
    int invA = CN_INV(r0), invB = CN_INV(r0 + 1);
#pragma unroll
    for (int j = 0; j < 4; ++j) { vn[j] = (f32x4){0.f, 0.f, 0.f, 0.f}; pn0[j] = (u32x2){0u, 0u}; pn1[j] = (u32x2){0u, 0u}; }
    if (r0 < r1) { const float* xr = CN_XPTR(r0);
#pragma unroll
        for (int j = 0; j < 4; ++j) vn[j] = *(const f32x4*)(xr + 4 * lane + 256 * j);
        unsigned long long m = __ballot(invA >= 0);
        if (m) { const int e0 = __builtin_ctzll(m); m &= m - 1; CN_YLOAD(pn0, e0, __builtin_amdgcn_readlane(invA, e0)); if (m) { const int e1 = __builtin_ctzll(m); CN_YLOAD(pn1, e1, __builtin_amdgcn_readlane(invA, e1)); } } }
    for (int r = r0; r < r1; ++r) {
        asm volatile("" ::: "memory");
        f32x4 v[4]; u32x2 pc0[4], pc1[4];
#pragma unroll
        for (int j = 0; j < 4; ++j) { v[j] = vn[j]; pc0[j] = pn0[j]; pc1[j] = pn1[j]; }
        const int invC = CN_INV(r + 2);
        if (r + 1 < r1) { const float* xr = CN_XPTR(r + 1);
#pragma unroll
            for (int j = 0; j < 4; ++j) vn[j] = *(const f32x4*)(xr + 4 * lane + 256 * j);
            unsigned long long m = __ballot(invB >= 0);
            if (m) { const int e0 = __builtin_ctzll(m); m &= m - 1; CN_YLOAD(pn0, e0, __builtin_amdgcn_readlane(invB, e0)); if (m) { const int e1 = __builtin_ctzll(m); CN_YLOAD(pn1, e1, __builtin_amdgcn_readlane(invB, e1)); } } }
        f32x4 a[4];
#pragma unroll
        for (int j = 0; j < 4; ++j) a[j] = (f32x4){0.f, 0.f, 0.f, 0.f};
        { unsigned long long m = __ballot(invA >= 0);
          if (m) { m &= m - 1; CN_YACC(pc0);
            if (m) { m &= m - 1; CN_YACC(pc1);
              while (m) { const int e2 = __builtin_ctzll(m); m &= m - 1; u32x2 t2[4]; CN_YLOAD(t2, e2, __builtin_amdgcn_readlane(invA, e2)); CN_YACC(t2); } } } }
        const int mi = (r >= RL) ? NB : (r >> 12);
        const float* gp = g2v + (size_t)mi * 6 * D;
#pragma unroll
        for (int j = 0; j < 4; ++j) { const f32x4 g = *(const f32x4*)(gp + 4 * lane + 256 * j); v[j] = v[j] + g * a[j]; }
        float* xw = CN_XPTR(r);
        if (MODE == 3) {
            float ss = 0.f;
#pragma unroll
            for (int j = 0; j < 4; ++j) ss += (v[j].x * v[j].x + v[j].y * v[j].y) + (v[j].z * v[j].z + v[j].w * v[j].w);
            const float rstd = rsqrtf(wave_sum(ss) * (1.f / D) + NORM_EPS);
#pragma unroll
            for (int j = 0; j < 4; ++j) *(f32x4*)(xw + 4 * lane + 256 * j) = v[j] * rstd * gv[j];
        } else {
#pragma unroll
            for (int j = 0; j < 4; ++j) *(f32x4*)(xw + 4 * lane + 256 * j) = v[j];
            norm_core<MODE>(wl, lane, v, r, gv, shiftv + (size_t)mi * 6 * D, scalev + (size_t)mi * 6 * D, H, bias16, out16);
        }
        invA = invB; invB = invC;
    }
#undef CN_XPTR
#undef CN_INV
#undef CN_YLOAD
#undef CN_YACC
    if (MODE == 1) __syncthreads();
}

__device__ __forceinline__ void final_norm(Frame& F, float* x, const float* gain) {
    const int lane = F.lane;
    for (int r = F.gw; r < RL; r += F.NGW) { float* xr = x + (size_t)r * D; f32x4 v[4]; float ss = 0.f;
#pragma unroll
        for (int j = 0; j < 4; ++j) { v[j] = *(const f32x4*)(xr + 4 * lane + 256 * j); ss += (v[j].x * v[j].x + v[j].y * v[j].y) + (v[j].z * v[j].z + v[j].w * v[j].w); }
        const float rstd = rsqrtf(wave_sum(ss) * (1.f / D) + NORM_EPS);
#pragma unroll
        for (int j = 0; j < 4; ++j) { const f32x4 g = *(const f32x4*)(gain + 4 * lane + 256 * j); *(f32x4*)(xr + 4 * lane + 256 * j) = v[j] * rstd * g; } }
}

__device__ __forceinline__ void qk_pass(Frame& F, bf16_t* QKV, const float* qn, const float* kn, const float* ropec, const float* ropes, bf16_t* KALL, bf16_t* VALL) {
    const int lane = F.lane, p = lane & 3;
    float gq1[8], gq2[8], gk1[8], gk2[8];
#pragma unroll
    for (int t = 0; t < 8; ++t) { gq1[t] = qn[8 * p + t]; gq2[t] = qn[32 + 8 * p + t]; gk1[t] = kn[8 * p + t]; gk2[t] = kn[32 + 8 * p + t]; }
    for (int r = F.gw; r < RT; r += F.NGW) {
        const bool isc = r >= RL; const int b = isc ? (r - RL) >> 8 : r >> 12; const int t = isc ? (r - RL) & 255 : r & 4095;
        const int pos = isc ? t : CTXL + t;
        bf16_t* row = QKV + (size_t)r * 1536;
        float cs[8], sn[8];
#pragma unroll
        for (int i = 0; i < 8; ++i) { cs[i] = 1.f; sn[i] = 0.f; }
        if (!isc) { const f32x4 c0 = *(const f32x4*)(ropec + t * 32 + 8 * p), c1 = *(const f32x4*)(ropec + t * 32 + 8 * p + 4), s0 = *(const f32x4*)(ropes + t * 32 + 8 * p), s1 = *(const f32x4*)(ropes + t * 32 + 8 * p + 4);
            cs[0] = c0.x; cs[1] = c0.y; cs[2] = c0.z; cs[3] = c0.w; cs[4] = c1.x; cs[5] = c1.y; cs[6] = c1.z; cs[7] = c1.w;
            sn[0] = s0.x; sn[1] = s0.y; sn[2] = s0.z; sn[3] = s0.w; sn[4] = s1.x; sn[5] = s1.y; sn[6] = s1.z; sn[7] = s1.w; }
        {
            bf16_t* hp = row + (lane >> 2) * 64 + 8 * p;
            const u32x4 u1 = *(const u32x4*)hp, u2 = *(const u32x4*)(hp + 32);
            float x1[8], x2[8];
            x1[0] = bf_lo(u1.x); x1[1] = bf_hi(u1.x); x1[2] = bf_lo(u1.y); x1[3] = bf_hi(u1.y); x1[4] = bf_lo(u1.z); x1[5] = bf_hi(u1.z); x1[6] = bf_lo(u1.w); x1[7] = bf_hi(u1.w);
            x2[0] = bf_lo(u2.x); x2[1] = bf_hi(u2.x); x2[2] = bf_lo(u2.y); x2[3] = bf_hi(u2.y); x2[4] = bf_lo(u2.z); x2[5] = bf_hi(u2.z); x2[6] = bf_lo(u2.w); x2[7] = bf_hi(u2.w);
            float ss = 0.f;
#pragma unroll
            for (int i = 0; i < 8; ++i) ss += x1[i] * x1[i] + x2[i] * x2[i];
            ss = quad_sum(ss);
            const float rstd = rsqrtf(ss * (1.f / 64.f) + NORM_EPS) * attn_body::C2;
            float y1[8], y2[8];
#pragma unroll
            for (int i = 0; i < 8; ++i) { const float a = x1[i] * rstd * gq1[i], c = x2[i] * rstd * gq2[i]; y1[i] = a * cs[i] - c * sn[i]; y2[i] = a * sn[i] + c * cs[i]; }
            u32x4 o1, o2; o1.x = pk2(y1[0], y1[1]); o1.y = pk2(y1[2], y1[3]); o1.z = pk2(y1[4], y1[5]); o1.w = pk2(y1[6], y1[7]);
            o2.x = pk2(y2[0], y2[1]); o2.y = pk2(y2[2], y2[3]); o2.z = pk2(y2[4], y2[5]); o2.w = pk2(y2[6], y2[7]);
            *(u32x4*)hp = o1; *(u32x4*)(hp + 32) = o2;
        }
        {
            const int kh = (lane >> 2) & 3;
            const bf16_t* hp = row + 1024 + kh * 64 + 8 * p;
            const u32x4 u1 = *(const u32x4*)hp, u2 = *(const u32x4*)(hp + 32);
            float x1[8], x2[8];
            x1[0] = bf_lo(u1.x); x1[1] = bf_hi(u1.x); x1[2] = bf_lo(u1.y); x1[3] = bf_hi(u1.y); x1[4] = bf_lo(u1.z); x1[5] = bf_hi(u1.z); x1[6] = bf_lo(u1.w); x1[7] = bf_hi(u1.w);
            x2[0] = bf_lo(u2.x); x2[1] = bf_hi(u2.x); x2[2] = bf_lo(u2.y); x2[3] = bf_hi(u2.y); x2[4] = bf_lo(u2.z); x2[5] = bf_hi(u2.z); x2[6] = bf_lo(u2.w); x2[7] = bf_hi(u2.w);
            float ss = 0.f;
#pragma unroll
            for (int i = 0; i < 8; ++i) ss += x1[i] * x1[i] + x2[i] * x2[i];
            ss = quad_sum(ss);
            const float rstd = rsqrtf(ss * (1.f / 64.f) + NORM_EPS);
            float y1[8], y2[8];
#pragma unroll
            for (int i = 0; i < 8; ++i) { const float a = x1[i] * rstd * gk1[i], c = x2[i] * rstd * gk2[i]; y1[i] = a * cs[i] - c * sn[i]; y2[i] = a * sn[i] + c * cs[i]; }
            if (lane < 16) {
                bf16_t* kp = KALL + ((size_t)b * KVLEN + pos) * 256 + kh * 64 + 8 * p;
                u32x4 o1, o2; o1.x = pk2(y1[0], y1[1]); o1.y = pk2(y1[2], y1[3]); o1.z = pk2(y1[4], y1[5]); o1.w = pk2(y1[6], y1[7]);
                o2.x = pk2(y2[0], y2[1]); o2.y = pk2(y2[2], y2[3]); o2.z = pk2(y2[4], y2[5]); o2.w = pk2(y2[6], y2[7]);
                *(u32x4*)kp = o1; *(u32x4*)(kp + 32) = o2;
            } else if (lane < 48) {
                const int c8 = (lane - 16) * 8;
                *(u32x4*)(VALL + ((size_t)b * KVLEN + pos) * 256 + c8) = *(const u32x4*)(row + 1280 + c8);
            }
        }
    }
}

__device__ __forceinline__ void mlstm_readout(Frame& F, const bf16_t* HF, const bf16_t* HB, const bf16_t* QKVO, const float* wnorm, bf16_t* MIX) {
    const int lane = F.lane;
    f32x4 gv[4];
#pragma unroll
    for (int j = 0; j < 4; ++j) gv[j] = *(const f32x4*)(wnorm + 4 * lane + 256 * j);
    for (int r = F.gw; r < RT; r += F.NGW) {
        const u32x2* pf = (const u32x2*)(HF + (size_t)r * D) + lane; const u32x2* pb = (const u32x2*)(HB + (size_t)r * D) + lane;
        const u32x2* po = (const u32x2*)(QKVO + (size_t)r * 3072 + 2048) + lane;
        u32x2 uf[4], ub[4], uo[4];
#pragma unroll
        for (int j = 0; j < 4; ++j) { uf[j] = pf[64 * j]; ub[j] = pb[64 * j]; uo[j] = po[64 * j]; }
        unsigned long long* o8 = (unsigned long long*)(MIX + (size_t)r * D) + lane;
#pragma unroll
        for (int j = 0; j < 4; ++j) {
            f32x4 h; h.x = bf_lo(uf[j].x) + bf_lo(ub[j].x); h.y = bf_hi(uf[j].x) + bf_hi(ub[j].x); h.z = bf_lo(uf[j].y) + bf_lo(ub[j].y); h.w = bf_hi(uf[j].y) + bf_hi(ub[j].y);
            const float ss = wave_sum((h.x * h.x + h.y * h.y) + (h.z * h.z + h.w * h.w));
            const float rstd = rsqrtf(ss * (1.f / 256.f) + NORM_EPS);
            f32x4 og; og.x = bf_lo(uo[j].x); og.y = bf_hi(uo[j].x); og.z = bf_lo(uo[j].y); og.w = bf_hi(uo[j].y);
            f32x4 y;
            y.x = h.x * rstd * gv[j].x * fast_rcp(1.f + __expf(-og.x)); y.y = h.y * rstd * gv[j].y * fast_rcp(1.f + __expf(-og.y));
            y.z = h.z * rstd * gv[j].z * fast_rcp(1.f + __expf(-og.z)); y.w = h.w * rstd * gv[j].w * fast_rcp(1.f + __expf(-og.w));
            o8[64 * j] = (unsigned long long)pk2(y.x, y.y) | ((unsigned long long)pk2(y.z, y.w) << 32);
        }
    }
}
namespace mls {
constexpr int XS = 272, PS = 144, NCH = 68;
constexpr int O_XQ = 0, O_XK = 17408, O_XKP = 34816, O_XV = 52224, O_P = 69632, O_CT = 78848, O_OT = 113664, O_GB = 131072;
constexpr int O_RD = O_GB + 2 * 5 * 64 * 4, O_NV = O_RD + 256, O_DEC = O_NV + 1024, O_PRE = O_DEC + 64;
constexpr int LDS_BYTES = O_PRE + 3 * 72 * 4;

__device__ __forceinline__ int row_of(int b, int dir, int c, int p) {
    const int base = (c < 4) ? (RL + b * CTXL + (dir ? 192 - 64 * c : 64 * c)) : (b * SEQ + (dir ? 4032 - 64 * (c - 4) : 64 * (c - 4)));
    return base + (dir ? 63 - p : p);
}
__device__ __forceinline__ bf16x8 tr8(const LAS unsigned char* p0, const LAS unsigned char* p1) {
    typedef short v4i16_t __attribute__((ext_vector_type(4)));
    const s16x4 lo = __builtin_bit_cast(s16x4, __builtin_amdgcn_ds_read_tr16_b64_v4i16((LAS v4i16_t*)p0));
    const s16x4 hi = __builtin_bit_cast(s16x4, __builtin_amdgcn_ds_read_tr16_b64_v4i16((LAS v4i16_t*)p1));
    return (bf16x8){lo[0], lo[1], lo[2], lo[3], hi[0], hi[1], hi[2], hi[3]};
}

__device__ __forceinline__ void gate_arrays(LAS unsigned char* L, const float lf, const float ig, int c, int lane) {
    const int par = c & 1;
    const float bs = wave_scan_add(lf, lane);
    const float a = ig - bs; const float pm = wave_scan_max(a, lane);
    const float mst = ((const LAS float*)(L + O_PRE))[144 + c];
    const float M = fmaxf(mst, pm), M63 = rdlane(M, 63);
    LAS float* gb = (LAS float*)(L + O_GB) + par * 320;
    gb[lane] = a; gb[64 + lane] = M; gb[128 + lane] = __expf(mst - M); gb[192 + lane] = __expf(-bs - M); gb[256 + lane] = __expf(a - M63);
    if (lane == 0) ((LAS float*)(L + O_DEC))[par] = __expf(mst - M63);
}

__device__ __forceinline__ void mlstm_unit(Frame& F, int b, int hd, int dir, int half, const bf16_t* QKVO, const float* GATES, bf16_t* HOUT) {
    LAS unsigned char* L = F.lds;
    const int tid = F.tid, lane = F.lane, w = F.wave, fr = lane & 15, g = lane >> 4;
    const int gi = (dir * 2) * 4 + hd, gf = (dir * 2 + 1) * 4 + hd;
    LAS float* pre = (LAS float*)(L + O_PRE);
    __syncthreads();
    if (tid < NCH) { float bs = 0.f, am = -INFINITY;
        for (int p = 0; p < 64; ++p) { const int row = row_of(b, dir, tid, p); const float lf = GATES[(size_t)row * 16 + gf], ig = GATES[(size_t)row * 16 + gi]; bs += lf; am = fmaxf(am, ig - bs); }
        pre[tid] = bs; pre[72 + tid] = am; }
    for (int i = tid; i < (O_OT - O_CT) / 4; i += NTHREADS) ((LAS unsigned*)(L + O_CT))[i] = 0u;
    for (int i = tid; i < 256; i += NTHREADS) ((LAS float*)(L + O_NV))[i] = 0.f;
    __syncthreads();
    if (tid == 0) { float m = 0.f; for (int c = 0; c < NCH; ++c) { pre[144 + c] = m; m = pre[c] + fmaxf(m, pre[72 + c]); } }
    __syncthreads();
    if (w == 0) { const int row = row_of(b, dir, 0, lane); gate_arrays(L, GATES[(size_t)row * 16 + gf], GATES[(size_t)row * 16 + gi], 0, lane); }
    __syncthreads();
    const int qcol = hd * 128, kcol = 512 + hd * 128, vcol = 1024 + hd * 256 + half * 128;
    u32x4 rq[2], rk[2], rv[2];
#define MLS_BAR() do { asm volatile("s_waitcnt lgkmcnt(0)" ::: "memory"); __builtin_amdgcn_s_barrier(); asm volatile("" ::: "memory"); } while (0)
#define MLS_LOAD(c) do { _Pragma("unroll") for (int i_ = 0; i_ < 2; ++i_) { const int pi_ = tid + 512 * i_, p_ = pi_ >> 4, c16_ = pi_ & 15; \
        const bf16_t* rp_ = QKVO + (size_t)row_of(b, dir, (c), p_) * 3072 + c16_ * 8; \
        rq[i_] = *(const u32x4*)(rp_ + qcol); rk[i_] = *(const u32x4*)(rp_ + kcol); rv[i_] = *(const u32x4*)(rp_ + vcol); } } while (0)
#define MLS_STAGE(c) do { const LAS float* wk_ = (const LAS float*)(L + O_GB) + ((c) & 1) * 320 + 256; \
        _Pragma("unroll") for (int i_ = 0; i_ < 2; ++i_) { const int pi_ = tid + 512 * i_, p_ = pi_ >> 4, c16_ = pi_ & 15; const int o_ = p_ * XS + c16_ * 16; \
        *(LAS u32x4*)(L + O_XQ + o_) = rq[i_]; *(LAS u32x4*)(L + O_XK + o_) = rk[i_]; *(LAS u32x4*)(L + O_XV + o_) = rv[i_]; \
        const float s_ = wk_[p_]; u32x4 kk_; \
        kk_.x = pk2(bf_lo(rk[i_].x) * s_, bf_hi(rk[i_].x) * s_); kk_.y = pk2(bf_lo(rk[i_].y) * s_, bf_hi(rk[i_].y) * s_); \
        kk_.z = pk2(bf_lo(rk[i_].z) * s_, bf_hi(rk[i_].z) * s_); kk_.w = pk2(bf_lo(rk[i_].w) * s_, bf_hi(rk[i_].w) * s_); \
        *(LAS u32x4*)(L + O_XKP + o_) = kk_; } } while (0)
    MLS_LOAD(0); MLS_STAGE(0);
    __syncthreads();
    f32x4 C[8];
#pragma unroll
    for (int i = 0; i < 8; ++i) C[i] = (f32x4){0.f, 0.f, 0.f, 0.f};
    LAS unsigned char* CTw = L + O_CT + w * (16 * XS);
    for (int c = 0; c < NCH; ++c) {
        const int par = c & 1; const bool more = (c + 1 < NCH);
        const LAS float* gb = (const LAS float*)(L + O_GB) + par * 320;
        float glf = 0.f, gig = 0.f;
        if (more && w == 0) { const int row = row_of(b, dir, c + 1, lane); glf = GATES[(size_t)row * 16 + gf]; gig = GATES[(size_t)row * 16 + gi]; }
        if (more) MLS_LOAD(c + 1);
        if (more && w == 0) gate_arrays(L, glf, gig, c + 1, lane);
        {
            const int mt = w >> 1;
            bf16x8 aq[4];
#pragma unroll
            for (int ks = 0; ks < 4; ++ks) aq[ks] = *(const LAS bf16x8*)(L + O_XQ + (16 * mt + fr) * XS + (32 * ks + 8 * g) * 2);
            const f32x4 Mj = *(const LAS f32x4*)(gb + 64 + 16 * mt + 4 * g);
#pragma unroll
            for (int n2 = 0; n2 < 2; ++n2) { const int nt = 2 * (w & 1) + n2;
                f32x4 s4 = (f32x4){0.f, 0.f, 0.f, 0.f};
#pragma unroll
                for (int ks = 0; ks < 4; ++ks) { const bf16x8 bk = *(const LAS bf16x8*)(L + O_XK + (16 * nt + fr) * XS + (32 * ks + 8 * g) * 2);
                    s4 = __builtin_amdgcn_mfma_f32_16x16x32_bf16(aq[ks], bk, s4, 0, 0, 0); }
                const int s = 16 * nt + fr; const float as = gb[s];
#pragma unroll
                for (int reg = 0; reg < 4; ++reg) { const int j = 16 * mt + 4 * g + reg;
                    const float pv = (s <= j) ? s4[reg] * __expf(as - Mj[reg]) : 0.f;
                    *(LAS bf16_t*)(L + O_P + j * PS + s * 2) = (bf16_t)f2bf(pv); } }
        }
        f32x4 acc[4];
        {
            bf16x8 ct[4];
#pragma unroll
            for (int ks = 0; ks < 4; ++ks) ct[ks] = *(const LAS bf16x8*)(CTw + fr * XS + (32 * ks + 8 * g) * 2);
#pragma unroll
            for (int mt = 0; mt < 4; ++mt) { f32x4 a4 = (f32x4){0.f, 0.f, 0.f, 0.f};
#pragma unroll
                for (int ks = 0; ks < 4; ++ks) { const bf16x8 q = *(const LAS bf16x8*)(L + O_XQ + (16 * mt + fr) * XS + (32 * ks + 8 * g) * 2);
                    a4 = __builtin_amdgcn_mfma_f32_16x16x32_bf16(q, ct[ks], a4, 0, 0, 0); }
                const f32x4 wi = *(const LAS f32x4*)(gb + 128 + 16 * mt + 4 * g);
                acc[mt] = a4 * wi; }
        }
        MLS_BAR();
        bf16x8 vf[2];
        {
            const LAS unsigned char* vb = L + O_XV + (8 * g + (fr >> 2)) * XS + (16 * w + (lane & 3) * 4) * 2;
#pragma unroll
            for (int k2 = 0; k2 < 2; ++k2) vf[k2] = tr8(vb + 32 * k2 * XS, vb + (32 * k2 + 4) * XS);
#pragma unroll
            for (int mt = 0; mt < 4; ++mt)
#pragma unroll
                for (int k2 = 0; k2 < 2; ++k2) { const bf16x8 ap = *(const LAS bf16x8*)(L + O_P + (16 * mt + fr) * PS + (32 * k2 + 8 * g) * 2);
                    acc[mt] = __builtin_amdgcn_mfma_f32_16x16x32_bf16(ap, vf[k2], acc[mt], 0, 0, 0); }
        }
        {
            const int j = tid >> 3, part = tid & 7;
            const u32x4 pu = *(const LAS u32x4*)(L + O_P + j * PS + part * 16);
            float rs = (bf_lo(pu.x) + bf_hi(pu.x)) + (bf_lo(pu.y) + bf_hi(pu.y)) + (bf_lo(pu.z) + bf_hi(pu.z)) + (bf_lo(pu.w) + bf_hi(pu.w));
            const u32x4 q0 = *(const LAS u32x4*)(L + O_XQ + j * XS + part * 32), q1 = *(const LAS u32x4*)(L + O_XQ + j * XS + part * 32 + 16);
            const LAS f32x4* np = (const LAS f32x4*)(L + O_NV + par * 512 + part * 64);
            const f32x4 n0 = np[0], n1 = np[1], n2 = np[2], n3 = np[3];
            float qn = bf_lo(q0.x) * n0.x + bf_hi(q0.x) * n0.y + bf_lo(q0.y) * n0.z + bf_hi(q0.y) * n0.w
                     + bf_lo(q0.z) * n1.x + bf_hi(q0.z) * n1.y + bf_lo(q0.w) * n1.z + bf_hi(q0.w) * n1.w
                     + bf_lo(q1.x) * n2.x + bf_hi(q1.x) * n2.y + bf_lo(q1.y) * n2.z + bf_hi(q1.y) * n2.w
                     + bf_lo(q1.z) * n3.x + bf_hi(q1.z) * n3.y + bf_lo(q1.w) * n3.z + bf_hi(q1.w) * n3.w;
            rs = oct_sum(rs); qn = oct_sum(qn);
            const float den = rs + gb[128 + j] * qn;
            if (part == 0) ((LAS float*)(L + O_RD))[j] = 1.f / fmaxf(fabsf(den), gb[192 + j]);
        }
        {
            const float decay = ((const LAS float*)(L + O_DEC))[par];
            const LAS unsigned char* kb = L + O_XKP + (8 * g + (fr >> 2)) * XS + ((lane & 3) * 4) * 2;
#pragma unroll
            for (int mt = 0; mt < 8; ++mt) { f32x4 c4 = C[mt] * decay;
#pragma unroll
                for (int k2 = 0; k2 < 2; ++k2) { const bf16x8 ak = tr8(kb + 32 * k2 * XS + 32 * mt, kb + (32 * k2 + 4) * XS + 32 * mt);
                    c4 = __builtin_amdgcn_mfma_f32_16x16x32_bf16(ak, vf[k2], c4, 0, 0, 0); }
                C[mt] = c4;
                u32x2 o; o.x = pk2(c4[0], c4[1]); o.y = pk2(c4[2], c4[3]);
                *(LAS u32x2*)(CTw + fr * XS + (16 * mt + 4 * g) * 2) = o; }
            const int dk = tid >> 2, part = tid & 3; float sm = 0.f;
#pragma unroll
            for (int t = 0; t < 16; ++t) sm += bf2f(*(const LAS bf16_t*)(L + O_XKP + (16 * part + t) * XS + dk * 2));
            sm = quad_sum(sm);
            if (part == 0) { const LAS float* nv = (const LAS float*)(L + O_NV); ((LAS float*)(L + O_NV))[(par ^ 1) * 128 + dk] = decay * nv[par * 128 + dk] + sm; }
        }
        MLS_BAR();
        {
#pragma unroll
            for (int mt = 0; mt < 4; ++mt) { const f32x4 rd = *(const LAS f32x4*)(L + O_RD + (16 * mt + 4 * g) * 4);
#pragma unroll
                for (int reg = 0; reg < 4; ++reg) *(LAS bf16_t*)(L + O_OT + (16 * mt + 4 * g + reg) * XS + (16 * w + fr) * 2) = (bf16_t)f2bf(acc[mt][reg] * rd[reg]); }
            if (more) MLS_STAGE(c + 1);
        }
        MLS_BAR();
        {
            const int j = tid >> 3, ch = tid & 7;
            const u32x4 o0 = *(const LAS u32x4*)(L + O_OT + j * XS + ch * 32), o1 = *(const LAS u32x4*)(L + O_OT + j * XS + ch * 32 + 16);
            bf16_t* op = HOUT + (size_t)row_of(b, dir, c, j) * D + hd * 256 + half * 128 + ch * 16;
            *(u32x4*)op = o0; *(u32x4*)(op + 8) = o1;
        }
    }
#undef MLS_BAR
#undef MLS_LOAD
#undef MLS_STAGE
}
}
constexpr int MISC_OFF = 135936, LDS_TOTAL = 136192;
static_assert(mls::LDS_BYTES <= MISC_OFF && pg8::STAGE_BYTES <= MISC_OFF && attn_body::LDS_BYTES <= MISC_OFF, "lds");
#ifndef EN_MASK
#define EN_MASK 0xFFFFFFFFu
#endif
#define PH_ON(k) (((EN_MASK) >> (k)) & 1u)
#ifndef REP_MASK
#define REP_MASK 0u
#endif
#define REP_ON(k) (((REP_MASK) >> (k)) & 1u)
#ifndef PH_LIMIT
#define PH_LIMIT 1000
#endif
#ifndef N_LAUNCH_SPLIT
#define N_LAUNCH_SPLIT 0
#endif
constexpr int N_PHASES = 1 + 10 + 9 + 9 + 9;

struct Args { const float* in[21]; float* out; unsigned char* ws; int ph_lo, ph_hi; };
static_assert(sizeof(Args) == 23 * 8 + 8, "no padding");

__device__ __forceinline__ Frame make_frame(unsigned char* lds_gen, unsigned char* ws_) {
    Frame F; int t = threadIdx.x; asm volatile("" : "+v"(t));
    int bx = blockIdx.x; asm volatile("" : "+s"(bx));
    F.lds = (LAS unsigned char*)lds_gen; F.tid = t; F.lane = t & 63; F.wave = __builtin_amdgcn_readfirstlane(t >> 6);
    F.G = gridDim.x; F.bid = bx; F.vcu = (F.G % 8 == 0) ? (bx % 8) * (F.G / 8) + bx / 8 : bx;
    F.gw = F.vcu * NWAVES + F.wave; F.NGW = F.G * NWAVES;
    unsigned char* w = ws_; asm volatile("" : "+s"(w)); F.ws = w; F.in = (const float* const*)(w + WS_PTRS); return F;
}
__global__ void __launch_bounds__(NTHREADS, 2) fwd(Args a) {
    extern __shared__ __attribute__((aligned(16))) unsigned char lds_raw[];
    unsigned char* const lds_gen = lds_raw;
    unsigned char* ws = a.ws;
    if (threadIdx.x < 4) ((LAS unsigned*)((LAS unsigned char*)lds_raw + MISC_OFF))[threadIdx.x] = 0u;
    __syncthreads();
    XcdBarrier bar = xcd_barrier_post((unsigned*)(ws + WS_CTL), (volatile LAS unsigned*)((LAS unsigned char*)lds_raw + MISC_OFF));
    int cur = 0; const int lo = a.ph_lo, hi = a.ph_hi & 0xffff; bool ran = false;
#define PHASE_BEGIN if (cur >= lo && cur < hi) { if (ran) xcd_barrier(bar); ran = true;
#define PHASE_END   } ++cur;

    if (blockIdx.x == 0 && threadIdx.x < 22) ((const float**)(ws + WS_PTRS))[threadIdx.x] = (threadIdx.x < 21) ? a.in[threadIdx.x] : (const float*)a.out;
#define XL ((float*)F.in[21])
#define XC ((float*)(F.ws + WS_XC))
#define H ((bf16_t*)(F.ws + WS_H))
#define MIX ((bf16_t*)(F.ws + WS_MIX))
#define BIG0 ((bf16_t*)(F.ws + WS_BIG0))
#define BIG1 ((bf16_t*)(F.ws + WS_BIG1))
#define GATES ((float*)(F.ws + WS_GATES))
#define AFF ((float*)(F.ws + WS_AFF))
#define INV ((int*)(F.ws + WS_INV))
#define SLROW ((int*)(F.ws + WS_SLROW))
#define SLG ((float*)(F.ws + WS_SLG))
#define IN(k) (F.in[k])

    PHASE_BEGIN if (PH_ON(0)) for (int rep_ = 0; rep_ < (REP_ON(0) ? 2 : 1); ++rep_) { if (rep_) xcd_barrier(bar); Frame F = make_frame(lds_gen, a.ws); p0_prologue(F, a.in, F.ws); } PHASE_END

    for (int layer = 0; layer < DEPTH; ++layer) {
        const bool last = (layer == DEPTH - 1); const int j = layer >> 1;
#define modv ((const float*)(F.ws + WS_MODV) + (size_t)layer * NMI * 6 * D)
#define xLs ((layer == 0) ? IN(0) : (const float*)XL)
#define xCs ((layer == 0) ? IN(2) : (const float*)XC)
        if ((layer & 1) == 0) {
            if (layer == 0) { PHASE_BEGIN if (PH_ON(1)) for (int rep_ = 0; rep_ < (REP_ON(1) ? 2 : 1); ++rep_) { if (rep_) xcd_barrier(bar); Frame F = make_frame(lds_gen, a.ws); norm_pass<1>(F, xLs, xCs, RT, IN(6) + layer * D, modv + 0 * D, modv + 1 * D, H, IN(8) + (size_t)j * D * MW_IN + 3072, MW_IN, IN(9) + j * 16, GATES); } PHASE_END }
            PHASE_BEGIN if (PH_ON(2)) for (int rep_ = 0; rep_ < (REP_ON(2) ? 2 : 1); ++rep_) { if (rep_) xcd_barrier(bar); Frame F = make_frame(lds_gen, a.ws); { pg8::PlainSched S{(const char*)H, (const char*)((bf16_t*)(F.ws + WS_WMI) + (size_t)j * 3072 * D), RT / 256, 12, D, F.G, F.bid};
                pg8::EpiBf16 E{BIG0, 3072, 2, 0.08838834764831845f}; pg8::gemm_phase(F.lds, F.tid, D, S, E); } } PHASE_END
            PHASE_BEGIN if (PH_ON(3)) for (int rep_ = 0; rep_ < (REP_ON(3) ? 2 : 1); ++rep_) { if (rep_) xcd_barrier(bar); Frame F = make_frame(lds_gen, a.ws); for (int u = F.vcu; u < 256; u += F.G) { const int half = u & 1, dir = (u >> 1) & 1, hd = (u >> 2) & 3, b = u >> 4;
                mls::mlstm_unit(F, b, hd, dir, half, BIG0, GATES, dir ? MIX : H); } } PHASE_END
            PHASE_BEGIN if (PH_ON(4)) for (int rep_ = 0; rep_ < (REP_ON(4) ? 2 : 1); ++rep_) { if (rep_) xcd_barrier(bar); Frame F = make_frame(lds_gen, a.ws); mlstm_readout(F, H, MIX, BIG0, IN(10) + j * D, MIX); } PHASE_END
            PHASE_BEGIN if (PH_ON(5)) for (int rep_ = 0; rep_ < (REP_ON(5) ? 2 : 1); ++rep_) { if (rep_) xcd_barrier(bar); Frame F = make_frame(lds_gen, a.ws); { pg8::PlainSched S{(const char*)MIX, (const char*)((bf16_t*)(F.ws + WS_WMO) + (size_t)j * D * D), RT / 256, 4, D, F.G, F.bid};
                pg8::EpiResid E{xLs, xCs, XL, XC, modv + 2 * D}; pg8::gemm_phase(F.lds, F.tid, D, S, E); } } PHASE_END
        } else {
#define KALL BIG1
#define VALL (BIG1 + (size_t)NB * KVLEN * 256)
            PHASE_BEGIN if (PH_ON(7)) for (int rep_ = 0; rep_ < (REP_ON(7) ? 2 : 1); ++rep_) { if (rep_) xcd_barrier(bar); Frame F = make_frame(lds_gen, a.ws); { pg8::PlainSched S{(const char*)H, (const char*)((bf16_t*)(F.ws + WS_WAI) + (size_t)j * 1536 * D), RT / 256, 6, D, F.G, F.bid};
                pg8::EpiBf16 E{BIG0, 1536, 0, 1.f}; pg8::gemm_phase(F.lds, F.tid, D, S, E); } } PHASE_END
            PHASE_BEGIN if (PH_ON(8)) for (int rep_ = 0; rep_ < (REP_ON(8) ? 2 : 1); ++rep_) { if (rep_) xcd_barrier(bar); Frame F = make_frame(lds_gen, a.ws); qk_pass(F, BIG0, IN(13) + j * 64, IN(14) + j * 64, (const float*)(F.ws + WS_ROPE), (const float*)(F.ws + WS_ROPE) + SEQ * 32, KALL, VALL); } PHASE_END
            PHASE_BEGIN if (PH_ON(9)) for (int rep_ = 0; rep_ < (REP_ON(9) ? 2 : 1); ++rep_) { if (rep_) xcd_barrier(bar); Frame F = make_frame(lds_gen, a.ws); { const int nun = last ? 4096 : 4096 + 256;
                for (int L = F.vcu; L < nun; L += F.G) {
                    const bool isc = L >= 4096; const int Lc = L - 4096;
                    const int grp = L >> 6, wi = L & 63;
                    const int b = isc ? (Lc >> 4) : (grp >> 2), hq = isc ? (Lc & 15) : ((grp & 3) * 4 + (wi >> 4));
                    const size_t row0 = isc ? ((size_t)RL + b * CTXL) : ((size_t)b * SEQ + (wi & 15) * 256);
                    const bf16_t* qp = BIG0 + row0 * 1536 + hq * 64; const bf16_t* kp = KALL + (size_t)b * KVLEN * 256 + (hq >> 2) * 64; const bf16_t* vp = VALL + (size_t)b * KVLEN * 256 + (hq >> 2) * 64; bf16_t* op = MIX + row0 * D + hq * 64;
                    if (isc) attn_body::attn_unit<8>(qp, 1536, kp, vp, 256, CTXL / 64, op, D, (char*)lds_gen, F.tid);
                    else     attn_body::attn_unit<8>(qp, 1536, kp, vp, 256, KVLEN / 64, op, D, (char*)lds_gen, F.tid); } } } PHASE_END
            PHASE_BEGIN if (PH_ON(10)) for (int rep_ = 0; rep_ < (REP_ON(10) ? 2 : 1); ++rep_) { if (rep_) xcd_barrier(bar); Frame F = make_frame(lds_gen, a.ws); { pg8::PlainSched S{(const char*)MIX, (const char*)((bf16_t*)(F.ws + WS_WAO) + (size_t)j * D * D), (last ? RL : RT) / 256, 4, D, F.G, F.bid};
                pg8::EpiResid E{xLs, xCs, XL, XC, modv + 2 * D}; pg8::gemm_phase(F.lds, F.tid, D, S, E); } } PHASE_END
        }
        const int nrows = last ? RL : RT;
        PHASE_BEGIN if (PH_ON(11)) for (int rep_ = 0; rep_ < (REP_ON(11) ? 2 : 1); ++rep_) { if (rep_) xcd_barrier(bar); Frame F = make_frame(lds_gen, a.ws); moe_weights(F, IN(17) + (size_t)layer * NE * D * D, IN(18) + (size_t)layer * NE * D * D, IN(19) + (size_t)layer * NE * D * D, F.ws);
            norm_pass<2>(F, XL, XC, nrows, IN(7) + layer * D, modv + 3 * D, modv + 4 * D, H, IN(16) + (size_t)layer * D * 16, 16, nullptr, AFF); } PHASE_END
        PHASE_BEGIN if (PH_ON(12)) for (int rep_ = 0; rep_ < (REP_ON(12) ? 2 : 1); ++rep_) { if (rep_) xcd_barrier(bar); Frame F = make_frame(lds_gen, a.ws); moe_select(F, AFF, INV, SLROW, SLG, last ? NB * NE : 2 * NB * NE); } PHASE_END
        PHASE_BEGIN if (PH_ON(14)) for (int rep_ = 0; rep_ < (REP_ON(14) ? 2 : 1); ++rep_) { if (rep_) xcd_barrier(bar); Frame F = make_frame(lds_gen, a.ws); { pg8::MoeSched S{(const char*)H, (const char*)(F.ws + WS_W1), last ? 32 : 34, 8, D, 2048, F.G, F.bid};
            pg8::EpiSwiglu E{BIG1}; pg8::gemm_phase<pg8::EpiSwiglu, pg8::MoeSched, true>(F.lds, F.tid, D, S, E, SLROW); } } PHASE_END
        PHASE_BEGIN if (PH_ON(15)) for (int rep_ = 0; rep_ < (REP_ON(15) ? 2 : 1); ++rep_) { if (rep_) xcd_barrier(bar); Frame F = make_frame(lds_gen, a.ws); { pg8::MoeSched S{(const char*)BIG1, (const char*)(F.ws + WS_W2), last ? 32 : 34, 4, D, 1024, F.G, F.bid};
            pg8::EpiRowScale E{BIG0, SLG}; pg8::gemm_phase(F.lds, F.tid, D, S, E); } } PHASE_END
        PHASE_BEGIN if (PH_ON(16)) for (int rep_ = 0; rep_ < (REP_ON(16) ? 2 : 1); ++rep_) { if (rep_) xcd_barrier(bar); Frame F = make_frame(lds_gen, a.ws);
            const int nl = layer + 1; const float* modn = (const float*)(F.ws + WS_MODV) + (size_t)nl * NMI * 6 * D;
            if (last) combine_norm<3>(F, BIG0, INV, XL, XC, modv + 5 * D, RL, IN(20), nullptr, nullptr, nullptr, nullptr, 0, nullptr, nullptr);
            else if (nl & 1) combine_norm<0>(F, BIG0, INV, XL, XC, modv + 5 * D, RT, IN(6) + nl * D, modn + 0 * D, modn + 1 * D, H, nullptr, 0, nullptr, nullptr);
            else combine_norm<1>(F, BIG0, INV, XL, XC, modv + 5 * D, RT, IN(6) + nl * D, modn + 0 * D, modn + 1 * D, H, IN(8) + (size_t)(nl >> 1) * D * MW_IN + 3072, MW_IN, IN(9) + (nl >> 1) * 16, GATES); } PHASE_END
    }
#undef XL
#undef XC
#undef H
#undef MIX
#undef BIG0
#undef BIG1
#undef GATES
#undef AFF
#undef INV
#undef SLROW
#undef SLG
#undef IN
#undef modv
#undef xLs
#undef xCs
#undef KALL
#undef VALL
#undef PHASE_BEGIN
#undef PHASE_END
}

extern "C" void kernel_launch(void* const* d_in, const int* in_sizes, int n_in, void* d_out, int out_size, void* d_ws, size_t ws_size, hipStream_t stream) {
    static int grid = 0;
    if (grid == 0) {
        if (n_in != 21 || out_size != RL * D || ws_size < WS_END) { fprintf(stderr, "kernel_launch: unexpected shapes: n_in %d out %d ws %zu (need %zu)\n", n_in, out_size, ws_size, (size_t)WS_END); grid = -1; return; }
        int dev = 0, cus = 0, per_cu = 0;
        if (hipGetDevice(&dev) != hipSuccess || hipDeviceGetAttribute(&cus, hipDeviceAttributeMultiprocessorCount, dev) != hipSuccess) { grid = -1; return; }
        if (hipFuncSetAttribute((const void*)fwd, hipFuncAttributeMaxDynamicSharedMemorySize, LDS_TOTAL) != hipSuccess) { fprintf(stderr, "kernel_launch: hipFuncSetAttribute failed\n"); grid = -1; return; }
        if (hipOccupancyMaxActiveBlocksPerMultiprocessor(&per_cu, (const void*)fwd, NTHREADS, LDS_TOTAL) != hipSuccess || per_cu < 1) fprintf(stderr, "kernel_launch: occupancy query says %d\n", per_cu);
        (void)hipGetLastError();
        grid = cus;
    }
    if (grid < 0) return;
    (void)in_sizes;
    if (hipMemsetAsync((char*)d_ws + WS_CTL, 0, CTL_BYTES, stream) != hipSuccess) return;
    Args a{};
    for (int i = 0; i < 21; ++i) a.in[i] = (const float*)d_in[i];
    a.out = (float*)d_out; a.ws = (unsigned char*)d_ws;
    const int nph = N_PHASES < PH_LIMIT ? N_PHASES : PH_LIMIT;
#if N_LAUNCH_SPLIT
    for (int p = 0; p < nph; ++p) { a.ph_lo = p; a.ph_hi = p + 1; hipLaunchKernelGGL(fwd, dim3(grid), dim3(NTHREADS), LDS_TOTAL, stream, a); }
#else
    a.ph_lo = 0; a.ph_hi = nph;
    hipLaunchKernelGGL(fwd, dim3(grid), dim3(NTHREADS), LDS_TOTAL, stream, a);
#endif
    const hipError_t le = hipPeekAtLastError();
    if (le != hipSuccess) fprintf(stderr, "kernel_launch: launch failed: %s\n", hipGetErrorName(le));
}
```

```cpp
#include <hip/hip_runtime.h>
#include <cstdio>
#include <cstdint>

#define GAS __attribute__((address_space(1)))
#define LAS __attribute__((address_space(3)))
typedef unsigned short bf16_t;
typedef short bf16x8 __attribute__((ext_vector_type(8)));
typedef short s16x4 __attribute__((ext_vector_type(4)));
typedef float f32x4 __attribute__((ext_vector_type(4)));
typedef float f32x2 __attribute__((ext_vector_type(2)));
typedef float f32x16 __attribute__((ext_vector_type(16)));
typedef unsigned u32x4 __attribute__((ext_vector_type(4)));
typedef unsigned u32x2 __attribute__((ext_vector_type(2)));

constexpr int D = 1024, NB = 16, SEQ = 4096, CTXL = 256, DEPTH = 4;
constexpr int RL = NB * SEQ, RC = NB * CTXL, RT = RL + RC;
constexpr int NE = 16, CAP_L = 512, CAP_C = 32, SLOTS_E = NB * CAP_L + NB * CAP_C;
constexpr int NMI = NB + 1;
constexpr int MW_IN = 3088;
constexpr int KVLEN = CTXL + SEQ;
constexpr int NWAVES = 8, NTHREADS = 512;
constexpr float NORM_EPS = 1e-6f;

constexpr size_t al256(size_t x) { return (x + 255) & ~(size_t)255; }
constexpr size_t WS_CTL   = 0;
constexpr size_t CTL_BYTES = 16384;
constexpr size_t WS_PTRS  = WS_CTL + CTL_BYTES;
constexpr size_t WS_MODV  = WS_PTRS + 256;
constexpr size_t WS_ROPE  = al256(WS_MODV + (size_t)DEPTH * NMI * 6 * D * 4);
constexpr size_t WS_XC    = al256(WS_ROPE + (size_t)2 * SEQ * 32 * 4);
constexpr size_t WS_GATES = al256(WS_XC + (size_t)RC * D * 4);
constexpr size_t WS_AFF   = al256(WS_GATES + (size_t)RT * 16 * 4);
constexpr size_t WS_INV   = al256(WS_AFF + (size_t)RT * 16 * 4);
constexpr size_t WS_SLROW = al256(WS_INV + (size_t)RT * 16 * 4);
constexpr size_t WS_SLG   = al256(WS_SLROW + (size_t)NE * SLOTS_E * 4);
constexpr size_t WS_WMI   = al256(WS_SLG + (size_t)NE * SLOTS_E * 4);
constexpr size_t WS_WMO   = al256(WS_WMI + (size_t)2 * 3072 * D * 2);
constexpr size_t WS_WAI   = al256(WS_WMO + (size_t)2 * D * D * 2);
constexpr size_t WS_WAO   = al256(WS_WAI + (size_t)2 * 1536 * D * 2);
constexpr size_t WS_W1    = al256(WS_WAO + (size_t)2 * D * D * 2);
constexpr size_t WS_W2    = al256(WS_W1 + (size_t)NE * 2048 * D * 2);
constexpr size_t WS_H     = al256(WS_W2 + (size_t)NE * D * D * 2);
constexpr size_t WS_MIX   = al256(WS_H + (size_t)RT * D * 2);
constexpr size_t WS_BIG0  = al256(WS_MIX + (size_t)RT * D * 2);
constexpr size_t BIG_HALF = (size_t)NE * SLOTS_E * D * 2;
constexpr size_t WS_BIG1  = al256(WS_BIG0 + BIG_HALF);
constexpr size_t WS_END   = al256(WS_BIG1 + BIG_HALF);
static_assert((size_t)RT * 3072 * 2 <= 2 * BIG_HALF, "qkvo fits");

#define LDS_WAIT() asm volatile("s_waitcnt lgkmcnt(0)" ::: "memory")
#define VM_WAIT() asm volatile("s_waitcnt vmcnt(0)" ::: "memory")
typedef __bf16 bf16x2_t __attribute__((ext_vector_type(2)));
__device__ __forceinline__ unsigned pk2(float lo, float hi) { f32x2 v = {lo, hi}; bf16x2_t b = __builtin_convertvector(v, bf16x2_t); return __builtin_bit_cast(unsigned, b); }
__device__ __forceinline__ unsigned f2bf(float f) { return pk2(f, f) & 0xffffu; }
__device__ __forceinline__ float bf_lo(unsigned u) { return __builtin_bit_cast(float, u << 16); }
__device__ __forceinline__ float bf_hi(unsigned u) { return __builtin_bit_cast(float, u & 0xffff0000u); }
__device__ __forceinline__ float bf2f(bf16_t b) { return __builtin_bit_cast(float, ((unsigned)b) << 16); }
__device__ __forceinline__ unsigned pk_fp8x4(float a, float b, float c, float d) {
    a = __builtin_amdgcn_fmed3f(a, -448.f, 448.f); b = __builtin_amdgcn_fmed3f(b, -448.f, 448.f); c = __builtin_amdgcn_fmed3f(c, -448.f, 448.f); d = __builtin_amdgcn_fmed3f(d, -448.f, 448.f);
    int p = __builtin_amdgcn_cvt_pk_fp8_f32(a, b, 0, false); p = __builtin_amdgcn_cvt_pk_fp8_f32(c, d, p, true); return (unsigned)p; }
#ifndef MOE_FP8_1
#define MOE_FP8_1 1
#endif
#ifndef MOE_FP8_2
#define MOE_FP8_2 1
#endif
constexpr float FP8_SH = 16.f, FP8_SW = 512.f, FP8_SA = 8.f;
template <int CTRL> __device__ __forceinline__ float dpp_f(float old, float v) { return __builtin_bit_cast(float, __builtin_amdgcn_update_dpp(__builtin_bit_cast(int, old), __builtin_bit_cast(int, v), CTRL, 0xf, 0xf, false)); }
__device__ __forceinline__ float rdlane(float v, int l) { return __builtin_bit_cast(float, __builtin_amdgcn_readlane(__builtin_bit_cast(int, v), l)); }
__device__ __forceinline__ float row16_sum(float v) {
    v += dpp_f<0xB1>(0.f, v); v += dpp_f<0x4E>(0.f, v); v += dpp_f<0x141>(0.f, v); v += dpp_f<0x140>(0.f, v); return v; }
__device__ __forceinline__ float oct_sum(float v) {
    v += dpp_f<0xB1>(0.f, v); v += dpp_f<0x4E>(0.f, v); v += dpp_f<0x141>(0.f, v); return v; }
__device__ __forceinline__ float quad_sum(float v) { v += dpp_f<0xB1>(0.f, v); v += dpp_f<0x4E>(0.f, v); return v; }
__device__ __forceinline__ float wave_sum(float v) {
    v = row16_sum(v); return (rdlane(v, 0) + rdlane(v, 16)) + (rdlane(v, 32) + rdlane(v, 48)); }
__device__ __forceinline__ float wave_scan_add(float v, int lane) {
    v += dpp_f<0x111>(0.f, v); v += dpp_f<0x112>(0.f, v); v += dpp_f<0x114>(0.f, v); v += dpp_f<0x118>(0.f, v);
    const float t0 = rdlane(v, 15), t1 = rdlane(v, 31), t2 = rdlane(v, 47);
    const int row = lane >> 4; return v + (row == 0 ? 0.f : row == 1 ? t0 : row == 2 ? t0 + t1 : (t0 + t1) + t2); }
__device__ __forceinline__ float wave_scan_max(float v, int lane) {
    const float NI = -INFINITY;
    v = fmaxf(v, dpp_f<0x111>(NI, v)); v = fmaxf(v, dpp_f<0x112>(NI, v)); v = fmaxf(v, dpp_f<0x114>(NI, v)); v = fmaxf(v, dpp_f<0x118>(NI, v));
    const float t0 = rdlane(v, 15), t1 = rdlane(v, 31), t2 = rdlane(v, 47);
    const int row = lane >> 4; return fmaxf(v, row == 0 ? NI : row == 1 ? t0 : row == 2 ? fmaxf(t0, t1) : fmaxf(fmaxf(t0, t1), t2)); }
__device__ __forceinline__ float fast_exp(float x) { return __builtin_amdgcn_exp2f(x * 1.4426950408889634f); }
__device__ __forceinline__ float fast_rcp(float x) { return __builtin_amdgcn_rcpf(x); }
__device__ __forceinline__ float silu_f(float x) { return x / (1.f + __expf(-x)); }

#define XB_TMO      128
#define XB_XCNT(j)  (256  + 64 * (j))
#define XB_XSUB(j)  (1280 + 64 * (j))
#define XB_XGEN(j)  (2304 + 64 * (j))
#define XB_TOP      3328
#define XB_TOPGEN   3392
#define XCD_BAR_WORDS 3456
#define XB_SPIN_CAP (1u << 21)
static_assert(XCD_BAR_WORDS * 4 <= CTL_BYTES, "ctl");

__device__ __forceinline__ unsigned xb_ld(unsigned* p)              { return __hip_atomic_load(p, __ATOMIC_RELAXED, __HIP_MEMORY_SCOPE_AGENT); }
__device__ __forceinline__ unsigned xb_add(unsigned* p, unsigned v) { return __hip_atomic_fetch_add(p, v, __ATOMIC_RELAXED, __HIP_MEMORY_SCOPE_AGENT); }
__device__ __forceinline__ unsigned xb_xcc_id() { return (unsigned)__builtin_amdgcn_s_getreg((3 << 11) | 20) & 0xFu; }
#define XB_SPIN(cond, bar) do { unsigned _sp = 0; while (cond) { __builtin_amdgcn_s_sleep(1); \
    if ((++_sp & 255u) == 0u) { if (xb_ld(&(bar)[XB_TMO])) break; if (_sp > XB_SPIN_CAP) { atomicAdd(&(bar)[XB_TMO], 1u); break; } } } } while (0)

struct XcdBarrier { unsigned* bar; unsigned x; volatile LAS unsigned* st; };

__device__ __forceinline__ XcdBarrier xcd_barrier_post(unsigned* bar, volatile LAS unsigned* st) {
    XcdBarrier b; b.bar = bar; b.x = xb_xcc_id(); b.st = st;
    if (threadIdx.x == 0) (void)xb_add(&bar[XB_XCNT(b.x)], 1u);
    return b;
}
__device__ __forceinline__ void xcd_barrier_complete(unsigned* bar, unsigned x, unsigned& nloc, unsigned& nx) {
    const unsigned G = gridDim.x * gridDim.y * gridDim.z;
    unsigned sum, cnt, mine, sp = 0u;
    for (;;) {
        sum = 0u; cnt = 0u; mine = 0u;
#pragma unroll
        for (unsigned j = 0; j < 16; ++j) { const unsigned c = xb_ld(&bar[XB_XCNT(j)]); sum += c; cnt += (c > 0u) ? 1u : 0u; mine = (j == x) ? c : mine; }
        if (sum == G) break;
        __builtin_amdgcn_s_sleep(1);
        if ((++sp & 255u) == 0u) { if (xb_ld(&bar[XB_TMO])) break; if (sp > XB_SPIN_CAP) { atomicAdd(&bar[XB_TMO], 1u); break; } }
    }
    nloc = mine > 0u ? mine : 1u; nx = cnt > 0u ? cnt : 1u;
}
__device__ __forceinline__ void xcd_barrier(const XcdBarrier& b) {
    asm volatile("s_waitcnt vmcnt(0)" ::: "memory");
    __syncthreads();
    if (threadIdx.x == 0) {
        unsigned* bar = b.bar;
        __builtin_amdgcn_s_waitcnt(0);
        unsigned nloc = b.st[0], nx = b.st[1];
        if (nloc == 0u) { xcd_barrier_complete(bar, b.x, nloc, nx); b.st[0] = nloc; b.st[1] = nx; }
        const unsigned old = xb_add(&bar[XB_XSUB(b.x)], 1u);
        const unsigned gen = old / nloc;
        if (old + 1u == (gen + 1u) * nloc) {
            __builtin_amdgcn_fence(__ATOMIC_RELEASE, "agent");
            asm volatile("s_waitcnt vmcnt(0)" ::: "memory");
            const unsigned og = xb_add(&bar[XB_TOP], 1u);
            const unsigned tg = og / nx;
            if (og + 1u == (tg + 1u) * nx) xb_add(&bar[XB_TOPGEN], 1u);
            else XB_SPIN(xb_ld(&bar[XB_TOPGEN]) == tg, bar);
            __builtin_amdgcn_fence(__ATOMIC_ACQUIRE, "agent");
            xb_add(&bar[XB_XGEN(b.x)], 1u);
            asm volatile("s_waitcnt vmcnt(0)" ::: "memory");
        } else {
            XB_SPIN(xb_ld(&bar[XB_XGEN(b.x)]) == gen, bar);
            __builtin_amdgcn_fence(__ATOMIC_ACQUIRE, "agent");
            asm volatile("s_waitcnt vmcnt(0)" ::: "memory");
        }
    }
    __syncthreads();
}
namespace pg8 {
constexpr int BM = 256, BK = 64, HALF = 128, HTB = HALF * BK * 2, STAGE_BYTES = 8 * HTB, NXCD = 8, WGM = 8;

__host__ __device__ __forceinline__ int lds_byte(int r, int c) { const int st = (r >> 4) * 2 + (c >> 5), rr = r & 15, cc = c & 31, ob = rr * 64 + cc * 2; return st * 1024 + (ob ^ (((ob >> 9) & 1) << 5)); }
__host__ __device__ __forceinline__ void stage_rc(int b, int& R, int& C) { const int st = b / 1024, sb = b % 1024, swz = sb ^ (((sb >> 9) & 1) << 5); R = (st >> 1) * 16 + swz / 64; C = (st & 1) * 32 + (swz % 64) / 2; }
__host__ __device__ __forceinline__ int perm32(int rho) { const int n = rho >> 4, i = rho & 15; return 8 * (i >> 2) + 4 * n + (i & 3); }

struct Unit { const char* A; const char* B; int pm, pn; };

__device__ __forceinline__ bool static_tile(int i, int G, int c, int nM, int nN, int& pm, int& pn) {
    const int nwg = nM * nN; const long L = (long)i * G + c; if (L >= nwg) return false;
    int wgid = (int)L; { const int q = nwg / NXCD, r = nwg % NXCD, xcd = wgid % NXCD, off = wgid / NXCD; wgid = (xcd < r ? xcd * (q + 1) : r * (q + 1) + (xcd - r) * q) + off; }
    const int nig = WGM * nN, gid = wgid / nig, fm = gid * WGM, gsz = (nM - fm) < WGM ? (nM - fm) : WGM;
    pm = fm + ((wgid % nig) % gsz); pn = (wgid % nig) / gsz; return true;
}
struct PlainSched {
    const char* A; const char* Bt; int nM, nN, K, G, c;
    __device__ __forceinline__ bool next(int i, Unit& u) const {
        int pm, pn; if (!static_tile(i, G, c, nM, nN, pm, pn)) return false;
        u.pm = pm; u.pn = pn; u.A = A + (size_t)pm * 256 * K * 2; u.B = Bt + (size_t)pn * 256 * K * 2; return true;
    }
};
struct MoeSched {
    const char* A; const char* W; int tpe, nN, K, bN, G, c;
    __device__ __forceinline__ bool next(int i, Unit& u) const {
        int pm, pn; if (!static_tile(i, G, c, NE * tpe, nN, pm, pn)) return false;
        const int e = pm / tpe, rt = pm - e * tpe;
        u.pm = e * (SLOTS_E / 256) + rt; u.pn = pn;
        u.A = A + (size_t)u.pm * 256 * K * 2; u.B = W + ((size_t)e * bN + (size_t)pn * 256) * K * 2; return true;
    }
};

__device__ __forceinline__ unsigned cvt_pk_bf16(float lo, float hi) { return pk2(lo, hi); }


struct EpiBf16 {
    static constexpr bool PERM = true;
    bf16_t* O; int ldc; int nscale; float scale;
    __device__ __forceinline__ void operator()(const f32x4 (&acc)[2][2][4][2], const Unit& u, int wr, int wc, int fr, int fq) const {
        const int row0 = u.pm * BM + wr * 64 + fr, col0 = u.pn * BM + wc * 32 + 8 * fq;
        const float s = (u.pn < nscale) ? scale : 1.f;
#pragma unroll
        for (int ai = 0; ai < 2; ++ai)
#pragma unroll
            for (int m = 0; m < 4; ++m) { bf16_t* rowp = O + (size_t)(row0 + ai * HALF + m * 16) * ldc + col0;
#pragma unroll
                for (int bj = 0; bj < 2; ++bj) { const f32x4 v0 = acc[ai][bj][m][0] * s, v1 = acc[ai][bj][m][1] * s;
                    u32x4 o; o.x = cvt_pk_bf16(v0[0], v0[1]); o.y = cvt_pk_bf16(v0[2], v0[3]); o.z = cvt_pk_bf16(v1[0], v1[1]); o.w = cvt_pk_bf16(v1[2], v1[3]);
                    *(u32x4*)(rowp + bj * HALF) = o; } }
    }
};
struct EpiResid {
    static constexpr bool PERM = false;
    const float* srcL; const float* srcC; float* dstL; float* dstC; const float* gate;
    __device__ __forceinline__ void operator()(const f32x4 (&acc)[2][2][4][2], const Unit& u, int wr, int wc, int fr, int fq) const {
        const bool isc = u.pm >= RL / 256;
        const int mi = isc ? NB : (u.pm >> 4);
        const int rbase = (isc ? (u.pm - RL / 256) : u.pm) * BM + wr * 64 + fr, col0 = u.pn * BM + wc * 32 + 4 * fq;
        const float* src = isc ? srcC : srcL; float* dst = isc ? dstC : dstL;
        const float* gp = gate + (size_t)mi * 6 * D + col0;
        f32x4 gv[2][2];
#pragma unroll
        for (int bj = 0; bj < 2; ++bj)
#pragma unroll
            for (int n = 0; n < 2; ++n) gv[bj][n] = *(const f32x4*)(gp + bj * HALF + n * 16);
#pragma unroll
        for (int ai = 0; ai < 2; ++ai)
#pragma unroll
            for (int m = 0; m < 4; ++m) { const size_t ro = (size_t)(rbase + ai * HALF + m * 16) * D + col0;
#pragma unroll
                for (int bj = 0; bj < 2; ++bj)
#pragma unroll
                    for (int n = 0; n < 2; ++n) { const f32x4 xv = *(const f32x4*)(src + ro + bj * HALF + n * 16);
                        *(f32x4*)(dst + ro + bj * HALF + n * 16) = xv + gv[bj][n] * acc[ai][bj][m][n]; } }
    }
};
struct EpiSwiglu {
    static constexpr bool PERM = true;
    void* O; float ds; bool f8out;
    __device__ __forceinline__ void operator()(const f32x4 (&acc)[2][2][4][2], const Unit& u, int wr, int wc, int fr, int fq) const {
        const int row0 = u.pm * BM + wr * 64 + fr, col0 = u.pn * HALF + wc * 32 + 8 * fq;
#pragma unroll
        for (int ai = 0; ai < 2; ++ai)
#pragma unroll
            for (int m = 0; m < 4; ++m) { const size_t ro = (size_t)(row0 + ai * HALF + m * 16) * D + col0;
                float r[8];
#pragma unroll
                for (int n = 0; n < 2; ++n)
#pragma unroll
                    for (int j = 0; j < 4; ++j) { const float g = acc[ai][0][m][n][j] * ds, up = acc[ai][1][m][n][j] * ds; r[n * 4 + j] = g * fast_rcp(1.f + fast_exp(-g)) * up; }
                if (f8out) { u32x2 o; o.x = pk_fp8x4(r[0] * FP8_SA, r[1] * FP8_SA, r[2] * FP8_SA, r[3] * FP8_SA); o.y = pk_fp8x4(r[4] * FP8_SA, r[5] * FP8_SA, r[6] * FP8_SA, r[7] * FP8_SA);
                    *(u32x2*)((unsigned char*)O + ro) = o; }
                else { u32x4 o; o.x = cvt_pk_bf16(r[0], r[1]); o.y = cvt_pk_bf16(r[2], r[3]); o.z = cvt_pk_bf16(r[4], r[5]); o.w = cvt_pk_bf16(r[6], r[7]);
                    *(u32x4*)((bf16_t*)O + ro) = o; } }
    }
};
struct EpiRowScale {
    static constexpr bool PERM = true;
    bf16_t* O; const float* g; float ds;
    __device__ __forceinline__ void operator()(const f32x4 (&acc)[2][2][4][2], const Unit& u, int wr, int wc, int fr, int fq) const {
        const int row0 = u.pm * BM + wr * 64 + fr, col0 = u.pn * BM + wc * 32 + 8 * fq;
#pragma unroll
        for (int ai = 0; ai < 2; ++ai)
#pragma unroll
            for (int m = 0; m < 4; ++m) { const int row = row0 + ai * HALF + m * 16; const float s = g[row] * ds; bf16_t* rowp = O + (size_t)row * D + col0;
#pragma unroll
                for (int bj = 0; bj < 2; ++bj) { const f32x4 v0 = acc[ai][bj][m][0] * s, v1 = acc[ai][bj][m][1] * s;
                    u32x4 o; o.x = cvt_pk_bf16(v0[0], v0[1]); o.y = cvt_pk_bf16(v0[2], v0[3]); o.z = cvt_pk_bf16(v1[0], v1[1]); o.w = cvt_pk_bf16(v1[2], v1[3]);
                    *(u32x4*)(rowp + bj * HALF) = o; } }
    }
};

template <class Epi, class Sched, bool GATHER = false, bool FP8 = false>
__device__ __forceinline__ void gemm_phase(LAS unsigned char* lds, const int tid, const int K, const Sched& S, const Epi& E, const int* rowidx = nullptr) {
    const int wid = __builtin_amdgcn_readfirstlane(tid >> 6), lane = tid & 63, wr = wid >> 2, wc = wid & 3, fr = lane & 15, fq = lane >> 4;
    const int nt = K / BK;
    unsigned voffA[2], voffB[2]; int gR[2], gC[2];
#pragma unroll
    for (int i = 0; i < 2; ++i) { int R, C; stage_rc(tid * 16 + i * 8192, R, C); const int Rb = Epi::PERM ? ((R & ~31) + perm32(R & 31)) : R;
        voffA[i] = (unsigned)(R * K + C) * 2u; voffB[i] = (unsigned)(Rb * K + C) * 2u; gR[i] = R; gC[i] = C * 2; }
    unsigned gcur[2][2], gnxt[2][2];
#define PG8_GIDX(dst, unit) do { if (GATHER) { _Pragma("unroll") for (int h_ = 0; h_ < 2; ++h_) _Pragma("unroll") for (int i_ = 0; i_ < 2; ++i_) \
        dst[h_][i_] = (unsigned)rowidx[(unit).pm * 256 + h_ * 128 + gR[i_]] * (unsigned)(K * 2) + (unsigned)gC[i_]; } } while (0)
    const size_t kstep = (size_t)(BK * 2);
    const size_t hstep = (size_t)HALF * K * 2;
    const unsigned ldsw = (unsigned)wid * 1024u;
    const int aoff = lds_byte(wr * 64 + fr, fq * 8), boff = lds_byte(wc * 32 + fr, fq * 8);
#define PG8_SA(b, h) (((b) * 2 + (h)) * HTB)
#define PG8_SB(b, h) ((4 + (b) * 2 + (h)) * HTB)
#define PG8_STAGE(bufoff, gbase, voff) do { _Pragma("unroll") for (int _i = 0; _i < 2; ++_i) \
        __builtin_amdgcn_global_load_lds((const unsigned*)((const char*)(gbase) + (voff)[_i]), (LAS unsigned*)(lds + (bufoff) + ldsw + _i * 8192), 16, 0, 0); } while (0)
#define PG8_STAGE_A(b, h, gbase, NX) do { if (GATHER) { unsigned go_[2]; go_[0] = (NX) ? gnxt[h][0] : gcur[h][0]; go_[1] = (NX) ? gnxt[h][1] : gcur[h][1]; PG8_STAGE(PG8_SA(b, h), (gbase), go_); } \
        else { PG8_STAGE(PG8_SA(b, h), (gbase) + (h) * hstep, voffA); } } while (0)
#define PG8_LDA(dst, b, h) do { _Pragma("unroll") for (int m = 0; m < 4; ++m) _Pragma("unroll") for (int k = 0; k < 2; ++k) dst[m][k] = *(const LAS bf16x8*)(lds + PG8_SA(b, h) + aoff + m * 2048 + k * 1024); } while (0)
#define PG8_LDB(dst, b, h) do { _Pragma("unroll") for (int n = 0; n < 2; ++n) _Pragma("unroll") for (int k = 0; k < 2; ++k) dst[n][k] = *(const LAS bf16x8*)(lds + PG8_SB(b, h) + boff + n * 2048 + k * 1024); } while (0)
#define PG8_MMA(ai, bj, At, Bt) do { __builtin_amdgcn_s_setprio(1); if (FP8) { _Pragma("unroll") for (int m = 0; m < 4; ++m) _Pragma("unroll") for (int n = 0; n < 2; ++n) { \
            typedef int v8i_ __attribute__((ext_vector_type(8))); typedef int v4i_ __attribute__((ext_vector_type(4))); \
            const v4i_ b0_ = __builtin_bit_cast(v4i_, Bt[n][0]), b1_ = __builtin_bit_cast(v4i_, Bt[n][1]), a0_ = __builtin_bit_cast(v4i_, At[m][0]), a1_ = __builtin_bit_cast(v4i_, At[m][1]); \
            const v8i_ bb_ = {b0_[0], b0_[1], b0_[2], b0_[3], b1_[0], b1_[1], b1_[2], b1_[3]}, aa_ = {a0_[0], a0_[1], a0_[2], a0_[3], a1_[0], a1_[1], a1_[2], a1_[3]}; \
            asm volatile("v_mfma_scale_f32_16x16x128_f8f6f4 %0, %1, %2, %0, %3, %3 op_sel_hi:[0,0,0]" : "+v"(acc[ai][bj][m][n]) : "v"(bb_), "v"(aa_), "v"(sc127)); } } \
        else { _Pragma("unroll") for (int m = 0; m < 4; ++m) _Pragma("unroll") for (int n = 0; n < 2; ++n) _Pragma("unroll") for (int k = 0; k < 2; ++k) \
        acc[ai][bj][m][n] = __builtin_amdgcn_mfma_f32_16x16x32_bf16(Bt[n][k], At[m][k], acc[ai][bj][m][n], 0, 0, 0); } __builtin_amdgcn_s_setprio(0); } while (0)
#define PG8_WAIT_V(n) asm volatile("s_waitcnt vmcnt(" #n ")" ::: "memory")
#define PG8_WAIT_L(n) asm volatile("s_waitcnt lgkmcnt(" #n ")" ::: "memory")
#define PG8_BAR __builtin_amdgcn_s_barrier()
#define PG8_SCHED __builtin_amdgcn_sched_barrier(0)
    Unit cur, nxt; int ui = 0;
    if (!S.next(0, cur)) return;
    int sc127 = 0x7F7F7F7F; asm volatile("" : "+v"(sc127));
    f32x4 acc[2][2][4][2];
#pragma unroll
    for (int a = 0; a < 2; ++a)
#pragma unroll
        for (int b = 0; b < 2; ++b)
#pragma unroll
            for (int m = 0; m < 4; ++m)
#pragma unroll
                for (int n = 0; n < 2; ++n) acc[a][b][m][n] = (f32x4){0.f, 0.f, 0.f, 0.f};
    bf16x8 At[4][2], B0[2][2], B1[2][2];
    const char* cA = GATHER ? S.A : cur.A; const char* cB = cur.B;
    PG8_GIDX(gcur, cur);
    PG8_STAGE(PG8_SB(0, 0), cB, voffB); PG8_STAGE(PG8_SB(0, 1), cB + hstep, voffB); PG8_STAGE_A(0, 0, cA, false); PG8_STAGE_A(0, 1, cA, false);
    if (wr == 1) PG8_BAR;
    PG8_WAIT_V(2); PG8_BAR;
    PG8_STAGE(PG8_SB(1, 0), cB + kstep, voffB); PG8_STAGE_A(1, 0, cA + kstep, false); PG8_STAGE(PG8_SB(1, 1), cB + hstep + kstep, voffB);
    PG8_WAIT_V(6); PG8_BAR;
    for (;;) {
        const bool has_next = S.next(ui + 1, nxt);
        const char* nA = (has_next && !GATHER) ? nxt.A : cA; const char* nB = has_next ? nxt.B : cB;
        if (GATHER) { if (has_next) { PG8_GIDX(gnxt, nxt); } else { _Pragma("unroll") for (int h_ = 0; h_ < 2; ++h_) { gnxt[h_][0] = gcur[h_][0]; gnxt[h_][1] = gcur[h_][1]; } } }
#pragma unroll 1
        for (int t = 0; t < nt; t += 2) {
            const bool last = (t == nt - 2);
            const char* a1 = cA + (size_t)(t + 1) * kstep;
            const char* a2 = last ? nA : cA + (size_t)(t + 2) * kstep; const char* b2 = last ? nB : cB + (size_t)(t + 2) * kstep;
            const char* a3 = a2 + kstep; const char* b3 = b2 + kstep;
            PG8_LDB(B0, 0, 0); PG8_LDB(B1, 0, 1); PG8_SCHED; PG8_LDA(At, 0, 0); PG8_STAGE_A(1, 1, a1, false);
            PG8_WAIT_V(8); PG8_WAIT_L(0); PG8_BAR; PG8_MMA(0, 0, At, B0); PG8_MMA(0, 1, At, B1); PG8_BAR; PG8_SCHED;
            PG8_LDA(At, 0, 1); PG8_STAGE(PG8_SB(0, 0), b2, voffB); PG8_STAGE(PG8_SB(0, 1), b2 + hstep, voffB); PG8_STAGE_A(0, 0, a2, last);
            PG8_WAIT_V(8); PG8_WAIT_L(0); PG8_BAR; PG8_MMA(1, 0, At, B0); PG8_MMA(1, 1, At, B1); PG8_BAR; PG8_SCHED;
            PG8_LDB(B0, 1, 0); PG8_LDB(B1, 1, 1); PG8_SCHED; PG8_LDA(At, 1, 0); PG8_STAGE_A(0, 1, a2, last);
            PG8_WAIT_V(8); PG8_WAIT_L(0); PG8_BAR; PG8_MMA(0, 0, At, B0); PG8_MMA(0, 1, At, B1); PG8_BAR; PG8_SCHED;
            PG8_LDA(At, 1, 1); PG8_STAGE(PG8_SB(1, 0), b3, voffB); PG8_STAGE(PG8_SB(1, 1), b3 + hstep, voffB); PG8_STAGE_A(1, 0, a3, last);
            PG8_WAIT_V(8); PG8_WAIT_L(0); PG8_BAR; PG8_MMA(1, 0, At, B0); PG8_MMA(1, 1, At, B1); PG8_BAR; PG8_SCHED;
        }
        if (wr == 0) PG8_BAR;
        if (FP8) asm volatile("s_nop 15\n\ts_nop 15" ::: "memory");
        { int tz = tid; asm volatile("" : "+v"(tz));
          const int wid2 = __builtin_amdgcn_readfirstlane(tz >> 6), lane2 = tz & 63;
          E(acc, cur, wid2 >> 2, wid2 & 3, lane2 & 15, lane2 >> 4); }
        if (!has_next) break;
#pragma unroll
        for (int a = 0; a < 2; ++a)
#pragma unroll
            for (int b = 0; b < 2; ++b)
#pragma unroll
                for (int m = 0; m < 4; ++m)
#pragma unroll
                    for (int n = 0; n < 2; ++n) acc[a][b][m][n] = (f32x4){0.f, 0.f, 0.f, 0.f};
        cur = nxt; cA = nA; cB = nB; ++ui;
        if (GATHER) { _Pragma("unroll") for (int h_ = 0; h_ < 2; ++h_) { gcur[h_][0] = gnxt[h_][0]; gcur[h_][1] = gnxt[h_][1]; } }
        if (wr == 1) PG8_BAR;
    }
    PG8_WAIT_V(0);
    PG8_BAR;
#undef PG8_SA
#undef PG8_SB
#undef PG8_STAGE
#undef PG8_STAGE_A
#undef PG8_GIDX
#undef PG8_LDA
#undef PG8_LDB
#undef PG8_MMA
#undef PG8_WAIT_V
#undef PG8_WAIT_L
#undef PG8_BAR
#undef PG8_SCHED
}
}
namespace attn_body {
constexpr int NW = 8, QBLK = 32, QB = QBLK * NW, KVBLK = 64;
__device__ __forceinline__ int crow(int r, int hi) { return (r & 3) + 8 * (r >> 2) + 4 * hi; }
#define SBAR() __builtin_amdgcn_sched_barrier(0)
constexpr int NSLOT = 3, SLOTB = 8192;
constexpr int LDS_K = 0, LDS_V = NSLOT * SLOTB, LDS_WS = 2 * NSLOT * SLOTB, LDS_OST = LDS_WS + NW * 64 * 4, LDS_BYTES = LDS_OST + NW * 4096;
constexpr float C2 = 0.125f * 1.4426950408889634f;
__device__ __forceinline__ void glds16(const void* gsrc, unsigned lds_dst) { unsigned keep;
  asm volatile("s_mov_b32 %0, m0\n\ts_mov_b32 m0, %2\n\ts_nop 0\n\tglobal_load_lds_dwordx4 %1, off\n\ts_mov_b32 m0, %0" : "=&s"(keep) : "v"(gsrc), "s"(lds_dst) : "memory"); }
__device__ __forceinline__ float max3f(float a, float b, float c) { float r; asm("v_max3_f32 %0, %1, %2, %3" : "=v"(r) : "v"(a), "v"(b), "v"(c)); return r; }
__device__ __forceinline__ float max2f(float a, float b) { float r; asm("v_max_f32_e32 %0, %1, %2" : "=v"(r) : "v"(a), "v"(b)); return r; }
__device__ __forceinline__ float fadd_s(float a, float b) { float r; asm("v_add_f32_e32 %0, %1, %2" : "=v"(r) : "v"(a), "v"(b)); return r; }
__device__ __forceinline__ float fsub_s(float a, float b) { float r; asm("v_sub_f32_e32 %0, %1, %2" : "=v"(r) : "v"(a), "v"(b)); return r; }
__device__ __forceinline__ unsigned cvtpk_s(float lo, float hi) { f32x2 v = {lo, hi}; bf16x2_t b = __builtin_convertvector(v, bf16x2_t); return __builtin_bit_cast(unsigned, b); }
#define WAIT_BAR(N) asm volatile("s_waitcnt vmcnt(" #N ") lgkmcnt(0)\n\ts_barrier" ::: "memory")

__device__ __forceinline__ void qkt(f32x16& p0, f32x16& p1, const char* Kslot, const bf16x8* qr, const f32x16& negm, int r32, int hi) {
  const char* kb = Kslot + hi * 1024 + r32 * 16;
  #pragma unroll
  for (int d0 = 0; d0 < 4; ++d0) {
    const bf16x8 b0 = *reinterpret_cast<const bf16x8*>(kb + d0 * 2048);
    const bf16x8 b1 = *reinterpret_cast<const bf16x8*>(kb + d0 * 2048 + 512);
    if (d0 == 0) { p0 = __builtin_amdgcn_mfma_f32_32x32x16_bf16(b0, qr[0], negm, 0, 0, 0); p1 = __builtin_amdgcn_mfma_f32_32x32x16_bf16(b1, qr[0], negm, 0, 0, 0); }
    else { p0 = __builtin_amdgcn_mfma_f32_32x32x16_bf16(b0, qr[d0], p0, 0, 0, 0); p1 = __builtin_amdgcn_mfma_f32_32x32x16_bf16(b1, qr[d0], p1, 0, 0, 0); } }
}
typedef __attribute__((address_space(3))) const char* lds_cptr;
typedef short v4i16_t __attribute__((ext_vector_type(4)));
__device__ __forceinline__ void kload8(bf16x8* kf, lds_cptr kp) {
  kf[0] = *(const LAS bf16x8*)(kp);        kf[1] = *(const LAS bf16x8*)(kp + 512);
  kf[2] = *(const LAS bf16x8*)(kp + 2048); kf[3] = *(const LAS bf16x8*)(kp + 2560);
  kf[4] = *(const LAS bf16x8*)(kp + 4096); kf[5] = *(const LAS bf16x8*)(kp + 4608);
  kf[6] = *(const LAS bf16x8*)(kp + 6144); kf[7] = *(const LAS bf16x8*)(kp + 6656);
}
__device__ __forceinline__ void kload2(bf16x8* kf, lds_cptr kp, int j) { kf[2 * j] = *(const LAS bf16x8*)(kp + j * 2048); kf[2 * j + 1] = *(const LAS bf16x8*)(kp + j * 2048 + 512); }
__device__ __forceinline__ s16x4 vtr(lds_cptr p) { return __builtin_bit_cast(s16x4, __builtin_amdgcn_ds_read_tr16_b64_v4i16((LAS v4i16_t*)p)); }
__device__ __forceinline__ float rowmax(const f32x16& p0, const f32x16& p1) {
  float a = max3f(p0[0], p0[1], p1[0]), b = max3f(p0[2], p0[3], p1[1]); a = max3f(a, p1[2], p1[3]);
  #pragma unroll
  for (int r = 4; r < 16; r += 4) { a = max3f(a, p0[r], p0[r + 1]); b = max3f(b, p0[r + 2], p0[r + 3]); a = max3f(a, p1[r], p1[r + 1]); b = max3f(b, p1[r + 2], p1[r + 3]); }
  const float m = max2f(a, b);
  auto rr = __builtin_amdgcn_permlane32_swap(__float_as_uint(m), __float_as_uint(m), false, false);
  return max2f(__uint_as_float(rr[0]), __uint_as_float(rr[1]));
}
__device__ __forceinline__ void pv(f32x16* o, int vb, bf16x8 pa0, bf16x8 pa1, bf16x8 pa2, bf16x8 pa3) {
  #pragma unroll
  for (int d0 = 0; d0 < 2; ++d0) { s16x4 lo[4], hi[4];
    #pragma unroll
    for (int ks = 0; ks < 4; ++ks) {
      asm volatile("ds_read_b64_tr_b16 %0,%1 offset:%c2" : "=&v"(lo[ks]) : "v"(vb), "i"(d0 * 4096 + ks * 1024) : "memory");
      asm volatile("ds_read_b64_tr_b16 %0,%1 offset:%c2" : "=&v"(hi[ks]) : "v"(vb), "i"(d0 * 4096 + ks * 1024 + 512) : "memory"); }
    asm volatile("s_waitcnt lgkmcnt(0)" ::: "memory"); SBAR();
    #define PK(k) (bf16x8){lo[k][0], lo[k][1], lo[k][2], lo[k][3], hi[k][0], hi[k][1], hi[k][2], hi[k][3]}
    o[d0] = __builtin_amdgcn_mfma_f32_32x32x16_bf16(pa0, PK(0), o[d0], 0, 0, 0);
    o[d0] = __builtin_amdgcn_mfma_f32_32x32x16_bf16(pa1, PK(1), o[d0], 0, 0, 0);
    o[d0] = __builtin_amdgcn_mfma_f32_32x32x16_bf16(pa2, PK(2), o[d0], 0, 0, 0);
    o[d0] = __builtin_amdgcn_mfma_f32_32x32x16_bf16(pa3, PK(3), o[d0], 0, 0, 0);
    #undef PK
  }
}

template <int THRL> __device__ __forceinline__ void attn_unit(const bf16_t* Qrow0, int QP, const bf16_t* __restrict__ Kh, const bf16_t* __restrict__ Vh, int KVP, int NT, bf16_t* Orow0, int OP, char* shm, const int tid) {
  const int lane = tid & 63, r32 = lane & 31, hi = lane >> 5; const int wid = __builtin_amdgcn_readfirstlane(tid >> 6);
  const bf16_t* Qw = Qrow0 + (long)(wid * QBLK) * QP;
  const unsigned lds0 = (unsigned)(uintptr_t)shm;
  float* wsf = (float*)(shm + LDS_WS) + wid * 64;
  const bf16_t* ksrc = Kh + (long)lane * KVP + wid * 8;
  const bf16_t* vsrc = Vh + (long)(16 * (wid & 3) + (lane >> 2)) * KVP + (wid >> 2) * 32 + (lane & 3) * 8;
  const unsigned kdst = lds0 + LDS_K + wid * 1024, vdst = lds0 + LDS_V + wid * 1024;
  #define DMA_K(t, slot) glds16(ksrc + (long)(t) * KVBLK * KVP, (unsigned)__builtin_amdgcn_readfirstlane(kdst + (slot)))
  #define DMA_V(t, slot) glds16(vsrc + (long)(t) * KVBLK * KVP, (unsigned)__builtin_amdgcn_readfirstlane(vdst + (slot)))
  const int vb0 = (int)(lds0 + LDS_V) + ((lane >> 4) & 1) * 32 + (lane & 3) * 8 + (4 * hi + ((lane & 15) >> 2)) * 64;
  const char* Kbase = shm + LDS_K; bf16x8 kf[8];
  const lds_cptr shm3 = (lds_cptr)shm; const lds_cptr kp0 = shm3 + LDS_K + hi * 1024 + r32 * 16; const lds_cptr vp0 = shm3 + LDS_V + ((lane >> 4) & 1) * 32 + (lane & 3) * 8 + (4 * hi + ((lane & 15) >> 2)) * 64;
  DMA_K(0, 0); DMA_V(0, 0); DMA_K(1, SLOTB);
  bf16x8 qr[4];
  #pragma unroll
  for (int d0 = 0; d0 < 4; ++d0) qr[d0] = *reinterpret_cast<const bf16x8*>(&Qw[(long)r32 * QP + d0 * 16 + hi * 8]);
  float mhat = 0.f, l_reg = 0.f; f32x16 o[2]; o[0] = f32x16{}; o[1] = f32x16{}; f32x16 negm = f32x16{}; asm volatile("" : "+v"(negm));
  bool resc = false;
  #define START(P0, P1) do { const float rm = rowmax(P0, P1); resc = false; \
    { const float dl = rm; mhat = fadd_s(mhat, dl); \
      _Pragma("unroll") for (int r = 0; r < 16; ++r) { P0[r] = fsub_s(P0[r], dl); P1[r] = fsub_s(P1[r], dl); } \
      _Pragma("unroll") for (int r = 0; r < 16; ++r) negm[r] = -mhat; asm volatile("" : "+v"(negm)); } \
    _Pragma("unroll") for (int r = 0; r < 16; ++r) P0[r] = __builtin_amdgcn_exp2f(P0[r]); } while (0)
  #define RESC() do { if (resc) { asm volatile("s_waitcnt lgkmcnt(0)" ::: "memory"); \
      _Pragma("unroll") for (int d_ = 0; d_ < 2; ++d_) _Pragma("unroll") for (int r = 0; r < 16; ++r) o[d_][r] *= wsf[crow(r, hi)]; } } while (0)
  f32x16 pA0, pA1, pB0, pB1;
  int sl_prev = 0, sl_cur = 0, sl_next = SLOTB;
  #define ROT() do { sl_prev = sl_cur; sl_cur = sl_next; sl_next = (sl_next == (NSLOT - 1) * SLOTB) ? 0 : sl_next + SLOTB; } while (0)
  DMA_K(2, 2 * SLOTB);
  WAIT_BAR(3);
  qkt(pA0, pA1, Kbase, qr, negm, r32, hi); asm volatile("s_nop 15\n\ts_nop 7" : "+v"(pA0), "+v"(pA1));
  START(pA0, pA1);
  _Pragma("unroll") for (int r = 0; r < 16; ++r) pA1[r] = __builtin_amdgcn_exp2f(pA1[r]);
  WAIT_BAR(0);
  DMA_K(3, 0); DMA_V(1, SLOTB);
  ROT();
  kload8(kf, kp0 + sl_cur);
  WAIT_BAR(2);
  s16x4 vlo[8], vhi[8]; u32x4 pw0, pw1, pw2, pw3;
  #define PKW(P, B) cvtpk_s(P[B], P[B + 1])
  #define PAF(k) __builtin_bit_cast(bf16x8, pw##k)
  #define VFR(i) (bf16x8){vlo[i][0], vlo[i][1], vlo[i][2], vlo[i][3], vhi[i][0], vhi[i][1], vhi[i][2], vhi[i][3]}
  #define PIN(x) asm volatile("" : "+v"(x))
  #define MX3(a, b, c) __builtin_fmaxf(__builtin_fmaxf((a), (b)), (c))
  #define GAPA(MF, A0, A1, A2, A3, W0, W1, PW) do { MF; sacc += A0; sacc += A1; sacc += A2; sacc += A3; PIN(sacc); W0; W1; PIN(PW); SBAR(); } while (0)
  #define EX(v) __builtin_amdgcn_exp2f(v)
  #define GAPB(MF, X, B) do { MF; X[B] = EX(X[B]); X[B + 1] = EX(X[B + 1]); X[B + 2] = EX(X[B + 2]); X[B + 3] = EX(X[B + 3]); PIN(X); SBAR(); } while (0)
  #define VRD(i) do { vlo[i] = vtr(vp_ + (((i) >> 2) * 4096 + ((i) & 3) * 1024)); vhi[i] = vtr(vp_ + (((i) >> 2) * 4096 + ((i) & 3) * 1024 + 512)); } while (0)
  #define KRD(G, j) do { if (G) { kload2(kf, kp0 + sl_next, j); SBAR(); } } while (0)
  #define STEP(C0, C1, P0, P1, t, GK, GV, GL) do { SBAR(); \
    const lds_cptr vp_ = vp0 + sl_prev; \
    VRD(0); SBAR(); float sacc = (P0[0] + P0[1]); \
    GAPA(C0 = __builtin_amdgcn_mfma_f32_32x32x16_bf16(kf[0], qr[0], negm, 0, 0, 0), P0[2], P0[3], P0[4], P0[5],     pw0[0] = PKW(P0, 0), pw0[1] = PKW(P0, 2), pw0); \
    VRD(4); SBAR(); GAPA(C1 = __builtin_amdgcn_mfma_f32_32x32x16_bf16(kf[1], qr[0], negm, 0, 0, 0), P0[6], P0[7], P0[8], P0[9],     pw0[2] = PKW(P0, 4), pw0[3] = PKW(P0, 6), pw0); \
    VRD(1); SBAR(); GAPA(C0 = __builtin_amdgcn_mfma_f32_32x32x16_bf16(kf[2], qr[1], C0, 0, 0, 0),   P0[10], P0[11], P0[12], P0[13], pw1[0] = PKW(P0, 8), pw1[1] = PKW(P0, 10), pw1); \
    VRD(5); SBAR(); GAPA(C1 = __builtin_amdgcn_mfma_f32_32x32x16_bf16(kf[3], qr[1], C1, 0, 0, 0),   P0[14], P0[15], P1[0], P1[1],   pw1[2] = PKW(P0, 12), pw1[3] = PKW(P0, 14), pw1); \
    VRD(2); SBAR(); GAPA(C0 = __builtin_amdgcn_mfma_f32_32x32x16_bf16(kf[4], qr[2], C0, 0, 0, 0),   P1[2], P1[3], P1[4], P1[5],     pw2[0] = PKW(P1, 0), pw2[1] = PKW(P1, 2), pw2); \
    VRD(6); SBAR(); GAPA(C1 = __builtin_amdgcn_mfma_f32_32x32x16_bf16(kf[5], qr[2], C1, 0, 0, 0),   P1[6], P1[7], P1[8], P1[9],     pw2[2] = PKW(P1, 4), pw2[3] = PKW(P1, 6), pw2); \
    VRD(3); SBAR(); GAPA(C0 = __builtin_amdgcn_mfma_f32_32x32x16_bf16(kf[6], qr[3], C0, 0, 0, 0),   P1[10], P1[11], P1[12], P1[13], pw3[0] = PKW(P1, 8), pw3[1] = PKW(P1, 10), pw3); \
    VRD(7); SBAR(); GAPA(C1 = __builtin_amdgcn_mfma_f32_32x32x16_bf16(kf[7], qr[3], C1, 0, 0, 0),   P1[14], P1[15], 0.f, 0.f,       pw3[2] = PKW(P1, 12), pw3[3] = PKW(P1, 14), pw3); \
    l_reg += sacc; \
    if (GK) { DMA_K((t) + 3, sl_cur); } if (GV) { DMA_V((t) + 1, sl_next); } \
    { float a = MX3(C0[0], C0[1], C1[0]), b = MX3(C0[2], C0[3], C1[1]); a = MX3(a, C1[2], C1[3]); \
      _Pragma("unroll") for (int r = 4; r < 16; r += 4) { a = MX3(a, C0[r], C0[r + 1]); b = MX3(b, C0[r + 2], C0[r + 3]); a = MX3(a, C1[r], C1[r + 1]); b = MX3(b, C1[r + 2], C1[r + 3]); } \
      float rm = __builtin_fmaxf(a, b); { auto rr = __builtin_amdgcn_permlane32_swap(__float_as_uint(rm), __float_as_uint(rm), false, false); rm = __builtin_fmaxf(__uint_as_float(rr[0]), __uint_as_float(rr[1])); } \
      resc = false; \
      if (__builtin_expect(__any(rm > (float)THRL), 0)) { const float dl = __builtin_fmaxf(rm, 0.f); mhat += dl; \
        _Pragma("unroll") for (int r = 0; r < 16; ++r) { C0[r] -= dl; C1[r] -= dl; } \
        _Pragma("unroll") for (int r = 0; r < 16; ++r) negm[r] = -mhat; asm volatile("" : "+v"(negm)); \
        const float f = __builtin_amdgcn_exp2f(-dl); l_reg *= f; if (hi == 0) wsf[r32] = f; resc = true; } } \
    SBAR(); \
    GAPB(o[0] = __builtin_amdgcn_mfma_f32_32x32x16_bf16(PAF(0), VFR(0), o[0], 0, 0, 0), C0, 0); \
    GAPB(o[1] = __builtin_amdgcn_mfma_f32_32x32x16_bf16(PAF(0), VFR(4), o[1], 0, 0, 0), C0, 4); \
    KRD(GL, 0); GAPB(o[0] = __builtin_amdgcn_mfma_f32_32x32x16_bf16(PAF(1), VFR(1), o[0], 0, 0, 0), C0, 8); \
    KRD(GL, 1); GAPB(o[1] = __builtin_amdgcn_mfma_f32_32x32x16_bf16(PAF(1), VFR(5), o[1], 0, 0, 0), C0, 12); \
    KRD(GL, 2); GAPB(o[0] = __builtin_amdgcn_mfma_f32_32x32x16_bf16(PAF(2), VFR(2), o[0], 0, 0, 0), C1, 0); \
    KRD(GL, 3); GAPB(o[1] = __builtin_amdgcn_mfma_f32_32x32x16_bf16(PAF(2), VFR(6), o[1], 0, 0, 0), C1, 4); \
    GAPB(o[0] = __builtin_amdgcn_mfma_f32_32x32x16_bf16(PAF(3), VFR(3), o[0], 0, 0, 0), C1, 8); \
    GAPB(o[1] = __builtin_amdgcn_mfma_f32_32x32x16_bf16(PAF(3), VFR(7), o[1], 0, 0, 0), C1, 12); \
    } while (0)
  int t = 1;
  for (; t + 5 < NT; t += 2) {
    STEP(pB0, pB1, pA0, pA1, t, true, true, true);     WAIT_BAR(2); RESC(); ROT();
    STEP(pA0, pA1, pB0, pB1, t + 1, true, true, true); WAIT_BAR(2); RESC(); ROT();
  }
  #define ENDW(tt) do { if ((tt) + 3 < NT) { WAIT_BAR(2); } else if ((tt) + 2 < NT) { WAIT_BAR(1); } else { WAIT_BAR(0); } } while (0)
  for (; t + 1 < NT; t += 2) {
    STEP(pB0, pB1, pA0, pA1, t, (t + 3 < NT), (t + 1 < NT), (t + 1 < NT));         ENDW(t);     RESC(); ROT();
    STEP(pA0, pA1, pB0, pB1, t + 1, (t + 4 < NT), (t + 2 < NT), (t + 2 < NT));     ENDW(t + 1); RESC(); ROT();
  }
  STEP(pB0, pB1, pA0, pA1, NT - 1, false, false, false); RESC();
  { float sacc = pB0[0] + pB0[1]; _Pragma("unroll") for (int r = 2; r < 16; ++r) sacc += pB0[r]; _Pragma("unroll") for (int r = 0; r < 16; ++r) sacc += pB1[r]; l_reg += sacc;
    pw0 = (u32x4){PKW(pB0, 0), PKW(pB0, 2), PKW(pB0, 4), PKW(pB0, 6)}; pw1 = (u32x4){PKW(pB0, 8), PKW(pB0, 10), PKW(pB0, 12), PKW(pB0, 14)}; pw2 = (u32x4){PKW(pB1, 0), PKW(pB1, 2), PKW(pB1, 4), PKW(pB1, 6)}; pw3 = (u32x4){PKW(pB1, 8), PKW(pB1, 10), PKW(pB1, 12), PKW(pB1, 14)};
    SBAR(); pv(o, vb0 + sl_cur, PAF(0), PAF(1), PAF(2), PAF(3)); }
  #undef PKW
  #undef PAF
  #undef VFR
  #undef PIN
  #undef MX3
  #undef GAPA
  #undef GAPB
  #undef EX
  #undef VRD
  #undef KRD
  #undef STEP
  #undef ENDW
  { auto rr = __builtin_amdgcn_permlane32_swap(__float_as_uint(l_reg), __float_as_uint(l_reg), false, false); l_reg = __uint_as_float(rr[0]) + __uint_as_float(rr[1]); }
  if (hi == 0) wsf[32 + r32] = l_reg; asm volatile("s_waitcnt lgkmcnt(0)" ::: "memory");
  float rli[16];
  #pragma unroll
  for (int r = 0; r < 16; ++r) rli[r] = __builtin_amdgcn_rcpf(wsf[32 + crow(r, hi)]);
  bf16_t* Ow = Orow0 + (long)(wid * QBLK) * OP;
  { bf16_t* stg = (bf16_t*)(shm + LDS_OST) + wid * 2048;
    #pragma unroll
    for (int r = 0; r < 16; ++r) { const int orow = crow(r, hi);
      #pragma unroll
      for (int d0 = 0; d0 < 2; ++d0) stg[orow * 64 + d0 * 32 + r32] = (bf16_t)f2bf(o[d0][r] * rli[r]); }
    asm volatile("s_waitcnt lgkmcnt(0)" ::: "memory");
    #pragma unroll
    for (int i = 0; i < 4; ++i) { const int row = i * 8 + (lane >> 3), ch = lane & 7; const u32x4 v = *(const u32x4*)(stg + row * 64 + ch * 8); *(u32x4*)(Ow + (long)row * OP + ch * 8) = v; } }
  asm volatile("s_waitcnt lgkmcnt(0)\n\ts_barrier" ::: "memory");
  #undef DMA_K
  #undef DMA_V
  #undef START
  #undef RESC
  #undef ROT
}
#undef SBAR
#undef WAIT_BAR
}
struct Frame {
    LAS unsigned char* lds;
    int tid, lane, wave;
    int vcu, G, gw, NGW, bid;
    unsigned char* ws; const float* const* in;
};

__device__ __forceinline__ void transpose_item(const float* W, int ldw, int K, bf16_t* WT, int k0, int n0, int dst_row0, LAS float* scr, int lane) {
    float tv[32];
#pragma unroll
    for (int i = 0; i < 32; ++i) tv[i] = W[(size_t)(k0 + 2 * i + (lane >> 5)) * ldw + n0 + (lane & 31)];
#pragma unroll
    for (int i = 0; i < 32; ++i) scr[(2 * i + (lane >> 5)) * 33 + (lane & 31)] = tv[i];
    LDS_WAIT(); asm volatile("" ::: "memory");
    const int c = lane & 7;
#pragma unroll
    for (int j = 0; j < 4; ++j) { const int n = (lane >> 3) + 8 * j; const LAS float* s = scr + (8 * c) * 33 + n;
        u32x4 o; o.x = pk2(s[0 * 33], s[1 * 33]); o.y = pk2(s[2 * 33], s[3 * 33]); o.z = pk2(s[4 * 33], s[5 * 33]); o.w = pk2(s[6 * 33], s[7 * 33]);
        *(u32x4*)(WT + (size_t)(dst_row0 + n) * K + k0 + 8 * c) = o; }
    LDS_WAIT(); asm volatile("" ::: "memory");
}

__device__ __forceinline__ void sincos_acc(float x, float& s, float& c) {
    const float k = rintf(x * 0.63661977236758134f);
    float r = fmaf(k, -1.5703125f, x); r = fmaf(k, -4.837512969970703125e-4f, r); r = fmaf(k, -7.54978995489188e-8f, r);
    const float z = r * r;
    const float sp = r + r * z * fmaf(z, fmaf(z, -1.9515295891e-4f, 8.3321608736e-3f), -1.6666654611e-1f);
    const float cp = fmaf(z * z, fmaf(z, fmaf(z, 2.443315711809948e-5f, -1.388731625493765e-3f), 4.166664568298827e-2f), fmaf(z, -0.5f, 1.0f));
    const int q = ((int)k) & 3;
    const float ss = (q & 1) ? cp : sp, cc = (q & 1) ? sp : cp;
    s = (q & 2) ? -ss : ss; c = ((q + 1) & 2) ? -cc : cc;
}

__device__ __forceinline__ void p0_prologue(Frame& F, const float* const* in, unsigned char* ws) {
    const float* c_lat = in[1]; const float* c_ctx = in[3]; const float* w_mod = in[4]; const float* b_mod = in[5];
    LAS float* sil = (LAS float*)F.lds;
    for (int i = F.tid; i < NMI * D; i += NTHREADS) { const int mi = i >> 10, k = i & 1023; const float v = (mi < NB) ? c_lat[mi * D + k] : c_ctx[k]; sil[i] = silu_f(v); }
    __syncthreads();
    {
        float* modv = (float*)(ws + WS_MODV);
        const int NT16 = 6 * D / 16;
        for (int task = F.gw; task < DEPTH * NT16; task += F.NGW) {
            const int layer = task / NT16, j0 = (task % NT16) * 16, jj = F.lane & 15, kq = F.lane >> 4;
            const float* wp = w_mod + (size_t)layer * D * 6 * D + j0 + jj;
            float acc[NMI];
#pragma unroll
            for (int m = 0; m < NMI; ++m) acc[m] = 0.f;
            for (int k = kq; k < D; k += 4) { const float w = wp[(size_t)k * 6 * D];
#pragma unroll
                for (int m = 0; m < NMI; ++m) acc[m] = fmaf(sil[m * D + k], w, acc[m]); }
#pragma unroll
            for (int m = 0; m < NMI; ++m) { float v = acc[m]; v += __shfl_xor(v, 16); v += __shfl_xor(v, 32); acc[m] = v; }
            if (kq == 0) { const float bb = b_mod[layer * 6 * D + j0 + jj];
#pragma unroll
                for (int m = 0; m < NMI; ++m) modv[((size_t)layer * NMI + m) * 6 * D + j0 + jj] = acc[m] + bb; }
        }
    }
    __syncthreads();
    {
        LAS float* scr = (LAS float*)(F.lds) + F.wave * (64 * 33);
        constexpr int I_MI = 16 * 96, I_MO = 16 * 32, I_AI = 16 * 48, I_AO = 16 * 32;
        constexpr int PER_J = I_MI + I_MO + I_AI + I_AO;
        for (int it = F.gw; it < 2 * PER_J; it += F.NGW) {
            const int j = it / PER_J; int r = it % PER_J;
            if (r < I_MI) { const int kb = r / 96, nb = r % 96; transpose_item(in[8] + (size_t)j * D * MW_IN, MW_IN, D, (bf16_t*)(ws + WS_WMI) + (size_t)j * 3072 * D, 64 * kb, 32 * nb, 32 * nb, scr, F.lane); continue; } r -= I_MI;
            if (r < I_MO) { const int kb = r / 32, nb = r % 32; transpose_item(in[11] + (size_t)j * D * D, D, D, (bf16_t*)(ws + WS_WMO) + (size_t)j * D * D, 64 * kb, 32 * nb, 32 * nb, scr, F.lane); continue; } r -= I_MO;
            if (r < I_AI) { const int kb = r / 48, nb = r % 48; transpose_item(in[12] + (size_t)j * D * 1536, 1536, D, (bf16_t*)(ws + WS_WAI) + (size_t)j * 1536 * D, 64 * kb, 32 * nb, 32 * nb, scr, F.lane); continue; } r -= I_AI;
            { const int kb = r / 32, nb = r % 32; transpose_item(in[15] + (size_t)j * D * D, D, D, (bf16_t*)(ws + WS_WAO) + (size_t)j * D * D, 64 * kb, 32 * nb, 32 * nb, scr, F.lane); }
        }
    }
    {
        float* rc = (float*)(ws + WS_ROPE); float* rs = rc + SEQ * 32;
        for (int i = F.bid * NTHREADS + F.tid; i < SEQ * 32; i += F.G * NTHREADS) {
            const int t = i >> 5, p = i & 31; const float pos = (p < 16) ? (float)(t >> 6) : (float)(t & 63);
            const float inv = exp2f(-(float)(p & 15) * (13.287712379549449f / 16.f));
            float s, c; sincos_acc(pos * inv, s, c); rc[i] = c; rs[i] = s; }
    }
    __syncthreads();
}

__device__ __forceinline__ void moe_weights(Frame& F, const float* wg, const float* wu, const float* wd, unsigned char* ws) {
    LAS float* T = (LAS float*)F.lds;
    const int lane = F.lane, w = F.wave;
    bf16_t* W1 = (bf16_t*)(ws + WS_W1); bf16_t* W2 = (bf16_t*)(ws + WS_W2);
    unsigned char* W1b = (unsigned char*)(ws + WS_W1); unsigned char* W2b = (unsigned char*)(ws + WS_W2);
    constexpr int NIT = NE * 3 * 16 * 4;
#define MW_SRC(it_) (((((it_) % 192) / 64) == 0 ? wg : ((((it_) % 192) / 64) == 1 ? wu : wd)) + (size_t)((it_) / 192) * D * D + (size_t)(64 * ((((it_) % 192) % 64) >> 2)) * D + 256 * ((((it_) % 192) % 64) & 3))
    f32x4 v[8];
    int it = F.vcu;
    if (it < NIT) { const float* src = MW_SRC(it);
#pragma unroll
        for (int i = 0; i < 8; ++i) v[i] = *(const f32x4*)(src + (size_t)(8 * w + i) * D + 4 * lane); }
    for (; it < NIT; it += F.G) {
        __syncthreads();
#pragma unroll
        for (int i = 0; i < 8; ++i) *(LAS f32x4*)(T + (8 * w + i) * 256 + ((4 * lane) ^ (8 * (w & 3)))) = v[i];
        if (it + F.G < NIT) { const float* src = MW_SRC(it + F.G);
#pragma unroll
            for (int i = 0; i < 8; ++i) v[i] = *(const f32x4*)(src + (size_t)(8 * w + i) * D + 4 * lane); }
        __syncthreads();
        const int e = it / 192, r = it % 192, which = r / 64, kb = (r % 64) >> 2, nq = (r % 64) & 3;
        const int nl = lane & 7, c = lane >> 3;
        bf16_t* base = (which == 2) ? (W2 + (size_t)e * D * D) : (W1 + (size_t)e * 2048 * D);
#pragma unroll
        for (int j = 0; j < 4; ++j) { const int n = 32 * w + 8 * j + nl; const LAS float* tp = T + (8 * c) * 256 + (n ^ (8 * (c & 3)));
            float t[8];
#pragma unroll
            for (int i = 0; i < 8; ++i) t[i] = tp[i * 256];
            const int ng = 256 * nq + n; const int drow = (which == 2) ? ng : (256 * (ng >> 7) + (which == 1 ? 128 : 0) + (ng & 127));
            const bool f8 = (which == 2) ? (MOE_FP8_2 != 0) : (MOE_FP8_1 != 0);
            if (f8) { u32x2 o; o.x = pk_fp8x4(t[0] * FP8_SW, t[1] * FP8_SW, t[2] * FP8_SW, t[3] * FP8_SW); o.y = pk_fp8x4(t[4] * FP8_SW, t[5] * FP8_SW, t[6] * FP8_SW, t[7] * FP8_SW);
                unsigned char* b8 = (which == 2) ? (W2b + (size_t)e * D * D) : (W1b + (size_t)e * 2048 * D);
                *(u32x2*)(b8 + (size_t)drow * D + 64 * kb + 8 * c) = o; }
            else { u32x4 o; o.x = pk2(t[0], t[1]); o.y = pk2(t[2], t[3]); o.z = pk2(t[4], t[5]); o.w = pk2(t[6], t[7]);
                *(u32x4*)(base + (size_t)drow * D + 64 * kb + 8 * c) = o; } }
    }
#undef MW_SRC
    __syncthreads();
}

__device__ __forceinline__ void load_w16(Frame& F, const float* W16, int ldw16) {
    LAS float* wl = (LAS float*)F.lds;
    for (int i = F.tid; i < D * 16; i += NTHREADS) { const int c = i >> 4, e = i & 15; const int l = (c & 255) >> 2, q = (c & 3) + 4 * (c >> 8);
        wl[(q * 64 + l) * 20 + e] = W16[(size_t)c * ldw16 + e]; }
    __syncthreads();
}
template <int MODE, bool F8 = false>
__device__ __forceinline__ void norm_core(LAS float* wl, const int lane, f32x4 (&v)[4], const int r, const f32x4 (&gv)[4], const float* shp, const float* scp, bf16_t* H, const float* bias16, float* out16) {
    float ss = 0.f;
#pragma unroll
    for (int j = 0; j < 4; ++j) ss += (v[j].x * v[j].x + v[j].y * v[j].y) + (v[j].z * v[j].z + v[j].w * v[j].w);
    const float rstd = rsqrtf(wave_sum(ss) * (1.f / D) + NORM_EPS);
    unsigned long long* o8 = (unsigned long long*)(H + (size_t)r * D) + lane;
#pragma unroll
    for (int j = 0; j < 4; ++j) { const f32x4 sh = *(const f32x4*)(shp + 4 * lane + 256 * j), sc = *(const f32x4*)(scp + 4 * lane + 256 * j);
        v[j] = (v[j] * rstd * gv[j]) * (sc + 1.f) + sh;
        if (F8) ((unsigned*)((unsigned char*)H + (size_t)r * D))[lane + 64 * j] = pk_fp8x4(v[j].x * FP8_SH, v[j].y * FP8_SH, v[j].z * FP8_SH, v[j].w * FP8_SH);
        else o8[64 * j] = (unsigned long long)pk2(v[j].x, v[j].y) | ((unsigned long long)pk2(v[j].z, v[j].w) << 32); }
    if (MODE != 0) {
        float p[16];
#pragma unroll
        for (int e = 0; e < 16; ++e) p[e] = 0.f;
#pragma unroll
        for (int j = 0; j < 4; ++j)
#pragma unroll
            for (int i = 0; i < 4; ++i) { const LAS f32x4* wp = (const LAS f32x4*)(wl + ((4 * j + i) * 64 + lane) * 20); const float xv = v[j][i];
#pragma unroll
                for (int e4 = 0; e4 < 4; ++e4) { const f32x4 w = wp[e4]; p[4 * e4 + 0] = fmaf(xv, w.x, p[4 * e4 + 0]); p[4 * e4 + 1] = fmaf(xv, w.y, p[4 * e4 + 1]); p[4 * e4 + 2] = fmaf(xv, w.z, p[4 * e4 + 2]); p[4 * e4 + 3] = fmaf(xv, w.w, p[4 * e4 + 3]); } }
        float q8[8], q4[4], q2[2], q1;
        { const bool up = (lane & 32) != 0;
#pragma unroll
          for (int i = 0; i < 8; ++i) { const float send = up ? p[i] : p[i + 8]; const float recv = __shfl_xor(send, 32); q8[i] = (up ? p[i + 8] : p[i]) + recv; } }
        { const bool up = (lane & 16) != 0;
#pragma unroll
          for (int i = 0; i < 4; ++i) { const float send = up ? q8[i] : q8[i + 4]; const float recv = __shfl_xor(send, 16); q4[i] = (up ? q8[i + 4] : q8[i]) + recv; } }
        { const bool up = (lane & 8) != 0;
#pragma unroll
          for (int i = 0; i < 2; ++i) { const float send = up ? q4[i] : q4[i + 2]; const float recv = __shfl_xor(send, 8); q2[i] = (up ? q4[i + 2] : q4[i]) + recv; } }
        { const bool up = (lane & 4) != 0; const float send = up ? q2[0] : q2[1]; const float recv = __shfl_xor(send, 4); q1 = (up ? q2[1] : q2[0]) + recv; }
        q1 = quad_sum(q1);
        const int e = ((lane >> 5) & 1) * 8 + ((lane >> 4) & 1) * 4 + ((lane >> 3) & 1) * 2 + ((lane >> 2) & 1);
        if (MODE == 1) {
            float g = q1 + bias16[e];
            g = 15.f * tanhf(g * (1.f / 15.f));
            const int gate = e >> 2;
            if (gate & 1) g = fminf(g, 0.f) - log1pf(__expf(-fabsf(g)));
            if ((lane & 3) == 0) out16[(size_t)r * 16 + e] = g;
        } else {
            float mx = q1;
#pragma unroll
            for (int o = 4; o < 64; o <<= 1) mx = fmaxf(mx, __shfl_xor(mx, o));
            const float ex = __expf(q1 - mx); float sm = ex;
#pragma unroll
            for (int o = 4; o < 64; o <<= 1) sm += __shfl_xor(sm, o);
            if ((lane & 3) == 0) out16[(size_t)e * RT + r] = ex / sm;
        }
    }
}
template <int MODE, bool F8 = false>
__device__ __forceinline__ void norm_pass(Frame& F, const float* xL, const float* xC, int nrows, const float* gain, const float* shiftv, const float* scalev  ,
                                          bf16_t* H, const float* W16, int ldw16, const float* bias16, float* out16) {
    LAS float* wl = (LAS float*)F.lds;
    if (MODE != 0) load_w16(F, W16, ldw16);
    const int lane = F.lane;
    f32x4 gv[4];
#pragma unroll
    for (int j = 0; j < 4; ++j) gv[j] = *(const f32x4*)(gain + 4 * lane + 256 * j);
    const int per = (nrows + F.NGW - 1) / F.NGW; const int r0 = F.gw * per, r1 = (r0 + per < nrows) ? r0 + per : nrows;
    f32x4 vn[4];
    if (r0 < r1) { const float* xr = (r0 >= RL) ? (xC + (size_t)(r0 - RL) * D) : (xL + (size_t)r0 * D);
#pragma unroll
        for (int j = 0; j < 4; ++j) vn[j] = *(const f32x4*)(xr + 4 * lane + 256 * j); }
    for (int r = r0; r < r1; ++r) {
        asm volatile("" ::: "memory");
        f32x4 v[4];
#pragma unroll
        for (int j = 0; j < 4; ++j) v[j] = vn[j];
        if (r + 1 < r1) { const int rn = r + 1; const float* xr = (rn >= RL) ? (xC + (size_t)(rn - RL) * D) : (xL + (size_t)rn * D);
#pragma unroll
            for (int j = 0; j < 4; ++j) vn[j] = *(const f32x4*)(xr + 4 * lane + 256 * j); }
        const int mi = (r >= RL) ? NB : (r >> 12);
        norm_core<MODE, F8>(wl, lane, v, r, gv, shiftv + (size_t)mi * 6 * D, scalev + (size_t)mi * 6 * D, H, bias16, out16);
    }
    if (MODE != 0) __syncthreads();
}

__device__ __forceinline__ void moe_select(Frame& F, const float* AFF, int* INV, int* SLROW, float* SLG, int nunits) {
    LAS unsigned* keys = (LAS unsigned*)F.lds;
    LAS unsigned* wsum = (LAS unsigned*)(F.lds + 16384);
    const int tid = F.tid, lane = F.lane, wave = F.wave;
    for (int u = F.vcu; u < nunits; u += F.G) {
        const int set = u >> 4, e = u & 15; const bool isc = set >= NB; const int b = isc ? set - NB : set;
        const int N = isc ? CTXL : SEQ, k = isc ? CAP_C : CAP_L, PER = isc ? 1 : 8;
        const int row0 = isc ? RL + b * CTXL : b * SEQ;
        const int nmine = (tid * PER < N) ? PER : 0;
        unsigned kv[8];
        if (tid < 32) wsum[tid] = 0u;
#pragma unroll
        for (int i = 0; i < 8; ++i) { kv[i] = 0u; if (i < nmine) kv[i] = __float_as_uint(AFF[(size_t)e * RT + row0 + tid * PER + i]); }
        __syncthreads();
        unsigned T = 0u; { unsigned kk = (unsigned)k;
        for (int pass = 0; pass < 8; ++pass) {
            const int shift = 28 - 4 * pass; LAS unsigned* hist = wsum + (pass & 1) * 16;
            if (tid < 16) wsum[((pass + 1) & 1) * 16 + tid] = 0u;
#pragma unroll
            for (int i = 0; i < 8; ++i) if (i < nmine && (pass == 0 || (kv[i] >> (shift + 4)) == (T >> (shift + 4)))) (void)__hip_atomic_fetch_add(&hist[(kv[i] >> shift) & 15u], 1u, __ATOMIC_RELAXED, __HIP_MEMORY_SCOPE_WORKGROUP);
            __syncthreads();
            unsigned cum = 0u, digit = 0u; bool found = false;
#pragma unroll
            for (int d = 15; d >= 0; --d) { const unsigned c = hist[d]; if (!found) { if (cum + c >= kk) { digit = (unsigned)d; found = true; } else cum += c; } }
            kk -= cum; T |= digit << shift;
            __syncthreads();
        } }
        unsigned ngt = 0u, neq = 0u;
#pragma unroll
        for (int i = 0; i < 8; ++i) { if (i < nmine) { ngt += kv[i] > T ? 1u : 0u; neq += kv[i] == T ? 1u : 0u; } }
        unsigned sgt = ngt, seq = neq;
#pragma unroll
        for (int o = 1; o < 64; o <<= 1) { const unsigned a = __shfl_up(sgt, o), c2 = __shfl_up(seq, o); if (lane >= o) { sgt += a; seq += c2; } }
        LAS unsigned* sc = wsum + 32;
        __syncthreads();
        if (lane == 63) { sc[wave] = sgt; sc[8 + wave] = seq; }
        __syncthreads();
        unsigned bgt = 0u, beq = 0u, tgt = 0u;
#pragma unroll
        for (int w = 0; w < 8; ++w) { const unsigned a = sc[w], c2 = sc[8 + w]; if (w < wave) { bgt += a; beq += c2; } tgt += a; }
        const unsigned need = (unsigned)k - tgt;
        unsigned pgt = bgt + sgt - ngt, peq = beq + seq - neq;
        const int sbase = isc ? NB * CAP_L + b * CAP_C : b * CAP_L;
#pragma unroll
        for (int i = 0; i < 8; ++i) { if (i < nmine) {
            const int row = row0 + tid * PER + i; int slot = -1;
            if (kv[i] > T) { slot = (int)(pgt + (peq < need ? peq : need)); ++pgt; }
            else if (kv[i] == T) { if (peq < need) slot = (int)(pgt + peq); ++peq; }
            if (slot >= 0) { SLROW[e * SLOTS_E + sbase + slot] = row; SLG[e * SLOTS_E + sbase + slot] = __uint_as_float(kv[i]); }
            INV[(size_t)e * RT + row] = slot >= 0 ? sbase + slot : -1; } }
        __syncthreads();
    }
    (void)keys;
}

__device__ __forceinline__ void moe_gather(Frame& F, const bf16_t* H, const int* SLROW, bf16_t* XG, bool with_ctx) {
    const int per_e = with_ctx ? SLOTS_E : NB * CAP_L; const int total = NE * per_e;
    const int per = (total + F.NGW - 1) / F.NGW; const int i0 = F.gw * per, i1 = (i0 + per < total) ? i0 + per : total;
    for (int i = i0; i < i1; i += 4) {
        u32x4 a[4], b2[4]; size_t dsto[4];
#pragma unroll
        for (int q = 0; q < 4; ++q) { const int ii = (i + q < i1) ? i + q : i1 - 1; const int e = ii / per_e, sl = ii - e * per_e; const int row = SLROW[e * SLOTS_E + sl];
            const u32x4* src = (const u32x4*)(H + (size_t)row * D) + F.lane; a[q] = src[0]; b2[q] = src[64]; dsto[q] = ((size_t)e * SLOTS_E + sl) * D; }
#pragma unroll
        for (int q = 0; q < 4; ++q) { u32x4* dst = (u32x4*)(XG + dsto[q]) + F.lane; dst[0] = a[q]; dst[64] = b2[q]; }
    }
}

template <int MODE>
__device__ __forceinline__ void combine_norm(Frame& F, const bf16_t* Y, const int* INV, float* xL, float* xC, const float* g2v  , int nrows,
                                             const float* gain, const float* shiftv, const float* scalev, bf16_t* H, const float* W16, int ldw16, const float* bias16, float* out16) {
    LAS float* wl = (LAS float*)F.lds;
    if (MODE == 1) load_w16(F, W16, ldw16);
    const int lane = F.lane;
    f32x4 gv[4];
#pragma unroll
    for (int j = 0; j < 4; ++j) gv[j] = *(const f32x4*)(gain + 4 * lane + 256 * j);
    const int per = (nrows + F.NGW - 1) / F.NGW; const int r0 = F.gw * per, r1 = (r0 + per < nrows) ? r0 + per : nrows;
#define CN_XPTR(rr) (((rr) >= RL) ? (xC + (size_t)((rr) - RL) * D) : (xL + (size_t)(rr) * D))
#define CN_INV(rr) (((rr) < r1 && lane < 16) ? INV[(size_t)lane * RT + (rr)] : -1)
#define CN_YLOAD(dst, e_, s_) do { const u32x2* yp_ = (const u32x2*)(Y + ((size_t)(e_) * SLOTS_E + (s_)) * D) + lane; _Pragma("unroll") for (int j = 0; j < 4; ++j) dst[j] = yp_[64 * j]; } while (0)
#define CN_YACC(src) do { _Pragma("unroll") for (int j = 0; j < 4; ++j) { a[j].x += bf_lo(src[j].x); a[j].y += bf_hi(src[j].x); a[j].z += bf_lo(src[j].y); a[j].w += bf_hi(src[j].y); } } while (0)
    f32x4 vn[4]; u32x2 pn0[4], pn1[4];
    int invA = CN_INV(r0), invB = CN_INV(r0 + 1);
#pragma unroll
    for (int j = 0; j < 4; ++j) { vn[j] = (f32x4){0.f, 0.f, 0.f, 0.f}; pn0[j] = (u32x2){0u, 0u}; pn1[j] = (u32x2){0u, 0u}; }
    if (r0 < r1) { const float* xr = CN_XPTR(r0);
#pragma unroll
        for (int j = 0; j < 4; ++j) vn[j] = *(const f32x4*)(xr + 4 * lane + 256 * j);
        unsigned long long m = __ballot(invA >= 0);
        if (m) { const int e0 = __builtin_ctzll(m); m &= m - 1; CN_YLOAD(pn0, e0, __builtin_amdgcn_readlane(invA, e0)); if (m) { const int e1 = __builtin_ctzll(m); CN_YLOAD(pn1, e1, __builtin_amdgcn_readlane(invA, e1)); } } }
    for (int r = r0; r < r1; ++r) {
        asm volatile("" ::: "memory");
        f32x4 v[4]; u32x2 pc0[4], pc1[4];
#pragma unroll
        for (int j = 0; j < 4; ++j) { v[j] = vn[j]; pc0[j] = pn0[j]; pc1[j] = pn1[j]; }
        const int invC = CN_INV(r + 2);
        if (r + 1 < r1) { const float* xr = CN_XPTR(r + 1);
#pragma unroll
            for (int j = 0; j < 4; ++j) vn[j] = *(const f32x4*)(xr + 4 * lane + 256 * j);
            unsigned long long m = __ballot(invB >= 0);
            if (m) { const int e0 = __builtin_ctzll(m); m &= m - 1; CN_YLOAD(pn0, e0, __builtin_amdgcn_readlane(invB, e0)); if (m) { const int e1 = __builtin_ctzll(m); CN_YLOAD(pn1, e1, __builtin_amdgcn_readlane(invB, e1)); } } }
        f32x4 a[4];
#pragma unroll
        for (int j = 0; j < 4; ++j) a[j] = (f32x4){0.f, 0.f, 0.f, 0.f};
        { unsigned long long m = __ballot(invA >= 0);
          if (m) { m &= m - 1; CN_YACC(pc0);
            if (m) { m &= m - 1; CN_YACC(pc1);
              while (m) { const int e2 = __builtin_ctzll(m); m &= m - 1; u32x2 t2[4]; CN_YLOAD(t2, e2, __builtin_amdgcn_readlane(invA, e2)); CN_YACC(t2); } } } }
        const int mi = (r >= RL) ? NB : (r >> 12);
        const float* gp = g2v + (size_t)mi * 6 * D;
#pragma unroll
        for (int j = 0; j < 4; ++j) { const f32x4 g = *(const f32x4*)(gp + 4 * lane + 256 * j); v[j] = v[j] + g * a[j]; }
        float* xw = CN_XPTR(r);
        if (MODE == 3) {
            float ss = 0.f;
#pragma unroll
            for (int j = 0; j < 4; ++j) ss += (v[j].x * v[j].x + v[j].y * v[j].y) + (v[j].z * v[j].z + v[j].w * v[j].w);
            const float rstd = rsqrtf(wave_sum(ss) * (1.f / D) + NORM_EPS);
#pragma unroll
            for (int j = 0; j < 4; ++j) *(f32x4*)(xw + 4 * lane + 256 * j) = v[j] * rstd * gv[j];
        } else {
#pragma unroll
            for (int j = 0; j < 4; ++j) *(f32x4*)(xw + 4 * lane + 256 * j) = v[j];
            norm_core<MODE>(wl, lane, v, r, gv, shiftv + (size_t)mi * 6 * D, scalev + (size_t)mi * 6 * D, H, bias16, out16);
        }
        invA = invB; invB = invC;
    }
#undef CN_XPTR
#undef CN_INV
#undef CN_YLOAD
#undef CN_YACC
    if (MODE == 1) __syncthreads();
}

__device__ __forceinline__ void final_norm(Frame& F, float* x, const float* gain) {
    const int lane = F.lane;
    for (int r = F.gw; r < RL; r += F.NGW) { float* xr = x + (size_t)r * D; f32x4 v[4]; float ss = 0.f;
#pragma unroll
        for (int j = 0; j < 4; ++j) { v[j] = *(const f32x4*)(xr + 4 * lane + 256 * j); ss += (v[j].x * v[j].x + v[j].y * v[j].y) + (v[j].z * v[j].z + v[j].w * v[j].w); }
        const float rstd = rsqrtf(wave_sum(ss) * (1.f / D) + NORM_EPS);
#pragma unroll
        for (int j = 0; j < 4; ++j) { const f32x4 g = *(const f32x4*)(gain + 4 * lane + 256 * j); *(f32x4*)(xr + 4 * lane + 256 * j) = v[j] * rstd * g; } }
}

__device__ __forceinline__ void qk_pass(Frame& F, bf16_t* QKV, const float* qn, const float* kn, const float* ropec, const float* ropes, bf16_t* KALL, bf16_t* VALL) {
    const int lane = F.lane, p = lane & 3;
    float gq1[8], gq2[8], gk1[8], gk2[8];
#pragma unroll
    for (int t = 0; t < 8; ++t) { gq1[t] = qn[8 * p + t]; gq2[t] = qn[32 + 8 * p + t]; gk1[t] = kn[8 * p + t]; gk2[t] = kn[32 + 8 * p + t]; }
    for (int r = F.gw; r < RT; r += F.NGW) {
        const bool isc = r >= RL; const int b = isc ? (r - RL) >> 8 : r >> 12; const int t = isc ? (r - RL) & 255 : r & 4095;
        const int pos = isc ? t : CTXL + t;
        bf16_t* row = QKV + (size_t)r * 1536;
        float cs[8], sn[8];
#pragma unroll
        for (int i = 0; i < 8; ++i) { cs[i] = 1.f; sn[i] = 0.f; }
        if (!isc) { const f32x4 c0 = *(const f32x4*)(ropec + t * 32 + 8 * p), c1 = *(const f32x4*)(ropec + t * 32 + 8 * p + 4), s0 = *(const f32x4*)(ropes + t * 32 + 8 * p), s1 = *(const f32x4*)(ropes + t * 32 + 8 * p + 4);
            cs[0] = c0.x; cs[1] = c0.y; cs[2] = c0.z; cs[3] = c0.w; cs[4] = c1.x; cs[5] = c1.y; cs[6] = c1.z; cs[7] = c1.w;
            sn[0] = s0.x; sn[1] = s0.y; sn[2] = s0.z; sn[3] = s0.w; sn[4] = s1.x; sn[5] = s1.y; sn[6] = s1.z; sn[7] = s1.w; }
        {
            bf16_t* hp = row + (lane >> 2) * 64 + 8 * p;
            const u32x4 u1 = *(const u32x4*)hp, u2 = *(const u32x4*)(hp + 32);
            float x1[8], x2[8];
            x1[0] = bf_lo(u1.x); x1[1] = bf_hi(u1.x); x1[2] = bf_lo(u1.y); x1[3] = bf_hi(u1.y); x1[4] = bf_lo(u1.z); x1[5] = bf_hi(u1.z); x1[6] = bf_lo(u1.w); x1[7] = bf_hi(u1.w);
            x2[0] = bf_lo(u2.x); x2[1] = bf_hi(u2.x); x2[2] = bf_lo(u2.y); x2[3] = bf_hi(u2.y); x2[4] = bf_lo(u2.z); x2[5] = bf_hi(u2.z); x2[6] = bf_lo(u2.w); x2[7] = bf_hi(u2.w);
            float ss = 0.f;
#pragma unroll
            for (int i = 0; i < 8; ++i) ss += x1[i] * x1[i] + x2[i] * x2[i];
            ss = quad_sum(ss);
            const float rstd = rsqrtf(ss * (1.f / 64.f) + NORM_EPS) * attn_body::C2;
            float y1[8], y2[8];
#pragma unroll
            for (int i = 0; i < 8; ++i) { const float a = x1[i] * rstd * gq1[i], c = x2[i] * rstd * gq2[i]; y1[i] = a * cs[i] - c * sn[i]; y2[i] = a * sn[i] + c * cs[i]; }
            u32x4 o1, o2; o1.x = pk2(y1[0], y1[1]); o1.y = pk2(y1[2], y1[3]); o1.z = pk2(y1[4], y1[5]); o1.w = pk2(y1[6], y1[7]);
            o2.x = pk2(y2[0], y2[1]); o2.y = pk2(y2[2], y2[3]); o2.z = pk2(y2[4], y2[5]); o2.w = pk2(y2[6], y2[7]);
            *(u32x4*)hp = o1; *(u32x4*)(hp + 32) = o2;
        }
        {
            const int kh = (lane >> 2) & 3;
            const bf16_t* hp = row + 1024 + kh * 64 + 8 * p;
            const u32x4 u1 = *(const u32x4*)hp, u2 = *(const u32x4*)(hp + 32);
            float x1[8], x2[8];
            x1[0] = bf_lo(u1.x); x1[1] = bf_hi(u1.x); x1[2] = bf_lo(u1.y); x1[3] = bf_hi(u1.y); x1[4] = bf_lo(u1.z); x1[5] = bf_hi(u1.z); x1[6] = bf_lo(u1.w); x1[7] = bf_hi(u1.w);
            x2[0] = bf_lo(u2.x); x2[1] = bf_hi(u2.x); x2[2] = bf_lo(u2.y); x2[3] = bf_hi(u2.y); x2[4] = bf_lo(u2.z); x2[5] = bf_hi(u2.z); x2[6] = bf_lo(u2.w); x2[7] = bf_hi(u2.w);
            float ss = 0.f;
#pragma unroll
            for (int i = 0; i < 8; ++i) ss += x1[i] * x1[i] + x2[i] * x2[i];
            ss = quad_sum(ss);
            const float rstd = rsqrtf(ss * (1.f / 64.f) + NORM_EPS);
            float y1[8], y2[8];
#pragma unroll
            for (int i = 0; i < 8; ++i) { const float a = x1[i] * rstd * gk1[i], c = x2[i] * rstd * gk2[i]; y1[i] = a * cs[i] - c * sn[i]; y2[i] = a * sn[i] + c * cs[i]; }
            if (lane < 16) {
                bf16_t* kp = KALL + ((size_t)b * KVLEN + pos) * 256 + kh * 64 + 8 * p;
                u32x4 o1, o2; o1.x = pk2(y1[0], y1[1]); o1.y = pk2(y1[2], y1[3]); o1.z = pk2(y1[4], y1[5]); o1.w = pk2(y1[6], y1[7]);
                o2.x = pk2(y2[0], y2[1]); o2.y = pk2(y2[2], y2[3]); o2.z = pk2(y2[4], y2[5]); o2.w = pk2(y2[6], y2[7]);
                *(u32x4*)kp = o1; *(u32x4*)(kp + 32) = o2;
            } else if (lane < 48) {
                const int c8 = (lane - 16) * 8;
                *(u32x4*)(VALL + ((size_t)b * KVLEN + pos) * 256 + c8) = *(const u32x4*)(row + 1280 + c8);
            }
        }
    }
}

__device__ __forceinline__ void mlstm_readout(Frame& F, const bf16_t* HF, const bf16_t* HB, const bf16_t* QKVO, const float* wnorm, bf16_t* MIX) {
    const int lane = F.lane;
    f32x4 gv[4];
#pragma unroll
    for (int j = 0; j < 4; ++j) gv[j] = *(const f32x4*)(wnorm + 4 * lane + 256 * j);
    for (int r = F.gw; r < RT; r += F.NGW) {
        const u32x2* pf = (const u32x2*)(HF + (size_t)r * D) + lane; const u32x2* pb = (const u32x2*)(HB + (size_t)r * D) + lane;
        const u32x2* po = (const u32x2*)(QKVO + (size_t)r * 3072 + 2048) + lane;
        u32x2 uf[4], ub[4], uo[4];
#pragma unroll
        for (int j = 0; j < 4; ++j) { uf[j] = pf[64 * j]; ub[j] = pb[64 * j]; uo[j] = po[64 * j]; }
        unsigned long long* o8 = (unsigned long long*)(MIX + (size_t)r * D) + lane;
#pragma unroll
        for (int j = 0; j < 4; ++j) {
            f32x4 h; h.x = bf_lo(uf[j].x) + bf_lo(ub[j].x); h.y = bf_hi(uf[j].x) + bf_hi(ub[j].x); h.z = bf_lo(uf[j].y) + bf_lo(ub[j].y); h.w = bf_hi(uf[j].y) + bf_hi(ub[j].y);
            const float ss = wave_sum((h.x * h.x + h.y * h.y) + (h.z * h.z + h.w * h.w));
            const float rstd = rsqrtf(ss * (1.f / 256.f) + NORM_EPS);
            f32x4 og; og.x = bf_lo(uo[j].x); og.y = bf_hi(uo[j].x); og.z = bf_lo(uo[j].y); og.w = bf_hi(uo[j].y);
            f32x4 y;
            y.x = h.x * rstd * gv[j].x * fast_rcp(1.f + __expf(-og.x)); y.y = h.y * rstd * gv[j].y * fast_rcp(1.f + __expf(-og.y));
            y.z = h.z * rstd * gv[j].z * fast_rcp(1.f + __expf(-og.z)); y.w = h.w * rstd * gv[j].w * fast_rcp(1.f + __expf(-og.w));
            o8[64 * j] = (unsigned long long)pk2(y.x, y.y) | ((unsigned long long)pk2(y.z, y.w) << 32);
        }
    }
}
namespace mls {
constexpr int XS = 272, PS = 144, NCH = 68;
constexpr int O_XQ = 0, O_XK = 17408, O_XKP = 34816, O_XV = 52224, O_P = 69632, O_CT = 78848, O_OT = 113664, O_GB = 131072;
constexpr int O_RD = O_GB + 2 * 5 * 64 * 4, O_NV = O_RD + 256, O_DEC = O_NV + 1024, O_PRE = O_DEC + 64;
constexpr int LDS_BYTES = O_PRE + 3 * 72 * 4;

__device__ __forceinline__ int row_of(int b, int dir, int c, int p) {
    const int base = (c < 4) ? (RL + b * CTXL + (dir ? 192 - 64 * c : 64 * c)) : (b * SEQ + (dir ? 4032 - 64 * (c - 4) : 64 * (c - 4)));
    return base + (dir ? 63 - p : p);
}
__device__ __forceinline__ bf16x8 tr8(const LAS unsigned char* p0, const LAS unsigned char* p1) {
    typedef short v4i16_t __attribute__((ext_vector_type(4)));
    const s16x4 lo = __builtin_bit_cast(s16x4, __builtin_amdgcn_ds_read_tr16_b64_v4i16((LAS v4i16_t*)p0));
    const s16x4 hi = __builtin_bit_cast(s16x4, __builtin_amdgcn_ds_read_tr16_b64_v4i16((LAS v4i16_t*)p1));
    return (bf16x8){lo[0], lo[1], lo[2], lo[3], hi[0], hi[1], hi[2], hi[3]};
}

__device__ __forceinline__ void gate_arrays(LAS unsigned char* L, const float lf, const float ig, int c, int lane) {
    const int par = c & 1;
    const float bs = wave_scan_add(lf, lane);
    const float a = ig - bs; const float pm = wave_scan_max(a, lane);
    const float mst = ((const LAS float*)(L + O_PRE))[144 + c];
    const float M = fmaxf(mst, pm), M63 = rdlane(M, 63);
    LAS float* gb = (LAS float*)(L + O_GB) + par * 320;
    gb[lane] = a; gb[64 + lane] = M; gb[128 + lane] = __expf(mst - M); gb[192 + lane] = __expf(-bs - M); gb[256 + lane] = __expf(a - M63);
    if (lane == 0) ((LAS float*)(L + O_DEC))[par] = __expf(mst - M63);
}

__device__ __forceinline__ void mlstm_unit(Frame& F, int b, int hd, int dir, int half, const bf16_t* QKVO, const float* GATES, bf16_t* HOUT) {
    LAS unsigned char* L = F.lds;
    const int tid = F.tid, lane = F.lane, w = F.wave, fr = lane & 15, g = lane >> 4;
    const int gi = (dir * 2) * 4 + hd, gf = (dir * 2 + 1) * 4 + hd;
    LAS float* pre = (LAS float*)(L + O_PRE);
    __syncthreads();
    if (tid < NCH) { float bs = 0.f, am = -INFINITY;
        for (int p = 0; p < 64; ++p) { const int row = row_of(b, dir, tid, p); const float lf = GATES[(size_t)row * 16 + gf], ig = GATES[(size_t)row * 16 + gi]; bs += lf; am = fmaxf(am, ig - bs); }
        pre[tid] = bs; pre[72 + tid] = am; }
    for (int i = tid; i < (O_OT - O_CT) / 4; i += NTHREADS) ((LAS unsigned*)(L + O_CT))[i] = 0u;
    for (int i = tid; i < 256; i += NTHREADS) ((LAS float*)(L + O_NV))[i] = 0.f;
    __syncthreads();
    if (tid == 0) { float m = 0.f; for (int c = 0; c < NCH; ++c) { pre[144 + c] = m; m = pre[c] + fmaxf(m, pre[72 + c]); } }
    __syncthreads();
    if (w == 0) { const int row = row_of(b, dir, 0, lane); gate_arrays(L, GATES[(size_t)row * 16 + gf], GATES[(size_t)row * 16 + gi], 0, lane); }
    __syncthreads();
    const int qcol = hd * 128, kcol = 512 + hd * 128, vcol = 1024 + hd * 256 + half * 128;
    u32x4 rq[2], rk[2], rv[2];
#define MLS_BAR() do { asm volatile("s_waitcnt lgkmcnt(0)" ::: "memory"); __builtin_amdgcn_s_barrier(); asm volatile("" ::: "memory"); } while (0)
#define MLS_LOAD(c) do { _Pragma("unroll") for (int i_ = 0; i_ < 2; ++i_) { const int pi_ = tid + 512 * i_, p_ = pi_ >> 4, c16_ = pi_ & 15; \
        const bf16_t* rp_ = QKVO + (size_t)row_of(b, dir, (c), p_) * 3072 + c16_ * 8; \
        rq[i_] = *(const u32x4*)(rp_ + qcol); rk[i_] = *(const u32x4*)(rp_ + kcol); rv[i_] = *(const u32x4*)(rp_ + vcol); } } while (0)
#define MLS_STAGE(c) do { const LAS float* wk_ = (const LAS float*)(L + O_GB) + ((c) & 1) * 320 + 256; \
        _Pragma("unroll") for (int i_ = 0; i_ < 2; ++i_) { const int pi_ = tid + 512 * i_, p_ = pi_ >> 4, c16_ = pi_ & 15; const int o_ = p_ * XS + c16_ * 16; \
        *(LAS u32x4*)(L + O_XQ + o_) = rq[i_]; *(LAS u32x4*)(L + O_XK + o_) = rk[i_]; *(LAS u32x4*)(L + O_XV + o_) = rv[i_]; \
        const float s_ = wk_[p_]; u32x4 kk_; \
        kk_.x = pk2(bf_lo(rk[i_].x) * s_, bf_hi(rk[i_].x) * s_); kk_.y = pk2(bf_lo(rk[i_].y) * s_, bf_hi(rk[i_].y) * s_); \
        kk_.z = pk2(bf_lo(rk[i_].z) * s_, bf_hi(rk[i_].z) * s_); kk_.w = pk2(bf_lo(rk[i_].w) * s_, bf_hi(rk[i_].w) * s_); \
        *(LAS u32x4*)(L + O_XKP + o_) = kk_; } } while (0)
    MLS_LOAD(0); MLS_STAGE(0);
    __syncthreads();
    f32x4 C[8];
#pragma unroll
    for (int i = 0; i < 8; ++i) C[i] = (f32x4){0.f, 0.f, 0.f, 0.f};
    LAS unsigned char* CTw = L + O_CT + w * (16 * XS);
    for (int c = 0; c < NCH; ++c) {
        const int par = c & 1; const bool more = (c + 1 < NCH);
        const LAS float* gb = (const LAS float*)(L + O_GB) + par * 320;
        float glf = 0.f, gig = 0.f;
        if (more && w == 0) { const int row = row_of(b, dir, c + 1, lane); glf = GATES[(size_t)row * 16 + gf]; gig = GATES[(size_t)row * 16 + gi]; }
        if (more) MLS_LOAD(c + 1);
        if (more && w == 0) gate_arrays(L, glf, gig, c + 1, lane);
        {
            const int mt = w >> 1;
            bf16x8 aq[4];
#pragma unroll
            for (int ks = 0; ks < 4; ++ks) aq[ks] = *(const LAS bf16x8*)(L + O_XQ + (16 * mt + fr) * XS + (32 * ks + 8 * g) * 2);
            const f32x4 Mj = *(const LAS f32x4*)(gb + 64 + 16 * mt + 4 * g);
#pragma unroll
            for (int n2 = 0; n2 < 2; ++n2) { const int nt = 2 * (w & 1) + n2;
                f32x4 s4 = (f32x4){0.f, 0.f, 0.f, 0.f};
#pragma unroll
                for (int ks = 0; ks < 4; ++ks) { const bf16x8 bk = *(const LAS bf16x8*)(L + O_XK + (16 * nt + fr) * XS + (32 * ks + 8 * g) * 2);
                    s4 = __builtin_amdgcn_mfma_f32_16x16x32_bf16(aq[ks], bk, s4, 0, 0, 0); }
                const int s = 16 * nt + fr; const float as = gb[s];
#pragma unroll
                for (int reg = 0; reg < 4; ++reg) { const int j = 16 * mt + 4 * g + reg;
                    const float pv = (s <= j) ? s4[reg] * __expf(as - Mj[reg]) : 0.f;
                    *(LAS bf16_t*)(L + O_P + j * PS + s * 2) = (bf16_t)f2bf(pv); } }
        }
        f32x4 acc[4];
        {
            bf16x8 ct[4];
#pragma unroll
            for (int ks = 0; ks < 4; ++ks) ct[ks] = *(const LAS bf16x8*)(CTw + fr * XS + (32 * ks + 8 * g) * 2);
#pragma unroll
            for (int mt = 0; mt < 4; ++mt) { f32x4 a4 = (f32x4){0.f, 0.f, 0.f, 0.f};
#pragma unroll
                for (int ks = 0; ks < 4; ++ks) { const bf16x8 q = *(const LAS bf16x8*)(L + O_XQ + (16 * mt + fr) * XS + (32 * ks + 8 * g) * 2);
                    a4 = __builtin_amdgcn_mfma_f32_16x16x32_bf16(q, ct[ks], a4, 0, 0, 0); }
                const f32x4 wi = *(const LAS f32x4*)(gb + 128 + 16 * mt + 4 * g);
                acc[mt] = a4 * wi; }
        }
        MLS_BAR();
        bf16x8 vf[2];
        {
            const LAS unsigned char* vb = L + O_XV + (8 * g + (fr >> 2)) * XS + (16 * w + (lane & 3) * 4) * 2;
#pragma unroll
            for (int k2 = 0; k2 < 2; ++k2) vf[k2] = tr8(vb + 32 * k2 * XS, vb + (32 * k2 + 4) * XS);
#pragma unroll
            for (int mt = 0; mt < 4; ++mt)
#pragma unroll
                for (int k2 = 0; k2 < 2; ++k2) { const bf16x8 ap = *(const LAS bf16x8*)(L + O_P + (16 * mt + fr) * PS + (32 * k2 + 8 * g) * 2);
                    acc[mt] = __builtin_amdgcn_mfma_f32_16x16x32_bf16(ap, vf[k2], acc[mt], 0, 0, 0); }
        }
        {
            const int j = tid >> 3, part = tid & 7;
            const u32x4 pu = *(const LAS u32x4*)(L + O_P + j * PS + part * 16);
            float rs = (bf_lo(pu.x) + bf_hi(pu.x)) + (bf_lo(pu.y) + bf_hi(pu.y)) + (bf_lo(pu.z) + bf_hi(pu.z)) + (bf_lo(pu.w) + bf_hi(pu.w));
            const u32x4 q0 = *(const LAS u32x4*)(L + O_XQ + j * XS + part * 32), q1 = *(const LAS u32x4*)(L + O_XQ + j * XS + part * 32 + 16);
            const LAS f32x4* np = (const LAS f32x4*)(L + O_NV + par * 512 + part * 64);
            const f32x4 n0 = np[0], n1 = np[1], n2 = np[2], n3 = np[3];
            float qn = bf_lo(q0.x) * n0.x + bf_hi(q0.x) * n0.y + bf_lo(q0.y) * n0.z + bf_hi(q0.y) * n0.w
                     + bf_lo(q0.z) * n1.x + bf_hi(q0.z) * n1.y + bf_lo(q0.w) * n1.z + bf_hi(q0.w) * n1.w
                     + bf_lo(q1.x) * n2.x + bf_hi(q1.x) * n2.y + bf_lo(q1.y) * n2.z + bf_hi(q1.y) * n2.w
                     + bf_lo(q1.z) * n3.x + bf_hi(q1.z) * n3.y + bf_lo(q1.w) * n3.z + bf_hi(q1.w) * n3.w;
            rs = oct_sum(rs); qn = oct_sum(qn);
            const float den = rs + gb[128 + j] * qn;
            if (part == 0) ((LAS float*)(L + O_RD))[j] = 1.f / fmaxf(fabsf(den), gb[192 + j]);
        }
        {
            const float decay = ((const LAS float*)(L + O_DEC))[par];
            const LAS unsigned char* kb = L + O_XKP + (8 * g + (fr >> 2)) * XS + ((lane & 3) * 4) * 2;
#pragma unroll
            for (int mt = 0; mt < 8; ++mt) { f32x4 c4 = C[mt] * decay;
#pragma unroll
                for (int k2 = 0; k2 < 2; ++k2) { const bf16x8 ak = tr8(kb + 32 * k2 * XS + 32 * mt, kb + (32 * k2 + 4) * XS + 32 * mt);
                    c4 = __builtin_amdgcn_mfma_f32_16x16x32_bf16(ak, vf[k2], c4, 0, 0, 0); }
                C[mt] = c4;
                u32x2 o; o.x = pk2(c4[0], c4[1]); o.y = pk2(c4[2], c4[3]);
                *(LAS u32x2*)(CTw + fr * XS + (16 * mt + 4 * g) * 2) = o; }
            const int dk = tid >> 2, part = tid & 3; float sm = 0.f;
#pragma unroll
            for (int t = 0; t < 16; ++t) sm += bf2f(*(const LAS bf16_t*)(L + O_XKP + (16 * part + t) * XS + dk * 2));
            sm = quad_sum(sm);
            if (part == 0) { const LAS float* nv = (const LAS float*)(L + O_NV); ((LAS float*)(L + O_NV))[(par ^ 1) * 128 + dk] = decay * nv[par * 128 + dk] + sm; }
        }
        MLS_BAR();
        {
#pragma unroll
            for (int mt = 0; mt < 4; ++mt) { const f32x4 rd = *(const LAS f32x4*)(L + O_RD + (16 * mt + 4 * g) * 4);
#pragma unroll
                for (int reg = 0; reg < 4; ++reg) *(LAS bf16_t*)(L + O_OT + (16 * mt + 4 * g + reg) * XS + (16 * w + fr) * 2) = (bf16_t)f2bf(acc[mt][reg] * rd[reg]); }
            if (more) MLS_STAGE(c + 1);
        }
        MLS_BAR();
        {
            const int j = tid >> 3, ch = tid & 7;
            const u32x4 o0 = *(const LAS u32x4*)(L + O_OT + j * XS + ch * 32), o1 = *(const LAS u32x4*)(L + O_OT + j * XS + ch * 32 + 16);
            bf16_t* op = HOUT + (size_t)row_of(b, dir, c, j) * D + hd * 256 + half * 128 + ch * 16;
            *(u32x4*)op = o0; *(u32x4*)(op + 8) = o1;
        }
    }
#undef MLS_BAR
#undef MLS_LOAD
#undef MLS_STAGE
}
}
constexpr int MISC_OFF = 135936, LDS_TOTAL = 136192;
static_assert(mls::LDS_BYTES <= MISC_OFF && pg8::STAGE_BYTES <= MISC_OFF && attn_body::LDS_BYTES <= MISC_OFF, "lds");
#ifndef EN_MASK
#define EN_MASK 0xFFFFFFFFu
#endif
#define PH_ON(k) (((EN_MASK) >> (k)) & 1u)
#ifndef REP_MASK
#define REP_MASK 0u
#endif
#define REP_ON(k) (((REP_MASK) >> (k)) & 1u)
#ifndef PH_LIMIT
#define PH_LIMIT 1000
#endif
#ifndef N_LAUNCH_SPLIT
#define N_LAUNCH_SPLIT 0
#endif
constexpr int N_PHASES = 1 + 10 + 9 + 9 + 9;

struct Args { const float* in[21]; float* out; unsigned char* ws; int ph_lo, ph_hi; };
static_assert(sizeof(Args) == 23 * 8 + 8, "no padding");

__device__ __forceinline__ Frame make_frame(unsigned char* lds_gen, unsigned char* ws_) {
    Frame F; int t = threadIdx.x; asm volatile("" : "+v"(t));
    int bx = blockIdx.x; asm volatile("" : "+s"(bx));
    F.lds = (LAS unsigned char*)lds_gen; F.tid = t; F.lane = t & 63; F.wave = __builtin_amdgcn_readfirstlane(t >> 6);
    F.G = gridDim.x; F.bid = bx; F.vcu = (F.G % 8 == 0) ? (bx % 8) * (F.G / 8) + bx / 8 : bx;
    F.gw = F.vcu * NWAVES + F.wave; F.NGW = F.G * NWAVES;
    unsigned char* w = ws_; asm volatile("" : "+s"(w)); F.ws = w; F.in = (const float* const*)(w + WS_PTRS); return F;
}
__global__ void __launch_bounds__(NTHREADS, 2) fwd(Args a) {
    extern __shared__ __attribute__((aligned(16))) unsigned char lds_raw[];
    unsigned char* const lds_gen = lds_raw;
    unsigned char* ws = a.ws;
    if (threadIdx.x < 4) ((LAS unsigned*)((LAS unsigned char*)lds_raw + MISC_OFF))[threadIdx.x] = 0u;
    __syncthreads();
    XcdBarrier bar = xcd_barrier_post((unsigned*)(ws + WS_CTL), (volatile LAS unsigned*)((LAS unsigned char*)lds_raw + MISC_OFF));
    int cur = 0; const int lo = a.ph_lo, hi = a.ph_hi & 0xffff; bool ran = false;
#define PHASE_BEGIN if (cur >= lo && cur < hi) { if (ran) xcd_barrier(bar); ran = true;
#define PHASE_END   } ++cur;

    if (blockIdx.x == 0 && threadIdx.x < 22) ((const float**)(ws + WS_PTRS))[threadIdx.x] = (threadIdx.x < 21) ? a.in[threadIdx.x] : (const float*)a.out;
#define XL ((float*)F.in[21])
#define XC ((float*)(F.ws + WS_XC))
#define H ((bf16_t*)(F.ws + WS_H))
#define MIX ((bf16_t*)(F.ws + WS_MIX))
#define BIG0 ((bf16_t*)(F.ws + WS_BIG0))
#define BIG1 ((bf16_t*)(F.ws + WS_BIG1))
#define GATES ((float*)(F.ws + WS_GATES))
#define AFF ((float*)(F.ws + WS_AFF))
#define INV ((int*)(F.ws + WS_INV))
#define SLROW ((int*)(F.ws + WS_SLROW))
#define SLG ((float*)(F.ws + WS_SLG))
#define IN(k) (F.in[k])

    PHASE_BEGIN if (PH_ON(0)) for (int rep_ = 0; rep_ < (REP_ON(0) ? 2 : 1); ++rep_) { if (rep_) xcd_barrier(bar); Frame F = make_frame(lds_gen, a.ws); p0_prologue(F, a.in, F.ws); } PHASE_END

    for (int layer = 0; layer < DEPTH; ++layer) {
        const bool last = (layer == DEPTH - 1); const int j = layer >> 1;
#define modv ((const float*)(F.ws + WS_MODV) + (size_t)layer * NMI * 6 * D)
#define xLs ((layer == 0) ? IN(0) : (const float*)XL)
#define xCs ((layer == 0) ? IN(2) : (const float*)XC)
        if ((layer & 1) == 0) {
            if (layer == 0) { PHASE_BEGIN if (PH_ON(1)) for (int rep_ = 0; rep_ < (REP_ON(1) ? 2 : 1); ++rep_) { if (rep_) xcd_barrier(bar); Frame F = make_frame(lds_gen, a.ws); norm_pass<1>(F, xLs, xCs, RT, IN(6) + layer * D, modv + 0 * D, modv + 1 * D, H, IN(8) + (size_t)j * D * MW_IN + 3072, MW_IN, IN(9) + j * 16, GATES); } PHASE_END }
            PHASE_BEGIN if (PH_ON(2)) for (int rep_ = 0; rep_ < (REP_ON(2) ? 2 : 1); ++rep_) { if (rep_) xcd_barrier(bar); Frame F = make_frame(lds_gen, a.ws); { pg8::PlainSched S{(const char*)H, (const char*)((bf16_t*)(F.ws + WS_WMI) + (size_t)j * 3072 * D), RT / 256, 12, D, F.G, F.bid};
                pg8::EpiBf16 E{BIG0, 3072, 2, 0.08838834764831845f}; pg8::gemm_phase(F.lds, F.tid, D, S, E); } } PHASE_END
            PHASE_BEGIN if (PH_ON(3)) for (int rep_ = 0; rep_ < (REP_ON(3) ? 2 : 1); ++rep_) { if (rep_) xcd_barrier(bar); Frame F = make_frame(lds_gen, a.ws); for (int u = F.vcu; u < 256; u += F.G) { const int half = u & 1, dir = (u >> 1) & 1, hd = (u >> 2) & 3, b = u >> 4;
                mls::mlstm_unit(F, b, hd, dir, half, BIG0, GATES, dir ? MIX : H); } } PHASE_END
            PHASE_BEGIN if (PH_ON(4)) for (int rep_ = 0; rep_ < (REP_ON(4) ? 2 : 1); ++rep_) { if (rep_) xcd_barrier(bar); Frame F = make_frame(lds_gen, a.ws); mlstm_readout(F, H, MIX, BIG0, IN(10) + j * D, MIX); } PHASE_END
            PHASE_BEGIN if (PH_ON(5)) for (int rep_ = 0; rep_ < (REP_ON(5) ? 2 : 1); ++rep_) { if (rep_) xcd_barrier(bar); Frame F = make_frame(lds_gen, a.ws); { pg8::PlainSched S{(const char*)MIX, (const char*)((bf16_t*)(F.ws + WS_WMO) + (size_t)j * D * D), RT / 256, 4, D, F.G, F.bid};
                pg8::EpiResid E{xLs, xCs, XL, XC, modv + 2 * D}; pg8::gemm_phase(F.lds, F.tid, D, S, E); } } PHASE_END
        } else {
#define KALL BIG1
#define VALL (BIG1 + (size_t)NB * KVLEN * 256)
            PHASE_BEGIN if (PH_ON(7)) for (int rep_ = 0; rep_ < (REP_ON(7) ? 2 : 1); ++rep_) { if (rep_) xcd_barrier(bar); Frame F = make_frame(lds_gen, a.ws); { pg8::PlainSched S{(const char*)H, (const char*)((bf16_t*)(F.ws + WS_WAI) + (size_t)j * 1536 * D), RT / 256, 6, D, F.G, F.bid};
                pg8::EpiBf16 E{BIG0, 1536, 0, 1.f}; pg8::gemm_phase(F.lds, F.tid, D, S, E); } } PHASE_END
            PHASE_BEGIN if (PH_ON(8)) for (int rep_ = 0; rep_ < (REP_ON(8) ? 2 : 1); ++rep_) { if (rep_) xcd_barrier(bar); Frame F = make_frame(lds_gen, a.ws); qk_pass(F, BIG0, IN(13) + j * 64, IN(14) + j * 64, (const float*)(F.ws + WS_ROPE), (const float*)(F.ws + WS_ROPE) + SEQ * 32, KALL, VALL); } PHASE_END
            PHASE_BEGIN if (PH_ON(9)) for (int rep_ = 0; rep_ < (REP_ON(9) ? 2 : 1); ++rep_) { if (rep_) xcd_barrier(bar); Frame F = make_frame(lds_gen, a.ws); { const int nun = last ? 4096 : 4096 + 256;
                for (int L = F.vcu; L < nun; L += F.G) {
                    const bool isc = L >= 4096; const int Lc = L - 4096;
                    const int grp = L >> 6, wi = L & 63;
                    const int b = isc ? (Lc >> 4) : (grp >> 2), hq = isc ? (Lc & 15) : ((grp & 3) * 4 + (wi >> 4));
                    const size_t row0 = isc ? ((size_t)RL + b * CTXL) : ((size_t)b * SEQ + (wi & 15) * 256);
                    const bf16_t* qp = BIG0 + row0 * 1536 + hq * 64; const bf16_t* kp = KALL + (size_t)b * KVLEN * 256 + (hq >> 2) * 64; const bf16_t* vp = VALL + (size_t)b * KVLEN * 256 + (hq >> 2) * 64; bf16_t* op = MIX + row0 * D + hq * 64;
                    if (isc) attn_body::attn_unit<8>(qp, 1536, kp, vp, 256, CTXL / 64, op, D, (char*)lds_gen, F.tid);
                    else     attn_body::attn_unit<8>(qp, 1536, kp, vp, 256, KVLEN / 64, op, D, (char*)lds_gen, F.tid); } } } PHASE_END
            PHASE_BEGIN if (PH_ON(10)) for (int rep_ = 0; rep_ < (REP_ON(10) ? 2 : 1); ++rep_) { if (rep_) xcd_barrier(bar); Frame F = make_frame(lds_gen, a.ws); { pg8::PlainSched S{(const char*)MIX, (const char*)((bf16_t*)(F.ws + WS_WAO) + (size_t)j * D * D), (last ? RL : RT) / 256, 4, D, F.G, F.bid};
                pg8::EpiResid E{xLs, xCs, XL, XC, modv + 2 * D}; pg8::gemm_phase(F.lds, F.tid, D, S, E); } } PHASE_END
        }
        const int nrows = last ? RL : RT;
        PHASE_BEGIN if (PH_ON(11)) for (int rep_ = 0; rep_ < (REP_ON(11) ? 2 : 1); ++rep_) { if (rep_) xcd_barrier(bar); Frame F = make_frame(lds_gen, a.ws); moe_weights(F, IN(17) + (size_t)layer * NE * D * D, IN(18) + (size_t)layer * NE * D * D, IN(19) + (size_t)layer * NE * D * D, F.ws);
            norm_pass<2, MOE_FP8_1 != 0>(F, XL, XC, nrows, IN(7) + layer * D, modv + 3 * D, modv + 4 * D, H, IN(16) + (size_t)layer * D * 16, 16, nullptr, AFF); } PHASE_END
        PHASE_BEGIN if (PH_ON(12)) for (int rep_ = 0; rep_ < (REP_ON(12) ? 2 : 1); ++rep_) { if (rep_) xcd_barrier(bar); Frame F = make_frame(lds_gen, a.ws); moe_select(F, AFF, INV, SLROW, SLG, last ? NB * NE : 2 * NB * NE); } PHASE_END
        PHASE_BEGIN if (PH_ON(14)) for (int rep_ = 0; rep_ < (REP_ON(14) ? 2 : 1); ++rep_) { if (rep_) xcd_barrier(bar); Frame F = make_frame(lds_gen, a.ws); { constexpr int K1 = MOE_FP8_1 ? D / 2 : D;
            pg8::MoeSched S{(const char*)H, (const char*)(F.ws + WS_W1), last ? 32 : 34, 8, K1, 2048, F.G, F.bid};
            pg8::EpiSwiglu E{(void*)BIG1, MOE_FP8_1 ? 1.f / (FP8_SH * FP8_SW) : 1.f, MOE_FP8_2 != 0}; pg8::gemm_phase<pg8::EpiSwiglu, pg8::MoeSched, true, MOE_FP8_1 != 0>(F.lds, F.tid, K1, S, E, SLROW); } } PHASE_END
        PHASE_BEGIN if (PH_ON(15)) for (int rep_ = 0; rep_ < (REP_ON(15) ? 2 : 1); ++rep_) { if (rep_) xcd_barrier(bar); Frame F = make_frame(lds_gen, a.ws); { constexpr int K2 = MOE_FP8_2 ? D / 2 : D;
            pg8::MoeSched S{(const char*)BIG1, (const char*)(F.ws + WS_W2), last ? 32 : 34, 4, K2, 1024, F.G, F.bid};
            pg8::EpiRowScale E{BIG0, SLG, MOE_FP8_2 ? 1.f / (FP8_SA * FP8_SW) : 1.f}; pg8::gemm_phase<pg8::EpiRowScale, pg8::MoeSched, false, MOE_FP8_2 != 0>(F.lds, F.tid, K2, S, E); } } PHASE_END
        PHASE_BEGIN if (PH_ON(16)) for (int rep_ = 0; rep_ < (REP_ON(16) ? 2 : 1); ++rep_) { if (rep_) xcd_barrier(bar); Frame F = make_frame(lds_gen, a.ws);
            const int nl = layer + 1; const float* modn = (const float*)(F.ws + WS_MODV) + (size_t)nl * NMI * 6 * D;
            if (last) combine_norm<3>(F, BIG0, INV, XL, XC, modv + 5 * D, RL, IN(20), nullptr, nullptr, nullptr, nullptr, 0, nullptr, nullptr);
            else if (nl & 1) combine_norm<0>(F, BIG0, INV, XL, XC, modv + 5 * D, RT, IN(6) + nl * D, modn + 0 * D, modn + 1 * D, H, nullptr, 0, nullptr, nullptr);
            else combine_norm<1>(F, BIG0, INV, XL, XC, modv + 5 * D, RT, IN(6) + nl * D, modn + 0 * D, modn + 1 * D, H, IN(8) + (size_t)(nl >> 1) * D * MW_IN + 3072, MW_IN, IN(9) + (nl >> 1) * 16, GATES); } PHASE_END
    }
#undef XL
#undef XC
#undef H
#undef MIX
#undef BIG0
#undef BIG1
#undef GATES
#undef AFF
#undef INV
#undef SLROW
#undef SLG
#undef IN
#undef modv
#undef xLs
#undef xCs
#undef KALL
#undef VALL
#undef PHASE_BEGIN
#undef PHASE_END
}

extern "C" void kernel_launch(void* const* d_in, const int* in_sizes, int n_in, void* d_out, int out_size, void* d_ws, size_t ws_size, hipStream_t stream) {
    static int grid = 0;
    if (grid == 0) {
        if (n_in != 21 || out_size != RL * D || ws_size < WS_END) { fprintf(stderr, "kernel_launch: unexpected shapes: n_in %d out %d ws %zu (need %zu)\n", n_in, out_size, ws_size, (size_t)WS_END); grid = -1; return; }
        int dev = 0, cus = 0, per_cu = 0;
        if (hipGetDevice(&dev) != hipSuccess || hipDeviceGetAttribute(&cus, hipDeviceAttributeMultiprocessorCount, dev) != hipSuccess) { grid = -1; return; }
        if (hipFuncSetAttribute((const void*)fwd, hipFuncAttributeMaxDynamicSharedMemorySize, LDS_TOTAL) != hipSuccess) { fprintf(stderr, "kernel_launch: hipFuncSetAttribute failed\n"); grid = -1; return; }
        if (hipOccupancyMaxActiveBlocksPerMultiprocessor(&per_cu, (const void*)fwd, NTHREADS, LDS_TOTAL) != hipSuccess || per_cu < 1) fprintf(stderr, "kernel_launch: occupancy query says %d\n", per_cu);
        (void)hipGetLastError();
        grid = cus;
    }
    if (grid < 0) return;
    (void)in_sizes;
    if (hipMemsetAsync((char*)d_ws + WS_CTL, 0, CTL_BYTES, stream) != hipSuccess) return;
    Args a{};
    for (int i = 0; i < 21; ++i) a.in[i] = (const float*)d_in[i];
    a.out = (float*)d_out; a.ws = (unsigned char*)d_ws;
    const int nph = N_PHASES < PH_LIMIT ? N_PHASES : PH_LIMIT;
#if N_LAUNCH_SPLIT
    for (int p = 0; p < nph; ++p) { a.ph_lo = p; a.ph_hi = p + 1; hipLaunchKernelGGL(fwd, dim3(grid), dim3(NTHREADS), LDS_TOTAL, stream, a); }
#else
    a.ph_lo = 0; a.ph_hi = nph;
    hipLaunchKernelGGL(fwd, dim3(grid), dim3(NTHREADS), LDS_TOTAL, stream, a);
#endif
    const hipError_t le = hipPeekAtLastError();
    if (le != hipSuccess) fprintf(stderr, "kernel_launch: launch failed: %s\n", hipGetErrorName(le));
}
```

```cpp
#include <hip/hip_runtime.h>
#include <cstdio>
#include <cstdint>

#define GAS __attribute__((address_space(1)))
#define LAS __attribute__((address_space(3)))
typedef unsigned short bf16_t;
typedef short bf16x8 __attribute__((ext_vector_type(8)));
typedef short s16x4 __attribute__((ext_vector_type(4)));
typedef float f32x4 __attribute__((ext_vector_type(4)));
typedef float f32x2 __attribute__((ext_vector_type(2)));
typedef float f32x16 __attribute__((ext_vector_type(16)));
typedef unsigned u32x4 __attribute__((ext_vector_type(4)));
typedef unsigned u32x2 __attribute__((ext_vector_type(2)));

constexpr int D = 1024, NB = 16, SEQ = 4096, CTXL = 256, DEPTH = 4;
constexpr int RL = NB * SEQ, RC = NB * CTXL, RT = RL + RC;
constexpr int NE = 16, CAP_L = 512, CAP_C = 32, SLOTS_E = NB * CAP_L + NB * CAP_C;
constexpr int NMI = NB + 1;
constexpr int MW_IN = 3088;
constexpr int KVLEN = CTXL + SEQ;
constexpr int NWAVES = 8, NTHREADS = 512;
constexpr float NORM_EPS = 1e-6f;

constexpr size_t al256(size_t x) { return (x + 255) & ~(size_t)255; }
constexpr size_t WS_CTL   = 0;
constexpr size_t CTL_BYTES = 16384;
constexpr size_t WS_PTRS  = WS_CTL + CTL_BYTES;
constexpr size_t WS_MODV  = WS_PTRS + 256;
constexpr size_t WS_ROPE  = al256(WS_MODV + (size_t)DEPTH * NMI * 6 * D * 4);
constexpr size_t WS_XC    = al256(WS_ROPE + (size_t)2 * SEQ * 32 * 4);
constexpr size_t WS_GATES = al256(WS_XC + (size_t)RC * D * 4);
constexpr size_t WS_AFF   = al256(WS_GATES + (size_t)RT * 16 * 4);
constexpr size_t WS_INV   = al256(WS_AFF + (size_t)RT * 16 * 4);
constexpr size_t WS_SLROW = al256(WS_INV + (size_t)RT * 16 * 4);
constexpr size_t WS_SLG   = al256(WS_SLROW + (size_t)NE * SLOTS_E * 4);
constexpr size_t WS_WMI   = al256(WS_SLG + (size_t)NE * SLOTS_E * 4);
constexpr size_t WS_WMO   = al256(WS_WMI + (size_t)2 * 3072 * D * 2);
constexpr size_t WS_WAI   = al256(WS_WMO + (size_t)2 * D * D * 2);
constexpr size_t WS_WAO   = al256(WS_WAI + (size_t)2 * 1536 * D * 2);
constexpr size_t WS_W1    = al256(WS_WAO + (size_t)2 * D * D * 2);
constexpr size_t WS_W2    = al256(WS_W1 + (size_t)NE * 2048 * D * 2);
constexpr size_t WS_H     = al256(WS_W2 + (size_t)NE * D * D * 2);
constexpr size_t WS_MIX   = al256(WS_H + (size_t)RT * D * 2);
constexpr size_t WS_BIG0  = al256(WS_MIX + (size_t)RT * D * 2);
constexpr size_t BIG_HALF = (size_t)NE * SLOTS_E * D * 2;
constexpr size_t WS_BIG1  = al256(WS_BIG0 + BIG_HALF);
constexpr size_t WS_END   = al256(WS_BIG1 + BIG_HALF);
static_assert((size_t)RT * 3072 * 2 <= 2 * BIG_HALF, "qkvo fits");

#define LDS_WAIT() asm volatile("s_waitcnt lgkmcnt(0)" ::: "memory")
#define VM_WAIT() asm volatile("s_waitcnt vmcnt(0)" ::: "memory")
typedef __bf16 bf16x2_t __attribute__((ext_vector_type(2)));
__device__ __forceinline__ unsigned pk2(float lo, float hi) { f32x2 v = {lo, hi}; bf16x2_t b = __builtin_convertvector(v, bf16x2_t); return __builtin_bit_cast(unsigned, b); }
__device__ __forceinline__ unsigned f2bf(float f) { return pk2(f, f) & 0xffffu; }
__device__ __forceinline__ float bf_lo(unsigned u) { return __builtin_bit_cast(float, u << 16); }
__device__ __forceinline__ float bf_hi(unsigned u) { return __builtin_bit_cast(float, u & 0xffff0000u); }
__device__ __forceinline__ float bf2f(bf16_t b) { return __builtin_bit_cast(float, ((unsigned)b) << 16); }
__device__ __forceinline__ unsigned pk_fp8x4(float a, float b, float c, float d) {
    a = __builtin_amdgcn_fmed3f(a, -448.f, 448.f); b = __builtin_amdgcn_fmed3f(b, -448.f, 448.f); c = __builtin_amdgcn_fmed3f(c, -448.f, 448.f); d = __builtin_amdgcn_fmed3f(d, -448.f, 448.f);
    int p = __builtin_amdgcn_cvt_pk_fp8_f32(a, b, 0, false); p = __builtin_amdgcn_cvt_pk_fp8_f32(c, d, p, true); return (unsigned)p; }
#ifndef MOE_FP8_1
#define MOE_FP8_1 1
#endif
#ifndef MOE_FP8_2
#define MOE_FP8_2 1
#endif
constexpr float FP8_SH = 16.f, FP8_SW = 512.f, FP8_SA = 8.f;
template <int CTRL> __device__ __forceinline__ float dpp_f(float old, float v) { return __builtin_bit_cast(float, __builtin_amdgcn_update_dpp(__builtin_bit_cast(int, old), __builtin_bit_cast(int, v), CTRL, 0xf, 0xf, false)); }
__device__ __forceinline__ float rdlane(float v, int l) { return __builtin_bit_cast(float, __builtin_amdgcn_readlane(__builtin_bit_cast(int, v), l)); }
__device__ __forceinline__ float row16_sum(float v) {
    v += dpp_f<0xB1>(0.f, v); v += dpp_f<0x4E>(0.f, v); v += dpp_f<0x141>(0.f, v); v += dpp_f<0x140>(0.f, v); return v; }
__device__ __forceinline__ float oct_sum(float v) {
    v += dpp_f<0xB1>(0.f, v); v += dpp_f<0x4E>(0.f, v); v += dpp_f<0x141>(0.f, v); return v; }
__device__ __forceinline__ float quad_sum(float v) { v += dpp_f<0xB1>(0.f, v); v += dpp_f<0x4E>(0.f, v); return v; }
__device__ __forceinline__ float wave_sum(float v) {
    v = row16_sum(v); return (rdlane(v, 0) + rdlane(v, 16)) + (rdlane(v, 32) + rdlane(v, 48)); }
__device__ __forceinline__ float wave_scan_add(float v, int lane) {
    v += dpp_f<0x111>(0.f, v); v += dpp_f<0x112>(0.f, v); v += dpp_f<0x114>(0.f, v); v += dpp_f<0x118>(0.f, v);
    const float t0 = rdlane(v, 15), t1 = rdlane(v, 31), t2 = rdlane(v, 47);
    const int row = lane >> 4; return v + (row == 0 ? 0.f : row == 1 ? t0 : row == 2 ? t0 + t1 : (t0 + t1) + t2); }
__device__ __forceinline__ float wave_scan_max(float v, int lane) {
    const float NI = -INFINITY;
    v = fmaxf(v, dpp_f<0x111>(NI, v)); v = fmaxf(v, dpp_f<0x112>(NI, v)); v = fmaxf(v, dpp_f<0x114>(NI, v)); v = fmaxf(v, dpp_f<0x118>(NI, v));
    const float t0 = rdlane(v, 15), t1 = rdlane(v, 31), t2 = rdlane(v, 47);
    const int row = lane >> 4; return fmaxf(v, row == 0 ? NI : row == 1 ? t0 : row == 2 ? fmaxf(t0, t1) : fmaxf(fmaxf(t0, t1), t2)); }
__device__ __forceinline__ float fast_exp(float x) { return __builtin_amdgcn_exp2f(x * 1.4426950408889634f); }
__device__ __forceinline__ float fast_rcp(float x) { return __builtin_amdgcn_rcpf(x); }
__device__ __forceinline__ float silu_f(float x) { return x / (1.f + __expf(-x)); }

#define XB_TMO      128
#define XB_XCNT(j)  (256  + 64 * (j))
#define XB_XSUB(j)  (1280 + 64 * (j))
#define XB_XGEN(j)  (2304 + 64 * (j))
#define XB_TOP      3328
#define XB_TOPGEN   3392
#define XCD_BAR_WORDS 3456
#define XB_SPIN_CAP (1u << 21)
static_assert(XCD_BAR_WORDS * 4 <= CTL_BYTES, "ctl");

__device__ __forceinline__ unsigned xb_ld(unsigned* p)              { return __hip_atomic_load(p, __ATOMIC_RELAXED, __HIP_MEMORY_SCOPE_AGENT); }
__device__ __forceinline__ unsigned xb_add(unsigned* p, unsigned v) { return __hip_atomic_fetch_add(p, v, __ATOMIC_RELAXED, __HIP_MEMORY_SCOPE_AGENT); }
__device__ __forceinline__ unsigned xb_xcc_id() { return (unsigned)__builtin_amdgcn_s_getreg((3 << 11) | 20) & 0xFu; }
#define XB_SPIN(cond, bar) do { unsigned _sp = 0; while (cond) { __builtin_amdgcn_s_sleep(1); \
    if ((++_sp & 255u) == 0u) { if (xb_ld(&(bar)[XB_TMO])) break; if (_sp > XB_SPIN_CAP) { atomicAdd(&(bar)[XB_TMO], 1u); break; } } } } while (0)

struct XcdBarrier { unsigned* bar; unsigned x; volatile LAS unsigned* st; };

__device__ __forceinline__ XcdBarrier xcd_barrier_post(unsigned* bar, volatile LAS unsigned* st) {
    XcdBarrier b; b.bar = bar; b.x = xb_xcc_id(); b.st = st;
    if (threadIdx.x == 0) (void)xb_add(&bar[XB_XCNT(b.x)], 1u);
    return b;
}
__device__ __forceinline__ void xcd_barrier_complete(unsigned* bar, unsigned x, unsigned& nloc, unsigned& nx) {
    const unsigned G = gridDim.x * gridDim.y * gridDim.z;
    unsigned sum, cnt, mine, sp = 0u;
    for (;;) {
        sum = 0u; cnt = 0u; mine = 0u;
#pragma unroll
        for (unsigned j = 0; j < 16; ++j) { const unsigned c = xb_ld(&bar[XB_XCNT(j)]); sum += c; cnt += (c > 0u) ? 1u : 0u; mine = (j == x) ? c : mine; }
        if (sum == G) break;
        __builtin_amdgcn_s_sleep(1);
        if ((++sp & 255u) == 0u) { if (xb_ld(&bar[XB_TMO])) break; if (sp > XB_SPIN_CAP) { atomicAdd(&bar[XB_TMO], 1u); break; } }
    }
    nloc = mine > 0u ? mine : 1u; nx = cnt > 0u ? cnt : 1u;
}
__device__ __forceinline__ void xcd_barrier(const XcdBarrier& b) {
    asm volatile("s_waitcnt vmcnt(0)" ::: "memory");
    __syncthreads();
    if (threadIdx.x == 0) {
        unsigned* bar = b.bar;
        __builtin_amdgcn_s_waitcnt(0);
        unsigned nloc = b.st[0], nx = b.st[1];
        if (nloc == 0u) { xcd_barrier_complete(bar, b.x, nloc, nx); b.st[0] = nloc; b.st[1] = nx; }
        const unsigned old = xb_add(&bar[XB_XSUB(b.x)], 1u);
        const unsigned gen = old / nloc;
        if (old + 1u == (gen + 1u) * nloc) {
            __builtin_amdgcn_fence(__ATOMIC_RELEASE, "agent");
            asm volatile("s_waitcnt vmcnt(0)" ::: "memory");
            const unsigned og = xb_add(&bar[XB_TOP], 1u);
            const unsigned tg = og / nx;
            if (og + 1u == (tg + 1u) * nx) xb_add(&bar[XB_TOPGEN], 1u);
            else XB_SPIN(xb_ld(&bar[XB_TOPGEN]) == tg, bar);
            __builtin_amdgcn_fence(__ATOMIC_ACQUIRE, "agent");
            xb_add(&bar[XB_XGEN(b.x)], 1u);
            asm volatile("s_waitcnt vmcnt(0)" ::: "memory");
        } else {
            XB_SPIN(xb_ld(&bar[XB_XGEN(b.x)]) == gen, bar);
            __builtin_amdgcn_fence(__ATOMIC_ACQUIRE, "agent");
            asm volatile("s_waitcnt vmcnt(0)" ::: "memory");
        }
    }
    __syncthreads();
}
namespace pg8 {
constexpr int BM = 256, BK = 64, HALF = 128, HTB = HALF * BK * 2, STAGE_BYTES = 8 * HTB, NXCD = 8, WGM = 8;

__host__ __device__ __forceinline__ int lds_byte(int r, int c) { const int st = (r >> 4) * 2 + (c >> 5), rr = r & 15, cc = c & 31, ob = rr * 64 + cc * 2; return st * 1024 + (ob ^ (((ob >> 9) & 1) << 5)); }
__host__ __device__ __forceinline__ void stage_rc(int b, int& R, int& C) { const int st = b / 1024, sb = b % 1024, swz = sb ^ (((sb >> 9) & 1) << 5); R = (st >> 1) * 16 + swz / 64; C = (st & 1) * 32 + (swz % 64) / 2; }
__host__ __device__ __forceinline__ int perm32(int rho) { const int n = rho >> 4, i = rho & 15; return 8 * (i >> 2) + 4 * n + (i & 3); }

struct Unit { const char* A; const char* B; int pm, pn; };

__device__ __forceinline__ bool static_tile(int i, int G, int c, int nM, int nN, int& pm, int& pn) {
    const int nwg = nM * nN; const long L = (long)i * G + c; if (L >= nwg) return false;
    int wgid = (int)L; { const int q = nwg / NXCD, r = nwg % NXCD, xcd = wgid % NXCD, off = wgid / NXCD; wgid = (xcd < r ? xcd * (q + 1) : r * (q + 1) + (xcd - r) * q) + off; }
    const int nig = WGM * nN, gid = wgid / nig, fm = gid * WGM, gsz = (nM - fm) < WGM ? (nM - fm) : WGM;
    pm = fm + ((wgid % nig) % gsz); pn = (wgid % nig) / gsz; return true;
}
struct PlainSched {
    const char* A; const char* Bt; int nM, nN, K, G, c;
    __device__ __forceinline__ bool next(int i, Unit& u) const {
        int pm, pn; if (!static_tile(i, G, c, nM, nN, pm, pn)) return false;
        u.pm = pm; u.pn = pn; u.A = A + (size_t)pm * 256 * K * 2; u.B = Bt + (size_t)pn * 256 * K * 2; return true;
    }
};
struct MoeSched {
    const char* A; const char* W; int tpe, nN, K, bN, G, c;
    __device__ __forceinline__ bool next(int i, Unit& u) const {
        int pm, pn; if (!static_tile(i, G, c, NE * tpe, nN, pm, pn)) return false;
        const int e = pm / tpe, rt = pm - e * tpe;
        u.pm = e * (SLOTS_E / 256) + rt; u.pn = pn;
        u.A = A + (size_t)u.pm * 256 * K * 2; u.B = W + ((size_t)e * bN + (size_t)pn * 256) * K * 2; return true;
    }
};

__device__ __forceinline__ unsigned cvt_pk_bf16(float lo, float hi) { return pk2(lo, hi); }


struct EpiBf16 {
    static constexpr bool PERM = true;
    bf16_t* O; int ldc; int nscale; float scale;
    __device__ __forceinline__ void operator()(const f32x4 (&acc)[2][2][4][2], const Unit& u, int wr, int wc, int fr, int fq) const {
        const int row0 = u.pm * BM + wr * 64 + fr, col0 = u.pn * BM + wc * 32 + 8 * fq;
        const float s = (u.pn < nscale) ? scale : 1.f;
#pragma unroll
        for (int ai = 0; ai < 2; ++ai)
#pragma unroll
            for (int m = 0; m < 4; ++m) { bf16_t* rowp = O + (size_t)(row0 + ai * HALF + m * 16) * ldc + col0;
#pragma unroll
                for (int bj = 0; bj < 2; ++bj) { const f32x4 v0 = acc[ai][bj][m][0] * s, v1 = acc[ai][bj][m][1] * s;
                    u32x4 o; o.x = cvt_pk_bf16(v0[0], v0[1]); o.y = cvt_pk_bf16(v0[2], v0[3]); o.z = cvt_pk_bf16(v1[0], v1[1]); o.w = cvt_pk_bf16(v1[2], v1[3]);
                    *(u32x4*)(rowp + bj * HALF) = o; } }
    }
};
struct EpiResid {
    static constexpr bool PERM = false;
    const float* srcL; const float* srcC; float* dstL; float* dstC; const float* gate;
    __device__ __forceinline__ void operator()(const f32x4 (&acc)[2][2][4][2], const Unit& u, int wr, int wc, int fr, int fq) const {
        const bool isc = u.pm >= RL / 256;
        const int mi = isc ? NB : (u.pm >> 4);
        const int rbase = (isc ? (u.pm - RL / 256) : u.pm) * BM + wr * 64 + fr, col0 = u.pn * BM + wc * 32 + 4 * fq;
        const float* src = isc ? srcC : srcL; float* dst = isc ? dstC : dstL;
        const float* gp = gate + (size_t)mi * 6 * D + col0;
        f32x4 gv[2][2];
#pragma unroll
        for (int bj = 0; bj < 2; ++bj)
#pragma unroll
            for (int n = 0; n < 2; ++n) gv[bj][n] = *(const f32x4*)(gp + bj * HALF + n * 16);
#pragma unroll
        for (int ai = 0; ai < 2; ++ai)
#pragma unroll
            for (int m = 0; m < 4; ++m) { const size_t ro = (size_t)(rbase + ai * HALF + m * 16) * D + col0;
#pragma unroll
                for (int bj = 0; bj < 2; ++bj)
#pragma unroll
                    for (int n = 0; n < 2; ++n) { const f32x4 xv = *(const f32x4*)(src + ro + bj * HALF + n * 16);
                        *(f32x4*)(dst + ro + bj * HALF + n * 16) = xv + gv[bj][n] * acc[ai][bj][m][n]; } }
    }
};
struct EpiSwiglu {
    static constexpr bool PERM = true;
    void* O; float ds; bool f8out;
    __device__ __forceinline__ void operator()(const f32x4 (&acc)[2][2][4][2], const Unit& u, int wr, int wc, int fr, int fq) const {
        const int row0 = u.pm * BM + wr * 64 + fr, col0 = u.pn * HALF + wc * 32 + 8 * fq;
#pragma unroll
        for (int ai = 0; ai < 2; ++ai)
#pragma unroll
            for (int m = 0; m < 4; ++m) { const size_t ro = (size_t)(row0 + ai * HALF + m * 16) * D + col0;
                float r[8];
#pragma unroll
                for (int n = 0; n < 2; ++n)
#pragma unroll
                    for (int j = 0; j < 4; ++j) { const float g = acc[ai][0][m][n][j] * ds, up = acc[ai][1][m][n][j] * ds; r[n * 4 + j] = g * fast_rcp(1.f + fast_exp(-g)) * up; }
                if (f8out) { u32x2 o; o.x = pk_fp8x4(r[0] * FP8_SA, r[1] * FP8_SA, r[2] * FP8_SA, r[3] * FP8_SA); o.y = pk_fp8x4(r[4] * FP8_SA, r[5] * FP8_SA, r[6] * FP8_SA, r[7] * FP8_SA);
                    *(u32x2*)((unsigned char*)O + ro) = o; }
                else { u32x4 o; o.x = cvt_pk_bf16(r[0], r[1]); o.y = cvt_pk_bf16(r[2], r[3]); o.z = cvt_pk_bf16(r[4], r[5]); o.w = cvt_pk_bf16(r[6], r[7]);
                    *(u32x4*)((bf16_t*)O + ro) = o; } }
    }
};
struct EpiRowScale {
    static constexpr bool PERM = true;
    bf16_t* O; const float* g; float ds;
    __device__ __forceinline__ void operator()(const f32x4 (&acc)[2][2][4][2], const Unit& u, int wr, int wc, int fr, int fq) const {
        const int row0 = u.pm * BM + wr * 64 + fr, col0 = u.pn * BM + wc * 32 + 8 * fq;
#pragma unroll
        for (int ai = 0; ai < 2; ++ai)
#pragma unroll
            for (int m = 0; m < 4; ++m) { const int row = row0 + ai * HALF + m * 16; const float s = g[row] * ds; bf16_t* rowp = O + (size_t)row * D + col0;
#pragma unroll
                for (int bj = 0; bj < 2; ++bj) { const f32x4 v0 = acc[ai][bj][m][0] * s, v1 = acc[ai][bj][m][1] * s;
                    u32x4 o; o.x = cvt_pk_bf16(v0[0], v0[1]); o.y = cvt_pk_bf16(v0[2], v0[3]); o.z = cvt_pk_bf16(v1[0], v1[1]); o.w = cvt_pk_bf16(v1[2], v1[3]);
                    *(u32x4*)(rowp + bj * HALF) = o; } }
    }
};

template <class Epi, class Sched, bool GATHER = false, bool FP8 = false>
__device__ __forceinline__ void gemm_phase(LAS unsigned char* lds, const int tid, const int K, const Sched& S, const Epi& E, const int* rowidx = nullptr) {
    const int wid = __builtin_amdgcn_readfirstlane(tid >> 6), lane = tid & 63, wr = wid >> 2, wc = wid & 3, fr = lane & 15, fq = lane >> 4;
    const int nt = K / BK;
    unsigned voffA[2], voffB[2]; int gR[2], gC[2];
#pragma unroll
    for (int i = 0; i < 2; ++i) { int R, C; stage_rc(tid * 16 + i * 8192, R, C); const int Rb = Epi::PERM ? ((R & ~31) + perm32(R & 31)) : R;
        voffA[i] = (unsigned)(R * K + C) * 2u; voffB[i] = (unsigned)(Rb * K + C) * 2u; gR[i] = R; gC[i] = C * 2; }
    unsigned gcur[2][2], gnxt[2][2];
#define PG8_GIDX(dst, unit) do { if (GATHER) { _Pragma("unroll") for (int h_ = 0; h_ < 2; ++h_) _Pragma("unroll") for (int i_ = 0; i_ < 2; ++i_) \
        dst[h_][i_] = (unsigned)rowidx[(unit).pm * 256 + h_ * 128 + gR[i_]] * (unsigned)(K * 2) + (unsigned)gC[i_]; } } while (0)
    const size_t kstep = (size_t)(BK * 2);
    const size_t hstep = (size_t)HALF * K * 2;
    const unsigned ldsw = (unsigned)wid * 1024u;
    const int aoff = lds_byte(wr * 64 + fr, fq * 8), boff = lds_byte(wc * 32 + fr, fq * 8);
#define PG8_SA(b, h) (((b) * 2 + (h)) * HTB)
#define PG8_SB(b, h) ((4 + (b) * 2 + (h)) * HTB)
#define PG8_STAGE(bufoff, gbase, voff) do { _Pragma("unroll") for (int _i = 0; _i < 2; ++_i) \
        __builtin_amdgcn_global_load_lds((const unsigned*)((const char*)(gbase) + (voff)[_i]), (LAS unsigned*)(lds + (bufoff) + ldsw + _i * 8192), 16, 0, 0); } while (0)
#define PG8_STAGE_A(b, h, gbase, NX) do { if (GATHER) { unsigned go_[2]; go_[0] = (NX) ? gnxt[h][0] : gcur[h][0]; go_[1] = (NX) ? gnxt[h][1] : gcur[h][1]; PG8_STAGE(PG8_SA(b, h), (gbase), go_); } \
        else { PG8_STAGE(PG8_SA(b, h), (gbase) + (h) * hstep, voffA); } } while (0)
#define PG8_LDA(dst, b, h) do { _Pragma("unroll") for (int m = 0; m < 4; ++m) _Pragma("unroll") for (int k = 0; k < 2; ++k) dst[m][k] = *(const LAS bf16x8*)(lds + PG8_SA(b, h) + aoff + m * 2048 + k * 1024); } while (0)
#define PG8_LDB(dst, b, h) do { _Pragma("unroll") for (int n = 0; n < 2; ++n) _Pragma("unroll") for (int k = 0; k < 2; ++k) dst[n][k] = *(const LAS bf16x8*)(lds + PG8_SB(b, h) + boff + n * 2048 + k * 1024); } while (0)
#define PG8_MMA(ai, bj, At, Bt) do { __builtin_amdgcn_s_setprio(1); if (FP8) { _Pragma("unroll") for (int m = 0; m < 4; ++m) _Pragma("unroll") for (int n = 0; n < 2; ++n) { \
            typedef int v8i_ __attribute__((ext_vector_type(8))); typedef int v4i_ __attribute__((ext_vector_type(4))); \
            const v4i_ b0_ = __builtin_bit_cast(v4i_, Bt[n][0]), b1_ = __builtin_bit_cast(v4i_, Bt[n][1]), a0_ = __builtin_bit_cast(v4i_, At[m][0]), a1_ = __builtin_bit_cast(v4i_, At[m][1]); \
            const v8i_ bb_ = {b0_[0], b0_[1], b0_[2], b0_[3], b1_[0], b1_[1], b1_[2], b1_[3]}, aa_ = {a0_[0], a0_[1], a0_[2], a0_[3], a1_[0], a1_[1], a1_[2], a1_[3]}; \
            asm volatile("v_mfma_scale_f32_16x16x128_f8f6f4 %0, %1, %2, %0, %3, %3 op_sel_hi:[0,0,0]" : "+v"(acc[ai][bj][m][n]) : "v"(bb_), "v"(aa_), "v"(sc127)); } } \
        else { _Pragma("unroll") for (int m = 0; m < 4; ++m) _Pragma("unroll") for (int n = 0; n < 2; ++n) _Pragma("unroll") for (int k = 0; k < 2; ++k) \
        acc[ai][bj][m][n] = __builtin_amdgcn_mfma_f32_16x16x32_bf16(Bt[n][k], At[m][k], acc[ai][bj][m][n], 0, 0, 0); } __builtin_amdgcn_s_setprio(0); } while (0)
#define PG8_WAIT_V(n) asm volatile("s_waitcnt vmcnt(" #n ")" ::: "memory")
#define PG8_WAIT_L(n) asm volatile("s_waitcnt lgkmcnt(" #n ")" ::: "memory")
#define PG8_BAR __builtin_amdgcn_s_barrier()
#define PG8_SCHED __builtin_amdgcn_sched_barrier(0)
    Unit cur, nxt; int ui = 0;
    if (!S.next(0, cur)) return;
    int sc127 = 0x7F7F7F7F; asm volatile("" : "+v"(sc127));
    f32x4 acc[2][2][4][2];
#pragma unroll
    for (int a = 0; a < 2; ++a)
#pragma unroll
        for (int b = 0; b < 2; ++b)
#pragma unroll
            for (int m = 0; m < 4; ++m)
#pragma unroll
                for (int n = 0; n < 2; ++n) acc[a][b][m][n] = (f32x4){0.f, 0.f, 0.f, 0.f};
    bf16x8 At[4][2], B0[2][2], B1[2][2];
    const char* cA = GATHER ? S.A : cur.A; const char* cB = cur.B;
    PG8_GIDX(gcur, cur);
    PG8_STAGE(PG8_SB(0, 0), cB, voffB); PG8_STAGE(PG8_SB(0, 1), cB + hstep, voffB); PG8_STAGE_A(0, 0, cA, false); PG8_STAGE_A(0, 1, cA, false);
    if (wr == 1) PG8_BAR;
    PG8_WAIT_V(2); PG8_BAR;
    PG8_STAGE(PG8_SB(1, 0), cB + kstep, voffB); PG8_STAGE_A(1, 0, cA + kstep, false); PG8_STAGE(PG8_SB(1, 1), cB + hstep + kstep, voffB);
    PG8_WAIT_V(6); PG8_BAR;
    for (;;) {
        const bool has_next = S.next(ui + 1, nxt);
        const char* nA = (has_next && !GATHER) ? nxt.A : cA; const char* nB = has_next ? nxt.B : cB;
        if (GATHER) { if (has_next) { PG8_GIDX(gnxt, nxt); } else { _Pragma("unroll") for (int h_ = 0; h_ < 2; ++h_) { gnxt[h_][0] = gcur[h_][0]; gnxt[h_][1] = gcur[h_][1]; } } }
#pragma unroll 1
        for (int t = 0; t < nt; t += 2) {
            const bool last = (t == nt - 2);
            const char* a1 = cA + (size_t)(t + 1) * kstep;
            const char* a2 = last ? nA : cA + (size_t)(t + 2) * kstep; const char* b2 = last ? nB : cB + (size_t)(t + 2) * kstep;
            const char* a3 = a2 + kstep; const char* b3 = b2 + kstep;
            PG8_LDB(B0, 0, 0); PG8_LDB(B1, 0, 1); PG8_SCHED; PG8_LDA(At, 0, 0); PG8_STAGE_A(1, 1, a1, false);
            PG8_WAIT_V(8); PG8_WAIT_L(0); PG8_BAR; PG8_MMA(0, 0, At, B0); PG8_MMA(0, 1, At, B1); PG8_BAR; PG8_SCHED;
            PG8_LDA(At, 0, 1); PG8_STAGE(PG8_SB(0, 0), b2, voffB); PG8_STAGE(PG8_SB(0, 1), b2 + hstep, voffB); PG8_STAGE_A(0, 0, a2, last);
            PG8_WAIT_V(8); PG8_WAIT_L(0); PG8_BAR; PG8_MMA(1, 0, At, B0); PG8_MMA(1, 1, At, B1); PG8_BAR; PG8_SCHED;
            PG8_LDB(B0, 1, 0); PG8_LDB(B1, 1, 1); PG8_SCHED; PG8_LDA(At, 1, 0); PG8_STAGE_A(0, 1, a2, last);
            PG8_WAIT_V(8); PG8_WAIT_L(0); PG8_BAR; PG8_MMA(0, 0, At, B0); PG8_MMA(0, 1, At, B1); PG8_BAR; PG8_SCHED;
            PG8_LDA(At, 1, 1); PG8_STAGE(PG8_SB(1, 0), b3, voffB); PG8_STAGE(PG8_SB(1, 1), b3 + hstep, voffB); PG8_STAGE_A(1, 0, a3, last);
            PG8_WAIT_V(8); PG8_WAIT_L(0); PG8_BAR; PG8_MMA(1, 0, At, B0); PG8_MMA(1, 1, At, B1); PG8_BAR; PG8_SCHED;
        }
        if (wr == 0) PG8_BAR;
        if (FP8) asm volatile("s_nop 15\n\ts_nop 15" ::: "memory");
        { int tz = tid; asm volatile("" : "+v"(tz));
          const int wid2 = __builtin_amdgcn_readfirstlane(tz >> 6), lane2 = tz & 63;
          E(acc, cur, wid2 >> 2, wid2 & 3, lane2 & 15, lane2 >> 4); }
        if (!has_next) break;
#pragma unroll
        for (int a = 0; a < 2; ++a)
#pragma unroll
            for (int b = 0; b < 2; ++b)
#pragma unroll
                for (int m = 0; m < 4; ++m)
#pragma unroll
                    for (int n = 0; n < 2; ++n) acc[a][b][m][n] = (f32x4){0.f, 0.f, 0.f, 0.f};
        cur = nxt; cA = nA; cB = nB; ++ui;
        if (GATHER) { _Pragma("unroll") for (int h_ = 0; h_ < 2; ++h_) { gcur[h_][0] = gnxt[h_][0]; gcur[h_][1] = gnxt[h_][1]; } }
        if (wr == 1) PG8_BAR;
    }
    PG8_WAIT_V(0);
    PG8_BAR;
#undef PG8_SA
#undef PG8_SB
#undef PG8_STAGE
#undef PG8_STAGE_A
#undef PG8_GIDX
#undef PG8_LDA
#undef PG8_LDB
#undef PG8_MMA
#undef PG8_WAIT_V
#undef PG8_WAIT_L
#undef PG8_BAR
#undef PG8_SCHED
}
}
namespace attn_body {
constexpr int NW = 8, QBLK = 32, QB = QBLK * NW, KVBLK = 64;
__device__ __forceinline__ int crow(int r, int hi) { return (r & 3) + 8 * (r >> 2) + 4 * hi; }
#define SBAR() __builtin_amdgcn_sched_barrier(0)
constexpr int NSLOT = 3, SLOTB = 8192;
constexpr int LDS_K = 0, LDS_V = NSLOT * SLOTB, LDS_WS = 2 * NSLOT * SLOTB, LDS_OST = LDS_WS + NW * 64 * 4, LDS_BYTES = LDS_OST + NW * 4096;
constexpr float C2 = 0.125f * 1.4426950408889634f;
__device__ __forceinline__ void glds16(const void* gsrc, unsigned lds_dst) { unsigned keep;
  asm volatile("s_mov_b32 %0, m0\n\ts_mov_b32 m0, %2\n\ts_nop 0\n\tglobal_load_lds_dwordx4 %1, off\n\ts_mov_b32 m0, %0" : "=&s"(keep) : "v"(gsrc), "s"(lds_dst) : "memory"); }
__device__ __forceinline__ float max3f(float a, float b, float c) { float r; asm("v_max3_f32 %0, %1, %2, %3" : "=v"(r) : "v"(a), "v"(b), "v"(c)); return r; }
__device__ __forceinline__ float max2f(float a, float b) { float r; asm("v_max_f32_e32 %0, %1, %2" : "=v"(r) : "v"(a), "v"(b)); return r; }
__device__ __forceinline__ float fadd_s(float a, float b) { float r; asm("v_add_f32_e32 %0, %1, %2" : "=v"(r) : "v"(a), "v"(b)); return r; }
__device__ __forceinline__ float fsub_s(float a, float b) { float r; asm("v_sub_f32_e32 %0, %1, %2" : "=v"(r) : "v"(a), "v"(b)); return r; }
__device__ __forceinline__ unsigned cvtpk_s(float lo, float hi) { f32x2 v = {lo, hi}; bf16x2_t b = __builtin_convertvector(v, bf16x2_t); return __builtin_bit_cast(unsigned, b); }
#define WAIT_BAR(N) asm volatile("s_waitcnt vmcnt(" #N ") lgkmcnt(0)\n\ts_barrier" ::: "memory")

__device__ __forceinline__ void qkt(f32x16& p0, f32x16& p1, const char* Kslot, const bf16x8* qr, const f32x16& negm, int r32, int hi) {
  const char* kb = Kslot + hi * 1024 + r32 * 16;
  #pragma unroll
  for (int d0 = 0; d0 < 4; ++d0) {
    const bf16x8 b0 = *reinterpret_cast<const bf16x8*>(kb + d0 * 2048);
    const bf16x8 b1 = *reinterpret_cast<const bf16x8*>(kb + d0 * 2048 + 512);
    if (d0 == 0) { p0 = __builtin_amdgcn_mfma_f32_32x32x16_bf16(b0, qr[0], negm, 0, 0, 0); p1 = __builtin_amdgcn_mfma_f32_32x32x16_bf16(b1, qr[0], negm, 0, 0, 0); }
    else { p0 = __builtin_amdgcn_mfma_f32_32x32x16_bf16(b0, qr[d0], p0, 0, 0, 0); p1 = __builtin_amdgcn_mfma_f32_32x32x16_bf16(b1, qr[d0], p1, 0, 0, 0); } }
}
typedef __attribute__((address_space(3))) const char* lds_cptr;
typedef short v4i16_t __attribute__((ext_vector_type(4)));
__device__ __forceinline__ void kload8(bf16x8* kf, lds_cptr kp) {
  kf[0] = *(const LAS bf16x8*)(kp);        kf[1] = *(const LAS bf16x8*)(kp + 512);
  kf[2] = *(const LAS bf16x8*)(kp + 2048); kf[3] = *(const LAS bf16x8*)(kp + 2560);
  kf[4] = *(const LAS bf16x8*)(kp + 4096); kf[5] = *(const LAS bf16x8*)(kp + 4608);
  kf[6] = *(const LAS bf16x8*)(kp + 6144); kf[7] = *(const LAS bf16x8*)(kp + 6656);
}
__device__ __forceinline__ void kload2(bf16x8* kf, lds_cptr kp, int j) { kf[2 * j] = *(const LAS bf16x8*)(kp + j * 2048); kf[2 * j + 1] = *(const LAS bf16x8*)(kp + j * 2048 + 512); }
__device__ __forceinline__ s16x4 vtr(lds_cptr p) { return __builtin_bit_cast(s16x4, __builtin_amdgcn_ds_read_tr16_b64_v4i16((LAS v4i16_t*)p)); }
__device__ __forceinline__ float rowmax(const f32x16& p0, const f32x16& p1) {
  float a = max3f(p0[0], p0[1], p1[0]), b = max3f(p0[2], p0[3], p1[1]); a = max3f(a, p1[2], p1[3]);
  #pragma unroll
  for (int r = 4; r < 16; r += 4) { a = max3f(a, p0[r], p0[r + 1]); b = max3f(b, p0[r + 2], p0[r + 3]); a = max3f(a, p1[r], p1[r + 1]); b = max3f(b, p1[r + 2], p1[r + 3]); }
  const float m = max2f(a, b);
  auto rr = __builtin_amdgcn_permlane32_swap(__float_as_uint(m), __float_as_uint(m), false, false);
  return max2f(__uint_as_float(rr[0]), __uint_as_float(rr[1]));
}
__device__ __forceinline__ void pv(f32x16* o, int vb, bf16x8 pa0, bf16x8 pa1, bf16x8 pa2, bf16x8 pa3) {
  #pragma unroll
  for (int d0 = 0; d0 < 2; ++d0) { s16x4 lo[4], hi[4];
    #pragma unroll
    for (int ks = 0; ks < 4; ++ks) {
      asm volatile("ds_read_b64_tr_b16 %0,%1 offset:%c2" : "=&v"(lo[ks]) : "v"(vb), "i"(d0 * 4096 + ks * 1024) : "memory");
      asm volatile("ds_read_b64_tr_b16 %0,%1 offset:%c2" : "=&v"(hi[ks]) : "v"(vb), "i"(d0 * 4096 + ks * 1024 + 512) : "memory"); }
    asm volatile("s_waitcnt lgkmcnt(0)" ::: "memory"); SBAR();
    #define PK(k) (bf16x8){lo[k][0], lo[k][1], lo[k][2], lo[k][3], hi[k][0], hi[k][1], hi[k][2], hi[k][3]}
    o[d0] = __builtin_amdgcn_mfma_f32_32x32x16_bf16(pa0, PK(0), o[d0], 0, 0, 0);
    o[d0] = __builtin_amdgcn_mfma_f32_32x32x16_bf16(pa1, PK(1), o[d0], 0, 0, 0);
    o[d0] = __builtin_amdgcn_mfma_f32_32x32x16_bf16(pa2, PK(2), o[d0], 0, 0, 0);
    o[d0] = __builtin_amdgcn_mfma_f32_32x32x16_bf16(pa3, PK(3), o[d0], 0, 0, 0);
    #undef PK
  }
}

template <int THRL> __device__ __forceinline__ void attn_unit(const bf16_t* Qrow0, int QP, const bf16_t* __restrict__ Kh, const bf16_t* __restrict__ Vh, int KVP, int NT, bf16_t* Orow0, int OP, char* shm, const int tid) {
  const int lane = tid & 63, r32 = lane & 31, hi = lane >> 5; const int wid = __builtin_amdgcn_readfirstlane(tid >> 6);
  const bf16_t* Qw = Qrow0 + (long)(wid * QBLK) * QP;
  const unsigned lds0 = (unsigned)(uintptr_t)shm;
  float* wsf = (float*)(shm + LDS_WS) + wid * 64;
  const bf16_t* ksrc = Kh + (long)lane * KVP + wid * 8;
  const bf16_t* vsrc = Vh + (long)(16 * (wid & 3) + (lane >> 2)) * KVP + (wid >> 2) * 32 + (lane & 3) * 8;
  const unsigned kdst = lds0 + LDS_K + wid * 1024, vdst = lds0 + LDS_V + wid * 1024;
  #define DMA_K(t, slot) glds16(ksrc + (long)(t) * KVBLK * KVP, (unsigned)__builtin_amdgcn_readfirstlane(kdst + (slot)))
  #define DMA_V(t, slot) glds16(vsrc + (long)(t) * KVBLK * KVP, (unsigned)__builtin_amdgcn_readfirstlane(vdst + (slot)))
  const int vb0 = (int)(lds0 + LDS_V) + ((lane >> 4) & 1) * 32 + (lane & 3) * 8 + (4 * hi + ((lane & 15) >> 2)) * 64;
  const char* Kbase = shm + LDS_K; bf16x8 kf[8];
  const lds_cptr shm3 = (lds_cptr)shm; const lds_cptr kp0 = shm3 + LDS_K + hi * 1024 + r32 * 16; const lds_cptr vp0 = shm3 + LDS_V + ((lane >> 4) & 1) * 32 + (lane & 3) * 8 + (4 * hi + ((lane & 15) >> 2)) * 64;
  DMA_K(0, 0); DMA_V(0, 0); DMA_K(1, SLOTB);
  bf16x8 qr[4];
  #pragma unroll
  for (int d0 = 0; d0 < 4; ++d0) qr[d0] = *reinterpret_cast<const bf16x8*>(&Qw[(long)r32 * QP + d0 * 16 + hi * 8]);
  float mhat = 0.f, l_reg = 0.f; f32x16 o[2]; o[0] = f32x16{}; o[1] = f32x16{}; f32x16 negm = f32x16{}; asm volatile("" : "+v"(negm));
  bool resc = false;
  #define START(P0, P1) do { const float rm = rowmax(P0, P1); resc = false; \
    { const float dl = rm; mhat = fadd_s(mhat, dl); \
      _Pragma("unroll") for (int r = 0; r < 16; ++r) { P0[r] = fsub_s(P0[r], dl); P1[r] = fsub_s(P1[r], dl); } \
      _Pragma("unroll") for (int r = 0; r < 16; ++r) negm[r] = -mhat; asm volatile("" : "+v"(negm)); } \
    _Pragma("unroll") for (int r = 0; r < 16; ++r) P0[r] = __builtin_amdgcn_exp2f(P0[r]); } while (0)
  #define RESC() do { if (resc) { asm volatile("s_waitcnt lgkmcnt(0)" ::: "memory"); \
      _Pragma("unroll") for (int d_ = 0; d_ < 2; ++d_) _Pragma("unroll") for (int r = 0; r < 16; ++r) o[d_][r] *= wsf[crow(r, hi)]; } } while (0)
  f32x16 pA0, pA1, pB0, pB1;
  int sl_prev = 0, sl_cur = 0, sl_next = SLOTB;
  #define ROT() do { sl_prev = sl_cur; sl_cur = sl_next; sl_next = (sl_next == (NSLOT - 1) * SLOTB) ? 0 : sl_next + SLOTB; } while (0)
  DMA_K(2, 2 * SLOTB);
  WAIT_BAR(3);
  qkt(pA0, pA1, Kbase, qr, negm, r32, hi); asm volatile("s_nop 15\n\ts_nop 7" : "+v"(pA0), "+v"(pA1));
  START(pA0, pA1);
  _Pragma("unroll") for (int r = 0; r < 16; ++r) pA1[r] = __builtin_amdgcn_exp2f(pA1[r]);
  WAIT_BAR(0);
  DMA_K(3, 0); DMA_V(1, SLOTB);
  ROT();
  kload8(kf, kp0 + sl_cur);
  WAIT_BAR(2);
  s16x4 vlo[8], vhi[8]; u32x4 pw0, pw1, pw2, pw3;
  #define PKW(P, B) cvtpk_s(P[B], P[B + 1])
  #define PAF(k) __builtin_bit_cast(bf16x8, pw##k)
  #define VFR(i) (bf16x8){vlo[i][0], vlo[i][1], vlo[i][2], vlo[i][3], vhi[i][0], vhi[i][1], vhi[i][2], vhi[i][3]}
  #define PIN(x) asm volatile("" : "+v"(x))
  #define MX3(a, b, c) __builtin_fmaxf(__builtin_fmaxf((a), (b)), (c))
  #define GAPA(MF, A0, A1, A2, A3, W0, W1, PW) do { MF; sacc += A0; sacc += A1; sacc += A2; sacc += A3; PIN(sacc); W0; W1; PIN(PW); SBAR(); } while (0)
  #define EX(v) __builtin_amdgcn_exp2f(v)
  #define GAPB(MF, X, B) do { MF; X[B] = EX(X[B]); X[B + 1] = EX(X[B + 1]); X[B + 2] = EX(X[B + 2]); X[B + 3] = EX(X[B + 3]); PIN(X); SBAR(); } while (0)
  #define VRD(i) do { vlo[i] = vtr(vp_ + (((i) >> 2) * 4096 + ((i) & 3) * 1024)); vhi[i] = vtr(vp_ + (((i) >> 2) * 4096 + ((i) & 3) * 1024 + 512)); } while (0)
  #define KRD(G, j) do { if (G) { kload2(kf, kp0 + sl_next, j); SBAR(); } } while (0)
  #define STEP(C0, C1, P0, P1, t, GK, GV, GL) do { SBAR(); \
    const lds_cptr vp_ = vp0 + sl_prev; \
    VRD(0); SBAR(); float sacc = (P0[0] + P0[1]); \
    GAPA(C0 = __builtin_amdgcn_mfma_f32_32x32x16_bf16(kf[0], qr[0], negm, 0, 0, 0), P0[2], P0[3], P0[4], P0[5],     pw0[0] = PKW(P0, 0), pw0[1] = PKW(P0, 2), pw0); \
    VRD(4); SBAR(); GAPA(C1 = __builtin_amdgcn_mfma_f32_32x32x16_bf16(kf[1], qr[0], negm, 0, 0, 0), P0[6], P0[7], P0[8], P0[9],     pw0[2] = PKW(P0, 4), pw0[3] = PKW(P0, 6), pw0); \
    VRD(1); SBAR(); GAPA(C0 = __builtin_amdgcn_mfma_f32_32x32x16_bf16(kf[2], qr[1], C0, 0, 0, 0),   P0[10], P0[11], P0[12], P0[13], pw1[0] = PKW(P0, 8), pw1[1] = PKW(P0, 10), pw1); \
    VRD(5); SBAR(); GAPA(C1 = __builtin_amdgcn_mfma_f32_32x32x16_bf16(kf[3], qr[1], C1, 0, 0, 0),   P0[14], P0[15], P1[0], P1[1],   pw1[2] = PKW(P0, 12), pw1[3] = PKW(P0, 14), pw1); \
    VRD(2); SBAR(); GAPA(C0 = __builtin_amdgcn_mfma_f32_32x32x16_bf16(kf[4], qr[2], C0, 0, 0, 0),   P1[2], P1[3], P1[4], P1[5],     pw2[0] = PKW(P1, 0), pw2[1] = PKW(P1, 2), pw2); \
    VRD(6); SBAR(); GAPA(C1 = __builtin_amdgcn_mfma_f32_32x32x16_bf16(kf[5], qr[2], C1, 0, 0, 0),   P1[6], P1[7], P1[8], P1[9],     pw2[2] = PKW(P1, 4), pw2[3] = PKW(P1, 6), pw2); \
    VRD(3); SBAR(); GAPA(C0 = __builtin_amdgcn_mfma_f32_32x32x16_bf16(kf[6], qr[3], C0, 0, 0, 0),   P1[10], P1[11], P1[12], P1[13], pw3[0] = PKW(P1, 8), pw3[1] = PKW(P1, 10), pw3); \
    VRD(7); SBAR(); GAPA(C1 = __builtin_amdgcn_mfma_f32_32x32x16_bf16(kf[7], qr[3], C1, 0, 0, 0),   P1[14], P1[15], 0.f, 0.f,       pw3[2] = PKW(P1, 12), pw3[3] = PKW(P1, 14), pw3); \
    l_reg += sacc; \
    if (GK) { DMA_K((t) + 3, sl_cur); } if (GV) { DMA_V((t) + 1, sl_next); } \
    { float a = MX3(C0[0], C0[1], C1[0]), b = MX3(C0[2], C0[3], C1[1]); a = MX3(a, C1[2], C1[3]); \
      _Pragma("unroll") for (int r = 4; r < 16; r += 4) { a = MX3(a, C0[r], C0[r + 1]); b = MX3(b, C0[r + 2], C0[r + 3]); a = MX3(a, C1[r], C1[r + 1]); b = MX3(b, C1[r + 2], C1[r + 3]); } \
      float rm = __builtin_fmaxf(a, b); { auto rr = __builtin_amdgcn_permlane32_swap(__float_as_uint(rm), __float_as_uint(rm), false, false); rm = __builtin_fmaxf(__uint_as_float(rr[0]), __uint_as_float(rr[1])); } \
      resc = false; \
      if (__builtin_expect(__any(rm > (float)THRL), 0)) { const float dl = __builtin_fmaxf(rm, 0.f); mhat += dl; \
        _Pragma("unroll") for (int r = 0; r < 16; ++r) { C0[r] -= dl; C1[r] -= dl; } \
        _Pragma("unroll") for (int r = 0; r < 16; ++r) negm[r] = -mhat; asm volatile("" : "+v"(negm)); \
        const float f = __builtin_amdgcn_exp2f(-dl); l_reg *= f; if (hi == 0) wsf[r32] = f; resc = true; } } \
    SBAR(); \
    GAPB(o[0] = __builtin_amdgcn_mfma_f32_32x32x16_bf16(PAF(0), VFR(0), o[0], 0, 0, 0), C0, 0); \
    GAPB(o[1] = __builtin_amdgcn_mfma_f32_32x32x16_bf16(PAF(0), VFR(4), o[1], 0, 0, 0), C0, 4); \
    KRD(GL, 0); GAPB(o[0] = __builtin_amdgcn_mfma_f32_32x32x16_bf16(PAF(1), VFR(1), o[0], 0, 0, 0), C0, 8); \
    KRD(GL, 1); GAPB(o[1] = __builtin_amdgcn_mfma_f32_32x32x16_bf16(PAF(1), VFR(5), o[1], 0, 0, 0), C0, 12); \
    KRD(GL, 2); GAPB(o[0] = __builtin_amdgcn_mfma_f32_32x32x16_bf16(PAF(2), VFR(2), o[0], 0, 0, 0), C1, 0); \
    KRD(GL, 3); GAPB(o[1] = __builtin_amdgcn_mfma_f32_32x32x16_bf16(PAF(2), VFR(6), o[1], 0, 0, 0), C1, 4); \
    GAPB(o[0] = __builtin_amdgcn_mfma_f32_32x32x16_bf16(PAF(3), VFR(3), o[0], 0, 0, 0), C1, 8); \
    GAPB(o[1] = __builtin_amdgcn_mfma_f32_32x32x16_bf16(PAF(3), VFR(7), o[1], 0, 0, 0), C1, 12); \
    } while (0)
  int t = 1;
  for (; t + 5 < NT; t += 2) {
    STEP(pB0, pB1, pA0, pA1, t, true, true, true);     WAIT_BAR(2); RESC(); ROT();
    STEP(pA0, pA1, pB0, pB1, t + 1, true, true, true); WAIT_BAR(2); RESC(); ROT();
  }
  #define ENDW(tt) do { if ((tt) + 3 < NT) { WAIT_BAR(2); } else if ((tt) + 2 < NT) { WAIT_BAR(1); } else { WAIT_BAR(0); } } while (0)
  for (; t + 1 < NT; t += 2) {
    STEP(pB0, pB1, pA0, pA1, t, (t + 3 < NT), (t + 1 < NT), (t + 1 < NT));         ENDW(t);     RESC(); ROT();
    STEP(pA0, pA1, pB0, pB1, t + 1, (t + 4 < NT), (t + 2 < NT), (t + 2 < NT));     ENDW(t + 1); RESC(); ROT();
  }
  STEP(pB0, pB1, pA0, pA1, NT - 1, false, false, false); RESC();
  { float sacc = pB0[0] + pB0[1]; _Pragma("unroll") for (int r = 2; r < 16; ++r) sacc += pB0[r]; _Pragma("unroll") for (int r = 0; r < 16; ++r) sacc += pB1[r]; l_reg += sacc;
    pw0 = (u32x4){PKW(pB0, 0), PKW(pB0, 2), PKW(pB0, 4), PKW(pB0, 6)}; pw1 = (u32x4){PKW(pB0, 8), PKW(pB0, 10), PKW(pB0, 12), PKW(pB0, 14)}; pw2 = (u32x4){PKW(pB1, 0), PKW(pB1, 2), PKW(pB1, 4), PKW(pB1, 6)}; pw3 = (u32x4){PKW(pB1, 8), PKW(pB1, 10), PKW(pB1, 12), PKW(pB1, 14)};
    SBAR(); pv(o, vb0 + sl_cur, PAF(0), PAF(1), PAF(2), PAF(3)); }
  #undef PKW
  #undef PAF
  #undef VFR
  #undef PIN
  #undef MX3
  #undef GAPA
  #undef GAPB
  #undef EX
  #undef VRD
  #undef KRD
  #undef STEP
  #undef ENDW
  { auto rr = __builtin_amdgcn_permlane32_swap(__float_as_uint(l_reg), __float_as_uint(l_reg), false, false); l_reg = __uint_as_float(rr[0]) + __uint_as_float(rr[1]); }
  if (hi == 0) wsf[32 + r32] = l_reg; asm volatile("s_waitcnt lgkmcnt(0)" ::: "memory");
  float rli[16];
  #pragma unroll
  for (int r = 0; r < 16; ++r) rli[r] = __builtin_amdgcn_rcpf(wsf[32 + crow(r, hi)]);
  bf16_t* Ow = Orow0 + (long)(wid * QBLK) * OP;
  { bf16_t* stg = (bf16_t*)(shm + LDS_OST) + wid * 2048;
    #pragma unroll
    for (int r = 0; r < 16; ++r) { const int orow = crow(r, hi);
      #pragma unroll
      for (int d0 = 0; d0 < 2; ++d0) stg[orow * 64 + d0 * 32 + r32] = (bf16_t)f2bf(o[d0][r] * rli[r]); }
    asm volatile("s_waitcnt lgkmcnt(0)" ::: "memory");
    #pragma unroll
    for (int i = 0; i < 4; ++i) { const int row = i * 8 + (lane >> 3), ch = lane & 7; const u32x4 v = *(const u32x4*)(stg + row * 64 + ch * 8); *(u32x4*)(Ow + (long)row * OP + ch * 8) = v; } }
  asm volatile("s_waitcnt lgkmcnt(0)\n\ts_barrier" ::: "memory");
  #undef DMA_K
  #undef DMA_V
  #undef START
  #undef RESC
  #undef ROT
}
#undef SBAR
#undef WAIT_BAR
}
struct Frame {
    LAS unsigned char* lds;
    int tid, lane, wave;
    int vcu, G, gw, NGW, bid;
    unsigned char* ws; const float* const* in;
};

__device__ __forceinline__ void transpose_item(const float* W, int ldw, int K, bf16_t* WT, int k0, int n0, int dst_row0, LAS float* scr, int lane) {
    float tv[32];
#pragma unroll
    for (int i = 0; i < 32; ++i) tv[i] = W[(size_t)(k0 + 2 * i + (lane >> 5)) * ldw + n0 + (lane & 31)];
#pragma unroll
    for (int i = 0; i < 32; ++i) scr[(2 * i + (lane >> 5)) * 33 + (lane & 31)] = tv[i];
    LDS_WAIT(); asm volatile("" ::: "memory");
    const int c = lane & 7;
#pragma unroll
    for (int j = 0; j < 4; ++j) { const int n = (lane >> 3) + 8 * j; const LAS float* s = scr + (8 * c) * 33 + n;
        u32x4 o; o.x = pk2(s[0 * 33], s[1 * 33]); o.y = pk2(s[2 * 33], s[3 * 33]); o.z = pk2(s[4 * 33], s[5 * 33]); o.w = pk2(s[6 * 33], s[7 * 33]);
        *(u32x4*)(WT + (size_t)(dst_row0 + n) * K + k0 + 8 * c) = o; }
    LDS_WAIT(); asm volatile("" ::: "memory");
}

__device__ __forceinline__ void sincos_acc(float x, float& s, float& c) {
    const float k = rintf(x * 0.63661977236758134f);
    float r = fmaf(k, -1.5703125f, x); r = fmaf(k, -4.837512969970703125e-4f, r); r = fmaf(k, -7.54978995489188e-8f, r);
    const float z = r * r;
    const float sp = r + r * z * fmaf(z, fmaf(z, -1.9515295891e-4f, 8.3321608736e-3f), -1.6666654611e-1f);
    const float cp = fmaf(z * z, fmaf(z, fmaf(z, 2.443315711809948e-5f, -1.388731625493765e-3f), 4.166664568298827e-2f), fmaf(z, -0.5f, 1.0f));
    const int q = ((int)k) & 3;
    const float ss = (q & 1) ? cp : sp, cc = (q & 1) ? sp : cp;
    s = (q & 2) ? -ss : ss; c = ((q + 1) & 2) ? -cc : cc;
}

__device__ __forceinline__ void p0_prologue(Frame& F, const float* const* in, unsigned char* ws) {
    const float* c_lat = in[1]; const float* c_ctx = in[3]; const float* w_mod = in[4]; const float* b_mod = in[5];
    LAS float* sil = (LAS float*)F.lds;
    for (int i = F.tid; i < NMI * D; i += NTHREADS) { const int mi = i >> 10, k = i & 1023; const float v = (mi < NB) ? c_lat[mi * D + k] : c_ctx[k]; sil[i] = silu_f(v); }
    __syncthreads();
    {
        float* modv = (float*)(ws + WS_MODV);
        const int NT16 = 6 * D / 16;
        for (int task = F.gw; task < DEPTH * NT16; task += F.NGW) {
            const int layer = task / NT16, j0 = (task % NT16) * 16, jj = F.lane & 15, kq = F.lane >> 4;
            const float* wp = w_mod + (size_t)layer * D * 6 * D + j0 + jj;
            float acc[NMI];
#pragma unroll
            for (int m = 0; m < NMI; ++m) acc[m] = 0.f;
            for (int k = kq; k < D; k += 4) { const float w = wp[(size_t)k * 6 * D];
#pragma unroll
                for (int m = 0; m < NMI; ++m) acc[m] = fmaf(sil[m * D + k], w, acc[m]); }
#pragma unroll
            for (int m = 0; m < NMI; ++m) { float v = acc[m]; v += __shfl_xor(v, 16); v += __shfl_xor(v, 32); acc[m] = v; }
            if (kq == 0) { const float bb = b_mod[layer * 6 * D + j0 + jj];
#pragma unroll
                for (int m = 0; m < NMI; ++m) modv[((size_t)layer * NMI + m) * 6 * D + j0 + jj] = acc[m] + bb; }
        }
    }
    __syncthreads();
    {
        LAS float* scr = (LAS float*)(F.lds) + F.wave * (64 * 33);
        constexpr int I_MI = 16 * 96, I_MO = 16 * 32, I_AI = 16 * 48, I_AO = 16 * 32;
        constexpr int PER_J = I_MI + I_MO + I_AI + I_AO;
        for (int it = F.gw; it < 2 * PER_J; it += F.NGW) {
            const int j = it / PER_J; int r = it % PER_J;
            if (r < I_MI) { const int kb = r / 96, nb = r % 96; transpose_item(in[8] + (size_t)j * D * MW_IN, MW_IN, D, (bf16_t*)(ws + WS_WMI) + (size_t)j * 3072 * D, 64 * kb, 32 * nb, 32 * nb, scr, F.lane); continue; } r -= I_MI;
            if (r < I_MO) { const int kb = r / 32, nb = r % 32; transpose_item(in[11] + (size_t)j * D * D, D, D, (bf16_t*)(ws + WS_WMO) + (size_t)j * D * D, 64 * kb, 32 * nb, 32 * nb, scr, F.lane); continue; } r -= I_MO;
            if (r < I_AI) { const int kb = r / 48, nb = r % 48; transpose_item(in[12] + (size_t)j * D * 1536, 1536, D, (bf16_t*)(ws + WS_WAI) + (size_t)j * 1536 * D, 64 * kb, 32 * nb, 32 * nb, scr, F.lane); continue; } r -= I_AI;
            { const int kb = r / 32, nb = r % 32; transpose_item(in[15] + (size_t)j * D * D, D, D, (bf16_t*)(ws + WS_WAO) + (size_t)j * D * D, 64 * kb, 32 * nb, 32 * nb, scr, F.lane); }
        }
    }
    {
        float* rc = (float*)(ws + WS_ROPE); float* rs = rc + SEQ * 32;
        for (int i = F.bid * NTHREADS + F.tid; i < SEQ * 32; i += F.G * NTHREADS) {
            const int t = i >> 5, p = i & 31; const float pos = (p < 16) ? (float)(t >> 6) : (float)(t & 63);
            const float inv = exp2f(-(float)(p & 15) * (13.287712379549449f / 16.f));
            float s, c; sincos_acc(pos * inv, s, c); rc[i] = c; rs[i] = s; }
    }
    __syncthreads();
}

__device__ __forceinline__ void moe_weights(Frame& F, const float* wg, const float* wu, const float* wd, unsigned char* ws) {
    LAS float* T = (LAS float*)F.lds;
    const int lane = F.lane, w = F.wave;
    bf16_t* W1 = (bf16_t*)(ws + WS_W1); bf16_t* W2 = (bf16_t*)(ws + WS_W2);
    unsigned char* W1b = (unsigned char*)(ws + WS_W1); unsigned char* W2b = (unsigned char*)(ws + WS_W2);
    constexpr int NIT = NE * 3 * 16 * 4;
#define MW_SRC(it_) (((((it_) % 192) / 64) == 0 ? wg : ((((it_) % 192) / 64) == 1 ? wu : wd)) + (size_t)((it_) / 192) * D * D + (size_t)(64 * ((((it_) % 192) % 64) >> 2)) * D + 256 * ((((it_) % 192) % 64) & 3))
    f32x4 v[8];
    int it = F.vcu;
    if (it < NIT) { const float* src = MW_SRC(it);
#pragma unroll
        for (int i = 0; i < 8; ++i) v[i] = *(const f32x4*)(src + (size_t)(8 * w + i) * D + 4 * lane); }
    for (; it < NIT; it += F.G) {
        __syncthreads();
#pragma unroll
        for (int i = 0; i < 8; ++i) *(LAS f32x4*)(T + (8 * w + i) * 256 + ((4 * lane) ^ (8 * (w & 3)))) = v[i];
        if (it + F.G < NIT) { const float* src = MW_SRC(it + F.G);
#pragma unroll
            for (int i = 0; i < 8; ++i) v[i] = *(const f32x4*)(src + (size_t)(8 * w + i) * D + 4 * lane); }
        __syncthreads();
        const int e = it / 192, r = it % 192, which = r / 64, kb = (r % 64) >> 2, nq = (r % 64) & 3;
        const int nl = lane & 7, c = lane >> 3;
        bf16_t* base = (which == 2) ? (W2 + (size_t)e * D * D) : (W1 + (size_t)e * 2048 * D);
#pragma unroll
        for (int j = 0; j < 4; ++j) { const int n = 32 * w + 8 * j + nl; const LAS float* tp = T + (8 * c) * 256 + (n ^ (8 * (c & 3)));
            float t[8];
#pragma unroll
            for (int i = 0; i < 8; ++i) t[i] = tp[i * 256];
            const int ng = 256 * nq + n; const int drow = (which == 2) ? ng : (256 * (ng >> 7) + (which == 1 ? 128 : 0) + (ng & 127));
            const bool f8 = (which == 2) ? (MOE_FP8_2 != 0) : (MOE_FP8_1 != 0);
            if (f8) { u32x2 o; o.x = pk_fp8x4(t[0] * FP8_SW, t[1] * FP8_SW, t[2] * FP8_SW, t[3] * FP8_SW); o.y = pk_fp8x4(t[4] * FP8_SW, t[5] * FP8_SW, t[6] * FP8_SW, t[7] * FP8_SW);
                unsigned char* b8 = (which == 2) ? (W2b + (size_t)e * D * D) : (W1b + (size_t)e * 2048 * D);
                *(u32x2*)(b8 + (size_t)drow * D + 64 * kb + 8 * c) = o; }
            else { u32x4 o; o.x = pk2(t[0], t[1]); o.y = pk2(t[2], t[3]); o.z = pk2(t[4], t[5]); o.w = pk2(t[6], t[7]);
                *(u32x4*)(base + (size_t)drow * D + 64 * kb + 8 * c) = o; } }
    }
#undef MW_SRC
    __syncthreads();
}

__device__ __forceinline__ void load_w16(Frame& F, const float* W16, int ldw16) {
    LAS float* wl = (LAS float*)F.lds;
    for (int i = F.tid; i < D * 16; i += NTHREADS) { const int c = i >> 4, e = i & 15; const int l = (c & 255) >> 2, q = (c & 3) + 4 * (c >> 8);
        wl[(q * 64 + l) * 20 + e] = W16[(size_t)c * ldw16 + e]; }
    __syncthreads();
}
template <int MODE, bool F8 = false>
__device__ __forceinline__ void norm_core(LAS float* wl, const int lane, f32x4 (&v)[4], const int r, const f32x4 (&gv)[4], const float* shp, const float* scp, bf16_t* H, const float* bias16, float* out16) {
    float ss = 0.f;
#pragma unroll
    for (int j = 0; j < 4; ++j) ss += (v[j].x * v[j].x + v[j].y * v[j].y) + (v[j].z * v[j].z + v[j].w * v[j].w);
    const float rstd = rsqrtf(wave_sum(ss) * (1.f / D) + NORM_EPS);
    unsigned long long* o8 = (unsigned long long*)(H + (size_t)r * D) + lane;
#pragma unroll
    for (int j = 0; j < 4; ++j) { const f32x4 sh = *(const f32x4*)(shp + 4 * lane + 256 * j), sc = *(const f32x4*)(scp + 4 * lane + 256 * j);
        v[j] = (v[j] * rstd * gv[j]) * (sc + 1.f) + sh;
        if (F8) ((unsigned*)((unsigned char*)H + (size_t)r * D))[lane + 64 * j] = pk_fp8x4(v[j].x * FP8_SH, v[j].y * FP8_SH, v[j].z * FP8_SH, v[j].w * FP8_SH);
        else o8[64 * j] = (unsigned long long)pk2(v[j].x, v[j].y) | ((unsigned long long)pk2(v[j].z, v[j].w) << 32); }
    if (MODE != 0) {
        float p[16];
#pragma unroll
        for (int e = 0; e < 16; ++e) p[e] = 0.f;
#pragma unroll
        for (int j = 0; j < 4; ++j) {
            f32x4 wq[4][4];
#pragma unroll
            for (int i = 0; i < 4; ++i) { const LAS f32x4* wp = (const LAS f32x4*)(wl + ((4 * j + i) * 64 + lane) * 20);
#pragma unroll
                for (int e4 = 0; e4 < 4; ++e4) wq[i][e4] = wp[e4]; }
            asm volatile("s_waitcnt lgkmcnt(0)" ::: "memory"); __builtin_amdgcn_sched_barrier(0);
#pragma unroll
            for (int i = 0; i < 4; ++i) { const float xv = v[j][i];
#pragma unroll
                for (int e4 = 0; e4 < 4; ++e4) { const f32x4 w = wq[i][e4]; p[4 * e4 + 0] = fmaf(xv, w.x, p[4 * e4 + 0]); p[4 * e4 + 1] = fmaf(xv, w.y, p[4 * e4 + 1]); p[4 * e4 + 2] = fmaf(xv, w.z, p[4 * e4 + 2]); p[4 * e4 + 3] = fmaf(xv, w.w, p[4 * e4 + 3]); } }
            __builtin_amdgcn_sched_barrier(0);
        }
        float q8[8], q4[4], q2[2], q1;
        { const bool up = (lane & 32) != 0;
#pragma unroll
          for (int i = 0; i < 8; ++i) { const float send = up ? p[i] : p[i + 8]; const float recv = __shfl_xor(send, 32); q8[i] = (up ? p[i + 8] : p[i]) + recv; } }
        { const bool up = (lane & 16) != 0;
#pragma unroll
          for (int i = 0; i < 4; ++i) { const float send = up ? q8[i] : q8[i + 4]; const float recv = __shfl_xor(send, 16); q4[i] = (up ? q8[i + 4] : q8[i]) + recv; } }
        { const bool up = (lane & 8) != 0;
#pragma unroll
          for (int i = 0; i < 2; ++i) { const float send = up ? q4[i] : q4[i + 2]; const float recv = __shfl_xor(send, 8); q2[i] = (up ? q4[i + 2] : q4[i]) + recv; } }
        { const bool up = (lane & 4) != 0; const float send = up ? q2[0] : q2[1]; const float recv = __shfl_xor(send, 4); q1 = (up ? q2[1] : q2[0]) + recv; }
        q1 = quad_sum(q1);
        const int e = ((lane >> 5) & 1) * 8 + ((lane >> 4) & 1) * 4 + ((lane >> 3) & 1) * 2 + ((lane >> 2) & 1);
        if (MODE == 1) {
            float g = q1 + bias16[e];
            g = 15.f * tanhf(g * (1.f / 15.f));
            const int gate = e >> 2;
            if (gate & 1) g = fminf(g, 0.f) - log1pf(__expf(-fabsf(g)));
            if ((lane & 3) == 0) out16[(size_t)r * 16 + e] = g;
        } else {
            float mx = q1;
#pragma unroll
            for (int o = 4; o < 64; o <<= 1) mx = fmaxf(mx, __shfl_xor(mx, o));
            const float ex = __expf(q1 - mx); float sm = ex;
#pragma unroll
            for (int o = 4; o < 64; o <<= 1) sm += __shfl_xor(sm, o);
            if ((lane & 3) == 0) out16[(size_t)e * RT + r] = ex / sm;
        }
    }
}
__device__ __forceinline__ float swap32_add(float a, float b) { auto r = __builtin_amdgcn_permlane32_swap(__float_as_uint(a), __float_as_uint(b), false, false); return __uint_as_float(r[0]) + __uint_as_float(r[1]); }
__device__ __forceinline__ float swap16_add(float a, float b) { auto r = __builtin_amdgcn_permlane16_swap(__float_as_uint(a), __float_as_uint(b), false, false); return __uint_as_float(r[0]) + __uint_as_float(r[1]); }
template <int MODE, bool F8 = false>
__device__ __forceinline__ void norm_pass(Frame& F, const float* xL, const float* xC, int nrows, const float* gain, const float* shiftv, const float* scalev  ,
                                          bf16_t* H, const float* W16, int ldw16, const float* bias16, float* out16) {
    LAS float* wl = (LAS float*)F.lds;
    if (MODE != 0) load_w16(F, W16, ldw16);
    const int lane = F.lane;
    f32x4 gv[4];
#pragma unroll
    for (int j = 0; j < 4; ++j) gv[j] = *(const f32x4*)(gain + 4 * lane + 256 * j);
    const int per = (((nrows + F.NGW - 1) / F.NGW) + 1) & ~1; const int r0 = F.gw * per, r1 = (r0 + per < nrows) ? r0 + per : nrows;
#define NP_XPTR(rr) (((rr) >= RL) ? (xC + (size_t)((rr) - RL) * D) : (xL + (size_t)(rr) * D))
    f32x4 vn[2][4];
    if (r0 < r1) {
#pragma unroll
        for (int q = 0; q < 2; ++q) { const float* xr = NP_XPTR(r0 + q);
#pragma unroll
            for (int j = 0; j < 4; ++j) vn[q][j] = *(const f32x4*)(xr + 4 * lane + 256 * j); } }
    for (int r = r0; r < r1; r += 2) {
        asm volatile("" ::: "memory");
        f32x4 v[2][4];
#pragma unroll
        for (int q = 0; q < 2; ++q)
#pragma unroll
            for (int j = 0; j < 4; ++j) v[q][j] = vn[q][j];
        if (r + 2 < r1) {
#pragma unroll
            for (int q = 0; q < 2; ++q) { const float* xr = NP_XPTR(r + 2 + q);
#pragma unroll
                for (int j = 0; j < 4; ++j) vn[q][j] = *(const f32x4*)(xr + 4 * lane + 256 * j); } }
        float ss[2];
#pragma unroll
        for (int q = 0; q < 2; ++q) { ss[q] = 0.f;
#pragma unroll
            for (int j = 0; j < 4; ++j) ss[q] += (v[q][j].x * v[q][j].x + v[q][j].y * v[q][j].y) + (v[q][j].z * v[q][j].z + v[q][j].w * v[q][j].w); }
        ss[0] = row16_sum(ss[0]); ss[1] = row16_sum(ss[1]);
        const float tot0 = (rdlane(ss[0], 0) + rdlane(ss[0], 16)) + (rdlane(ss[0], 32) + rdlane(ss[0], 48)), tot1 = (rdlane(ss[1], 0) + rdlane(ss[1], 16)) + (rdlane(ss[1], 32) + rdlane(ss[1], 48));
        const float rstd[2] = {rsqrtf(tot0 * (1.f / D) + NORM_EPS), rsqrtf(tot1 * (1.f / D) + NORM_EPS)};
#pragma unroll
        for (int q = 0; q < 2; ++q) { const int rr = r + q; const int mi = (rr >= RL) ? NB : (rr >> 12);
            const float* shp = shiftv + (size_t)mi * 6 * D; const float* scp = scalev + (size_t)mi * 6 * D;
#pragma unroll
            for (int j = 0; j < 4; ++j) { const f32x4 sh = *(const f32x4*)(shp + 4 * lane + 256 * j), sc = *(const f32x4*)(scp + 4 * lane + 256 * j);
                v[q][j] = (v[q][j] * rstd[q] * gv[j]) * (sc + 1.f) + sh;
                if (F8) ((unsigned*)((unsigned char*)H + (size_t)rr * D))[lane + 64 * j] = pk_fp8x4(v[q][j].x * FP8_SH, v[q][j].y * FP8_SH, v[q][j].z * FP8_SH, v[q][j].w * FP8_SH);
                else ((unsigned long long*)(H + (size_t)rr * D))[lane + 64 * j] = (unsigned long long)pk2(v[q][j].x, v[q][j].y) | ((unsigned long long)pk2(v[q][j].z, v[q][j].w) << 32); } }
        if (MODE != 0) {
            float p[2][16];
#pragma unroll
            for (int q = 0; q < 2; ++q)
#pragma unroll
                for (int e = 0; e < 16; ++e) p[q][e] = 0.f;
#pragma unroll
            for (int j = 0; j < 4; ++j) {
                f32x4 wq[4][4];
#pragma unroll
                for (int i = 0; i < 4; ++i) { const LAS f32x4* wp = (const LAS f32x4*)(wl + ((4 * j + i) * 64 + lane) * 20);
#pragma unroll
                    for (int e4 = 0; e4 < 4; ++e4) wq[i][e4] = wp[e4]; }
                asm volatile("s_waitcnt lgkmcnt(0)" ::: "memory"); __builtin_amdgcn_sched_barrier(0);
#pragma unroll
                for (int i = 0; i < 4; ++i)
#pragma unroll
                    for (int q = 0; q < 2; ++q) { const float xv = v[q][j][i];
#pragma unroll
                        for (int e4 = 0; e4 < 4; ++e4) { const f32x4 w = wq[i][e4]; p[q][4 * e4 + 0] = fmaf(xv, w.x, p[q][4 * e4 + 0]); p[q][4 * e4 + 1] = fmaf(xv, w.y, p[q][4 * e4 + 1]);
                            p[q][4 * e4 + 2] = fmaf(xv, w.z, p[q][4 * e4 + 2]); p[q][4 * e4 + 3] = fmaf(xv, w.w, p[q][4 * e4 + 3]); } }
                __builtin_amdgcn_sched_barrier(0);
            }
            float q16[16], q8[8], q4[4], q2[2], q1;
#pragma unroll
            for (int e = 0; e < 16; ++e) q16[e] = swap32_add(p[0][e], p[1][e]);
#pragma unroll
            for (int i = 0; i < 8; ++i) q8[i] = swap16_add(q16[i], q16[i + 8]);
            { const bool up = (lane & 8) != 0;
#pragma unroll
              for (int i = 0; i < 4; ++i) { const float send = up ? q8[i] : q8[i + 4]; const float recv = __shfl_xor(send, 8); q4[i] = (up ? q8[i + 4] : q8[i]) + recv; } }
            { const bool up = (lane & 4) != 0;
#pragma unroll
              for (int i = 0; i < 2; ++i) { const float send = up ? q4[i] : q4[i + 2]; const float recv = __shfl_xor(send, 4); q2[i] = (up ? q4[i + 2] : q4[i]) + recv; } }
            { const bool up = (lane & 2) != 0; const float send = up ? q2[0] : q2[1]; const float recv = dpp_f<0x4E>(0.f, send); q1 = (up ? q2[1] : q2[0]) + recv; }
            q1 += dpp_f<0xB1>(0.f, q1);
            const int e = ((lane >> 4) & 1) * 8 + ((lane >> 3) & 1) * 4 + ((lane >> 2) & 1) * 2 + ((lane >> 1) & 1);
            const int rr = r + (lane >> 5);
            if (MODE == 1) {
                float g = q1 + bias16[e];
                g = 15.f * tanhf(g * (1.f / 15.f));
                const int gate = e >> 2;
                if (gate & 1) g = fminf(g, 0.f) - log1pf(__expf(-fabsf(g)));
                if ((lane & 1) == 0) out16[(size_t)rr * 16 + e] = g;
            } else {
                float mx = q1;
                mx = fmaxf(mx, dpp_f<0x4E>(mx, mx)); mx = fmaxf(mx, dpp_f<0x141>(mx, mx)); mx = fmaxf(mx, dpp_f<0x140>(mx, mx));
                { auto t = __builtin_amdgcn_permlane16_swap(__float_as_uint(mx), __float_as_uint(mx), false, false); mx = fmaxf(__uint_as_float(t[0]), __uint_as_float(t[1])); }
                const float ex = __expf(q1 - mx); float sm = ex;
                sm += dpp_f<0x4E>(0.f, sm); sm += dpp_f<0x141>(0.f, sm); sm += dpp_f<0x140>(0.f, sm);
                sm = swap16_add(sm, sm);
                if ((lane & 1) == 0) out16[(size_t)e * RT + rr] = ex / sm;
            }
        }
    }
#undef NP_XPTR
    if (MODE != 0) __syncthreads();
}

__device__ __forceinline__ void moe_select(Frame& F, const float* AFF, int* INV, int* SLROW, float* SLG, int nunits) {
    LAS unsigned* keys = (LAS unsigned*)F.lds;
    LAS unsigned* wsum = (LAS unsigned*)(F.lds + 16384);
    const int tid = F.tid, lane = F.lane, wave = F.wave;
    for (int u = F.vcu; u < nunits; u += F.G) {
        const int set = u >> 4, e = u & 15; const bool isc = set >= NB; const int b = isc ? set - NB : set;
        const int N = isc ? CTXL : SEQ, k = isc ? CAP_C : CAP_L, PER = isc ? 1 : 8;
        const int row0 = isc ? RL + b * CTXL : b * SEQ;
        const int nmine = (tid * PER < N) ? PER : 0;
        unsigned kv[8];
        if (tid < 32) wsum[tid] = 0u;
#pragma unroll
        for (int i = 0; i < 8; ++i) { kv[i] = 0u; if (i < nmine) kv[i] = __float_as_uint(AFF[(size_t)e * RT + row0 + tid * PER + i]); }
        __syncthreads();
        unsigned T = 0u; { unsigned kk = (unsigned)k;
        for (int pass = 0; pass < 8; ++pass) {
            const int shift = 28 - 4 * pass; LAS unsigned* hist = wsum + (pass & 1) * 16;
            if (tid < 16) wsum[((pass + 1) & 1) * 16 + tid] = 0u;
#pragma unroll
            for (int i = 0; i < 8; ++i) if (i < nmine && (pass == 0 || (kv[i] >> (shift + 4)) == (T >> (shift + 4)))) (void)__hip_atomic_fetch_add(&hist[(kv[i] >> shift) & 15u], 1u, __ATOMIC_RELAXED, __HIP_MEMORY_SCOPE_WORKGROUP);
            __syncthreads();
            unsigned cum = 0u, digit = 0u; bool found = false;
#pragma unroll
            for (int d = 15; d >= 0; --d) { const unsigned c = hist[d]; if (!found) { if (cum + c >= kk) { digit = (unsigned)d; found = true; } else cum += c; } }
            kk -= cum; T |= digit << shift;
            __syncthreads();
        } }
        unsigned ngt = 0u, neq = 0u;
#pragma unroll
        for (int i = 0; i < 8; ++i) { if (i < nmine) { ngt += kv[i] > T ? 1u : 0u; neq += kv[i] == T ? 1u : 0u; } }
        unsigned sgt = ngt, seq = neq;
#pragma unroll
        for (int o = 1; o < 64; o <<= 1) { const unsigned a = __shfl_up(sgt, o), c2 = __shfl_up(seq, o); if (lane >= o) { sgt += a; seq += c2; } }
        LAS unsigned* sc = wsum + 32;
        __syncthreads();
        if (lane == 63) { sc[wave] = sgt; sc[8 + wave] = seq; }
        __syncthreads();
        unsigned bgt = 0u, beq = 0u, tgt = 0u;
#pragma unroll
        for (int w = 0; w < 8; ++w) { const unsigned a = sc[w], c2 = sc[8 + w]; if (w < wave) { bgt += a; beq += c2; } tgt += a; }
        const unsigned need = (unsigned)k - tgt;
        unsigned pgt = bgt + sgt - ngt, peq = beq + seq - neq;
        const int sbase = isc ? NB * CAP_L + b * CAP_C : b * CAP_L;
#pragma unroll
        for (int i = 0; i < 8; ++i) { if (i < nmine) {
            const int row = row0 + tid * PER + i; int slot = -1;
            if (kv[i] > T) { slot = (int)(pgt + (peq < need ? peq : need)); ++pgt; }
            else if (kv[i] == T) { if (peq < need) slot = (int)(pgt + peq); ++peq; }
            if (slot >= 0) { SLROW[e * SLOTS_E + sbase + slot] = row; SLG[e * SLOTS_E + sbase + slot] = __uint_as_float(kv[i]); }
            INV[(size_t)e * RT + row] = slot >= 0 ? sbase + slot : -1; } }
        __syncthreads();
    }
    (void)keys;
}

__device__ __forceinline__ void moe_gather(Frame& F, const bf16_t* H, const int* SLROW, bf16_t* XG, bool with_ctx) {
    const int per_e = with_ctx ? SLOTS_E : NB * CAP_L; const int total = NE * per_e;
    const int per = (total + F.NGW - 1) / F.NGW; const int i0 = F.gw * per, i1 = (i0 + per < total) ? i0 + per : total;
    for (int i = i0; i < i1; i += 4) {
        u32x4 a[4], b2[4]; size_t dsto[4];
#pragma unroll
        for (int q = 0; q < 4; ++q) { const int ii = (i + q < i1) ? i + q : i1 - 1; const int e = ii / per_e, sl = ii - e * per_e; const int row = SLROW[e * SLOTS_E + sl];
            const u32x4* src = (const u32x4*)(H + (size_t)row * D) + F.lane; a[q] = src[0]; b2[q] = src[64]; dsto[q] = ((size_t)e * SLOTS_E + sl) * D; }
#pragma unroll
        for (int q = 0; q < 4; ++q) { u32x4* dst = (u32x4*)(XG + dsto[q]) + F.lane; dst[0] = a[q]; dst[64] = b2[q]; }
    }
}

template <int MODE>
__device__ __forceinline__ void combine_norm(Frame& F, const bf16_t* Y, const int* INV, float* xL, float* xC, const float* g2v  , int nrows,
                                             const float* gain, const float* shiftv, const float* scalev, bf16_t* H, const float* W16, int ldw16, const float* bias16, float* out16) {
    LAS float* wl = (LAS float*)F.lds;
    if (MODE == 1) load_w16(F, W16, ldw16);
    const int lane = F.lane;
    f32x4 gv[4];
#pragma unroll
    for (int j = 0; j < 4; ++j) gv[j] = *(const f32x4*)(gain + 4 * lane + 256 * j);
    const int per = (nrows + F.NGW - 1) / F.NGW; const int r0 = F.gw * per, r1 = (r0 + per < nrows) ? r0 + per : nrows;
#define CN_XPTR(rr) (((rr) >= RL) ? (xC + (size_t)((rr) - RL) * D) : (xL + (size_t)(rr) * D))
#define CN_INV(rr) (((rr) < r1 && lane < 16) ? INV[(size_t)lane * RT + (rr)] : -1)
#define CN_YLOAD(dst, e_, s_) do { const u32x2* yp_ = (const u32x2*)(Y + ((size_t)(e_) * SLOTS_E + (s_)) * D) + lane; _Pragma("unroll") for (int j = 0; j < 4; ++j) dst[j] = yp_[64 * j]; } while (0)
#define CN_YACC(src) do { _Pragma("unroll") for (int j = 0; j < 4; ++j) { a[j].x += bf_lo(src[j].x); a[j].y += bf_hi(src[j].x); a[j].z += bf_lo(src[j].y); a[j].w += bf_hi(src[j].y); } } while (0)
    f32x4 vn[4]; u32x2 pn0[4], pn1[4];
    int invA = CN_INV(r0), invB = CN_INV(r0 + 1);
#pragma unroll
    for (int j = 0; j < 4; ++j) { vn[j] = (f32x4){0.f, 0.f, 0.f, 0.f}; pn0[j] = (u32x2){0u, 0u}; pn1[j] = (u32x2){0u, 0u}; }
    if (r0 < r1) { const float* xr = CN_XPTR(r0);
#pragma unroll
        for (int j = 0; j < 4; ++j) vn[j] = *(const f32x4*)(xr + 4 * lane + 256 * j);
        unsigned long long m = __ballot(invA >= 0);
        if (m) { const int e0 = __builtin_ctzll(m); m &= m - 1; CN_YLOAD(pn0, e0, __builtin_amdgcn_readlane(invA, e0)); if (m) { const int e1 = __builtin_ctzll(m); CN_YLOAD(pn1, e1, __builtin_amdgcn_readlane(invA, e1)); } } }
    for (int r = r0; r < r1; ++r) {
        asm volatile("" ::: "memory");
        f32x4 v[4]; u32x2 pc0[4], pc1[4];
#pragma unroll
        for (int j = 0; j < 4; ++j) { v[j] = vn[j]; pc0[j] = pn0[j]; pc1[j] = pn1[j]; }
        const int invC = CN_INV(r + 2);
        if (r + 1 < r1) { const float* xr = CN_XPTR(r + 1);
#pragma unroll
            for (int j = 0; j < 4; ++j) vn[j] = *(const f32x4*)(xr + 4 * lane + 256 * j);
            unsigned long long m = __ballot(invB >= 0);
            if (m) { const int e0 = __builtin_ctzll(m); m &= m - 1; CN_YLOAD(pn0, e0, __builtin_amdgcn_readlane(invB, e0)); if (m) { const int e1 = __builtin_ctzll(m); CN_YLOAD(pn1, e1, __builtin_amdgcn_readlane(invB, e1)); } } }
        f32x4 a[4];
#pragma unroll
        for (int j = 0; j < 4; ++j) a[j] = (f32x4){0.f, 0.f, 0.f, 0.f};
        { unsigned long long m = __ballot(invA >= 0);
          if (m) { m &= m - 1; CN_YACC(pc0);
            if (m) { m &= m - 1; CN_YACC(pc1);
              while (m) { const int e2 = __builtin_ctzll(m); m &= m - 1; u32x2 t2[4]; CN_YLOAD(t2, e2, __builtin_amdgcn_readlane(invA, e2)); CN_YACC(t2); } } } }
        const int mi = (r >= RL) ? NB : (r >> 12);
        const float* gp = g2v + (size_t)mi * 6 * D;
#pragma unroll
        for (int j = 0; j < 4; ++j) { const f32x4 g = *(const f32x4*)(gp + 4 * lane + 256 * j); v[j] = v[j] + g * a[j]; }
        float* xw = CN_XPTR(r);
        if (MODE == 3) {
            float ss = 0.f;
#pragma unroll
            for (int j = 0; j < 4; ++j) ss += (v[j].x * v[j].x + v[j].y * v[j].y) + (v[j].z * v[j].z + v[j].w * v[j].w);
            const float rstd = rsqrtf(wave_sum(ss) * (1.f / D) + NORM_EPS);
#pragma unroll
            for (int j = 0; j < 4; ++j) *(f32x4*)(xw + 4 * lane + 256 * j) = v[j] * rstd * gv[j];
        } else {
#pragma unroll
            for (int j = 0; j < 4; ++j) *(f32x4*)(xw + 4 * lane + 256 * j) = v[j];
            norm_core<MODE>(wl, lane, v, r, gv, shiftv + (size_t)mi * 6 * D, scalev + (size_t)mi * 6 * D, H, bias16, out16);
        }
        invA = invB; invB = invC;
    }
#undef CN_XPTR
#undef CN_INV
#undef CN_YLOAD
#undef CN_YACC
    if (MODE == 1) __syncthreads();
}

__device__ __forceinline__ void final_norm(Frame& F, float* x, const float* gain) {
    const int lane = F.lane;
    for (int r = F.gw; r < RL; r += F.NGW) { float* xr = x + (size_t)r * D; f32x4 v[4]; float ss = 0.f;
#pragma unroll
        for (int j = 0; j < 4; ++j) { v[j] = *(const f32x4*)(xr + 4 * lane + 256 * j); ss += (v[j].x * v[j].x + v[j].y * v[j].y) + (v[j].z * v[j].z + v[j].w * v[j].w); }
        const float rstd = rsqrtf(wave_sum(ss) * (1.f / D) + NORM_EPS);
#pragma unroll
        for (int j = 0; j < 4; ++j) { const f32x4 g = *(const f32x4*)(gain + 4 * lane + 256 * j); *(f32x4*)(xr + 4 * lane + 256 * j) = v[j] * rstd * g; } }
}

__device__ __forceinline__ void qk_pass(Frame& F, bf16_t* QKV, const float* qn, const float* kn, const float* ropec, const float* ropes, bf16_t* KALL, bf16_t* VALL) {
    const int lane = F.lane, p = lane & 3;
    float gq1[8], gq2[8], gk1[8], gk2[8];
#pragma unroll
    for (int t = 0; t < 8; ++t) { gq1[t] = qn[8 * p + t]; gq2[t] = qn[32 + 8 * p + t]; gk1[t] = kn[8 * p + t]; gk2[t] = kn[32 + 8 * p + t]; }
    for (int r = F.gw; r < RT; r += F.NGW) {
        const bool isc = r >= RL; const int b = isc ? (r - RL) >> 8 : r >> 12; const int t = isc ? (r - RL) & 255 : r & 4095;
        const int pos = isc ? t : CTXL + t;
        bf16_t* row = QKV + (size_t)r * 1536;
        float cs[8], sn[8];
#pragma unroll
        for (int i = 0; i < 8; ++i) { cs[i] = 1.f; sn[i] = 0.f; }
        if (!isc) { const f32x4 c0 = *(const f32x4*)(ropec + t * 32 + 8 * p), c1 = *(const f32x4*)(ropec + t * 32 + 8 * p + 4), s0 = *(const f32x4*)(ropes + t * 32 + 8 * p), s1 = *(const f32x4*)(ropes + t * 32 + 8 * p + 4);
            cs[0] = c0.x; cs[1] = c0.y; cs[2] = c0.z; cs[3] = c0.w; cs[4] = c1.x; cs[5] = c1.y; cs[6] = c1.z; cs[7] = c1.w;
            sn[0] = s0.x; sn[1] = s0.y; sn[2] = s0.z; sn[3] = s0.w; sn[4] = s1.x; sn[5] = s1.y; sn[6] = s1.z; sn[7] = s1.w; }
        {
            bf16_t* hp = row + (lane >> 2) * 64 + 8 * p;
            const u32x4 u1 = *(const u32x4*)hp, u2 = *(const u32x4*)(hp + 32);
            float x1[8], x2[8];
            x1[0] = bf_lo(u1.x); x1[1] = bf_hi(u1.x); x1[2] = bf_lo(u1.y); x1[3] = bf_hi(u1.y); x1[4] = bf_lo(u1.z); x1[5] = bf_hi(u1.z); x1[6] = bf_lo(u1.w); x1[7] = bf_hi(u1.w);
            x2[0] = bf_lo(u2.x); x2[1] = bf_hi(u2.x); x2[2] = bf_lo(u2.y); x2[3] = bf_hi(u2.y); x2[4] = bf_lo(u2.z); x2[5] = bf_hi(u2.z); x2[6] = bf_lo(u2.w); x2[7] = bf_hi(u2.w);
            float ss = 0.f;
#pragma unroll
            for (int i = 0; i < 8; ++i) ss += x1[i] * x1[i] + x2[i] * x2[i];
            ss = quad_sum(ss);
            const float rstd = rsqrtf(ss * (1.f / 64.f) + NORM_EPS) * attn_body::C2;
            float y1[8], y2[8];
#pragma unroll
            for (int i = 0; i < 8; ++i) { const float a = x1[i] * rstd * gq1[i], c = x2[i] * rstd * gq2[i]; y1[i] = a * cs[i] - c * sn[i]; y2[i] = a * sn[i] + c * cs[i]; }
            u32x4 o1, o2; o1.x = pk2(y1[0], y1[1]); o1.y = pk2(y1[2], y1[3]); o1.z = pk2(y1[4], y1[5]); o1.w = pk2(y1[6], y1[7]);
            o2.x = pk2(y2[0], y2[1]); o2.y = pk2(y2[2], y2[3]); o2.z = pk2(y2[4], y2[5]); o2.w = pk2(y2[6], y2[7]);
            *(u32x4*)hp = o1; *(u32x4*)(hp + 32) = o2;
        }
        {
            const int kh = (lane >> 2) & 3;
            const bf16_t* hp = row + 1024 + kh * 64 + 8 * p;
            const u32x4 u1 = *(const u32x4*)hp, u2 = *(const u32x4*)(hp + 32);
            float x1[8], x2[8];
            x1[0] = bf_lo(u1.x); x1[1] = bf_hi(u1.x); x1[2] = bf_lo(u1.y); x1[3] = bf_hi(u1.y); x1[4] = bf_lo(u1.z); x1[5] = bf_hi(u1.z); x1[6] = bf_lo(u1.w); x1[7] = bf_hi(u1.w);
            x2[0] = bf_lo(u2.x); x2[1] = bf_hi(u2.x); x2[2] = bf_lo(u2.y); x2[3] = bf_hi(u2.y); x2[4] = bf_lo(u2.z); x2[5] = bf_hi(u2.z); x2[6] = bf_lo(u2.w); x2[7] = bf_hi(u2.w);
            float ss = 0.f;
#pragma unroll
            for (int i = 0; i < 8; ++i) ss += x1[i] * x1[i] + x2[i] * x2[i];
            ss = quad_sum(ss);
            const float rstd = rsqrtf(ss * (1.f / 64.f) + NORM_EPS);
            float y1[8], y2[8];
#pragma unroll
            for (int i = 0; i < 8; ++i) { const float a = x1[i] * rstd * gk1[i], c = x2[i] * rstd * gk2[i]; y1[i] = a * cs[i] - c * sn[i]; y2[i] = a * sn[i] + c * cs[i]; }
            if (lane < 16) {
                bf16_t* kp = KALL + ((size_t)b * KVLEN + pos) * 256 + kh * 64 + 8 * p;
                u32x4 o1, o2; o1.x = pk2(y1[0], y1[1]); o1.y = pk2(y1[2], y1[3]); o1.z = pk2(y1[4], y1[5]); o1.w = pk2(y1[6], y1[7]);
                o2.x = pk2(y2[0], y2[1]); o2.y = pk2(y2[2], y2[3]); o2.z = pk2(y2[4], y2[5]); o2.w = pk2(y2[6], y2[7]);
                *(u32x4*)kp = o1; *(u32x4*)(kp + 32) = o2;
            } else if (lane < 48) {
                const int c8 = (lane - 16) * 8;
                *(u32x4*)(VALL + ((size_t)b * KVLEN + pos) * 256 + c8) = *(const u32x4*)(row + 1280 + c8);
            }
        }
    }
}

__device__ __forceinline__ void mlstm_readout(Frame& F, const bf16_t* HF, const bf16_t* HB, const bf16_t* QKVO, const float* wnorm, bf16_t* MIX) {
    const int lane = F.lane;
    f32x4 gv[4];
#pragma unroll
    for (int j = 0; j < 4; ++j) gv[j] = *(const f32x4*)(wnorm + 4 * lane + 256 * j);
    for (int r = F.gw; r < RT; r += F.NGW) {
        const u32x2* pf = (const u32x2*)(HF + (size_t)r * D) + lane; const u32x2* pb = (const u32x2*)(HB + (size_t)r * D) + lane;
        const u32x2* po = (const u32x2*)(QKVO + (size_t)r * 3072 + 2048) + lane;
        u32x2 uf[4], ub[4], uo[4];
#pragma unroll
        for (int j = 0; j < 4; ++j) { uf[j] = pf[64 * j]; ub[j] = pb[64 * j]; uo[j] = po[64 * j]; }
        unsigned long long* o8 = (unsigned long long*)(MIX + (size_t)r * D) + lane;
#pragma unroll
        for (int j = 0; j < 4; ++j) {
            f32x4 h; h.x = bf_lo(uf[j].x) + bf_lo(ub[j].x); h.y = bf_hi(uf[j].x) + bf_hi(ub[j].x); h.z = bf_lo(uf[j].y) + bf_lo(ub[j].y); h.w = bf_hi(uf[j].y) + bf_hi(ub[j].y);
            const float ss = wave_sum((h.x * h.x + h.y * h.y) + (h.z * h.z + h.w * h.w));
            const float rstd = rsqrtf(ss * (1.f / 256.f) + NORM_EPS);
            f32x4 og; og.x = bf_lo(uo[j].x); og.y = bf_hi(uo[j].x); og.z = bf_lo(uo[j].y); og.w = bf_hi(uo[j].y);
            f32x4 y;
            y.x = h.x * rstd * gv[j].x * fast_rcp(1.f + __expf(-og.x)); y.y = h.y * rstd * gv[j].y * fast_rcp(1.f + __expf(-og.y));
            y.z = h.z * rstd * gv[j].z * fast_rcp(1.f + __expf(-og.z)); y.w = h.w * rstd * gv[j].w * fast_rcp(1.f + __expf(-og.w));
            o8[64 * j] = (unsigned long long)pk2(y.x, y.y) | ((unsigned long long)pk2(y.z, y.w) << 32);
        }
    }
}
namespace mls {
constexpr int XS = 272, PS = 144, NCH = 68;
constexpr int O_XQ = 0, O_XK = 17408, O_XKP = 34816, O_XV = 52224, O_P = 69632, O_CT = 78848, O_OT = 113664, O_GB = 131072;
constexpr int O_RD = O_GB + 2 * 5 * 64 * 4, O_NV = O_RD + 256, O_DEC = O_NV + 1024, O_PRE = O_DEC + 64;
constexpr int LDS_BYTES = O_PRE + 3 * 72 * 4;

__device__ __forceinline__ int row_of(int b, int dir, int c, int p) {
    const int base = (c < 4) ? (RL + b * CTXL + (dir ? 192 - 64 * c : 64 * c)) : (b * SEQ + (dir ? 4032 - 64 * (c - 4) : 64 * (c - 4)));
    return base + (dir ? 63 - p : p);
}
__device__ __forceinline__ bf16x8 tr8(const LAS unsigned char* p0, const LAS unsigned char* p1) {
    typedef short v4i16_t __attribute__((ext_vector_type(4)));
    const s16x4 lo = __builtin_bit_cast(s16x4, __builtin_amdgcn_ds_read_tr16_b64_v4i16((LAS v4i16_t*)p0));
    const s16x4 hi = __builtin_bit_cast(s16x4, __builtin_amdgcn_ds_read_tr16_b64_v4i16((LAS v4i16_t*)p1));
    return (bf16x8){lo[0], lo[1], lo[2], lo[3], hi[0], hi[1], hi[2], hi[3]};
}

__device__ __forceinline__ void gate_arrays(LAS unsigned char* L, const float lf, const float ig, int c, int lane) {
    const int par = c & 1;
    const float bs = wave_scan_add(lf, lane);
    const float a = ig - bs; const float pm = wave_scan_max(a, lane);
    const float mst = ((const LAS float*)(L + O_PRE))[144 + c];
    const float M = fmaxf(mst, pm), M63 = rdlane(M, 63);
    LAS float* gb = (LAS float*)(L + O_GB) + par * 320;
    gb[lane] = a; gb[64 + lane] = M; gb[128 + lane] = __expf(mst - M); gb[192 + lane] = __expf(-bs - M); gb[256 + lane] = __expf(a - M63);
    if (lane == 0) ((LAS float*)(L + O_DEC))[par] = __expf(mst - M63);
}

__device__ __forceinline__ void mlstm_unit(Frame& F, int b, int hd, int dir, int half, const bf16_t* QKVO, const float* GATES, bf16_t* HOUT) {
    LAS unsigned char* L = F.lds;
    const int tid = F.tid, lane = F.lane, w = F.wave, fr = lane & 15, g = lane >> 4;
    const int gi = (dir * 2) * 4 + hd, gf = (dir * 2 + 1) * 4 + hd;
    LAS float* pre = (LAS float*)(L + O_PRE);
    __syncthreads();
    {
        float lfv[9], igv[9];
#pragma unroll
        for (int q = 0; q < 9; ++q) { const int c = w + 8 * q; lfv[q] = 0.f; igv[q] = 0.f;
            if (c < NCH) { const int row = row_of(b, dir, c, lane); lfv[q] = GATES[(size_t)row * 16 + gf]; igv[q] = GATES[(size_t)row * 16 + gi]; } }
#pragma unroll
        for (int q = 0; q < 9; ++q) { const int c = w + 8 * q;
            if (c < NCH) { const float bs = wave_scan_add(lfv[q], lane); float am = igv[q] - bs;
                am = fmaxf(am, dpp_f<0xB1>(am, am)); am = fmaxf(am, dpp_f<0x4E>(am, am)); am = fmaxf(am, dpp_f<0x141>(am, am)); am = fmaxf(am, dpp_f<0x140>(am, am));
                am = fmaxf(fmaxf(rdlane(am, 0), rdlane(am, 16)), fmaxf(rdlane(am, 32), rdlane(am, 48)));
                if (lane == 0) { pre[c] = rdlane(bs, 63); pre[72 + c] = am; } } }
    }
    for (int i = tid; i < (O_OT - O_CT) / 4; i += NTHREADS) ((LAS unsigned*)(L + O_CT))[i] = 0u;
    for (int i = tid; i < 256; i += NTHREADS) ((LAS float*)(L + O_NV))[i] = 0.f;
    __syncthreads();
    if (tid == 0) { float m = 0.f; for (int c = 0; c < NCH; ++c) { pre[144 + c] = m; m = pre[c] + fmaxf(m, pre[72 + c]); } }
    __syncthreads();
    if (w == 0) { const int row = row_of(b, dir, 0, lane); gate_arrays(L, GATES[(size_t)row * 16 + gf], GATES[(size_t)row * 16 + gi], 0, lane); }
    __syncthreads();
    const int qcol = hd * 128, kcol = 512 + hd * 128, vcol = 1024 + hd * 256 + half * 128;
    u32x4 rq[2], rk[2], rv[2];
#define MLS_BAR() do { asm volatile("s_waitcnt lgkmcnt(0)" ::: "memory"); __builtin_amdgcn_s_barrier(); asm volatile("" ::: "memory"); } while (0)
#define MLS_LOAD(c) do { _Pragma("unroll") for (int i_ = 0; i_ < 2; ++i_) { const int pi_ = tid + 512 * i_, p_ = pi_ >> 4, c16_ = pi_ & 15; \
        const bf16_t* rp_ = QKVO + (size_t)row_of(b, dir, (c), p_) * 3072 + c16_ * 8; \
        rq[i_] = *(const u32x4*)(rp_ + qcol); rk[i_] = *(const u32x4*)(rp_ + kcol); rv[i_] = *(const u32x4*)(rp_ + vcol); } } while (0)
#define MLS_STAGE(c) do { const LAS float* wk_ = (const LAS float*)(L + O_GB) + ((c) & 1) * 320 + 256; \
        _Pragma("unroll") for (int i_ = 0; i_ < 2; ++i_) { const int pi_ = tid + 512 * i_, p_ = pi_ >> 4, c16_ = pi_ & 15; const int o_ = p_ * XS + c16_ * 16; \
        *(LAS u32x4*)(L + O_XQ + o_) = rq[i_]; *(LAS u32x4*)(L + O_XK + o_) = rk[i_]; *(LAS u32x4*)(L + O_XV + o_) = rv[i_]; \
        const float s_ = wk_[p_]; u32x4 kk_; \
        kk_.x = pk2(bf_lo(rk[i_].x) * s_, bf_hi(rk[i_].x) * s_); kk_.y = pk2(bf_lo(rk[i_].y) * s_, bf_hi(rk[i_].y) * s_); \
        kk_.z = pk2(bf_lo(rk[i_].z) * s_, bf_hi(rk[i_].z) * s_); kk_.w = pk2(bf_lo(rk[i_].w) * s_, bf_hi(rk[i_].w) * s_); \
        *(LAS u32x4*)(L + O_XKP + o_) = kk_; } } while (0)
    MLS_LOAD(0); MLS_STAGE(0);
    __syncthreads();
    f32x4 C[8];
#pragma unroll
    for (int i = 0; i < 8; ++i) C[i] = (f32x4){0.f, 0.f, 0.f, 0.f};
    LAS unsigned char* CTw = L + O_CT + w * (16 * XS);
    float glf_n = 0.f, gig_n = 0.f;
    if (w == 7) { const int row = row_of(b, dir, 1, lane); glf_n = GATES[(size_t)row * 16 + gf]; gig_n = GATES[(size_t)row * 16 + gi]; }
    for (int c = 0; c < NCH; ++c) {
        const int par = c & 1; const bool more = (c + 1 < NCH);
        const LAS float* gb = (const LAS float*)(L + O_GB) + par * 320;
        const float glf = glf_n, gig = gig_n;
        if (w == 7 && c + 2 < NCH) { const int row = row_of(b, dir, c + 2, lane); glf_n = GATES[(size_t)row * 16 + gf]; gig_n = GATES[(size_t)row * 16 + gi]; }
        if (more) MLS_LOAD(c + 1);
#define LFENCE() do { asm volatile("s_waitcnt lgkmcnt(0)" ::: "memory"); __builtin_amdgcn_sched_barrier(0); } while (0)
#define QFRAG(mt_, ks_) (*(const LAS bf16x8*)(L + O_XQ + (16 * (mt_) + fr) * XS + (32 * (ks_) + 8 * g) * 2))
        f32x4 acc[4];
        {
            const int mt1 = w >> 1;
            bf16x8 ct[4], qa[2][4], qb[2][4];
#pragma unroll
            for (int ks = 0; ks < 4; ++ks) ct[ks] = *(const LAS bf16x8*)(CTw + fr * XS + (32 * ks + 8 * g) * 2);
#pragma unroll
            for (int m2 = 0; m2 < 2; ++m2)
#pragma unroll
                for (int ks = 0; ks < 4; ++ks) qa[m2][ks] = QFRAG(m2, ks);
            LFENCE();
#pragma unroll
            for (int m2 = 0; m2 < 2; ++m2)
#pragma unroll
                for (int ks = 0; ks < 4; ++ks) qb[m2][ks] = QFRAG(2 + m2, ks);
            __builtin_amdgcn_sched_barrier(0);
#pragma unroll
            for (int m2 = 0; m2 < 2; ++m2) { f32x4 a4 = (f32x4){0.f, 0.f, 0.f, 0.f};
#pragma unroll
                for (int ks = 0; ks < 4; ++ks) a4 = __builtin_amdgcn_mfma_f32_16x16x32_bf16(qa[m2][ks], ct[ks], a4, 0, 0, 0);
                acc[m2] = a4; }
            LFENCE();
            bf16x8 aq[4], bk[2][4];
#pragma unroll
            for (int ks = 0; ks < 4; ++ks) aq[ks] = QFRAG(mt1, ks);
#pragma unroll
            for (int n2 = 0; n2 < 2; ++n2)
#pragma unroll
                for (int ks = 0; ks < 4; ++ks) bk[n2][ks] = *(const LAS bf16x8*)(L + O_XK + (16 * (2 * (w & 1) + n2) + fr) * XS + (32 * ks + 8 * g) * 2);
            const f32x4 Mj = *(const LAS f32x4*)(gb + 64 + 16 * mt1 + 4 * g);
            float as[2]; as[0] = gb[16 * (2 * (w & 1)) + fr]; as[1] = gb[16 * (2 * (w & 1) + 1) + fr];
            f32x4 wi[4];
#pragma unroll
            for (int mt = 0; mt < 4; ++mt) wi[mt] = *(const LAS f32x4*)(gb + 128 + 16 * mt + 4 * g);
            __builtin_amdgcn_sched_barrier(0);
#pragma unroll
            for (int m2 = 0; m2 < 2; ++m2) { f32x4 a4 = (f32x4){0.f, 0.f, 0.f, 0.f};
#pragma unroll
                for (int ks = 0; ks < 4; ++ks) a4 = __builtin_amdgcn_mfma_f32_16x16x32_bf16(qb[m2][ks], ct[ks], a4, 0, 0, 0);
                acc[2 + m2] = a4; }
            LFENCE();
            f32x4 s4[2];
#pragma unroll
            for (int n2 = 0; n2 < 2; ++n2) { s4[n2] = (f32x4){0.f, 0.f, 0.f, 0.f};
#pragma unroll
                for (int ks = 0; ks < 4; ++ks) s4[n2] = __builtin_amdgcn_mfma_f32_16x16x32_bf16(aq[ks], bk[n2][ks], s4[n2], 0, 0, 0); }
#pragma unroll
            for (int mt = 0; mt < 4; ++mt) acc[mt] = acc[mt] * wi[mt];
#pragma unroll
            for (int n2 = 0; n2 < 2; ++n2) { const int sidx = 16 * (2 * (w & 1) + n2) + fr;
#pragma unroll
                for (int reg = 0; reg < 4; ++reg) { const int j = 16 * mt1 + 4 * g + reg;
                    const float pv = (sidx <= j) ? s4[n2][reg] * __expf(as[n2] - Mj[reg]) : 0.f;
                    *(LAS bf16_t*)(L + O_P + j * PS + sidx * 2) = (bf16_t)f2bf(pv); } }
        }
        MLS_BAR();
        bf16x8 vf[2];
        float rdv; float nsum;
        const float decay = ((const LAS float*)(L + O_DEC))[par];
        {
            const LAS unsigned char* vb = L + O_XV + (8 * g + (fr >> 2)) * XS + (16 * w + (lane & 3) * 4) * 2;
            const LAS unsigned char* kb = L + O_XKP + (8 * g + (fr >> 2)) * XS + ((lane & 3) * 4) * 2;
            bf16x8 ap[4][2];
#pragma unroll
            for (int k2 = 0; k2 < 2; ++k2) vf[k2] = tr8(vb + 32 * k2 * XS, vb + (32 * k2 + 4) * XS);
#pragma unroll
            for (int mt = 0; mt < 4; ++mt)
#pragma unroll
                for (int k2 = 0; k2 < 2; ++k2) ap[mt][k2] = *(const LAS bf16x8*)(L + O_P + (16 * mt + fr) * PS + (32 * k2 + 8 * g) * 2);
            LFENCE();
            const int j = tid >> 3, part = tid & 7;
            const u32x4 pu = *(const LAS u32x4*)(L + O_P + j * PS + part * 16);
            const u32x4 q0 = *(const LAS u32x4*)(L + O_XQ + j * XS + part * 32), q1 = *(const LAS u32x4*)(L + O_XQ + j * XS + part * 32 + 16);
            const LAS f32x4* np = (const LAS f32x4*)(L + O_NV + par * 512 + part * 64);
            const f32x4 n0 = np[0], n1 = np[1], n2 = np[2], n3 = np[3];
            const float wint_j = gb[128 + j], emq_j = gb[192 + j];
            bf16x8 ak[4][2];
#pragma unroll
            for (int mt = 0; mt < 4; ++mt)
#pragma unroll
                for (int k2 = 0; k2 < 2; ++k2) ak[mt][k2] = tr8(kb + 32 * k2 * XS + 32 * mt, kb + (32 * k2 + 4) * XS + 32 * mt);
            __builtin_amdgcn_sched_barrier(0);
#pragma unroll
            for (int mt = 0; mt < 4; ++mt)
#pragma unroll
                for (int k2 = 0; k2 < 2; ++k2) acc[mt] = __builtin_amdgcn_mfma_f32_16x16x32_bf16(ap[mt][k2], vf[k2], acc[mt], 0, 0, 0);
            LFENCE();
            bf16x8 ak2[4][2];
#pragma unroll
            for (int mt = 0; mt < 4; ++mt)
#pragma unroll
                for (int k2 = 0; k2 < 2; ++k2) ak2[mt][k2] = tr8(kb + 32 * k2 * XS + 32 * (4 + mt), kb + (32 * k2 + 4) * XS + 32 * (4 + mt));
            const int dk = tid >> 2, part4 = tid & 3; bf16_t kc[16];
#pragma unroll
            for (int t = 0; t < 16; ++t) kc[t] = *(const LAS bf16_t*)(L + O_XKP + (16 * part4 + t) * XS + dk * 2);
            const float nold = ((const LAS float*)(L + O_NV))[par * 128 + dk];
            __builtin_amdgcn_sched_barrier(0);
#pragma unroll
            for (int mt = 0; mt < 4; ++mt) { f32x4 c4 = C[mt] * decay;
#pragma unroll
                for (int k2 = 0; k2 < 2; ++k2) c4 = __builtin_amdgcn_mfma_f32_16x16x32_bf16(ak[mt][k2], vf[k2], c4, 0, 0, 0);
                C[mt] = c4; }
            float rs = (bf_lo(pu.x) + bf_hi(pu.x)) + (bf_lo(pu.y) + bf_hi(pu.y)) + (bf_lo(pu.z) + bf_hi(pu.z)) + (bf_lo(pu.w) + bf_hi(pu.w));
            float qn = bf_lo(q0.x) * n0.x + bf_hi(q0.x) * n0.y + bf_lo(q0.y) * n0.z + bf_hi(q0.y) * n0.w
                     + bf_lo(q0.z) * n1.x + bf_hi(q0.z) * n1.y + bf_lo(q0.w) * n1.z + bf_hi(q0.w) * n1.w
                     + bf_lo(q1.x) * n2.x + bf_hi(q1.x) * n2.y + bf_lo(q1.y) * n2.z + bf_hi(q1.y) * n2.w
                     + bf_lo(q1.z) * n3.x + bf_hi(q1.z) * n3.y + bf_lo(q1.w) * n3.z + bf_hi(q1.w) * n3.w;
            rs = oct_sum(rs); qn = oct_sum(qn);
            rdv = 1.f / fmaxf(fabsf(rs + wint_j * qn), emq_j);
            LFENCE();
#pragma unroll
            for (int mt = 0; mt < 4; ++mt) { f32x4 c4 = C[4 + mt] * decay;
#pragma unroll
                for (int k2 = 0; k2 < 2; ++k2) c4 = __builtin_amdgcn_mfma_f32_16x16x32_bf16(ak2[mt][k2], vf[k2], c4, 0, 0, 0);
                C[4 + mt] = c4; }
            float sm = 0.f;
#pragma unroll
            for (int t = 0; t < 16; ++t) sm += bf2f(kc[t]);
            sm = quad_sum(sm);
            nsum = decay * nold + sm;
        }
#undef LFENCE
#undef QFRAG
        asm volatile("" ::: "memory");
        if ((tid & 7) == 0) ((LAS float*)(L + O_RD))[tid >> 3] = rdv;
        if ((tid & 3) == 0) ((LAS float*)(L + O_NV))[(par ^ 1) * 128 + (tid >> 2)] = nsum;
#pragma unroll
        for (int mt = 0; mt < 8; ++mt) { u32x2 o; o.x = pk2(C[mt][0], C[mt][1]); o.y = pk2(C[mt][2], C[mt][3]);
            *(LAS u32x2*)(CTw + fr * XS + (16 * mt + 4 * g) * 2) = o; }
        if (more && w == 7) gate_arrays(L, glf, gig, c + 1, lane);
        MLS_BAR();
        {
#pragma unroll
            for (int mt = 0; mt < 4; ++mt) { const f32x4 rd = *(const LAS f32x4*)(L + O_RD + (16 * mt + 4 * g) * 4);
#pragma unroll
                for (int reg = 0; reg < 4; ++reg) *(LAS bf16_t*)(L + O_OT + (16 * mt + 4 * g + reg) * XS + (16 * w + fr) * 2) = (bf16_t)f2bf(acc[mt][reg] * rd[reg]); }
            if (more) MLS_STAGE(c + 1);
        }
        MLS_BAR();
        {
            const int j = tid >> 3, ch = tid & 7;
            const u32x4 o0 = *(const LAS u32x4*)(L + O_OT + j * XS + ch * 32), o1 = *(const LAS u32x4*)(L + O_OT + j * XS + ch * 32 + 16);
            bf16_t* op = HOUT + (size_t)row_of(b, dir, c, j) * D + hd * 256 + half * 128 + ch * 16;
            *(u32x4*)op = o0; *(u32x4*)(op + 8) = o1;
        }
    }
#undef MLS_BAR
#undef MLS_LOAD
#undef MLS_STAGE
}
}
constexpr int MISC_OFF = 135936, LDS_TOTAL = 136192;
static_assert(mls::LDS_BYTES <= MISC_OFF && pg8::STAGE_BYTES <= MISC_OFF && attn_body::LDS_BYTES <= MISC_OFF, "lds");
#ifndef EN_MASK
#define EN_MASK 0xFFFFFFFFu
#endif
#define PH_ON(k) (((EN_MASK) >> (k)) & 1u)
#ifndef REP_MASK
#define REP_MASK 0u
#endif
#define REP_ON(k) (((REP_MASK) >> (k)) & 1u)
#ifndef PH_LIMIT
#define PH_LIMIT 1000
#endif
#ifndef N_LAUNCH_SPLIT
#define N_LAUNCH_SPLIT 0
#endif
constexpr int N_PHASES = 1 + 10 + 9 + 9 + 9;

struct Args { const float* in[21]; float* out; unsigned char* ws; int ph_lo, ph_hi; };
static_assert(sizeof(Args) == 23 * 8 + 8, "no padding");

__device__ __forceinline__ Frame make_frame(unsigned char* lds_gen, unsigned char* ws_) {
    Frame F; int t = threadIdx.x; asm volatile("" : "+v"(t));
    int bx = blockIdx.x; asm volatile("" : "+s"(bx));
    F.lds = (LAS unsigned char*)lds_gen; F.tid = t; F.lane = t & 63; F.wave = __builtin_amdgcn_readfirstlane(t >> 6);
    F.G = gridDim.x; F.bid = bx; F.vcu = (F.G % 8 == 0) ? (bx % 8) * (F.G / 8) + bx / 8 : bx;
    F.gw = F.vcu * NWAVES + F.wave; F.NGW = F.G * NWAVES;
    unsigned char* w = ws_; asm volatile("" : "+s"(w)); F.ws = w; F.in = (const float* const*)(w + WS_PTRS); return F;
}
__global__ void __launch_bounds__(NTHREADS, 2) fwd(Args a) {
    extern __shared__ __attribute__((aligned(16))) unsigned char lds_raw[];
    unsigned char* const lds_gen = lds_raw;
    unsigned char* ws = a.ws;
    if (threadIdx.x < 4) ((LAS unsigned*)((LAS unsigned char*)lds_raw + MISC_OFF))[threadIdx.x] = 0u;
    __syncthreads();
    XcdBarrier bar = xcd_barrier_post((unsigned*)(ws + WS_CTL), (volatile LAS unsigned*)((LAS unsigned char*)lds_raw + MISC_OFF));
    int cur = 0; const int lo = a.ph_lo, hi = a.ph_hi & 0xffff; bool ran = false;
#define PHASE_BEGIN if (cur >= lo && cur < hi) { if (ran) xcd_barrier(bar); ran = true;
#define PHASE_END   } ++cur;

    if (blockIdx.x == 0 && threadIdx.x < 22) ((const float**)(ws + WS_PTRS))[threadIdx.x] = (threadIdx.x < 21) ? a.in[threadIdx.x] : (const float*)a.out;
#define XL ((float*)F.in[21])
#define XC ((float*)(F.ws + WS_XC))
#define H ((bf16_t*)(F.ws + WS_H))
#define MIX ((bf16_t*)(F.ws + WS_MIX))
#define BIG0 ((bf16_t*)(F.ws + WS_BIG0))
#define BIG1 ((bf16_t*)(F.ws + WS_BIG1))
#define GATES ((float*)(F.ws + WS_GATES))
#define AFF ((float*)(F.ws + WS_AFF))
#define INV ((int*)(F.ws + WS_INV))
#define SLROW ((int*)(F.ws + WS_SLROW))
#define SLG ((float*)(F.ws + WS_SLG))
#define IN(k) (F.in[k])

    PHASE_BEGIN if (PH_ON(0)) for (int rep_ = 0; rep_ < (REP_ON(0) ? 2 : 1); ++rep_) { if (rep_) xcd_barrier(bar); Frame F = make_frame(lds_gen, a.ws); p0_prologue(F, a.in, F.ws); } PHASE_END

    for (int layer = 0; layer < DEPTH; ++layer) {
        const bool last = (layer == DEPTH - 1); const int j = layer >> 1;
#define modv ((const float*)(F.ws + WS_MODV) + (size_t)layer * NMI * 6 * D)
#define xLs ((layer == 0) ? IN(0) : (const float*)XL)
#define xCs ((layer == 0) ? IN(2) : (const float*)XC)
        if ((layer & 1) == 0) {
            if (layer == 0) { PHASE_BEGIN if (PH_ON(1)) for (int rep_ = 0; rep_ < (REP_ON(1) ? 2 : 1); ++rep_) { if (rep_) xcd_barrier(bar); Frame F = make_frame(lds_gen, a.ws); norm_pass<1>(F, xLs, xCs, RT, IN(6) + layer * D, modv + 0 * D, modv + 1 * D, H, IN(8) + (size_t)j * D * MW_IN + 3072, MW_IN, IN(9) + j * 16, GATES); } PHASE_END }
            PHASE_BEGIN if (PH_ON(2)) for (int rep_ = 0; rep_ < (REP_ON(2) ? 2 : 1); ++rep_) { if (rep_) xcd_barrier(bar); Frame F = make_frame(lds_gen, a.ws); { pg8::PlainSched S{(const char*)H, (const char*)((bf16_t*)(F.ws + WS_WMI) + (size_t)j * 3072 * D), RT / 256, 12, D, F.G, F.bid};
                pg8::EpiBf16 E{BIG0, 3072, 2, 0.08838834764831845f}; pg8::gemm_phase(F.lds, F.tid, D, S, E); } } PHASE_END
            PHASE_BEGIN if (PH_ON(3)) for (int rep_ = 0; rep_ < (REP_ON(3) ? 2 : 1); ++rep_) { if (rep_) xcd_barrier(bar); Frame F = make_frame(lds_gen, a.ws); for (int u = F.vcu; u < 256; u += F.G) { const int half = u & 1, dir = (u >> 1) & 1, hd = (u >> 2) & 3, b = u >> 4;
                mls::mlstm_unit(F, b, hd, dir, half, BIG0, GATES, dir ? MIX : H); } } PHASE_END
            PHASE_BEGIN if (PH_ON(4)) for (int rep_ = 0; rep_ < (REP_ON(4) ? 2 : 1); ++rep_) { if (rep_) xcd_barrier(bar); Frame F = make_frame(lds_gen, a.ws); mlstm_readout(F, H, MIX, BIG0, IN(10) + j * D, MIX); } PHASE_END
            PHASE_BEGIN if (PH_ON(5)) for (int rep_ = 0; rep_ < (REP_ON(5) ? 2 : 1); ++rep_) { if (rep_) xcd_barrier(bar); Frame F = make_frame(lds_gen, a.ws); { pg8::PlainSched S{(const char*)MIX, (const char*)((bf16_t*)(F.ws + WS_WMO) + (size_t)j * D * D), RT / 256, 4, D, F.G, F.bid};
                pg8::EpiResid E{xLs, xCs, XL, XC, modv + 2 * D}; pg8::gemm_phase(F.lds, F.tid, D, S, E); } } PHASE_END
        } else {
#define KALL BIG1
#define VALL (BIG1 + (size_t)NB * KVLEN * 256)
            PHASE_BEGIN if (PH_ON(7)) for (int rep_ = 0; rep_ < (REP_ON(7) ? 2 : 1); ++rep_) { if (rep_) xcd_barrier(bar); Frame F = make_frame(lds_gen, a.ws); { pg8::PlainSched S{(const char*)H, (const char*)((bf16_t*)(F.ws + WS_WAI) + (size_t)j * 1536 * D), RT / 256, 6, D, F.G, F.bid};
                pg8::EpiBf16 E{BIG0, 1536, 0, 1.f}; pg8::gemm_phase(F.lds, F.tid, D, S, E); } } PHASE_END
            PHASE_BEGIN if (PH_ON(8)) for (int rep_ = 0; rep_ < (REP_ON(8) ? 2 : 1); ++rep_) { if (rep_) xcd_barrier(bar); Frame F = make_frame(lds_gen, a.ws); qk_pass(F, BIG0, IN(13) + j * 64, IN(14) + j * 64, (const float*)(F.ws + WS_ROPE), (const float*)(F.ws + WS_ROPE) + SEQ * 32, KALL, VALL); } PHASE_END
            PHASE_BEGIN if (PH_ON(9)) for (int rep_ = 0; rep_ < (REP_ON(9) ? 2 : 1); ++rep_) { if (rep_) xcd_barrier(bar); Frame F = make_frame(lds_gen, a.ws); { const int nun = last ? 4096 : 4096 + 256;
                for (int L = F.vcu; L < nun; L += F.G) {
                    const bool isc = L >= 4096; const int Lc = L - 4096;
                    const int grp = L >> 6, wi = L & 63;
                    const int b = isc ? (Lc >> 4) : (grp >> 2), hq = isc ? (Lc & 15) : ((grp & 3) * 4 + (wi >> 4));
                    const size_t row0 = isc ? ((size_t)RL + b * CTXL) : ((size_t)b * SEQ + (wi & 15) * 256);
                    const bf16_t* qp = BIG0 + row0 * 1536 + hq * 64; const bf16_t* kp = KALL + (size_t)b * KVLEN * 256 + (hq >> 2) * 64; const bf16_t* vp = VALL + (size_t)b * KVLEN * 256 + (hq >> 2) * 64; bf16_t* op = MIX + row0 * D + hq * 64;
                    if (isc) attn_body::attn_unit<8>(qp, 1536, kp, vp, 256, CTXL / 64, op, D, (char*)lds_gen, F.tid);
                    else     attn_body::attn_unit<8>(qp, 1536, kp, vp, 256, KVLEN / 64, op, D, (char*)lds_gen, F.tid); } } } PHASE_END
            PHASE_BEGIN if (PH_ON(10)) for (int rep_ = 0; rep_ < (REP_ON(10) ? 2 : 1); ++rep_) { if (rep_) xcd_barrier(bar); Frame F = make_frame(lds_gen, a.ws); { pg8::PlainSched S{(const char*)MIX, (const char*)((bf16_t*)(F.ws + WS_WAO) + (size_t)j * D * D), (last ? RL : RT) / 256, 4, D, F.G, F.bid};
                pg8::EpiResid E{xLs, xCs, XL, XC, modv + 2 * D}; pg8::gemm_phase(F.lds, F.tid, D, S, E); } } PHASE_END
        }
        const int nrows = last ? RL : RT;
        PHASE_BEGIN if (PH_ON(11)) for (int rep_ = 0; rep_ < (REP_ON(11) ? 2 : 1); ++rep_) { if (rep_) xcd_barrier(bar); Frame F = make_frame(lds_gen, a.ws); moe_weights(F, IN(17) + (size_t)layer * NE * D * D, IN(18) + (size_t)layer * NE * D * D, IN(19) + (size_t)layer * NE * D * D, F.ws);
            norm_pass<2, MOE_FP8_1 != 0>(F, XL, XC, nrows, IN(7) + layer * D, modv + 3 * D, modv + 4 * D, H, IN(16) + (size_t)layer * D * 16, 16, nullptr, AFF); } PHASE_END
        PHASE_BEGIN if (PH_ON(12)) for (int rep_ = 0; rep_ < (REP_ON(12) ? 2 : 1); ++rep_) { if (rep_) xcd_barrier(bar); Frame F = make_frame(lds_gen, a.ws); moe_select(F, AFF, INV, SLROW, SLG, last ? NB * NE : 2 * NB * NE); } PHASE_END
        PHASE_BEGIN if (PH_ON(14)) for (int rep_ = 0; rep_ < (REP_ON(14) ? 2 : 1); ++rep_) { if (rep_) xcd_barrier(bar); Frame F = make_frame(lds_gen, a.ws); { constexpr int K1 = MOE_FP8_1 ? D / 2 : D;
            pg8::MoeSched S{(const char*)H, (const char*)(F.ws + WS_W1), last ? 32 : 34, 8, K1, 2048, F.G, F.bid};
            pg8::EpiSwiglu E{(void*)BIG1, MOE_FP8_1 ? 1.f / (FP8_SH * FP8_SW) : 1.f, MOE_FP8_2 != 0}; pg8::gemm_phase<pg8::EpiSwiglu, pg8::MoeSched, true, MOE_FP8_1 != 0>(F.lds, F.tid, K1, S, E, SLROW); } } PHASE_END
        PHASE_BEGIN if (PH_ON(15)) for (int rep_ = 0; rep_ < (REP_ON(15) ? 2 : 1); ++rep_) { if (rep_) xcd_barrier(bar); Frame F = make_frame(lds_gen, a.ws); { constexpr int K2 = MOE_FP8_2 ? D / 2 : D;
            pg8::MoeSched S{(const char*)BIG1, (const char*)(F.ws + WS_W2), last ? 32 : 34, 4, K2, 1024, F.G, F.bid};
            pg8::EpiRowScale E{BIG0, SLG, MOE_FP8_2 ? 1.f / (FP8_SA * FP8_SW) : 1.f}; pg8::gemm_phase<pg8::EpiRowScale, pg8::MoeSched, false, MOE_FP8_2 != 0>(F.lds, F.tid, K2, S, E); } } PHASE_END
        PHASE_BEGIN if (PH_ON(16)) for (int rep_ = 0; rep_ < (REP_ON(16) ? 2 : 1); ++rep_) { if (rep_) xcd_barrier(bar); Frame F = make_frame(lds_gen, a.ws);
            const int nl = layer + 1; const float* modn = (const float*)(F.ws + WS_MODV) + (size_t)nl * NMI * 6 * D;
            if (last) combine_norm<3>(F, BIG0, INV, XL, XC, modv + 5 * D, RL, IN(20), nullptr, nullptr, nullptr, nullptr, 0, nullptr, nullptr);
            else if (nl & 1) combine_norm<0>(F, BIG0, INV, XL, XC, modv + 5 * D, RT, IN(6) + nl * D, modn + 0 * D, modn + 1 * D, H, nullptr, 0, nullptr, nullptr);
            else combine_norm<1>(F, BIG0, INV, XL, XC, modv + 5 * D, RT, IN(6) + nl * D, modn + 0 * D, modn + 1 * D, H, IN(8) + (size_t)(nl >> 1) * D * MW_IN + 3072, MW_IN, IN(9) + (nl >> 1) * 16, GATES); } PHASE_END
    }
#undef XL
#undef XC
#undef H
#undef MIX
#undef BIG0
#undef BIG1
#undef GATES
#undef AFF
#undef INV
#undef SLROW
#undef SLG
#undef IN
#undef modv
#undef xLs
#undef xCs
#undef KALL
#undef VALL
#undef PHASE_BEGIN
#undef PHASE_END
}

extern "C" void kernel_launch(void* const* d_in, const int* in_sizes, int n_in, void* d_out, int out_size, void* d_ws, size_t ws_size, hipStream_t stream) {
    static int grid = 0;
    if (grid == 0) {
        if (n_in != 21 || out_size != RL * D || ws_size < WS_END) { fprintf(stderr, "kernel_launch: unexpected shapes: n_in %d out %d ws %zu (need %zu)\n", n_in, out_size, ws_size, (size_t)WS_END); grid = -1; return; }
        int dev = 0, cus = 0, per_cu = 0;
        if (hipGetDevice(&dev) != hipSuccess || hipDeviceGetAttribute(&cus, hipDeviceAttributeMultiprocessorCount, dev) != hipSuccess) { grid = -1; return; }
        if (hipFuncSetAttribute((const void*)fwd, hipFuncAttributeMaxDynamicSharedMemorySize, LDS_TOTAL) != hipSuccess) { fprintf(stderr, "kernel_launch: hipFuncSetAttribute failed\n"); grid = -1; return; }
        if (hipOccupancyMaxActiveBlocksPerMultiprocessor(&per_cu, (const void*)fwd, NTHREADS, LDS_TOTAL) != hipSuccess || per_cu < 1) fprintf(stderr, "kernel_launch: occupancy query says %d\n", per_cu);
        (void)hipGetLastError();
        grid = cus;
    }
    if (grid < 0) return;
    (void)in_sizes;
    if (hipMemsetAsync((char*)d_ws + WS_CTL, 0, CTL_BYTES, stream) != hipSuccess) return;
    Args a{};
    for (int i = 0; i < 21; ++i) a.in[i] = (const float*)d_in[i];
    a.out = (float*)d_out; a.ws = (unsigned char*)d_ws;
    const int nph = N_PHASES < PH_LIMIT ? N_PHASES : PH_LIMIT;
#if N_LAUNCH_SPLIT
    for (int p = 0; p < nph; ++p) { a.ph_lo = p; a.ph_hi = p + 1; hipLaunchKernelGGL(fwd, dim3(grid), dim3(NTHREADS), LDS_TOTAL, stream, a); }
#else
    a.ph_lo = 0; a.ph_hi = nph;
    hipLaunchKernelGGL(fwd, dim3(grid), dim3(NTHREADS), LDS_TOTAL, stream, a);
#endif
    const hipError_t le = hipPeekAtLastError();
    if (le != hipSuccess) fprintf(stderr, "kernel_launch: launch failed: %s\n", hipGetErrorName(le));
}
```

```cpp
#include <hip/hip_runtime.h>
#include <cstdio>
#include <cstdint>

#define GAS __attribute__((address_space(1)))
#define LAS __attribute__((address_space(3)))
typedef unsigned short bf16_t;
typedef short bf16x8 __attribute__((ext_vector_type(8)));
typedef short s16x4 __attribute__((ext_vector_type(4)));
typedef float f32x4 __attribute__((ext_vector_type(4)));
typedef float f32x2 __attribute__((ext_vector_type(2)));
typedef float f32x16 __attribute__((ext_vector_type(16)));
typedef unsigned u32x4 __attribute__((ext_vector_type(4)));
typedef unsigned u32x2 __attribute__((ext_vector_type(2)));

constexpr int D = 1024, NB = 16, SEQ = 4096, CTXL = 256, DEPTH = 4;
constexpr int RL = NB * SEQ, RC = NB * CTXL, RT = RL + RC;
constexpr int NE = 16, CAP_L = 512, CAP_C = 32, SLOTS_E = NB * CAP_L + NB * CAP_C;
constexpr int NMI = NB + 1;
constexpr int MW_IN = 3088;
constexpr int KVLEN = CTXL + SEQ;
constexpr int NWAVES = 8, NTHREADS = 512;
constexpr float NORM_EPS = 1e-6f;

constexpr size_t al256(size_t x) { return (x + 255) & ~(size_t)255; }
constexpr size_t WS_CTL   = 0;
constexpr size_t CTL_BYTES = 16384;
constexpr size_t WS_PTRS  = WS_CTL + CTL_BYTES;
constexpr size_t WS_MODV  = WS_PTRS + 256;
constexpr size_t WS_ROPE  = al256(WS_MODV + (size_t)DEPTH * NMI * 6 * D * 4);
constexpr size_t WS_XC    = al256(WS_ROPE + (size_t)2 * SEQ * 32 * 4);
constexpr size_t WS_GATES = al256(WS_XC + (size_t)RC * D * 4);
constexpr size_t WS_AFF   = al256(WS_GATES + (size_t)RT * 16 * 4);
constexpr size_t WS_INV   = al256(WS_AFF + (size_t)RT * 16 * 4);
constexpr size_t WS_SLROW = al256(WS_INV + (size_t)RT * 16 * 4);
constexpr size_t WS_SLG   = al256(WS_SLROW + (size_t)NE * SLOTS_E * 4);
constexpr size_t WS_WMI   = al256(WS_SLG + (size_t)NE * SLOTS_E * 4);
constexpr size_t WS_WMO   = al256(WS_WMI + (size_t)2 * 3072 * D * 2);
constexpr size_t WS_WAI   = al256(WS_WMO + (size_t)2 * D * D * 2);
constexpr size_t WS_WAO   = al256(WS_WAI + (size_t)2 * 1536 * D * 2);
constexpr size_t WS_W1    = al256(WS_WAO + (size_t)2 * D * D * 2);
constexpr size_t WS_W2    = al256(WS_W1 + (size_t)NE * 2048 * D * 2);
constexpr size_t WS_H     = al256(WS_W2 + (size_t)NE * D * D * 2);
constexpr size_t WS_MIX   = al256(WS_H + (size_t)RT * D * 2);
constexpr size_t WS_BIG0  = al256(WS_MIX + (size_t)RT * D * 2);
constexpr size_t BIG_HALF = (size_t)NE * SLOTS_E * D * 2;
constexpr size_t WS_BIG1  = al256(WS_BIG0 + BIG_HALF);
constexpr size_t WS_END   = al256(WS_BIG1 + BIG_HALF);
static_assert((size_t)RT * 3072 * 2 <= 2 * BIG_HALF, "qkvo fits");

#define LDS_WAIT() asm volatile("s_waitcnt lgkmcnt(0)" ::: "memory")
#define VM_WAIT() asm volatile("s_waitcnt vmcnt(0)" ::: "memory")
typedef __bf16 bf16x2_t __attribute__((ext_vector_type(2)));
__device__ __forceinline__ unsigned pk2(float lo, float hi) { f32x2 v = {lo, hi}; bf16x2_t b = __builtin_convertvector(v, bf16x2_t); return __builtin_bit_cast(unsigned, b); }
__device__ __forceinline__ unsigned f2bf(float f) { return pk2(f, f) & 0xffffu; }
__device__ __forceinline__ float bf_lo(unsigned u) { return __builtin_bit_cast(float, u << 16); }
__device__ __forceinline__ float bf_hi(unsigned u) { return __builtin_bit_cast(float, u & 0xffff0000u); }
__device__ __forceinline__ float bf2f(bf16_t b) { return __builtin_bit_cast(float, ((unsigned)b) << 16); }
__device__ __forceinline__ unsigned pk_fp8x4(float a, float b, float c, float d) {
    a = __builtin_amdgcn_fmed3f(a, -448.f, 448.f); b = __builtin_amdgcn_fmed3f(b, -448.f, 448.f); c = __builtin_amdgcn_fmed3f(c, -448.f, 448.f); d = __builtin_amdgcn_fmed3f(d, -448.f, 448.f);
    int p = __builtin_amdgcn_cvt_pk_fp8_f32(a, b, 0, false); p = __builtin_amdgcn_cvt_pk_fp8_f32(c, d, p, true); return (unsigned)p; }
#ifndef MOE_FP8_1
#define MOE_FP8_1 1
#endif
#ifndef MOE_FP8_2
#define MOE_FP8_2 1
#endif
constexpr float FP8_SH = 16.f, FP8_SW = 512.f, FP8_SA = 8.f;
template <int CTRL> __device__ __forceinline__ float dpp_f(float old, float v) { return __builtin_bit_cast(float, __builtin_amdgcn_update_dpp(__builtin_bit_cast(int, old), __builtin_bit_cast(int, v), CTRL, 0xf, 0xf, false)); }
__device__ __forceinline__ float rdlane(float v, int l) { return __builtin_bit_cast(float, __builtin_amdgcn_readlane(__builtin_bit_cast(int, v), l)); }
__device__ __forceinline__ float row16_sum(float v) {
    v += dpp_f<0xB1>(0.f, v); v += dpp_f<0x4E>(0.f, v); v += dpp_f<0x141>(0.f, v); v += dpp_f<0x140>(0.f, v); return v; }
__device__ __forceinline__ float oct_sum(float v) {
    v += dpp_f<0xB1>(0.f, v); v += dpp_f<0x4E>(0.f, v); v += dpp_f<0x141>(0.f, v); return v; }
__device__ __forceinline__ float quad_sum(float v) { v += dpp_f<0xB1>(0.f, v); v += dpp_f<0x4E>(0.f, v); return v; }
__device__ __forceinline__ float wave_sum(float v) {
    v = row16_sum(v); return (rdlane(v, 0) + rdlane(v, 16)) + (rdlane(v, 32) + rdlane(v, 48)); }
__device__ __forceinline__ float wave_scan_add(float v, int lane) {
    v += dpp_f<0x111>(0.f, v); v += dpp_f<0x112>(0.f, v); v += dpp_f<0x114>(0.f, v); v += dpp_f<0x118>(0.f, v);
    const float t0 = rdlane(v, 15), t1 = rdlane(v, 31), t2 = rdlane(v, 47);
    const int row = lane >> 4; return v + (row == 0 ? 0.f : row == 1 ? t0 : row == 2 ? t0 + t1 : (t0 + t1) + t2); }
__device__ __forceinline__ float wave_scan_max(float v, int lane) {
    const float NI = -INFINITY;
    v = fmaxf(v, dpp_f<0x111>(NI, v)); v = fmaxf(v, dpp_f<0x112>(NI, v)); v = fmaxf(v, dpp_f<0x114>(NI, v)); v = fmaxf(v, dpp_f<0x118>(NI, v));
    const float t0 = rdlane(v, 15), t1 = rdlane(v, 31), t2 = rdlane(v, 47);
    const int row = lane >> 4; return fmaxf(v, row == 0 ? NI : row == 1 ? t0 : row == 2 ? fmaxf(t0, t1) : fmaxf(fmaxf(t0, t1), t2)); }
__device__ __forceinline__ float fast_exp(float x) { return __builtin_amdgcn_exp2f(x * 1.4426950408889634f); }
__device__ __forceinline__ float fast_rcp(float x) { return __builtin_amdgcn_rcpf(x); }
__device__ __forceinline__ float silu_f(float x) { return x / (1.f + __expf(-x)); }

#define XB_TMO      128
#define XB_XCNT(j)  (256  + 64 * (j))
#define XB_XSUB(j)  (1280 + 64 * (j))
#define XB_XGEN(j)  (2304 + 64 * (j))
#define XB_TOP      3328
#define XB_TOPGEN   3392
#define XCD_BAR_WORDS 3456
#define XB_SPIN_CAP (1u << 21)
static_assert(XCD_BAR_WORDS * 4 <= CTL_BYTES, "ctl");

__device__ __forceinline__ unsigned xb_ld(unsigned* p)              { return __hip_atomic_load(p, __ATOMIC_RELAXED, __HIP_MEMORY_SCOPE_AGENT); }
__device__ __forceinline__ unsigned xb_add(unsigned* p, unsigned v) { return __hip_atomic_fetch_add(p, v, __ATOMIC_RELAXED, __HIP_MEMORY_SCOPE_AGENT); }
__device__ __forceinline__ unsigned xb_xcc_id() { return (unsigned)__builtin_amdgcn_s_getreg((3 << 11) | 20) & 0xFu; }
#define XB_SPIN(cond, bar) do { unsigned _sp = 0; while (cond) { __builtin_amdgcn_s_sleep(1); \
    if ((++_sp & 255u) == 0u) { if (xb_ld(&(bar)[XB_TMO])) break; if (_sp > XB_SPIN_CAP) { atomicAdd(&(bar)[XB_TMO], 1u); break; } } } } while (0)

struct XcdBarrier { unsigned* bar; unsigned x; volatile LAS unsigned* st; };

__device__ __forceinline__ XcdBarrier xcd_barrier_post(unsigned* bar, volatile LAS unsigned* st) {
    XcdBarrier b; b.bar = bar; b.x = xb_xcc_id(); b.st = st;
    if (threadIdx.x == 0) (void)xb_add(&bar[XB_XCNT(b.x)], 1u);
    return b;
}
__device__ __forceinline__ void xcd_barrier_complete(unsigned* bar, unsigned x, unsigned& nloc, unsigned& nx) {
    const unsigned G = gridDim.x * gridDim.y * gridDim.z;
    unsigned sum, cnt, mine, sp = 0u;
    for (;;) {
        sum = 0u; cnt = 0u; mine = 0u;
#pragma unroll
        for (unsigned j = 0; j < 16; ++j) { const unsigned c = xb_ld(&bar[XB_XCNT(j)]); sum += c; cnt += (c > 0u) ? 1u : 0u; mine = (j == x) ? c : mine; }
        if (sum == G) break;
        __builtin_amdgcn_s_sleep(1);
        if ((++sp & 255u) == 0u) { if (xb_ld(&bar[XB_TMO])) break; if (sp > XB_SPIN_CAP) { atomicAdd(&bar[XB_TMO], 1u); break; } }
    }
    nloc = mine > 0u ? mine : 1u; nx = cnt > 0u ? cnt : 1u;
}
__device__ __forceinline__ void xcd_barrier(const XcdBarrier& b, const int wave_s) {
    asm volatile("s_waitcnt vmcnt(0)" ::: "memory");
    __syncthreads();
    int ln_; asm volatile("v_mbcnt_lo_u32_b32 %0, -1, 0\n\tv_mbcnt_hi_u32_b32 %0, -1, %0" : "=v"(ln_));
    if (wave_s == 0 && ln_ == 0) {
        unsigned* bar = b.bar;
        __builtin_amdgcn_s_waitcnt(0);
        unsigned nloc = b.st[0], nx = b.st[1];
        if (nloc == 0u) { xcd_barrier_complete(bar, b.x, nloc, nx); b.st[0] = nloc; b.st[1] = nx; }
        const unsigned old = xb_add(&bar[XB_XSUB(b.x)], 1u);
        const unsigned gen = old / nloc;
        if (old + 1u == (gen + 1u) * nloc) {
            __builtin_amdgcn_fence(__ATOMIC_RELEASE, "agent");
            asm volatile("s_waitcnt vmcnt(0)" ::: "memory");
            const unsigned og = xb_add(&bar[XB_TOP], 1u);
            const unsigned tg = og / nx;
            if (og + 1u == (tg + 1u) * nx) xb_add(&bar[XB_TOPGEN], 1u);
            else XB_SPIN(xb_ld(&bar[XB_TOPGEN]) == tg, bar);
            __builtin_amdgcn_fence(__ATOMIC_ACQUIRE, "agent");
            xb_add(&bar[XB_XGEN(b.x)], 1u);
            asm volatile("s_waitcnt vmcnt(0)" ::: "memory");
        } else {
            XB_SPIN(xb_ld(&bar[XB_XGEN(b.x)]) == gen, bar);
            __builtin_amdgcn_fence(__ATOMIC_ACQUIRE, "agent");
            asm volatile("s_waitcnt vmcnt(0)" ::: "memory");
        }
    }
    __syncthreads();
}
namespace pg8 {
constexpr int BM = 256, BK = 64, HALF = 128, HTB = HALF * BK * 2, STAGE_BYTES = 8 * HTB, NXCD = 8, WGM = 8;

__host__ __device__ __forceinline__ int lds_byte(int r, int c) { const int st = (r >> 4) * 2 + (c >> 5), rr = r & 15, cc = c & 31, ob = rr * 64 + cc * 2; return st * 1024 + (ob ^ (((ob >> 9) & 1) << 5)); }
__host__ __device__ __forceinline__ void stage_rc(int b, int& R, int& C) { const int st = b / 1024, sb = b % 1024, swz = sb ^ (((sb >> 9) & 1) << 5); R = (st >> 1) * 16 + swz / 64; C = (st & 1) * 32 + (swz % 64) / 2; }
__host__ __device__ __forceinline__ int perm32(int rho) { const int n = rho >> 4, i = rho & 15; return 8 * (i >> 2) + 4 * n + (i & 3); }

struct Unit { const char* A; const char* B; int pm, pn; };

__device__ __forceinline__ bool static_tile(int i, int G, int c, int nM, int nN, int& pm, int& pn) {
    const int nwg = nM * nN; const long L = (long)i * G + c; if (L >= nwg) return false;
    int wgid = (int)L; { const int q = nwg / NXCD, r = nwg % NXCD, xcd = wgid % NXCD, off = wgid / NXCD; wgid = (xcd < r ? xcd * (q + 1) : r * (q + 1) + (xcd - r) * q) + off; }
    const int nig = WGM * nN, gid = wgid / nig, fm = gid * WGM, gsz = (nM - fm) < WGM ? (nM - fm) : WGM;
    pm = fm + ((wgid % nig) % gsz); pn = (wgid % nig) / gsz; return true;
}
struct PlainSched {
    const char* A; const char* Bt; int nM, nN, K, G, c;
    __device__ __forceinline__ bool next(int i, Unit& u) const {
        int pm, pn; if (!static_tile(i, G, c, nM, nN, pm, pn)) return false;
        u.pm = pm; u.pn = pn; u.A = A + (size_t)pm * 256 * K * 2; u.B = Bt + (size_t)pn * 256 * K * 2; return true;
    }
};
struct MoeSched {
    const char* A; const char* W; int tpe, nN, K, bN, G, c;
    __device__ __forceinline__ bool next(int i, Unit& u) const {
        int pm, pn; if (!static_tile(i, G, c, NE * tpe, nN, pm, pn)) return false;
        const int e = pm / tpe, rt = pm - e * tpe;
        u.pm = e * (SLOTS_E / 256) + rt; u.pn = pn;
        u.A = A + (size_t)u.pm * 256 * K * 2; u.B = W + ((size_t)e * bN + (size_t)pn * 256) * K * 2; return true;
    }
};

__device__ __forceinline__ unsigned cvt_pk_bf16(float lo, float hi) { return pk2(lo, hi); }


struct EpiBf16 {
    static constexpr bool PERM = true;
    bf16_t* O; int ldc; int nscale; float scale;
    __device__ __forceinline__ void operator()(const f32x4 (&acc)[2][2][4][2], const Unit& u, int wr, int wc, int fr, int fq) const {
        const int row0 = u.pm * BM + wr * 64 + fr, col0 = u.pn * BM + wc * 32 + 8 * fq;
        const float s = (u.pn < nscale) ? scale : 1.f;
#pragma unroll
        for (int ai = 0; ai < 2; ++ai)
#pragma unroll
            for (int m = 0; m < 4; ++m) { bf16_t* rowp = O + (size_t)(row0 + ai * HALF + m * 16) * ldc + col0;
#pragma unroll
                for (int bj = 0; bj < 2; ++bj) { const f32x4 v0 = acc[ai][bj][m][0] * s, v1 = acc[ai][bj][m][1] * s;
                    u32x4 o; o.x = cvt_pk_bf16(v0[0], v0[1]); o.y = cvt_pk_bf16(v0[2], v0[3]); o.z = cvt_pk_bf16(v1[0], v1[1]); o.w = cvt_pk_bf16(v1[2], v1[3]);
                    *(u32x4*)(rowp + bj * HALF) = o; } }
    }
};
struct EpiResid {
    static constexpr bool PERM = false;
    const float* srcL; const float* srcC; float* dstL; float* dstC; const float* gate;
    __device__ __forceinline__ void operator()(const f32x4 (&acc)[2][2][4][2], const Unit& u, int wr, int wc, int fr, int fq) const {
        const bool isc = u.pm >= RL / 256;
        const int mi = isc ? NB : (u.pm >> 4);
        const int rbase = (isc ? (u.pm - RL / 256) : u.pm) * BM + wr * 64 + fr, col0 = u.pn * BM + wc * 32 + 4 * fq;
        const float* src = isc ? srcC : srcL; float* dst = isc ? dstC : dstL;
        const float* gp = gate + (size_t)mi * 6 * D + col0;
        f32x4 gv[2][2];
#pragma unroll
        for (int bj = 0; bj < 2; ++bj)
#pragma unroll
            for (int n = 0; n < 2; ++n) gv[bj][n] = *(const f32x4*)(gp + bj * HALF + n * 16);
#pragma unroll
        for (int ai = 0; ai < 2; ++ai)
#pragma unroll
            for (int m = 0; m < 4; ++m) { const size_t ro = (size_t)(rbase + ai * HALF + m * 16) * D + col0;
#pragma unroll
                for (int bj = 0; bj < 2; ++bj)
#pragma unroll
                    for (int n = 0; n < 2; ++n) { const f32x4 xv = *(const f32x4*)(src + ro + bj * HALF + n * 16);
                        *(f32x4*)(dst + ro + bj * HALF + n * 16) = xv + gv[bj][n] * acc[ai][bj][m][n]; } }
    }
};
struct EpiSwiglu {
    static constexpr bool PERM = true;
    void* O; float ds; bool f8out;
    __device__ __forceinline__ void operator()(const f32x4 (&acc)[2][2][4][2], const Unit& u, int wr, int wc, int fr, int fq) const {
        const int row0 = u.pm * BM + wr * 64 + fr, col0 = u.pn * HALF + wc * 32 + 8 * fq;
#pragma unroll
        for (int ai = 0; ai < 2; ++ai)
#pragma unroll
            for (int m = 0; m < 4; ++m) { const size_t ro = (size_t)(row0 + ai * HALF + m * 16) * D + col0;
                float r[8];
#pragma unroll
                for (int n = 0; n < 2; ++n)
#pragma unroll
                    for (int j = 0; j < 4; ++j) { const float g = acc[ai][0][m][n][j] * ds, up = acc[ai][1][m][n][j] * ds; r[n * 4 + j] = g * fast_rcp(1.f + fast_exp(-g)) * up; }
                if (f8out) { u32x2 o; o.x = pk_fp8x4(r[0] * FP8_SA, r[1] * FP8_SA, r[2] * FP8_SA, r[3] * FP8_SA); o.y = pk_fp8x4(r[4] * FP8_SA, r[5] * FP8_SA, r[6] * FP8_SA, r[7] * FP8_SA);
                    *(u32x2*)((unsigned char*)O + ro) = o; }
                else { u32x4 o; o.x = cvt_pk_bf16(r[0], r[1]); o.y = cvt_pk_bf16(r[2], r[3]); o.z = cvt_pk_bf16(r[4], r[5]); o.w = cvt_pk_bf16(r[6], r[7]);
                    *(u32x4*)((bf16_t*)O + ro) = o; } }
    }
};
struct EpiRowScale {
    static constexpr bool PERM = true;
    bf16_t* O; const float* g; float ds;
    __device__ __forceinline__ void operator()(const f32x4 (&acc)[2][2][4][2], const Unit& u, int wr, int wc, int fr, int fq) const {
        const int row0 = u.pm * BM + wr * 64 + fr, col0 = u.pn * BM + wc * 32 + 8 * fq;
#pragma unroll
        for (int ai = 0; ai < 2; ++ai)
#pragma unroll
            for (int m = 0; m < 4; ++m) { const int row = row0 + ai * HALF + m * 16; const float s = g[row] * ds; bf16_t* rowp = O + (size_t)row * D + col0;
#pragma unroll
                for (int bj = 0; bj < 2; ++bj) { const f32x4 v0 = acc[ai][bj][m][0] * s, v1 = acc[ai][bj][m][1] * s;
                    u32x4 o; o.x = cvt_pk_bf16(v0[0], v0[1]); o.y = cvt_pk_bf16(v0[2], v0[3]); o.z = cvt_pk_bf16(v1[0], v1[1]); o.w = cvt_pk_bf16(v1[2], v1[3]);
                    *(u32x4*)(rowp + bj * HALF) = o; } }
    }
};

template <class Epi, class Sched, bool GATHER = false, bool FP8 = false>
__device__ __forceinline__ void gemm_phase(LAS unsigned char* lds, const int tid, const int K, const Sched& S, const Epi& E, const int* rowidx = nullptr) {
    const int wid = __builtin_amdgcn_readfirstlane(tid >> 6), lane = tid & 63, wr = wid >> 2, wc = wid & 3, fr = lane & 15, fq = lane >> 4;
    const int nt = K / BK;
    unsigned voffA[2], voffB[2]; int gR[2], gC[2];
#pragma unroll
    for (int i = 0; i < 2; ++i) { int R, C; stage_rc(tid * 16 + i * 8192, R, C); const int Rb = Epi::PERM ? ((R & ~31) + perm32(R & 31)) : R;
        voffA[i] = (unsigned)(R * K + C) * 2u; voffB[i] = (unsigned)(Rb * K + C) * 2u; gR[i] = R; gC[i] = C * 2; }
    unsigned gcur[2][2], gnxt[2][2];
#define PG8_GIDX(dst, unit) do { if (GATHER) { _Pragma("unroll") for (int h_ = 0; h_ < 2; ++h_) _Pragma("unroll") for (int i_ = 0; i_ < 2; ++i_) \
        dst[h_][i_] = (unsigned)rowidx[(unit).pm * 256 + h_ * 128 + gR[i_]] * (unsigned)(K * 2) + (unsigned)gC[i_]; } } while (0)
    const size_t kstep = (size_t)(BK * 2);
    const size_t hstep = (size_t)HALF * K * 2;
    const unsigned ldsw = (unsigned)wid * 1024u;
    const int aoff = lds_byte(wr * 64 + fr, fq * 8), boff = lds_byte(wc * 32 + fr, fq * 8);
#define PG8_SA(b, h) (((b) * 2 + (h)) * HTB)
#define PG8_SB(b, h) ((4 + (b) * 2 + (h)) * HTB)
#define PG8_STAGE(bufoff, gbase, voff) do { _Pragma("unroll") for (int _i = 0; _i < 2; ++_i) \
        __builtin_amdgcn_global_load_lds((const unsigned*)((const char*)(gbase) + (voff)[_i]), (LAS unsigned*)(lds + (bufoff) + ldsw + _i * 8192), 16, 0, 0); } while (0)
#define PG8_STAGE_A(b, h, gbase, NX) do { if (GATHER) { unsigned go_[2]; go_[0] = (NX) ? gnxt[h][0] : gcur[h][0]; go_[1] = (NX) ? gnxt[h][1] : gcur[h][1]; PG8_STAGE(PG8_SA(b, h), (gbase), go_); } \
        else { PG8_STAGE(PG8_SA(b, h), (gbase) + (h) * hstep, voffA); } } while (0)
#define PG8_LDA(dst, b, h) do { _Pragma("unroll") for (int m = 0; m < 4; ++m) _Pragma("unroll") for (int k = 0; k < 2; ++k) dst[m][k] = *(const LAS bf16x8*)(lds + PG8_SA(b, h) + aoff + m * 2048 + k * 1024); } while (0)
#define PG8_LDB(dst, b, h) do { _Pragma("unroll") for (int n = 0; n < 2; ++n) _Pragma("unroll") for (int k = 0; k < 2; ++k) dst[n][k] = *(const LAS bf16x8*)(lds + PG8_SB(b, h) + boff + n * 2048 + k * 1024); } while (0)
#define PG8_MMA(ai, bj, At, Bt) do { __builtin_amdgcn_s_setprio(1); if (FP8) { _Pragma("unroll") for (int m = 0; m < 4; ++m) _Pragma("unroll") for (int n = 0; n < 2; ++n) { \
            typedef int v8i_ __attribute__((ext_vector_type(8))); typedef int v4i_ __attribute__((ext_vector_type(4))); \
            const v4i_ b0_ = __builtin_bit_cast(v4i_, Bt[n][0]), b1_ = __builtin_bit_cast(v4i_, Bt[n][1]), a0_ = __builtin_bit_cast(v4i_, At[m][0]), a1_ = __builtin_bit_cast(v4i_, At[m][1]); \
            const v8i_ bb_ = {b0_[0], b0_[1], b0_[2], b0_[3], b1_[0], b1_[1], b1_[2], b1_[3]}, aa_ = {a0_[0], a0_[1], a0_[2], a0_[3], a1_[0], a1_[1], a1_[2], a1_[3]}; \
            asm volatile("v_mfma_scale_f32_16x16x128_f8f6f4 %0, %1, %2, %0, %3, %3 op_sel_hi:[0,0,0]" : "+v"(acc[ai][bj][m][n]) : "v"(bb_), "v"(aa_), "v"(sc127)); } } \
        else { _Pragma("unroll") for (int m = 0; m < 4; ++m) _Pragma("unroll") for (int n = 0; n < 2; ++n) _Pragma("unroll") for (int k = 0; k < 2; ++k) \
        acc[ai][bj][m][n] = __builtin_amdgcn_mfma_f32_16x16x32_bf16(Bt[n][k], At[m][k], acc[ai][bj][m][n], 0, 0, 0); } __builtin_amdgcn_s_setprio(0); } while (0)
#define PG8_WAIT_V(n) asm volatile("s_waitcnt vmcnt(" #n ")" ::: "memory")
#define PG8_WAIT_L(n) asm volatile("s_waitcnt lgkmcnt(" #n ")" ::: "memory")
#define PG8_BAR __builtin_amdgcn_s_barrier()
#define PG8_SCHED __builtin_amdgcn_sched_barrier(0)
    Unit cur, nxt; int ui = 0;
    if (!S.next(0, cur)) return;
    int sc127 = 0x7F7F7F7F; asm volatile("" : "+v"(sc127));
    f32x4 acc[2][2][4][2];
#pragma unroll
    for (int a = 0; a < 2; ++a)
#pragma unroll
        for (int b = 0; b < 2; ++b)
#pragma unroll
            for (int m = 0; m < 4; ++m)
#pragma unroll
                for (int n = 0; n < 2; ++n) acc[a][b][m][n] = (f32x4){0.f, 0.f, 0.f, 0.f};
    bf16x8 At[4][2], B0[2][2], B1[2][2];
    const char* cA = GATHER ? S.A : cur.A; const char* cB = cur.B;
    PG8_GIDX(gcur, cur);
    PG8_STAGE(PG8_SB(0, 0), cB, voffB); PG8_STAGE(PG8_SB(0, 1), cB + hstep, voffB); PG8_STAGE_A(0, 0, cA, false); PG8_STAGE_A(0, 1, cA, false);
    if (wr == 1) PG8_BAR;
    PG8_WAIT_V(2); PG8_BAR;
    PG8_STAGE(PG8_SB(1, 0), cB + kstep, voffB); PG8_STAGE_A(1, 0, cA + kstep, false); PG8_STAGE(PG8_SB(1, 1), cB + hstep + kstep, voffB);
    PG8_WAIT_V(6); PG8_BAR;
    for (;;) {
        const bool has_next = S.next(ui + 1, nxt);
        const char* nA = (has_next && !GATHER) ? nxt.A : cA; const char* nB = has_next ? nxt.B : cB;
        if (GATHER) { if (has_next) { PG8_GIDX(gnxt, nxt); } else { _Pragma("unroll") for (int h_ = 0; h_ < 2; ++h_) { gnxt[h_][0] = gcur[h_][0]; gnxt[h_][1] = gcur[h_][1]; } } }
#pragma unroll 1
        for (int t = 0; t < nt; t += 2) {
            const bool last = (t == nt - 2);
            const char* a1 = cA + (size_t)(t + 1) * kstep;
            const char* a2 = last ? nA : cA + (size_t)(t + 2) * kstep; const char* b2 = last ? nB : cB + (size_t)(t + 2) * kstep;
            const char* a3 = a2 + kstep; const char* b3 = b2 + kstep;
            PG8_LDB(B0, 0, 0); PG8_LDB(B1, 0, 1); PG8_SCHED; PG8_LDA(At, 0, 0); PG8_STAGE_A(1, 1, a1, false);
            PG8_WAIT_V(8); PG8_WAIT_L(0); PG8_BAR; PG8_MMA(0, 0, At, B0); PG8_MMA(0, 1, At, B1); PG8_BAR; PG8_SCHED;
            PG8_LDA(At, 0, 1); PG8_STAGE(PG8_SB(0, 0), b2, voffB); PG8_STAGE(PG8_SB(0, 1), b2 + hstep, voffB); PG8_STAGE_A(0, 0, a2, last);
            PG8_WAIT_V(8); PG8_WAIT_L(0); PG8_BAR; PG8_MMA(1, 0, At, B0); PG8_MMA(1, 1, At, B1); PG8_BAR; PG8_SCHED;
            PG8_LDB(B0, 1, 0); PG8_LDB(B1, 1, 1); PG8_SCHED; PG8_LDA(At, 1, 0); PG8_STAGE_A(0, 1, a2, last);
            PG8_WAIT_V(8); PG8_WAIT_L(0); PG8_BAR; PG8_MMA(0, 0, At, B0); PG8_MMA(0, 1, At, B1); PG8_BAR; PG8_SCHED;
            PG8_LDA(At, 1, 1); PG8_STAGE(PG8_SB(1, 0), b3, voffB); PG8_STAGE(PG8_SB(1, 1), b3 + hstep, voffB); PG8_STAGE_A(1, 0, a3, last);
            PG8_WAIT_V(8); PG8_WAIT_L(0); PG8_BAR; PG8_MMA(1, 0, At, B0); PG8_MMA(1, 1, At, B1); PG8_BAR; PG8_SCHED;
        }
        if (wr == 0) PG8_BAR;
        if (FP8) asm volatile("s_nop 15\n\ts_nop 15" ::: "memory");
        { int tz = tid; asm volatile("" : "+v"(tz));
          const int wid2 = __builtin_amdgcn_readfirstlane(tz >> 6), lane2 = tz & 63;
          E(acc, cur, wid2 >> 2, wid2 & 3, lane2 & 15, lane2 >> 4); }
        if (!has_next) break;
#pragma unroll
        for (int a = 0; a < 2; ++a)
#pragma unroll
            for (int b = 0; b < 2; ++b)
#pragma unroll
                for (int m = 0; m < 4; ++m)
#pragma unroll
                    for (int n = 0; n < 2; ++n) acc[a][b][m][n] = (f32x4){0.f, 0.f, 0.f, 0.f};
        cur = nxt; cA = nA; cB = nB; ++ui;
        if (GATHER) { _Pragma("unroll") for (int h_ = 0; h_ < 2; ++h_) { gcur[h_][0] = gnxt[h_][0]; gcur[h_][1] = gnxt[h_][1]; } }
        if (wr == 1) PG8_BAR;
    }
    PG8_WAIT_V(0);
    PG8_BAR;
#undef PG8_SA
#undef PG8_SB
#undef PG8_STAGE
#undef PG8_STAGE_A
#undef PG8_GIDX
#undef PG8_LDA
#undef PG8_LDB
#undef PG8_MMA
#undef PG8_WAIT_V
#undef PG8_WAIT_L
#undef PG8_BAR
#undef PG8_SCHED
}
}
namespace attn_body {
constexpr int NW = 8, QBLK = 32, QB = QBLK * NW, KVBLK = 64;
__device__ __forceinline__ int crow(int r, int hi) { return (r & 3) + 8 * (r >> 2) + 4 * hi; }
#define SBAR() __builtin_amdgcn_sched_barrier(0)
constexpr int NSLOT = 3, SLOTB = 8192;
constexpr int LDS_K = 0, LDS_V = NSLOT * SLOTB, LDS_WS = 2 * NSLOT * SLOTB, LDS_OST = LDS_WS + NW * 64 * 4, LDS_BYTES = LDS_OST + NW * 4096;
constexpr float C2 = 0.125f * 1.4426950408889634f;
__device__ __forceinline__ void glds16(const void* gsrc, unsigned lds_dst) { unsigned keep;
  asm volatile("s_mov_b32 %0, m0\n\ts_mov_b32 m0, %2\n\ts_nop 0\n\tglobal_load_lds_dwordx4 %1, off\n\ts_mov_b32 m0, %0" : "=&s"(keep) : "v"(gsrc), "s"(lds_dst) : "memory"); }
__device__ __forceinline__ float max3f(float a, float b, float c) { float r; asm("v_max3_f32 %0, %1, %2, %3" : "=v"(r) : "v"(a), "v"(b), "v"(c)); return r; }
__device__ __forceinline__ float max2f(float a, float b) { float r; asm("v_max_f32_e32 %0, %1, %2" : "=v"(r) : "v"(a), "v"(b)); return r; }
__device__ __forceinline__ float fadd_s(float a, float b) { float r; asm("v_add_f32_e32 %0, %1, %2" : "=v"(r) : "v"(a), "v"(b)); return r; }
__device__ __forceinline__ float fsub_s(float a, float b) { float r; asm("v_sub_f32_e32 %0, %1, %2" : "=v"(r) : "v"(a), "v"(b)); return r; }
__device__ __forceinline__ unsigned cvtpk_s(float lo, float hi) { f32x2 v = {lo, hi}; bf16x2_t b = __builtin_convertvector(v, bf16x2_t); return __builtin_bit_cast(unsigned, b); }
#define WAIT_BAR(N) asm volatile("s_waitcnt vmcnt(" #N ") lgkmcnt(0)\n\ts_barrier" ::: "memory")

__device__ __forceinline__ void qkt(f32x16& p0, f32x16& p1, const char* Kslot, const bf16x8* qr, const f32x16& negm, int r32, int hi) {
  const char* kb = Kslot + hi * 1024 + r32 * 16;
  #pragma unroll
  for (int d0 = 0; d0 < 4; ++d0) {
    const bf16x8 b0 = *reinterpret_cast<const bf16x8*>(kb + d0 * 2048);
    const bf16x8 b1 = *reinterpret_cast<const bf16x8*>(kb + d0 * 2048 + 512);
    if (d0 == 0) { p0 = __builtin_amdgcn_mfma_f32_32x32x16_bf16(b0, qr[0], negm, 0, 0, 0); p1 = __builtin_amdgcn_mfma_f32_32x32x16_bf16(b1, qr[0], negm, 0, 0, 0); }
    else { p0 = __builtin_amdgcn_mfma_f32_32x32x16_bf16(b0, qr[d0], p0, 0, 0, 0); p1 = __builtin_amdgcn_mfma_f32_32x32x16_bf16(b1, qr[d0], p1, 0, 0, 0); } }
}
typedef __attribute__((address_space(3))) const char* lds_cptr;
typedef short v4i16_t __attribute__((ext_vector_type(4)));
__device__ __forceinline__ void kload8(bf16x8* kf, lds_cptr kp) {
  kf[0] = *(const LAS bf16x8*)(kp);        kf[1] = *(const LAS bf16x8*)(kp + 512);
  kf[2] = *(const LAS bf16x8*)(kp + 2048); kf[3] = *(const LAS bf16x8*)(kp + 2560);
  kf[4] = *(const LAS bf16x8*)(kp + 4096); kf[5] = *(const LAS bf16x8*)(kp + 4608);
  kf[6] = *(const LAS bf16x8*)(kp + 6144); kf[7] = *(const LAS bf16x8*)(kp + 6656);
}
__device__ __forceinline__ void kload2(bf16x8* kf, lds_cptr kp, int j) { kf[2 * j] = *(const LAS bf16x8*)(kp + j * 2048); kf[2 * j + 1] = *(const LAS bf16x8*)(kp + j * 2048 + 512); }
__device__ __forceinline__ s16x4 vtr(lds_cptr p) { return __builtin_bit_cast(s16x4, __builtin_amdgcn_ds_read_tr16_b64_v4i16((LAS v4i16_t*)p)); }
__device__ __forceinline__ float rowmax(const f32x16& p0, const f32x16& p1) {
  float a = max3f(p0[0], p0[1], p1[0]), b = max3f(p0[2], p0[3], p1[1]); a = max3f(a, p1[2], p1[3]);
  #pragma unroll
  for (int r = 4; r < 16; r += 4) { a = max3f(a, p0[r], p0[r + 1]); b = max3f(b, p0[r + 2], p0[r + 3]); a = max3f(a, p1[r], p1[r + 1]); b = max3f(b, p1[r + 2], p1[r + 3]); }
  const float m = max2f(a, b);
  auto rr = __builtin_amdgcn_permlane32_swap(__float_as_uint(m), __float_as_uint(m), false, false);
  return max2f(__uint_as_float(rr[0]), __uint_as_float(rr[1]));
}
__device__ __forceinline__ void pv(f32x16* o, int vb, bf16x8 pa0, bf16x8 pa1, bf16x8 pa2, bf16x8 pa3) {
  #pragma unroll
  for (int d0 = 0; d0 < 2; ++d0) { s16x4 lo[4], hi[4];
    #pragma unroll
    for (int ks = 0; ks < 4; ++ks) {
      asm volatile("ds_read_b64_tr_b16 %0,%1 offset:%c2" : "=&v"(lo[ks]) : "v"(vb), "i"(d0 * 4096 + ks * 1024) : "memory");
      asm volatile("ds_read_b64_tr_b16 %0,%1 offset:%c2" : "=&v"(hi[ks]) : "v"(vb), "i"(d0 * 4096 + ks * 1024 + 512) : "memory"); }
    asm volatile("s_waitcnt lgkmcnt(0)" ::: "memory"); SBAR();
    #define PK(k) (bf16x8){lo[k][0], lo[k][1], lo[k][2], lo[k][3], hi[k][0], hi[k][1], hi[k][2], hi[k][3]}
    o[d0] = __builtin_amdgcn_mfma_f32_32x32x16_bf16(pa0, PK(0), o[d0], 0, 0, 0);
    o[d0] = __builtin_amdgcn_mfma_f32_32x32x16_bf16(pa1, PK(1), o[d0], 0, 0, 0);
    o[d0] = __builtin_amdgcn_mfma_f32_32x32x16_bf16(pa2, PK(2), o[d0], 0, 0, 0);
    o[d0] = __builtin_amdgcn_mfma_f32_32x32x16_bf16(pa3, PK(3), o[d0], 0, 0, 0);
    #undef PK
  }
}

template <int THRL> __device__ __forceinline__ void attn_unit(const bf16_t* Qrow0, int QP, const bf16_t* __restrict__ Kh, const bf16_t* __restrict__ Vh, int KVP, int NT, bf16_t* Orow0, int OP, char* shm, const int tid, const float mfix) {
  const int lane = tid & 63, r32 = lane & 31, hi = lane >> 5; const int wid = __builtin_amdgcn_readfirstlane(tid >> 6);
  const bf16_t* Qw = Qrow0 + (long)(wid * QBLK) * QP;
  const unsigned lds0 = (unsigned)(uintptr_t)shm;
  float* wsf = (float*)(shm + LDS_WS) + wid * 64;
  const bf16_t* ksrc = Kh + (long)lane * KVP + wid * 8;
  const bf16_t* vsrc = Vh + (long)(16 * (wid & 3) + (lane >> 2)) * KVP + (wid >> 2) * 32 + (lane & 3) * 8;
  const unsigned kdst = lds0 + LDS_K + wid * 1024, vdst = lds0 + LDS_V + wid * 1024;
  #define DMA_K(t, slot) glds16(ksrc + (long)(t) * KVBLK * KVP, (unsigned)__builtin_amdgcn_readfirstlane(kdst + (slot)))
  #define DMA_V(t, slot) glds16(vsrc + (long)(t) * KVBLK * KVP, (unsigned)__builtin_amdgcn_readfirstlane(vdst + (slot)))
  const int vb0 = (int)(lds0 + LDS_V) + ((lane >> 4) & 1) * 32 + (lane & 3) * 8 + (4 * hi + ((lane & 15) >> 2)) * 64;
  const char* Kbase = shm + LDS_K; bf16x8 kf[8];
  const lds_cptr shm3 = (lds_cptr)shm; const lds_cptr kp0 = shm3 + LDS_K + hi * 1024 + r32 * 16; const lds_cptr vp0 = shm3 + LDS_V + ((lane >> 4) & 1) * 32 + (lane & 3) * 8 + (4 * hi + ((lane & 15) >> 2)) * 64;
  DMA_K(0, 0); DMA_V(0, 0); DMA_K(1, SLOTB);
  bf16x8 qr[4];
  #pragma unroll
  for (int d0 = 0; d0 < 4; ++d0) qr[d0] = *reinterpret_cast<const bf16x8*>(&Qw[(long)r32 * QP + d0 * 16 + hi * 8]);
  float l_reg = 0.f; f32x16 o[2]; o[0] = f32x16{}; o[1] = f32x16{}; const f32x16 negm = f32x16{}; (void)mfix;
  #define START(P0, P1) do { _Pragma("unroll") for (int r = 0; r < 16; ++r) P0[r] = __builtin_amdgcn_exp2f(P0[r]); } while (0)
  #define RESC() do { } while (0)
  f32x16 pA0, pA1, pB0, pB1;
  int sl_prev = 0, sl_cur = 0, sl_next = SLOTB;
  #define ROT() do { sl_prev = sl_cur; sl_cur = sl_next; sl_next = (sl_next == (NSLOT - 1) * SLOTB) ? 0 : sl_next + SLOTB; } while (0)
  DMA_K(2, 2 * SLOTB);
  WAIT_BAR(3);
  qkt(pA0, pA1, Kbase, qr, negm, r32, hi); asm volatile("s_nop 15\n\ts_nop 7" : "+v"(pA0), "+v"(pA1));
  START(pA0, pA1);
  _Pragma("unroll") for (int r = 0; r < 16; ++r) pA1[r] = __builtin_amdgcn_exp2f(pA1[r]);
  WAIT_BAR(0);
  DMA_K(3, 0); DMA_V(1, SLOTB);
  ROT();
  kload8(kf, kp0 + sl_cur);
  WAIT_BAR(2);
  s16x4 vlo[8], vhi[8]; u32x4 pw0, pw1, pw2, pw3;
  #define PKW(P, B) cvtpk_s(P[B], P[B + 1])
  #define PAF(k) __builtin_bit_cast(bf16x8, pw##k)
  #define VFR(i) (bf16x8){vlo[i][0], vlo[i][1], vlo[i][2], vlo[i][3], vhi[i][0], vhi[i][1], vhi[i][2], vhi[i][3]}
  #define PIN(x) asm volatile("" : "+v"(x))
  #define MX3(a, b, c) __builtin_fmaxf(__builtin_fmaxf((a), (b)), (c))
  #define GAPA(MF, A0, A1, A2, A3, W0, W1, PW) do { MF; sacc += A0; sacc += A1; sacc += A2; sacc += A3; PIN(sacc); W0; W1; PIN(PW); SBAR(); } while (0)
  #define EX(v) __builtin_amdgcn_exp2f(v)
  #define GAPB(MF, X, B) do { MF; X[B] = EX(X[B]); X[B + 1] = EX(X[B + 1]); X[B + 2] = EX(X[B + 2]); X[B + 3] = EX(X[B + 3]); PIN(X); SBAR(); } while (0)
  #define VRD(i) do { vlo[i] = vtr(vp_ + (((i) >> 2) * 4096 + ((i) & 3) * 1024)); vhi[i] = vtr(vp_ + (((i) >> 2) * 4096 + ((i) & 3) * 1024 + 512)); } while (0)
  #define KRD(G, j) do { if (G) { kload2(kf, kp0 + sl_next, j); SBAR(); } } while (0)
  #define STEP(C0, C1, P0, P1, t, GK, GV, GL) do { SBAR(); \
    const lds_cptr vp_ = vp0 + sl_prev; \
    VRD(0); SBAR(); float sacc = (P0[0] + P0[1]); \
    GAPA(C0 = __builtin_amdgcn_mfma_f32_32x32x16_bf16(kf[0], qr[0], negm, 0, 0, 0), P0[2], P0[3], P0[4], P0[5],     pw0[0] = PKW(P0, 0), pw0[1] = PKW(P0, 2), pw0); \
    VRD(4); SBAR(); GAPA(C1 = __builtin_amdgcn_mfma_f32_32x32x16_bf16(kf[1], qr[0], negm, 0, 0, 0), P0[6], P0[7], P0[8], P0[9],     pw0[2] = PKW(P0, 4), pw0[3] = PKW(P0, 6), pw0); \
    VRD(1); SBAR(); GAPA(C0 = __builtin_amdgcn_mfma_f32_32x32x16_bf16(kf[2], qr[1], C0, 0, 0, 0),   P0[10], P0[11], P0[12], P0[13], pw1[0] = PKW(P0, 8), pw1[1] = PKW(P0, 10), pw1); \
    VRD(5); SBAR(); GAPA(C1 = __builtin_amdgcn_mfma_f32_32x32x16_bf16(kf[3], qr[1], C1, 0, 0, 0),   P0[14], P0[15], P1[0], P1[1],   pw1[2] = PKW(P0, 12), pw1[3] = PKW(P0, 14), pw1); \
    VRD(2); SBAR(); GAPA(C0 = __builtin_amdgcn_mfma_f32_32x32x16_bf16(kf[4], qr[2], C0, 0, 0, 0),   P1[2], P1[3], P1[4], P1[5],     pw2[0] = PKW(P1, 0), pw2[1] = PKW(P1, 2), pw2); \
    VRD(6); SBAR(); GAPA(C1 = __builtin_amdgcn_mfma_f32_32x32x16_bf16(kf[5], qr[2], C1, 0, 0, 0),   P1[6], P1[7], P1[8], P1[9],     pw2[2] = PKW(P1, 4), pw2[3] = PKW(P1, 6), pw2); \
    VRD(3); SBAR(); GAPA(C0 = __builtin_amdgcn_mfma_f32_32x32x16_bf16(kf[6], qr[3], C0, 0, 0, 0),   P1[10], P1[11], P1[12], P1[13], pw3[0] = PKW(P1, 8), pw3[1] = PKW(P1, 10), pw3); \
    VRD(7); SBAR(); GAPA(C1 = __builtin_amdgcn_mfma_f32_32x32x16_bf16(kf[7], qr[3], C1, 0, 0, 0),   P1[14], P1[15], 0.f, 0.f,       pw3[2] = PKW(P1, 12), pw3[3] = PKW(P1, 14), pw3); \
    l_reg += sacc; \
    if (GK) { DMA_K((t) + 3, sl_cur); } if (GV) { DMA_V((t) + 1, sl_next); } \
    SBAR(); \
    GAPB(o[0] = __builtin_amdgcn_mfma_f32_32x32x16_bf16(PAF(0), VFR(0), o[0], 0, 0, 0), C0, 0); \
    GAPB(o[1] = __builtin_amdgcn_mfma_f32_32x32x16_bf16(PAF(0), VFR(4), o[1], 0, 0, 0), C0, 4); \
    KRD(GL, 0); GAPB(o[0] = __builtin_amdgcn_mfma_f32_32x32x16_bf16(PAF(1), VFR(1), o[0], 0, 0, 0), C0, 8); \
    KRD(GL, 1); GAPB(o[1] = __builtin_amdgcn_mfma_f32_32x32x16_bf16(PAF(1), VFR(5), o[1], 0, 0, 0), C0, 12); \
    KRD(GL, 2); GAPB(o[0] = __builtin_amdgcn_mfma_f32_32x32x16_bf16(PAF(2), VFR(2), o[0], 0, 0, 0), C1, 0); \
    KRD(GL, 3); GAPB(o[1] = __builtin_amdgcn_mfma_f32_32x32x16_bf16(PAF(2), VFR(6), o[1], 0, 0, 0), C1, 4); \
    GAPB(o[0] = __builtin_amdgcn_mfma_f32_32x32x16_bf16(PAF(3), VFR(3), o[0], 0, 0, 0), C1, 8); \
    GAPB(o[1] = __builtin_amdgcn_mfma_f32_32x32x16_bf16(PAF(3), VFR(7), o[1], 0, 0, 0), C1, 12); \
    } while (0)
  int t = 1;
  for (; t + 5 < NT; t += 2) {
    STEP(pB0, pB1, pA0, pA1, t, true, true, true);     WAIT_BAR(2); RESC(); ROT();
    STEP(pA0, pA1, pB0, pB1, t + 1, true, true, true); WAIT_BAR(2); RESC(); ROT();
  }
  #define ENDW(tt) do { if ((tt) + 3 < NT) { WAIT_BAR(2); } else if ((tt) + 2 < NT) { WAIT_BAR(1); } else { WAIT_BAR(0); } } while (0)
  for (; t + 1 < NT; t += 2) {
    STEP(pB0, pB1, pA0, pA1, t, (t + 3 < NT), (t + 1 < NT), (t + 1 < NT));         ENDW(t);     RESC(); ROT();
    STEP(pA0, pA1, pB0, pB1, t + 1, (t + 4 < NT), (t + 2 < NT), (t + 2 < NT));     ENDW(t + 1); RESC(); ROT();
  }
  STEP(pB0, pB1, pA0, pA1, NT - 1, false, false, false); RESC();
  { float sacc = pB0[0] + pB0[1]; _Pragma("unroll") for (int r = 2; r < 16; ++r) sacc += pB0[r]; _Pragma("unroll") for (int r = 0; r < 16; ++r) sacc += pB1[r]; l_reg += sacc;
    pw0 = (u32x4){PKW(pB0, 0), PKW(pB0, 2), PKW(pB0, 4), PKW(pB0, 6)}; pw1 = (u32x4){PKW(pB0, 8), PKW(pB0, 10), PKW(pB0, 12), PKW(pB0, 14)}; pw2 = (u32x4){PKW(pB1, 0), PKW(pB1, 2), PKW(pB1, 4), PKW(pB1, 6)}; pw3 = (u32x4){PKW(pB1, 8), PKW(pB1, 10), PKW(pB1, 12), PKW(pB1, 14)};
    SBAR(); pv(o, vb0 + sl_cur, PAF(0), PAF(1), PAF(2), PAF(3)); }
  #undef PKW
  #undef PAF
  #undef VFR
  #undef PIN
  #undef MX3
  #undef GAPA
  #undef GAPB
  #undef EX
  #undef VRD
  #undef KRD
  #undef STEP
  #undef ENDW
  { auto rr = __builtin_amdgcn_permlane32_swap(__float_as_uint(l_reg), __float_as_uint(l_reg), false, false); l_reg = __uint_as_float(rr[0]) + __uint_as_float(rr[1]); }
  if (hi == 0) wsf[32 + r32] = l_reg; asm volatile("s_waitcnt lgkmcnt(0)" ::: "memory");
  float rli[16];
  #pragma unroll
  for (int r = 0; r < 16; ++r) rli[r] = __builtin_amdgcn_rcpf(wsf[32 + crow(r, hi)]);
  bf16_t* Ow = Orow0 + (long)(wid * QBLK) * OP;
  { bf16_t* stg = (bf16_t*)(shm + LDS_OST) + wid * 2048;
    #pragma unroll
    for (int r = 0; r < 16; ++r) { const int orow = crow(r, hi);
      #pragma unroll
      for (int d0 = 0; d0 < 2; ++d0) stg[orow * 64 + d0 * 32 + r32] = (bf16_t)f2bf(o[d0][r] * rli[r]); }
    asm volatile("s_waitcnt lgkmcnt(0)" ::: "memory");
    #pragma unroll
    for (int i = 0; i < 4; ++i) { const int row = i * 8 + (lane >> 3), ch = lane & 7; const u32x4 v = *(const u32x4*)(stg + row * 64 + ch * 8); *(u32x4*)(Ow + (long)row * OP + ch * 8) = v; } }
  asm volatile("s_waitcnt lgkmcnt(0)\n\ts_barrier" ::: "memory");
  #undef DMA_K
  #undef DMA_V
  #undef START
  #undef RESC
  #undef ROT
}
#undef SBAR
#undef WAIT_BAR
}
struct Frame {
    LAS unsigned char* lds;
    int tid, lane, wave;
    int vcu, G, gw, NGW, bid;
    unsigned char* ws; const float* const* in;
};

__device__ __forceinline__ void transpose_item(const float* W, int ldw, int K, bf16_t* WT, int k0, int n0, int dst_row0, LAS float* scr, int lane) {
    float tv[32];
#pragma unroll
    for (int i = 0; i < 32; ++i) tv[i] = W[(size_t)(k0 + 2 * i + (lane >> 5)) * ldw + n0 + (lane & 31)];
#pragma unroll
    for (int i = 0; i < 32; ++i) scr[(2 * i + (lane >> 5)) * 33 + (lane & 31)] = tv[i];
    LDS_WAIT(); asm volatile("" ::: "memory");
    const int c = lane & 7;
#pragma unroll
    for (int j = 0; j < 4; ++j) { const int n = (lane >> 3) + 8 * j; const LAS float* s = scr + (8 * c) * 33 + n;
        u32x4 o; o.x = pk2(s[0 * 33], s[1 * 33]); o.y = pk2(s[2 * 33], s[3 * 33]); o.z = pk2(s[4 * 33], s[5 * 33]); o.w = pk2(s[6 * 33], s[7 * 33]);
        *(u32x4*)(WT + (size_t)(dst_row0 + n) * K + k0 + 8 * c) = o; }
    LDS_WAIT(); asm volatile("" ::: "memory");
}

__device__ __forceinline__ void sincos_acc(float x, float& s, float& c) {
    const float k = rintf(x * 0.63661977236758134f);
    float r = fmaf(k, -1.5703125f, x); r = fmaf(k, -4.837512969970703125e-4f, r); r = fmaf(k, -7.54978995489188e-8f, r);
    const float z = r * r;
    const float sp = r + r * z * fmaf(z, fmaf(z, -1.9515295891e-4f, 8.3321608736e-3f), -1.6666654611e-1f);
    const float cp = fmaf(z * z, fmaf(z, fmaf(z, 2.443315711809948e-5f, -1.388731625493765e-3f), 4.166664568298827e-2f), fmaf(z, -0.5f, 1.0f));
    const int q = ((int)k) & 3;
    const float ss = (q & 1) ? cp : sp, cc = (q & 1) ? sp : cp;
    s = (q & 2) ? -ss : ss; c = ((q + 1) & 2) ? -cc : cc;
}

__device__ __forceinline__ void p0_prologue(Frame& F, const float* const* in, unsigned char* ws) {
    const float* c_lat = in[1]; const float* c_ctx = in[3]; const float* w_mod = in[4]; const float* b_mod = in[5];
    LAS float* sil = (LAS float*)F.lds;
    for (int i = F.tid; i < NMI * D; i += NTHREADS) { const int mi = i >> 10, k = i & 1023; const float v = (mi < NB) ? c_lat[mi * D + k] : c_ctx[k]; sil[i] = silu_f(v); }
    __syncthreads();
    {
        float* modv = (float*)(ws + WS_MODV);
        const int NT16 = 6 * D / 16;
        for (int task = F.gw; task < DEPTH * NT16; task += F.NGW) {
            const int layer = task / NT16, j0 = (task % NT16) * 16, jj = F.lane & 15, kq = F.lane >> 4;
            const float* wp = w_mod + (size_t)layer * D * 6 * D + j0 + jj;
            float acc[NMI];
#pragma unroll
            for (int m = 0; m < NMI; ++m) acc[m] = 0.f;
            for (int k = kq; k < D; k += 4) { const float w = wp[(size_t)k * 6 * D];
#pragma unroll
                for (int m = 0; m < NMI; ++m) acc[m] = fmaf(sil[m * D + k], w, acc[m]); }
#pragma unroll
            for (int m = 0; m < NMI; ++m) { float v = acc[m]; v += __shfl_xor(v, 16); v += __shfl_xor(v, 32); acc[m] = v; }
            if (kq == 0) { const float bb = b_mod[layer * 6 * D + j0 + jj];
#pragma unroll
                for (int m = 0; m < NMI; ++m) modv[((size_t)layer * NMI + m) * 6 * D + j0 + jj] = acc[m] + bb; }
        }
    }
    __syncthreads();
    {
        LAS float* scr = (LAS float*)(F.lds) + F.wave * (64 * 33);
        constexpr int I_MI = 16 * 96, I_MO = 16 * 32, I_AI = 16 * 48, I_AO = 16 * 32;
        constexpr int PER_J = I_MI + I_MO + I_AI + I_AO;
        for (int it = F.gw; it < 2 * PER_J; it += F.NGW) {
            const int j = it / PER_J; int r = it % PER_J;
            if (r < I_MI) { const int kb = r / 96, nb = r % 96; transpose_item(in[8] + (size_t)j * D * MW_IN, MW_IN, D, (bf16_t*)(ws + WS_WMI) + (size_t)j * 3072 * D, 64 * kb, 32 * nb, 32 * nb, scr, F.lane); continue; } r -= I_MI;
            if (r < I_MO) { const int kb = r / 32, nb = r % 32; transpose_item(in[11] + (size_t)j * D * D, D, D, (bf16_t*)(ws + WS_WMO) + (size_t)j * D * D, 64 * kb, 32 * nb, 32 * nb, scr, F.lane); continue; } r -= I_MO;
            if (r < I_AI) { const int kb = r / 48, nb = r % 48; transpose_item(in[12] + (size_t)j * D * 1536, 1536, D, (bf16_t*)(ws + WS_WAI) + (size_t)j * 1536 * D, 64 * kb, 32 * nb, 32 * nb, scr, F.lane); continue; } r -= I_AI;
            { const int kb = r / 32, nb = r % 32; transpose_item(in[15] + (size_t)j * D * D, D, D, (bf16_t*)(ws + WS_WAO) + (size_t)j * D * D, 64 * kb, 32 * nb, 32 * nb, scr, F.lane); }
        }
    }
    {
        float* rc = (float*)(ws + WS_ROPE); float* rs = rc + SEQ * 32;
        for (int i = F.bid * NTHREADS + F.tid; i < SEQ * 32; i += F.G * NTHREADS) {
            const int t = i >> 5, p = i & 31; const float pos = (p < 16) ? (float)(t >> 6) : (float)(t & 63);
            const float inv = exp2f(-(float)(p & 15) * (13.287712379549449f / 16.f));
            float s, c; sincos_acc(pos * inv, s, c); rc[i] = c; rs[i] = s; }
    }
    __syncthreads();
}

__device__ __forceinline__ void moe_weights(Frame& F, const float* wg, const float* wu, const float* wd, unsigned char* ws) {
    LAS float* T = (LAS float*)F.lds;
    const int lane = F.lane, w = F.wave;
    bf16_t* W1 = (bf16_t*)(ws + WS_W1); bf16_t* W2 = (bf16_t*)(ws + WS_W2);
    unsigned char* W1b = (unsigned char*)(ws + WS_W1); unsigned char* W2b = (unsigned char*)(ws + WS_W2);
    constexpr int NIT = NE * 3 * 16 * 4;
#define MW_SRC(it_) (((((it_) % 192) / 64) == 0 ? wg : ((((it_) % 192) / 64) == 1 ? wu : wd)) + (size_t)((it_) / 192) * D * D + (size_t)(64 * ((((it_) % 192) % 64) >> 2)) * D + 256 * ((((it_) % 192) % 64) & 3))
    f32x4 v[8];
    int it = F.vcu;
    if (it < NIT) { const float* src = MW_SRC(it);
#pragma unroll
        for (int i = 0; i < 8; ++i) v[i] = *(const f32x4*)(src + (size_t)(8 * w + i) * D + 4 * lane); }
    for (; it < NIT; it += F.G) {
        __syncthreads();
#pragma unroll
        for (int i = 0; i < 8; ++i) *(LAS f32x4*)(T + (8 * w + i) * 256 + ((4 * lane) ^ (8 * (w & 3)))) = v[i];
        if (it + F.G < NIT) { const float* src = MW_SRC(it + F.G);
#pragma unroll
            for (int i = 0; i < 8; ++i) v[i] = *(const f32x4*)(src + (size_t)(8 * w + i) * D + 4 * lane); }
        __syncthreads();
        const int e = it / 192, r = it % 192, which = r / 64, kb = (r % 64) >> 2, nq = (r % 64) & 3;
        const int nl = lane & 7, c = lane >> 3;
        bf16_t* base = (which == 2) ? (W2 + (size_t)e * D * D) : (W1 + (size_t)e * 2048 * D);
#pragma unroll
        for (int j = 0; j < 4; ++j) { const int n = 32 * w + 8 * j + nl; const LAS float* tp = T + (8 * c) * 256 + (n ^ (8 * (c & 3)));
            float t[8];
#pragma unroll
            for (int i = 0; i < 8; ++i) t[i] = tp[i * 256];
            const int ng = 256 * nq + n; const int drow = (which == 2) ? ng : (256 * (ng >> 7) + (which == 1 ? 128 : 0) + (ng & 127));
            const bool f8 = (which == 2) ? (MOE_FP8_2 != 0) : (MOE_FP8_1 != 0);
            if (f8) { u32x2 o; o.x = pk_fp8x4(t[0] * FP8_SW, t[1] * FP8_SW, t[2] * FP8_SW, t[3] * FP8_SW); o.y = pk_fp8x4(t[4] * FP8_SW, t[5] * FP8_SW, t[6] * FP8_SW, t[7] * FP8_SW);
                unsigned char* b8 = (which == 2) ? (W2b + (size_t)e * D * D) : (W1b + (size_t)e * 2048 * D);
                *(u32x2*)(b8 + (size_t)drow * D + 64 * kb + 8 * c) = o; }
            else { u32x4 o; o.x = pk2(t[0], t[1]); o.y = pk2(t[2], t[3]); o.z = pk2(t[4], t[5]); o.w = pk2(t[6], t[7]);
                *(u32x4*)(base + (size_t)drow * D + 64 * kb + 8 * c) = o; } }
    }
#undef MW_SRC
    __syncthreads();
}

__device__ __forceinline__ void load_w16(Frame& F, const float* W16, int ldw16) {
    LAS float* wl = (LAS float*)F.lds;
    for (int i = F.tid; i < D * 16; i += NTHREADS) { const int c = i >> 4, e = i & 15; const int l = (c & 255) >> 2, q = (c & 3) + 4 * (c >> 8);
        wl[(q * 64 + l) * 20 + e] = W16[(size_t)c * ldw16 + e]; }
    __syncthreads();
}
template <int MODE, bool F8 = false>
__device__ __forceinline__ void norm_core(LAS float* wl, const int lane, f32x4 (&v)[4], const int r, const f32x4 (&gv)[4], const float* shp, const float* scp, bf16_t* H, const float* bias16, float* out16) {
    float ss = 0.f;
#pragma unroll
    for (int j = 0; j < 4; ++j) ss += (v[j].x * v[j].x + v[j].y * v[j].y) + (v[j].z * v[j].z + v[j].w * v[j].w);
    const float rstd = rsqrtf(wave_sum(ss) * (1.f / D) + NORM_EPS);
    unsigned long long* o8 = (unsigned long long*)(H + (size_t)r * D) + lane;
#pragma unroll
    for (int j = 0; j < 4; ++j) { const f32x4 sh = *(const f32x4*)(shp + 4 * lane + 256 * j), sc = *(const f32x4*)(scp + 4 * lane + 256 * j);
        v[j] = (v[j] * rstd * gv[j]) * (sc + 1.f) + sh;
        if (F8) ((unsigned*)((unsigned char*)H + (size_t)r * D))[lane + 64 * j] = pk_fp8x4(v[j].x * FP8_SH, v[j].y * FP8_SH, v[j].z * FP8_SH, v[j].w * FP8_SH);
        else o8[64 * j] = (unsigned long long)pk2(v[j].x, v[j].y) | ((unsigned long long)pk2(v[j].z, v[j].w) << 32); }
    if (MODE != 0) {
        float p[16];
#pragma unroll
        for (int e = 0; e < 16; ++e) p[e] = 0.f;
#pragma unroll
        for (int j = 0; j < 4; ++j) {
            f32x4 wq[4][4];
#pragma unroll
            for (int i = 0; i < 4; ++i) { const LAS f32x4* wp = (const LAS f32x4*)(wl + ((4 * j + i) * 64 + lane) * 20);
#pragma unroll
                for (int e4 = 0; e4 < 4; ++e4) wq[i][e4] = wp[e4]; }
            asm volatile("s_waitcnt lgkmcnt(0)" ::: "memory"); __builtin_amdgcn_sched_barrier(0);
#pragma unroll
            for (int i = 0; i < 4; ++i) { const float xv = v[j][i];
#pragma unroll
                for (int e4 = 0; e4 < 4; ++e4) { const f32x4 w = wq[i][e4]; p[4 * e4 + 0] = fmaf(xv, w.x, p[4 * e4 + 0]); p[4 * e4 + 1] = fmaf(xv, w.y, p[4 * e4 + 1]); p[4 * e4 + 2] = fmaf(xv, w.z, p[4 * e4 + 2]); p[4 * e4 + 3] = fmaf(xv, w.w, p[4 * e4 + 3]); } }
            __builtin_amdgcn_sched_barrier(0);
        }
        float q8[8], q4[4], q2[2], q1;
        { const bool up = (lane & 32) != 0;
#pragma unroll
          for (int i = 0; i < 8; ++i) { const float send = up ? p[i] : p[i + 8]; const float recv = __shfl_xor(send, 32); q8[i] = (up ? p[i + 8] : p[i]) + recv; } }
        { const bool up = (lane & 16) != 0;
#pragma unroll
          for (int i = 0; i < 4; ++i) { const float send = up ? q8[i] : q8[i + 4]; const float recv = __shfl_xor(send, 16); q4[i] = (up ? q8[i + 4] : q8[i]) + recv; } }
        { const bool up = (lane & 8) != 0;
#pragma unroll
          for (int i = 0; i < 2; ++i) { const float send = up ? q4[i] : q4[i + 2]; const float recv = __shfl_xor(send, 8); q2[i] = (up ? q4[i + 2] : q4[i]) + recv; } }
        { const bool up = (lane & 4) != 0; const float send = up ? q2[0] : q2[1]; const float recv = __shfl_xor(send, 4); q1 = (up ? q2[1] : q2[0]) + recv; }
        q1 = quad_sum(q1);
        const int e = ((lane >> 5) & 1) * 8 + ((lane >> 4) & 1) * 4 + ((lane >> 3) & 1) * 2 + ((lane >> 2) & 1);
        if (MODE == 1) {
            float g = q1 + bias16[e];
            g = 15.f * tanhf(g * (1.f / 15.f));
            const int gate = e >> 2;
            if (gate & 1) g = fminf(g, 0.f) - log1pf(__expf(-fabsf(g)));
            if ((lane & 3) == 0) out16[(size_t)r * 16 + e] = g;
        } else {
            float mx = q1;
#pragma unroll
            for (int o = 4; o < 64; o <<= 1) mx = fmaxf(mx, __shfl_xor(mx, o));
            const float ex = __expf(q1 - mx); float sm = ex;
#pragma unroll
            for (int o = 4; o < 64; o <<= 1) sm += __shfl_xor(sm, o);
            if ((lane & 3) == 0) out16[(size_t)e * RT + r] = ex / sm;
        }
    }
}
__device__ __forceinline__ float swap32_add(float a, float b) { auto r = __builtin_amdgcn_permlane32_swap(__float_as_uint(a), __float_as_uint(b), false, false); return __uint_as_float(r[0]) + __uint_as_float(r[1]); }
__device__ __forceinline__ float swap16_add(float a, float b) { auto r = __builtin_amdgcn_permlane16_swap(__float_as_uint(a), __float_as_uint(b), false, false); return __uint_as_float(r[0]) + __uint_as_float(r[1]); }
template <int MODE, bool F8 = false>
__device__ __forceinline__ void norm_pass(Frame& F, const float* xL, const float* xC, int nrows, const float* gain, const float* shiftv, const float* scalev  ,
                                          bf16_t* H, const float* W16, int ldw16, const float* bias16, float* out16) {
    LAS float* wl = (LAS float*)F.lds;
    if (MODE != 0) load_w16(F, W16, ldw16);
    const int lane = F.lane;
    f32x4 gv[4];
#pragma unroll
    for (int j = 0; j < 4; ++j) gv[j] = *(const f32x4*)(gain + 4 * lane + 256 * j);
    const int per = (((nrows + F.NGW - 1) / F.NGW) + 1) & ~1; const int r0 = F.gw * per, r1 = (r0 + per < nrows) ? r0 + per : nrows;
#define NP_XPTR(rr) (((rr) >= RL) ? (xC + (size_t)((rr) - RL) * D) : (xL + (size_t)(rr) * D))
    f32x4 vn[2][4];
    if (r0 < r1) {
#pragma unroll
        for (int q = 0; q < 2; ++q) { const float* xr = NP_XPTR(r0 + q);
#pragma unroll
            for (int j = 0; j < 4; ++j) vn[q][j] = *(const f32x4*)(xr + 4 * lane + 256 * j); } }
    for (int r = r0; r < r1; r += 2) {
        asm volatile("" ::: "memory");
        f32x4 v[2][4];
#pragma unroll
        for (int q = 0; q < 2; ++q)
#pragma unroll
            for (int j = 0; j < 4; ++j) v[q][j] = vn[q][j];
        if (r + 2 < r1) {
#pragma unroll
            for (int q = 0; q < 2; ++q) { const float* xr = NP_XPTR(r + 2 + q);
#pragma unroll
                for (int j = 0; j < 4; ++j) vn[q][j] = *(const f32x4*)(xr + 4 * lane + 256 * j); } }
        float ss[2];
#pragma unroll
        for (int q = 0; q < 2; ++q) { ss[q] = 0.f;
#pragma unroll
            for (int j = 0; j < 4; ++j) ss[q] += (v[q][j].x * v[q][j].x + v[q][j].y * v[q][j].y) + (v[q][j].z * v[q][j].z + v[q][j].w * v[q][j].w); }
        ss[0] = row16_sum(ss[0]); ss[1] = row16_sum(ss[1]);
        const float tot0 = (rdlane(ss[0], 0) + rdlane(ss[0], 16)) + (rdlane(ss[0], 32) + rdlane(ss[0], 48)), tot1 = (rdlane(ss[1], 0) + rdlane(ss[1], 16)) + (rdlane(ss[1], 32) + rdlane(ss[1], 48));
        const float rstd[2] = {rsqrtf(tot0 * (1.f / D) + NORM_EPS), rsqrtf(tot1 * (1.f / D) + NORM_EPS)};
#pragma unroll
        for (int q = 0; q < 2; ++q) { const int rr = r + q; const int mi = (rr >= RL) ? NB : (rr >> 12);
            const float* shp = shiftv + (size_t)mi * 6 * D; const float* scp = scalev + (size_t)mi * 6 * D;
#pragma unroll
            for (int j = 0; j < 4; ++j) { const f32x4 sh = *(const f32x4*)(shp + 4 * lane + 256 * j), sc = *(const f32x4*)(scp + 4 * lane + 256 * j);
                v[q][j] = (v[q][j] * rstd[q] * gv[j]) * (sc + 1.f) + sh;
                if (F8) ((unsigned*)((unsigned char*)H + (size_t)rr * D))[lane + 64 * j] = pk_fp8x4(v[q][j].x * FP8_SH, v[q][j].y * FP8_SH, v[q][j].z * FP8_SH, v[q][j].w * FP8_SH);
                else ((unsigned long long*)(H + (size_t)rr * D))[lane + 64 * j] = (unsigned long long)pk2(v[q][j].x, v[q][j].y) | ((unsigned long long)pk2(v[q][j].z, v[q][j].w) << 32); } }
        if (MODE != 0) {
            float p[2][16];
#pragma unroll
            for (int q = 0; q < 2; ++q)
#pragma unroll
                for (int e = 0; e < 16; ++e) p[q][e] = 0.f;
#pragma unroll
            for (int j = 0; j < 4; ++j) {
                f32x4 wq[4][4];
#pragma unroll
                for (int i = 0; i < 4; ++i) { const LAS f32x4* wp = (const LAS f32x4*)(wl + ((4 * j + i) * 64 + lane) * 20);
#pragma unroll
                    for (int e4 = 0; e4 < 4; ++e4) wq[i][e4] = wp[e4]; }
                asm volatile("s_waitcnt lgkmcnt(0)" ::: "memory"); __builtin_amdgcn_sched_barrier(0);
#pragma unroll
                for (int i = 0; i < 4; ++i)
#pragma unroll
                    for (int q = 0; q < 2; ++q) { const float xv = v[q][j][i];
#pragma unroll
                        for (int e4 = 0; e4 < 4; ++e4) { const f32x4 w = wq[i][e4]; p[q][4 * e4 + 0] = fmaf(xv, w.x, p[q][4 * e4 + 0]); p[q][4 * e4 + 1] = fmaf(xv, w.y, p[q][4 * e4 + 1]);
                            p[q][4 * e4 + 2] = fmaf(xv, w.z, p[q][4 * e4 + 2]); p[q][4 * e4 + 3] = fmaf(xv, w.w, p[q][4 * e4 + 3]); } }
                __builtin_amdgcn_sched_barrier(0);
            }
            float q16[16], q8[8], q4[4], q2[2], q1;
#pragma unroll
            for (int e = 0; e < 16; ++e) q16[e] = swap32_add(p[0][e], p[1][e]);
#pragma unroll
            for (int i = 0; i < 8; ++i) q8[i] = swap16_add(q16[i], q16[i + 8]);
            { const bool up = (lane & 8) != 0;
#pragma unroll
              for (int i = 0; i < 4; ++i) { const float send = up ? q8[i] : q8[i + 4]; const float recv = __shfl_xor(send, 8); q4[i] = (up ? q8[i + 4] : q8[i]) + recv; } }
            { const bool up = (lane & 4) != 0;
#pragma unroll
              for (int i = 0; i < 2; ++i) { const float send = up ? q4[i] : q4[i + 2]; const float recv = __shfl_xor(send, 4); q2[i] = (up ? q4[i + 2] : q4[i]) + recv; } }
            { const bool up = (lane & 2) != 0; const float send = up ? q2[0] : q2[1]; const float recv = dpp_f<0x4E>(0.f, send); q1 = (up ? q2[1] : q2[0]) + recv; }
            q1 += dpp_f<0xB1>(0.f, q1);
            const int e = ((lane >> 4) & 1) * 8 + ((lane >> 3) & 1) * 4 + ((lane >> 2) & 1) * 2 + ((lane >> 1) & 1);
            const int rr = r + (lane >> 5);
            if (MODE == 1) {
                float g = q1 + bias16[e];
                g = 15.f * tanhf(g * (1.f / 15.f));
                const int gate = e >> 2;
                if (gate & 1) g = fminf(g, 0.f) - log1pf(__expf(-fabsf(g)));
                if ((lane & 1) == 0) out16[(size_t)rr * 16 + e] = g;
            } else {
                float mx = q1;
                mx = fmaxf(mx, dpp_f<0x4E>(mx, mx)); mx = fmaxf(mx, dpp_f<0x141>(mx, mx)); mx = fmaxf(mx, dpp_f<0x140>(mx, mx));
                { auto t = __builtin_amdgcn_permlane16_swap(__float_as_uint(mx), __float_as_uint(mx), false, false); mx = fmaxf(__uint_as_float(t[0]), __uint_as_float(t[1])); }
                const float ex = __expf(q1 - mx); float sm = ex;
                sm += dpp_f<0x4E>(0.f, sm); sm += dpp_f<0x141>(0.f, sm); sm += dpp_f<0x140>(0.f, sm);
                sm = swap16_add(sm, sm);
                if ((lane & 1) == 0) out16[(size_t)e * RT + rr] = ex / sm;
            }
        }
    }
#undef NP_XPTR
    if (MODE != 0) __syncthreads();
}

__device__ __forceinline__ void moe_select(Frame& F, const float* AFF, int* INV, int* SLROW, float* SLG, int nunits) {
    LAS unsigned* keys = (LAS unsigned*)F.lds;
    LAS unsigned* wsum = (LAS unsigned*)(F.lds + 16384);
    const int tid = F.tid, lane = F.lane, wave = F.wave;
    for (int u = F.vcu; u < nunits; u += F.G) {
        const int set = u >> 4, e = u & 15; const bool isc = set >= NB; const int b = isc ? set - NB : set;
        const int N = isc ? CTXL : SEQ, k = isc ? CAP_C : CAP_L, PER = isc ? 1 : 8;
        const int row0 = isc ? RL + b * CTXL : b * SEQ;
        const int nmine = (tid * PER < N) ? PER : 0;
        unsigned kv[8];
        if (tid < 32) wsum[tid] = 0u;
#pragma unroll
        for (int i = 0; i < 8; ++i) { kv[i] = 0u; if (i < nmine) kv[i] = __float_as_uint(AFF[(size_t)e * RT + row0 + tid * PER + i]); }
        __syncthreads();
        unsigned T = 0u; { unsigned kk = (unsigned)k;
        for (int pass = 0; pass < 8; ++pass) {
            const int shift = 28 - 4 * pass; LAS unsigned* hist = wsum + (pass & 1) * 16;
            if (tid < 16) wsum[((pass + 1) & 1) * 16 + tid] = 0u;
#pragma unroll
            for (int i = 0; i < 8; ++i) if (i < nmine && (pass == 0 || (kv[i] >> (shift + 4)) == (T >> (shift + 4)))) (void)__hip_atomic_fetch_add(&hist[(kv[i] >> shift) & 15u], 1u, __ATOMIC_RELAXED, __HIP_MEMORY_SCOPE_WORKGROUP);
            __syncthreads();
            unsigned cum = 0u, digit = 0u; bool found = false;
#pragma unroll
            for (int d = 15; d >= 0; --d) { const unsigned c = hist[d]; if (!found) { if (cum + c >= kk) { digit = (unsigned)d; found = true; } else cum += c; } }
            kk -= cum; T |= digit << shift;
            __syncthreads();
        } }
        unsigned ngt = 0u, neq = 0u;
#pragma unroll
        for (int i = 0; i < 8; ++i) { if (i < nmine) { ngt += kv[i] > T ? 1u : 0u; neq += kv[i] == T ? 1u : 0u; } }
        unsigned sgt = ngt, seq = neq;
#pragma unroll
        for (int o = 1; o < 64; o <<= 1) { const unsigned a = __shfl_up(sgt, o), c2 = __shfl_up(seq, o); if (lane >= o) { sgt += a; seq += c2; } }
        LAS unsigned* sc = wsum + 32;
        __syncthreads();
        if (lane == 63) { sc[wave] = sgt; sc[8 + wave] = seq; }
        __syncthreads();
        unsigned bgt = 0u, beq = 0u, tgt = 0u;
#pragma unroll
        for (int w = 0; w < 8; ++w) { const unsigned a = sc[w], c2 = sc[8 + w]; if (w < wave) { bgt += a; beq += c2; } tgt += a; }
        const unsigned need = (unsigned)k - tgt;
        unsigned pgt = bgt + sgt - ngt, peq = beq + seq - neq;
        const int sbase = isc ? NB * CAP_L + b * CAP_C : b * CAP_L;
#pragma unroll
        for (int i = 0; i < 8; ++i) { if (i < nmine) {
            const int row = row0 + tid * PER + i; int slot = -1;
            if (kv[i] > T) { slot = (int)(pgt + (peq < need ? peq : need)); ++pgt; }
            else if (kv[i] == T) { if (peq < need) slot = (int)(pgt + peq); ++peq; }
            if (slot >= 0) { SLROW[e * SLOTS_E + sbase + slot] = row; SLG[e * SLOTS_E + sbase + slot] = __uint_as_float(kv[i]); }
            INV[(size_t)e * RT + row] = slot >= 0 ? sbase + slot : -1; } }
        __syncthreads();
    }
    (void)keys;
}

__device__ __forceinline__ void moe_gather(Frame& F, const bf16_t* H, const int* SLROW, bf16_t* XG, bool with_ctx) {
    const int per_e = with_ctx ? SLOTS_E : NB * CAP_L; const int total = NE * per_e;
    const int per = (total + F.NGW - 1) / F.NGW; const int i0 = F.gw * per, i1 = (i0 + per < total) ? i0 + per : total;
    for (int i = i0; i < i1; i += 4) {
        u32x4 a[4], b2[4]; size_t dsto[4];
#pragma unroll
        for (int q = 0; q < 4; ++q) { const int ii = (i + q < i1) ? i + q : i1 - 1; const int e = ii / per_e, sl = ii - e * per_e; const int row = SLROW[e * SLOTS_E + sl];
            const u32x4* src = (const u32x4*)(H + (size_t)row * D) + F.lane; a[q] = src[0]; b2[q] = src[64]; dsto[q] = ((size_t)e * SLOTS_E + sl) * D; }
#pragma unroll
        for (int q = 0; q < 4; ++q) { u32x4* dst = (u32x4*)(XG + dsto[q]) + F.lane; dst[0] = a[q]; dst[64] = b2[q]; }
    }
}

template <int MODE>
__device__ __forceinline__ void combine_norm(Frame& F, const bf16_t* Y, const int* INV, float* xL, float* xC, const float* g2v  , int nrows,
                                             const float* gain, const float* shiftv, const float* scalev, bf16_t* H, const float* W16, int ldw16, const float* bias16, float* out16) {
    LAS float* wl = (LAS float*)F.lds;
    if (MODE == 1) load_w16(F, W16, ldw16);
    const int lane = F.lane;
    f32x4 gv[4];
#pragma unroll
    for (int j = 0; j < 4; ++j) gv[j] = *(const f32x4*)(gain + 4 * lane + 256 * j);
    const int per = (nrows + F.NGW - 1) / F.NGW; const int r0 = F.gw * per, r1 = (r0 + per < nrows) ? r0 + per : nrows;
#define CN_XPTR(rr) (((rr) >= RL) ? (xC + (size_t)((rr) - RL) * D) : (xL + (size_t)(rr) * D))
#define CN_INV(rr) (((rr) < r1 && lane < 16) ? INV[(size_t)lane * RT + (rr)] : -1)
#define CN_YLOAD(dst, e_, s_) do { const u32x2* yp_ = (const u32x2*)(Y + ((size_t)(e_) * SLOTS_E + (s_)) * D) + lane; _Pragma("unroll") for (int j = 0; j < 4; ++j) dst[j] = yp_[64 * j]; } while (0)
#define CN_YACC(src) do { _Pragma("unroll") for (int j = 0; j < 4; ++j) { a[j].x += bf_lo(src[j].x); a[j].y += bf_hi(src[j].x); a[j].z += bf_lo(src[j].y); a[j].w += bf_hi(src[j].y); } } while (0)
    f32x4 vn[4]; u32x2 pn0[4], pn1[4];
    int invA = CN_INV(r0), invB = CN_INV(r0 + 1);
#pragma unroll
    for (int j = 0; j < 4; ++j) { vn[j] = (f32x4){0.f, 0.f, 0.f, 0.f}; pn0[j] = (u32x2){0u, 0u}; pn1[j] = (u32x2){0u, 0u}; }
    if (r0 < r1) { const float* xr = CN_XPTR(r0);
#pragma unroll
        for (int j = 0; j < 4; ++j) vn[j] = *(const f32x4*)(xr + 4 * lane + 256 * j);
        unsigned long long m = __ballot(invA >= 0);
        if (m) { const int e0 = __builtin_ctzll(m); m &= m - 1; CN_YLOAD(pn0, e0, __builtin_amdgcn_readlane(invA, e0)); if (m) { const int e1 = __builtin_ctzll(m); CN_YLOAD(pn1, e1, __builtin_amdgcn_readlane(invA, e1)); } } }
    for (int r = r0; r < r1; ++r) {
        asm volatile("" ::: "memory");
        f32x4 v[4]; u32x2 pc0[4], pc1[4];
#pragma unroll
        for (int j = 0; j < 4; ++j) { v[j] = vn[j]; pc0[j] = pn0[j]; pc1[j] = pn1[j]; }
        const int invC = CN_INV(r + 2);
        if (r + 1 < r1) { const float* xr = CN_XPTR(r + 1);
#pragma unroll
            for (int j = 0; j < 4; ++j) vn[j] = *(const f32x4*)(xr + 4 * lane + 256 * j);
            unsigned long long m = __ballot(invB >= 0);
            if (m) { const int e0 = __builtin_ctzll(m); m &= m - 1; CN_YLOAD(pn0, e0, __builtin_amdgcn_readlane(invB, e0)); if (m) { const int e1 = __builtin_ctzll(m); CN_YLOAD(pn1, e1, __builtin_amdgcn_readlane(invB, e1)); } } }
        f32x4 a[4];
#pragma unroll
        for (int j = 0; j < 4; ++j) a[j] = (f32x4){0.f, 0.f, 0.f, 0.f};
        { unsigned long long m = __ballot(invA >= 0);
          if (m) { m &= m - 1; CN_YACC(pc0);
            if (m) { m &= m - 1; CN_YACC(pc1);
              while (m) { const int e2 = __builtin_ctzll(m); m &= m - 1; u32x2 t2[4]; CN_YLOAD(t2, e2, __builtin_amdgcn_readlane(invA, e2)); CN_YACC(t2); } } } }
        const int mi = (r >= RL) ? NB : (r >> 12);
        const float* gp = g2v + (size_t)mi * 6 * D;
#pragma unroll
        for (int j = 0; j < 4; ++j) { const f32x4 g = *(const f32x4*)(gp + 4 * lane + 256 * j); v[j] = v[j] + g * a[j]; }
        float* xw = CN_XPTR(r);
        if (MODE == 3) {
            float ss = 0.f;
#pragma unroll
            for (int j = 0; j < 4; ++j) ss += (v[j].x * v[j].x + v[j].y * v[j].y) + (v[j].z * v[j].z + v[j].w * v[j].w);
            const float rstd = rsqrtf(wave_sum(ss) * (1.f / D) + NORM_EPS);
#pragma unroll
            for (int j = 0; j < 4; ++j) *(f32x4*)(xw + 4 * lane + 256 * j) = v[j] * rstd * gv[j];
        } else {
#pragma unroll
            for (int j = 0; j < 4; ++j) *(f32x4*)(xw + 4 * lane + 256 * j) = v[j];
            norm_core<MODE>(wl, lane, v, r, gv, shiftv + (size_t)mi * 6 * D, scalev + (size_t)mi * 6 * D, H, bias16, out16);
        }
        invA = invB; invB = invC;
    }
#undef CN_XPTR
#undef CN_INV
#undef CN_YLOAD
#undef CN_YACC
    if (MODE == 1) __syncthreads();
}

__device__ __forceinline__ void final_norm(Frame& F, float* x, const float* gain) {
    const int lane = F.lane;
    for (int r = F.gw; r < RL; r += F.NGW) { float* xr = x + (size_t)r * D; f32x4 v[4]; float ss = 0.f;
#pragma unroll
        for (int j = 0; j < 4; ++j) { v[j] = *(const f32x4*)(xr + 4 * lane + 256 * j); ss += (v[j].x * v[j].x + v[j].y * v[j].y) + (v[j].z * v[j].z + v[j].w * v[j].w); }
        const float rstd = rsqrtf(wave_sum(ss) * (1.f / D) + NORM_EPS);
#pragma unroll
        for (int j = 0; j < 4; ++j) { const f32x4 g = *(const f32x4*)(gain + 4 * lane + 256 * j); *(f32x4*)(xr + 4 * lane + 256 * j) = v[j] * rstd * g; } }
}

__device__ __forceinline__ void unpack8(const u32x4 u, float (&x)[8]) { x[0] = bf_lo(u.x); x[1] = bf_hi(u.x); x[2] = bf_lo(u.y); x[3] = bf_hi(u.y); x[4] = bf_lo(u.z); x[5] = bf_hi(u.z); x[6] = bf_lo(u.w); x[7] = bf_hi(u.w); }
__device__ __forceinline__ u32x4 pack8(const float (&y)[8]) { u32x4 o; o.x = pk2(y[0], y[1]); o.y = pk2(y[2], y[3]); o.z = pk2(y[4], y[5]); o.w = pk2(y[6], y[7]); return o; }
__device__ __forceinline__ void qk_pass(Frame& F, bf16_t* QKV, const float* qn, const float* kn, const float* ropec, const float* ropes, bf16_t* KALL, bf16_t* VALL) {
    const int lane = F.lane, p = lane & 3;
    float gq1[8], gq2[8], gk1[8], gk2[8];
#pragma unroll
    for (int t = 0; t < 8; ++t) { gq1[t] = qn[8 * p + t]; gq2[t] = qn[32 + 8 * p + t]; gk1[t] = kn[8 * p + t]; gk2[t] = kn[32 + 8 * p + t]; }
    const int per = (((RT + F.NGW - 1) / F.NGW) + 3) & ~3; const int r0 = F.gw * per, r1 = (r0 + per < RT) ? r0 + per : RT;
    const int kh = (lane >> 2) & 3;
    for (int r = r0; r < r1; r += 4) {
        u32x4 qa[4], qb[4], ka[4], kb2[4], vv[4]; f32x4 c0[4], c1[4], s0[4], s1[4];
#pragma unroll
        for (int q = 0; q < 4; ++q) { const int rr = (r + q < r1) ? r + q : r1 - 1; const bool isc = rr >= RL; const int t = isc ? (rr - RL) & 255 : rr & 4095;
            const bf16_t* row = QKV + (size_t)rr * 1536;
            qa[q] = *(const u32x4*)(row + (lane >> 2) * 64 + 8 * p); qb[q] = *(const u32x4*)(row + (lane >> 2) * 64 + 8 * p + 32);
            ka[q] = *(const u32x4*)(row + 1024 + kh * 64 + 8 * p); kb2[q] = *(const u32x4*)(row + 1024 + kh * 64 + 8 * p + 32);
            vv[q] = *(const u32x4*)(row + 1280 + ((lane - 16) & 31) * 8);
            const int tt = isc ? 0 : t;
            c0[q] = *(const f32x4*)(ropec + tt * 32 + 8 * p); c1[q] = *(const f32x4*)(ropec + tt * 32 + 8 * p + 4); s0[q] = *(const f32x4*)(ropes + tt * 32 + 8 * p); s1[q] = *(const f32x4*)(ropes + tt * 32 + 8 * p + 4); }
#pragma unroll
        for (int q = 0; q < 4; ++q) { const int rr = r + q; if (rr < r1) {
            const bool isc = rr >= RL; const int b = isc ? (rr - RL) >> 8 : rr >> 12; const int t = isc ? (rr - RL) & 255 : rr & 4095; const int pos = isc ? t : CTXL + t;
            bf16_t* row = QKV + (size_t)rr * 1536;
            float cs[8], sn[8];
            cs[0] = c0[q].x; cs[1] = c0[q].y; cs[2] = c0[q].z; cs[3] = c0[q].w; cs[4] = c1[q].x; cs[5] = c1[q].y; cs[6] = c1[q].z; cs[7] = c1[q].w;
            sn[0] = s0[q].x; sn[1] = s0[q].y; sn[2] = s0[q].z; sn[3] = s0[q].w; sn[4] = s1[q].x; sn[5] = s1[q].y; sn[6] = s1[q].z; sn[7] = s1[q].w;
            if (isc) {
#pragma unroll
                for (int i = 0; i < 8; ++i) { cs[i] = 1.f; sn[i] = 0.f; } }
            {
                float x1[8], x2[8]; unpack8(qa[q], x1); unpack8(qb[q], x2);
                float ss = 0.f;
#pragma unroll
                for (int i = 0; i < 8; ++i) ss += x1[i] * x1[i] + x2[i] * x2[i];
                ss = quad_sum(ss);
                const float rstd = rsqrtf(ss * (1.f / 64.f) + NORM_EPS) * attn_body::C2;
                float y1[8], y2[8];
#pragma unroll
                for (int i = 0; i < 8; ++i) { const float a = x1[i] * rstd * gq1[i], c = x2[i] * rstd * gq2[i]; y1[i] = a * cs[i] - c * sn[i]; y2[i] = a * sn[i] + c * cs[i]; }
                bf16_t* hp = row + (lane >> 2) * 64 + 8 * p;
                *(u32x4*)hp = pack8(y1); *(u32x4*)(hp + 32) = pack8(y2);
            }
            {
                float x1[8], x2[8]; unpack8(ka[q], x1); unpack8(kb2[q], x2);
                float ss = 0.f;
#pragma unroll
                for (int i = 0; i < 8; ++i) ss += x1[i] * x1[i] + x2[i] * x2[i];
                ss = quad_sum(ss);
                const float rstd = rsqrtf(ss * (1.f / 64.f) + NORM_EPS);
                float y1[8], y2[8];
#pragma unroll
                for (int i = 0; i < 8; ++i) { const float a = x1[i] * rstd * gk1[i], c = x2[i] * rstd * gk2[i]; y1[i] = a * cs[i] - c * sn[i]; y2[i] = a * sn[i] + c * cs[i]; }
                if (lane < 16) { bf16_t* kp = KALL + ((size_t)b * KVLEN + pos) * 256 + kh * 64 + 8 * p; *(u32x4*)kp = pack8(y1); *(u32x4*)(kp + 32) = pack8(y2); }
                else if (lane < 48) *(u32x4*)(VALL + ((size_t)b * KVLEN + pos) * 256 + (lane - 16) * 8) = vv[q];
            } } }
    }
}

__device__ __forceinline__ void mlstm_readout(Frame& F, const bf16_t* HF, const bf16_t* HB, const bf16_t* QKVO, const float* wnorm, bf16_t* MIX) {
    const int lane = F.lane;
    f32x4 gv[4];
#pragma unroll
    for (int j = 0; j < 4; ++j) gv[j] = *(const f32x4*)(wnorm + 4 * lane + 256 * j);
    const int per = (((RT + F.NGW - 1) / F.NGW) + 3) & ~3; const int r0 = F.gw * per, r1 = (r0 + per < RT) ? r0 + per : RT;
    for (int r = r0; r < r1; r += 4) {
        u32x2 uf[4][4], ub[4][4], uo[4][4];
#pragma unroll
        for (int q = 0; q < 4; ++q) { const int rr = (r + q < r1) ? r + q : r1 - 1;
            const u32x2* pf = (const u32x2*)(HF + (size_t)rr * D) + lane; const u32x2* pb = (const u32x2*)(HB + (size_t)rr * D) + lane; const u32x2* po = (const u32x2*)(QKVO + (size_t)rr * 3072 + 2048) + lane;
#pragma unroll
            for (int j = 0; j < 4; ++j) { uf[q][j] = pf[64 * j]; ub[q][j] = pb[64 * j]; uo[q][j] = po[64 * j]; } }
#pragma unroll
        for (int q = 0; q < 4; ++q) { const int rr = r + q; if (rr < r1) {
            unsigned long long* o8 = (unsigned long long*)(MIX + (size_t)rr * D) + lane;
#pragma unroll
            for (int j = 0; j < 4; ++j) {
                f32x4 h; h.x = bf_lo(uf[q][j].x) + bf_lo(ub[q][j].x); h.y = bf_hi(uf[q][j].x) + bf_hi(ub[q][j].x); h.z = bf_lo(uf[q][j].y) + bf_lo(ub[q][j].y); h.w = bf_hi(uf[q][j].y) + bf_hi(ub[q][j].y);
                const float ss = wave_sum((h.x * h.x + h.y * h.y) + (h.z * h.z + h.w * h.w));
                const float rstd = rsqrtf(ss * (1.f / 256.f) + NORM_EPS);
                f32x4 og; og.x = bf_lo(uo[q][j].x); og.y = bf_hi(uo[q][j].x); og.z = bf_lo(uo[q][j].y); og.w = bf_hi(uo[q][j].y);
                f32x4 y;
                y.x = h.x * rstd * gv[j].x * fast_rcp(1.f + __expf(-og.x)); y.y = h.y * rstd * gv[j].y * fast_rcp(1.f + __expf(-og.y));
                y.z = h.z * rstd * gv[j].z * fast_rcp(1.f + __expf(-og.z)); y.w = h.w * rstd * gv[j].w * fast_rcp(1.f + __expf(-og.w));
                o8[64 * j] = (unsigned long long)pk2(y.x, y.y) | ((unsigned long long)pk2(y.z, y.w) << 32);
            } } }
    }
}
namespace mls {
constexpr int XS = 272, PS = 144, NCH = 68;
constexpr int O_XQ = 0, O_XK = 17408, O_XKP = 34816, O_XV = 52224, O_P = 69632, O_CT = 78848, O_OT = 113664, O_GB = 131072;
constexpr int O_RD = O_GB + 2 * 5 * 64 * 4, O_NV = O_RD + 256, O_DEC = O_NV + 1024, O_PRE = O_DEC + 64;
constexpr int LDS_BYTES = O_PRE + 3 * 72 * 4;

__device__ __forceinline__ int row_of(int b, int dir, int c, int p) {
    const int base = (c < 4) ? (RL + b * CTXL + (dir ? 192 - 64 * c : 64 * c)) : (b * SEQ + (dir ? 4032 - 64 * (c - 4) : 64 * (c - 4)));
    return base + (dir ? 63 - p : p);
}
__device__ __forceinline__ bf16x8 tr8(const LAS unsigned char* p0, const LAS unsigned char* p1) {
    typedef short v4i16_t __attribute__((ext_vector_type(4)));
    const s16x4 lo = __builtin_bit_cast(s16x4, __builtin_amdgcn_ds_read_tr16_b64_v4i16((LAS v4i16_t*)p0));
    const s16x4 hi = __builtin_bit_cast(s16x4, __builtin_amdgcn_ds_read_tr16_b64_v4i16((LAS v4i16_t*)p1));
    return (bf16x8){lo[0], lo[1], lo[2], lo[3], hi[0], hi[1], hi[2], hi[3]};
}

__device__ __forceinline__ void gate_arrays(LAS unsigned char* L, const float lf, const float ig, int c, int lane) {
    const int par = c & 1;
    const float bs = wave_scan_add(lf, lane);
    const float a = ig - bs; const float pm = wave_scan_max(a, lane);
    const float mst = ((const LAS float*)(L + O_PRE))[144 + c];
    const float M = fmaxf(mst, pm), M63 = rdlane(M, 63);
    LAS float* gb = (LAS float*)(L + O_GB) + par * 320;
    gb[lane] = a; gb[64 + lane] = M; gb[128 + lane] = __expf(mst - M); gb[192 + lane] = __expf(-bs - M); gb[256 + lane] = __expf(a - M63);
    if (lane == 0) ((LAS float*)(L + O_DEC))[par] = __expf(mst - M63);
}

__device__ __forceinline__ void mlstm_unit(Frame& F, int b, int hd, int dir, int half, const bf16_t* QKVO, const float* GATES, bf16_t* HOUT) {
    LAS unsigned char* L = F.lds;
    const int tid = F.tid, lane = F.lane, w = F.wave, fr = lane & 15, g = lane >> 4;
    const int gi = (dir * 2) * 4 + hd, gf = (dir * 2 + 1) * 4 + hd;
    LAS float* pre = (LAS float*)(L + O_PRE);
    __syncthreads();
    {
        float lfv[9], igv[9];
#pragma unroll
        for (int q = 0; q < 9; ++q) { const int c = w + 8 * q; lfv[q] = 0.f; igv[q] = 0.f;
            if (c < NCH) { const int row = row_of(b, dir, c, lane); lfv[q] = GATES[(size_t)row * 16 + gf]; igv[q] = GATES[(size_t)row * 16 + gi]; } }
#pragma unroll
        for (int q = 0; q < 9; ++q) { const int c = w + 8 * q;
            if (c < NCH) { const float bs = wave_scan_add(lfv[q], lane); float am = igv[q] - bs;
                am = fmaxf(am, dpp_f<0xB1>(am, am)); am = fmaxf(am, dpp_f<0x4E>(am, am)); am = fmaxf(am, dpp_f<0x141>(am, am)); am = fmaxf(am, dpp_f<0x140>(am, am));
                am = fmaxf(fmaxf(rdlane(am, 0), rdlane(am, 16)), fmaxf(rdlane(am, 32), rdlane(am, 48)));
                if (lane == 0) { pre[c] = rdlane(bs, 63); pre[72 + c] = am; } } }
    }
    for (int i = tid; i < (O_OT - O_CT) / 4; i += NTHREADS) ((LAS unsigned*)(L + O_CT))[i] = 0u;
    for (int i = tid; i < 256; i += NTHREADS) ((LAS float*)(L + O_NV))[i] = 0.f;
    __syncthreads();
    if (tid == 0) { float m = 0.f; for (int c = 0; c < NCH; ++c) { pre[144 + c] = m; m = pre[c] + fmaxf(m, pre[72 + c]); } }
    __syncthreads();
    if (w == 0) { const int row = row_of(b, dir, 0, lane); gate_arrays(L, GATES[(size_t)row * 16 + gf], GATES[(size_t)row * 16 + gi], 0, lane); }
    __syncthreads();
    const int qcol = hd * 128, kcol = 512 + hd * 128, vcol = 1024 + hd * 256 + half * 128;
    u32x4 rq[2], rk[2], rv[2];
#define MLS_BAR() do { asm volatile("s_waitcnt lgkmcnt(0)" ::: "memory"); __builtin_amdgcn_s_barrier(); asm volatile("" ::: "memory"); } while (0)
#define MLS_LOAD(c) do { _Pragma("unroll") for (int i_ = 0; i_ < 2; ++i_) { const int pi_ = tid + 512 * i_, p_ = pi_ >> 4, c16_ = pi_ & 15; \
        const bf16_t* rp_ = QKVO + (size_t)row_of(b, dir, (c), p_) * 3072 + c16_ * 8; \
        rq[i_] = *(const u32x4*)(rp_ + qcol); rk[i_] = *(const u32x4*)(rp_ + kcol); rv[i_] = *(const u32x4*)(rp_ + vcol); } } while (0)
#define MLS_STAGE(c) do { const LAS float* wk_ = (const LAS float*)(L + O_GB) + ((c) & 1) * 320 + 256; \
        _Pragma("unroll") for (int i_ = 0; i_ < 2; ++i_) { const int pi_ = tid + 512 * i_, p_ = pi_ >> 4, c16_ = pi_ & 15; const int o_ = p_ * XS + c16_ * 16; \
        *(LAS u32x4*)(L + O_XQ + o_) = rq[i_]; *(LAS u32x4*)(L + O_XK + o_) = rk[i_]; *(LAS u32x4*)(L + O_XV + o_) = rv[i_]; \
        const float s_ = wk_[p_]; u32x4 kk_; \
        kk_.x = pk2(bf_lo(rk[i_].x) * s_, bf_hi(rk[i_].x) * s_); kk_.y = pk2(bf_lo(rk[i_].y) * s_, bf_hi(rk[i_].y) * s_); \
        kk_.z = pk2(bf_lo(rk[i_].z) * s_, bf_hi(rk[i_].z) * s_); kk_.w = pk2(bf_lo(rk[i_].w) * s_, bf_hi(rk[i_].w) * s_); \
        *(LAS u32x4*)(L + O_XKP + o_) = kk_; } } while (0)
    MLS_LOAD(0); MLS_STAGE(0);
    __syncthreads();
    f32x4 C[8];
#pragma unroll
    for (int i = 0; i < 8; ++i) C[i] = (f32x4){0.f, 0.f, 0.f, 0.f};
    LAS unsigned char* CTw = L + O_CT + w * (16 * XS);
    float glf_n = 0.f, gig_n = 0.f;
    if (w == 7) { const int row = row_of(b, dir, 1, lane); glf_n = GATES[(size_t)row * 16 + gf]; gig_n = GATES[(size_t)row * 16 + gi]; }
    for (int c = 0; c < NCH; ++c) {
        const int par = c & 1; const bool more = (c + 1 < NCH);
        const LAS float* gb = (const LAS float*)(L + O_GB) + par * 320;
        const float glf = glf_n, gig = gig_n;
        if (w == 7 && c + 2 < NCH) { const int row = row_of(b, dir, c + 2, lane); glf_n = GATES[(size_t)row * 16 + gf]; gig_n = GATES[(size_t)row * 16 + gi]; }
        if (more) MLS_LOAD(c + 1);
#define LFENCE() do { asm volatile("s_waitcnt lgkmcnt(0)" ::: "memory"); __builtin_amdgcn_sched_barrier(0); } while (0)
#define QFRAG(mt_, ks_) (*(const LAS bf16x8*)(L + O_XQ + (16 * (mt_) + fr) * XS + (32 * (ks_) + 8 * g) * 2))
        f32x4 acc[4];
        {
            const int mt1 = w >> 1;
            bf16x8 ct[4], qa[2][4], qb[2][4];
#pragma unroll
            for (int ks = 0; ks < 4; ++ks) ct[ks] = *(const LAS bf16x8*)(CTw + fr * XS + (32 * ks + 8 * g) * 2);
#pragma unroll
            for (int m2 = 0; m2 < 2; ++m2)
#pragma unroll
                for (int ks = 0; ks < 4; ++ks) qa[m2][ks] = QFRAG(m2, ks);
            LFENCE();
#pragma unroll
            for (int m2 = 0; m2 < 2; ++m2)
#pragma unroll
                for (int ks = 0; ks < 4; ++ks) qb[m2][ks] = QFRAG(2 + m2, ks);
            __builtin_amdgcn_sched_barrier(0);
#pragma unroll
            for (int m2 = 0; m2 < 2; ++m2) { f32x4 a4 = (f32x4){0.f, 0.f, 0.f, 0.f};
#pragma unroll
                for (int ks = 0; ks < 4; ++ks) a4 = __builtin_amdgcn_mfma_f32_16x16x32_bf16(qa[m2][ks], ct[ks], a4, 0, 0, 0);
                acc[m2] = a4; }
            LFENCE();
            bf16x8 aq[4], bk[2][4];
#pragma unroll
            for (int ks = 0; ks < 4; ++ks) aq[ks] = QFRAG(mt1, ks);
#pragma unroll
            for (int n2 = 0; n2 < 2; ++n2)
#pragma unroll
                for (int ks = 0; ks < 4; ++ks) bk[n2][ks] = *(const LAS bf16x8*)(L + O_XK + (16 * (2 * (w & 1) + n2) + fr) * XS + (32 * ks + 8 * g) * 2);
            const f32x4 Mj = *(const LAS f32x4*)(gb + 64 + 16 * mt1 + 4 * g);
            float as[2]; as[0] = gb[16 * (2 * (w & 1)) + fr]; as[1] = gb[16 * (2 * (w & 1) + 1) + fr];
            f32x4 wi[4];
#pragma unroll
            for (int mt = 0; mt < 4; ++mt) wi[mt] = *(const LAS f32x4*)(gb + 128 + 16 * mt + 4 * g);
            __builtin_amdgcn_sched_barrier(0);
#pragma unroll
            for (int m2 = 0; m2 < 2; ++m2) { f32x4 a4 = (f32x4){0.f, 0.f, 0.f, 0.f};
#pragma unroll
                for (int ks = 0; ks < 4; ++ks) a4 = __builtin_amdgcn_mfma_f32_16x16x32_bf16(qb[m2][ks], ct[ks], a4, 0, 0, 0);
                acc[2 + m2] = a4; }
            LFENCE();
            f32x4 s4[2];
#pragma unroll
            for (int n2 = 0; n2 < 2; ++n2) { s4[n2] = (f32x4){0.f, 0.f, 0.f, 0.f};
#pragma unroll
                for (int ks = 0; ks < 4; ++ks) s4[n2] = __builtin_amdgcn_mfma_f32_16x16x32_bf16(aq[ks], bk[n2][ks], s4[n2], 0, 0, 0); }
#pragma unroll
            for (int mt = 0; mt < 4; ++mt) acc[mt] = acc[mt] * wi[mt];
#pragma unroll
            for (int n2 = 0; n2 < 2; ++n2) { const int sidx = 16 * (2 * (w & 1) + n2) + fr;
#pragma unroll
                for (int reg = 0; reg < 4; ++reg) { const int j = 16 * mt1 + 4 * g + reg;
                    const float pv = (sidx <= j) ? s4[n2][reg] * __expf(as[n2] - Mj[reg]) : 0.f;
                    *(LAS bf16_t*)(L + O_P + j * PS + sidx * 2) = (bf16_t)f2bf(pv); } }
        }
        MLS_BAR();
        bf16x8 vf[2];
        float rdv; float nsum;
        const float decay = ((const LAS float*)(L + O_DEC))[par];
        {
            const LAS unsigned char* vb = L + O_XV + (8 * g + (fr >> 2)) * XS + (16 * w + (lane & 3) * 4) * 2;
            const LAS unsigned char* kb = L + O_XKP + (8 * g + (fr >> 2)) * XS + ((lane & 3) * 4) * 2;
            bf16x8 ap[4][2];
#pragma unroll
            for (int k2 = 0; k2 < 2; ++k2) vf[k2] = tr8(vb + 32 * k2 * XS, vb + (32 * k2 + 4) * XS);
#pragma unroll
            for (int mt = 0; mt < 4; ++mt)
#pragma unroll
                for (int k2 = 0; k2 < 2; ++k2) ap[mt][k2] = *(const LAS bf16x8*)(L + O_P + (16 * mt + fr) * PS + (32 * k2 + 8 * g) * 2);
            LFENCE();
            const int j = tid >> 3, part = tid & 7;
            const u32x4 pu = *(const LAS u32x4*)(L + O_P + j * PS + part * 16);
            const u32x4 q0 = *(const LAS u32x4*)(L + O_XQ + j * XS + part * 32), q1 = *(const LAS u32x4*)(L + O_XQ + j * XS + part * 32 + 16);
            const LAS f32x4* np = (const LAS f32x4*)(L + O_NV + par * 512 + part * 64);
            const f32x4 n0 = np[0], n1 = np[1], n2 = np[2], n3 = np[3];
            const float wint_j = gb[128 + j], emq_j = gb[192 + j];
            bf16x8 ak[4][2];
#pragma unroll
            for (int mt = 0; mt < 4; ++mt)
#pragma unroll
                for (int k2 = 0; k2 < 2; ++k2) ak[mt][k2] = tr8(kb + 32 * k2 * XS + 32 * mt, kb + (32 * k2 + 4) * XS + 32 * mt);
            __builtin_amdgcn_sched_barrier(0);
#pragma unroll
            for (int mt = 0; mt < 4; ++mt)
#pragma unroll
                for (int k2 = 0; k2 < 2; ++k2) acc[mt] = __builtin_amdgcn_mfma_f32_16x16x32_bf16(ap[mt][k2], vf[k2], acc[mt], 0, 0, 0);
            LFENCE();
            bf16x8 ak2[4][2];
#pragma unroll
            for (int mt = 0; mt < 4; ++mt)
#pragma unroll
                for (int k2 = 0; k2 < 2; ++k2) ak2[mt][k2] = tr8(kb + 32 * k2 * XS + 32 * (4 + mt), kb + (32 * k2 + 4) * XS + 32 * (4 + mt));
            const int dk = tid >> 2, part4 = tid & 3; bf16_t kc[16];
#pragma unroll
            for (int t = 0; t < 16; ++t) kc[t] = *(const LAS bf16_t*)(L + O_XKP + (16 * part4 + t) * XS + dk * 2);
            const float nold = ((const LAS float*)(L + O_NV))[par * 128 + dk];
            __builtin_amdgcn_sched_barrier(0);
#pragma unroll
            for (int mt = 0; mt < 4; ++mt) { f32x4 c4 = C[mt] * decay;
#pragma unroll
                for (int k2 = 0; k2 < 2; ++k2) c4 = __builtin_amdgcn_mfma_f32_16x16x32_bf16(ak[mt][k2], vf[k2], c4, 0, 0, 0);
                C[mt] = c4; }
            float rs = (bf_lo(pu.x) + bf_hi(pu.x)) + (bf_lo(pu.y) + bf_hi(pu.y)) + (bf_lo(pu.z) + bf_hi(pu.z)) + (bf_lo(pu.w) + bf_hi(pu.w));
            float qn = bf_lo(q0.x) * n0.x + bf_hi(q0.x) * n0.y + bf_lo(q0.y) * n0.z + bf_hi(q0.y) * n0.w
                     + bf_lo(q0.z) * n1.x + bf_hi(q0.z) * n1.y + bf_lo(q0.w) * n1.z + bf_hi(q0.w) * n1.w
                     + bf_lo(q1.x) * n2.x + bf_hi(q1.x) * n2.y + bf_lo(q1.y) * n2.z + bf_hi(q1.y) * n2.w
                     + bf_lo(q1.z) * n3.x + bf_hi(q1.z) * n3.y + bf_lo(q1.w) * n3.z + bf_hi(q1.w) * n3.w;
            rs = oct_sum(rs); qn = oct_sum(qn);
            rdv = 1.f / fmaxf(fabsf(rs + wint_j * qn), emq_j);
            LFENCE();
#pragma unroll
            for (int mt = 0; mt < 4; ++mt) { f32x4 c4 = C[4 + mt] * decay;
#pragma unroll
                for (int k2 = 0; k2 < 2; ++k2) c4 = __builtin_amdgcn_mfma_f32_16x16x32_bf16(ak2[mt][k2], vf[k2], c4, 0, 0, 0);
                C[4 + mt] = c4; }
            float sm = 0.f;
#pragma unroll
            for (int t = 0; t < 16; ++t) sm += bf2f(kc[t]);
            sm = quad_sum(sm);
            nsum = decay * nold + sm;
        }
#undef LFENCE
#undef QFRAG
        asm volatile("" ::: "memory");
        if ((tid & 7) == 0) ((LAS float*)(L + O_RD))[tid >> 3] = rdv;
        if ((tid & 3) == 0) ((LAS float*)(L + O_NV))[(par ^ 1) * 128 + (tid >> 2)] = nsum;
#pragma unroll
        for (int mt = 0; mt < 8; ++mt) { u32x2 o; o.x = pk2(C[mt][0], C[mt][1]); o.y = pk2(C[mt][2], C[mt][3]);
            *(LAS u32x2*)(CTw + fr * XS + (16 * mt + 4 * g) * 2) = o; }
        if (more && w == 7) gate_arrays(L, glf, gig, c + 1, lane);
        MLS_BAR();
        {
#pragma unroll
            for (int mt = 0; mt < 4; ++mt) { const f32x4 rd = *(const LAS f32x4*)(L + O_RD + (16 * mt + 4 * g) * 4);
#pragma unroll
                for (int reg = 0; reg < 4; ++reg) *(LAS bf16_t*)(L + O_OT + (16 * mt + 4 * g + reg) * XS + (16 * w + fr) * 2) = (bf16_t)f2bf(acc[mt][reg] * rd[reg]); }
            if (more) MLS_STAGE(c + 1);
        }
        MLS_BAR();
        {
            const int j = tid >> 3, ch = tid & 7;
            const u32x4 o0 = *(const LAS u32x4*)(L + O_OT + j * XS + ch * 32), o1 = *(const LAS u32x4*)(L + O_OT + j * XS + ch * 32 + 16);
            bf16_t* op = HOUT + (size_t)row_of(b, dir, c, j) * D + hd * 256 + half * 128 + ch * 16;
            *(u32x4*)op = o0; *(u32x4*)(op + 8) = o1;
        }
    }
#undef MLS_BAR
#undef MLS_LOAD
#undef MLS_STAGE
}
}
constexpr int MISC_OFF = 135936, LDS_TOTAL = 136192;
static_assert(mls::LDS_BYTES <= MISC_OFF && pg8::STAGE_BYTES <= MISC_OFF && attn_body::LDS_BYTES <= MISC_OFF, "lds");
#ifndef EN_MASK
#define EN_MASK 0xFFFFFFFFu
#endif
#define PH_ON(k) (((EN_MASK) >> (k)) & 1u)
#ifndef REP_MASK
#define REP_MASK 0u
#endif
#define REP_ON(k) (((REP_MASK) >> (k)) & 1u)
#ifndef PH_LIMIT
#define PH_LIMIT 1000
#endif
#ifndef N_LAUNCH_SPLIT
#define N_LAUNCH_SPLIT 0
#endif
constexpr int N_PHASES = 1 + 10 + 9 + 9 + 9;

struct Args { const float* in[21]; float* out; unsigned char* ws; int ph_lo, ph_hi; };
static_assert(sizeof(Args) == 23 * 8 + 8, "no padding");

__device__ __forceinline__ Frame make_frame(unsigned char* lds_gen, unsigned char* ws_, const int wave_s) {
    Frame F; int ln; asm volatile("v_mbcnt_lo_u32_b32 %0, -1, 0\n\tv_mbcnt_hi_u32_b32 %0, -1, %0" : "=v"(ln));
    int wv = wave_s; asm volatile("" : "+s"(wv));
    int bx = blockIdx.x; asm volatile("" : "+s"(bx));
    F.lds = (LAS unsigned char*)lds_gen; F.tid = wv * 64 + ln; F.lane = ln; F.wave = wv;
    F.G = gridDim.x; F.bid = bx; F.vcu = (F.G % 8 == 0) ? (bx % 8) * (F.G / 8) + bx / 8 : bx;
    F.gw = F.vcu * NWAVES + F.wave; F.NGW = F.G * NWAVES;
    unsigned char* w = ws_; asm volatile("" : "+s"(w)); F.ws = w; F.in = (const float* const*)(w + WS_PTRS); return F;
}
__global__ void __launch_bounds__(NTHREADS, 2) fwd(Args a) {
    extern __shared__ __attribute__((aligned(16))) unsigned char lds_raw[];
    unsigned char* const lds_gen = lds_raw;
    const int wave_s = __builtin_amdgcn_readfirstlane((int)threadIdx.x >> 6);
    unsigned char* ws = a.ws;
    if (threadIdx.x < 4) ((LAS unsigned*)((LAS unsigned char*)lds_raw + MISC_OFF))[threadIdx.x] = 0u;
    __syncthreads();
    XcdBarrier bar = xcd_barrier_post((unsigned*)(ws + WS_CTL), (volatile LAS unsigned*)((LAS unsigned char*)lds_raw + MISC_OFF));
    int cur = 0; const int lo = a.ph_lo, hi = a.ph_hi & 0xffff; bool ran = false;
#define PHASE_BEGIN if (cur >= lo && cur < hi) { if (ran) xcd_barrier(bar, wave_s); ran = true;
#define PHASE_END   } ++cur;

    if (blockIdx.x == 0 && threadIdx.x < 22) ((const float**)(ws + WS_PTRS))[threadIdx.x] = (threadIdx.x < 21) ? a.in[threadIdx.x] : (const float*)a.out;
#define XL ((float*)F.in[21])
#define XC ((float*)(F.ws + WS_XC))
#define H ((bf16_t*)(F.ws + WS_H))
#define MIX ((bf16_t*)(F.ws + WS_MIX))
#define BIG0 ((bf16_t*)(F.ws + WS_BIG0))
#define BIG1 ((bf16_t*)(F.ws + WS_BIG1))
#define GATES ((float*)(F.ws + WS_GATES))
#define AFF ((float*)(F.ws + WS_AFF))
#define INV ((int*)(F.ws + WS_INV))
#define SLROW ((int*)(F.ws + WS_SLROW))
#define SLG ((float*)(F.ws + WS_SLG))
#define IN(k) (F.in[k])

    PHASE_BEGIN if (PH_ON(0)) for (int rep_ = 0; rep_ < (REP_ON(0) ? 2 : 1); ++rep_) { if (rep_) xcd_barrier(bar, wave_s); Frame F = make_frame(lds_gen, a.ws, wave_s); p0_prologue(F, a.in, F.ws); } PHASE_END

    for (int layer = 0; layer < DEPTH; ++layer) {
        const bool last = (layer == DEPTH - 1); const int j = layer >> 1;
#define modv ((const float*)(F.ws + WS_MODV) + (size_t)layer * NMI * 6 * D)
#define xLs ((layer == 0) ? IN(0) : (const float*)XL)
#define xCs ((layer == 0) ? IN(2) : (const float*)XC)
        if ((layer & 1) == 0) {
            if (layer == 0) { PHASE_BEGIN if (PH_ON(1)) for (int rep_ = 0; rep_ < (REP_ON(1) ? 2 : 1); ++rep_) { if (rep_) xcd_barrier(bar, wave_s); Frame F = make_frame(lds_gen, a.ws, wave_s); norm_pass<1>(F, xLs, xCs, RT, IN(6) + layer * D, modv + 0 * D, modv + 1 * D, H, IN(8) + (size_t)j * D * MW_IN + 3072, MW_IN, IN(9) + j * 16, GATES); } PHASE_END }
            PHASE_BEGIN if (PH_ON(2)) for (int rep_ = 0; rep_ < (REP_ON(2) ? 2 : 1); ++rep_) { if (rep_) xcd_barrier(bar, wave_s); Frame F = make_frame(lds_gen, a.ws, wave_s); { pg8::PlainSched S{(const char*)H, (const char*)((bf16_t*)(F.ws + WS_WMI) + (size_t)j * 3072 * D), RT / 256, 12, D, F.G, F.bid};
                pg8::EpiBf16 E{BIG0, 3072, 2, 0.08838834764831845f}; pg8::gemm_phase(F.lds, F.tid, D, S, E); } } PHASE_END
            PHASE_BEGIN if (PH_ON(3)) for (int rep_ = 0; rep_ < (REP_ON(3) ? 2 : 1); ++rep_) { if (rep_) xcd_barrier(bar, wave_s); Frame F = make_frame(lds_gen, a.ws, wave_s); for (int u = F.vcu; u < 256; u += F.G) { const int half = u & 1, dir = (u >> 1) & 1, hd = (u >> 2) & 3, b = u >> 4;
                mls::mlstm_unit(F, b, hd, dir, half, BIG0, GATES, dir ? MIX : H); } } PHASE_END
            PHASE_BEGIN if (PH_ON(4)) for (int rep_ = 0; rep_ < (REP_ON(4) ? 2 : 1); ++rep_) { if (rep_) xcd_barrier(bar, wave_s); Frame F = make_frame(lds_gen, a.ws, wave_s); mlstm_readout(F, H, MIX, BIG0, IN(10) + j * D, MIX); } PHASE_END
            PHASE_BEGIN if (PH_ON(5)) for (int rep_ = 0; rep_ < (REP_ON(5) ? 2 : 1); ++rep_) { if (rep_) xcd_barrier(bar, wave_s); Frame F = make_frame(lds_gen, a.ws, wave_s); { pg8::PlainSched S{(const char*)MIX, (const char*)((bf16_t*)(F.ws + WS_WMO) + (size_t)j * D * D), RT / 256, 4, D, F.G, F.bid};
                pg8::EpiResid E{xLs, xCs, XL, XC, modv + 2 * D}; pg8::gemm_phase(F.lds, F.tid, D, S, E); } } PHASE_END
        } else {
#define KALL BIG1
#define VALL (BIG1 + (size_t)NB * KVLEN * 256)
            PHASE_BEGIN if (PH_ON(7)) for (int rep_ = 0; rep_ < (REP_ON(7) ? 2 : 1); ++rep_) { if (rep_) xcd_barrier(bar, wave_s); Frame F = make_frame(lds_gen, a.ws, wave_s); { pg8::PlainSched S{(const char*)H, (const char*)((bf16_t*)(F.ws + WS_WAI) + (size_t)j * 1536 * D), RT / 256, 6, D, F.G, F.bid};
                pg8::EpiBf16 E{BIG0, 1536, 0, 1.f}; pg8::gemm_phase(F.lds, F.tid, D, S, E); } } PHASE_END
            PHASE_BEGIN if (PH_ON(8)) for (int rep_ = 0; rep_ < (REP_ON(8) ? 2 : 1); ++rep_) { if (rep_) xcd_barrier(bar, wave_s); Frame F = make_frame(lds_gen, a.ws, wave_s); qk_pass(F, BIG0, IN(13) + j * 64, IN(14) + j * 64, (const float*)(F.ws + WS_ROPE), (const float*)(F.ws + WS_ROPE) + SEQ * 32, KALL, VALL); } PHASE_END
            PHASE_BEGIN if (PH_ON(9)) for (int rep_ = 0; rep_ < (REP_ON(9) ? 2 : 1); ++rep_) { if (rep_) xcd_barrier(bar, wave_s); Frame F = make_frame(lds_gen, a.ws, wave_s); { const int nun = last ? 4096 : 4096 + 256;
                float mfix; { float gq = fabsf(IN(13)[j * 64 + F.lane]), gk = fabsf(IN(14)[j * 64 + F.lane]);
#pragma unroll
                    for (int o = 1; o < 64; o <<= 1) { gq = fmaxf(gq, __shfl_xor(gq, o)); gk = fmaxf(gk, __shfl_xor(gk, o)); }
                    mfix = attn_body::C2 * 64.f * gq * gk; }
                for (int L = F.vcu; L < nun; L += F.G) {
                    const bool isc = L >= 4096; const int Lc = L - 4096;
                    const int grp = L >> 6, wi = L & 63;
                    const int b = isc ? (Lc >> 4) : (grp >> 2), hq = isc ? (Lc & 15) : ((grp & 3) * 4 + (wi >> 4));
                    const size_t row0 = isc ? ((size_t)RL + b * CTXL) : ((size_t)b * SEQ + (wi & 15) * 256);
                    const bf16_t* qp = BIG0 + row0 * 1536 + hq * 64; const bf16_t* kp = KALL + (size_t)b * KVLEN * 256 + (hq >> 2) * 64; const bf16_t* vp = VALL + (size_t)b * KVLEN * 256 + (hq >> 2) * 64; bf16_t* op = MIX + row0 * D + hq * 64;
                    if (isc) attn_body::attn_unit<8>(qp, 1536, kp, vp, 256, CTXL / 64, op, D, (char*)lds_gen, F.tid, mfix);
                    else     attn_body::attn_unit<8>(qp, 1536, kp, vp, 256, KVLEN / 64, op, D, (char*)lds_gen, F.tid, mfix); } } } PHASE_END
            PHASE_BEGIN if (PH_ON(10)) for (int rep_ = 0; rep_ < (REP_ON(10) ? 2 : 1); ++rep_) { if (rep_) xcd_barrier(bar, wave_s); Frame F = make_frame(lds_gen, a.ws, wave_s); { pg8::PlainSched S{(const char*)MIX, (const char*)((bf16_t*)(F.ws + WS_WAO) + (size_t)j * D * D), (last ? RL : RT) / 256, 4, D, F.G, F.bid};
                pg8::EpiResid E{xLs, xCs, XL, XC, modv + 2 * D}; pg8::gemm_phase(F.lds, F.tid, D, S, E); } } PHASE_END
        }
        const int nrows = last ? RL : RT;
        PHASE_BEGIN if (PH_ON(11)) for (int rep_ = 0; rep_ < (REP_ON(11) ? 2 : 1); ++rep_) { if (rep_) xcd_barrier(bar, wave_s); Frame F = make_frame(lds_gen, a.ws, wave_s); moe_weights(F, IN(17) + (size_t)layer * NE * D * D, IN(18) + (size_t)layer * NE * D * D, IN(19) + (size_t)layer * NE * D * D, F.ws);
            norm_pass<2, MOE_FP8_1 != 0>(F, XL, XC, nrows, IN(7) + layer * D, modv + 3 * D, modv + 4 * D, H, IN(16) + (size_t)layer * D * 16, 16, nullptr, AFF); } PHASE_END
        PHASE_BEGIN if (PH_ON(12)) for (int rep_ = 0; rep_ < (REP_ON(12) ? 2 : 1); ++rep_) { if (rep_) xcd_barrier(bar, wave_s); Frame F = make_frame(lds_gen, a.ws, wave_s); moe_select(F, AFF, INV, SLROW, SLG, last ? NB * NE : 2 * NB * NE); } PHASE_END
        PHASE_BEGIN if (PH_ON(14)) for (int rep_ = 0; rep_ < (REP_ON(14) ? 2 : 1); ++rep_) { if (rep_) xcd_barrier(bar, wave_s); Frame F = make_frame(lds_gen, a.ws, wave_s); { constexpr int K1 = MOE_FP8_1 ? D / 2 : D;
            pg8::MoeSched S{(const char*)H, (const char*)(F.ws + WS_W1), last ? 32 : 34, 8, K1, 2048, F.G, F.bid};
            pg8::EpiSwiglu E{(void*)BIG1, MOE_FP8_1 ? 1.f / (FP8_SH * FP8_SW) : 1.f, MOE_FP8_2 != 0}; pg8::gemm_phase<pg8::EpiSwiglu, pg8::MoeSched, true, MOE_FP8_1 != 0>(F.lds, F.tid, K1, S, E, SLROW); } } PHASE_END
        PHASE_BEGIN if (PH_ON(15)) for (int rep_ = 0; rep_ < (REP_ON(15) ? 2 : 1); ++rep_) { if (rep_) xcd_barrier(bar, wave_s); Frame F = make_frame(lds_gen, a.ws, wave_s); { constexpr int K2 = MOE_FP8_2 ? D / 2 : D;
            pg8::MoeSched S{(const char*)BIG1, (const char*)(F.ws + WS_W2), last ? 32 : 34, 4, K2, 1024, F.G, F.bid};
            pg8::EpiRowScale E{BIG0, SLG, MOE_FP8_2 ? 1.f / (FP8_SA * FP8_SW) : 1.f}; pg8::gemm_phase<pg8::EpiRowScale, pg8::MoeSched, false, MOE_FP8_2 != 0>(F.lds, F.tid, K2, S, E); } } PHASE_END
        PHASE_BEGIN if (PH_ON(16)) for (int rep_ = 0; rep_ < (REP_ON(16) ? 2 : 1); ++rep_) { if (rep_) xcd_barrier(bar, wave_s); Frame F = make_frame(lds_gen, a.ws, wave_s);
            const int nl = layer + 1; const float* modn = (const float*)(F.ws + WS_MODV) + (size_t)nl * NMI * 6 * D;
            if (last) combine_norm<3>(F, BIG0, INV, XL, XC, modv + 5 * D, RL, IN(20), nullptr, nullptr, nullptr, nullptr, 0, nullptr, nullptr);
            else if (nl & 1) combine_norm<0>(F, BIG0, INV, XL, XC, modv + 5 * D, RT, IN(6) + nl * D, modn + 0 * D, modn + 1 * D, H, nullptr, 0, nullptr, nullptr);
            else combine_norm<1>(F, BIG0, INV, XL, XC, modv + 5 * D, RT, IN(6) + nl * D, modn + 0 * D, modn + 1 * D, H, IN(8) + (size_t)(nl >> 1) * D * MW_IN + 3072, MW_IN, IN(9) + (nl >> 1) * 16, GATES); } PHASE_END
    }
#undef XL
#undef XC
#undef H
#undef MIX
#undef BIG0
#undef BIG1
#undef GATES
#undef AFF
#undef INV
#undef SLROW
#undef SLG
#undef IN
#undef modv
#undef xLs
#undef xCs
#undef KALL
#undef VALL
#undef PHASE_BEGIN
#undef PHASE_END
}

extern "C" void kernel_launch(void* const* d_in, const int* in_sizes, int n_in, void* d_out, int out_size, void* d_ws, size_t ws_size, hipStream_t stream) {
    static int grid = 0;
    if (grid == 0) {
        if (n_in != 21 || out_size != RL * D || ws_size < WS_END) { fprintf(stderr, "kernel_launch: unexpected shapes: n_in %d out %d ws %zu (need %zu)\n", n_in, out_size, ws_size, (size_t)WS_END); grid = -1; return; }
        int dev = 0, cus = 0, per_cu = 0;
        if (hipGetDevice(&dev) != hipSuccess || hipDeviceGetAttribute(&cus, hipDeviceAttributeMultiprocessorCount, dev) != hipSuccess) { grid = -1; return; }
        if (hipFuncSetAttribute((const void*)fwd, hipFuncAttributeMaxDynamicSharedMemorySize, LDS_TOTAL) != hipSuccess) { fprintf(stderr, "kernel_launch: hipFuncSetAttribute failed\n"); grid = -1; return; }
        if (hipOccupancyMaxActiveBlocksPerMultiprocessor(&per_cu, (const void*)fwd, NTHREADS, LDS_TOTAL) != hipSuccess || per_cu < 1) fprintf(stderr, "kernel_launch: occupancy query says %d\n", per_cu);
        (void)hipGetLastError();
        grid = cus;
    }
    if (grid < 0) return;
    (void)in_sizes;
    if (hipMemsetAsync((char*)d_ws + WS_CTL, 0, CTL_BYTES, stream) != hipSuccess) return;
    Args a{};
    for (int i = 0; i < 21; ++i) a.in[i] = (const float*)d_in[i];
    a.out = (float*)d_out; a.ws = (unsigned char*)d_ws;
    const int nph = N_PHASES < PH_LIMIT ? N_PHASES : PH_LIMIT;
#if N_LAUNCH_SPLIT
    for (int p = 0; p < nph; ++p) { a.ph_lo = p; a.ph_hi = p + 1; hipLaunchKernelGGL(fwd, dim3(grid), dim3(NTHREADS), LDS_TOTAL, stream, a); }
#else
    a.ph_lo = 0; a.ph_hi = nph;
    hipLaunchKernelGGL(fwd, dim3(grid), dim3(NTHREADS), LDS_TOTAL, stream, a);
#endif
    const hipError_t le = hipPeekAtLastError();
    if (le != hipSuccess) fprintf(stderr, "kernel_launch: launch failed: %s\n", hipGetErrorName(le));
}
```

```cpp
#include <hip/hip_runtime.h>
#include <cstdio>
#include <cstdint>

#define GAS __attribute__((address_space(1)))
#define LAS __attribute__((address_space(3)))
typedef unsigned short bf16_t;
typedef short bf16x8 __attribute__((ext_vector_type(8)));
typedef short s16x4 __attribute__((ext_vector_type(4)));
typedef float f32x4 __attribute__((ext_vector_type(4)));
typedef float f32x2 __attribute__((ext_vector_type(2)));
typedef float f32x16 __attribute__((ext_vector_type(16)));
typedef unsigned u32x4 __attribute__((ext_vector_type(4)));
typedef unsigned u32x2 __attribute__((ext_vector_type(2)));

constexpr int D = 1024, NB = 16, SEQ = 4096, CTXL = 256, DEPTH = 4;
constexpr int RL = NB * SEQ, RC = NB * CTXL, RT = RL + RC;
constexpr int NE = 16, CAP_L = 512, CAP_C = 32, SLOTS_E = NB * CAP_L + NB * CAP_C;
constexpr int NMI = NB + 1;
constexpr int MW_IN = 3088;
constexpr int KVLEN = CTXL + SEQ;
constexpr int NWAVES = 8, NTHREADS = 512;
constexpr float NORM_EPS = 1e-6f;

constexpr size_t al256(size_t x) { return (x + 255) & ~(size_t)255; }
constexpr size_t WS_CTL   = 0;
constexpr size_t CTL_BYTES = 16384;
constexpr size_t WS_CNT   = WS_CTL + 14336;
constexpr size_t WS_PTRS  = WS_CTL + CTL_BYTES;
constexpr size_t WS_MODV  = WS_PTRS + 256;
constexpr size_t WS_ROPE  = al256(WS_MODV + (size_t)DEPTH * NMI * 6 * D * 4);
constexpr size_t WS_XC    = al256(WS_ROPE + (size_t)2 * SEQ * 32 * 4);
constexpr size_t WS_GATES = al256(WS_XC + (size_t)RC * D * 4);
constexpr size_t WS_AFF   = al256(WS_GATES + (size_t)RT * 16 * 4);
constexpr size_t WS_INV   = al256(WS_AFF + (size_t)RT * 16 * 4);
constexpr size_t WS_SLROW = al256(WS_INV + (size_t)RT * 16 * 4);
constexpr size_t WS_SLG   = al256(WS_SLROW + (size_t)NE * SLOTS_E * 4);
constexpr size_t WS_WMI   = al256(WS_SLG + (size_t)NE * SLOTS_E * 4);
constexpr size_t WS_WMO   = al256(WS_WMI + (size_t)2 * 3072 * D * 2);
constexpr size_t WS_WAI   = al256(WS_WMO + (size_t)2 * D * D * 2);
constexpr size_t WS_WAO   = al256(WS_WAI + (size_t)2 * 1536 * D * 2);
constexpr size_t WS_W1    = al256(WS_WAO + (size_t)2 * D * D * 2);
constexpr size_t WS_W2    = al256(WS_W1 + (size_t)NE * 2048 * D * 2);
constexpr size_t WS_H     = al256(WS_W2 + (size_t)NE * D * D * 2);
constexpr size_t WS_MIX   = al256(WS_H + (size_t)RT * D * 2);
constexpr size_t WS_BIG0  = al256(WS_MIX + (size_t)RT * D * 2);
constexpr size_t BIG_HALF = (size_t)NE * SLOTS_E * D * 2;
constexpr size_t WS_BIG1  = al256(WS_BIG0 + BIG_HALF);
constexpr size_t WS_END   = al256(WS_BIG1 + BIG_HALF);
static_assert((size_t)RT * 3072 * 2 <= 2 * BIG_HALF, "qkvo fits");

#define LDS_WAIT() asm volatile("s_waitcnt lgkmcnt(0)" ::: "memory")
#define VM_WAIT() asm volatile("s_waitcnt vmcnt(0)" ::: "memory")
typedef __bf16 bf16x2_t __attribute__((ext_vector_type(2)));
__device__ __forceinline__ unsigned pk2(float lo, float hi) { f32x2 v = {lo, hi}; bf16x2_t b = __builtin_convertvector(v, bf16x2_t); return __builtin_bit_cast(unsigned, b); }
__device__ __forceinline__ unsigned f2bf(float f) { return pk2(f, f) & 0xffffu; }
__device__ __forceinline__ float bf_lo(unsigned u) { return __builtin_bit_cast(float, u << 16); }
__device__ __forceinline__ float bf_hi(unsigned u) { return __builtin_bit_cast(float, u & 0xffff0000u); }
__device__ __forceinline__ float bf2f(bf16_t b) { return __builtin_bit_cast(float, ((unsigned)b) << 16); }
__device__ __forceinline__ unsigned pk_fp8x4(float a, float b, float c, float d) {
    a = __builtin_amdgcn_fmed3f(a, -448.f, 448.f); b = __builtin_amdgcn_fmed3f(b, -448.f, 448.f); c = __builtin_amdgcn_fmed3f(c, -448.f, 448.f); d = __builtin_amdgcn_fmed3f(d, -448.f, 448.f);
    int p = __builtin_amdgcn_cvt_pk_fp8_f32(a, b, 0, false); p = __builtin_amdgcn_cvt_pk_fp8_f32(c, d, p, true); return (unsigned)p; }
#ifndef MOE_FP8_1
#define MOE_FP8_1 1
#endif
#ifndef MOE_FP8_2
#define MOE_FP8_2 1
#endif
constexpr float FP8_SH = 16.f, FP8_SW = 512.f, FP8_SA = 8.f;
template <int CTRL> __device__ __forceinline__ float dpp_f(float old, float v) { return __builtin_bit_cast(float, __builtin_amdgcn_update_dpp(__builtin_bit_cast(int, old), __builtin_bit_cast(int, v), CTRL, 0xf, 0xf, false)); }
__device__ __forceinline__ float rdlane(float v, int l) { return __builtin_bit_cast(float, __builtin_amdgcn_readlane(__builtin_bit_cast(int, v), l)); }
__device__ __forceinline__ float row16_sum(float v) {
    v += dpp_f<0xB1>(0.f, v); v += dpp_f<0x4E>(0.f, v); v += dpp_f<0x141>(0.f, v); v += dpp_f<0x140>(0.f, v); return v; }
__device__ __forceinline__ float oct_sum(float v) {
    v += dpp_f<0xB1>(0.f, v); v += dpp_f<0x4E>(0.f, v); v += dpp_f<0x141>(0.f, v); return v; }
__device__ __forceinline__ float quad_sum(float v) { v += dpp_f<0xB1>(0.f, v); v += dpp_f<0x4E>(0.f, v); return v; }
__device__ __forceinline__ float wave_sum(float v) {
    v = row16_sum(v); return (rdlane(v, 0) + rdlane(v, 16)) + (rdlane(v, 32) + rdlane(v, 48)); }
__device__ __forceinline__ float wave_scan_add(float v, int lane) {
    v += dpp_f<0x111>(0.f, v); v += dpp_f<0x112>(0.f, v); v += dpp_f<0x114>(0.f, v); v += dpp_f<0x118>(0.f, v);
    const float t0 = rdlane(v, 15), t1 = rdlane(v, 31), t2 = rdlane(v, 47);
    const int row = lane >> 4; return v + (row == 0 ? 0.f : row == 1 ? t0 : row == 2 ? t0 + t1 : (t0 + t1) + t2); }
__device__ __forceinline__ float wave_scan_max(float v, int lane) {
    const float NI = -INFINITY;
    v = fmaxf(v, dpp_f<0x111>(NI, v)); v = fmaxf(v, dpp_f<0x112>(NI, v)); v = fmaxf(v, dpp_f<0x114>(NI, v)); v = fmaxf(v, dpp_f<0x118>(NI, v));
    const float t0 = rdlane(v, 15), t1 = rdlane(v, 31), t2 = rdlane(v, 47);
    const int row = lane >> 4; return fmaxf(v, row == 0 ? NI : row == 1 ? t0 : row == 2 ? fmaxf(t0, t1) : fmaxf(fmaxf(t0, t1), t2)); }
__device__ __forceinline__ float fast_exp(float x) { return __builtin_amdgcn_exp2f(x * 1.4426950408889634f); }
__device__ __forceinline__ float fast_rcp(float x) { return __builtin_amdgcn_rcpf(x); }
__device__ __forceinline__ float silu_f(float x) { return x / (1.f + __expf(-x)); }

#define XB_TMO      128
#define XB_XCNT(j)  (256  + 64 * (j))
#define XB_XSUB(j)  (1280 + 64 * (j))
#define XB_XGEN(j)  (2304 + 64 * (j))
#define XB_TOP      3328
#define XB_TOPGEN   3392
#define XCD_BAR_WORDS 3456
#define XB_SPIN_CAP (1u << 21)
static_assert(XCD_BAR_WORDS * 4 <= CTL_BYTES, "ctl");

__device__ __forceinline__ unsigned xb_ld(unsigned* p)              { return __hip_atomic_load(p, __ATOMIC_RELAXED, __HIP_MEMORY_SCOPE_AGENT); }
__device__ __forceinline__ unsigned xb_add(unsigned* p, unsigned v) { return __hip_atomic_fetch_add(p, v, __ATOMIC_RELAXED, __HIP_MEMORY_SCOPE_AGENT); }
__device__ __forceinline__ unsigned xb_xcc_id() { return (unsigned)__builtin_amdgcn_s_getreg((3 << 11) | 20) & 0xFu; }
#define XB_SPIN(cond, bar) do { unsigned _sp = 0; while (cond) { __builtin_amdgcn_s_sleep(1); \
    if ((++_sp & 255u) == 0u) { if (xb_ld(&(bar)[XB_TMO])) break; if (_sp > XB_SPIN_CAP) { atomicAdd(&(bar)[XB_TMO], 1u); break; } } } } while (0)

struct XcdBarrier { unsigned* bar; unsigned x; volatile LAS unsigned* st; };

__device__ __forceinline__ XcdBarrier xcd_barrier_post(unsigned* bar, volatile LAS unsigned* st) {
    XcdBarrier b; b.bar = bar; b.x = xb_xcc_id(); b.st = st;
    if (threadIdx.x == 0) (void)xb_add(&bar[XB_XCNT(b.x)], 1u);
    return b;
}
__device__ __forceinline__ void xcd_barrier_complete(unsigned* bar, unsigned x, unsigned& nloc, unsigned& nx) {
    const unsigned G = gridDim.x * gridDim.y * gridDim.z;
    unsigned sum, cnt, mine, sp = 0u;
    for (;;) {
        sum = 0u; cnt = 0u; mine = 0u;
#pragma unroll
        for (unsigned j = 0; j < 16; ++j) { const unsigned c = xb_ld(&bar[XB_XCNT(j)]); sum += c; cnt += (c > 0u) ? 1u : 0u; mine = (j == x) ? c : mine; }
        if (sum == G) break;
        __builtin_amdgcn_s_sleep(1);
        if ((++sp & 255u) == 0u) { if (xb_ld(&bar[XB_TMO])) break; if (sp > XB_SPIN_CAP) { atomicAdd(&bar[XB_TMO], 1u); break; } }
    }
    nloc = mine > 0u ? mine : 1u; nx = cnt > 0u ? cnt : 1u;
}
__device__ __forceinline__ void xcd_barrier(const XcdBarrier& b, const int wave_s) {
    asm volatile("s_waitcnt vmcnt(0)" ::: "memory");
    __syncthreads();
    int ln_; asm volatile("v_mbcnt_lo_u32_b32 %0, -1, 0\n\tv_mbcnt_hi_u32_b32 %0, -1, %0" : "=v"(ln_));
    if (wave_s == 0 && ln_ == 0) {
        unsigned* bar = b.bar;
        __builtin_amdgcn_s_waitcnt(0);
        unsigned nloc = b.st[0], nx = b.st[1];
        if (nloc == 0u) { xcd_barrier_complete(bar, b.x, nloc, nx); b.st[0] = nloc; b.st[1] = nx; }
        const unsigned old = xb_add(&bar[XB_XSUB(b.x)], 1u);
        const unsigned gen = old / nloc;
        if (old + 1u == (gen + 1u) * nloc) {
            __builtin_amdgcn_fence(__ATOMIC_RELEASE, "agent");
            asm volatile("s_waitcnt vmcnt(0)" ::: "memory");
            const unsigned og = xb_add(&bar[XB_TOP], 1u);
            const unsigned tg = og / nx;
            if (og + 1u == (tg + 1u) * nx) xb_add(&bar[XB_TOPGEN], 1u);
            else XB_SPIN(xb_ld(&bar[XB_TOPGEN]) == tg, bar);
            __builtin_amdgcn_fence(__ATOMIC_ACQUIRE, "agent");
            xb_add(&bar[XB_XGEN(b.x)], 1u);
            asm volatile("s_waitcnt vmcnt(0)" ::: "memory");
        } else {
            XB_SPIN(xb_ld(&bar[XB_XGEN(b.x)]) == gen, bar);
            __builtin_amdgcn_fence(__ATOMIC_ACQUIRE, "agent");
            asm volatile("s_waitcnt vmcnt(0)" ::: "memory");
        }
    }
    __syncthreads();
}
namespace pg8 {
constexpr int BM = 256, BK = 64, HALF = 128, HTB = HALF * BK * 2, STAGE_BYTES = 8 * HTB, NXCD = 8, WGM = 4;

__host__ __device__ __forceinline__ int lds_byte(int r, int c) { const int st = (r >> 4) * 2 + (c >> 5), rr = r & 15, cc = c & 31, ob = rr * 64 + cc * 2; return st * 1024 + (ob ^ (((ob >> 9) & 1) << 5)); }
__host__ __device__ __forceinline__ void stage_rc(int b, int& R, int& C) { const int st = b / 1024, sb = b % 1024, swz = sb ^ (((sb >> 9) & 1) << 5); R = (st >> 1) * 16 + swz / 64; C = (st & 1) * 32 + (swz % 64) / 2; }
__host__ __device__ __forceinline__ int perm32(int rho) { const int n = rho >> 4, i = rho & 15; return 8 * (i >> 2) + 4 * n + (i & 3); }

struct Unit { const char* A; const char* B; int pm, pn; };

__device__ __forceinline__ bool static_tile(int i, int G, int c, int nM, int nN, int& pm, int& pn) {
    const int nwg = nM * nN; const long L = (long)i * G + c; if (L >= nwg) return false;
    int wgid = (int)L; { const int q = nwg / NXCD, r = nwg % NXCD, xcd = wgid % NXCD, off = wgid / NXCD; wgid = (xcd < r ? xcd * (q + 1) : r * (q + 1) + (xcd - r) * q) + off; }
    const int nig = WGM * nN, gid = wgid / nig, fm = gid * WGM, gsz = (nM - fm) < WGM ? (nM - fm) : WGM;
    pm = fm + ((wgid % nig) % gsz); pn = (wgid % nig) / gsz; return true;
}
struct PlainSched {
    const char* A; const char* Bt; int nM, nN, K, G, c;
    __device__ __forceinline__ bool next(int i, Unit& u) const {
        int pm, pn; if (!static_tile(i, G, c, nM, nN, pm, pn)) return false;
        u.pm = pm; u.pn = pn; u.A = A + (size_t)pm * 256 * K * 2; u.B = Bt + (size_t)pn * 256 * K * 2; return true;
    }
};
struct MoeSched {
    const char* A; const char* W; int tpe, nN, K, bN, G, c;
    __device__ __forceinline__ bool next(int i, Unit& u) const {
        int pm, pn; if (!static_tile(i, G, c, NE * tpe, nN, pm, pn)) return false;
        const int e = pm / tpe, rt = pm - e * tpe;
        u.pm = e * (SLOTS_E / 256) + rt; u.pn = pn;
        u.A = A + (size_t)u.pm * 256 * K * 2; u.B = W + ((size_t)e * bN + (size_t)pn * 256) * K * 2; return true;
    }
};

__device__ __forceinline__ unsigned cvt_pk_bf16(float lo, float hi) { return pk2(lo, hi); }


struct EpiBf16 {
    static constexpr bool PERM = true; static constexpr int NSTORE = 16;
    bf16_t* O; int ldc; int nscale; float scale;
    __device__ __forceinline__ void operator()(const f32x4 (&acc)[2][2][4][2], const Unit& u, int wr, int wc, int fr, int fq) const {
        const int row0 = u.pm * BM + wr * 64 + fr, col0 = u.pn * BM + wc * 32 + 8 * fq;
        const float s = (u.pn < nscale) ? scale : 1.f;
#pragma unroll
        for (int ai = 0; ai < 2; ++ai)
#pragma unroll
            for (int m = 0; m < 4; ++m) { bf16_t* rowp = O + (size_t)(row0 + ai * HALF + m * 16) * ldc + col0;
#pragma unroll
                for (int bj = 0; bj < 2; ++bj) { const f32x4 v0 = acc[ai][bj][m][0] * s, v1 = acc[ai][bj][m][1] * s;
                    u32x4 o; o.x = cvt_pk_bf16(v0[0], v0[1]); o.y = cvt_pk_bf16(v0[2], v0[3]); o.z = cvt_pk_bf16(v1[0], v1[1]); o.w = cvt_pk_bf16(v1[2], v1[3]);
                    *(u32x4*)(rowp + bj * HALF) = o; } }
    }
};
struct EpiResid {
    static constexpr bool PERM = false; static constexpr int NSTORE = 32;
    const float* srcL; const float* srcC; float* dstL; float* dstC; const float* gate;
    __device__ __forceinline__ void operator()(const f32x4 (&acc)[2][2][4][2], const Unit& u, int wr, int wc, int fr, int fq) const {
        const bool isc = u.pm >= RL / 256;
        const int mi = isc ? NB : (u.pm >> 4);
        const int rbase = (isc ? (u.pm - RL / 256) : u.pm) * BM + wr * 64 + fr, col0 = u.pn * BM + wc * 32 + 4 * fq;
        const float* src = isc ? srcC : srcL; float* dst = isc ? dstC : dstL;
        const float* gp = gate + (size_t)mi * 6 * D + col0;
        f32x4 gv[2][2];
#pragma unroll
        for (int bj = 0; bj < 2; ++bj)
#pragma unroll
            for (int n = 0; n < 2; ++n) gv[bj][n] = *(const f32x4*)(gp + bj * HALF + n * 16);
#pragma unroll
        for (int ai = 0; ai < 2; ++ai)
#pragma unroll
            for (int m = 0; m < 4; ++m) { const size_t ro = (size_t)(rbase + ai * HALF + m * 16) * D + col0;
#pragma unroll
                for (int bj = 0; bj < 2; ++bj)
#pragma unroll
                    for (int n = 0; n < 2; ++n) { const f32x4 xv = *(const f32x4*)(src + ro + bj * HALF + n * 16);
                        *(f32x4*)(dst + ro + bj * HALF + n * 16) = xv + gv[bj][n] * acc[ai][bj][m][n]; } }
    }
};
struct EpiSwiglu {
    static constexpr bool PERM = true; static constexpr int NSTORE = 8;
    void* O; float ds; bool f8out;
    __device__ __forceinline__ void operator()(const f32x4 (&acc)[2][2][4][2], const Unit& u, int wr, int wc, int fr, int fq) const {
        const int row0 = u.pm * BM + wr * 64 + fr, col0 = u.pn * HALF + wc * 32 + 8 * fq;
#pragma unroll
        for (int ai = 0; ai < 2; ++ai)
#pragma unroll
            for (int m = 0; m < 4; ++m) { const size_t ro = (size_t)(row0 + ai * HALF + m * 16) * D + col0;
                float r[8];
#pragma unroll
                for (int n = 0; n < 2; ++n)
#pragma unroll
                    for (int j = 0; j < 4; ++j) { const float g = acc[ai][0][m][n][j] * ds, up = acc[ai][1][m][n][j] * ds; r[n * 4 + j] = g * fast_rcp(1.f + fast_exp(-g)) * up; }
                if (f8out) { u32x2 o; o.x = pk_fp8x4(r[0] * FP8_SA, r[1] * FP8_SA, r[2] * FP8_SA, r[3] * FP8_SA); o.y = pk_fp8x4(r[4] * FP8_SA, r[5] * FP8_SA, r[6] * FP8_SA, r[7] * FP8_SA);
                    *(u32x2*)((unsigned char*)O + ro) = o; }
                else { u32x4 o; o.x = cvt_pk_bf16(r[0], r[1]); o.y = cvt_pk_bf16(r[2], r[3]); o.z = cvt_pk_bf16(r[4], r[5]); o.w = cvt_pk_bf16(r[6], r[7]);
                    *(u32x4*)((bf16_t*)O + ro) = o; } }
    }
};
struct EpiRowScale {
    static constexpr bool PERM = true; static constexpr int NSTORE = 16;
    bf16_t* O; const float* g; float ds;
    __device__ __forceinline__ void operator()(const f32x4 (&acc)[2][2][4][2], const Unit& u, int wr, int wc, int fr, int fq) const {
        const int row0 = u.pm * BM + wr * 64 + fr, col0 = u.pn * BM + wc * 32 + 8 * fq;
#pragma unroll
        for (int ai = 0; ai < 2; ++ai)
#pragma unroll
            for (int m = 0; m < 4; ++m) { const int row = row0 + ai * HALF + m * 16; const float s = g[row] * ds; bf16_t* rowp = O + (size_t)row * D + col0;
#pragma unroll
                for (int bj = 0; bj < 2; ++bj) { const f32x4 v0 = acc[ai][bj][m][0] * s, v1 = acc[ai][bj][m][1] * s;
                    u32x4 o; o.x = cvt_pk_bf16(v0[0], v0[1]); o.y = cvt_pk_bf16(v0[2], v0[3]); o.z = cvt_pk_bf16(v1[0], v1[1]); o.w = cvt_pk_bf16(v1[2], v1[3]);
                    *(u32x4*)(rowp + bj * HALF) = o; } }
    }
};

template <class Epi, class Sched, bool GATHER = false, bool FP8 = false>
__device__ __forceinline__ void gemm_phase(LAS unsigned char* lds, const int tid, const int K, const Sched& S, const Epi& E, const int* rowidx = nullptr) {
    const int wid = __builtin_amdgcn_readfirstlane(tid >> 6), lane = tid & 63, wr = wid >> 2, wc = wid & 3, fr = lane & 15, fq = lane >> 4;
    const int nt = K / BK;
    unsigned voffA[2], voffB[2]; int gR[2], gC[2];
#pragma unroll
    for (int i = 0; i < 2; ++i) { int R, C; stage_rc(tid * 16 + i * 8192, R, C); const int Rb = Epi::PERM ? ((R & ~31) + perm32(R & 31)) : R;
        voffA[i] = (unsigned)(R * K + C) * 2u; voffB[i] = (unsigned)(Rb * K + C) * 2u; gR[i] = R; gC[i] = C * 2; }
    unsigned gcur[2][2], gnxt[2][2];
#define PG8_GIDX(dst, unit) do { if (GATHER) { _Pragma("unroll") for (int h_ = 0; h_ < 2; ++h_) _Pragma("unroll") for (int i_ = 0; i_ < 2; ++i_) \
        dst[h_][i_] = (unsigned)rowidx[(unit).pm * 256 + h_ * 128 + gR[i_]] * (unsigned)(K * 2) + (unsigned)gC[i_]; } } while (0)
    const size_t kstep = (size_t)(BK * 2);
    const size_t hstep = (size_t)HALF * K * 2;
    const unsigned ldsw = (unsigned)wid * 1024u;
    const int aoff = lds_byte(wr * 64 + fr, fq * 8), boff = lds_byte(wc * 32 + fr, fq * 8);
#define PG8_SA(b, h) (((b) * 2 + (h)) * HTB)
#define PG8_SB(b, h) ((4 + (b) * 2 + (h)) * HTB)
#define PG8_STAGE(bufoff, gbase, voff) do { _Pragma("unroll") for (int _i = 0; _i < 2; ++_i) \
        __builtin_amdgcn_global_load_lds((const unsigned*)((const char*)(gbase) + (voff)[_i]), (LAS unsigned*)(lds + (bufoff) + ldsw + _i * 8192), 16, 0, 0); } while (0)
#define PG8_STAGE_A(b, h, gbase, NX) do { if (GATHER) { unsigned go_[2]; go_[0] = (NX) ? gnxt[h][0] : gcur[h][0]; go_[1] = (NX) ? gnxt[h][1] : gcur[h][1]; PG8_STAGE(PG8_SA(b, h), (gbase), go_); } \
        else { PG8_STAGE(PG8_SA(b, h), (gbase) + (h) * hstep, voffA); } } while (0)
#define PG8_LDA(dst, b, h) do { _Pragma("unroll") for (int m = 0; m < 4; ++m) _Pragma("unroll") for (int k = 0; k < 2; ++k) dst[m][k] = *(const LAS bf16x8*)(lds + PG8_SA(b, h) + aoff + m * 2048 + k * 1024); } while (0)
#define PG8_LDB(dst, b, h) do { _Pragma("unroll") for (int n = 0; n < 2; ++n) _Pragma("unroll") for (int k = 0; k < 2; ++k) dst[n][k] = *(const LAS bf16x8*)(lds + PG8_SB(b, h) + boff + n * 2048 + k * 1024); } while (0)
#define PG8_MMA(ai, bj, At, Bt) do { __builtin_amdgcn_s_setprio(1); if (FP8) { _Pragma("unroll") for (int m = 0; m < 4; ++m) _Pragma("unroll") for (int n = 0; n < 2; ++n) { \
            typedef int v8i_ __attribute__((ext_vector_type(8))); typedef int v4i_ __attribute__((ext_vector_type(4))); \
            const v4i_ b0_ = __builtin_bit_cast(v4i_, Bt[n][0]), b1_ = __builtin_bit_cast(v4i_, Bt[n][1]), a0_ = __builtin_bit_cast(v4i_, At[m][0]), a1_ = __builtin_bit_cast(v4i_, At[m][1]); \
            const v8i_ bb_ = {b0_[0], b0_[1], b0_[2], b0_[3], b1_[0], b1_[1], b1_[2], b1_[3]}, aa_ = {a0_[0], a0_[1], a0_[2], a0_[3], a1_[0], a1_[1], a1_[2], a1_[3]}; \
            asm volatile("v_mfma_scale_f32_16x16x128_f8f6f4 %0, %1, %2, %0, %3, %3 op_sel_hi:[0,0,0]" : "+v"(acc[ai][bj][m][n]) : "v"(bb_), "v"(aa_), "v"(sc127)); } } \
        else { _Pragma("unroll") for (int m = 0; m < 4; ++m) _Pragma("unroll") for (int n = 0; n < 2; ++n) _Pragma("unroll") for (int k = 0; k < 2; ++k) \
        acc[ai][bj][m][n] = __builtin_amdgcn_mfma_f32_16x16x32_bf16(Bt[n][k], At[m][k], acc[ai][bj][m][n], 0, 0, 0); } __builtin_amdgcn_s_setprio(0); } while (0)
#define PG8_WAIT_V(n) asm volatile("s_waitcnt vmcnt(" #n ")" ::: "memory")
#define PG8_WAIT_VE() do { if (Epi::NSTORE == 32) asm volatile("s_waitcnt vmcnt(40)" ::: "memory"); else if (Epi::NSTORE == 16) asm volatile("s_waitcnt vmcnt(24)" ::: "memory"); else asm volatile("s_waitcnt vmcnt(16)" ::: "memory"); } while (0)
#define PG8_WAIT_L(n) asm volatile("s_waitcnt lgkmcnt(" #n ")" ::: "memory")
#define PG8_BAR __builtin_amdgcn_s_barrier()
#define PG8_SCHED __builtin_amdgcn_sched_barrier(0)
    Unit cur, nxt; int ui = 0;
    if (!S.next(0, cur)) return;
    int sc127 = 0x7F7F7F7F; asm volatile("" : "+v"(sc127));
    f32x4 acc[2][2][4][2];
#pragma unroll
    for (int a = 0; a < 2; ++a)
#pragma unroll
        for (int b = 0; b < 2; ++b)
#pragma unroll
            for (int m = 0; m < 4; ++m)
#pragma unroll
                for (int n = 0; n < 2; ++n) acc[a][b][m][n] = (f32x4){0.f, 0.f, 0.f, 0.f};
    bf16x8 At[4][2], B0[2][2], B1[2][2];
    const char* cA = GATHER ? S.A : cur.A; const char* cB = cur.B;
    PG8_GIDX(gcur, cur);
    PG8_STAGE(PG8_SB(0, 0), cB, voffB); PG8_STAGE(PG8_SB(0, 1), cB + hstep, voffB); PG8_STAGE_A(0, 0, cA, false); PG8_STAGE_A(0, 1, cA, false);
    if (wr == 1) PG8_BAR;
    PG8_WAIT_V(2); PG8_BAR;
    PG8_STAGE(PG8_SB(1, 0), cB + kstep, voffB); PG8_STAGE_A(1, 0, cA + kstep, false); PG8_STAGE(PG8_SB(1, 1), cB + hstep + kstep, voffB);
    PG8_WAIT_V(6); PG8_BAR;
    for (;;) {
        const bool has_next = S.next(ui + 1, nxt);
        const char* nA = (has_next && !GATHER) ? nxt.A : cA; const char* nB = has_next ? nxt.B : cB;
        if (GATHER) { if (has_next) { PG8_GIDX(gnxt, nxt); } else { _Pragma("unroll") for (int h_ = 0; h_ < 2; ++h_) { gnxt[h_][0] = gcur[h_][0]; gnxt[h_][1] = gcur[h_][1]; } } }
#pragma unroll 1
        for (int t = 0; t < nt; t += 2) {
            const bool last = (t == nt - 2);
            const char* a1 = cA + (size_t)(t + 1) * kstep;
            const char* a2 = last ? nA : cA + (size_t)(t + 2) * kstep; const char* b2 = last ? nB : cB + (size_t)(t + 2) * kstep;
            const char* a3 = a2 + kstep; const char* b3 = b2 + kstep;
            PG8_LDB(B0, 0, 0); PG8_LDB(B1, 0, 1); PG8_SCHED; PG8_LDA(At, 0, 0); PG8_STAGE_A(1, 1, a1, false);
            PG8_WAIT_V(8); PG8_WAIT_L(0); PG8_BAR; PG8_MMA(0, 0, At, B0); PG8_MMA(0, 1, At, B1); PG8_BAR; PG8_SCHED;
            PG8_LDA(At, 0, 1); PG8_STAGE(PG8_SB(0, 0), b2, voffB); PG8_STAGE(PG8_SB(0, 1), b2 + hstep, voffB); PG8_STAGE_A(0, 0, a2, last);
            PG8_WAIT_V(8); PG8_WAIT_L(0); PG8_BAR; PG8_MMA(1, 0, At, B0); PG8_MMA(1, 1, At, B1); PG8_BAR; PG8_SCHED;
            PG8_LDB(B0, 1, 0); PG8_LDB(B1, 1, 1); PG8_SCHED; PG8_LDA(At, 1, 0); PG8_STAGE_A(0, 1, a2, last);
            PG8_WAIT_V(8); PG8_WAIT_L(0); PG8_BAR; PG8_MMA(0, 0, At, B0); PG8_MMA(0, 1, At, B1); PG8_BAR; PG8_SCHED;
            PG8_LDA(At, 1, 1); PG8_STAGE(PG8_SB(1, 0), b3, voffB); PG8_STAGE(PG8_SB(1, 1), b3 + hstep, voffB); PG8_STAGE_A(1, 0, a3, last);
            PG8_WAIT_V(8); PG8_WAIT_L(0); PG8_BAR; PG8_MMA(1, 0, At, B0); PG8_MMA(1, 1, At, B1); PG8_BAR; PG8_SCHED;
        }
        if (wr == 0) PG8_BAR;
        if (FP8) asm volatile("s_nop 15\n\ts_nop 15" ::: "memory");
        { int tz = tid; asm volatile("" : "+v"(tz));
          const int wid2 = __builtin_amdgcn_readfirstlane(tz >> 6), lane2 = tz & 63;
          E(acc, cur, wid2 >> 2, wid2 & 3, lane2 & 15, lane2 >> 4); }
        if (!has_next) break;
#pragma unroll
        for (int a = 0; a < 2; ++a)
#pragma unroll
            for (int b = 0; b < 2; ++b)
#pragma unroll
                for (int m = 0; m < 4; ++m)
#pragma unroll
                    for (int n = 0; n < 2; ++n) acc[a][b][m][n] = (f32x4){0.f, 0.f, 0.f, 0.f};
        cur = nxt; cA = nA; cB = nB; ++ui;
        if (GATHER) { _Pragma("unroll") for (int h_ = 0; h_ < 2; ++h_) { gcur[h_][0] = gnxt[h_][0]; gcur[h_][1] = gnxt[h_][1]; } }
        if (wr == 1) PG8_BAR;
    }
    PG8_WAIT_V(0);
    PG8_BAR;
#undef PG8_SA
#undef PG8_SB
#undef PG8_STAGE
#undef PG8_STAGE_A
#undef PG8_GIDX
#undef PG8_LDA
#undef PG8_LDB
#undef PG8_MMA
#undef PG8_WAIT_V
#undef PG8_WAIT_VE
#undef PG8_WAIT_L
#undef PG8_BAR
#undef PG8_SCHED
}
}
namespace attn_body {
constexpr int NW = 8, QBLK = 32, QB = QBLK * NW, KVBLK = 64;
__device__ __forceinline__ int crow(int r, int hi) { return (r & 3) + 8 * (r >> 2) + 4 * hi; }
#define SBAR() __builtin_amdgcn_sched_barrier(0)
constexpr int NSLOT = 3, SLOTB = 8192;
constexpr int LDS_K = 0, LDS_V = NSLOT * SLOTB, LDS_WS = 2 * NSLOT * SLOTB, LDS_OST = LDS_WS + NW * 64 * 4, LDS_BYTES = LDS_OST + NW * 4096;
constexpr float C2 = 0.125f * 1.4426950408889634f;
__device__ __forceinline__ void glds16(const void* gsrc, unsigned lds_dst) { unsigned keep;
  asm volatile("s_mov_b32 %0, m0\n\ts_mov_b32 m0, %2\n\ts_nop 0\n\tglobal_load_lds_dwordx4 %1, off\n\ts_mov_b32 m0, %0" : "=&s"(keep) : "v"(gsrc), "s"(lds_dst) : "memory"); }
__device__ __forceinline__ float max3f(float a, float b, float c) { float r; asm("v_max3_f32 %0, %1, %2, %3" : "=v"(r) : "v"(a), "v"(b), "v"(c)); return r; }
__device__ __forceinline__ float max2f(float a, float b) { float r; asm("v_max_f32_e32 %0, %1, %2" : "=v"(r) : "v"(a), "v"(b)); return r; }
__device__ __forceinline__ float fadd_s(float a, float b) { float r; asm("v_add_f32_e32 %0, %1, %2" : "=v"(r) : "v"(a), "v"(b)); return r; }
__device__ __forceinline__ float fsub_s(float a, float b) { float r; asm("v_sub_f32_e32 %0, %1, %2" : "=v"(r) : "v"(a), "v"(b)); return r; }
__device__ __forceinline__ unsigned cvtpk_s(float lo, float hi) { f32x2 v = {lo, hi}; bf16x2_t b = __builtin_convertvector(v, bf16x2_t); return __builtin_bit_cast(unsigned, b); }
#define WAIT_BAR(N) asm volatile("s_waitcnt vmcnt(" #N ") lgkmcnt(0)\n\ts_barrier" ::: "memory")

__device__ __forceinline__ void qkt(f32x16& p0, f32x16& p1, const char* Kslot, const bf16x8* qr, const f32x16& negm, int r32, int hi) {
  const char* kb = Kslot + hi * 1024 + r32 * 16;
  #pragma unroll
  for (int d0 = 0; d0 < 4; ++d0) {
    const bf16x8 b0 = *reinterpret_cast<const bf16x8*>(kb + d0 * 2048);
    const bf16x8 b1 = *reinterpret_cast<const bf16x8*>(kb + d0 * 2048 + 512);
    if (d0 == 0) { p0 = __builtin_amdgcn_mfma_f32_32x32x16_bf16(b0, qr[0], negm, 0, 0, 0); p1 = __builtin_amdgcn_mfma_f32_32x32x16_bf16(b1, qr[0], negm, 0, 0, 0); }
    else { p0 = __builtin_amdgcn_mfma_f32_32x32x16_bf16(b0, qr[d0], p0, 0, 0, 0); p1 = __builtin_amdgcn_mfma_f32_32x32x16_bf16(b1, qr[d0], p1, 0, 0, 0); } }
}
typedef __attribute__((address_space(3))) const char* lds_cptr;
typedef short v4i16_t __attribute__((ext_vector_type(4)));
__device__ __forceinline__ void kload8(bf16x8* kf, lds_cptr kp) {
  kf[0] = *(const LAS bf16x8*)(kp);        kf[1] = *(const LAS bf16x8*)(kp + 512);
  kf[2] = *(const LAS bf16x8*)(kp + 2048); kf[3] = *(const LAS bf16x8*)(kp + 2560);
  kf[4] = *(const LAS bf16x8*)(kp + 4096); kf[5] = *(const LAS bf16x8*)(kp + 4608);
  kf[6] = *(const LAS bf16x8*)(kp + 6144); kf[7] = *(const LAS bf16x8*)(kp + 6656);
}
__device__ __forceinline__ void kload2(bf16x8* kf, lds_cptr kp, int j) { kf[2 * j] = *(const LAS bf16x8*)(kp + j * 2048); kf[2 * j + 1] = *(const LAS bf16x8*)(kp + j * 2048 + 512); }
__device__ __forceinline__ s16x4 vtr(lds_cptr p) { return __builtin_bit_cast(s16x4, __builtin_amdgcn_ds_read_tr16_b64_v4i16((LAS v4i16_t*)p)); }
__device__ __forceinline__ float rowmax(const f32x16& p0, const f32x16& p1) {
  float a = max3f(p0[0], p0[1], p1[0]), b = max3f(p0[2], p0[3], p1[1]); a = max3f(a, p1[2], p1[3]);
  #pragma unroll
  for (int r = 4; r < 16; r += 4) { a = max3f(a, p0[r], p0[r + 1]); b = max3f(b, p0[r + 2], p0[r + 3]); a = max3f(a, p1[r], p1[r + 1]); b = max3f(b, p1[r + 2], p1[r + 3]); }
  const float m = max2f(a, b);
  auto rr = __builtin_amdgcn_permlane32_swap(__float_as_uint(m), __float_as_uint(m), false, false);
  return max2f(__uint_as_float(rr[0]), __uint_as_float(rr[1]));
}
__device__ __forceinline__ void pv(f32x16* o, int vb, bf16x8 pa0, bf16x8 pa1, bf16x8 pa2, bf16x8 pa3) {
  #pragma unroll
  for (int d0 = 0; d0 < 2; ++d0) { s16x4 lo[4], hi[4];
    #pragma unroll
    for (int ks = 0; ks < 4; ++ks) {
      asm volatile("ds_read_b64_tr_b16 %0,%1 offset:%c2" : "=&v"(lo[ks]) : "v"(vb), "i"(d0 * 4096 + ks * 1024) : "memory");
      asm volatile("ds_read_b64_tr_b16 %0,%1 offset:%c2" : "=&v"(hi[ks]) : "v"(vb), "i"(d0 * 4096 + ks * 1024 + 512) : "memory"); }
    asm volatile("s_waitcnt lgkmcnt(0)" ::: "memory"); SBAR();
    #define PK(k) (bf16x8){lo[k][0], lo[k][1], lo[k][2], lo[k][3], hi[k][0], hi[k][1], hi[k][2], hi[k][3]}
    o[d0] = __builtin_amdgcn_mfma_f32_32x32x16_bf16(pa0, PK(0), o[d0], 0, 0, 0);
    o[d0] = __builtin_amdgcn_mfma_f32_32x32x16_bf16(pa1, PK(1), o[d0], 0, 0, 0);
    o[d0] = __builtin_amdgcn_mfma_f32_32x32x16_bf16(pa2, PK(2), o[d0], 0, 0, 0);
    o[d0] = __builtin_amdgcn_mfma_f32_32x32x16_bf16(pa3, PK(3), o[d0], 0, 0, 0);
    #undef PK
  }
}

template <int THRL> __device__ __forceinline__ void attn_unit(const bf16_t* Qrow0, int QP, const bf16_t* __restrict__ Kh, const bf16_t* __restrict__ Vh, int KVP, int NT, bf16_t* Orow0, int OP, char* shm, const int tid, const float mfix) {
  const int lane = tid & 63, r32 = lane & 31, hi = lane >> 5; const int wid = __builtin_amdgcn_readfirstlane(tid >> 6);
  const bf16_t* Qw = Qrow0 + (long)(wid * QBLK) * QP;
  const unsigned lds0 = (unsigned)(uintptr_t)shm;
  float* wsf = (float*)(shm + LDS_WS) + wid * 64;
  const bf16_t* ksrc = Kh + (long)lane * KVP + wid * 8;
  const bf16_t* vsrc = Vh + (long)(16 * (wid & 3) + (lane >> 2)) * KVP + (wid >> 2) * 32 + (lane & 3) * 8;
  const unsigned kdst = lds0 + LDS_K + wid * 1024, vdst = lds0 + LDS_V + wid * 1024;
  #define DMA_K(t, slot) glds16(ksrc + (long)(t) * KVBLK * KVP, (unsigned)__builtin_amdgcn_readfirstlane(kdst + (slot)))
  #define DMA_V(t, slot) glds16(vsrc + (long)(t) * KVBLK * KVP, (unsigned)__builtin_amdgcn_readfirstlane(vdst + (slot)))
  const int vb0 = (int)(lds0 + LDS_V) + ((lane >> 4) & 1) * 32 + (lane & 3) * 8 + (4 * hi + ((lane & 15) >> 2)) * 64;
  const char* Kbase = shm + LDS_K; bf16x8 kf[8];
  const lds_cptr shm3 = (lds_cptr)shm; const lds_cptr kp0 = shm3 + LDS_K + hi * 1024 + r32 * 16; const lds_cptr vp0 = shm3 + LDS_V + ((lane >> 4) & 1) * 32 + (lane & 3) * 8 + (4 * hi + ((lane & 15) >> 2)) * 64;
  DMA_K(0, 0); DMA_V(0, 0); DMA_K(1, SLOTB);
  bf16x8 qr[4];
  #pragma unroll
  for (int d0 = 0; d0 < 4; ++d0) qr[d0] = *reinterpret_cast<const bf16x8*>(&Qw[(long)r32 * QP + d0 * 16 + hi * 8]);
  float l_reg = 0.f; f32x16 o[2]; o[0] = f32x16{}; o[1] = f32x16{}; const f32x16 negm = f32x16{}; (void)mfix;
  #define START(P0, P1) do { _Pragma("unroll") for (int r = 0; r < 16; ++r) P0[r] = __builtin_amdgcn_exp2f(P0[r]); } while (0)
  #define RESC() do { } while (0)
  f32x16 pA0, pA1, pB0, pB1;
  int sl_prev = 0, sl_cur = 0, sl_next = SLOTB;
  #define ROT() do { sl_prev = sl_cur; sl_cur = sl_next; sl_next = (sl_next == (NSLOT - 1) * SLOTB) ? 0 : sl_next + SLOTB; } while (0)
  DMA_K(2, 2 * SLOTB);
  WAIT_BAR(3);
  qkt(pA0, pA1, Kbase, qr, negm, r32, hi); asm volatile("s_nop 15\n\ts_nop 7" : "+v"(pA0), "+v"(pA1));
  START(pA0, pA1);
  _Pragma("unroll") for (int r = 0; r < 16; ++r) pA1[r] = __builtin_amdgcn_exp2f(pA1[r]);
  WAIT_BAR(0);
  DMA_K(3, 0); DMA_V(1, SLOTB);
  ROT();
  kload8(kf, kp0 + sl_cur);
  WAIT_BAR(2);
  s16x4 vlo[8], vhi[8]; u32x4 pw0, pw1, pw2, pw3;
  #define PKW(P, B) cvtpk_s(P[B], P[B + 1])
  #define PAF(k) __builtin_bit_cast(bf16x8, pw##k)
  #define VFR(i) (bf16x8){vlo[i][0], vlo[i][1], vlo[i][2], vlo[i][3], vhi[i][0], vhi[i][1], vhi[i][2], vhi[i][3]}
  #define PIN(x) asm volatile("" : "+v"(x))
  #define MX3(a, b, c) __builtin_fmaxf(__builtin_fmaxf((a), (b)), (c))
  #define GAPA(MF, A0, A1, A2, A3, W0, W1, PW) do { MF; sacc += A0; sacc += A1; sacc += A2; sacc += A3; PIN(sacc); W0; W1; PIN(PW); SBAR(); } while (0)
  #define EX(v) __builtin_amdgcn_exp2f(v)
  #define GAPB(MF, X, B) do { MF; X[B] = EX(X[B]); X[B + 1] = EX(X[B + 1]); X[B + 2] = EX(X[B + 2]); X[B + 3] = EX(X[B + 3]); PIN(X); SBAR(); } while (0)
  #define VRD(i) do { vlo[i] = vtr(vp_ + (((i) >> 2) * 4096 + ((i) & 3) * 1024)); vhi[i] = vtr(vp_ + (((i) >> 2) * 4096 + ((i) & 3) * 1024 + 512)); } while (0)
  #define KRD(G, j) do { if (G) { kload2(kf, kp0 + sl_next, j); SBAR(); } } while (0)
  #define STEP(C0, C1, P0, P1, t, GK, GV, GL) do { SBAR(); \
    const lds_cptr vp_ = vp0 + sl_prev; \
    VRD(0); SBAR(); float sacc = (P0[0] + P0[1]); \
    GAPA(C0 = __builtin_amdgcn_mfma_f32_32x32x16_bf16(kf[0], qr[0], negm, 0, 0, 0), P0[2], P0[3], P0[4], P0[5],     pw0[0] = PKW(P0, 0), pw0[1] = PKW(P0, 2), pw0); \
    VRD(4); SBAR(); GAPA(C1 = __builtin_amdgcn_mfma_f32_32x32x16_bf16(kf[1], qr[0], negm, 0, 0, 0), P0[6], P0[7], P0[8], P0[9],     pw0[2] = PKW(P0, 4), pw0[3] = PKW(P0, 6), pw0); \
    VRD(1); SBAR(); GAPA(C0 = __builtin_amdgcn_mfma_f32_32x32x16_bf16(kf[2], qr[1], C0, 0, 0, 0),   P0[10], P0[11], P0[12], P0[13], pw1[0] = PKW(P0, 8), pw1[1] = PKW(P0, 10), pw1); \
    VRD(5); SBAR(); GAPA(C1 = __builtin_amdgcn_mfma_f32_32x32x16_bf16(kf[3], qr[1], C1, 0, 0, 0),   P0[14], P0[15], P1[0], P1[1],   pw1[2] = PKW(P0, 12), pw1[3] = PKW(P0, 14), pw1); \
    VRD(2); SBAR(); GAPA(C0 = __builtin_amdgcn_mfma_f32_32x32x16_bf16(kf[4], qr[2], C0, 0, 0, 0),   P1[2], P1[3], P1[4], P1[5],     pw2[0] = PKW(P1, 0), pw2[1] = PKW(P1, 2), pw2); \
    VRD(6); SBAR(); GAPA(C1 = __builtin_amdgcn_mfma_f32_32x32x16_bf16(kf[5], qr[2], C1, 0, 0, 0),   P1[6], P1[7], P1[8], P1[9],     pw2[2] = PKW(P1, 4), pw2[3] = PKW(P1, 6), pw2); \
    VRD(3); SBAR(); GAPA(C0 = __builtin_amdgcn_mfma_f32_32x32x16_bf16(kf[6], qr[3], C0, 0, 0, 0),   P1[10], P1[11], P1[12], P1[13], pw3[0] = PKW(P1, 8), pw3[1] = PKW(P1, 10), pw3); \
    VRD(7); SBAR(); GAPA(C1 = __builtin_amdgcn_mfma_f32_32x32x16_bf16(kf[7], qr[3], C1, 0, 0, 0),   P1[14], P1[15], 0.f, 0.f,       pw3[2] = PKW(P1, 12), pw3[3] = PKW(P1, 14), pw3); \
    l_reg += sacc; \
    if (GK) { DMA_K((t) + 3, sl_cur); } if (GV) { DMA_V((t) + 1, sl_next); } \
    SBAR(); \
    GAPB(o[0] = __builtin_amdgcn_mfma_f32_32x32x16_bf16(PAF(0), VFR(0), o[0], 0, 0, 0), C0, 0); \
    GAPB(o[1] = __builtin_amdgcn_mfma_f32_32x32x16_bf16(PAF(0), VFR(4), o[1], 0, 0, 0), C0, 4); \
    KRD(GL, 0); GAPB(o[0] = __builtin_amdgcn_mfma_f32_32x32x16_bf16(PAF(1), VFR(1), o[0], 0, 0, 0), C0, 8); \
    KRD(GL, 1); GAPB(o[1] = __builtin_amdgcn_mfma_f32_32x32x16_bf16(PAF(1), VFR(5), o[1], 0, 0, 0), C0, 12); \
    KRD(GL, 2); GAPB(o[0] = __builtin_amdgcn_mfma_f32_32x32x16_bf16(PAF(2), VFR(2), o[0], 0, 0, 0), C1, 0); \
    KRD(GL, 3); GAPB(o[1] = __builtin_amdgcn_mfma_f32_32x32x16_bf16(PAF(2), VFR(6), o[1], 0, 0, 0), C1, 4); \
    GAPB(o[0] = __builtin_amdgcn_mfma_f32_32x32x16_bf16(PAF(3), VFR(3), o[0], 0, 0, 0), C1, 8); \
    GAPB(o[1] = __builtin_amdgcn_mfma_f32_32x32x16_bf16(PAF(3), VFR(7), o[1], 0, 0, 0), C1, 12); \
    } while (0)
  int t = 1;
  for (; t + 5 < NT; t += 2) {
    STEP(pB0, pB1, pA0, pA1, t, true, true, true);     WAIT_BAR(2); RESC(); ROT();
    STEP(pA0, pA1, pB0, pB1, t + 1, true, true, true); WAIT_BAR(2); RESC(); ROT();
  }
  #define ENDW(tt) do { if ((tt) + 3 < NT) { WAIT_BAR(2); } else if ((tt) + 2 < NT) { WAIT_BAR(1); } else { WAIT_BAR(0); } } while (0)
  for (; t + 1 < NT; t += 2) {
    STEP(pB0, pB1, pA0, pA1, t, (t + 3 < NT), (t + 1 < NT), (t + 1 < NT));         ENDW(t);     RESC(); ROT();
    STEP(pA0, pA1, pB0, pB1, t + 1, (t + 4 < NT), (t + 2 < NT), (t + 2 < NT));     ENDW(t + 1); RESC(); ROT();
  }
  STEP(pB0, pB1, pA0, pA1, NT - 1, false, false, false); RESC();
  { float sacc = pB0[0] + pB0[1]; _Pragma("unroll") for (int r = 2; r < 16; ++r) sacc += pB0[r]; _Pragma("unroll") for (int r = 0; r < 16; ++r) sacc += pB1[r]; l_reg += sacc;
    pw0 = (u32x4){PKW(pB0, 0), PKW(pB0, 2), PKW(pB0, 4), PKW(pB0, 6)}; pw1 = (u32x4){PKW(pB0, 8), PKW(pB0, 10), PKW(pB0, 12), PKW(pB0, 14)}; pw2 = (u32x4){PKW(pB1, 0), PKW(pB1, 2), PKW(pB1, 4), PKW(pB1, 6)}; pw3 = (u32x4){PKW(pB1, 8), PKW(pB1, 10), PKW(pB1, 12), PKW(pB1, 14)};
    SBAR(); pv(o, vb0 + sl_cur, PAF(0), PAF(1), PAF(2), PAF(3)); }
  #undef PKW
  #undef PAF
  #undef VFR
  #undef PIN
  #undef MX3
  #undef GAPA
  #undef GAPB
  #undef EX
  #undef VRD
  #undef KRD
  #undef STEP
  #undef ENDW
  { auto rr = __builtin_amdgcn_permlane32_swap(__float_as_uint(l_reg), __float_as_uint(l_reg), false, false); l_reg = __uint_as_float(rr[0]) + __uint_as_float(rr[1]); }
  if (hi == 0) wsf[32 + r32] = l_reg; asm volatile("s_waitcnt lgkmcnt(0)" ::: "memory");
  float rli[16];
  #pragma unroll
  for (int r = 0; r < 16; ++r) rli[r] = __builtin_amdgcn_rcpf(wsf[32 + crow(r, hi)]);
  bf16_t* Ow = Orow0 + (long)(wid * QBLK) * OP;
  { bf16_t* stg = (bf16_t*)(shm + LDS_OST) + wid * 2048;
    #pragma unroll
    for (int r = 0; r < 16; ++r) { const int orow = crow(r, hi);
      #pragma unroll
      for (int d0 = 0; d0 < 2; ++d0) stg[orow * 64 + d0 * 32 + r32] = (bf16_t)f2bf(o[d0][r] * rli[r]); }
    asm volatile("s_waitcnt lgkmcnt(0)" ::: "memory");
    #pragma unroll
    for (int i = 0; i < 4; ++i) { const int row = i * 8 + (lane >> 3), ch = lane & 7; const u32x4 v = *(const u32x4*)(stg + row * 64 + ch * 8); *(u32x4*)(Ow + (long)row * OP + ch * 8) = v; } }
  asm volatile("s_waitcnt lgkmcnt(0)\n\ts_barrier" ::: "memory");
  #undef DMA_K
  #undef DMA_V
  #undef START
  #undef RESC
  #undef ROT
}
#undef SBAR
#undef WAIT_BAR
}
struct Frame {
    LAS unsigned char* lds;
    int tid, lane, wave;
    int vcu, G, gw, NGW, bid;
    unsigned char* ws; const unsigned long long* inq;
};

__device__ __forceinline__ void transpose_item(const float* W, int ldw, int K, bf16_t* WT, int k0, int n0, int dst_row0, LAS float* scr, int lane) {
    float tv[32];
#pragma unroll
    for (int i = 0; i < 32; ++i) tv[i] = W[(size_t)(k0 + 2 * i + (lane >> 5)) * ldw + n0 + (lane & 31)];
#pragma unroll
    for (int i = 0; i < 32; ++i) scr[(2 * i + (lane >> 5)) * 33 + (lane & 31)] = tv[i];
    LDS_WAIT(); asm volatile("" ::: "memory");
    const int c = lane & 7;
#pragma unroll
    for (int j = 0; j < 4; ++j) { const int n = (lane >> 3) + 8 * j; const LAS float* s = scr + (8 * c) * 33 + n;
        u32x4 o; o.x = pk2(s[0 * 33], s[1 * 33]); o.y = pk2(s[2 * 33], s[3 * 33]); o.z = pk2(s[4 * 33], s[5 * 33]); o.w = pk2(s[6 * 33], s[7 * 33]);
        *(u32x4*)(WT + (size_t)(dst_row0 + n) * K + k0 + 8 * c) = o; }
    LDS_WAIT(); asm volatile("" ::: "memory");
}

__device__ __forceinline__ void sincos_acc(float x, float& s, float& c) {
    const float k = rintf(x * 0.63661977236758134f);
    float r = fmaf(k, -1.5703125f, x); r = fmaf(k, -4.837512969970703125e-4f, r); r = fmaf(k, -7.54978995489188e-8f, r);
    const float z = r * r;
    const float sp = r + r * z * fmaf(z, fmaf(z, -1.9515295891e-4f, 8.3321608736e-3f), -1.6666654611e-1f);
    const float cp = fmaf(z * z, fmaf(z, fmaf(z, 2.443315711809948e-5f, -1.388731625493765e-3f), 4.166664568298827e-2f), fmaf(z, -0.5f, 1.0f));
    const int q = ((int)k) & 3;
    const float ss = (q & 1) ? cp : sp, cc = (q & 1) ? sp : cp;
    s = (q & 2) ? -ss : ss; c = ((q + 1) & 2) ? -cc : cc;
}

__device__ __forceinline__ void p0_prologue(Frame& F, const float* const* in, unsigned char* ws) {
    const float* c_lat = in[1]; const float* c_ctx = in[3]; const float* w_mod = in[4]; const float* b_mod = in[5];
    LAS float* sil = (LAS float*)F.lds;
    for (int i = F.tid; i < NMI * D; i += NTHREADS) { const int mi = i >> 10, k = i & 1023; const float v = (mi < NB) ? c_lat[mi * D + k] : c_ctx[k]; sil[i] = silu_f(v); }
    __syncthreads();
    {
        float* modv = (float*)(ws + WS_MODV);
        const int NT16 = 6 * D / 16;
        for (int task = F.gw; task < DEPTH * NT16; task += F.NGW) {
            const int layer = task / NT16, j0 = (task % NT16) * 16, jj = F.lane & 15, kq = F.lane >> 4;
            const float* wp = w_mod + (size_t)layer * D * 6 * D + j0 + jj;
            float acc[NMI];
#pragma unroll
            for (int m = 0; m < NMI; ++m) acc[m] = 0.f;
            for (int k0 = kq; k0 < D; k0 += 64) {
                float wv[16];
#pragma unroll
                for (int u = 0; u < 16; ++u) wv[u] = wp[(size_t)(k0 + 4 * u) * 6 * D];
#pragma unroll
                for (int u = 0; u < 16; ++u) { const int k = k0 + 4 * u;
#pragma unroll
                    for (int m = 0; m < NMI; ++m) acc[m] = fmaf(sil[m * D + k], wv[u], acc[m]); } }
#pragma unroll
            for (int m = 0; m < NMI; ++m) { float v = acc[m]; v += __shfl_xor(v, 16); v += __shfl_xor(v, 32); acc[m] = v; }
            if (kq == 0) { const float bb = b_mod[layer * 6 * D + j0 + jj];
#pragma unroll
                for (int m = 0; m < NMI; ++m) modv[((size_t)layer * NMI + m) * 6 * D + j0 + jj] = acc[m] + bb; }
        }
    }
    __syncthreads();
    {
        LAS float* scr = (LAS float*)(F.lds) + F.wave * (64 * 33);
        constexpr int I_MI = 16 * 96, I_MO = 16 * 32, I_AI = 16 * 48, I_AO = 16 * 32;
        constexpr int PER_J = I_MI + I_MO + I_AI + I_AO;
        for (int it = F.gw; it < 2 * PER_J; it += F.NGW) {
            const int j = it / PER_J; int r = it % PER_J;
            if (r < I_MI) { const int kb = r / 96, nb = r % 96; transpose_item(in[8] + (size_t)j * D * MW_IN, MW_IN, D, (bf16_t*)(ws + WS_WMI) + (size_t)j * 3072 * D, 64 * kb, 32 * nb, 32 * nb, scr, F.lane); continue; } r -= I_MI;
            if (r < I_MO) { const int kb = r / 32, nb = r % 32; transpose_item(in[11] + (size_t)j * D * D, D, D, (bf16_t*)(ws + WS_WMO) + (size_t)j * D * D, 64 * kb, 32 * nb, 32 * nb, scr, F.lane); continue; } r -= I_MO;
            if (r < I_AI) { const int kb = r / 48, nb = r % 48; transpose_item(in[12] + (size_t)j * D * 1536, 1536, D, (bf16_t*)(ws + WS_WAI) + (size_t)j * 1536 * D, 64 * kb, 32 * nb, 32 * nb, scr, F.lane); continue; } r -= I_AI;
            { const int kb = r / 32, nb = r % 32; transpose_item(in[15] + (size_t)j * D * D, D, D, (bf16_t*)(ws + WS_WAO) + (size_t)j * D * D, 64 * kb, 32 * nb, 32 * nb, scr, F.lane); }
        }
    }
    {
        float* rc = (float*)(ws + WS_ROPE); float* rs = rc + SEQ * 32;
        for (int i = F.bid * NTHREADS + F.tid; i < SEQ * 32; i += F.G * NTHREADS) {
            const int t = i >> 5, p = i & 31; const float pos = (p < 16) ? (float)(t >> 6) : (float)(t & 63);
            const float inv = exp2f(-(float)(p & 15) * (13.287712379549449f / 16.f));
            float s, c; sincos_acc(pos * inv, s, c); rc[i] = c; rs[i] = s; }
    }
    __syncthreads();
}

__device__ __forceinline__ void moe_weights(Frame& F, const float* wg, const float* wu, const float* wd, unsigned char* ws, unsigned* counter) {
    LAS float* T = (LAS float*)F.lds;
    volatile LAS int* slot = (volatile LAS int*)(F.lds + 65536 + 256);
    const int lane = F.lane, w = F.wave, tid = F.tid;
    bf16_t* W1 = (bf16_t*)(ws + WS_W1); bf16_t* W2 = (bf16_t*)(ws + WS_W2);
    unsigned char* W1b = (unsigned char*)(ws + WS_W1); unsigned char* W2b = (unsigned char*)(ws + WS_W2);
    constexpr int NIT = NE * 3 * 16 * 4;
#define MW_SRC(it_) (((((it_) % 192) / 64) == 0 ? wg : ((((it_) % 192) / 64) == 1 ? wu : wd)) + (size_t)((it_) / 192) * D * D + (size_t)(64 * ((((it_) % 192) % 64) >> 2)) * D + 256 * ((((it_) % 192) % 64) & 3))
    __syncthreads();
    int pend = NIT;
    if (tid == 0) { slot[0] = (int)__hip_atomic_fetch_add(counter, 1u, __ATOMIC_RELAXED, __HIP_MEMORY_SCOPE_AGENT); pend = (int)__hip_atomic_fetch_add(counter, 1u, __ATOMIC_RELAXED, __HIP_MEMORY_SCOPE_AGENT); }
    __syncthreads();
    int it = slot[0];
    f32x4 v[8];
    if (it < NIT) { const float* src = MW_SRC(it);
#pragma unroll
        for (int i = 0; i < 8; ++i) v[i] = *(const f32x4*)(src + (size_t)(8 * w + i) * D + 4 * lane); }
    while (it < NIT) {
        if (tid == 0) { slot[1] = pend; pend = (int)__hip_atomic_fetch_add(counter, 1u, __ATOMIC_RELAXED, __HIP_MEMORY_SCOPE_AGENT); }
        __syncthreads();
#pragma unroll
        for (int i = 0; i < 8; ++i) *(LAS f32x4*)(T + (8 * w + i) * 256 + ((4 * lane) ^ (8 * (w & 3)))) = v[i];
        const int nx = slot[1];
        if (nx < NIT) { const float* src = MW_SRC(nx);
#pragma unroll
            for (int i = 0; i < 8; ++i) v[i] = *(const f32x4*)(src + (size_t)(8 * w + i) * D + 4 * lane); }
        __syncthreads();
        const int e = it / 192, r = it % 192, which = r / 64, kb = (r % 64) >> 2, nq = (r % 64) & 3;
        const int nl = lane & 7, c = lane >> 3;
        bf16_t* base = (which == 2) ? (W2 + (size_t)e * D * D) : (W1 + (size_t)e * 2048 * D);
#pragma unroll
        for (int j = 0; j < 4; ++j) { const int n = 32 * w + 8 * j + nl; const LAS float* tp = T + (8 * c) * 256 + (n ^ (8 * (c & 3)));
            float t[8];
#pragma unroll
            for (int i = 0; i < 8; ++i) t[i] = tp[i * 256];
            const int ng = 256 * nq + n; const int drow = (which == 2) ? ng : (256 * (ng >> 7) + (which == 1 ? 128 : 0) + (ng & 127));
            const bool f8 = (which == 2) ? (MOE_FP8_2 != 0) : (MOE_FP8_1 != 0);
            if (f8) { u32x2 o; o.x = pk_fp8x4(t[0] * FP8_SW, t[1] * FP8_SW, t[2] * FP8_SW, t[3] * FP8_SW); o.y = pk_fp8x4(t[4] * FP8_SW, t[5] * FP8_SW, t[6] * FP8_SW, t[7] * FP8_SW);
                unsigned char* b8 = (which == 2) ? (W2b + (size_t)e * D * D) : (W1b + (size_t)e * 2048 * D);
                *(u32x2*)(b8 + (size_t)drow * D + 64 * kb + 8 * c) = o; }
            else { u32x4 o; o.x = pk2(t[0], t[1]); o.y = pk2(t[2], t[3]); o.z = pk2(t[4], t[5]); o.w = pk2(t[6], t[7]);
                *(u32x4*)(base + (size_t)drow * D + 64 * kb + 8 * c) = o; } }
        it = nx;
    }
#undef MW_SRC
    __syncthreads();
}

__device__ __forceinline__ void load_w16(Frame& F, const float* W16, int ldw16) {
    LAS float* wl = (LAS float*)F.lds;
    for (int i = F.tid; i < D * 16; i += NTHREADS) { const int c = i >> 4, e = i & 15; const int l = (c & 255) >> 2, q = (c & 3) + 4 * (c >> 8);
        wl[(q * 64 + l) * 20 + e] = W16[(size_t)c * ldw16 + e]; }
    __syncthreads();
}
template <int MODE, bool F8 = false>
__device__ __forceinline__ void norm_core(LAS float* wl, const int lane, f32x4 (&v)[4], const int r, const f32x4 (&gv)[4], const float* shp, const float* scp, bf16_t* H, const float* bias16, float* out16) {
    float ss = 0.f;
#pragma unroll
    for (int j = 0; j < 4; ++j) ss += (v[j].x * v[j].x + v[j].y * v[j].y) + (v[j].z * v[j].z + v[j].w * v[j].w);
    const float rstd = rsqrtf(wave_sum(ss) * (1.f / D) + NORM_EPS);
    unsigned long long* o8 = (unsigned long long*)(H + (size_t)r * D) + lane;
#pragma unroll
    for (int j = 0; j < 4; ++j) { const f32x4 sh = *(const f32x4*)(shp + 4 * lane + 256 * j), sc = *(const f32x4*)(scp + 4 * lane + 256 * j);
        v[j] = (v[j] * rstd * gv[j]) * (sc + 1.f) + sh;
        if (F8) ((unsigned*)((unsigned char*)H + (size_t)r * D))[lane + 64 * j] = pk_fp8x4(v[j].x * FP8_SH, v[j].y * FP8_SH, v[j].z * FP8_SH, v[j].w * FP8_SH);
        else o8[64 * j] = (unsigned long long)pk2(v[j].x, v[j].y) | ((unsigned long long)pk2(v[j].z, v[j].w) << 32); }
    if (MODE != 0) {
        float p[16];
#pragma unroll
        for (int e = 0; e < 16; ++e) p[e] = 0.f;
#pragma unroll
        for (int j = 0; j < 4; ++j) {
            f32x4 wq[4][4];
#pragma unroll
            for (int i = 0; i < 4; ++i) { const LAS f32x4* wp = (const LAS f32x4*)(wl + ((4 * j + i) * 64 + lane) * 20);
#pragma unroll
                for (int e4 = 0; e4 < 4; ++e4) wq[i][e4] = wp[e4]; }
            asm volatile("s_waitcnt lgkmcnt(0)" ::: "memory"); __builtin_amdgcn_sched_barrier(0);
#pragma unroll
            for (int i = 0; i < 4; ++i) { const float xv = v[j][i];
#pragma unroll
                for (int e4 = 0; e4 < 4; ++e4) { const f32x4 w = wq[i][e4]; p[4 * e4 + 0] = fmaf(xv, w.x, p[4 * e4 + 0]); p[4 * e4 + 1] = fmaf(xv, w.y, p[4 * e4 + 1]); p[4 * e4 + 2] = fmaf(xv, w.z, p[4 * e4 + 2]); p[4 * e4 + 3] = fmaf(xv, w.w, p[4 * e4 + 3]); } }
            __builtin_amdgcn_sched_barrier(0);
        }
        float q8[8], q4[4], q2[2], q1;
        { const bool up = (lane & 32) != 0;
#pragma unroll
          for (int i = 0; i < 8; ++i) { const float send = up ? p[i] : p[i + 8]; const float recv = __shfl_xor(send, 32); q8[i] = (up ? p[i + 8] : p[i]) + recv; } }
        { const bool up = (lane & 16) != 0;
#pragma unroll
          for (int i = 0; i < 4; ++i) { const float send = up ? q8[i] : q8[i + 4]; const float recv = __shfl_xor(send, 16); q4[i] = (up ? q8[i + 4] : q8[i]) + recv; } }
        { const bool up = (lane & 8) != 0;
#pragma unroll
          for (int i = 0; i < 2; ++i) { const float send = up ? q4[i] : q4[i + 2]; const float recv = __shfl_xor(send, 8); q2[i] = (up ? q4[i + 2] : q4[i]) + recv; } }
        { const bool up = (lane & 4) != 0; const float send = up ? q2[0] : q2[1]; const float recv = __shfl_xor(send, 4); q1 = (up ? q2[1] : q2[0]) + recv; }
        q1 = quad_sum(q1);
        const int e = ((lane >> 5) & 1) * 8 + ((lane >> 4) & 1) * 4 + ((lane >> 3) & 1) * 2 + ((lane >> 2) & 1);
        if (MODE == 1) {
            float g = q1 + bias16[e];
            g = 15.f * tanhf(g * (1.f / 15.f));
            const int gate = e >> 2;
            if (gate & 1) g = fminf(g, 0.f) - log1pf(__expf(-fabsf(g)));
            if ((lane & 3) == 0) out16[(size_t)r * 16 + e] = g;
        } else {
            float mx = q1;
#pragma unroll
            for (int o = 4; o < 64; o <<= 1) mx = fmaxf(mx, __shfl_xor(mx, o));
            const float ex = __expf(q1 - mx); float sm = ex;
#pragma unroll
            for (int o = 4; o < 64; o <<= 1) sm += __shfl_xor(sm, o);
            if ((lane & 3) == 0) out16[(size_t)e * RT + r] = ex / sm;
        }
    }
}
__device__ __forceinline__ float swap32_add(float a, float b) { auto r = __builtin_amdgcn_permlane32_swap(__float_as_uint(a), __float_as_uint(b), false, false); return __uint_as_float(r[0]) + __uint_as_float(r[1]); }
__device__ __forceinline__ float swap16_add(float a, float b) { auto r = __builtin_amdgcn_permlane16_swap(__float_as_uint(a), __float_as_uint(b), false, false); return __uint_as_float(r[0]) + __uint_as_float(r[1]); }
template <int MODE, bool F8 = false>
__device__ __forceinline__ void norm_pass(Frame& F, const float* xL, const float* xC, int nrows, const float* gain, const float* shiftv, const float* scalev  ,
                                          bf16_t* H, const float* W16, int ldw16, const float* bias16, float* out16) {
    LAS float* wl = (LAS float*)F.lds;
    if (MODE != 0) load_w16(F, W16, ldw16);
    const int lane = F.lane;
    f32x4 gv[4];
#pragma unroll
    for (int j = 0; j < 4; ++j) gv[j] = *(const f32x4*)(gain + 4 * lane + 256 * j);
    const int per = (((nrows + F.NGW - 1) / F.NGW) + 1) & ~1; const int r0 = F.gw * per, r1 = (r0 + per < nrows) ? r0 + per : nrows;
#define NP_XPTR(rr) (((rr) >= RL) ? (xC + (size_t)((rr) - RL) * D) : (xL + (size_t)(rr) * D))
    f32x4 vn[2][4];
    if (r0 < r1) {
#pragma unroll
        for (int q = 0; q < 2; ++q) { const float* xr = NP_XPTR(r0 + q);
#pragma unroll
            for (int j = 0; j < 4; ++j) vn[q][j] = *(const f32x4*)(xr + 4 * lane + 256 * j); } }
    for (int r = r0; r < r1; r += 2) {
        asm volatile("" ::: "memory");
        f32x4 v[2][4];
#pragma unroll
        for (int q = 0; q < 2; ++q)
#pragma unroll
            for (int j = 0; j < 4; ++j) v[q][j] = vn[q][j];
        if (r + 2 < r1) {
#pragma unroll
            for (int q = 0; q < 2; ++q) { const float* xr = NP_XPTR(r + 2 + q);
#pragma unroll
                for (int j = 0; j < 4; ++j) vn[q][j] = *(const f32x4*)(xr + 4 * lane + 256 * j); } }
        float ss[2];
#pragma unroll
        for (int q = 0; q < 2; ++q) { ss[q] = 0.f;
#pragma unroll
            for (int j = 0; j < 4; ++j) ss[q] += (v[q][j].x * v[q][j].x + v[q][j].y * v[q][j].y) + (v[q][j].z * v[q][j].z + v[q][j].w * v[q][j].w); }
        ss[0] = row16_sum(ss[0]); ss[1] = row16_sum(ss[1]);
        const float tot0 = (rdlane(ss[0], 0) + rdlane(ss[0], 16)) + (rdlane(ss[0], 32) + rdlane(ss[0], 48)), tot1 = (rdlane(ss[1], 0) + rdlane(ss[1], 16)) + (rdlane(ss[1], 32) + rdlane(ss[1], 48));
        const float rstd[2] = {rsqrtf(tot0 * (1.f / D) + NORM_EPS), rsqrtf(tot1 * (1.f / D) + NORM_EPS)};
#pragma unroll
        for (int q = 0; q < 2; ++q) { const int rr = r + q; const int mi = (rr >= RL) ? NB : (rr >> 12);
            const float* shp = shiftv + (size_t)mi * 6 * D; const float* scp = scalev + (size_t)mi * 6 * D;
#pragma unroll
            for (int j = 0; j < 4; ++j) { const f32x4 sh = *(const f32x4*)(shp + 4 * lane + 256 * j), sc = *(const f32x4*)(scp + 4 * lane + 256 * j);
                v[q][j] = (v[q][j] * rstd[q] * gv[j]) * (sc + 1.f) + sh;
                if (F8) ((unsigned*)((unsigned char*)H + (size_t)rr * D))[lane + 64 * j] = pk_fp8x4(v[q][j].x * FP8_SH, v[q][j].y * FP8_SH, v[q][j].z * FP8_SH, v[q][j].w * FP8_SH);
                else ((unsigned long long*)(H + (size_t)rr * D))[lane + 64 * j] = (unsigned long long)pk2(v[q][j].x, v[q][j].y) | ((unsigned long long)pk2(v[q][j].z, v[q][j].w) << 32); } }
        if (MODE != 0) {
            f32x2 p2[2][8];
#pragma unroll
            for (int q = 0; q < 2; ++q)
#pragma unroll
                for (int e = 0; e < 8; ++e) p2[q][e] = (f32x2){0.f, 0.f};
#pragma unroll
            for (int j = 0; j < 4; ++j) {
                f32x4 wq[4][4];
#pragma unroll
                for (int i = 0; i < 4; ++i) { const LAS f32x4* wp = (const LAS f32x4*)(wl + ((4 * j + i) * 64 + lane) * 20);
#pragma unroll
                    for (int e4 = 0; e4 < 4; ++e4) wq[i][e4] = wp[e4]; }
                asm volatile("s_waitcnt lgkmcnt(0)" ::: "memory"); __builtin_amdgcn_sched_barrier(0);
#pragma unroll
                for (int i = 0; i < 4; ++i)
#pragma unroll
                    for (int q = 0; q < 2; ++q) { const float xv = v[q][j][i]; const f32x2 x2 = {xv, xv};
#pragma unroll
                        for (int e4 = 0; e4 < 4; ++e4) { const f32x4 w = wq[i][e4];
                            p2[q][2 * e4 + 0] = __builtin_elementwise_fma(x2, (f32x2){w.x, w.y}, p2[q][2 * e4 + 0]);
                            p2[q][2 * e4 + 1] = __builtin_elementwise_fma(x2, (f32x2){w.z, w.w}, p2[q][2 * e4 + 1]); } }
                __builtin_amdgcn_sched_barrier(0);
            }
            float p[2][16];
#pragma unroll
            for (int q = 0; q < 2; ++q)
#pragma unroll
                for (int e = 0; e < 8; ++e) { p[q][2 * e] = p2[q][e].x; p[q][2 * e + 1] = p2[q][e].y; }
            float q16[16], q8[8], q4[4], q2[2], q1;
#pragma unroll
            for (int e = 0; e < 16; ++e) q16[e] = swap32_add(p[0][e], p[1][e]);
#pragma unroll
            for (int i = 0; i < 8; ++i) q8[i] = swap16_add(q16[i], q16[i + 8]);
            { const bool up = (lane & 8) != 0;
#pragma unroll
              for (int i = 0; i < 4; ++i) { const float send = up ? q8[i] : q8[i + 4]; const float recv = __shfl_xor(send, 8); q4[i] = (up ? q8[i + 4] : q8[i]) + recv; } }
            { const bool up = (lane & 4) != 0;
#pragma unroll
              for (int i = 0; i < 2; ++i) { const float send = up ? q4[i] : q4[i + 2]; const float recv = __shfl_xor(send, 4); q2[i] = (up ? q4[i + 2] : q4[i]) + recv; } }
            { const bool up = (lane & 2) != 0; const float send = up ? q2[0] : q2[1]; const float recv = dpp_f<0x4E>(0.f, send); q1 = (up ? q2[1] : q2[0]) + recv; }
            q1 += dpp_f<0xB1>(0.f, q1);
            const int e = ((lane >> 4) & 1) * 8 + ((lane >> 3) & 1) * 4 + ((lane >> 2) & 1) * 2 + ((lane >> 1) & 1);
            const int rr = r + (lane >> 5);
            if (MODE == 1) {
                float g = q1 + bias16[e];
                g = 15.f * tanhf(g * (1.f / 15.f));
                const int gate = e >> 2;
                if (gate & 1) g = fminf(g, 0.f) - log1pf(__expf(-fabsf(g)));
                if ((lane & 1) == 0) out16[(size_t)rr * 16 + e] = g;
            } else {
                float mx = q1;
                mx = fmaxf(mx, dpp_f<0x4E>(mx, mx)); mx = fmaxf(mx, dpp_f<0x141>(mx, mx)); mx = fmaxf(mx, dpp_f<0x140>(mx, mx));
                { auto t = __builtin_amdgcn_permlane16_swap(__float_as_uint(mx), __float_as_uint(mx), false, false); mx = fmaxf(__uint_as_float(t[0]), __uint_as_float(t[1])); }
                const float ex = __expf(q1 - mx); float sm = ex;
                sm += dpp_f<0x4E>(0.f, sm); sm += dpp_f<0x141>(0.f, sm); sm += dpp_f<0x140>(0.f, sm);
                sm = swap16_add(sm, sm);
                if ((lane & 1) == 0) out16[(size_t)e * RT + rr] = ex / sm;
            }
        }
    }
#undef NP_XPTR
    if (MODE != 0) __syncthreads();
}

__device__ __forceinline__ void moe_select(Frame& F, const float* AFF, int* INV, int* SLROW, float* SLG, int nunits) {
    LAS unsigned* keys = (LAS unsigned*)F.lds;
    LAS unsigned* wsum = (LAS unsigned*)(F.lds + 16384);
    const int tid = F.tid, lane = F.lane, wave = F.wave;
    for (int u = F.vcu; u < nunits; u += F.G) {
        const int set = u >> 4, e = u & 15; const bool isc = set >= NB; const int b = isc ? set - NB : set;
        const int N = isc ? CTXL : SEQ, k = isc ? CAP_C : CAP_L, PER = isc ? 1 : 8;
        const int row0 = isc ? RL + b * CTXL : b * SEQ;
        const int nmine = (tid * PER < N) ? PER : 0;
        unsigned kv[8];
        if (tid < 32) wsum[tid] = 0u;
#pragma unroll
        for (int i = 0; i < 8; ++i) { kv[i] = 0u; if (i < nmine) kv[i] = __float_as_uint(AFF[(size_t)e * RT + row0 + tid * PER + i]); }
        __syncthreads();
        unsigned T = 0u; { unsigned kk = (unsigned)k;
        for (int pass = 0; pass < 8; ++pass) {
            const int shift = 28 - 4 * pass; LAS unsigned* hist = wsum + (pass & 1) * 16;
            if (tid < 16) wsum[((pass + 1) & 1) * 16 + tid] = 0u;
#pragma unroll
            for (int i = 0; i < 8; ++i) if (i < nmine && (pass == 0 || (kv[i] >> (shift + 4)) == (T >> (shift + 4)))) (void)__hip_atomic_fetch_add(&hist[(kv[i] >> shift) & 15u], 1u, __ATOMIC_RELAXED, __HIP_MEMORY_SCOPE_WORKGROUP);
            __syncthreads();
            unsigned cum = 0u, digit = 0u; bool found = false;
#pragma unroll
            for (int d = 15; d >= 0; --d) { const unsigned c = hist[d]; if (!found) { if (cum + c >= kk) { digit = (unsigned)d; found = true; } else cum += c; } }
            kk -= cum; T |= digit << shift;
            __syncthreads();
        } }
        unsigned ngt = 0u, neq = 0u;
#pragma unroll
        for (int i = 0; i < 8; ++i) { if (i < nmine) { ngt += kv[i] > T ? 1u : 0u; neq += kv[i] == T ? 1u : 0u; } }
        unsigned sgt = ngt, seq = neq;
#pragma unroll
        for (int o = 1; o < 64; o <<= 1) { const unsigned a = __shfl_up(sgt, o), c2 = __shfl_up(seq, o); if (lane >= o) { sgt += a; seq += c2; } }
        LAS unsigned* sc = wsum + 32;
        __syncthreads();
        if (lane == 63) { sc[wave] = sgt; sc[8 + wave] = seq; }
        __syncthreads();
        unsigned bgt = 0u, beq = 0u, tgt = 0u;
#pragma unroll
        for (int w = 0; w < 8; ++w) { const unsigned a = sc[w], c2 = sc[8 + w]; if (w < wave) { bgt += a; beq += c2; } tgt += a; }
        const unsigned need = (unsigned)k - tgt;
        unsigned pgt = bgt + sgt - ngt, peq = beq + seq - neq;
        const int sbase = isc ? NB * CAP_L + b * CAP_C : b * CAP_L;
#pragma unroll
        for (int i = 0; i < 8; ++i) { if (i < nmine) {
            const int row = row0 + tid * PER + i; int slot = -1;
            if (kv[i] > T) { slot = (int)(pgt + (peq < need ? peq : need)); ++pgt; }
            else if (kv[i] == T) { if (peq < need) slot = (int)(pgt + peq); ++peq; }
            if (slot >= 0) { SLROW[e * SLOTS_E + sbase + slot] = row; SLG[e * SLOTS_E + sbase + slot] = __uint_as_float(kv[i]); }
            INV[(size_t)e * RT + row] = slot >= 0 ? sbase + slot : -1; } }
        __syncthreads();
    }
    (void)keys;
}

__device__ __forceinline__ void moe_gather(Frame& F, const bf16_t* H, const int* SLROW, bf16_t* XG, bool with_ctx) {
    const int per_e = with_ctx ? SLOTS_E : NB * CAP_L; const int total = NE * per_e;
    const int per = (total + F.NGW - 1) / F.NGW; const int i0 = F.gw * per, i1 = (i0 + per < total) ? i0 + per : total;
    for (int i = i0; i < i1; i += 4) {
        u32x4 a[4], b2[4]; size_t dsto[4];
#pragma unroll
        for (int q = 0; q < 4; ++q) { const int ii = (i + q < i1) ? i + q : i1 - 1; const int e = ii / per_e, sl = ii - e * per_e; const int row = SLROW[e * SLOTS_E + sl];
            const u32x4* src = (const u32x4*)(H + (size_t)row * D) + F.lane; a[q] = src[0]; b2[q] = src[64]; dsto[q] = ((size_t)e * SLOTS_E + sl) * D; }
#pragma unroll
        for (int q = 0; q < 4; ++q) { u32x4* dst = (u32x4*)(XG + dsto[q]) + F.lane; dst[0] = a[q]; dst[64] = b2[q]; }
    }
}

template <int MODE>
__device__ __forceinline__ void combine_norm(Frame& F, const bf16_t* Y, const int* INV, float* xL, float* xC, const float* g2v  , int nrows,
                                             const float* gain, const float* shiftv, const float* scalev, bf16_t* H, const float* W16, int ldw16, const float* bias16, float* out16) {
    LAS float* wl = (LAS float*)F.lds;
    if (MODE == 1) load_w16(F, W16, ldw16);
    const int lane = F.lane;
    f32x4 gv[4];
#pragma unroll
    for (int j = 0; j < 4; ++j) gv[j] = *(const f32x4*)(gain + 4 * lane + 256 * j);
    const int per = (nrows + F.NGW - 1) / F.NGW; const int r0 = F.gw * per, r1 = (r0 + per < nrows) ? r0 + per : nrows;
#define CN_XPTR(rr) (((rr) >= RL) ? (xC + (size_t)((rr) - RL) * D) : (xL + (size_t)(rr) * D))
#define CN_INV(rr) (((rr) < r1 && lane < 16) ? INV[(size_t)lane * RT + (rr)] : -1)
#define CN_YLOAD(dst, e_, s_) do { const u32x2* yp_ = (const u32x2*)(Y + ((size_t)(e_) * SLOTS_E + (s_)) * D) + lane; _Pragma("unroll") for (int j = 0; j < 4; ++j) dst[j] = yp_[64 * j]; } while (0)
#define CN_YACC(src) do { _Pragma("unroll") for (int j = 0; j < 4; ++j) { a[j].x += bf_lo(src[j].x); a[j].y += bf_hi(src[j].x); a[j].z += bf_lo(src[j].y); a[j].w += bf_hi(src[j].y); } } while (0)
    f32x4 vn[4]; u32x2 pn0[4], pn1[4];
    int invA = CN_INV(r0), invB = CN_INV(r0 + 1);
#pragma unroll
    for (int j = 0; j < 4; ++j) { vn[j] = (f32x4){0.f, 0.f, 0.f, 0.f}; pn0[j] = (u32x2){0u, 0u}; pn1[j] = (u32x2){0u, 0u}; }
    if (r0 < r1) { const float* xr = CN_XPTR(r0);
#pragma unroll
        for (int j = 0; j < 4; ++j) vn[j] = *(const f32x4*)(xr + 4 * lane + 256 * j);
        unsigned long long m = __ballot(invA >= 0);
        if (m) { const int e0 = __builtin_ctzll(m); m &= m - 1; CN_YLOAD(pn0, e0, __builtin_amdgcn_readlane(invA, e0)); if (m) { const int e1 = __builtin_ctzll(m); CN_YLOAD(pn1, e1, __builtin_amdgcn_readlane(invA, e1)); } } }
    for (int r = r0; r < r1; ++r) {
        asm volatile("" ::: "memory");
        f32x4 v[4]; u32x2 pc0[4], pc1[4];
#pragma unroll
        for (int j = 0; j < 4; ++j) { v[j] = vn[j]; pc0[j] = pn0[j]; pc1[j] = pn1[j]; }
        const int invC = CN_INV(r + 2);
        if (r + 1 < r1) { const float* xr = CN_XPTR(r + 1);
#pragma unroll
            for (int j = 0; j < 4; ++j) vn[j] = *(const f32x4*)(xr + 4 * lane + 256 * j);
            unsigned long long m = __ballot(invB >= 0);
            if (m) { const int e0 = __builtin_ctzll(m); m &= m - 1; CN_YLOAD(pn0, e0, __builtin_amdgcn_readlane(invB, e0)); if (m) { const int e1 = __builtin_ctzll(m); CN_YLOAD(pn1, e1, __builtin_amdgcn_readlane(invB, e1)); } } }
        f32x4 a[4];
#pragma unroll
        for (int j = 0; j < 4; ++j) a[j] = (f32x4){0.f, 0.f, 0.f, 0.f};
        { unsigned long long m = __ballot(invA >= 0);
          if (m) { m &= m - 1; CN_YACC(pc0);
            if (m) { m &= m - 1; CN_YACC(pc1);
              while (m) { const int e2 = __builtin_ctzll(m); m &= m - 1; u32x2 t2[4]; CN_YLOAD(t2, e2, __builtin_amdgcn_readlane(invA, e2)); CN_YACC(t2); } } } }
        const int mi = (r >= RL) ? NB : (r >> 12);
        const float* gp = g2v + (size_t)mi * 6 * D;
#pragma unroll
        for (int j = 0; j < 4; ++j) { const f32x4 g = *(const f32x4*)(gp + 4 * lane + 256 * j); v[j] = v[j] + g * a[j]; }
        float* xw = CN_XPTR(r);
        if (MODE == 3) {
            float ss = 0.f;
#pragma unroll
            for (int j = 0; j < 4; ++j) ss += (v[j].x * v[j].x + v[j].y * v[j].y) + (v[j].z * v[j].z + v[j].w * v[j].w);
            const float rstd = rsqrtf(wave_sum(ss) * (1.f / D) + NORM_EPS);
#pragma unroll
            for (int j = 0; j < 4; ++j) *(f32x4*)(xw + 4 * lane + 256 * j) = v[j] * rstd * gv[j];
        } else {
#pragma unroll
            for (int j = 0; j < 4; ++j) *(f32x4*)(xw + 4 * lane + 256 * j) = v[j];
            norm_core<MODE>(wl, lane, v, r, gv, shiftv + (size_t)mi * 6 * D, scalev + (size_t)mi * 6 * D, H, bias16, out16);
        }
        invA = invB; invB = invC;
    }
#undef CN_XPTR
#undef CN_INV
#undef CN_YLOAD
#undef CN_YACC
    if (MODE == 1) __syncthreads();
}

__device__ __forceinline__ void final_norm(Frame& F, float* x, const float* gain) {
    const int lane = F.lane;
    for (int r = F.gw; r < RL; r += F.NGW) { float* xr = x + (size_t)r * D; f32x4 v[4]; float ss = 0.f;
#pragma unroll
        for (int j = 0; j < 4; ++j) { v[j] = *(const f32x4*)(xr + 4 * lane + 256 * j); ss += (v[j].x * v[j].x + v[j].y * v[j].y) + (v[j].z * v[j].z + v[j].w * v[j].w); }
        const float rstd = rsqrtf(wave_sum(ss) * (1.f / D) + NORM_EPS);
#pragma unroll
        for (int j = 0; j < 4; ++j) { const f32x4 g = *(const f32x4*)(gain + 4 * lane + 256 * j); *(f32x4*)(xr + 4 * lane + 256 * j) = v[j] * rstd * g; } }
}

__device__ __forceinline__ void unpack8(const u32x4 u, float (&x)[8]) { x[0] = bf_lo(u.x); x[1] = bf_hi(u.x); x[2] = bf_lo(u.y); x[3] = bf_hi(u.y); x[4] = bf_lo(u.z); x[5] = bf_hi(u.z); x[6] = bf_lo(u.w); x[7] = bf_hi(u.w); }
__device__ __forceinline__ u32x4 pack8(const float (&y)[8]) { u32x4 o; o.x = pk2(y[0], y[1]); o.y = pk2(y[2], y[3]); o.z = pk2(y[4], y[5]); o.w = pk2(y[6], y[7]); return o; }
__device__ __forceinline__ void qk_pass(Frame& F, bf16_t* QKV, const float* qn, const float* kn, const float* ropec, const float* ropes, bf16_t* KALL, bf16_t* VALL) {
    const int lane = F.lane, p = lane & 3;
    float gq1[8], gq2[8], gk1[8], gk2[8];
#pragma unroll
    for (int t = 0; t < 8; ++t) { gq1[t] = qn[8 * p + t]; gq2[t] = qn[32 + 8 * p + t]; gk1[t] = kn[8 * p + t]; gk2[t] = kn[32 + 8 * p + t]; }
    const int per = (((RT + F.NGW - 1) / F.NGW) + 3) & ~3; const int r0 = F.gw * per, r1 = (r0 + per < RT) ? r0 + per : RT;
    const int kh = (lane >> 2) & 3;
    for (int r = r0; r < r1; r += 4) {
        u32x4 qa[4], qb[4], ka[4], kb2[4], vv[4]; f32x4 c0[4], c1[4], s0[4], s1[4];
#pragma unroll
        for (int q = 0; q < 4; ++q) { const int rr = (r + q < r1) ? r + q : r1 - 1; const bool isc = rr >= RL; const int t = isc ? (rr - RL) & 255 : rr & 4095;
            const bf16_t* row = QKV + (size_t)rr * 1536;
            qa[q] = *(const u32x4*)(row + (lane >> 2) * 64 + 8 * p); qb[q] = *(const u32x4*)(row + (lane >> 2) * 64 + 8 * p + 32);
            ka[q] = *(const u32x4*)(row + 1024 + kh * 64 + 8 * p); kb2[q] = *(const u32x4*)(row + 1024 + kh * 64 + 8 * p + 32);
            vv[q] = *(const u32x4*)(row + 1280 + ((lane - 16) & 31) * 8);
            const int tt = isc ? 0 : t;
            c0[q] = *(const f32x4*)(ropec + tt * 32 + 8 * p); c1[q] = *(const f32x4*)(ropec + tt * 32 + 8 * p + 4); s0[q] = *(const f32x4*)(ropes + tt * 32 + 8 * p); s1[q] = *(const f32x4*)(ropes + tt * 32 + 8 * p + 4); }
#pragma unroll
        for (int q = 0; q < 4; ++q) { const int rr = r + q; if (rr < r1) {
            const bool isc = rr >= RL; const int b = isc ? (rr - RL) >> 8 : rr >> 12; const int t = isc ? (rr - RL) & 255 : rr & 4095; const int pos = isc ? t : CTXL + t;
            bf16_t* row = QKV + (size_t)rr * 1536;
            float cs[8], sn[8];
            cs[0] = c0[q].x; cs[1] = c0[q].y; cs[2] = c0[q].z; cs[3] = c0[q].w; cs[4] = c1[q].x; cs[5] = c1[q].y; cs[6] = c1[q].z; cs[7] = c1[q].w;
            sn[0] = s0[q].x; sn[1] = s0[q].y; sn[2] = s0[q].z; sn[3] = s0[q].w; sn[4] = s1[q].x; sn[5] = s1[q].y; sn[6] = s1[q].z; sn[7] = s1[q].w;
            if (isc) {
#pragma unroll
                for (int i = 0; i < 8; ++i) { cs[i] = 1.f; sn[i] = 0.f; } }
            {
                float x1[8], x2[8]; unpack8(qa[q], x1); unpack8(qb[q], x2);
                float ss = 0.f;
#pragma unroll
                for (int i = 0; i < 8; ++i) ss += x1[i] * x1[i] + x2[i] * x2[i];
                ss = quad_sum(ss);
                const float rstd = rsqrtf(ss * (1.f / 64.f) + NORM_EPS) * attn_body::C2;
                float y1[8], y2[8];
#pragma unroll
                for (int i = 0; i < 8; ++i) { const float a = x1[i] * rstd * gq1[i], c = x2[i] * rstd * gq2[i]; y1[i] = a * cs[i] - c * sn[i]; y2[i] = a * sn[i] + c * cs[i]; }
                bf16_t* hp = row + (lane >> 2) * 64 + 8 * p;
                *(u32x4*)hp = pack8(y1); *(u32x4*)(hp + 32) = pack8(y2);
            }
            {
                float x1[8], x2[8]; unpack8(ka[q], x1); unpack8(kb2[q], x2);
                float ss = 0.f;
#pragma unroll
                for (int i = 0; i < 8; ++i) ss += x1[i] * x1[i] + x2[i] * x2[i];
                ss = quad_sum(ss);
                const float rstd = rsqrtf(ss * (1.f / 64.f) + NORM_EPS);
                float y1[8], y2[8];
#pragma unroll
                for (int i = 0; i < 8; ++i) { const float a = x1[i] * rstd * gk1[i], c = x2[i] * rstd * gk2[i]; y1[i] = a * cs[i] - c * sn[i]; y2[i] = a * sn[i] + c * cs[i]; }
                if (lane < 16) { bf16_t* kp = KALL + ((size_t)b * KVLEN + pos) * 256 + kh * 64 + 8 * p; *(u32x4*)kp = pack8(y1); *(u32x4*)(kp + 32) = pack8(y2); }
                else if (lane < 48) *(u32x4*)(VALL + ((size_t)b * KVLEN + pos) * 256 + (lane - 16) * 8) = vv[q];
            } } }
    }
}

__device__ __forceinline__ void mlstm_readout(Frame& F, const bf16_t* HF, const bf16_t* HB, const bf16_t* QKVO, const float* wnorm, bf16_t* MIX) {
    const int lane = F.lane;
    f32x4 gv[4];
#pragma unroll
    for (int j = 0; j < 4; ++j) gv[j] = *(const f32x4*)(wnorm + 4 * lane + 256 * j);
    const int per = (((RT + F.NGW - 1) / F.NGW) + 3) & ~3; const int r0 = F.gw * per, r1 = (r0 + per < RT) ? r0 + per : RT;
    for (int r = r0; r < r1; r += 4) {
        u32x2 uf[4][4], ub[4][4], uo[4][4];
#pragma unroll
        for (int q = 0; q < 4; ++q) { const int rr = (r + q < r1) ? r + q : r1 - 1;
            const u32x2* pf = (const u32x2*)(HF + (size_t)rr * D) + lane; const u32x2* pb = (const u32x2*)(HB + (size_t)rr * D) + lane; const u32x2* po = (const u32x2*)(QKVO + (size_t)rr * 3072 + 2048) + lane;
#pragma unroll
            for (int j = 0; j < 4; ++j) { uf[q][j] = pf[64 * j]; ub[q][j] = pb[64 * j]; uo[q][j] = po[64 * j]; } }
#pragma unroll
        for (int q = 0; q < 4; ++q) { const int rr = r + q; if (rr < r1) {
            unsigned long long* o8 = (unsigned long long*)(MIX + (size_t)rr * D) + lane;
#pragma unroll
            for (int j = 0; j < 4; ++j) {
                f32x4 h; h.x = bf_lo(uf[q][j].x) + bf_lo(ub[q][j].x); h.y = bf_hi(uf[q][j].x) + bf_hi(ub[q][j].x); h.z = bf_lo(uf[q][j].y) + bf_lo(ub[q][j].y); h.w = bf_hi(uf[q][j].y) + bf_hi(ub[q][j].y);
                const float ss = wave_sum((h.x * h.x + h.y * h.y) + (h.z * h.z + h.w * h.w));
                const float rstd = rsqrtf(ss * (1.f / 256.f) + NORM_EPS);
                f32x4 og; og.x = bf_lo(uo[q][j].x); og.y = bf_hi(uo[q][j].x); og.z = bf_lo(uo[q][j].y); og.w = bf_hi(uo[q][j].y);
                f32x4 y;
                y.x = h.x * rstd * gv[j].x * fast_rcp(1.f + __expf(-og.x)); y.y = h.y * rstd * gv[j].y * fast_rcp(1.f + __expf(-og.y));
                y.z = h.z * rstd * gv[j].z * fast_rcp(1.f + __expf(-og.z)); y.w = h.w * rstd * gv[j].w * fast_rcp(1.f + __expf(-og.w));
                o8[64 * j] = (unsigned long long)pk2(y.x, y.y) | ((unsigned long long)pk2(y.z, y.w) << 32);
            } } }
    }
}
namespace mls {
constexpr int XS = 272, PS = 144, NCH = 68;
constexpr int O_XQ = 0, O_XK = 17408, O_XKP = 34816, O_XV = 52224, O_P = 69632, O_CT = 78848, O_OT = 113664, O_GB = 131072;
constexpr int O_RD = O_GB + 2 * 5 * 64 * 4, O_NV = O_RD + 256, O_DEC = O_NV + 1024, O_PRE = O_DEC + 64;
constexpr int LDS_BYTES = O_PRE + 3 * 72 * 4;

__device__ __forceinline__ int row_of(int b, int dir, int c, int p) {
    const int base = (c < 4) ? (RL + b * CTXL + (dir ? 192 - 64 * c : 64 * c)) : (b * SEQ + (dir ? 4032 - 64 * (c - 4) : 64 * (c - 4)));
    return base + (dir ? 63 - p : p);
}
__device__ __forceinline__ bf16x8 tr8(const LAS unsigned char* p0, const LAS unsigned char* p1) {
    typedef short v4i16_t __attribute__((ext_vector_type(4)));
    const s16x4 lo = __builtin_bit_cast(s16x4, __builtin_amdgcn_ds_read_tr16_b64_v4i16((LAS v4i16_t*)p0));
    const s16x4 hi = __builtin_bit_cast(s16x4, __builtin_amdgcn_ds_read_tr16_b64_v4i16((LAS v4i16_t*)p1));
    return (bf16x8){lo[0], lo[1], lo[2], lo[3], hi[0], hi[1], hi[2], hi[3]};
}

__device__ __forceinline__ void gate_arrays(LAS unsigned char* L, const float lf, const float ig, int c, int lane) {
    const int par = c & 1;
    const float bs = wave_scan_add(lf, lane);
    const float a = ig - bs; const float pm = wave_scan_max(a, lane);
    const float mst = ((const LAS float*)(L + O_PRE))[144 + c];
    const float M = fmaxf(mst, pm), M63 = rdlane(M, 63);
    LAS float* gb = (LAS float*)(L + O_GB) + par * 320;
    gb[lane] = a; gb[64 + lane] = M; gb[128 + lane] = __expf(mst - M); gb[192 + lane] = __expf(-bs - M); gb[256 + lane] = __expf(a - M63);
    if (lane == 0) ((LAS float*)(L + O_DEC))[par] = __expf(mst - M63);
}

__device__ __forceinline__ void mlstm_unit(Frame& F, int b, int hd, int dir, int half, const bf16_t* QKVO, const float* GATES, bf16_t* HOUT) {
    LAS unsigned char* L = F.lds;
    const int tid = F.tid, lane = F.lane, w = F.wave, fr = lane & 15, g = lane >> 4;
    const int gi = (dir * 2) * 4 + hd, gf = (dir * 2 + 1) * 4 + hd;
    LAS float* pre = (LAS float*)(L + O_PRE);
    __syncthreads();
    {
        float lfv[9], igv[9];
#pragma unroll
        for (int q = 0; q < 9; ++q) { const int c = w + 8 * q; lfv[q] = 0.f; igv[q] = 0.f;
            if (c < NCH) { const int row = row_of(b, dir, c, lane); lfv[q] = GATES[(size_t)row * 16 + gf]; igv[q] = GATES[(size_t)row * 16 + gi]; } }
#pragma unroll
        for (int q = 0; q < 9; ++q) { const int c = w + 8 * q;
            if (c < NCH) { const float bs = wave_scan_add(lfv[q], lane); float am = igv[q] - bs;
                am = fmaxf(am, dpp_f<0xB1>(am, am)); am = fmaxf(am, dpp_f<0x4E>(am, am)); am = fmaxf(am, dpp_f<0x141>(am, am)); am = fmaxf(am, dpp_f<0x140>(am, am));
                am = fmaxf(fmaxf(rdlane(am, 0), rdlane(am, 16)), fmaxf(rdlane(am, 32), rdlane(am, 48)));
                if (lane == 0) { pre[c] = rdlane(bs, 63); pre[72 + c] = am; } } }
    }
    for (int i = tid; i < (O_OT - O_CT) / 4; i += NTHREADS) ((LAS unsigned*)(L + O_CT))[i] = 0u;
    for (int i = tid; i < 256; i += NTHREADS) ((LAS float*)(L + O_NV))[i] = 0.f;
    __syncthreads();
    if (tid == 0) { float m = 0.f; for (int c = 0; c < NCH; ++c) { pre[144 + c] = m; m = pre[c] + fmaxf(m, pre[72 + c]); } }
    __syncthreads();
    if (w == 0) { const int row = row_of(b, dir, 0, lane); gate_arrays(L, GATES[(size_t)row * 16 + gf], GATES[(size_t)row * 16 + gi], 0, lane); }
    __syncthreads();
    const int qcol = hd * 128, kcol = 512 + hd * 128, vcol = 1024 + hd * 256 + half * 128;
    u32x4 rq[2], rk[2], rv[2];
#define MLS_BAR() do { asm volatile("s_waitcnt lgkmcnt(0)" ::: "memory"); __builtin_amdgcn_s_barrier(); asm volatile("" ::: "memory"); } while (0)
#define MLS_LOAD(c) do { _Pragma("unroll") for (int i_ = 0; i_ < 2; ++i_) { const int pi_ = tid + 512 * i_, p_ = pi_ >> 4, c16_ = pi_ & 15; \
        const bf16_t* rp_ = QKVO + (size_t)row_of(b, dir, (c), p_) * 3072 + c16_ * 8; \
        rq[i_] = *(const u32x4*)(rp_ + qcol); rk[i_] = *(const u32x4*)(rp_ + kcol); rv[i_] = *(const u32x4*)(rp_ + vcol); } } while (0)
#define MLS_STAGE(c) do { const LAS float* wk_ = (const LAS float*)(L + O_GB) + ((c) & 1) * 320 + 256; \
        _Pragma("unroll") for (int i_ = 0; i_ < 2; ++i_) { const int pi_ = tid + 512 * i_, p_ = pi_ >> 4, c16_ = pi_ & 15; const int o_ = p_ * XS + c16_ * 16; \
        *(LAS u32x4*)(L + O_XQ + o_) = rq[i_]; *(LAS u32x4*)(L + O_XK + o_) = rk[i_]; *(LAS u32x4*)(L + O_XV + o_) = rv[i_]; \
        const float s_ = wk_[p_]; u32x4 kk_; \
        kk_.x = pk2(bf_lo(rk[i_].x) * s_, bf_hi(rk[i_].x) * s_); kk_.y = pk2(bf_lo(rk[i_].y) * s_, bf_hi(rk[i_].y) * s_); \
        kk_.z = pk2(bf_lo(rk[i_].z) * s_, bf_hi(rk[i_].z) * s_); kk_.w = pk2(bf_lo(rk[i_].w) * s_, bf_hi(rk[i_].w) * s_); \
        *(LAS u32x4*)(L + O_XKP + o_) = kk_; } } while (0)
    MLS_LOAD(0); MLS_STAGE(0);
    __syncthreads();
    f32x4 C[8];
#pragma unroll
    for (int i = 0; i < 8; ++i) C[i] = (f32x4){0.f, 0.f, 0.f, 0.f};
    LAS unsigned char* CTw = L + O_CT + w * (16 * XS);
    float glf_n = 0.f, gig_n = 0.f;
    if (w == 7) { const int row = row_of(b, dir, 1, lane); glf_n = GATES[(size_t)row * 16 + gf]; gig_n = GATES[(size_t)row * 16 + gi]; }
    for (int c = 0; c < NCH; ++c) {
        const int par = c & 1; const bool more = (c + 1 < NCH);
        const LAS float* gb = (const LAS float*)(L + O_GB) + par * 320;
        const float glf = glf_n, gig = gig_n;
        if (w == 7 && c + 2 < NCH) { const int row = row_of(b, dir, c + 2, lane); glf_n = GATES[(size_t)row * 16 + gf]; gig_n = GATES[(size_t)row * 16 + gi]; }
        if (more) MLS_LOAD(c + 1);
#define LFENCE() do { asm volatile("s_waitcnt lgkmcnt(0)" ::: "memory"); __builtin_amdgcn_sched_barrier(0); } while (0)
#define QFRAG(mt_, ks_) (*(const LAS bf16x8*)(L + O_XQ + (16 * (mt_) + fr) * XS + (32 * (ks_) + 8 * g) * 2))
        f32x4 acc[4];
        {
            const int mt1 = w >> 1;
            bf16x8 ct[4], qa[2][4], qb[2][4];
#pragma unroll
            for (int ks = 0; ks < 4; ++ks) ct[ks] = *(const LAS bf16x8*)(CTw + fr * XS + (32 * ks + 8 * g) * 2);
#pragma unroll
            for (int m2 = 0; m2 < 2; ++m2)
#pragma unroll
                for (int ks = 0; ks < 4; ++ks) qa[m2][ks] = QFRAG(m2, ks);
            LFENCE();
#pragma unroll
            for (int m2 = 0; m2 < 2; ++m2)
#pragma unroll
                for (int ks = 0; ks < 4; ++ks) qb[m2][ks] = QFRAG(2 + m2, ks);
            __builtin_amdgcn_sched_barrier(0);
#pragma unroll
            for (int m2 = 0; m2 < 2; ++m2) { f32x4 a4 = (f32x4){0.f, 0.f, 0.f, 0.f};
#pragma unroll
                for (int ks = 0; ks < 4; ++ks) a4 = __builtin_amdgcn_mfma_f32_16x16x32_bf16(qa[m2][ks], ct[ks], a4, 0, 0, 0);
                acc[m2] = a4; }
            LFENCE();
            bf16x8 aq[4], bk[2][4];
#pragma unroll
            for (int ks = 0; ks < 4; ++ks) aq[ks] = QFRAG(mt1, ks);
#pragma unroll
            for (int n2 = 0; n2 < 2; ++n2)
#pragma unroll
                for (int ks = 0; ks < 4; ++ks) bk[n2][ks] = *(const LAS bf16x8*)(L + O_XK + (16 * (2 * (w & 1) + n2) + fr) * XS + (32 * ks + 8 * g) * 2);
            const f32x4 Mj = *(const LAS f32x4*)(gb + 64 + 16 * mt1 + 4 * g);
            float as[2]; as[0] = gb[16 * (2 * (w & 1)) + fr]; as[1] = gb[16 * (2 * (w & 1) + 1) + fr];
            f32x4 wi[4];
#pragma unroll
            for (int mt = 0; mt < 4; ++mt) wi[mt] = *(const LAS f32x4*)(gb + 128 + 16 * mt + 4 * g);
            __builtin_amdgcn_sched_barrier(0);
#pragma unroll
            for (int m2 = 0; m2 < 2; ++m2) { f32x4 a4 = (f32x4){0.f, 0.f, 0.f, 0.f};
#pragma unroll
                for (int ks = 0; ks < 4; ++ks) a4 = __builtin_amdgcn_mfma_f32_16x16x32_bf16(qb[m2][ks], ct[ks], a4, 0, 0, 0);
                acc[2 + m2] = a4; }
            LFENCE();
            f32x4 s4[2];
#pragma unroll
            for (int n2 = 0; n2 < 2; ++n2) { s4[n2] = (f32x4){0.f, 0.f, 0.f, 0.f};
#pragma unroll
                for (int ks = 0; ks < 4; ++ks) s4[n2] = __builtin_amdgcn_mfma_f32_16x16x32_bf16(aq[ks], bk[n2][ks], s4[n2], 0, 0, 0); }
#pragma unroll
            for (int mt = 0; mt < 4; ++mt) acc[mt] = acc[mt] * wi[mt];
#pragma unroll
            for (int n2 = 0; n2 < 2; ++n2) { const int sidx = 16 * (2 * (w & 1) + n2) + fr;
#pragma unroll
                for (int reg = 0; reg < 4; ++reg) { const int j = 16 * mt1 + 4 * g + reg;
                    const float pv = (sidx <= j) ? s4[n2][reg] * __expf(as[n2] - Mj[reg]) : 0.f;
                    *(LAS bf16_t*)(L + O_P + j * PS + sidx * 2) = (bf16_t)f2bf(pv); } }
        }
        MLS_BAR();
        bf16x8 vf[2];
        float rdv; float nsum;
        const float decay = ((const LAS float*)(L + O_DEC))[par];
        {
            const LAS unsigned char* vb = L + O_XV + (8 * g + (fr >> 2)) * XS + (16 * w + (lane & 3) * 4) * 2;
            const LAS unsigned char* kb = L + O_XKP + (8 * g + (fr >> 2)) * XS + ((lane & 3) * 4) * 2;
            bf16x8 ap[4][2];
#pragma unroll
            for (int k2 = 0; k2 < 2; ++k2) vf[k2] = tr8(vb + 32 * k2 * XS, vb + (32 * k2 + 4) * XS);
#pragma unroll
            for (int mt = 0; mt < 4; ++mt)
#pragma unroll
                for (int k2 = 0; k2 < 2; ++k2) ap[mt][k2] = *(const LAS bf16x8*)(L + O_P + (16 * mt + fr) * PS + (32 * k2 + 8 * g) * 2);
            LFENCE();
            const int j = tid >> 3, part = tid & 7;
            const u32x4 pu = *(const LAS u32x4*)(L + O_P + j * PS + part * 16);
            const u32x4 q0 = *(const LAS u32x4*)(L + O_XQ + j * XS + part * 32), q1 = *(const LAS u32x4*)(L + O_XQ + j * XS + part * 32 + 16);
            const LAS f32x4* np = (const LAS f32x4*)(L + O_NV + par * 512 + part * 64);
            const f32x4 n0 = np[0], n1 = np[1], n2 = np[2], n3 = np[3];
            const float wint_j = gb[128 + j], emq_j = gb[192 + j];
            bf16x8 ak[4][2];
#pragma unroll
            for (int mt = 0; mt < 4; ++mt)
#pragma unroll
                for (int k2 = 0; k2 < 2; ++k2) ak[mt][k2] = tr8(kb + 32 * k2 * XS + 32 * mt, kb + (32 * k2 + 4) * XS + 32 * mt);
            __builtin_amdgcn_sched_barrier(0);
#pragma unroll
            for (int mt = 0; mt < 4; ++mt)
#pragma unroll
                for (int k2 = 0; k2 < 2; ++k2) acc[mt] = __builtin_amdgcn_mfma_f32_16x16x32_bf16(ap[mt][k2], vf[k2], acc[mt], 0, 0, 0);
            LFENCE();
            const int dk = tid >> 2, part4 = tid & 3; bf16_t kc[16];
#pragma unroll
            for (int t = 0; t < 16; ++t) kc[t] = *(const LAS bf16_t*)(L + O_XKP + (16 * part4 + t) * XS + dk * 2);
            const float nold = ((const LAS float*)(L + O_NV))[par * 128 + dk];
            __builtin_amdgcn_sched_barrier(0);
#pragma unroll
            for (int mt = 0; mt < 4; ++mt) { f32x4 c4 = C[mt] * decay;
#pragma unroll
                for (int k2 = 0; k2 < 2; ++k2) c4 = __builtin_amdgcn_mfma_f32_16x16x32_bf16(ak[mt][k2], vf[k2], c4, 0, 0, 0);
                C[mt] = c4; }
            float rs = (bf_lo(pu.x) + bf_hi(pu.x)) + (bf_lo(pu.y) + bf_hi(pu.y)) + (bf_lo(pu.z) + bf_hi(pu.z)) + (bf_lo(pu.w) + bf_hi(pu.w));
            float qn = bf_lo(q0.x) * n0.x + bf_hi(q0.x) * n0.y + bf_lo(q0.y) * n0.z + bf_hi(q0.y) * n0.w
                     + bf_lo(q0.z) * n1.x + bf_hi(q0.z) * n1.y + bf_lo(q0.w) * n1.z + bf_hi(q0.w) * n1.w
                     + bf_lo(q1.x) * n2.x + bf_hi(q1.x) * n2.y + bf_lo(q1.y) * n2.z + bf_hi(q1.y) * n2.w
                     + bf_lo(q1.z) * n3.x + bf_hi(q1.z) * n3.y + bf_lo(q1.w) * n3.z + bf_hi(q1.w) * n3.w;
            rs = oct_sum(rs); qn = oct_sum(qn);
            rdv = 1.f / fmaxf(fabsf(rs + wint_j * qn), emq_j);
            float sm0 = 0.f;
#pragma unroll
            for (int t = 0; t < 16; ++t) sm0 += bf2f(kc[t]);
            __builtin_amdgcn_sched_barrier(0);
#pragma unroll
            for (int mt = 0; mt < 4; ++mt)
#pragma unroll
                for (int k2 = 0; k2 < 2; ++k2) ak[mt][k2] = tr8(kb + 32 * k2 * XS + 32 * (4 + mt), kb + (32 * k2 + 4) * XS + 32 * (4 + mt));
            LFENCE();
#pragma unroll
            for (int mt = 0; mt < 4; ++mt) { f32x4 c4 = C[4 + mt] * decay;
#pragma unroll
                for (int k2 = 0; k2 < 2; ++k2) c4 = __builtin_amdgcn_mfma_f32_16x16x32_bf16(ak[mt][k2], vf[k2], c4, 0, 0, 0);
                C[4 + mt] = c4; }
            float sm = quad_sum(sm0);
            nsum = decay * nold + sm;
        }
#undef LFENCE
#undef QFRAG
        asm volatile("" ::: "memory");
        if ((tid & 7) == 0) ((LAS float*)(L + O_RD))[tid >> 3] = rdv;
        if ((tid & 3) == 0) ((LAS float*)(L + O_NV))[(par ^ 1) * 128 + (tid >> 2)] = nsum;
#pragma unroll
        for (int mt = 0; mt < 8; ++mt) { u32x2 o; o.x = pk2(C[mt][0], C[mt][1]); o.y = pk2(C[mt][2], C[mt][3]);
            *(LAS u32x2*)(CTw + fr * XS + (16 * mt + 4 * g) * 2) = o; }
        if (more && w == 7) gate_arrays(L, glf, gig, c + 1, lane);
        MLS_BAR();
        {
#pragma unroll
            for (int mt = 0; mt < 4; ++mt) { const f32x4 rd = *(const LAS f32x4*)(L + O_RD + (16 * mt + 4 * g) * 4);
#pragma unroll
                for (int reg = 0; reg < 4; ++reg) *(LAS bf16_t*)(L + O_OT + (16 * mt + 4 * g + reg) * XS + (16 * w + fr) * 2) = (bf16_t)f2bf(acc[mt][reg] * rd[reg]); }
            if (more) MLS_STAGE(c + 1);
        }
        MLS_BAR();
        {
            const int j = tid >> 3, ch = tid & 7;
            const u32x4 o0 = *(const LAS u32x4*)(L + O_OT + j * XS + ch * 32), o1 = *(const LAS u32x4*)(L + O_OT + j * XS + ch * 32 + 16);
            bf16_t* op = HOUT + (size_t)row_of(b, dir, c, j) * D + hd * 256 + half * 128 + ch * 16;
            *(u32x4*)op = o0; *(u32x4*)(op + 8) = o1;
        }
    }
#undef MLS_BAR
#undef MLS_LOAD
#undef MLS_STAGE
}
}
constexpr int MISC_OFF = 135936, LDS_TOTAL = 136192;
static_assert(mls::LDS_BYTES <= MISC_OFF && pg8::STAGE_BYTES <= MISC_OFF && attn_body::LDS_BYTES <= MISC_OFF, "lds");
#ifndef EN_MASK
#define EN_MASK 0xFFFFFFFFu
#endif
#define PH_ON(k) (((EN_MASK) >> (k)) & 1u)
#ifndef REP_MASK
#define REP_MASK 0u
#endif
#define REP_ON(k) (((REP_MASK) >> (k)) & 1u)
#ifndef PH_LIMIT
#define PH_LIMIT 1000
#endif
#ifndef N_LAUNCH_SPLIT
#define N_LAUNCH_SPLIT 0
#endif
constexpr int N_PHASES = 1 + 10 + 9 + 9 + 9;

struct Args { const float* in[21]; float* out; unsigned char* ws; int ph_lo, ph_hi; };
static_assert(sizeof(Args) == 23 * 8 + 8, "no padding");

__device__ __forceinline__ Frame make_frame(unsigned char* lds_gen, unsigned char* ws_, const int wave_s) {
    Frame F; int ln; asm volatile("v_mbcnt_lo_u32_b32 %0, -1, 0\n\tv_mbcnt_hi_u32_b32 %0, -1, %0" : "=v"(ln));
    int wv = wave_s; asm volatile("" : "+s"(wv));
    int bx = blockIdx.x; asm volatile("" : "+s"(bx));
    F.lds = (LAS unsigned char*)lds_gen; F.tid = wv * 64 + ln; F.lane = ln; F.wave = wv;
    F.G = gridDim.x; F.bid = bx; F.vcu = (F.G % 8 == 0) ? (bx % 8) * (F.G / 8) + bx / 8 : bx;
    F.gw = F.vcu * NWAVES + F.wave; F.NGW = F.G * NWAVES;
    unsigned long long wi = (unsigned long long)ws_; asm volatile("" : "+s"(wi)); GAS unsigned char* wg = (GAS unsigned char*)wi;
    F.ws = (unsigned char*)wg; F.inq = (const unsigned long long*)(GAS const unsigned long long*)(wg + WS_PTRS); return F;
}
__global__ void __launch_bounds__(NTHREADS, 2) fwd(Args a) {
    extern __shared__ __attribute__((aligned(16))) unsigned char lds_raw[];
    unsigned char* const lds_gen = lds_raw;
    const int wave_s = __builtin_amdgcn_readfirstlane((int)threadIdx.x >> 6);
    unsigned char* ws = a.ws;
    if (threadIdx.x < 4) ((LAS unsigned*)((LAS unsigned char*)lds_raw + MISC_OFF))[threadIdx.x] = 0u;
    __syncthreads();
    XcdBarrier bar = xcd_barrier_post((unsigned*)(ws + WS_CTL), (volatile LAS unsigned*)((LAS unsigned char*)lds_raw + MISC_OFF));
    int cur = 0; const int lo = a.ph_lo, hi = a.ph_hi & 0xffff; bool ran = false;
#define PHASE_BEGIN if (cur >= lo && cur < hi) { if (ran) xcd_barrier(bar, wave_s); ran = true;
#define PHASE_END   } ++cur;

    if (blockIdx.x == 0 && threadIdx.x < 22) ((const float**)(ws + WS_PTRS))[threadIdx.x] = (threadIdx.x < 21) ? a.in[threadIdx.x] : (const float*)a.out;
#define XL ((float*)(GAS float*)(F.inq[21]))
#define XC ((float*)(F.ws + WS_XC))
#define H ((bf16_t*)(F.ws + WS_H))
#define MIX ((bf16_t*)(F.ws + WS_MIX))
#define BIG0 ((bf16_t*)(F.ws + WS_BIG0))
#define BIG1 ((bf16_t*)(F.ws + WS_BIG1))
#define GATES ((float*)(F.ws + WS_GATES))
#define AFF ((float*)(F.ws + WS_AFF))
#define INV ((int*)(F.ws + WS_INV))
#define SLROW ((int*)(F.ws + WS_SLROW))
#define SLG ((float*)(F.ws + WS_SLG))
#define IN(k) ((const float*)(GAS const float*)(F.inq[k]))

    PHASE_BEGIN if (PH_ON(0)) for (int rep_ = 0; rep_ < (REP_ON(0) ? 2 : 1); ++rep_) { if (rep_) xcd_barrier(bar, wave_s); Frame F = make_frame(lds_gen, a.ws, wave_s); p0_prologue(F, a.in, F.ws); } PHASE_END

    for (int layer = 0; layer < DEPTH; ++layer) {
        const bool last = (layer == DEPTH - 1); const int j = layer >> 1;
#define modv ((const float*)(F.ws + WS_MODV) + (size_t)layer * NMI * 6 * D)
#define xLs ((layer == 0) ? IN(0) : (const float*)XL)
#define xCs ((layer == 0) ? IN(2) : (const float*)XC)
        if ((layer & 1) == 0) {
            if (layer == 0) { PHASE_BEGIN if (PH_ON(1)) for (int rep_ = 0; rep_ < (REP_ON(1) ? 2 : 1); ++rep_) { if (rep_) xcd_barrier(bar, wave_s); Frame F = make_frame(lds_gen, a.ws, wave_s); norm_pass<1>(F, xLs, xCs, RT, IN(6) + layer * D, modv + 0 * D, modv + 1 * D, H, IN(8) + (size_t)j * D * MW_IN + 3072, MW_IN, IN(9) + j * 16, GATES); } PHASE_END }
            PHASE_BEGIN if (PH_ON(2)) for (int rep_ = 0; rep_ < (REP_ON(2) ? 2 : 1); ++rep_) { if (rep_) xcd_barrier(bar, wave_s); Frame F = make_frame(lds_gen, a.ws, wave_s); { pg8::PlainSched S{(const char*)H, (const char*)((bf16_t*)(F.ws + WS_WMI) + (size_t)j * 3072 * D), RT / 256, 12, D, F.G, F.bid};
                pg8::EpiBf16 E{BIG0, 3072, 2, 0.08838834764831845f}; pg8::gemm_phase(F.lds, F.tid, D, S, E); moe_weights(F, IN(17) + (size_t)layer * NE * D * D, IN(18) + (size_t)layer * NE * D * D, IN(19) + (size_t)layer * NE * D * D, F.ws, (unsigned*)(F.ws + WS_CNT) + 16 * layer); } } PHASE_END
            PHASE_BEGIN if (PH_ON(3)) for (int rep_ = 0; rep_ < (REP_ON(3) ? 2 : 1); ++rep_) { if (rep_) xcd_barrier(bar, wave_s); Frame F = make_frame(lds_gen, a.ws, wave_s); for (int u = F.vcu; u < 256; u += F.G) { const int half = u & 1, dir = (u >> 1) & 1, hd = (u >> 2) & 3, b = u >> 4;
                mls::mlstm_unit(F, b, hd, dir, half, BIG0, GATES, dir ? MIX : H); } } PHASE_END
            PHASE_BEGIN if (PH_ON(4)) for (int rep_ = 0; rep_ < (REP_ON(4) ? 2 : 1); ++rep_) { if (rep_) xcd_barrier(bar, wave_s); Frame F = make_frame(lds_gen, a.ws, wave_s); mlstm_readout(F, H, MIX, BIG0, IN(10) + j * D, MIX); } PHASE_END
            PHASE_BEGIN if (PH_ON(5)) for (int rep_ = 0; rep_ < (REP_ON(5) ? 2 : 1); ++rep_) { if (rep_) xcd_barrier(bar, wave_s); Frame F = make_frame(lds_gen, a.ws, wave_s); { pg8::PlainSched S{(const char*)MIX, (const char*)((bf16_t*)(F.ws + WS_WMO) + (size_t)j * D * D), RT / 256, 4, D, F.G, F.bid};
                pg8::EpiResid E{xLs, xCs, XL, XC, modv + 2 * D}; pg8::gemm_phase(F.lds, F.tid, D, S, E); moe_weights(F, IN(17) + (size_t)layer * NE * D * D, IN(18) + (size_t)layer * NE * D * D, IN(19) + (size_t)layer * NE * D * D, F.ws, (unsigned*)(F.ws + WS_CNT) + 16 * layer); } } PHASE_END
        } else {
#define KALL BIG1
#define VALL (BIG1 + (size_t)NB * KVLEN * 256)
            PHASE_BEGIN if (PH_ON(7)) for (int rep_ = 0; rep_ < (REP_ON(7) ? 2 : 1); ++rep_) { if (rep_) xcd_barrier(bar, wave_s); Frame F = make_frame(lds_gen, a.ws, wave_s); { pg8::PlainSched S{(const char*)H, (const char*)((bf16_t*)(F.ws + WS_WAI) + (size_t)j * 1536 * D), RT / 256, 6, D, F.G, F.bid};
                pg8::EpiBf16 E{BIG0, 1536, 0, 1.f}; pg8::gemm_phase(F.lds, F.tid, D, S, E); moe_weights(F, IN(17) + (size_t)layer * NE * D * D, IN(18) + (size_t)layer * NE * D * D, IN(19) + (size_t)layer * NE * D * D, F.ws, (unsigned*)(F.ws + WS_CNT) + 16 * layer); } } PHASE_END
            PHASE_BEGIN if (PH_ON(8)) for (int rep_ = 0; rep_ < (REP_ON(8) ? 2 : 1); ++rep_) { if (rep_) xcd_barrier(bar, wave_s); Frame F = make_frame(lds_gen, a.ws, wave_s); qk_pass(F, BIG0, IN(13) + j * 64, IN(14) + j * 64, (const float*)(F.ws + WS_ROPE), (const float*)(F.ws + WS_ROPE) + SEQ * 32, KALL, VALL); } PHASE_END
            PHASE_BEGIN if (PH_ON(9)) for (int rep_ = 0; rep_ < (REP_ON(9) ? 2 : 1); ++rep_) { if (rep_) xcd_barrier(bar, wave_s); Frame F = make_frame(lds_gen, a.ws, wave_s); { const int nun = last ? 4096 : 4096 + 256;
                float mfix; { float gq = fabsf(IN(13)[j * 64 + F.lane]), gk = fabsf(IN(14)[j * 64 + F.lane]);
#pragma unroll
                    for (int o = 1; o < 64; o <<= 1) { gq = fmaxf(gq, __shfl_xor(gq, o)); gk = fmaxf(gk, __shfl_xor(gk, o)); }
                    mfix = attn_body::C2 * 64.f * gq * gk; }
                for (int L = F.vcu; L < nun; L += F.G) {
                    const bool isc = L >= 4096; const int Lc = L - 4096;
                    const int grp = L >> 6, wi = L & 63;
                    const int b = isc ? (Lc >> 4) : (grp >> 2), hq = isc ? (Lc & 15) : ((grp & 3) * 4 + (wi >> 4));
                    const size_t row0 = isc ? ((size_t)RL + b * CTXL) : ((size_t)b * SEQ + (wi & 15) * 256);
                    const bf16_t* qp = BIG0 + row0 * 1536 + hq * 64; const bf16_t* kp = KALL + (size_t)b * KVLEN * 256 + (hq >> 2) * 64; const bf16_t* vp = VALL + (size_t)b * KVLEN * 256 + (hq >> 2) * 64; bf16_t* op = MIX + row0 * D + hq * 64;
                    if (isc) attn_body::attn_unit<8>(qp, 1536, kp, vp, 256, CTXL / 64, op, D, (char*)lds_gen, F.tid, mfix);
                    else     attn_body::attn_unit<8>(qp, 1536, kp, vp, 256, KVLEN / 64, op, D, (char*)lds_gen, F.tid, mfix); } } } PHASE_END
            PHASE_BEGIN if (PH_ON(10)) for (int rep_ = 0; rep_ < (REP_ON(10) ? 2 : 1); ++rep_) { if (rep_) xcd_barrier(bar, wave_s); Frame F = make_frame(lds_gen, a.ws, wave_s); { pg8::PlainSched S{(const char*)MIX, (const char*)((bf16_t*)(F.ws + WS_WAO) + (size_t)j * D * D), (last ? RL : RT) / 256, 4, D, F.G, F.bid};
                pg8::EpiResid E{xLs, xCs, XL, XC, modv + 2 * D}; pg8::gemm_phase(F.lds, F.tid, D, S, E); moe_weights(F, IN(17) + (size_t)layer * NE * D * D, IN(18) + (size_t)layer * NE * D * D, IN(19) + (size_t)layer * NE * D * D, F.ws, (unsigned*)(F.ws + WS_CNT) + 16 * layer); } } PHASE_END
        }
        const int nrows = last ? RL : RT;
        PHASE_BEGIN if (PH_ON(11)) for (int rep_ = 0; rep_ < (REP_ON(11) ? 2 : 1); ++rep_) { if (rep_) xcd_barrier(bar, wave_s); Frame F = make_frame(lds_gen, a.ws, wave_s); moe_weights(F, IN(17) + (size_t)layer * NE * D * D, IN(18) + (size_t)layer * NE * D * D, IN(19) + (size_t)layer * NE * D * D, F.ws, (unsigned*)(F.ws + WS_CNT) + 16 * layer);
            norm_pass<2, MOE_FP8_1 != 0>(F, XL, XC, nrows, IN(7) + layer * D, modv + 3 * D, modv + 4 * D, H, IN(16) + (size_t)layer * D * 16, 16, nullptr, AFF); } PHASE_END
        PHASE_BEGIN if (PH_ON(12)) for (int rep_ = 0; rep_ < (REP_ON(12) ? 2 : 1); ++rep_) { if (rep_) xcd_barrier(bar, wave_s); Frame F = make_frame(lds_gen, a.ws, wave_s); moe_select(F, AFF, INV, SLROW, SLG, last ? NB * NE : 2 * NB * NE); } PHASE_END
        PHASE_BEGIN if (PH_ON(14)) for (int rep_ = 0; rep_ < (REP_ON(14) ? 2 : 1); ++rep_) { if (rep_) xcd_barrier(bar, wave_s); Frame F = make_frame(lds_gen, a.ws, wave_s); { constexpr int K1 = MOE_FP8_1 ? D / 2 : D;
            pg8::MoeSched S{(const char*)H, (const char*)(F.ws + WS_W1), last ? 32 : 34, 8, K1, 2048, F.G, F.bid};
            pg8::EpiSwiglu E{(void*)BIG1, MOE_FP8_1 ? 1.f / (FP8_SH * FP8_SW) : 1.f, MOE_FP8_2 != 0}; pg8::gemm_phase<pg8::EpiSwiglu, pg8::MoeSched, true, MOE_FP8_1 != 0>(F.lds, F.tid, K1, S, E, SLROW); } } PHASE_END
        PHASE_BEGIN if (PH_ON(15)) for (int rep_ = 0; rep_ < (REP_ON(15) ? 2 : 1); ++rep_) { if (rep_) xcd_barrier(bar, wave_s); Frame F = make_frame(lds_gen, a.ws, wave_s); { constexpr int K2 = MOE_FP8_2 ? D / 2 : D;
            pg8::MoeSched S{(const char*)BIG1, (const char*)(F.ws + WS_W2), last ? 32 : 34, 4, K2, 1024, F.G, F.bid};
            pg8::EpiRowScale E{BIG0, SLG, MOE_FP8_2 ? 1.f / (FP8_SA * FP8_SW) : 1.f}; pg8::gemm_phase<pg8::EpiRowScale, pg8::MoeSched, false, MOE_FP8_2 != 0>(F.lds, F.tid, K2, S, E); } } PHASE_END
        PHASE_BEGIN if (PH_ON(16)) for (int rep_ = 0; rep_ < (REP_ON(16) ? 2 : 1); ++rep_) { if (rep_) xcd_barrier(bar, wave_s); Frame F = make_frame(lds_gen, a.ws, wave_s);
            const int nl = layer + 1; const float* modn = (const float*)(F.ws + WS_MODV) + (size_t)nl * NMI * 6 * D;
            if (last) combine_norm<3>(F, BIG0, INV, XL, XC, modv + 5 * D, RL, IN(20), nullptr, nullptr, nullptr, nullptr, 0, nullptr, nullptr);
            else if (nl & 1) combine_norm<0>(F, BIG0, INV, XL, XC, modv + 5 * D, RT, IN(6) + nl * D, modn + 0 * D, modn + 1 * D, H, nullptr, 0, nullptr, nullptr);
            else combine_norm<1>(F, BIG0, INV, XL, XC, modv + 5 * D, RT, IN(6) + nl * D, modn + 0 * D, modn + 1 * D, H, IN(8) + (size_t)(nl >> 1) * D * MW_IN + 3072, MW_IN, IN(9) + (nl >> 1) * 16, GATES); } PHASE_END
    }
#undef XL
#undef XC
#undef H
#undef MIX
#undef BIG0
#undef BIG1
#undef GATES
#undef AFF
#undef INV
#undef SLROW
#undef SLG
#undef IN
#undef modv
#undef xLs
#undef xCs
#undef KALL
#undef VALL
#undef PHASE_BEGIN
#undef PHASE_END
}

extern "C" void kernel_launch(void* const* d_in, const int* in_sizes, int n_in, void* d_out, int out_size, void* d_ws, size_t ws_size, hipStream_t stream) {
    static int grid = 0;
    if (grid == 0) {
        if (n_in != 21 || out_size != RL * D || ws_size < WS_END) { fprintf(stderr, "kernel_launch: unexpected shapes: n_in %d out %d ws %zu (need %zu)\n", n_in, out_size, ws_size, (size_t)WS_END); grid = -1; return; }
        int dev = 0, cus = 0, per_cu = 0;
        if (hipGetDevice(&dev) != hipSuccess || hipDeviceGetAttribute(&cus, hipDeviceAttributeMultiprocessorCount, dev) != hipSuccess) { grid = -1; return; }
        if (hipFuncSetAttribute((const void*)fwd, hipFuncAttributeMaxDynamicSharedMemorySize, LDS_TOTAL) != hipSuccess) { fprintf(stderr, "kernel_launch: hipFuncSetAttribute failed\n"); grid = -1; return; }
        if (hipOccupancyMaxActiveBlocksPerMultiprocessor(&per_cu, (const void*)fwd, NTHREADS, LDS_TOTAL) != hipSuccess || per_cu < 1) fprintf(stderr, "kernel_launch: occupancy query says %d\n", per_cu);
        (void)hipGetLastError();
        grid = cus;
    }
    if (grid < 0) return;
    (void)in_sizes;
    if (hipMemsetAsync((char*)d_ws + WS_CTL, 0, CTL_BYTES, stream) != hipSuccess) return;
    Args a{};
    for (int i = 0; i < 21; ++i) a.in[i] = (const float*)d_in[i];
    a.out = (float*)d_out; a.ws = (unsigned char*)d_ws;
    const int nph = N_PHASES < PH_LIMIT ? N_PHASES : PH_LIMIT;
#if N_LAUNCH_SPLIT
    for (int p = 0; p < nph; ++p) { a.ph_lo = p; a.ph_hi = p + 1; hipLaunchKernelGGL(fwd, dim3(grid), dim3(NTHREADS), LDS_TOTAL, stream, a); }
#else
    a.ph_lo = 0; a.ph_hi = nph;
    hipLaunchKernelGGL(fwd, dim3(grid), dim3(NTHREADS), LDS_TOTAL, stream, a);
#endif
    const hipError_t le = hipPeekAtLastError();
    if (le != hipSuccess) fprintf(stderr, "kernel_launch: launch failed: %s\n", hipGetErrorName(le));
}
```

```cpp
#include <hip/hip_runtime.h>
#include <cstdio>
#include <cstdint>

#define GAS __attribute__((address_space(1)))
#define LAS __attribute__((address_space(3)))
typedef unsigned short bf16_t;
typedef short bf16x8 __attribute__((ext_vector_type(8)));
typedef short s16x4 __attribute__((ext_vector_type(4)));
typedef float f32x4 __attribute__((ext_vector_type(4)));
typedef float f32x2 __attribute__((ext_vector_type(2)));
typedef float f32x16 __attribute__((ext_vector_type(16)));
typedef unsigned u32x4 __attribute__((ext_vector_type(4)));
typedef unsigned u32x2 __attribute__((ext_vector_type(2)));

constexpr int D = 1024, NB = 16, SEQ = 4096, CTXL = 256, DEPTH = 4;
constexpr int RL = NB * SEQ, RC = NB * CTXL, RT = RL + RC;
constexpr int NE = 16, CAP_L = 512, CAP_C = 32, SLOTS_E = NB * CAP_L + NB * CAP_C;
constexpr int NMI = NB + 1;
constexpr int MW_IN = 3088;
constexpr int KVLEN = CTXL + SEQ;
constexpr int NWAVES = 8, NTHREADS = 512;
constexpr float NORM_EPS = 1e-6f;

constexpr size_t al256(size_t x) { return (x + 255) & ~(size_t)255; }
constexpr size_t WS_CTL   = 0;
constexpr size_t CTL_BYTES = 16384;
constexpr size_t WS_CNT   = WS_CTL + 14336;
constexpr size_t WS_PTRS  = WS_CTL + CTL_BYTES;
constexpr size_t WS_MODV  = WS_PTRS + 256;
constexpr size_t WS_ROPE  = al256(WS_MODV + (size_t)DEPTH * NMI * 6 * D * 4);
constexpr size_t WS_X16   = al256(WS_ROPE + (size_t)2 * SEQ * 32 * 4);
constexpr size_t WS_GATES = al256(WS_X16 + (size_t)RT * D * 2);
constexpr size_t WS_AFF   = al256(WS_GATES + (size_t)RT * 16 * 4);
constexpr size_t WS_INV   = al256(WS_AFF + (size_t)RT * 16 * 4);
constexpr size_t WS_SLROW = al256(WS_INV + (size_t)RT * 16 * 4);
constexpr size_t WS_SLG   = al256(WS_SLROW + (size_t)NE * SLOTS_E * 4);
constexpr size_t WS_WMI   = al256(WS_SLG + (size_t)NE * SLOTS_E * 4);
constexpr size_t WS_WMO   = al256(WS_WMI + (size_t)2 * 3072 * D * 2);
constexpr size_t WS_WAI   = al256(WS_WMO + (size_t)2 * D * D * 2);
constexpr size_t WS_WAO   = al256(WS_WAI + (size_t)2 * 1536 * D * 2);
constexpr size_t WS_W1    = al256(WS_WAO + (size_t)2 * D * D * 2);
constexpr size_t WS_W2    = al256(WS_W1 + (size_t)NE * 2048 * D * 2);
constexpr size_t WS_H     = al256(WS_W2 + (size_t)NE * D * D * 2);
constexpr size_t WS_MIX   = al256(WS_H + (size_t)RT * D * 2);
constexpr size_t WS_BIG0  = al256(WS_MIX + (size_t)RT * D * 2);
constexpr size_t BIG_HALF = (size_t)NE * SLOTS_E * D * 2;
constexpr size_t WS_BIG1  = al256(WS_BIG0 + BIG_HALF);
constexpr size_t WS_END   = al256(WS_BIG1 + BIG_HALF);
static_assert((size_t)RT * 3072 * 2 <= 2 * BIG_HALF, "qkvo fits");

#define LDS_WAIT() asm volatile("s_waitcnt lgkmcnt(0)" ::: "memory")
#define VM_WAIT() asm volatile("s_waitcnt vmcnt(0)" ::: "memory")
typedef __bf16 bf16x2_t __attribute__((ext_vector_type(2)));
__device__ __forceinline__ unsigned pk2(float lo, float hi) { f32x2 v = {lo, hi}; bf16x2_t b = __builtin_convertvector(v, bf16x2_t); return __builtin_bit_cast(unsigned, b); }
__device__ __forceinline__ unsigned f2bf(float f) { return pk2(f, f) & 0xffffu; }
__device__ __forceinline__ float bf_lo(unsigned u) { return __builtin_bit_cast(float, u << 16); }
__device__ __forceinline__ float bf_hi(unsigned u) { return __builtin_bit_cast(float, u & 0xffff0000u); }
__device__ __forceinline__ float bf2f(bf16_t b) { return __builtin_bit_cast(float, ((unsigned)b) << 16); }
__device__ __forceinline__ unsigned pk_fp8x4(float a, float b, float c, float d) {
    a = __builtin_amdgcn_fmed3f(a, -448.f, 448.f); b = __builtin_amdgcn_fmed3f(b, -448.f, 448.f); c = __builtin_amdgcn_fmed3f(c, -448.f, 448.f); d = __builtin_amdgcn_fmed3f(d, -448.f, 448.f);
    int p = __builtin_amdgcn_cvt_pk_fp8_f32(a, b, 0, false); p = __builtin_amdgcn_cvt_pk_fp8_f32(c, d, p, true); return (unsigned)p; }
#ifndef MOE_FP8_1
#define MOE_FP8_1 1
#endif
#ifndef MOE_FP8_2
#define MOE_FP8_2 1
#endif
constexpr float FP8_SH = 16.f, FP8_SW = 512.f, FP8_SA = 8.f;
template <int CTRL> __device__ __forceinline__ float dpp_f(float old, float v) { return __builtin_bit_cast(float, __builtin_amdgcn_update_dpp(__builtin_bit_cast(int, old), __builtin_bit_cast(int, v), CTRL, 0xf, 0xf, false)); }
__device__ __forceinline__ float rdlane(float v, int l) { return __builtin_bit_cast(float, __builtin_amdgcn_readlane(__builtin_bit_cast(int, v), l)); }
__device__ __forceinline__ float row16_sum(float v) {
    v += dpp_f<0xB1>(0.f, v); v += dpp_f<0x4E>(0.f, v); v += dpp_f<0x141>(0.f, v); v += dpp_f<0x140>(0.f, v); return v; }
__device__ __forceinline__ float oct_sum(float v) {
    v += dpp_f<0xB1>(0.f, v); v += dpp_f<0x4E>(0.f, v); v += dpp_f<0x141>(0.f, v); return v; }
__device__ __forceinline__ float quad_sum(float v) { v += dpp_f<0xB1>(0.f, v); v += dpp_f<0x4E>(0.f, v); return v; }
__device__ __forceinline__ float wave_sum(float v) {
    v = row16_sum(v); return (rdlane(v, 0) + rdlane(v, 16)) + (rdlane(v, 32) + rdlane(v, 48)); }
__device__ __forceinline__ float wave_scan_add(float v, int lane) {
    v += dpp_f<0x111>(0.f, v); v += dpp_f<0x112>(0.f, v); v += dpp_f<0x114>(0.f, v); v += dpp_f<0x118>(0.f, v);
    const float t0 = rdlane(v, 15), t1 = rdlane(v, 31), t2 = rdlane(v, 47);
    const int row = lane >> 4; return v + (row == 0 ? 0.f : row == 1 ? t0 : row == 2 ? t0 + t1 : (t0 + t1) + t2); }
__device__ __forceinline__ float wave_scan_max(float v, int lane) {
    const float NI = -INFINITY;
    v = fmaxf(v, dpp_f<0x111>(NI, v)); v = fmaxf(v, dpp_f<0x112>(NI, v)); v = fmaxf(v, dpp_f<0x114>(NI, v)); v = fmaxf(v, dpp_f<0x118>(NI, v));
    const float t0 = rdlane(v, 15), t1 = rdlane(v, 31), t2 = rdlane(v, 47);
    const int row = lane >> 4; return fmaxf(v, row == 0 ? NI : row == 1 ? t0 : row == 2 ? fmaxf(t0, t1) : fmaxf(fmaxf(t0, t1), t2)); }
__device__ __forceinline__ float fast_exp(float x) { return __builtin_amdgcn_exp2f(x * 1.4426950408889634f); }
__device__ __forceinline__ float fast_rcp(float x) { return __builtin_amdgcn_rcpf(x); }
__device__ __forceinline__ float silu_f(float x) { return x / (1.f + __expf(-x)); }

#define XB_TMO      128
#define XB_XCNT(j)  (256  + 64 * (j))
#define XB_XSUB(j)  (1280 + 64 * (j))
#define XB_XGEN(j)  (2304 + 64 * (j))
#define XB_TOP      3328
#define XB_TOPGEN   3392
#define XCD_BAR_WORDS 3456
#define XB_SPIN_CAP (1u << 21)
static_assert(XCD_BAR_WORDS * 4 <= CTL_BYTES, "ctl");

__device__ __forceinline__ unsigned xb_ld(unsigned* p)              { return __hip_atomic_load(p, __ATOMIC_RELAXED, __HIP_MEMORY_SCOPE_AGENT); }
__device__ __forceinline__ unsigned xb_add(unsigned* p, unsigned v) { return __hip_atomic_fetch_add(p, v, __ATOMIC_RELAXED, __HIP_MEMORY_SCOPE_AGENT); }
__device__ __forceinline__ unsigned xb_xcc_id() { return (unsigned)__builtin_amdgcn_s_getreg((3 << 11) | 20) & 0xFu; }
#define XB_SPIN(cond, bar) do { unsigned _sp = 0; while (cond) { __builtin_amdgcn_s_sleep(1); \
    if ((++_sp & 255u) == 0u) { if (xb_ld(&(bar)[XB_TMO])) break; if (_sp > XB_SPIN_CAP) { atomicAdd(&(bar)[XB_TMO], 1u); break; } } } } while (0)

struct XcdBarrier { unsigned* bar; unsigned x; volatile LAS unsigned* st; };

__device__ __forceinline__ XcdBarrier xcd_barrier_post(unsigned* bar, volatile LAS unsigned* st) {
    XcdBarrier b; b.bar = bar; b.x = xb_xcc_id(); b.st = st;
    if (threadIdx.x == 0) (void)xb_add(&bar[XB_XCNT(b.x)], 1u);
    return b;
}
__device__ __forceinline__ void xcd_barrier_complete(unsigned* bar, unsigned x, unsigned& nloc, unsigned& nx) {
    const unsigned G = gridDim.x * gridDim.y * gridDim.z;
    unsigned sum, cnt, mine, sp = 0u;
    for (;;) {
        sum = 0u; cnt = 0u; mine = 0u;
#pragma unroll
        for (unsigned j = 0; j < 16; ++j) { const unsigned c = xb_ld(&bar[XB_XCNT(j)]); sum += c; cnt += (c > 0u) ? 1u : 0u; mine = (j == x) ? c : mine; }
        if (sum == G) break;
        __builtin_amdgcn_s_sleep(1);
        if ((++sp & 255u) == 0u) { if (xb_ld(&bar[XB_TMO])) break; if (sp > XB_SPIN_CAP) { atomicAdd(&bar[XB_TMO], 1u); break; } }
    }
    nloc = mine > 0u ? mine : 1u; nx = cnt > 0u ? cnt : 1u;
}
__device__ __forceinline__ void xcd_barrier(const XcdBarrier& b, const int wave_s) {
    asm volatile("s_waitcnt vmcnt(0)" ::: "memory");
    __syncthreads();
    int ln_; asm volatile("v_mbcnt_lo_u32_b32 %0, -1, 0\n\tv_mbcnt_hi_u32_b32 %0, -1, %0" : "=v"(ln_));
    if (wave_s == 0 && ln_ == 0) {
        unsigned* bar = b.bar;
        __builtin_amdgcn_s_waitcnt(0);
        unsigned nloc = b.st[0], nx = b.st[1];
        if (nloc == 0u) { xcd_barrier_complete(bar, b.x, nloc, nx); b.st[0] = nloc; b.st[1] = nx; }
        const unsigned old = xb_add(&bar[XB_XSUB(b.x)], 1u);
        const unsigned gen = old / nloc;
        if (old + 1u == (gen + 1u) * nloc) {
            __builtin_amdgcn_fence(__ATOMIC_RELEASE, "agent");
            asm volatile("s_waitcnt vmcnt(0)" ::: "memory");
            const unsigned og = xb_add(&bar[XB_TOP], 1u);
            const unsigned tg = og / nx;
            if (og + 1u == (tg + 1u) * nx) xb_add(&bar[XB_TOPGEN], 1u);
            else XB_SPIN(xb_ld(&bar[XB_TOPGEN]) == tg, bar);
            __builtin_amdgcn_fence(__ATOMIC_ACQUIRE, "agent");
            xb_add(&bar[XB_XGEN(b.x)], 1u);
            asm volatile("s_waitcnt vmcnt(0)" ::: "memory");
        } else {
            XB_SPIN(xb_ld(&bar[XB_XGEN(b.x)]) == gen, bar);
            __builtin_amdgcn_fence(__ATOMIC_ACQUIRE, "agent");
            asm volatile("s_waitcnt vmcnt(0)" ::: "memory");
        }
    }
    __syncthreads();
}
namespace pg8 {
constexpr int BM = 256, BK = 64, HALF = 128, HTB = HALF * BK * 2, STAGE_BYTES = 8 * HTB, NXCD = 8, WGM = 4;

__host__ __device__ __forceinline__ int lds_byte(int r, int c) { const int st = (r >> 4) * 2 + (c >> 5), rr = r & 15, cc = c & 31, ob = rr * 64 + cc * 2; return st * 1024 + (ob ^ (((ob >> 9) & 1) << 5)); }
__host__ __device__ __forceinline__ void stage_rc(int b, int& R, int& C) { const int st = b / 1024, sb = b % 1024, swz = sb ^ (((sb >> 9) & 1) << 5); R = (st >> 1) * 16 + swz / 64; C = (st & 1) * 32 + (swz % 64) / 2; }
__host__ __device__ __forceinline__ int perm32(int rho) { const int n = rho >> 4, i = rho & 15; return 8 * (i >> 2) + 4 * n + (i & 3); }

struct Unit { const char* A; const char* B; int pm, pn; };

__device__ __forceinline__ bool static_tile(int i, int G, int c, int nM, int nN, int& pm, int& pn) {
    const int nwg = nM * nN; const long L = (long)i * G + c; if (L >= nwg) return false;
    int wgid = (int)L; { const int q = nwg / NXCD, r = nwg % NXCD, xcd = wgid % NXCD, off = wgid / NXCD; wgid = (xcd < r ? xcd * (q + 1) : r * (q + 1) + (xcd - r) * q) + off; }
    const int nig = WGM * nN, gid = wgid / nig, fm = gid * WGM, gsz = (nM - fm) < WGM ? (nM - fm) : WGM;
    pm = fm + ((wgid % nig) % gsz); pn = (wgid % nig) / gsz; return true;
}
struct PlainSched {
    const char* A; const char* Bt; int nM, nN, K, G, c;
    __device__ __forceinline__ bool next(int i, Unit& u) const {
        int pm, pn; if (!static_tile(i, G, c, nM, nN, pm, pn)) return false;
        u.pm = pm; u.pn = pn; u.A = A + (size_t)pm * 256 * K * 2; u.B = Bt + (size_t)pn * 256 * K * 2; return true;
    }
};
struct MoeSched {
    const char* A; const char* W; int tpe, nN, K, bN, G, c;
    __device__ __forceinline__ bool next(int i, Unit& u) const {
        int pm, pn; if (!static_tile(i, G, c, NE * tpe, nN, pm, pn)) return false;
        const int e = pm / tpe, rt = pm - e * tpe;
        u.pm = e * (SLOTS_E / 256) + rt; u.pn = pn;
        u.A = A + (size_t)u.pm * 256 * K * 2; u.B = W + ((size_t)e * bN + (size_t)pn * 256) * K * 2; return true;
    }
};

__device__ __forceinline__ unsigned cvt_pk_bf16(float lo, float hi) { return pk2(lo, hi); }


struct EpiBf16 {
    static constexpr bool PERM = true; static constexpr int NSTORE = 16;
    bf16_t* O; int ldc; int nscale; float scale;
    __device__ __forceinline__ void operator()(const f32x4 (&acc)[2][2][4][2], const Unit& u, int wr, int wc, int fr, int fq) const {
        const int row0 = u.pm * BM + wr * 64 + fr, col0 = u.pn * BM + wc * 32 + 8 * fq;
        const float s = (u.pn < nscale) ? scale : 1.f;
#pragma unroll
        for (int ai = 0; ai < 2; ++ai)
#pragma unroll
            for (int m = 0; m < 4; ++m) { bf16_t* rowp = O + (size_t)(row0 + ai * HALF + m * 16) * ldc + col0;
#pragma unroll
                for (int bj = 0; bj < 2; ++bj) { const f32x4 v0 = acc[ai][bj][m][0] * s, v1 = acc[ai][bj][m][1] * s;
                    u32x4 o; o.x = cvt_pk_bf16(v0[0], v0[1]); o.y = cvt_pk_bf16(v0[2], v0[3]); o.z = cvt_pk_bf16(v1[0], v1[1]); o.w = cvt_pk_bf16(v1[2], v1[3]);
                    *(u32x4*)(rowp + bj * HALF) = o; } }
    }
};
struct EpiResid {
    static constexpr bool PERM = true; static constexpr int NSTORE = 16;
    const float* srcL; const float* srcC; bf16_t* X16; const float* gate; bool f32src;
    __device__ __forceinline__ void operator()(const f32x4 (&acc)[2][2][4][2], const Unit& u, int wr, int wc, int fr, int fq) const {
        const bool isc = u.pm >= RL / 256;
        const int mi = isc ? NB : (u.pm >> 4);
        const int row0 = u.pm * BM + wr * 64 + fr, col0 = u.pn * BM + wc * 32 + 8 * fq;
        const float* gp = gate + (size_t)mi * 6 * D + col0;
        f32x4 gv[2][2];
#pragma unroll
        for (int bj = 0; bj < 2; ++bj)
#pragma unroll
            for (int n = 0; n < 2; ++n) gv[bj][n] = *(const f32x4*)(gp + bj * HALF + n * 4);
#pragma unroll
        for (int ai = 0; ai < 2; ++ai)
#pragma unroll
            for (int m = 0; m < 4; ++m) { const int row = row0 + ai * HALF + m * 16; bf16_t* xp = X16 + (size_t)row * D + col0;
                const float* sp = isc ? (srcC + (size_t)(row - RL) * D + col0) : (srcL + (size_t)row * D + col0);
#pragma unroll
                for (int bj = 0; bj < 2; ++bj) { f32x4 x0, x1;
                    if (f32src) { x0 = *(const f32x4*)(sp + bj * HALF); x1 = *(const f32x4*)(sp + bj * HALF + 4); }
                    else { const u32x4 xu = *(const u32x4*)(xp + bj * HALF); x0 = (f32x4){bf_lo(xu.x), bf_hi(xu.x), bf_lo(xu.y), bf_hi(xu.y)}; x1 = (f32x4){bf_lo(xu.z), bf_hi(xu.z), bf_lo(xu.w), bf_hi(xu.w)}; }
                    const f32x4 v0 = x0 + gv[bj][0] * acc[ai][bj][m][0], v1 = x1 + gv[bj][1] * acc[ai][bj][m][1];
                    u32x4 o; o.x = cvt_pk_bf16(v0[0], v0[1]); o.y = cvt_pk_bf16(v0[2], v0[3]); o.z = cvt_pk_bf16(v1[0], v1[1]); o.w = cvt_pk_bf16(v1[2], v1[3]);
                    *(u32x4*)(xp + bj * HALF) = o; } }
    }
};
struct EpiSwiglu {
    static constexpr bool PERM = true; static constexpr int NSTORE = 8;
    void* O; float ds; bool f8out;
    __device__ __forceinline__ void operator()(const f32x4 (&acc)[2][2][4][2], const Unit& u, int wr, int wc, int fr, int fq) const {
        const int row0 = u.pm * BM + wr * 64 + fr, col0 = u.pn * HALF + wc * 32 + 8 * fq;
#pragma unroll
        for (int ai = 0; ai < 2; ++ai)
#pragma unroll
            for (int m = 0; m < 4; ++m) { const size_t ro = (size_t)(row0 + ai * HALF + m * 16) * D + col0;
                float r[8];
#pragma unroll
                for (int n = 0; n < 2; ++n)
#pragma unroll
                    for (int j = 0; j < 4; ++j) { const float g = acc[ai][0][m][n][j] * ds, up = acc[ai][1][m][n][j] * ds; r[n * 4 + j] = g * fast_rcp(1.f + fast_exp(-g)) * up; }
                if (f8out) { u32x2 o; o.x = pk_fp8x4(r[0] * FP8_SA, r[1] * FP8_SA, r[2] * FP8_SA, r[3] * FP8_SA); o.y = pk_fp8x4(r[4] * FP8_SA, r[5] * FP8_SA, r[6] * FP8_SA, r[7] * FP8_SA);
                    *(u32x2*)((unsigned char*)O + ro) = o; }
                else { u32x4 o; o.x = cvt_pk_bf16(r[0], r[1]); o.y = cvt_pk_bf16(r[2], r[3]); o.z = cvt_pk_bf16(r[4], r[5]); o.w = cvt_pk_bf16(r[6], r[7]);
                    *(u32x4*)((bf16_t*)O + ro) = o; } }
    }
};
struct EpiRowScale {
    static constexpr bool PERM = true; static constexpr int NSTORE = 16;
    bf16_t* O; const float* g; float ds;
    __device__ __forceinline__ void operator()(const f32x4 (&acc)[2][2][4][2], const Unit& u, int wr, int wc, int fr, int fq) const {
        const int row0 = u.pm * BM + wr * 64 + fr, col0 = u.pn * BM + wc * 32 + 8 * fq;
#pragma unroll
        for (int ai = 0; ai < 2; ++ai)
#pragma unroll
            for (int m = 0; m < 4; ++m) { const int row = row0 + ai * HALF + m * 16; const float s = g[row] * ds; bf16_t* rowp = O + (size_t)row * D + col0;
#pragma unroll
                for (int bj = 0; bj < 2; ++bj) { const f32x4 v0 = acc[ai][bj][m][0] * s, v1 = acc[ai][bj][m][1] * s;
                    u32x4 o; o.x = cvt_pk_bf16(v0[0], v0[1]); o.y = cvt_pk_bf16(v0[2], v0[3]); o.z = cvt_pk_bf16(v1[0], v1[1]); o.w = cvt_pk_bf16(v1[2], v1[3]);
                    *(u32x4*)(rowp + bj * HALF) = o; } }
    }
};

template <class Epi, class Sched, bool GATHER = false, bool FP8 = false>
__device__ __forceinline__ void gemm_phase(LAS unsigned char* lds, const int tid, const int K, const Sched& S, const Epi& E, const int* rowidx = nullptr) {
    const int wid = __builtin_amdgcn_readfirstlane(tid >> 6), lane = tid & 63, wr = wid >> 2, wc = wid & 3, fr = lane & 15, fq = lane >> 4;
    const int nt = K / BK;
    unsigned voffA[2], voffB[2]; int gR[2], gC[2];
#pragma unroll
    for (int i = 0; i < 2; ++i) { int R, C; stage_rc(tid * 16 + i * 8192, R, C); const int Rb = Epi::PERM ? ((R & ~31) + perm32(R & 31)) : R;
        voffA[i] = (unsigned)(R * K + C) * 2u; voffB[i] = (unsigned)(Rb * K + C) * 2u; gR[i] = R; gC[i] = C * 2; }
    unsigned gcur[2][2], gnxt[2][2];
#define PG8_GIDX(dst, unit) do { if (GATHER) { _Pragma("unroll") for (int h_ = 0; h_ < 2; ++h_) _Pragma("unroll") for (int i_ = 0; i_ < 2; ++i_) \
        dst[h_][i_] = (unsigned)rowidx[(unit).pm * 256 + h_ * 128 + gR[i_]] * (unsigned)(K * 2) + (unsigned)gC[i_]; } } while (0)
    const size_t kstep = (size_t)(BK * 2);
    const size_t hstep = (size_t)HALF * K * 2;
    const unsigned ldsw = (unsigned)wid * 1024u;
    const int aoff = lds_byte(wr * 64 + fr, fq * 8), boff = lds_byte(wc * 32 + fr, fq * 8);
#define PG8_SA(b, h) (((b) * 2 + (h)) * HTB)
#define PG8_SB(b, h) ((4 + (b) * 2 + (h)) * HTB)
#define PG8_STAGE(bufoff, gbase, voff) do { _Pragma("unroll") for (int _i = 0; _i < 2; ++_i) \
        __builtin_amdgcn_global_load_lds((const unsigned*)((const char*)(gbase) + (voff)[_i]), (LAS unsigned*)(lds + (bufoff) + ldsw + _i * 8192), 16, 0, 0); } while (0)
#define PG8_STAGE_A(b, h, gbase, NX) do { if (GATHER) { unsigned go_[2]; go_[0] = (NX) ? gnxt[h][0] : gcur[h][0]; go_[1] = (NX) ? gnxt[h][1] : gcur[h][1]; PG8_STAGE(PG8_SA(b, h), (gbase), go_); } \
        else { PG8_STAGE(PG8_SA(b, h), (gbase) + (h) * hstep, voffA); } } while (0)
#define PG8_LDA(dst, b, h) do { _Pragma("unroll") for (int m = 0; m < 4; ++m) _Pragma("unroll") for (int k = 0; k < 2; ++k) dst[m][k] = *(const LAS bf16x8*)(lds + PG8_SA(b, h) + aoff + m * 2048 + k * 1024); } while (0)
#define PG8_LDB(dst, b, h) do { _Pragma("unroll") for (int n = 0; n < 2; ++n) _Pragma("unroll") for (int k = 0; k < 2; ++k) dst[n][k] = *(const LAS bf16x8*)(lds + PG8_SB(b, h) + boff + n * 2048 + k * 1024); } while (0)
#define PG8_MMA(ai, bj, At, Bt) do { __builtin_amdgcn_s_setprio(1); if (FP8) { _Pragma("unroll") for (int m = 0; m < 4; ++m) _Pragma("unroll") for (int n = 0; n < 2; ++n) { \
            typedef int v8i_ __attribute__((ext_vector_type(8))); typedef int v4i_ __attribute__((ext_vector_type(4))); \
            const v4i_ b0_ = __builtin_bit_cast(v4i_, Bt[n][0]), b1_ = __builtin_bit_cast(v4i_, Bt[n][1]), a0_ = __builtin_bit_cast(v4i_, At[m][0]), a1_ = __builtin_bit_cast(v4i_, At[m][1]); \
            const v8i_ bb_ = {b0_[0], b0_[1], b0_[2], b0_[3], b1_[0], b1_[1], b1_[2], b1_[3]}, aa_ = {a0_[0], a0_[1], a0_[2], a0_[3], a1_[0], a1_[1], a1_[2], a1_[3]}; \
            asm volatile("v_mfma_scale_f32_16x16x128_f8f6f4 %0, %1, %2, %0, %3, %3 op_sel_hi:[0,0,0]" : "+v"(acc[ai][bj][m][n]) : "v"(bb_), "v"(aa_), "v"(sc127)); } } \
        else { _Pragma("unroll") for (int m = 0; m < 4; ++m) _Pragma("unroll") for (int n = 0; n < 2; ++n) _Pragma("unroll") for (int k = 0; k < 2; ++k) \
        acc[ai][bj][m][n] = __builtin_amdgcn_mfma_f32_16x16x32_bf16(Bt[n][k], At[m][k], acc[ai][bj][m][n], 0, 0, 0); } __builtin_amdgcn_s_setprio(0); } while (0)
#define PG8_WAIT_V(n) asm volatile("s_waitcnt vmcnt(" #n ")" ::: "memory")
#define PG8_WAIT_VE() do { if (Epi::NSTORE == 32) asm volatile("s_waitcnt vmcnt(40)" ::: "memory"); else if (Epi::NSTORE == 16) asm volatile("s_waitcnt vmcnt(24)" ::: "memory"); else asm volatile("s_waitcnt vmcnt(16)" ::: "memory"); } while (0)
#define PG8_WAIT_L(n) asm volatile("s_waitcnt lgkmcnt(" #n ")" ::: "memory")
#define PG8_BAR __builtin_amdgcn_s_barrier()
#define PG8_SCHED __builtin_amdgcn_sched_barrier(0)
    Unit cur, nxt; int ui = 0;
    if (!S.next(0, cur)) return;
    int sc127 = 0x7F7F7F7F; asm volatile("" : "+v"(sc127));
    f32x4 acc[2][2][4][2];
#pragma unroll
    for (int a = 0; a < 2; ++a)
#pragma unroll
        for (int b = 0; b < 2; ++b)
#pragma unroll
            for (int m = 0; m < 4; ++m)
#pragma unroll
                for (int n = 0; n < 2; ++n) acc[a][b][m][n] = (f32x4){0.f, 0.f, 0.f, 0.f};
    bf16x8 At[4][2], B0[2][2], B1[2][2];
    const char* cA = GATHER ? S.A : cur.A; const char* cB = cur.B;
    PG8_GIDX(gcur, cur);
    PG8_STAGE(PG8_SB(0, 0), cB, voffB); PG8_STAGE(PG8_SB(0, 1), cB + hstep, voffB); PG8_STAGE_A(0, 0, cA, false); PG8_STAGE_A(0, 1, cA, false);
    if (wr == 1) PG8_BAR;
    PG8_WAIT_V(2); PG8_BAR;
    PG8_STAGE(PG8_SB(1, 0), cB + kstep, voffB); PG8_STAGE_A(1, 0, cA + kstep, false); PG8_STAGE(PG8_SB(1, 1), cB + hstep + kstep, voffB);
    PG8_WAIT_V(6); PG8_BAR;
    for (;;) {
        const bool has_next = S.next(ui + 1, nxt);
        const char* nA = (has_next && !GATHER) ? nxt.A : cA; const char* nB = has_next ? nxt.B : cB;
        if (GATHER) { if (has_next) { PG8_GIDX(gnxt, nxt); } else { _Pragma("unroll") for (int h_ = 0; h_ < 2; ++h_) { gnxt[h_][0] = gcur[h_][0]; gnxt[h_][1] = gcur[h_][1]; } } }
#pragma unroll 1
        for (int t = 0; t < nt; t += 2) {
            const bool last = (t == nt - 2);
            const char* a1 = cA + (size_t)(t + 1) * kstep;
            const char* a2 = last ? nA : cA + (size_t)(t + 2) * kstep; const char* b2 = last ? nB : cB + (size_t)(t + 2) * kstep;
            const char* a3 = a2 + kstep; const char* b3 = b2 + kstep;
            PG8_LDB(B0, 0, 0); PG8_LDB(B1, 0, 1); PG8_SCHED; PG8_LDA(At, 0, 0); PG8_STAGE_A(1, 1, a1, false);
            PG8_WAIT_V(8); PG8_WAIT_L(0); PG8_BAR; PG8_MMA(0, 0, At, B0); PG8_MMA(0, 1, At, B1); PG8_BAR; PG8_SCHED;
            PG8_LDA(At, 0, 1); PG8_STAGE(PG8_SB(0, 0), b2, voffB); PG8_STAGE(PG8_SB(0, 1), b2 + hstep, voffB); PG8_STAGE_A(0, 0, a2, last);
            PG8_WAIT_V(8); PG8_WAIT_L(0); PG8_BAR; PG8_MMA(1, 0, At, B0); PG8_MMA(1, 1, At, B1); PG8_BAR; PG8_SCHED;
            PG8_LDB(B0, 1, 0); PG8_LDB(B1, 1, 1); PG8_SCHED; PG8_LDA(At, 1, 0); PG8_STAGE_A(0, 1, a2, last);
            PG8_WAIT_V(8); PG8_WAIT_L(0); PG8_BAR; PG8_MMA(0, 0, At, B0); PG8_MMA(0, 1, At, B1); PG8_BAR; PG8_SCHED;
            PG8_LDA(At, 1, 1); PG8_STAGE(PG8_SB(1, 0), b3, voffB); PG8_STAGE(PG8_SB(1, 1), b3 + hstep, voffB); PG8_STAGE_A(1, 0, a3, last);
            PG8_WAIT_V(8); PG8_WAIT_L(0); PG8_BAR; PG8_MMA(1, 0, At, B0); PG8_MMA(1, 1, At, B1); PG8_BAR; PG8_SCHED;
        }
        if (wr == 0) PG8_BAR;
        if (FP8) asm volatile("s_nop 15\n\ts_nop 15" ::: "memory");
        { int tz = tid; asm volatile("" : "+v"(tz));
          const int wid2 = __builtin_amdgcn_readfirstlane(tz >> 6), lane2 = tz & 63;
          E(acc, cur, wid2 >> 2, wid2 & 3, lane2 & 15, lane2 >> 4); }
        if (!has_next) break;
#pragma unroll
        for (int a = 0; a < 2; ++a)
#pragma unroll
            for (int b = 0; b < 2; ++b)
#pragma unroll
                for (int m = 0; m < 4; ++m)
#pragma unroll
                    for (int n = 0; n < 2; ++n) acc[a][b][m][n] = (f32x4){0.f, 0.f, 0.f, 0.f};
        cur = nxt; cA = nA; cB = nB; ++ui;
        if (GATHER) { _Pragma("unroll") for (int h_ = 0; h_ < 2; ++h_) { gcur[h_][0] = gnxt[h_][0]; gcur[h_][1] = gnxt[h_][1]; } }
        if (wr == 1) PG8_BAR;
    }
    PG8_WAIT_V(0);
    PG8_BAR;
#undef PG8_SA
#undef PG8_SB
#undef PG8_STAGE
#undef PG8_STAGE_A
#undef PG8_GIDX
#undef PG8_LDA
#undef PG8_LDB
#undef PG8_MMA
#undef PG8_WAIT_V
#undef PG8_WAIT_VE
#undef PG8_WAIT_L
#undef PG8_BAR
#undef PG8_SCHED
}
}
namespace attn_body {
constexpr int NW = 8, QBLK = 32, QB = QBLK * NW, KVBLK = 64;
__device__ __forceinline__ int crow(int r, int hi) { return (r & 3) + 8 * (r >> 2) + 4 * hi; }
#define SBAR() __builtin_amdgcn_sched_barrier(0)
constexpr int NSLOT = 3, SLOTB = 8192;
constexpr int LDS_K = 0, LDS_V = NSLOT * SLOTB, LDS_WS = 2 * NSLOT * SLOTB, LDS_OST = LDS_WS + NW * 64 * 4, LDS_BYTES = LDS_OST + NW * 4096;
constexpr float C2 = 0.125f * 1.4426950408889634f;
__device__ __forceinline__ void glds16(const void* gsrc, unsigned lds_dst) { unsigned keep;
  asm volatile("s_mov_b32 %0, m0\n\ts_mov_b32 m0, %2\n\ts_nop 0\n\tglobal_load_lds_dwordx4 %1, off\n\ts_mov_b32 m0, %0" : "=&s"(keep) : "v"(gsrc), "s"(lds_dst) : "memory"); }
__device__ __forceinline__ float max3f(float a, float b, float c) { float r; asm("v_max3_f32 %0, %1, %2, %3" : "=v"(r) : "v"(a), "v"(b), "v"(c)); return r; }
__device__ __forceinline__ float max2f(float a, float b) { float r; asm("v_max_f32_e32 %0, %1, %2" : "=v"(r) : "v"(a), "v"(b)); return r; }
__device__ __forceinline__ float fadd_s(float a, float b) { float r; asm("v_add_f32_e32 %0, %1, %2" : "=v"(r) : "v"(a), "v"(b)); return r; }
__device__ __forceinline__ float fsub_s(float a, float b) { float r; asm("v_sub_f32_e32 %0, %1, %2" : "=v"(r) : "v"(a), "v"(b)); return r; }
__device__ __forceinline__ unsigned cvtpk_s(float lo, float hi) { f32x2 v = {lo, hi}; bf16x2_t b = __builtin_convertvector(v, bf16x2_t); return __builtin_bit_cast(unsigned, b); }
#define WAIT_BAR(N) asm volatile("s_waitcnt vmcnt(" #N ") lgkmcnt(0)\n\ts_barrier" ::: "memory")

__device__ __forceinline__ void qkt(f32x16& p0, f32x16& p1, const char* Kslot, const bf16x8* qr, const f32x16& negm, int r32, int hi) {
  const char* kb = Kslot + hi * 1024 + r32 * 16;
  #pragma unroll
  for (int d0 = 0; d0 < 4; ++d0) {
    const bf16x8 b0 = *reinterpret_cast<const bf16x8*>(kb + d0 * 2048);
    const bf16x8 b1 = *reinterpret_cast<const bf16x8*>(kb + d0 * 2048 + 512);
    if (d0 == 0) { p0 = __builtin_amdgcn_mfma_f32_32x32x16_bf16(b0, qr[0], negm, 0, 0, 0); p1 = __builtin_amdgcn_mfma_f32_32x32x16_bf16(b1, qr[0], negm, 0, 0, 0); }
    else { p0 = __builtin_amdgcn_mfma_f32_32x32x16_bf16(b0, qr[d0], p0, 0, 0, 0); p1 = __builtin_amdgcn_mfma_f32_32x32x16_bf16(b1, qr[d0], p1, 0, 0, 0); } }
}
typedef __attribute__((address_space(3))) const char* lds_cptr;
typedef short v4i16_t __attribute__((ext_vector_type(4)));
__device__ __forceinline__ void kload8(bf16x8* kf, lds_cptr kp) {
  kf[0] = *(const LAS bf16x8*)(kp);        kf[1] = *(const LAS bf16x8*)(kp + 512);
  kf[2] = *(const LAS bf16x8*)(kp + 2048); kf[3] = *(const LAS bf16x8*)(kp + 2560);
  kf[4] = *(const LAS bf16x8*)(kp + 4096); kf[5] = *(const LAS bf16x8*)(kp + 4608);
  kf[6] = *(const LAS bf16x8*)(kp + 6144); kf[7] = *(const LAS bf16x8*)(kp + 6656);
}
__device__ __forceinline__ void kload2(bf16x8* kf, lds_cptr kp, int j) { kf[2 * j] = *(const LAS bf16x8*)(kp + j * 2048); kf[2 * j + 1] = *(const LAS bf16x8*)(kp + j * 2048 + 512); }
__device__ __forceinline__ s16x4 vtr(lds_cptr p) { return __builtin_bit_cast(s16x4, __builtin_amdgcn_ds_read_tr16_b64_v4i16((LAS v4i16_t*)p)); }
__device__ __forceinline__ float rowmax(const f32x16& p0, const f32x16& p1) {
  float a = max3f(p0[0], p0[1], p1[0]), b = max3f(p0[2], p0[3], p1[1]); a = max3f(a, p1[2], p1[3]);
  #pragma unroll
  for (int r = 4; r < 16; r += 4) { a = max3f(a, p0[r], p0[r + 1]); b = max3f(b, p0[r + 2], p0[r + 3]); a = max3f(a, p1[r], p1[r + 1]); b = max3f(b, p1[r + 2], p1[r + 3]); }
  const float m = max2f(a, b);
  auto rr = __builtin_amdgcn_permlane32_swap(__float_as_uint(m), __float_as_uint(m), false, false);
  return max2f(__uint_as_float(rr[0]), __uint_as_float(rr[1]));
}
__device__ __forceinline__ void pv(f32x16* o, int vb, bf16x8 pa0, bf16x8 pa1, bf16x8 pa2, bf16x8 pa3) {
  #pragma unroll
  for (int d0 = 0; d0 < 2; ++d0) { s16x4 lo[4], hi[4];
    #pragma unroll
    for (int ks = 0; ks < 4; ++ks) {
      asm volatile("ds_read_b64_tr_b16 %0,%1 offset:%c2" : "=&v"(lo[ks]) : "v"(vb), "i"(d0 * 4096 + ks * 1024) : "memory");
      asm volatile("ds_read_b64_tr_b16 %0,%1 offset:%c2" : "=&v"(hi[ks]) : "v"(vb), "i"(d0 * 4096 + ks * 1024 + 512) : "memory"); }
    asm volatile("s_waitcnt lgkmcnt(0)" ::: "memory"); SBAR();
    #define PK(k) (bf16x8){lo[k][0], lo[k][1], lo[k][2], lo[k][3], hi[k][0], hi[k][1], hi[k][2], hi[k][3]}
    o[d0] = __builtin_amdgcn_mfma_f32_32x32x16_bf16(pa0, PK(0), o[d0], 0, 0, 0);
    o[d0] = __builtin_amdgcn_mfma_f32_32x32x16_bf16(pa1, PK(1), o[d0], 0, 0, 0);
    o[d0] = __builtin_amdgcn_mfma_f32_32x32x16_bf16(pa2, PK(2), o[d0], 0, 0, 0);
    o[d0] = __builtin_amdgcn_mfma_f32_32x32x16_bf16(pa3, PK(3), o[d0], 0, 0, 0);
    #undef PK
  }
}

template <int THRL> __device__ __forceinline__ void attn_unit(const bf16_t* Qrow0, int QP, const bf16_t* __restrict__ Kh, const bf16_t* __restrict__ Vh, int KVP, int NT, bf16_t* Orow0, int OP, char* shm, const int tid, const float mfix) {
  const int lane = tid & 63, r32 = lane & 31, hi = lane >> 5; const int wid = __builtin_amdgcn_readfirstlane(tid >> 6);
  const bf16_t* Qw = Qrow0 + (long)(wid * QBLK) * QP;
  const unsigned lds0 = (unsigned)(uintptr_t)shm;
  float* wsf = (float*)(shm + LDS_WS) + wid * 64;
  const bf16_t* ksrc = Kh + (long)lane * KVP + wid * 8;
  const bf16_t* vsrc = Vh + (long)(16 * (wid & 3) + (lane >> 2)) * KVP + (wid >> 2) * 32 + (lane & 3) * 8;
  const unsigned kdst = lds0 + LDS_K + wid * 1024, vdst = lds0 + LDS_V + wid * 1024;
  #define DMA_K(t, slot) glds16(ksrc + (long)(t) * KVBLK * KVP, (unsigned)__builtin_amdgcn_readfirstlane(kdst + (slot)))
  #define DMA_V(t, slot) glds16(vsrc + (long)(t) * KVBLK * KVP, (unsigned)__builtin_amdgcn_readfirstlane(vdst + (slot)))
  const int vb0 = (int)(lds0 + LDS_V) + ((lane >> 4) & 1) * 32 + (lane & 3) * 8 + (4 * hi + ((lane & 15) >> 2)) * 64;
  const char* Kbase = shm + LDS_K; bf16x8 kf[8];
  const lds_cptr shm3 = (lds_cptr)shm; const lds_cptr kp0 = shm3 + LDS_K + hi * 1024 + r32 * 16; const lds_cptr vp0 = shm3 + LDS_V + ((lane >> 4) & 1) * 32 + (lane & 3) * 8 + (4 * hi + ((lane & 15) >> 2)) * 64;
  DMA_K(0, 0); DMA_V(0, 0); DMA_K(1, SLOTB);
  bf16x8 qr[4];
  #pragma unroll
  for (int d0 = 0; d0 < 4; ++d0) qr[d0] = *reinterpret_cast<const bf16x8*>(&Qw[(long)r32 * QP + d0 * 16 + hi * 8]);
  float l_reg = 0.f; f32x16 o[2]; o[0] = f32x16{}; o[1] = f32x16{}; const f32x16 negm = f32x16{}; (void)mfix;
  #define START(P0, P1) do { _Pragma("unroll") for (int r = 0; r < 16; ++r) P0[r] = __builtin_amdgcn_exp2f(P0[r]); } while (0)
  #define RESC() do { } while (0)
  f32x16 pA0, pA1, pB0, pB1;
  int sl_prev = 0, sl_cur = 0, sl_next = SLOTB;
  #define ROT() do { sl_prev = sl_cur; sl_cur = sl_next; sl_next = (sl_next == (NSLOT - 1) * SLOTB) ? 0 : sl_next + SLOTB; } while (0)
  DMA_K(2, 2 * SLOTB);
  WAIT_BAR(3);
  qkt(pA0, pA1, Kbase, qr, negm, r32, hi); asm volatile("s_nop 15\n\ts_nop 7" : "+v"(pA0), "+v"(pA1));
  START(pA0, pA1);
  _Pragma("unroll") for (int r = 0; r < 16; ++r) pA1[r] = __builtin_amdgcn_exp2f(pA1[r]);
  WAIT_BAR(0);
  DMA_K(3, 0); DMA_V(1, SLOTB);
  ROT();
  kload8(kf, kp0 + sl_cur);
  WAIT_BAR(2);
  s16x4 vlo[8], vhi[8]; u32x4 pw0, pw1, pw2, pw3;
  #define PKW(P, B) cvtpk_s(P[B], P[B + 1])
  #define PAF(k) __builtin_bit_cast(bf16x8, pw##k)
  #define VFR(i) (bf16x8){vlo[i][0], vlo[i][1], vlo[i][2], vlo[i][3], vhi[i][0], vhi[i][1], vhi[i][2], vhi[i][3]}
  #define PIN(x) asm volatile("" : "+v"(x))
  #define MX3(a, b, c) __builtin_fmaxf(__builtin_fmaxf((a), (b)), (c))
  #define GAPA(MF, A0, A1, A2, A3, W0, W1, PW) do { MF; sacc += A0; sacc += A1; sacc += A2; sacc += A3; PIN(sacc); W0; W1; PIN(PW); SBAR(); } while (0)
  #define EX(v) __builtin_amdgcn_exp2f(v)
  #define GAPB(MF, X, B) do { MF; X[B] = EX(X[B]); X[B + 1] = EX(X[B + 1]); X[B + 2] = EX(X[B + 2]); X[B + 3] = EX(X[B + 3]); PIN(X); SBAR(); } while (0)
  #define VRD(i) do { vlo[i] = vtr(vp_ + (((i) >> 2) * 4096 + ((i) & 3) * 1024)); vhi[i] = vtr(vp_ + (((i) >> 2) * 4096 + ((i) & 3) * 1024 + 512)); } while (0)
  #define KRD(G, j) do { if (G) { kload2(kf, kp0 + sl_next, j); SBAR(); } } while (0)
  #define STEP(C0, C1, P0, P1, t, GK, GV, GL) do { SBAR(); \
    const lds_cptr vp_ = vp0 + sl_prev; \
    VRD(0); SBAR(); float sacc = (P0[0] + P0[1]); \
    GAPA(C0 = __builtin_amdgcn_mfma_f32_32x32x16_bf16(kf[0], qr[0], negm, 0, 0, 0), P0[2], P0[3], P0[4], P0[5],     pw0[0] = PKW(P0, 0), pw0[1] = PKW(P0, 2), pw0); \
    VRD(4); SBAR(); GAPA(C1 = __builtin_amdgcn_mfma_f32_32x32x16_bf16(kf[1], qr[0], negm, 0, 0, 0), P0[6], P0[7], P0[8], P0[9],     pw0[2] = PKW(P0, 4), pw0[3] = PKW(P0, 6), pw0); \
    VRD(1); SBAR(); GAPA(C0 = __builtin_amdgcn_mfma_f32_32x32x16_bf16(kf[2], qr[1], C0, 0, 0, 0),   P0[10], P0[11], P0[12], P0[13], pw1[0] = PKW(P0, 8), pw1[1] = PKW(P0, 10), pw1); \
    VRD(5); SBAR(); GAPA(C1 = __builtin_amdgcn_mfma_f32_32x32x16_bf16(kf[3], qr[1], C1, 0, 0, 0),   P0[14], P0[15], P1[0], P1[1],   pw1[2] = PKW(P0, 12), pw1[3] = PKW(P0, 14), pw1); \
    VRD(2); SBAR(); GAPA(C0 = __builtin_amdgcn_mfma_f32_32x32x16_bf16(kf[4], qr[2], C0, 0, 0, 0),   P1[2], P1[3], P1[4], P1[5],     pw2[0] = PKW(P1, 0), pw2[1] = PKW(P1, 2), pw2); \
    VRD(6); SBAR(); GAPA(C1 = __builtin_amdgcn_mfma_f32_32x32x16_bf16(kf[5], qr[2], C1, 0, 0, 0),   P1[6], P1[7], P1[8], P1[9],     pw2[2] = PKW(P1, 4), pw2[3] = PKW(P1, 6), pw2); \
    VRD(3); SBAR(); GAPA(C0 = __builtin_amdgcn_mfma_f32_32x32x16_bf16(kf[6], qr[3], C0, 0, 0, 0),   P1[10], P1[11], P1[12], P1[13], pw3[0] = PKW(P1, 8), pw3[1] = PKW(P1, 10), pw3); \
    VRD(7); SBAR(); GAPA(C1 = __builtin_amdgcn_mfma_f32_32x32x16_bf16(kf[7], qr[3], C1, 0, 0, 0),   P1[14], P1[15], 0.f, 0.f,       pw3[2] = PKW(P1, 12), pw3[3] = PKW(P1, 14), pw3); \
    l_reg += sacc; \
    if (GK) { DMA_K((t) + 3, sl_cur); } if (GV) { DMA_V((t) + 1, sl_next); } \
    SBAR(); \
    GAPB(o[0] = __builtin_amdgcn_mfma_f32_32x32x16_bf16(PAF(0), VFR(0), o[0], 0, 0, 0), C0, 0); \
    GAPB(o[1] = __builtin_amdgcn_mfma_f32_32x32x16_bf16(PAF(0), VFR(4), o[1], 0, 0, 0), C0, 4); \
    KRD(GL, 0); GAPB(o[0] = __builtin_amdgcn_mfma_f32_32x32x16_bf16(PAF(1), VFR(1), o[0], 0, 0, 0), C0, 8); \
    KRD(GL, 1); GAPB(o[1] = __builtin_amdgcn_mfma_f32_32x32x16_bf16(PAF(1), VFR(5), o[1], 0, 0, 0), C0, 12); \
    KRD(GL, 2); GAPB(o[0] = __builtin_amdgcn_mfma_f32_32x32x16_bf16(PAF(2), VFR(2), o[0], 0, 0, 0), C1, 0); \
    KRD(GL, 3); GAPB(o[1] = __builtin_amdgcn_mfma_f32_32x32x16_bf16(PAF(2), VFR(6), o[1], 0, 0, 0), C1, 4); \
    GAPB(o[0] = __builtin_amdgcn_mfma_f32_32x32x16_bf16(PAF(3), VFR(3), o[0], 0, 0, 0), C1, 8); \
    GAPB(o[1] = __builtin_amdgcn_mfma_f32_32x32x16_bf16(PAF(3), VFR(7), o[1], 0, 0, 0), C1, 12); \
    } while (0)
  int t = 1;
  for (; t + 5 < NT; t += 2) {
    STEP(pB0, pB1, pA0, pA1, t, true, true, true);     WAIT_BAR(2); RESC(); ROT();
    STEP(pA0, pA1, pB0, pB1, t + 1, true, true, true); WAIT_BAR(2); RESC(); ROT();
  }
  #define ENDW(tt) do { if ((tt) + 3 < NT) { WAIT_BAR(2); } else if ((tt) + 2 < NT) { WAIT_BAR(1); } else { WAIT_BAR(0); } } while (0)
  for (; t + 1 < NT; t += 2) {
    STEP(pB0, pB1, pA0, pA1, t, (t + 3 < NT), (t + 1 < NT), (t + 1 < NT));         ENDW(t);     RESC(); ROT();
    STEP(pA0, pA1, pB0, pB1, t + 1, (t + 4 < NT), (t + 2 < NT), (t + 2 < NT));     ENDW(t + 1); RESC(); ROT();
  }
  STEP(pB0, pB1, pA0, pA1, NT - 1, false, false, false); RESC();
  { float sacc = pB0[0] + pB0[1]; _Pragma("unroll") for (int r = 2; r < 16; ++r) sacc += pB0[r]; _Pragma("unroll") for (int r = 0; r < 16; ++r) sacc += pB1[r]; l_reg += sacc;
    pw0 = (u32x4){PKW(pB0, 0), PKW(pB0, 2), PKW(pB0, 4), PKW(pB0, 6)}; pw1 = (u32x4){PKW(pB0, 8), PKW(pB0, 10), PKW(pB0, 12), PKW(pB0, 14)}; pw2 = (u32x4){PKW(pB1, 0), PKW(pB1, 2), PKW(pB1, 4), PKW(pB1, 6)}; pw3 = (u32x4){PKW(pB1, 8), PKW(pB1, 10), PKW(pB1, 12), PKW(pB1, 14)};
    SBAR(); pv(o, vb0 + sl_cur, PAF(0), PAF(1), PAF(2), PAF(3)); }
  #undef PKW
  #undef PAF
  #undef VFR
  #undef PIN
  #undef MX3
  #undef GAPA
  #undef GAPB
  #undef EX
  #undef VRD
  #undef KRD
  #undef STEP
  #undef ENDW
  { auto rr = __builtin_amdgcn_permlane32_swap(__float_as_uint(l_reg), __float_as_uint(l_reg), false, false); l_reg = __uint_as_float(rr[0]) + __uint_as_float(rr[1]); }
  if (hi == 0) wsf[32 + r32] = l_reg; asm volatile("s_waitcnt lgkmcnt(0)" ::: "memory");
  float rli[16];
  #pragma unroll
  for (int r = 0; r < 16; ++r) rli[r] = __builtin_amdgcn_rcpf(wsf[32 + crow(r, hi)]);
  bf16_t* Ow = Orow0 + (long)(wid * QBLK) * OP;
  { bf16_t* stg = (bf16_t*)(shm + LDS_OST) + wid * 2048;
    #pragma unroll
    for (int r = 0; r < 16; ++r) { const int orow = crow(r, hi);
      #pragma unroll
      for (int d0 = 0; d0 < 2; ++d0) stg[orow * 64 + d0 * 32 + r32] = (bf16_t)f2bf(o[d0][r] * rli[r]); }
    asm volatile("s_waitcnt lgkmcnt(0)" ::: "memory");
    #pragma unroll
    for (int i = 0; i < 4; ++i) { const int row = i * 8 + (lane >> 3), ch = lane & 7; const u32x4 v = *(const u32x4*)(stg + row * 64 + ch * 8); *(u32x4*)(Ow + (long)row * OP + ch * 8) = v; } }
  asm volatile("s_waitcnt lgkmcnt(0)\n\ts_barrier" ::: "memory");
  #undef DMA_K
  #undef DMA_V
  #undef START
  #undef RESC
  #undef ROT
}
#undef SBAR
#undef WAIT_BAR
}
struct Frame {
    LAS unsigned char* lds;
    int tid, lane, wave;
    int vcu, G, gw, NGW, bid;
    unsigned char* ws; const unsigned long long* inq;
};

__device__ __forceinline__ void transpose_item(const float* W, int ldw, int K, bf16_t* WT, int k0, int n0, int dst_row0, LAS float* scr, int lane) {
    float tv[32];
#pragma unroll
    for (int i = 0; i < 32; ++i) tv[i] = W[(size_t)(k0 + 2 * i + (lane >> 5)) * ldw + n0 + (lane & 31)];
#pragma unroll
    for (int i = 0; i < 32; ++i) scr[(2 * i + (lane >> 5)) * 33 + (lane & 31)] = tv[i];
    LDS_WAIT(); asm volatile("" ::: "memory");
    const int c = lane & 7;
#pragma unroll
    for (int j = 0; j < 4; ++j) { const int n = (lane >> 3) + 8 * j; const LAS float* s = scr + (8 * c) * 33 + n;
        u32x4 o; o.x = pk2(s[0 * 33], s[1 * 33]); o.y = pk2(s[2 * 33], s[3 * 33]); o.z = pk2(s[4 * 33], s[5 * 33]); o.w = pk2(s[6 * 33], s[7 * 33]);
        *(u32x4*)(WT + (size_t)(dst_row0 + n) * K + k0 + 8 * c) = o; }
    LDS_WAIT(); asm volatile("" ::: "memory");
}

__device__ __forceinline__ void sincos_acc(float x, float& s, float& c) {
    const float k = rintf(x * 0.63661977236758134f);
    float r = fmaf(k, -1.5703125f, x); r = fmaf(k, -4.837512969970703125e-4f, r); r = fmaf(k, -7.54978995489188e-8f, r);
    const float z = r * r;
    const float sp = r + r * z * fmaf(z, fmaf(z, -1.9515295891e-4f, 8.3321608736e-3f), -1.6666654611e-1f);
    const float cp = fmaf(z * z, fmaf(z, fmaf(z, 2.443315711809948e-5f, -1.388731625493765e-3f), 4.166664568298827e-2f), fmaf(z, -0.5f, 1.0f));
    const int q = ((int)k) & 3;
    const float ss = (q & 1) ? cp : sp, cc = (q & 1) ? sp : cp;
    s = (q & 2) ? -ss : ss; c = ((q + 1) & 2) ? -cc : cc;
}

__device__ __forceinline__ void p0_prologue(Frame& F, const float* const* in, unsigned char* ws) {
    const float* c_lat = in[1]; const float* c_ctx = in[3]; const float* w_mod = in[4]; const float* b_mod = in[5];
    LAS float* sil = (LAS float*)F.lds;
    for (int i = F.tid; i < NMI * D; i += NTHREADS) { const int mi = i >> 10, k = i & 1023; const float v = (mi < NB) ? c_lat[mi * D + k] : c_ctx[k]; sil[i] = silu_f(v); }
    __syncthreads();
    {
        float* modv = (float*)(ws + WS_MODV);
        const int NT16 = 6 * D / 16;
        for (int task = F.gw; task < DEPTH * NT16; task += F.NGW) {
            const int layer = task / NT16, j0 = (task % NT16) * 16, jj = F.lane & 15, kq = F.lane >> 4;
            const float* wp = w_mod + (size_t)layer * D * 6 * D + j0 + jj;
            float acc[NMI];
#pragma unroll
            for (int m = 0; m < NMI; ++m) acc[m] = 0.f;
            for (int k0 = kq; k0 < D; k0 += 64) {
                float wv[16];
#pragma unroll
                for (int u = 0; u < 16; ++u) wv[u] = wp[(size_t)(k0 + 4 * u) * 6 * D];
#pragma unroll
                for (int u = 0; u < 16; ++u) { const int k = k0 + 4 * u;
#pragma unroll
                    for (int m = 0; m < NMI; ++m) acc[m] = fmaf(sil[m * D + k], wv[u], acc[m]); } }
#pragma unroll
            for (int m = 0; m < NMI; ++m) { float v = acc[m]; v += __shfl_xor(v, 16); v += __shfl_xor(v, 32); acc[m] = v; }
            if (kq == 0) { const float bb = b_mod[layer * 6 * D + j0 + jj];
#pragma unroll
                for (int m = 0; m < NMI; ++m) modv[((size_t)layer * NMI + m) * 6 * D + j0 + jj] = acc[m] + bb; }
        }
    }
    __syncthreads();
    {
        LAS float* scr = (LAS float*)(F.lds) + F.wave * (64 * 33);
        constexpr int I_MI = 16 * 96, I_MO = 16 * 32, I_AI = 16 * 48, I_AO = 16 * 32;
        constexpr int PER_J = I_MI + I_MO + I_AI + I_AO;
        for (int it = F.gw; it < 2 * PER_J; it += F.NGW) {
            const int j = it / PER_J; int r = it % PER_J;
            if (r < I_MI) { const int kb = r / 96, nb = r % 96; transpose_item(in[8] + (size_t)j * D * MW_IN, MW_IN, D, (bf16_t*)(ws + WS_WMI) + (size_t)j * 3072 * D, 64 * kb, 32 * nb, 32 * nb, scr, F.lane); continue; } r -= I_MI;
            if (r < I_MO) { const int kb = r / 32, nb = r % 32; transpose_item(in[11] + (size_t)j * D * D, D, D, (bf16_t*)(ws + WS_WMO) + (size_t)j * D * D, 64 * kb, 32 * nb, 32 * nb, scr, F.lane); continue; } r -= I_MO;
            if (r < I_AI) { const int kb = r / 48, nb = r % 48; transpose_item(in[12] + (size_t)j * D * 1536, 1536, D, (bf16_t*)(ws + WS_WAI) + (size_t)j * 1536 * D, 64 * kb, 32 * nb, 32 * nb, scr, F.lane); continue; } r -= I_AI;
            { const int kb = r / 32, nb = r % 32; transpose_item(in[15] + (size_t)j * D * D, D, D, (bf16_t*)(ws + WS_WAO) + (size_t)j * D * D, 64 * kb, 32 * nb, 32 * nb, scr, F.lane); }
        }
    }
    {
        float* rc = (float*)(ws + WS_ROPE); float* rs = rc + SEQ * 32;
        for (int i = F.bid * NTHREADS + F.tid; i < SEQ * 32; i += F.G * NTHREADS) {
            const int t = i >> 5, p = i & 31; const float pos = (p < 16) ? (float)(t >> 6) : (float)(t & 63);
            const float inv = exp2f(-(float)(p & 15) * (13.287712379549449f / 16.f));
            float s, c; sincos_acc(pos * inv, s, c); rc[i] = c; rs[i] = s; }
    }
    __syncthreads();
}

__device__ __forceinline__ void moe_weights(Frame& F, const float* wg, const float* wu, const float* wd, unsigned char* ws, unsigned* counter) {
    LAS float* T = (LAS float*)F.lds;
    volatile LAS int* slot = (volatile LAS int*)(F.lds + 65536 + 256);
    const int lane = F.lane, w = F.wave, tid = F.tid;
    bf16_t* W1 = (bf16_t*)(ws + WS_W1); bf16_t* W2 = (bf16_t*)(ws + WS_W2);
    unsigned char* W1b = (unsigned char*)(ws + WS_W1); unsigned char* W2b = (unsigned char*)(ws + WS_W2);
    constexpr int NIT = NE * 3 * 16 * 4;
#define MW_SRC(it_) (((((it_) % 192) / 64) == 0 ? wg : ((((it_) % 192) / 64) == 1 ? wu : wd)) + (size_t)((it_) / 192) * D * D + (size_t)(64 * ((((it_) % 192) % 64) >> 2)) * D + 256 * ((((it_) % 192) % 64) & 3))
    __syncthreads();
    int pend = NIT;
    if (tid == 0) { slot[0] = (int)__hip_atomic_fetch_add(counter, 1u, __ATOMIC_RELAXED, __HIP_MEMORY_SCOPE_AGENT); pend = (int)__hip_atomic_fetch_add(counter, 1u, __ATOMIC_RELAXED, __HIP_MEMORY_SCOPE_AGENT); }
    __syncthreads();
    int it = slot[0];
    f32x4 v[8];
    if (it < NIT) { const float* src = MW_SRC(it);
#pragma unroll
        for (int i = 0; i < 8; ++i) v[i] = *(const f32x4*)(src + (size_t)(8 * w + i) * D + 4 * lane); }
    while (it < NIT) {
        if (tid == 0) { slot[1] = pend; pend = (int)__hip_atomic_fetch_add(counter, 1u, __ATOMIC_RELAXED, __HIP_MEMORY_SCOPE_AGENT); }
        __syncthreads();
#pragma unroll
        for (int i = 0; i < 8; ++i) *(LAS f32x4*)(T + (8 * w + i) * 256 + ((4 * lane) ^ (8 * (w & 3)))) = v[i];
        const int nx = slot[1];
        if (nx < NIT) { const float* src = MW_SRC(nx);
#pragma unroll
            for (int i = 0; i < 8; ++i) v[i] = *(const f32x4*)(src + (size_t)(8 * w + i) * D + 4 * lane); }
        __syncthreads();
        const int e = it / 192, r = it % 192, which = r / 64, kb = (r % 64) >> 2, nq = (r % 64) & 3;
        const int nl = lane & 7, c = lane >> 3;
        bf16_t* base = (which == 2) ? (W2 + (size_t)e * D * D) : (W1 + (size_t)e * 2048 * D);
#pragma unroll
        for (int j = 0; j < 4; ++j) { const int n = 32 * w + 8 * j + nl; const LAS float* tp = T + (8 * c) * 256 + (n ^ (8 * (c & 3)));
            float t[8];
#pragma unroll
            for (int i = 0; i < 8; ++i) t[i] = tp[i * 256];
            const int ng = 256 * nq + n; const int drow = (which == 2) ? ng : (256 * (ng >> 7) + (which == 1 ? 128 : 0) + (ng & 127));
            const bool f8 = (which == 2) ? (MOE_FP8_2 != 0) : (MOE_FP8_1 != 0);
            if (f8) { u32x2 o; o.x = pk_fp8x4(t[0] * FP8_SW, t[1] * FP8_SW, t[2] * FP8_SW, t[3] * FP8_SW); o.y = pk_fp8x4(t[4] * FP8_SW, t[5] * FP8_SW, t[6] * FP8_SW, t[7] * FP8_SW);
                unsigned char* b8 = (which == 2) ? (W2b + (size_t)e * D * D) : (W1b + (size_t)e * 2048 * D);
                *(u32x2*)(b8 + (size_t)drow * D + 64 * kb + 8 * c) = o; }
            else { u32x4 o; o.x = pk2(t[0], t[1]); o.y = pk2(t[2], t[3]); o.z = pk2(t[4], t[5]); o.w = pk2(t[6], t[7]);
                *(u32x4*)(base + (size_t)drow * D + 64 * kb + 8 * c) = o; } }
        it = nx;
    }
#undef MW_SRC
    __syncthreads();
}

__device__ __forceinline__ void load_w16(Frame& F, const float* W16, int ldw16) {
    LAS float* wl = (LAS float*)F.lds;
    for (int i = F.tid; i < D * 16; i += NTHREADS) { const int c = i >> 4, e = i & 15; const int l = (c & 255) >> 2, q = (c & 3) + 4 * (c >> 8);
        wl[(q * 64 + l) * 20 + e] = W16[(size_t)c * ldw16 + e]; }
    __syncthreads();
}
template <int MODE, bool F8 = false>
__device__ __forceinline__ void norm_core(LAS float* wl, const int lane, f32x4 (&v)[4], const int r, const f32x4 (&gv)[4], const float* shp, const float* scp, bf16_t* H, const float* bias16, float* out16) {
    float ss = 0.f;
#pragma unroll
    for (int j = 0; j < 4; ++j) ss += (v[j].x * v[j].x + v[j].y * v[j].y) + (v[j].z * v[j].z + v[j].w * v[j].w);
    const float rstd = rsqrtf(wave_sum(ss) * (1.f / D) + NORM_EPS);
    unsigned long long* o8 = (unsigned long long*)(H + (size_t)r * D) + lane;
#pragma unroll
    for (int j = 0; j < 4; ++j) { const f32x4 sh = *(const f32x4*)(shp + 4 * lane + 256 * j), sc = *(const f32x4*)(scp + 4 * lane + 256 * j);
        v[j] = (v[j] * rstd * gv[j]) * (sc + 1.f) + sh;
        if (F8) ((unsigned*)((unsigned char*)H + (size_t)r * D))[lane + 64 * j] = pk_fp8x4(v[j].x * FP8_SH, v[j].y * FP8_SH, v[j].z * FP8_SH, v[j].w * FP8_SH);
        else o8[64 * j] = (unsigned long long)pk2(v[j].x, v[j].y) | ((unsigned long long)pk2(v[j].z, v[j].w) << 32); }
    if (MODE != 0) {
        float p[16];
#pragma unroll
        for (int e = 0; e < 16; ++e) p[e] = 0.f;
#pragma unroll
        for (int j = 0; j < 4; ++j) {
            f32x4 wq[4][4];
#pragma unroll
            for (int i = 0; i < 4; ++i) { const LAS f32x4* wp = (const LAS f32x4*)(wl + ((4 * j + i) * 64 + lane) * 20);
#pragma unroll
                for (int e4 = 0; e4 < 4; ++e4) wq[i][e4] = wp[e4]; }
            asm volatile("s_waitcnt lgkmcnt(0)" ::: "memory"); __builtin_amdgcn_sched_barrier(0);
#pragma unroll
            for (int i = 0; i < 4; ++i) { const float xv = v[j][i];
#pragma unroll
                for (int e4 = 0; e4 < 4; ++e4) { const f32x4 w = wq[i][e4]; p[4 * e4 + 0] = fmaf(xv, w.x, p[4 * e4 + 0]); p[4 * e4 + 1] = fmaf(xv, w.y, p[4 * e4 + 1]); p[4 * e4 + 2] = fmaf(xv, w.z, p[4 * e4 + 2]); p[4 * e4 + 3] = fmaf(xv, w.w, p[4 * e4 + 3]); } }
            __builtin_amdgcn_sched_barrier(0);
        }
        float q8[8], q4[4], q2[2], q1;
        { const bool up = (lane & 32) != 0;
#pragma unroll
          for (int i = 0; i < 8; ++i) { const float send = up ? p[i] : p[i + 8]; const float recv = __shfl_xor(send, 32); q8[i] = (up ? p[i + 8] : p[i]) + recv; } }
        { const bool up = (lane & 16) != 0;
#pragma unroll
          for (int i = 0; i < 4; ++i) { const float send = up ? q8[i] : q8[i + 4]; const float recv = __shfl_xor(send, 16); q4[i] = (up ? q8[i + 4] : q8[i]) + recv; } }
        { const bool up = (lane & 8) != 0;
#pragma unroll
          for (int i = 0; i < 2; ++i) { const float send = up ? q4[i] : q4[i + 2]; const float recv = __shfl_xor(send, 8); q2[i] = (up ? q4[i + 2] : q4[i]) + recv; } }
        { const bool up = (lane & 4) != 0; const float send = up ? q2[0] : q2[1]; const float recv = __shfl_xor(send, 4); q1 = (up ? q2[1] : q2[0]) + recv; }
        q1 = quad_sum(q1);
        const int e = ((lane >> 5) & 1) * 8 + ((lane >> 4) & 1) * 4 + ((lane >> 3) & 1) * 2 + ((lane >> 2) & 1);
        if (MODE == 1) {
            float g = q1 + bias16[e];
            g = 15.f * tanhf(g * (1.f / 15.f));
            const int gate = e >> 2;
            if (gate & 1) g = fminf(g, 0.f) - log1pf(__expf(-fabsf(g)));
            if ((lane & 3) == 0) out16[(size_t)r * 16 + e] = g;
        } else {
            float mx = q1;
#pragma unroll
            for (int o = 4; o < 64; o <<= 1) mx = fmaxf(mx, __shfl_xor(mx, o));
            const float ex = __expf(q1 - mx); float sm = ex;
#pragma unroll
            for (int o = 4; o < 64; o <<= 1) sm += __shfl_xor(sm, o);
            if ((lane & 3) == 0) out16[(size_t)e * RT + r] = ex / sm;
        }
    }
}
__device__ __forceinline__ float swap32_add(float a, float b) { auto r = __builtin_amdgcn_permlane32_swap(__float_as_uint(a), __float_as_uint(b), false, false); return __uint_as_float(r[0]) + __uint_as_float(r[1]); }
__device__ __forceinline__ float swap16_add(float a, float b) { auto r = __builtin_amdgcn_permlane16_swap(__float_as_uint(a), __float_as_uint(b), false, false); return __uint_as_float(r[0]) + __uint_as_float(r[1]); }
template <int MODE, bool F8 = false, bool X16SRC = false>
__device__ __forceinline__ void norm_pass(Frame& F, const float* xL, const float* xC  , int nrows, const float* gain, const float* shiftv, const float* scalev  ,
                                          bf16_t* H, const float* W16, int ldw16, const float* bias16, float* out16) {
    LAS float* wl = (LAS float*)F.lds;
    if (MODE != 0) load_w16(F, W16, ldw16);
    const int lane = F.lane;
    f32x4 gv[4];
#pragma unroll
    for (int j = 0; j < 4; ++j) gv[j] = *(const f32x4*)(gain + 4 * lane + 256 * j);
    const int per = (((nrows + F.NGW - 1) / F.NGW) + 1) & ~1; const int r0 = F.gw * per, r1 = (r0 + per < nrows) ? r0 + per : nrows;
#define NP_XPTR(rr) (((rr) >= RL) ? (xC + (size_t)((rr) - RL) * D) : (xL + (size_t)(rr) * D))
#define NP_LOADROW(dst, rr) do { if (X16SRC) { const u32x2* xp_ = (const u32x2*)((const bf16_t*)xL + (size_t)(rr) * D) + lane; _Pragma("unroll") for (int j = 0; j < 4; ++j) { const u32x2 t_ = xp_[64 * j]; dst[j] = (f32x4){bf_lo(t_.x), bf_hi(t_.x), bf_lo(t_.y), bf_hi(t_.y)}; } } \
        else { const float* xr_ = NP_XPTR(rr); _Pragma("unroll") for (int j = 0; j < 4; ++j) dst[j] = *(const f32x4*)(xr_ + 4 * lane + 256 * j); } } while (0)
    f32x4 vn[2][4];
    if (r0 < r1) { NP_LOADROW(vn[0], r0); NP_LOADROW(vn[1], r0 + 1); }
    for (int r = r0; r < r1; r += 2) {
        asm volatile("" ::: "memory");
        f32x4 v[2][4];
#pragma unroll
        for (int q = 0; q < 2; ++q)
#pragma unroll
            for (int j = 0; j < 4; ++j) v[q][j] = vn[q][j];
        if (r + 2 < r1) { NP_LOADROW(vn[0], r + 2); NP_LOADROW(vn[1], r + 3); }
        float ss[2];
#pragma unroll
        for (int q = 0; q < 2; ++q) { ss[q] = 0.f;
#pragma unroll
            for (int j = 0; j < 4; ++j) ss[q] += (v[q][j].x * v[q][j].x + v[q][j].y * v[q][j].y) + (v[q][j].z * v[q][j].z + v[q][j].w * v[q][j].w); }
        ss[0] = row16_sum(ss[0]); ss[1] = row16_sum(ss[1]);
        const float tot0 = (rdlane(ss[0], 0) + rdlane(ss[0], 16)) + (rdlane(ss[0], 32) + rdlane(ss[0], 48)), tot1 = (rdlane(ss[1], 0) + rdlane(ss[1], 16)) + (rdlane(ss[1], 32) + rdlane(ss[1], 48));
        const float rstd[2] = {rsqrtf(tot0 * (1.f / D) + NORM_EPS), rsqrtf(tot1 * (1.f / D) + NORM_EPS)};
#pragma unroll
        for (int q = 0; q < 2; ++q) { const int rr = r + q; const int mi = (rr >= RL) ? NB : (rr >> 12);
            const float* shp = shiftv + (size_t)mi * 6 * D; const float* scp = scalev + (size_t)mi * 6 * D;
#pragma unroll
            for (int j = 0; j < 4; ++j) { const f32x4 sh = *(const f32x4*)(shp + 4 * lane + 256 * j), sc = *(const f32x4*)(scp + 4 * lane + 256 * j);
                v[q][j] = (v[q][j] * rstd[q] * gv[j]) * (sc + 1.f) + sh;
                if (F8) ((unsigned*)((unsigned char*)H + (size_t)rr * D))[lane + 64 * j] = pk_fp8x4(v[q][j].x * FP8_SH, v[q][j].y * FP8_SH, v[q][j].z * FP8_SH, v[q][j].w * FP8_SH);
                else ((unsigned long long*)(H + (size_t)rr * D))[lane + 64 * j] = (unsigned long long)pk2(v[q][j].x, v[q][j].y) | ((unsigned long long)pk2(v[q][j].z, v[q][j].w) << 32); } }
        if (MODE != 0) {
            f32x2 p2[2][8];
#pragma unroll
            for (int q = 0; q < 2; ++q)
#pragma unroll
                for (int e = 0; e < 8; ++e) p2[q][e] = (f32x2){0.f, 0.f};
#pragma unroll
            for (int j = 0; j < 4; ++j) {
                f32x4 wq[4][4];
#pragma unroll
                for (int i = 0; i < 4; ++i) { const LAS f32x4* wp = (const LAS f32x4*)(wl + ((4 * j + i) * 64 + lane) * 20);
#pragma unroll
                    for (int e4 = 0; e4 < 4; ++e4) wq[i][e4] = wp[e4]; }
                asm volatile("s_waitcnt lgkmcnt(0)" ::: "memory"); __builtin_amdgcn_sched_barrier(0);
#pragma unroll
                for (int i = 0; i < 4; ++i)
#pragma unroll
                    for (int q = 0; q < 2; ++q) { const float xv = v[q][j][i]; const f32x2 x2 = {xv, xv};
#pragma unroll
                        for (int e4 = 0; e4 < 4; ++e4) { const f32x4 w = wq[i][e4];
                            p2[q][2 * e4 + 0] = __builtin_elementwise_fma(x2, (f32x2){w.x, w.y}, p2[q][2 * e4 + 0]);
                            p2[q][2 * e4 + 1] = __builtin_elementwise_fma(x2, (f32x2){w.z, w.w}, p2[q][2 * e4 + 1]); } }
                __builtin_amdgcn_sched_barrier(0);
            }
            float p[2][16];
#pragma unroll
            for (int q = 0; q < 2; ++q)
#pragma unroll
                for (int e = 0; e < 8; ++e) { p[q][2 * e] = p2[q][e].x; p[q][2 * e + 1] = p2[q][e].y; }
            float q16[16], q8[8], q4[4], q2[2], q1;
#pragma unroll
            for (int e = 0; e < 16; ++e) q16[e] = swap32_add(p[0][e], p[1][e]);
#pragma unroll
            for (int i = 0; i < 8; ++i) q8[i] = swap16_add(q16[i], q16[i + 8]);
            { const bool up = (lane & 8) != 0;
#pragma unroll
              for (int i = 0; i < 4; ++i) { const float send = up ? q8[i] : q8[i + 4]; const float recv = __shfl_xor(send, 8); q4[i] = (up ? q8[i + 4] : q8[i]) + recv; } }
            { const bool up = (lane & 4) != 0;
#pragma unroll
              for (int i = 0; i < 2; ++i) { const float send = up ? q4[i] : q4[i + 2]; const float recv = __shfl_xor(send, 4); q2[i] = (up ? q4[i + 2] : q4[i]) + recv; } }
            { const bool up = (lane & 2) != 0; const float send = up ? q2[0] : q2[1]; const float recv = dpp_f<0x4E>(0.f, send); q1 = (up ? q2[1] : q2[0]) + recv; }
            q1 += dpp_f<0xB1>(0.f, q1);
            const int e = ((lane >> 4) & 1) * 8 + ((lane >> 3) & 1) * 4 + ((lane >> 2) & 1) * 2 + ((lane >> 1) & 1);
            const int rr = r + (lane >> 5);
            if (MODE == 1) {
                float g = q1 + bias16[e];
                g = 15.f * tanhf(g * (1.f / 15.f));
                const int gate = e >> 2;
                if (gate & 1) g = fminf(g, 0.f) - log1pf(__expf(-fabsf(g)));
                if ((lane & 1) == 0) out16[(size_t)rr * 16 + e] = g;
            } else {
                float mx = q1;
                mx = fmaxf(mx, dpp_f<0x4E>(mx, mx)); mx = fmaxf(mx, dpp_f<0x141>(mx, mx)); mx = fmaxf(mx, dpp_f<0x140>(mx, mx));
                { auto t = __builtin_amdgcn_permlane16_swap(__float_as_uint(mx), __float_as_uint(mx), false, false); mx = fmaxf(__uint_as_float(t[0]), __uint_as_float(t[1])); }
                const float ex = __expf(q1 - mx); float sm = ex;
                sm += dpp_f<0x4E>(0.f, sm); sm += dpp_f<0x141>(0.f, sm); sm += dpp_f<0x140>(0.f, sm);
                sm = swap16_add(sm, sm);
                if ((lane & 1) == 0) out16[(size_t)e * RT + rr] = ex / sm;
            }
        }
    }
#undef NP_XPTR
#undef NP_LOADROW
    if (MODE != 0) __syncthreads();
}

__device__ __forceinline__ void moe_select(Frame& F, const float* AFF, int* INV, int* SLROW, float* SLG, int nunits) {
    LAS unsigned* keys = (LAS unsigned*)F.lds;
    LAS unsigned* wsum = (LAS unsigned*)(F.lds + 16384);
    const int tid = F.tid, lane = F.lane, wave = F.wave;
    for (int u = F.vcu; u < nunits; u += F.G) {
        const int set = u >> 4, e = u & 15; const bool isc = set >= NB; const int b = isc ? set - NB : set;
        const int N = isc ? CTXL : SEQ, k = isc ? CAP_C : CAP_L, PER = isc ? 1 : 8;
        const int row0 = isc ? RL + b * CTXL : b * SEQ;
        const int nmine = (tid * PER < N) ? PER : 0;
        unsigned kv[8];
        if (tid < 32) wsum[tid] = 0u;
#pragma unroll
        for (int i = 0; i < 8; ++i) { kv[i] = 0u; if (i < nmine) kv[i] = __float_as_uint(AFF[(size_t)e * RT + row0 + tid * PER + i]); }
        __syncthreads();
        unsigned T = 0u; { unsigned kk = (unsigned)k;
        for (int pass = 0; pass < 8; ++pass) {
            const int shift = 28 - 4 * pass; LAS unsigned* hist = wsum + (pass & 1) * 16;
            if (tid < 16) wsum[((pass + 1) & 1) * 16 + tid] = 0u;
#pragma unroll
            for (int i = 0; i < 8; ++i) if (i < nmine && (pass == 0 || (kv[i] >> (shift + 4)) == (T >> (shift + 4)))) (void)__hip_atomic_fetch_add(&hist[(kv[i] >> shift) & 15u], 1u, __ATOMIC_RELAXED, __HIP_MEMORY_SCOPE_WORKGROUP);
            __syncthreads();
            unsigned cum = 0u, digit = 0u; bool found = false;
#pragma unroll
            for (int d = 15; d >= 0; --d) { const unsigned c = hist[d]; if (!found) { if (cum + c >= kk) { digit = (unsigned)d; found = true; } else cum += c; } }
            kk -= cum; T |= digit << shift;
            __syncthreads();
        } }
        unsigned ngt = 0u, neq = 0u;
#pragma unroll
        for (int i = 0; i < 8; ++i) { if (i < nmine) { ngt += kv[i] > T ? 1u : 0u; neq += kv[i] == T ? 1u : 0u; } }
        unsigned sgt = ngt, seq = neq;
#pragma unroll
        for (int o = 1; o < 64; o <<= 1) { const unsigned a = __shfl_up(sgt, o), c2 = __shfl_up(seq, o); if (lane >= o) { sgt += a; seq += c2; } }
        LAS unsigned* sc = wsum + 32;
        __syncthreads();
        if (lane == 63) { sc[wave] = sgt; sc[8 + wave] = seq; }
        __syncthreads();
        unsigned bgt = 0u, beq = 0u, tgt = 0u;
#pragma unroll
        for (int w = 0; w < 8; ++w) { const unsigned a = sc[w], c2 = sc[8 + w]; if (w < wave) { bgt += a; beq += c2; } tgt += a; }
        const unsigned need = (unsigned)k - tgt;
        unsigned pgt = bgt + sgt - ngt, peq = beq + seq - neq;
        const int sbase = isc ? NB * CAP_L + b * CAP_C : b * CAP_L;
#pragma unroll
        for (int i = 0; i < 8; ++i) { if (i < nmine) {
            const int row = row0 + tid * PER + i; int slot = -1;
            if (kv[i] > T) { slot = (int)(pgt + (peq < need ? peq : need)); ++pgt; }
            else if (kv[i] == T) { if (peq < need) slot = (int)(pgt + peq); ++peq; }
            if (slot >= 0) { SLROW[e * SLOTS_E + sbase + slot] = row; SLG[e * SLOTS_E + sbase + slot] = __uint_as_float(kv[i]); }
            INV[(size_t)e * RT + row] = slot >= 0 ? sbase + slot : -1; } }
        __syncthreads();
    }
    (void)keys;
}

__device__ __forceinline__ void moe_gather(Frame& F, const bf16_t* H, const int* SLROW, bf16_t* XG, bool with_ctx) {
    const int per_e = with_ctx ? SLOTS_E : NB * CAP_L; const int total = NE * per_e;
    const int per = (total + F.NGW - 1) / F.NGW; const int i0 = F.gw * per, i1 = (i0 + per < total) ? i0 + per : total;
    for (int i = i0; i < i1; i += 4) {
        u32x4 a[4], b2[4]; size_t dsto[4];
#pragma unroll
        for (int q = 0; q < 4; ++q) { const int ii = (i + q < i1) ? i + q : i1 - 1; const int e = ii / per_e, sl = ii - e * per_e; const int row = SLROW[e * SLOTS_E + sl];
            const u32x4* src = (const u32x4*)(H + (size_t)row * D) + F.lane; a[q] = src[0]; b2[q] = src[64]; dsto[q] = ((size_t)e * SLOTS_E + sl) * D; }
#pragma unroll
        for (int q = 0; q < 4; ++q) { u32x4* dst = (u32x4*)(XG + dsto[q]) + F.lane; dst[0] = a[q]; dst[64] = b2[q]; }
    }
}

template <int MODE>
__device__ __forceinline__ void combine_norm(Frame& F, const bf16_t* Y, const int* INV, bf16_t* X16, float* outL  , const float* g2v  , int nrows,
                                             const float* gain, const float* shiftv, const float* scalev, bf16_t* H, const float* W16, int ldw16, const float* bias16, float* out16) {
    LAS float* wl = (LAS float*)F.lds;
    if (MODE == 1) load_w16(F, W16, ldw16);
    const int lane = F.lane;
    f32x4 gv[4];
#pragma unroll
    for (int j = 0; j < 4; ++j) gv[j] = *(const f32x4*)(gain + 4 * lane + 256 * j);
    const int per = (nrows + F.NGW - 1) / F.NGW; const int r0 = F.gw * per, r1 = (r0 + per < nrows) ? r0 + per : nrows;
#define CN_XLOAD(dst, rr) do { const u32x2* xp_ = (const u32x2*)(X16 + (size_t)(rr) * D) + lane; _Pragma("unroll") for (int j = 0; j < 4; ++j) { const u32x2 t_ = xp_[64 * j]; dst[j] = (f32x4){bf_lo(t_.x), bf_hi(t_.x), bf_lo(t_.y), bf_hi(t_.y)}; } } while (0)
#define CN_INV(rr) (((rr) < r1 && lane < 16) ? INV[(size_t)lane * RT + (rr)] : -1)
#define CN_YLOAD(dst, e_, s_) do { const u32x2* yp_ = (const u32x2*)(Y + ((size_t)(e_) * SLOTS_E + (s_)) * D) + lane; _Pragma("unroll") for (int j = 0; j < 4; ++j) dst[j] = yp_[64 * j]; } while (0)
#define CN_YACC(src) do { _Pragma("unroll") for (int j = 0; j < 4; ++j) { a[j].x += bf_lo(src[j].x); a[j].y += bf_hi(src[j].x); a[j].z += bf_lo(src[j].y); a[j].w += bf_hi(src[j].y); } } while (0)
    f32x4 vn[4]; u32x2 pn0[4], pn1[4];
    int invA = CN_INV(r0), invB = CN_INV(r0 + 1);
#pragma unroll
    for (int j = 0; j < 4; ++j) { vn[j] = (f32x4){0.f, 0.f, 0.f, 0.f}; pn0[j] = (u32x2){0u, 0u}; pn1[j] = (u32x2){0u, 0u}; }
    if (r0 < r1) { CN_XLOAD(vn, r0);
        unsigned long long m = __ballot(invA >= 0);
        if (m) { const int e0 = __builtin_ctzll(m); m &= m - 1; CN_YLOAD(pn0, e0, __builtin_amdgcn_readlane(invA, e0)); if (m) { const int e1 = __builtin_ctzll(m); CN_YLOAD(pn1, e1, __builtin_amdgcn_readlane(invA, e1)); } } }
    for (int r = r0; r < r1; ++r) {
        asm volatile("" ::: "memory");
        f32x4 v[4]; u32x2 pc0[4], pc1[4];
#pragma unroll
        for (int j = 0; j < 4; ++j) { v[j] = vn[j]; pc0[j] = pn0[j]; pc1[j] = pn1[j]; }
        const int invC = CN_INV(r + 2);
        if (r + 1 < r1) { CN_XLOAD(vn, r + 1);
            unsigned long long m = __ballot(invB >= 0);
            if (m) { const int e0 = __builtin_ctzll(m); m &= m - 1; CN_YLOAD(pn0, e0, __builtin_amdgcn_readlane(invB, e0)); if (m) { const int e1 = __builtin_ctzll(m); CN_YLOAD(pn1, e1, __builtin_amdgcn_readlane(invB, e1)); } } }
        f32x4 a[4];
#pragma unroll
        for (int j = 0; j < 4; ++j) a[j] = (f32x4){0.f, 0.f, 0.f, 0.f};
        { unsigned long long m = __ballot(invA >= 0);
          if (m) { m &= m - 1; CN_YACC(pc0);
            if (m) { m &= m - 1; CN_YACC(pc1);
              while (m) { const int e2 = __builtin_ctzll(m); m &= m - 1; u32x2 t2[4]; CN_YLOAD(t2, e2, __builtin_amdgcn_readlane(invA, e2)); CN_YACC(t2); } } } }
        const int mi = (r >= RL) ? NB : (r >> 12);
        const float* gp = g2v + (size_t)mi * 6 * D;
#pragma unroll
        for (int j = 0; j < 4; ++j) { const f32x4 g = *(const f32x4*)(gp + 4 * lane + 256 * j); v[j] = v[j] + g * a[j]; }
        if (MODE == 3) { float* xw = outL + (size_t)r * D;
            float ss = 0.f;
#pragma unroll
            for (int j = 0; j < 4; ++j) ss += (v[j].x * v[j].x + v[j].y * v[j].y) + (v[j].z * v[j].z + v[j].w * v[j].w);
            const float rstd = rsqrtf(wave_sum(ss) * (1.f / D) + NORM_EPS);
#pragma unroll
            for (int j = 0; j < 4; ++j) *(f32x4*)(xw + 4 * lane + 256 * j) = v[j] * rstd * gv[j];
        } else {
#pragma unroll
            for (int j = 0; j < 4; ++j) ((unsigned long long*)(X16 + (size_t)r * D))[lane + 64 * j] = (unsigned long long)pk2(v[j].x, v[j].y) | ((unsigned long long)pk2(v[j].z, v[j].w) << 32);
            norm_core<MODE>(wl, lane, v, r, gv, shiftv + (size_t)mi * 6 * D, scalev + (size_t)mi * 6 * D, H, bias16, out16);
        }
        invA = invB; invB = invC;
    }
#undef CN_XLOAD
#undef CN_INV
#undef CN_YLOAD
#undef CN_YACC
    if (MODE == 1) __syncthreads();
}

__device__ __forceinline__ void final_norm(Frame& F, float* x, const float* gain) {
    const int lane = F.lane;
    for (int r = F.gw; r < RL; r += F.NGW) { float* xr = x + (size_t)r * D; f32x4 v[4]; float ss = 0.f;
#pragma unroll
        for (int j = 0; j < 4; ++j) { v[j] = *(const f32x4*)(xr + 4 * lane + 256 * j); ss += (v[j].x * v[j].x + v[j].y * v[j].y) + (v[j].z * v[j].z + v[j].w * v[j].w); }
        const float rstd = rsqrtf(wave_sum(ss) * (1.f / D) + NORM_EPS);
#pragma unroll
        for (int j = 0; j < 4; ++j) { const f32x4 g = *(const f32x4*)(gain + 4 * lane + 256 * j); *(f32x4*)(xr + 4 * lane + 256 * j) = v[j] * rstd * g; } }
}

__device__ __forceinline__ void unpack8(const u32x4 u, float (&x)[8]) { x[0] = bf_lo(u.x); x[1] = bf_hi(u.x); x[2] = bf_lo(u.y); x[3] = bf_hi(u.y); x[4] = bf_lo(u.z); x[5] = bf_hi(u.z); x[6] = bf_lo(u.w); x[7] = bf_hi(u.w); }
__device__ __forceinline__ u32x4 pack8(const float (&y)[8]) { u32x4 o; o.x = pk2(y[0], y[1]); o.y = pk2(y[2], y[3]); o.z = pk2(y[4], y[5]); o.w = pk2(y[6], y[7]); return o; }
__device__ __forceinline__ void qk_pass(Frame& F, bf16_t* QKV, const float* qn, const float* kn, const float* ropec, const float* ropes, bf16_t* KALL, bf16_t* VALL) {
    const int lane = F.lane, p = lane & 3;
    float gq1[8], gq2[8], gk1[8], gk2[8];
#pragma unroll
    for (int t = 0; t < 8; ++t) { gq1[t] = qn[8 * p + t]; gq2[t] = qn[32 + 8 * p + t]; gk1[t] = kn[8 * p + t]; gk2[t] = kn[32 + 8 * p + t]; }
    const int per = (((RT + F.NGW - 1) / F.NGW) + 3) & ~3; const int r0 = F.gw * per, r1 = (r0 + per < RT) ? r0 + per : RT;
    const int kh = (lane >> 2) & 3;
    for (int r = r0; r < r1; r += 4) {
        u32x4 qa[4], qb[4], ka[4], kb2[4], vv[4]; f32x4 c0[4], c1[4], s0[4], s1[4];
#pragma unroll
        for (int q = 0; q < 4; ++q) { const int rr = (r + q < r1) ? r + q : r1 - 1; const bool isc = rr >= RL; const int t = isc ? (rr - RL) & 255 : rr & 4095;
            const bf16_t* row = QKV + (size_t)rr * 1536;
            qa[q] = *(const u32x4*)(row + (lane >> 2) * 64 + 8 * p); qb[q] = *(const u32x4*)(row + (lane >> 2) * 64 + 8 * p + 32);
            ka[q] = *(const u32x4*)(row + 1024 + kh * 64 + 8 * p); kb2[q] = *(const u32x4*)(row + 1024 + kh * 64 + 8 * p + 32);
            vv[q] = *(const u32x4*)(row + 1280 + ((lane - 16) & 31) * 8);
            const int tt = isc ? 0 : t;
            c0[q] = *(const f32x4*)(ropec + tt * 32 + 8 * p); c1[q] = *(const f32x4*)(ropec + tt * 32 + 8 * p + 4); s0[q] = *(const f32x4*)(ropes + tt * 32 + 8 * p); s1[q] = *(const f32x4*)(ropes + tt * 32 + 8 * p + 4); }
#pragma unroll
        for (int q = 0; q < 4; ++q) { const int rr = r + q; if (rr < r1) {
            const bool isc = rr >= RL; const int b = isc ? (rr - RL) >> 8 : rr >> 12; const int t = isc ? (rr - RL) & 255 : rr & 4095; const int pos = isc ? t : CTXL + t;
            bf16_t* row = QKV + (size_t)rr * 1536;
            float cs[8], sn[8];
            cs[0] = c0[q].x; cs[1] = c0[q].y; cs[2] = c0[q].z; cs[3] = c0[q].w; cs[4] = c1[q].x; cs[5] = c1[q].y; cs[6] = c1[q].z; cs[7] = c1[q].w;
            sn[0] = s0[q].x; sn[1] = s0[q].y; sn[2] = s0[q].z; sn[3] = s0[q].w; sn[4] = s1[q].x; sn[5] = s1[q].y; sn[6] = s1[q].z; sn[7] = s1[q].w;
            if (isc) {
#pragma unroll
                for (int i = 0; i < 8; ++i) { cs[i] = 1.f; sn[i] = 0.f; } }
            {
                float x1[8], x2[8]; unpack8(qa[q], x1); unpack8(qb[q], x2);
                float ss = 0.f;
#pragma unroll
                for (int i = 0; i < 8; ++i) ss += x1[i] * x1[i] + x2[i] * x2[i];
                ss = quad_sum(ss);
                const float rstd = rsqrtf(ss * (1.f / 64.f) + NORM_EPS) * attn_body::C2;
                float y1[8], y2[8];
#pragma unroll
                for (int i = 0; i < 8; ++i) { const float a = x1[i] * rstd * gq1[i], c = x2[i] * rstd * gq2[i]; y1[i] = a * cs[i] - c * sn[i]; y2[i] = a * sn[i] + c * cs[i]; }
                bf16_t* hp = row + (lane >> 2) * 64 + 8 * p;
                *(u32x4*)hp = pack8(y1); *(u32x4*)(hp + 32) = pack8(y2);
            }
            {
                float x1[8], x2[8]; unpack8(ka[q], x1); unpack8(kb2[q], x2);
                float ss = 0.f;
#pragma unroll
                for (int i = 0; i < 8; ++i) ss += x1[i] * x1[i] + x2[i] * x2[i];
                ss = quad_sum(ss);
                const float rstd = rsqrtf(ss * (1.f / 64.f) + NORM_EPS);
                float y1[8], y2[8];
#pragma unroll
                for (int i = 0; i < 8; ++i) { const float a = x1[i] * rstd * gk1[i], c = x2[i] * rstd * gk2[i]; y1[i] = a * cs[i] - c * sn[i]; y2[i] = a * sn[i] + c * cs[i]; }
                if (lane < 16) { bf16_t* kp = KALL + ((size_t)b * KVLEN + pos) * 256 + kh * 64 + 8 * p; *(u32x4*)kp = pack8(y1); *(u32x4*)(kp + 32) = pack8(y2); }
                else if (lane < 48) *(u32x4*)(VALL + ((size_t)b * KVLEN + pos) * 256 + (lane - 16) * 8) = vv[q];
            } } }
    }
}

__device__ __forceinline__ void mlstm_readout(Frame& F, const bf16_t* HF, const bf16_t* HB, const bf16_t* QKVO, const float* wnorm, bf16_t* MIX) {
    const int lane = F.lane;
    f32x4 gv[4];
#pragma unroll
    for (int j = 0; j < 4; ++j) gv[j] = *(const f32x4*)(wnorm + 4 * lane + 256 * j);
    const int per = (((RT + F.NGW - 1) / F.NGW) + 3) & ~3; const int r0 = F.gw * per, r1 = (r0 + per < RT) ? r0 + per : RT;
    for (int r = r0; r < r1; r += 4) {
        u32x2 uf[4][4], ub[4][4], uo[4][4];
#pragma unroll
        for (int q = 0; q < 4; ++q) { const int rr = (r + q < r1) ? r + q : r1 - 1;
            const u32x2* pf = (const u32x2*)(HF + (size_t)rr * D) + lane; const u32x2* pb = (const u32x2*)(HB + (size_t)rr * D) + lane; const u32x2* po = (const u32x2*)(QKVO + (size_t)rr * 3072 + 2048) + lane;
#pragma unroll
            for (int j = 0; j < 4; ++j) { uf[q][j] = pf[64 * j]; ub[q][j] = pb[64 * j]; uo[q][j] = po[64 * j]; } }
#pragma unroll
        for (int q = 0; q < 4; ++q) { const int rr = r + q; if (rr < r1) {
            unsigned long long* o8 = (unsigned long long*)(MIX + (size_t)rr * D) + lane;
#pragma unroll
            for (int j = 0; j < 4; ++j) {
                f32x4 h; h.x = bf_lo(uf[q][j].x) + bf_lo(ub[q][j].x); h.y = bf_hi(uf[q][j].x) + bf_hi(ub[q][j].x); h.z = bf_lo(uf[q][j].y) + bf_lo(ub[q][j].y); h.w = bf_hi(uf[q][j].y) + bf_hi(ub[q][j].y);
                const float ss = wave_sum((h.x * h.x + h.y * h.y) + (h.z * h.z + h.w * h.w));
                const float rstd = rsqrtf(ss * (1.f / 256.f) + NORM_EPS);
                f32x4 og; og.x = bf_lo(uo[q][j].x); og.y = bf_hi(uo[q][j].x); og.z = bf_lo(uo[q][j].y); og.w = bf_hi(uo[q][j].y);
                f32x4 y;
                y.x = h.x * rstd * gv[j].x * fast_rcp(1.f + __expf(-og.x)); y.y = h.y * rstd * gv[j].y * fast_rcp(1.f + __expf(-og.y));
                y.z = h.z * rstd * gv[j].z * fast_rcp(1.f + __expf(-og.z)); y.w = h.w * rstd * gv[j].w * fast_rcp(1.f + __expf(-og.w));
                o8[64 * j] = (unsigned long long)pk2(y.x, y.y) | ((unsigned long long)pk2(y.z, y.w) << 32);
            } } }
    }
}
namespace mls {
constexpr int XS = 272, PS = 144, NCH = 68;
constexpr int O_XQ = 0, O_XK = 17408, O_XKP = 34816, O_XV = 52224, O_P = 69632, O_CT = 78848, O_OT = 113664, O_GB = 131072;
constexpr int O_RD = O_GB + 2 * 5 * 64 * 4, O_NV = O_RD + 256, O_DEC = O_NV + 1024, O_PRE = O_DEC + 64;
constexpr int LDS_BYTES = O_PRE + 3 * 72 * 4;

__device__ __forceinline__ int row_of(int b, int dir, int c, int p) {
    const int base = (c < 4) ? (RL + b * CTXL + (dir ? 192 - 64 * c : 64 * c)) : (b * SEQ + (dir ? 4032 - 64 * (c - 4) : 64 * (c - 4)));
    return base + (dir ? 63 - p : p);
}
__device__ __forceinline__ bf16x8 tr8(const LAS unsigned char* p0, const LAS unsigned char* p1) {
    typedef short v4i16_t __attribute__((ext_vector_type(4)));
    const s16x4 lo = __builtin_bit_cast(s16x4, __builtin_amdgcn_ds_read_tr16_b64_v4i16((LAS v4i16_t*)p0));
    const s16x4 hi = __builtin_bit_cast(s16x4, __builtin_amdgcn_ds_read_tr16_b64_v4i16((LAS v4i16_t*)p1));
    return (bf16x8){lo[0], lo[1], lo[2], lo[3], hi[0], hi[1], hi[2], hi[3]};
}

__device__ __forceinline__ void gate_arrays(LAS unsigned char* L, const float lf, const float ig, int c, int lane) {
    const int par = c & 1;
    const float bs = wave_scan_add(lf, lane);
    const float a = ig - bs; const float pm = wave_scan_max(a, lane);
    const float mst = ((const LAS float*)(L + O_PRE))[144 + c];
    const float M = fmaxf(mst, pm), M63 = rdlane(M, 63);
    LAS float* gb = (LAS float*)(L + O_GB) + par * 320;
    gb[lane] = a; gb[64 + lane] = M; gb[128 + lane] = __expf(mst - M); gb[192 + lane] = __expf(-bs - M); gb[256 + lane] = __expf(a - M63);
    if (lane == 0) ((LAS float*)(L + O_DEC))[par] = __expf(mst - M63);
}

__device__ __forceinline__ void mlstm_unit(Frame& F, int b, int hd, int dir, int half, const bf16_t* QKVO, const float* GATES, bf16_t* HOUT) {
    LAS unsigned char* L = F.lds;
    const int tid = F.tid, lane = F.lane, w = F.wave, fr = lane & 15, g = lane >> 4;
    const int gi = (dir * 2) * 4 + hd, gf = (dir * 2 + 1) * 4 + hd;
    LAS float* pre = (LAS float*)(L + O_PRE);
    __syncthreads();
    {
        float lfv[9], igv[9];
#pragma unroll
        for (int q = 0; q < 9; ++q) { const int c = w + 8 * q; lfv[q] = 0.f; igv[q] = 0.f;
            if (c < NCH) { const int row = row_of(b, dir, c, lane); lfv[q] = GATES[(size_t)row * 16 + gf]; igv[q] = GATES[(size_t)row * 16 + gi]; } }
#pragma unroll
        for (int q = 0; q < 9; ++q) { const int c = w + 8 * q;
            if (c < NCH) { const float bs = wave_scan_add(lfv[q], lane); float am = igv[q] - bs;
                am = fmaxf(am, dpp_f<0xB1>(am, am)); am = fmaxf(am, dpp_f<0x4E>(am, am)); am = fmaxf(am, dpp_f<0x141>(am, am)); am = fmaxf(am, dpp_f<0x140>(am, am));
                am = fmaxf(fmaxf(rdlane(am, 0), rdlane(am, 16)), fmaxf(rdlane(am, 32), rdlane(am, 48)));
                if (lane == 0) { pre[c] = rdlane(bs, 63); pre[72 + c] = am; } } }
    }
    for (int i = tid; i < (O_OT - O_CT) / 4; i += NTHREADS) ((LAS unsigned*)(L + O_CT))[i] = 0u;
    for (int i = tid; i < 256; i += NTHREADS) ((LAS float*)(L + O_NV))[i] = 0.f;
    __syncthreads();
    if (tid == 0) { float m = 0.f; for (int c = 0; c < NCH; ++c) { pre[144 + c] = m; m = pre[c] + fmaxf(m, pre[72 + c]); } }
    __syncthreads();
    if (w == 0) { const int row = row_of(b, dir, 0, lane); gate_arrays(L, GATES[(size_t)row * 16 + gf], GATES[(size_t)row * 16 + gi], 0, lane); }
    __syncthreads();
    const int qcol = hd * 128, kcol = 512 + hd * 128, vcol = 1024 + hd * 256 + half * 128;
    u32x4 rq[2], rk[2], rv[2];
#define MLS_BAR() do { asm volatile("s_waitcnt lgkmcnt(0)" ::: "memory"); __builtin_amdgcn_s_barrier(); asm volatile("" ::: "memory"); } while (0)
#define MLS_LOAD(c) do { _Pragma("unroll") for (int i_ = 0; i_ < 2; ++i_) { const int pi_ = tid + 512 * i_, p_ = pi_ >> 4, c16_ = pi_ & 15; \
        const bf16_t* rp_ = QKVO + (size_t)row_of(b, dir, (c), p_) * 3072 + c16_ * 8; \
        rq[i_] = *(const u32x4*)(rp_ + qcol); rk[i_] = *(const u32x4*)(rp_ + kcol); rv[i_] = *(const u32x4*)(rp_ + vcol); } } while (0)
#define MLS_STAGE(c) do { const LAS float* wk_ = (const LAS float*)(L + O_GB) + ((c) & 1) * 320 + 256; \
        _Pragma("unroll") for (int i_ = 0; i_ < 2; ++i_) { const int pi_ = tid + 512 * i_, p_ = pi_ >> 4, c16_ = pi_ & 15; const int o_ = p_ * XS + c16_ * 16; \
        *(LAS u32x4*)(L + O_XQ + o_) = rq[i_]; *(LAS u32x4*)(L + O_XK + o_) = rk[i_]; *(LAS u32x4*)(L + O_XV + o_) = rv[i_]; \
        const float s_ = wk_[p_]; u32x4 kk_; \
        kk_.x = pk2(bf_lo(rk[i_].x) * s_, bf_hi(rk[i_].x) * s_); kk_.y = pk2(bf_lo(rk[i_].y) * s_, bf_hi(rk[i_].y) * s_); \
        kk_.z = pk2(bf_lo(rk[i_].z) * s_, bf_hi(rk[i_].z) * s_); kk_.w = pk2(bf_lo(rk[i_].w) * s_, bf_hi(rk[i_].w) * s_); \
        *(LAS u32x4*)(L + O_XKP + o_) = kk_; } } while (0)
    MLS_LOAD(0); MLS_STAGE(0);
    __syncthreads();
    f32x4 C[8];
#pragma unroll
    for (int i = 0; i < 8; ++i) C[i] = (f32x4){0.f, 0.f, 0.f, 0.f};
    LAS unsigned char* CTw = L + O_CT + w * (16 * XS);
    float glf_n = 0.f, gig_n = 0.f;
    if (w == 7) { const int row = row_of(b, dir, 1, lane); glf_n = GATES[(size_t)row * 16 + gf]; gig_n = GATES[(size_t)row * 16 + gi]; }
    for (int c = 0; c < NCH; ++c) {
        const int par = c & 1; const bool more = (c + 1 < NCH);
        const LAS float* gb = (const LAS float*)(L + O_GB) + par * 320;
        const float glf = glf_n, gig = gig_n;
        if (w == 7 && c + 2 < NCH) { const int row = row_of(b, dir, c + 2, lane); glf_n = GATES[(size_t)row * 16 + gf]; gig_n = GATES[(size_t)row * 16 + gi]; }
        if (more) MLS_LOAD(c + 1);
#define LFENCE() do { asm volatile("s_waitcnt lgkmcnt(0)" ::: "memory"); __builtin_amdgcn_sched_barrier(0); } while (0)
#define QFRAG(mt_, ks_) (*(const LAS bf16x8*)(L + O_XQ + (16 * (mt_) + fr) * XS + (32 * (ks_) + 8 * g) * 2))
        f32x4 acc[4];
        {
            const int mt1 = w >> 1;
            bf16x8 ct[4], qa[2][4], qb[2][4];
#pragma unroll
            for (int ks = 0; ks < 4; ++ks) ct[ks] = *(const LAS bf16x8*)(CTw + fr * XS + (32 * ks + 8 * g) * 2);
#pragma unroll
            for (int m2 = 0; m2 < 2; ++m2)
#pragma unroll
                for (int ks = 0; ks < 4; ++ks) qa[m2][ks] = QFRAG(m2, ks);
            LFENCE();
#pragma unroll
            for (int m2 = 0; m2 < 2; ++m2)
#pragma unroll
                for (int ks = 0; ks < 4; ++ks) qb[m2][ks] = QFRAG(2 + m2, ks);
            __builtin_amdgcn_sched_barrier(0);
#pragma unroll
            for (int m2 = 0; m2 < 2; ++m2) { f32x4 a4 = (f32x4){0.f, 0.f, 0.f, 0.f};
#pragma unroll
                for (int ks = 0; ks < 4; ++ks) a4 = __builtin_amdgcn_mfma_f32_16x16x32_bf16(qa[m2][ks], ct[ks], a4, 0, 0, 0);
                acc[m2] = a4; }
            LFENCE();
            bf16x8 aq[4], bk[2][4];
#pragma unroll
            for (int ks = 0; ks < 4; ++ks) aq[ks] = QFRAG(mt1, ks);
#pragma unroll
            for (int n2 = 0; n2 < 2; ++n2)
#pragma unroll
                for (int ks = 0; ks < 4; ++ks) bk[n2][ks] = *(const LAS bf16x8*)(L + O_XK + (16 * (2 * (w & 1) + n2) + fr) * XS + (32 * ks + 8 * g) * 2);
            const f32x4 Mj = *(const LAS f32x4*)(gb + 64 + 16 * mt1 + 4 * g);
            float as[2]; as[0] = gb[16 * (2 * (w & 1)) + fr]; as[1] = gb[16 * (2 * (w & 1) + 1) + fr];
            f32x4 wi[4];
#pragma unroll
            for (int mt = 0; mt < 4; ++mt) wi[mt] = *(const LAS f32x4*)(gb + 128 + 16 * mt + 4 * g);
            __builtin_amdgcn_sched_barrier(0);
#pragma unroll
            for (int m2 = 0; m2 < 2; ++m2) { f32x4 a4 = (f32x4){0.f, 0.f, 0.f, 0.f};
#pragma unroll
                for (int ks = 0; ks < 4; ++ks) a4 = __builtin_amdgcn_mfma_f32_16x16x32_bf16(qb[m2][ks], ct[ks], a4, 0, 0, 0);
                acc[2 + m2] = a4; }
            LFENCE();
            f32x4 s4[2];
#pragma unroll
            for (int n2 = 0; n2 < 2; ++n2) { s4[n2] = (f32x4){0.f, 0.f, 0.f, 0.f};
#pragma unroll
                for (int ks = 0; ks < 4; ++ks) s4[n2] = __builtin_amdgcn_mfma_f32_16x16x32_bf16(aq[ks], bk[n2][ks], s4[n2], 0, 0, 0); }
#pragma unroll
            for (int mt = 0; mt < 4; ++mt) acc[mt] = acc[mt] * wi[mt];
#pragma unroll
            for (int n2 = 0; n2 < 2; ++n2) { const int sidx = 16 * (2 * (w & 1) + n2) + fr;
#pragma unroll
                for (int reg = 0; reg < 4; ++reg) { const int j = 16 * mt1 + 4 * g + reg;
                    const float pv = (sidx <= j) ? s4[n2][reg] * __expf(as[n2] - Mj[reg]) : 0.f;
                    *(LAS bf16_t*)(L + O_P + j * PS + sidx * 2) = (bf16_t)f2bf(pv); } }
        }
        MLS_BAR();
        bf16x8 vf[2];
        float rdv; float nsum;
        const float decay = ((const LAS float*)(L + O_DEC))[par];
        {
            const LAS unsigned char* vb = L + O_XV + (8 * g + (fr >> 2)) * XS + (16 * w + (lane & 3) * 4) * 2;
            const LAS unsigned char* kb = L + O_XKP + (8 * g + (fr >> 2)) * XS + ((lane & 3) * 4) * 2;
            bf16x8 ap[4][2];
#pragma unroll
            for (int k2 = 0; k2 < 2; ++k2) vf[k2] = tr8(vb + 32 * k2 * XS, vb + (32 * k2 + 4) * XS);
#pragma unroll
            for (int mt = 0; mt < 4; ++mt)
#pragma unroll
                for (int k2 = 0; k2 < 2; ++k2) ap[mt][k2] = *(const LAS bf16x8*)(L + O_P + (16 * mt + fr) * PS + (32 * k2 + 8 * g) * 2);
            LFENCE();
            const int j = tid >> 3, part = tid & 7;
            const u32x4 pu = *(const LAS u32x4*)(L + O_P + j * PS + part * 16);
            const u32x4 q0 = *(const LAS u32x4*)(L + O_XQ + j * XS + part * 32), q1 = *(const LAS u32x4*)(L + O_XQ + j * XS + part * 32 + 16);
            const LAS f32x4* np = (const LAS f32x4*)(L + O_NV + par * 512 + part * 64);
            const f32x4 n0 = np[0], n1 = np[1], n2 = np[2], n3 = np[3];
            const float wint_j = gb[128 + j], emq_j = gb[192 + j];
            bf16x8 ak[4][2];
#pragma unroll
            for (int mt = 0; mt < 4; ++mt)
#pragma unroll
                for (int k2 = 0; k2 < 2; ++k2) ak[mt][k2] = tr8(kb + 32 * k2 * XS + 32 * mt, kb + (32 * k2 + 4) * XS + 32 * mt);
            __builtin_amdgcn_sched_barrier(0);
#pragma unroll
            for (int mt = 0; mt < 4; ++mt)
#pragma unroll
                for (int k2 = 0; k2 < 2; ++k2) acc[mt] = __builtin_amdgcn_mfma_f32_16x16x32_bf16(ap[mt][k2], vf[k2], acc[mt], 0, 0, 0);
            LFENCE();
            const int dk = tid >> 2, part4 = tid & 3; bf16_t kc[16];
#pragma unroll
            for (int t = 0; t < 16; ++t) kc[t] = *(const LAS bf16_t*)(L + O_XKP + (16 * part4 + t) * XS + dk * 2);
            const float nold = ((const LAS float*)(L + O_NV))[par * 128 + dk];
            __builtin_amdgcn_sched_barrier(0);
#pragma unroll
            for (int mt = 0; mt < 4; ++mt) { f32x4 c4 = C[mt] * decay;
#pragma unroll
                for (int k2 = 0; k2 < 2; ++k2) c4 = __builtin_amdgcn_mfma_f32_16x16x32_bf16(ak[mt][k2], vf[k2], c4, 0, 0, 0);
                C[mt] = c4; }
            float rs = (bf_lo(pu.x) + bf_hi(pu.x)) + (bf_lo(pu.y) + bf_hi(pu.y)) + (bf_lo(pu.z) + bf_hi(pu.z)) + (bf_lo(pu.w) + bf_hi(pu.w));
            float qn = bf_lo(q0.x) * n0.x + bf_hi(q0.x) * n0.y + bf_lo(q0.y) * n0.z + bf_hi(q0.y) * n0.w
                     + bf_lo(q0.z) * n1.x + bf_hi(q0.z) * n1.y + bf_lo(q0.w) * n1.z + bf_hi(q0.w) * n1.w
                     + bf_lo(q1.x) * n2.x + bf_hi(q1.x) * n2.y + bf_lo(q1.y) * n2.z + bf_hi(q1.y) * n2.w
                     + bf_lo(q1.z) * n3.x + bf_hi(q1.z) * n3.y + bf_lo(q1.w) * n3.z + bf_hi(q1.w) * n3.w;
            rs = oct_sum(rs); qn = oct_sum(qn);
            rdv = 1.f / fmaxf(fabsf(rs + wint_j * qn), emq_j);
            float sm0 = 0.f;
#pragma unroll
            for (int t = 0; t < 16; ++t) sm0 += bf2f(kc[t]);
            __builtin_amdgcn_sched_barrier(0);
#pragma unroll
            for (int mt = 0; mt < 4; ++mt)
#pragma unroll
                for (int k2 = 0; k2 < 2; ++k2) ak[mt][k2] = tr8(kb + 32 * k2 * XS + 32 * (4 + mt), kb + (32 * k2 + 4) * XS + 32 * (4 + mt));
            LFENCE();
#pragma unroll
            for (int mt = 0; mt < 4; ++mt) { f32x4 c4 = C[4 + mt] * decay;
#pragma unroll
                for (int k2 = 0; k2 < 2; ++k2) c4 = __builtin_amdgcn_mfma_f32_16x16x32_bf16(ak[mt][k2], vf[k2], c4, 0, 0, 0);
                C[4 + mt] = c4; }
            float sm = quad_sum(sm0);
            nsum = decay * nold + sm;
        }
#undef LFENCE
#undef QFRAG
        asm volatile("" ::: "memory");
        if ((tid & 7) == 0) ((LAS float*)(L + O_RD))[tid >> 3] = rdv;
        if ((tid & 3) == 0) ((LAS float*)(L + O_NV))[(par ^ 1) * 128 + (tid >> 2)] = nsum;
#pragma unroll
        for (int mt = 0; mt < 8; ++mt) { u32x2 o; o.x = pk2(C[mt][0], C[mt][1]); o.y = pk2(C[mt][2], C[mt][3]);
            *(LAS u32x2*)(CTw + fr * XS + (16 * mt + 4 * g) * 2) = o; }
        if (more && w == 7) gate_arrays(L, glf, gig, c + 1, lane);
        MLS_BAR();
        {
#pragma unroll
            for (int mt = 0; mt < 4; ++mt) { const f32x4 rd = *(const LAS f32x4*)(L + O_RD + (16 * mt + 4 * g) * 4);
#pragma unroll
                for (int reg = 0; reg < 4; ++reg) *(LAS bf16_t*)(L + O_OT + (16 * mt + 4 * g + reg) * XS + (16 * w + fr) * 2) = (bf16_t)f2bf(acc[mt][reg] * rd[reg]); }
            if (more) MLS_STAGE(c + 1);
        }
        MLS_BAR();
        {
            const int j = tid >> 3, ch = tid & 7;
            const u32x4 o0 = *(const LAS u32x4*)(L + O_OT + j * XS + ch * 32), o1 = *(const LAS u32x4*)(L + O_OT + j * XS + ch * 32 + 16);
            bf16_t* op = HOUT + (size_t)row_of(b, dir, c, j) * D + hd * 256 + half * 128 + ch * 16;
            *(u32x4*)op = o0; *(u32x4*)(op + 8) = o1;
        }
    }
#undef MLS_BAR
#undef MLS_LOAD
#undef MLS_STAGE
}
}
constexpr int MISC_OFF = 135936, LDS_TOTAL = 136192;
static_assert(mls::LDS_BYTES <= MISC_OFF && pg8::STAGE_BYTES <= MISC_OFF && attn_body::LDS_BYTES <= MISC_OFF, "lds");
#ifndef EN_MASK
#define EN_MASK 0xFFFFFFFFu
#endif
#define PH_ON(k) (((EN_MASK) >> (k)) & 1u)
#ifndef REP_MASK
#define REP_MASK 0u
#endif
#define REP_ON(k) (((REP_MASK) >> (k)) & 1u)
#ifndef PH_LIMIT
#define PH_LIMIT 1000
#endif
#ifndef N_LAUNCH_SPLIT
#define N_LAUNCH_SPLIT 0
#endif
constexpr int N_PHASES = 1 + 10 + 9 + 9 + 9;

struct Args { const float* in[21]; float* out; unsigned char* ws; int ph_lo, ph_hi; };
static_assert(sizeof(Args) == 23 * 8 + 8, "no padding");

__device__ __forceinline__ Frame make_frame(unsigned char* lds_gen, unsigned char* ws_, const int wave_s) {
    Frame F; int ln; asm volatile("v_mbcnt_lo_u32_b32 %0, -1, 0\n\tv_mbcnt_hi_u32_b32 %0, -1, %0" : "=v"(ln));
    int wv = wave_s; asm volatile("" : "+s"(wv));
    int bx = blockIdx.x; asm volatile("" : "+s"(bx));
    F.lds = (LAS unsigned char*)lds_gen; F.tid = wv * 64 + ln; F.lane = ln; F.wave = wv;
    F.G = gridDim.x; F.bid = bx; F.vcu = (F.G % 8 == 0) ? (bx % 8) * (F.G / 8) + bx / 8 : bx;
    F.gw = F.vcu * NWAVES + F.wave; F.NGW = F.G * NWAVES;
    unsigned long long wi = (unsigned long long)ws_; asm volatile("" : "+s"(wi)); GAS unsigned char* wg = (GAS unsigned char*)wi;
    F.ws = (unsigned char*)wg; F.inq = (const unsigned long long*)(GAS const unsigned long long*)(wg + WS_PTRS); return F;
}
__global__ void __launch_bounds__(NTHREADS, 2) fwd(Args a) {
    extern __shared__ __attribute__((aligned(16))) unsigned char lds_raw[];
    unsigned char* const lds_gen = lds_raw;
    const int wave_s = __builtin_amdgcn_readfirstlane((int)threadIdx.x >> 6);
    unsigned char* ws = a.ws;
    if (threadIdx.x < 4) ((LAS unsigned*)((LAS unsigned char*)lds_raw + MISC_OFF))[threadIdx.x] = 0u;
    __syncthreads();
    XcdBarrier bar = xcd_barrier_post((unsigned*)(ws + WS_CTL), (volatile LAS unsigned*)((LAS unsigned char*)lds_raw + MISC_OFF));
    int cur = 0; const int lo = a.ph_lo, hi = a.ph_hi & 0xffff; bool ran = false;
#define PHASE_BEGIN if (cur >= lo && cur < hi) { if (ran) xcd_barrier(bar, wave_s); ran = true;
#define PHASE_END   } ++cur;

    if (blockIdx.x == 0 && threadIdx.x < 22) ((const float**)(ws + WS_PTRS))[threadIdx.x] = (threadIdx.x < 21) ? a.in[threadIdx.x] : (const float*)a.out;
#define XL ((float*)(GAS float*)(F.inq[21]))
#define X16 ((bf16_t*)(F.ws + WS_X16))
#define H ((bf16_t*)(F.ws + WS_H))
#define MIX ((bf16_t*)(F.ws + WS_MIX))
#define BIG0 ((bf16_t*)(F.ws + WS_BIG0))
#define BIG1 ((bf16_t*)(F.ws + WS_BIG1))
#define GATES ((float*)(F.ws + WS_GATES))
#define AFF ((float*)(F.ws + WS_AFF))
#define INV ((int*)(F.ws + WS_INV))
#define SLROW ((int*)(F.ws + WS_SLROW))
#define SLG ((float*)(F.ws + WS_SLG))
#define IN(k) ((const float*)(GAS const float*)(F.inq[k]))

    PHASE_BEGIN if (PH_ON(0)) for (int rep_ = 0; rep_ < (REP_ON(0) ? 2 : 1); ++rep_) { if (rep_) xcd_barrier(bar, wave_s); Frame F = make_frame(lds_gen, a.ws, wave_s); p0_prologue(F, a.in, F.ws); } PHASE_END

    for (int layer = 0; layer < DEPTH; ++layer) {
        const bool last = (layer == DEPTH - 1); const int j = layer >> 1;
#define modv ((const float*)(F.ws + WS_MODV) + (size_t)layer * NMI * 6 * D)
#define xLs ((layer == 0) ? IN(0) : (const float*)XL)
#define xCs ((layer == 0) ? IN(2) : (const float*)XC)
        if ((layer & 1) == 0) {
            if (layer == 0) { PHASE_BEGIN if (PH_ON(1)) for (int rep_ = 0; rep_ < (REP_ON(1) ? 2 : 1); ++rep_) { if (rep_) xcd_barrier(bar, wave_s); Frame F = make_frame(lds_gen, a.ws, wave_s); norm_pass<1>(F, IN(0), IN(2), RT, IN(6) + layer * D, modv + 0 * D, modv + 1 * D, H, IN(8) + (size_t)j * D * MW_IN + 3072, MW_IN, IN(9) + j * 16, GATES); } PHASE_END }
            PHASE_BEGIN if (PH_ON(2)) for (int rep_ = 0; rep_ < (REP_ON(2) ? 2 : 1); ++rep_) { if (rep_) xcd_barrier(bar, wave_s); Frame F = make_frame(lds_gen, a.ws, wave_s); { pg8::PlainSched S{(const char*)H, (const char*)((bf16_t*)(F.ws + WS_WMI) + (size_t)j * 3072 * D), RT / 256, 12, D, F.G, F.bid};
                pg8::EpiBf16 E{BIG0, 3072, 2, 0.08838834764831845f}; pg8::gemm_phase(F.lds, F.tid, D, S, E); moe_weights(F, IN(17) + (size_t)layer * NE * D * D, IN(18) + (size_t)layer * NE * D * D, IN(19) + (size_t)layer * NE * D * D, F.ws, (unsigned*)(F.ws + WS_CNT) + 16 * layer); } } PHASE_END
            PHASE_BEGIN if (PH_ON(3)) for (int rep_ = 0; rep_ < (REP_ON(3) ? 2 : 1); ++rep_) { if (rep_) xcd_barrier(bar, wave_s); Frame F = make_frame(lds_gen, a.ws, wave_s); for (int u = F.vcu; u < 256; u += F.G) { const int half = u & 1, dir = (u >> 1) & 1, hd = (u >> 2) & 3, b = u >> 4;
                mls::mlstm_unit(F, b, hd, dir, half, BIG0, GATES, dir ? MIX : H); } } PHASE_END
            PHASE_BEGIN if (PH_ON(4)) for (int rep_ = 0; rep_ < (REP_ON(4) ? 2 : 1); ++rep_) { if (rep_) xcd_barrier(bar, wave_s); Frame F = make_frame(lds_gen, a.ws, wave_s); mlstm_readout(F, H, MIX, BIG0, IN(10) + j * D, MIX); } PHASE_END
            PHASE_BEGIN if (PH_ON(5)) for (int rep_ = 0; rep_ < (REP_ON(5) ? 2 : 1); ++rep_) { if (rep_) xcd_barrier(bar, wave_s); Frame F = make_frame(lds_gen, a.ws, wave_s); { pg8::PlainSched S{(const char*)MIX, (const char*)((bf16_t*)(F.ws + WS_WMO) + (size_t)j * D * D), RT / 256, 4, D, F.G, F.bid};
                pg8::EpiResid E{IN(0), IN(2), X16, modv + 2 * D, layer == 0}; pg8::gemm_phase(F.lds, F.tid, D, S, E); moe_weights(F, IN(17) + (size_t)layer * NE * D * D, IN(18) + (size_t)layer * NE * D * D, IN(19) + (size_t)layer * NE * D * D, F.ws, (unsigned*)(F.ws + WS_CNT) + 16 * layer); } } PHASE_END
        } else {
#define KALL BIG1
#define VALL (BIG1 + (size_t)NB * KVLEN * 256)
            PHASE_BEGIN if (PH_ON(7)) for (int rep_ = 0; rep_ < (REP_ON(7) ? 2 : 1); ++rep_) { if (rep_) xcd_barrier(bar, wave_s); Frame F = make_frame(lds_gen, a.ws, wave_s); { pg8::PlainSched S{(const char*)H, (const char*)((bf16_t*)(F.ws + WS_WAI) + (size_t)j * 1536 * D), RT / 256, 6, D, F.G, F.bid};
                pg8::EpiBf16 E{BIG0, 1536, 0, 1.f}; pg8::gemm_phase(F.lds, F.tid, D, S, E); moe_weights(F, IN(17) + (size_t)layer * NE * D * D, IN(18) + (size_t)layer * NE * D * D, IN(19) + (size_t)layer * NE * D * D, F.ws, (unsigned*)(F.ws + WS_CNT) + 16 * layer); } } PHASE_END
            PHASE_BEGIN if (PH_ON(8)) for (int rep_ = 0; rep_ < (REP_ON(8) ? 2 : 1); ++rep_) { if (rep_) xcd_barrier(bar, wave_s); Frame F = make_frame(lds_gen, a.ws, wave_s); qk_pass(F, BIG0, IN(13) + j * 64, IN(14) + j * 64, (const float*)(F.ws + WS_ROPE), (const float*)(F.ws + WS_ROPE) + SEQ * 32, KALL, VALL); } PHASE_END
            PHASE_BEGIN if (PH_ON(9)) for (int rep_ = 0; rep_ < (REP_ON(9) ? 2 : 1); ++rep_) { if (rep_) xcd_barrier(bar, wave_s); Frame F = make_frame(lds_gen, a.ws, wave_s); { const int nun = last ? 4096 : 4096 + 256;
                float mfix; { float gq = fabsf(IN(13)[j * 64 + F.lane]), gk = fabsf(IN(14)[j * 64 + F.lane]);
#pragma unroll
                    for (int o = 1; o < 64; o <<= 1) { gq = fmaxf(gq, __shfl_xor(gq, o)); gk = fmaxf(gk, __shfl_xor(gk, o)); }
                    mfix = attn_body::C2 * 64.f * gq * gk; }
                for (int L = F.vcu; L < nun; L += F.G) {
                    const bool isc = L >= 4096; const int Lc = L - 4096;
                    const int grp = L >> 6, wi = L & 63;
                    const int b = isc ? (Lc >> 4) : (grp >> 2), hq = isc ? (Lc & 15) : ((grp & 3) * 4 + (wi >> 4));
                    const size_t row0 = isc ? ((size_t)RL + b * CTXL) : ((size_t)b * SEQ + (wi & 15) * 256);
                    const bf16_t* qp = BIG0 + row0 * 1536 + hq * 64; const bf16_t* kp = KALL + (size_t)b * KVLEN * 256 + (hq >> 2) * 64; const bf16_t* vp = VALL + (size_t)b * KVLEN * 256 + (hq >> 2) * 64; bf16_t* op = MIX + row0 * D + hq * 64;
                    if (isc) attn_body::attn_unit<8>(qp, 1536, kp, vp, 256, CTXL / 64, op, D, (char*)lds_gen, F.tid, mfix);
                    else     attn_body::attn_unit<8>(qp, 1536, kp, vp, 256, KVLEN / 64, op, D, (char*)lds_gen, F.tid, mfix); } } } PHASE_END
            PHASE_BEGIN if (PH_ON(10)) for (int rep_ = 0; rep_ < (REP_ON(10) ? 2 : 1); ++rep_) { if (rep_) xcd_barrier(bar, wave_s); Frame F = make_frame(lds_gen, a.ws, wave_s); { pg8::PlainSched S{(const char*)MIX, (const char*)((bf16_t*)(F.ws + WS_WAO) + (size_t)j * D * D), (last ? RL : RT) / 256, 4, D, F.G, F.bid};
                pg8::EpiResid E{IN(0), IN(2), X16, modv + 2 * D, layer == 0}; pg8::gemm_phase(F.lds, F.tid, D, S, E); moe_weights(F, IN(17) + (size_t)layer * NE * D * D, IN(18) + (size_t)layer * NE * D * D, IN(19) + (size_t)layer * NE * D * D, F.ws, (unsigned*)(F.ws + WS_CNT) + 16 * layer); } } PHASE_END
        }
        const int nrows = last ? RL : RT;
        PHASE_BEGIN if (PH_ON(11)) for (int rep_ = 0; rep_ < (REP_ON(11) ? 2 : 1); ++rep_) { if (rep_) xcd_barrier(bar, wave_s); Frame F = make_frame(lds_gen, a.ws, wave_s); moe_weights(F, IN(17) + (size_t)layer * NE * D * D, IN(18) + (size_t)layer * NE * D * D, IN(19) + (size_t)layer * NE * D * D, F.ws, (unsigned*)(F.ws + WS_CNT) + 16 * layer);
            norm_pass<2, MOE_FP8_1 != 0, true>(F, (const float*)X16, nullptr, nrows, IN(7) + layer * D, modv + 3 * D, modv + 4 * D, H, IN(16) + (size_t)layer * D * 16, 16, nullptr, AFF); } PHASE_END
        PHASE_BEGIN if (PH_ON(12)) for (int rep_ = 0; rep_ < (REP_ON(12) ? 2 : 1); ++rep_) { if (rep_) xcd_barrier(bar, wave_s); Frame F = make_frame(lds_gen, a.ws, wave_s); moe_select(F, AFF, INV, SLROW, SLG, last ? NB * NE : 2 * NB * NE); } PHASE_END
        PHASE_BEGIN if (PH_ON(14)) for (int rep_ = 0; rep_ < (REP_ON(14) ? 2 : 1); ++rep_) { if (rep_) xcd_barrier(bar, wave_s); Frame F = make_frame(lds_gen, a.ws, wave_s); { constexpr int K1 = MOE_FP8_1 ? D / 2 : D;
            pg8::MoeSched S{(const char*)H, (const char*)(F.ws + WS_W1), last ? 32 : 34, 8, K1, 2048, F.G, F.bid};
            pg8::EpiSwiglu E{(void*)BIG1, MOE_FP8_1 ? 1.f / (FP8_SH * FP8_SW) : 1.f, MOE_FP8_2 != 0}; pg8::gemm_phase<pg8::EpiSwiglu, pg8::MoeSched, true, MOE_FP8_1 != 0>(F.lds, F.tid, K1, S, E, SLROW); } } PHASE_END
        PHASE_BEGIN if (PH_ON(15)) for (int rep_ = 0; rep_ < (REP_ON(15) ? 2 : 1); ++rep_) { if (rep_) xcd_barrier(bar, wave_s); Frame F = make_frame(lds_gen, a.ws, wave_s); { constexpr int K2 = MOE_FP8_2 ? D / 2 : D;
            pg8::MoeSched S{(const char*)BIG1, (const char*)(F.ws + WS_W2), last ? 32 : 34, 4, K2, 1024, F.G, F.bid};
            pg8::EpiRowScale E{BIG0, SLG, MOE_FP8_2 ? 1.f / (FP8_SA * FP8_SW) : 1.f}; pg8::gemm_phase<pg8::EpiRowScale, pg8::MoeSched, false, MOE_FP8_2 != 0>(F.lds, F.tid, K2, S, E); } } PHASE_END
        PHASE_BEGIN if (PH_ON(16)) for (int rep_ = 0; rep_ < (REP_ON(16) ? 2 : 1); ++rep_) { if (rep_) xcd_barrier(bar, wave_s); Frame F = make_frame(lds_gen, a.ws, wave_s);
            const int nl = layer + 1; const float* modn = (const float*)(F.ws + WS_MODV) + (size_t)nl * NMI * 6 * D;
            if (last) combine_norm<3>(F, BIG0, INV, X16, XL, modv + 5 * D, RL, IN(20), nullptr, nullptr, nullptr, nullptr, 0, nullptr, nullptr);
            else if (nl & 1) combine_norm<0>(F, BIG0, INV, X16, nullptr, modv + 5 * D, RT, IN(6) + nl * D, modn + 0 * D, modn + 1 * D, H, nullptr, 0, nullptr, nullptr);
            else combine_norm<1>(F, BIG0, INV, X16, nullptr, modv + 5 * D, RT, IN(6) + nl * D, modn + 0 * D, modn + 1 * D, H, IN(8) + (size_t)(nl >> 1) * D * MW_IN + 3072, MW_IN, IN(9) + (nl >> 1) * 16, GATES); } PHASE_END
    }
#undef XL
#undef X16
#undef H
#undef MIX
#undef BIG0
#undef BIG1
#undef GATES
#undef AFF
#undef INV
#undef SLROW
#undef SLG
#undef IN
#undef modv
#undef xLs
#undef xCs
#undef KALL
#undef VALL
#undef PHASE_BEGIN
#undef PHASE_END
}

extern "C" void kernel_launch(void* const* d_in, const int* in_sizes, int n_in, void* d_out, int out_size, void* d_ws, size_t ws_size, hipStream_t stream) {
    static int grid = 0;
    if (grid == 0) {
        if (n_in != 21 || out_size != RL * D || ws_size < WS_END) { fprintf(stderr, "kernel_launch: unexpected shapes: n_in %d out %d ws %zu (need %zu)\n", n_in, out_size, ws_size, (size_t)WS_END); grid = -1; return; }
        int dev = 0, cus = 0, per_cu = 0;
        if (hipGetDevice(&dev) != hipSuccess || hipDeviceGetAttribute(&cus, hipDeviceAttributeMultiprocessorCount, dev) != hipSuccess) { grid = -1; return; }
        if (hipFuncSetAttribute((const void*)fwd, hipFuncAttributeMaxDynamicSharedMemorySize, LDS_TOTAL) != hipSuccess) { fprintf(stderr, "kernel_launch: hipFuncSetAttribute failed\n"); grid = -1; return; }
        if (hipOccupancyMaxActiveBlocksPerMultiprocessor(&per_cu, (const void*)fwd, NTHREADS, LDS_TOTAL) != hipSuccess || per_cu < 1) fprintf(stderr, "kernel_launch: occupancy query says %d\n", per_cu);
        (void)hipGetLastError();
        grid = cus;
    }
    if (grid < 0) return;
    (void)in_sizes;
    if (hipMemsetAsync((char*)d_ws + WS_CTL, 0, CTL_BYTES, stream) != hipSuccess) return;
    Args a{};
    for (int i = 0; i < 21; ++i) a.in[i] = (const float*)d_in[i];
    a.out = (float*)d_out; a.ws = (unsigned char*)d_ws;
    const int nph = N_PHASES < PH_LIMIT ? N_PHASES : PH_LIMIT;
#if N_LAUNCH_SPLIT
    for (int p = 0; p < nph; ++p) { a.ph_lo = p; a.ph_hi = p + 1; hipLaunchKernelGGL(fwd, dim3(grid), dim3(NTHREADS), LDS_TOTAL, stream, a); }
#else
    a.ph_lo = 0; a.ph_hi = nph;
    hipLaunchKernelGGL(fwd, dim3(grid), dim3(NTHREADS), LDS_TOTAL, stream, a);
#endif
    const hipError_t le = hipPeekAtLastError();
    if (le != hipSuccess) fprintf(stderr, "kernel_launch: launch failed: %s\n", hipGetErrorName(le));
}
```

```cpp
#include <hip/hip_runtime.h>
#include <cstdio>
#include <cstdint>

#define GAS __attribute__((address_space(1)))
#define LAS __attribute__((address_space(3)))
typedef unsigned short bf16_t;
typedef short bf16x8 __attribute__((ext_vector_type(8)));
typedef short s16x4 __attribute__((ext_vector_type(4)));
typedef float f32x4 __attribute__((ext_vector_type(4)));
typedef float f32x2 __attribute__((ext_vector_type(2)));
typedef float f32x16 __attribute__((ext_vector_type(16)));
typedef unsigned u32x4 __attribute__((ext_vector_type(4)));
typedef unsigned u32x2 __attribute__((ext_vector_type(2)));

constexpr int D = 1024, NB = 16, SEQ = 4096, CTXL = 256, DEPTH = 4;
constexpr int RL = NB * SEQ, RC = NB * CTXL, RT = RL + RC;
constexpr int NE = 16, CAP_L = 512, CAP_C = 32, SLOTS_E = NB * CAP_L + NB * CAP_C;
constexpr int NMI = NB + 1;
constexpr int MW_IN = 3088;
constexpr int KVLEN = CTXL + SEQ;
constexpr int NWAVES = 8, NTHREADS = 512;
constexpr float NORM_EPS = 1e-6f;

#ifndef MOE_FP8_1
#define MOE_FP8_1 1
#endif
#ifndef MOE_FP8_2
#define MOE_FP8_2 1
#endif
constexpr size_t al256(size_t x) { return (x + 255) & ~(size_t)255; }
constexpr size_t WS_CTL   = 0;
constexpr size_t CTL_BYTES = 16384;
constexpr size_t WS_CNT   = WS_CTL + 14336;
constexpr size_t WS_PTRS  = WS_CTL + CTL_BYTES;
constexpr size_t WS_MODV  = WS_PTRS + 256;
constexpr size_t WS_ROPE  = al256(WS_MODV + (size_t)DEPTH * NMI * 6 * D * 4);
constexpr size_t WS_X16   = al256(WS_ROPE + (size_t)2 * SEQ * 32 * 4);
constexpr size_t WS_GATES = al256(WS_X16 + (size_t)RT * D * 2);
constexpr size_t WS_AFF   = al256(WS_GATES + (size_t)RT * 16 * 4);
constexpr size_t WS_INV   = al256(WS_AFF + (size_t)RT * 16 * 4);
constexpr size_t WS_SLROW = al256(WS_INV + (size_t)RT * 16 * 4);
constexpr size_t WS_SLG   = al256(WS_SLROW + (size_t)NE * SLOTS_E * 4);
constexpr size_t WS_WMI   = al256(WS_SLG + (size_t)NE * SLOTS_E * 4);
constexpr size_t WS_WMO   = al256(WS_WMI + (size_t)2 * 3072 * D * 2);
constexpr size_t WS_WAI   = al256(WS_WMO + (size_t)2 * D * D * 2);
constexpr size_t WS_WAO   = al256(WS_WAI + (size_t)2 * 1536 * D * 2);
constexpr size_t WS_W1    = al256(WS_WAO + (size_t)2 * D * D * 2);
constexpr size_t WS_W2    = al256(WS_W1 + (size_t)NE * 2048 * D * 2);
constexpr size_t WS_H     = al256(WS_W2 + (size_t)NE * D * D * 2);
constexpr size_t WS_MIX   = al256(WS_H + (size_t)RT * D * 2);
constexpr size_t WS_BIG0  = al256(WS_MIX + (size_t)RT * D * 2);
constexpr size_t BIG_HALF = (size_t)NE * SLOTS_E * D * 2;
constexpr size_t WS_BIG1  = al256(WS_BIG0 + BIG_HALF);
constexpr size_t BIG1_BYTES = MOE_FP8_2 ? BIG_HALF / 2 : BIG_HALF;
constexpr size_t WS_END   = al256(WS_BIG1 + BIG1_BYTES);
static_assert((size_t)RT * 3072 * 2 <= BIG_HALF + BIG1_BYTES && (size_t)2 * NB * KVLEN * 256 * 2 <= BIG1_BYTES, "qkvo / kv fit");

#define LDS_WAIT() asm volatile("s_waitcnt lgkmcnt(0)" ::: "memory")
#define VM_WAIT() asm volatile("s_waitcnt vmcnt(0)" ::: "memory")
typedef __bf16 bf16x2_t __attribute__((ext_vector_type(2)));
__device__ __forceinline__ unsigned pk2(float lo, float hi) { f32x2 v = {lo, hi}; bf16x2_t b = __builtin_convertvector(v, bf16x2_t); return __builtin_bit_cast(unsigned, b); }
__device__ __forceinline__ unsigned f2bf(float f) { return pk2(f, f) & 0xffffu; }
__device__ __forceinline__ float bf_lo(unsigned u) { return __builtin_bit_cast(float, u << 16); }
__device__ __forceinline__ float bf_hi(unsigned u) { return __builtin_bit_cast(float, u & 0xffff0000u); }
__device__ __forceinline__ float bf2f(bf16_t b) { return __builtin_bit_cast(float, ((unsigned)b) << 16); }
__device__ __forceinline__ unsigned pk_fp8x4(float a, float b, float c, float d) {
    a = __builtin_amdgcn_fmed3f(a, -448.f, 448.f); b = __builtin_amdgcn_fmed3f(b, -448.f, 448.f); c = __builtin_amdgcn_fmed3f(c, -448.f, 448.f); d = __builtin_amdgcn_fmed3f(d, -448.f, 448.f);
    int p = __builtin_amdgcn_cvt_pk_fp8_f32(a, b, 0, false); p = __builtin_amdgcn_cvt_pk_fp8_f32(c, d, p, true); return (unsigned)p; }
#ifndef MOE_Y_FP8
#define MOE_Y_FP8 1
#endif
constexpr float FP8_SH = 16.f, FP8_SW = 512.f, FP8_SA = 8.f, FP8_SY = 256.f;
template <int CTRL> __device__ __forceinline__ float dpp_f(float old, float v) { return __builtin_bit_cast(float, __builtin_amdgcn_update_dpp(__builtin_bit_cast(int, old), __builtin_bit_cast(int, v), CTRL, 0xf, 0xf, false)); }
__device__ __forceinline__ float rdlane(float v, int l) { return __builtin_bit_cast(float, __builtin_amdgcn_readlane(__builtin_bit_cast(int, v), l)); }
__device__ __forceinline__ float row16_sum(float v) {
    v += dpp_f<0xB1>(0.f, v); v += dpp_f<0x4E>(0.f, v); v += dpp_f<0x141>(0.f, v); v += dpp_f<0x140>(0.f, v); return v; }
__device__ __forceinline__ float oct_sum(float v) {
    v += dpp_f<0xB1>(0.f, v); v += dpp_f<0x4E>(0.f, v); v += dpp_f<0x141>(0.f, v); return v; }
__device__ __forceinline__ float quad_sum(float v) { v += dpp_f<0xB1>(0.f, v); v += dpp_f<0x4E>(0.f, v); return v; }
__device__ __forceinline__ float wave_sum(float v) {
    v = row16_sum(v); return (rdlane(v, 0) + rdlane(v, 16)) + (rdlane(v, 32) + rdlane(v, 48)); }
__device__ __forceinline__ float wave_scan_add(float v, int lane) {
    v += dpp_f<0x111>(0.f, v); v += dpp_f<0x112>(0.f, v); v += dpp_f<0x114>(0.f, v); v += dpp_f<0x118>(0.f, v);
    const float t0 = rdlane(v, 15), t1 = rdlane(v, 31), t2 = rdlane(v, 47);
    const int row = lane >> 4; return v + (row == 0 ? 0.f : row == 1 ? t0 : row == 2 ? t0 + t1 : (t0 + t1) + t2); }
__device__ __forceinline__ float wave_scan_max(float v, int lane) {
    const float NI = -INFINITY;
    v = fmaxf(v, dpp_f<0x111>(NI, v)); v = fmaxf(v, dpp_f<0x112>(NI, v)); v = fmaxf(v, dpp_f<0x114>(NI, v)); v = fmaxf(v, dpp_f<0x118>(NI, v));
    const float t0 = rdlane(v, 15), t1 = rdlane(v, 31), t2 = rdlane(v, 47);
    const int row = lane >> 4; return fmaxf(v, row == 0 ? NI : row == 1 ? t0 : row == 2 ? fmaxf(t0, t1) : fmaxf(fmaxf(t0, t1), t2)); }
__device__ __forceinline__ float fast_exp(float x) { return __builtin_amdgcn_exp2f(x * 1.4426950408889634f); }
__device__ __forceinline__ float fast_rcp(float x) { return __builtin_amdgcn_rcpf(x); }
__device__ __forceinline__ float silu_f(float x) { return x / (1.f + __expf(-x)); }

#define XB_TMO      128
#define XB_XCNT(j)  (256  + 64 * (j))
#define XB_XSUB(j)  (1280 + 64 * (j))
#define XB_XGEN(j)  (2304 + 64 * (j))
#define XB_TOP      3328
#define XB_TOPGEN   3392
#define XCD_BAR_WORDS 3456
#define XB_SPIN_CAP (1u << 21)
static_assert(XCD_BAR_WORDS * 4 <= CTL_BYTES, "ctl");

__device__ __forceinline__ unsigned xb_ld(unsigned* p)              { return __hip_atomic_load(p, __ATOMIC_RELAXED, __HIP_MEMORY_SCOPE_AGENT); }
__device__ __forceinline__ unsigned xb_add(unsigned* p, unsigned v) { return __hip_atomic_fetch_add(p, v, __ATOMIC_RELAXED, __HIP_MEMORY_SCOPE_AGENT); }
__device__ __forceinline__ unsigned xb_xcc_id() { return (unsigned)__builtin_amdgcn_s_getreg((3 << 11) | 20) & 0xFu; }
#define XB_SPIN(cond, bar) do { unsigned _sp = 0; while (cond) { __builtin_amdgcn_s_sleep(1); \
    if ((++_sp & 255u) == 0u) { if (xb_ld(&(bar)[XB_TMO])) break; if (_sp > XB_SPIN_CAP) { atomicAdd(&(bar)[XB_TMO], 1u); break; } } } } while (0)

struct XcdBarrier { unsigned* bar; unsigned x; volatile LAS unsigned* st; };

__device__ __forceinline__ XcdBarrier xcd_barrier_post(unsigned* bar, volatile LAS unsigned* st) {
    XcdBarrier b; b.bar = bar; b.x = xb_xcc_id(); b.st = st;
    if (threadIdx.x == 0) (void)xb_add(&bar[XB_XCNT(b.x)], 1u);
    return b;
}
__device__ __forceinline__ void xcd_barrier_complete(unsigned* bar, unsigned x, unsigned& nloc, unsigned& nx) {
    const unsigned G = gridDim.x * gridDim.y * gridDim.z;
    unsigned sum, cnt, mine, sp = 0u;
    for (;;) {
        sum = 0u; cnt = 0u; mine = 0u;
#pragma unroll
        for (unsigned j = 0; j < 16; ++j) { const unsigned c = xb_ld(&bar[XB_XCNT(j)]); sum += c; cnt += (c > 0u) ? 1u : 0u; mine = (j == x) ? c : mine; }
        if (sum == G) break;
        __builtin_amdgcn_s_sleep(1);
        if ((++sp & 255u) == 0u) { if (xb_ld(&bar[XB_TMO])) break; if (sp > XB_SPIN_CAP) { atomicAdd(&bar[XB_TMO], 1u); break; } }
    }
    nloc = mine > 0u ? mine : 1u; nx = cnt > 0u ? cnt : 1u;
}
__device__ __forceinline__ void xcd_barrier(const XcdBarrier& b, const int wave_s) {
    asm volatile("s_waitcnt vmcnt(0)" ::: "memory");
    __syncthreads();
    int ln_; asm volatile("v_mbcnt_lo_u32_b32 %0, -1, 0\n\tv_mbcnt_hi_u32_b32 %0, -1, %0" : "=v"(ln_));
    if (wave_s == 0 && ln_ == 0) {
        unsigned* bar = b.bar;
        __builtin_amdgcn_s_waitcnt(0);
        unsigned nloc = b.st[0], nx = b.st[1];
        if (nloc == 0u) { xcd_barrier_complete(bar, b.x, nloc, nx); b.st[0] = nloc; b.st[1] = nx; }
        const unsigned old = xb_add(&bar[XB_XSUB(b.x)], 1u);
        const unsigned gen = old / nloc;
        if (old + 1u == (gen + 1u) * nloc) {
            __builtin_amdgcn_fence(__ATOMIC_RELEASE, "agent");
            asm volatile("s_waitcnt vmcnt(0)" ::: "memory");
            const unsigned og = xb_add(&bar[XB_TOP], 1u);
            const unsigned tg = og / nx;
            if (og + 1u == (tg + 1u) * nx) xb_add(&bar[XB_TOPGEN], 1u);
            else XB_SPIN(xb_ld(&bar[XB_TOPGEN]) == tg, bar);
            __builtin_amdgcn_fence(__ATOMIC_ACQUIRE, "agent");
            xb_add(&bar[XB_XGEN(b.x)], 1u);
            asm volatile("s_waitcnt vmcnt(0)" ::: "memory");
        } else {
            XB_SPIN(xb_ld(&bar[XB_XGEN(b.x)]) == gen, bar);
            __builtin_amdgcn_fence(__ATOMIC_ACQUIRE, "agent");
            asm volatile("s_waitcnt vmcnt(0)" ::: "memory");
        }
    }
    __syncthreads();
}
namespace pg8 {
constexpr int BM = 256, BK = 64, HALF = 128, HTB = HALF * BK * 2, STAGE_BYTES = 8 * HTB, NXCD = 8, WGM = 4;

__host__ __device__ __forceinline__ int lds_byte(int r, int c) { const int st = (r >> 4) * 2 + (c >> 5), rr = r & 15, cc = c & 31, ob = rr * 64 + cc * 2; return st * 1024 + (ob ^ (((ob >> 9) & 1) << 5)); }
__host__ __device__ __forceinline__ void stage_rc(int b, int& R, int& C) { const int st = b / 1024, sb = b % 1024, swz = sb ^ (((sb >> 9) & 1) << 5); R = (st >> 1) * 16 + swz / 64; C = (st & 1) * 32 + (swz % 64) / 2; }
__host__ __device__ __forceinline__ int perm32(int rho) { const int n = rho >> 4, i = rho & 15; return 8 * (i >> 2) + 4 * n + (i & 3); }

struct Unit { const char* A; const char* B; int pm, pn; };

__device__ __forceinline__ bool static_tile(int i, int G, int c, int nM, int nN, int& pm, int& pn) {
    const int nwg = nM * nN; const long L = (long)i * G + c; if (L >= nwg) return false;
    int wgid = (int)L; { const int q = nwg / NXCD, r = nwg % NXCD, xcd = wgid % NXCD, off = wgid / NXCD; wgid = (xcd < r ? xcd * (q + 1) : r * (q + 1) + (xcd - r) * q) + off; }
    const int nig = WGM * nN, gid = wgid / nig, fm = gid * WGM, gsz = (nM - fm) < WGM ? (nM - fm) : WGM;
    pm = fm + ((wgid % nig) % gsz); pn = (wgid % nig) / gsz; return true;
}
struct PlainSched {
    const char* A; const char* Bt; int nM, nN, K, G, c;
    __device__ __forceinline__ bool next(int i, Unit& u) const {
        int pm, pn; if (!static_tile(i, G, c, nM, nN, pm, pn)) return false;
        u.pm = pm; u.pn = pn; u.A = A + (size_t)pm * 256 * K * 2; u.B = Bt + (size_t)pn * 256 * K * 2; return true;
    }
};
struct MoeSched {
    const char* A; const char* W; int tpe, nN, K, bN, G, c;
    __device__ __forceinline__ bool next(int i, Unit& u) const {
        int pm, pn; if (!static_tile(i, G, c, NE * tpe, nN, pm, pn)) return false;
        const int e = pm / tpe, rt = pm - e * tpe;
        u.pm = e * (SLOTS_E / 256) + rt; u.pn = pn;
        u.A = A + (size_t)u.pm * 256 * K * 2; u.B = W + ((size_t)e * bN + (size_t)pn * 256) * K * 2; return true;
    }
};

__device__ __forceinline__ unsigned cvt_pk_bf16(float lo, float hi) { return pk2(lo, hi); }


struct EpiBf16 {
    static constexpr bool PERM = true; static constexpr int NSTORE = 16;
    bf16_t* O; int ldc; int nscale; float scale;
    __device__ __forceinline__ void operator()(const f32x4 (&acc)[2][2][4][2], const Unit& u, int wr, int wc, int fr, int fq) const {
        const int row0 = u.pm * BM + wr * 64 + fr, col0 = u.pn * BM + wc * 32 + 8 * fq;
        const float s = (u.pn < nscale) ? scale : 1.f;
#pragma unroll
        for (int ai = 0; ai < 2; ++ai)
#pragma unroll
            for (int m = 0; m < 4; ++m) { bf16_t* rowp = O + (size_t)(row0 + ai * HALF + m * 16) * ldc + col0;
#pragma unroll
                for (int bj = 0; bj < 2; ++bj) { const f32x4 v0 = acc[ai][bj][m][0] * s, v1 = acc[ai][bj][m][1] * s;
                    u32x4 o; o.x = cvt_pk_bf16(v0[0], v0[1]); o.y = cvt_pk_bf16(v0[2], v0[3]); o.z = cvt_pk_bf16(v1[0], v1[1]); o.w = cvt_pk_bf16(v1[2], v1[3]);
                    *(u32x4*)(rowp + bj * HALF) = o; } }
    }
};
struct EpiResid {
    static constexpr bool PERM = true; static constexpr int NSTORE = 16;
    const float* srcL; const float* srcC; bf16_t* X16; const float* gate; bool f32src;
    __device__ __forceinline__ void operator()(const f32x4 (&acc)[2][2][4][2], const Unit& u, int wr, int wc, int fr, int fq) const {
        const bool isc = u.pm >= RL / 256;
        const int mi = isc ? NB : (u.pm >> 4);
        const int row0 = u.pm * BM + wr * 64 + fr, col0 = u.pn * BM + wc * 32 + 8 * fq;
        const float* gp = gate + (size_t)mi * 6 * D + col0;
        f32x4 gv[2][2];
#pragma unroll
        for (int bj = 0; bj < 2; ++bj)
#pragma unroll
            for (int n = 0; n < 2; ++n) gv[bj][n] = *(const f32x4*)(gp + bj * HALF + n * 4);
#pragma unroll
        for (int ai = 0; ai < 2; ++ai)
#pragma unroll
            for (int m = 0; m < 4; ++m) { const int row = row0 + ai * HALF + m * 16; bf16_t* xp = X16 + (size_t)row * D + col0;
                const float* sp = isc ? (srcC + (size_t)(row - RL) * D + col0) : (srcL + (size_t)row * D + col0);
#pragma unroll
                for (int bj = 0; bj < 2; ++bj) { f32x4 x0, x1;
                    if (f32src) { x0 = *(const f32x4*)(sp + bj * HALF); x1 = *(const f32x4*)(sp + bj * HALF + 4); }
                    else { const u32x4 xu = *(const u32x4*)(xp + bj * HALF); x0 = (f32x4){bf_lo(xu.x), bf_hi(xu.x), bf_lo(xu.y), bf_hi(xu.y)}; x1 = (f32x4){bf_lo(xu.z), bf_hi(xu.z), bf_lo(xu.w), bf_hi(xu.w)}; }
                    const f32x4 v0 = x0 + gv[bj][0] * acc[ai][bj][m][0], v1 = x1 + gv[bj][1] * acc[ai][bj][m][1];
                    u32x4 o; o.x = cvt_pk_bf16(v0[0], v0[1]); o.y = cvt_pk_bf16(v0[2], v0[3]); o.z = cvt_pk_bf16(v1[0], v1[1]); o.w = cvt_pk_bf16(v1[2], v1[3]);
                    *(u32x4*)(xp + bj * HALF) = o; } }
    }
};
struct EpiSwiglu {
    static constexpr bool PERM = true; static constexpr int NSTORE = 8;
    void* O; float ds; bool f8out;
    __device__ __forceinline__ void operator()(const f32x4 (&acc)[2][2][4][2], const Unit& u, int wr, int wc, int fr, int fq) const {
        const int row0 = u.pm * BM + wr * 64 + fr, col0 = u.pn * HALF + wc * 32 + 8 * fq;
#pragma unroll
        for (int ai = 0; ai < 2; ++ai)
#pragma unroll
            for (int m = 0; m < 4; ++m) { const size_t ro = (size_t)(row0 + ai * HALF + m * 16) * D + col0;
                float r[8];
#pragma unroll
                for (int n = 0; n < 2; ++n)
#pragma unroll
                    for (int j = 0; j < 4; ++j) { const float g = acc[ai][0][m][n][j] * ds, up = acc[ai][1][m][n][j] * ds; r[n * 4 + j] = g * fast_rcp(1.f + fast_exp(-g)) * up; }
                if (f8out) { u32x2 o; o.x = pk_fp8x4(r[0] * FP8_SA, r[1] * FP8_SA, r[2] * FP8_SA, r[3] * FP8_SA); o.y = pk_fp8x4(r[4] * FP8_SA, r[5] * FP8_SA, r[6] * FP8_SA, r[7] * FP8_SA);
                    *(u32x2*)((unsigned char*)O + ro) = o; }
                else { u32x4 o; o.x = cvt_pk_bf16(r[0], r[1]); o.y = cvt_pk_bf16(r[2], r[3]); o.z = cvt_pk_bf16(r[4], r[5]); o.w = cvt_pk_bf16(r[6], r[7]);
                    *(u32x4*)((bf16_t*)O + ro) = o; } }
    }
};
struct EpiRowScale {
    static constexpr bool PERM = true; static constexpr int NSTORE = 16;
    void* O; const float* g; float ds;
    __device__ __forceinline__ void operator()(const f32x4 (&acc)[2][2][4][2], const Unit& u, int wr, int wc, int fr, int fq) const {
        const int row0 = u.pm * BM + wr * 64 + fr, col0 = u.pn * BM + wc * 32 + 8 * fq;
#pragma unroll
        for (int ai = 0; ai < 2; ++ai)
#pragma unroll
            for (int m = 0; m < 4; ++m) { const int row = row0 + ai * HALF + m * 16; const float s = g[row] * ds * (MOE_Y_FP8 ? FP8_SY : 1.f); const size_t ro = (size_t)row * D + col0;
#pragma unroll
                for (int bj = 0; bj < 2; ++bj) { const f32x4 v0 = acc[ai][bj][m][0] * s, v1 = acc[ai][bj][m][1] * s;
                    if (MOE_Y_FP8) { u32x2 o; o.x = pk_fp8x4(v0[0], v0[1], v0[2], v0[3]); o.y = pk_fp8x4(v1[0], v1[1], v1[2], v1[3]); *(u32x2*)((unsigned char*)O + ro + bj * HALF) = o; }
                    else { u32x4 o; o.x = cvt_pk_bf16(v0[0], v0[1]); o.y = cvt_pk_bf16(v0[2], v0[3]); o.z = cvt_pk_bf16(v1[0], v1[1]); o.w = cvt_pk_bf16(v1[2], v1[3]);
                        *(u32x4*)((bf16_t*)O + ro + bj * HALF) = o; } } }
    }
};

template <class Epi, class Sched, bool GATHER = false, bool FP8 = false>
__device__ __forceinline__ void gemm_phase(LAS unsigned char* lds, const int tid, const int K, const Sched& S, const Epi& E, const int* rowidx = nullptr) {
    const int wid = __builtin_amdgcn_readfirstlane(tid >> 6), lane = tid & 63, wr = wid >> 2, wc = wid & 3, fr = lane & 15, fq = lane >> 4;
    const int nt = K / BK;
    unsigned voffA[2], voffB[2]; int gR[2], gC[2];
#pragma unroll
    for (int i = 0; i < 2; ++i) { int R, C; stage_rc(tid * 16 + i * 8192, R, C); const int Rb = Epi::PERM ? ((R & ~31) + perm32(R & 31)) : R;
        voffA[i] = (unsigned)(R * K + C) * 2u; voffB[i] = (unsigned)(Rb * K + C) * 2u; gR[i] = R; gC[i] = C * 2; }
    unsigned gcur[2][2], gnxt[2][2];
#define PG8_GIDX(dst, unit) do { if (GATHER) { _Pragma("unroll") for (int h_ = 0; h_ < 2; ++h_) _Pragma("unroll") for (int i_ = 0; i_ < 2; ++i_) \
        dst[h_][i_] = (unsigned)rowidx[(unit).pm * 256 + h_ * 128 + gR[i_]] * (unsigned)(K * 2) + (unsigned)gC[i_]; } } while (0)
    const size_t kstep = (size_t)(BK * 2);
    const size_t hstep = (size_t)HALF * K * 2;
    const unsigned ldsw = (unsigned)wid * 1024u;
    const int aoff = lds_byte(wr * 64 + fr, fq * 8), boff = lds_byte(wc * 32 + fr, fq * 8);
#define PG8_SA(b, h) (((b) * 2 + (h)) * HTB)
#define PG8_SB(b, h) ((4 + (b) * 2 + (h)) * HTB)
#define PG8_STAGE(bufoff, gbase, voff) do { _Pragma("unroll") for (int _i = 0; _i < 2; ++_i) \
        __builtin_amdgcn_global_load_lds((const unsigned*)((const char*)(gbase) + (voff)[_i]), (LAS unsigned*)(lds + (bufoff) + ldsw + _i * 8192), 16, 0, 0); } while (0)
#define PG8_STAGE_A(b, h, gbase, NX) do { if (GATHER) { unsigned go_[2]; go_[0] = (NX) ? gnxt[h][0] : gcur[h][0]; go_[1] = (NX) ? gnxt[h][1] : gcur[h][1]; PG8_STAGE(PG8_SA(b, h), (gbase), go_); } \
        else { PG8_STAGE(PG8_SA(b, h), (gbase) + (h) * hstep, voffA); } } while (0)
#define PG8_LDA(dst, b, h) do { _Pragma("unroll") for (int m = 0; m < 4; ++m) _Pragma("unroll") for (int k = 0; k < 2; ++k) dst[m][k] = *(const LAS bf16x8*)(lds + PG8_SA(b, h) + aoff + m * 2048 + k * 1024); } while (0)
#define PG8_LDB(dst, b, h) do { _Pragma("unroll") for (int n = 0; n < 2; ++n) _Pragma("unroll") for (int k = 0; k < 2; ++k) dst[n][k] = *(const LAS bf16x8*)(lds + PG8_SB(b, h) + boff + n * 2048 + k * 1024); } while (0)
#define PG8_MMA(ai, bj, At, Bt) do { __builtin_amdgcn_s_setprio(1); if (FP8) { _Pragma("unroll") for (int m = 0; m < 4; ++m) _Pragma("unroll") for (int n = 0; n < 2; ++n) { \
            typedef int v8i_ __attribute__((ext_vector_type(8))); typedef int v4i_ __attribute__((ext_vector_type(4))); \
            const v4i_ b0_ = __builtin_bit_cast(v4i_, Bt[n][0]), b1_ = __builtin_bit_cast(v4i_, Bt[n][1]), a0_ = __builtin_bit_cast(v4i_, At[m][0]), a1_ = __builtin_bit_cast(v4i_, At[m][1]); \
            const v8i_ bb_ = {b0_[0], b0_[1], b0_[2], b0_[3], b1_[0], b1_[1], b1_[2], b1_[3]}, aa_ = {a0_[0], a0_[1], a0_[2], a0_[3], a1_[0], a1_[1], a1_[2], a1_[3]}; \
            asm volatile("v_mfma_scale_f32_16x16x128_f8f6f4 %0, %1, %2, %0, %3, %3 op_sel_hi:[0,0,0]" : "+v"(acc[ai][bj][m][n]) : "v"(bb_), "v"(aa_), "v"(sc127)); } } \
        else { _Pragma("unroll") for (int m = 0; m < 4; ++m) _Pragma("unroll") for (int n = 0; n < 2; ++n) _Pragma("unroll") for (int k = 0; k < 2; ++k) \
        acc[ai][bj][m][n] = __builtin_amdgcn_mfma_f32_16x16x32_bf16(Bt[n][k], At[m][k], acc[ai][bj][m][n], 0, 0, 0); } __builtin_amdgcn_s_setprio(0); } while (0)
#define PG8_WAIT_V(n) asm volatile("s_waitcnt vmcnt(" #n ")" ::: "memory")
#define PG8_WAIT_VE() do { if (Epi::NSTORE == 32) asm volatile("s_waitcnt vmcnt(40)" ::: "memory"); else if (Epi::NSTORE == 16) asm volatile("s_waitcnt vmcnt(24)" ::: "memory"); else asm volatile("s_waitcnt vmcnt(16)" ::: "memory"); } while (0)
#define PG8_WAIT_L(n) asm volatile("s_waitcnt lgkmcnt(" #n ")" ::: "memory")
#define PG8_BAR __builtin_amdgcn_s_barrier()
#define PG8_SCHED __builtin_amdgcn_sched_barrier(0)
    Unit cur, nxt; int ui = 0;
    if (!S.next(0, cur)) return;
    int sc127 = 0x7F7F7F7F; asm volatile("" : "+v"(sc127));
    f32x4 acc[2][2][4][2];
#pragma unroll
    for (int a = 0; a < 2; ++a)
#pragma unroll
        for (int b = 0; b < 2; ++b)
#pragma unroll
            for (int m = 0; m < 4; ++m)
#pragma unroll
                for (int n = 0; n < 2; ++n) acc[a][b][m][n] = (f32x4){0.f, 0.f, 0.f, 0.f};
    bf16x8 At[4][2], B0[2][2], B1[2][2];
    const char* cA = GATHER ? S.A : cur.A; const char* cB = cur.B;
    PG8_GIDX(gcur, cur);
    PG8_STAGE(PG8_SB(0, 0), cB, voffB); PG8_STAGE(PG8_SB(0, 1), cB + hstep, voffB); PG8_STAGE_A(0, 0, cA, false); PG8_STAGE_A(0, 1, cA, false);
    if (wr == 1) PG8_BAR;
    PG8_WAIT_V(2); PG8_BAR;
    PG8_STAGE(PG8_SB(1, 0), cB + kstep, voffB); PG8_STAGE_A(1, 0, cA + kstep, false); PG8_STAGE(PG8_SB(1, 1), cB + hstep + kstep, voffB);
    PG8_WAIT_V(6); PG8_BAR;
    for (;;) {
        const bool has_next = S.next(ui + 1, nxt);
        const char* nA = (has_next && !GATHER) ? nxt.A : cA; const char* nB = has_next ? nxt.B : cB;
        if (GATHER) { if (has_next) { PG8_GIDX(gnxt, nxt); } else { _Pragma("unroll") for (int h_ = 0; h_ < 2; ++h_) { gnxt[h_][0] = gcur[h_][0]; gnxt[h_][1] = gcur[h_][1]; } } }
#pragma unroll 1
        for (int t = 0; t < nt; t += 2) {
            const bool last = (t == nt - 2);
            const char* a1 = cA + (size_t)(t + 1) * kstep;
            const char* a2 = last ? nA : cA + (size_t)(t + 2) * kstep; const char* b2 = last ? nB : cB + (size_t)(t + 2) * kstep;
            const char* a3 = a2 + kstep; const char* b3 = b2 + kstep;
            PG8_LDB(B0, 0, 0); PG8_LDB(B1, 0, 1); PG8_SCHED; PG8_LDA(At, 0, 0); PG8_STAGE_A(1, 1, a1, false);
            PG8_WAIT_V(8); PG8_WAIT_L(0); PG8_BAR; PG8_MMA(0, 0, At, B0); PG8_MMA(0, 1, At, B1); PG8_BAR; PG8_SCHED;
            PG8_LDA(At, 0, 1); PG8_STAGE(PG8_SB(0, 0), b2, voffB); PG8_STAGE(PG8_SB(0, 1), b2 + hstep, voffB); PG8_STAGE_A(0, 0, a2, last);
            PG8_WAIT_V(8); PG8_WAIT_L(0); PG8_BAR; PG8_MMA(1, 0, At, B0); PG8_MMA(1, 1, At, B1); PG8_BAR; PG8_SCHED;
            PG8_LDB(B0, 1, 0); PG8_LDB(B1, 1, 1); PG8_SCHED; PG8_LDA(At, 1, 0); PG8_STAGE_A(0, 1, a2, last);
            PG8_WAIT_V(8); PG8_WAIT_L(0); PG8_BAR; PG8_MMA(0, 0, At, B0); PG8_MMA(0, 1, At, B1); PG8_BAR; PG8_SCHED;
            PG8_LDA(At, 1, 1); PG8_STAGE(PG8_SB(1, 0), b3, voffB); PG8_STAGE(PG8_SB(1, 1), b3 + hstep, voffB); PG8_STAGE_A(1, 0, a3, last);
            PG8_WAIT_V(8); PG8_WAIT_L(0); PG8_BAR; PG8_MMA(1, 0, At, B0); PG8_MMA(1, 1, At, B1); PG8_BAR; PG8_SCHED;
        }
        if (wr == 0) PG8_BAR;
        if (FP8) asm volatile("s_nop 15\n\ts_nop 15" ::: "memory");
        { int tz = tid; asm volatile("" : "+v"(tz));
          const int wid2 = __builtin_amdgcn_readfirstlane(tz >> 6), lane2 = tz & 63;
          E(acc, cur, wid2 >> 2, wid2 & 3, lane2 & 15, lane2 >> 4); }
        if (!has_next) break;
#pragma unroll
        for (int a = 0; a < 2; ++a)
#pragma unroll
            for (int b = 0; b < 2; ++b)
#pragma unroll
                for (int m = 0; m < 4; ++m)
#pragma unroll
                    for (int n = 0; n < 2; ++n) acc[a][b][m][n] = (f32x4){0.f, 0.f, 0.f, 0.f};
        cur = nxt; cA = nA; cB = nB; ++ui;
        if (GATHER) { _Pragma("unroll") for (int h_ = 0; h_ < 2; ++h_) { gcur[h_][0] = gnxt[h_][0]; gcur[h_][1] = gnxt[h_][1]; } }
        if (wr == 1) PG8_BAR;
    }
    PG8_WAIT_V(0);
    PG8_BAR;
#undef PG8_SA
#undef PG8_SB
#undef PG8_STAGE
#undef PG8_STAGE_A
#undef PG8_GIDX
#undef PG8_LDA
#undef PG8_LDB
#undef PG8_MMA
#undef PG8_WAIT_V
#undef PG8_WAIT_VE
#undef PG8_WAIT_L
#undef PG8_BAR
#undef PG8_SCHED
}
}
namespace attn_body {
constexpr int NW = 8, QBLK = 32, QB = QBLK * NW, KVBLK = 64;
__device__ __forceinline__ int crow(int r, int hi) { return (r & 3) + 8 * (r >> 2) + 4 * hi; }
#define SBAR() __builtin_amdgcn_sched_barrier(0)
constexpr int NSLOT = 3, SLOTB = 8192;
constexpr int LDS_K = 0, LDS_V = NSLOT * SLOTB, LDS_WS = 2 * NSLOT * SLOTB, LDS_OST = LDS_WS + NW * 64 * 4, LDS_BYTES = LDS_OST + NW * 4096;
constexpr float C2 = 0.125f * 1.4426950408889634f;
__device__ __forceinline__ void glds16(const void* gsrc, unsigned lds_dst) { unsigned keep;
  asm volatile("s_mov_b32 %0, m0\n\ts_mov_b32 m0, %2\n\ts_nop 0\n\tglobal_load_lds_dwordx4 %1, off\n\ts_mov_b32 m0, %0" : "=&s"(keep) : "v"(gsrc), "s"(lds_dst) : "memory"); }
__device__ __forceinline__ float max3f(float a, float b, float c) { float r; asm("v_max3_f32 %0, %1, %2, %3" : "=v"(r) : "v"(a), "v"(b), "v"(c)); return r; }
__device__ __forceinline__ float max2f(float a, float b) { float r; asm("v_max_f32_e32 %0, %1, %2" : "=v"(r) : "v"(a), "v"(b)); return r; }
__device__ __forceinline__ float fadd_s(float a, float b) { float r; asm("v_add_f32_e32 %0, %1, %2" : "=v"(r) : "v"(a), "v"(b)); return r; }
__device__ __forceinline__ float fsub_s(float a, float b) { float r; asm("v_sub_f32_e32 %0, %1, %2" : "=v"(r) : "v"(a), "v"(b)); return r; }
__device__ __forceinline__ unsigned cvtpk_s(float lo, float hi) { f32x2 v = {lo, hi}; bf16x2_t b = __builtin_convertvector(v, bf16x2_t); return __builtin_bit_cast(unsigned, b); }
#define WAIT_BAR(N) asm volatile("s_waitcnt vmcnt(" #N ") lgkmcnt(0)\n\ts_barrier" ::: "memory")

__device__ __forceinline__ void qkt(f32x16& p0, f32x16& p1, const char* Kslot, const bf16x8* qr, const f32x16& negm, int r32, int hi) {
  const char* kb = Kslot + hi * 1024 + r32 * 16;
  #pragma unroll
  for (int d0 = 0; d0 < 4; ++d0) {
    const bf16x8 b0 = *reinterpret_cast<const bf16x8*>(kb + d0 * 2048);
    const bf16x8 b1 = *reinterpret_cast<const bf16x8*>(kb + d0 * 2048 + 512);
    if (d0 == 0) { p0 = __builtin_amdgcn_mfma_f32_32x32x16_bf16(b0, qr[0], negm, 0, 0, 0); p1 = __builtin_amdgcn_mfma_f32_32x32x16_bf16(b1, qr[0], negm, 0, 0, 0); }
    else { p0 = __builtin_amdgcn_mfma_f32_32x32x16_bf16(b0, qr[d0], p0, 0, 0, 0); p1 = __builtin_amdgcn_mfma_f32_32x32x16_bf16(b1, qr[d0], p1, 0, 0, 0); } }
}
typedef __attribute__((address_space(3))) const char* lds_cptr;
typedef short v4i16_t __attribute__((ext_vector_type(4)));
__device__ __forceinline__ void kload8(bf16x8* kf, lds_cptr kp) {
  kf[0] = *(const LAS bf16x8*)(kp);        kf[1] = *(const LAS bf16x8*)(kp + 512);
  kf[2] = *(const LAS bf16x8*)(kp + 2048); kf[3] = *(const LAS bf16x8*)(kp + 2560);
  kf[4] = *(const LAS bf16x8*)(kp + 4096); kf[5] = *(const LAS bf16x8*)(kp + 4608);
  kf[6] = *(const LAS bf16x8*)(kp + 6144); kf[7] = *(const LAS bf16x8*)(kp + 6656);
}
__device__ __forceinline__ void kload2(bf16x8* kf, lds_cptr kp, int j) { kf[2 * j] = *(const LAS bf16x8*)(kp + j * 2048); kf[2 * j + 1] = *(const LAS bf16x8*)(kp + j * 2048 + 512); }
__device__ __forceinline__ s16x4 vtr(lds_cptr p) { return __builtin_bit_cast(s16x4, __builtin_amdgcn_ds_read_tr16_b64_v4i16((LAS v4i16_t*)p)); }
__device__ __forceinline__ float rowmax(const f32x16& p0, const f32x16& p1) {
  float a = max3f(p0[0], p0[1], p1[0]), b = max3f(p0[2], p0[3], p1[1]); a = max3f(a, p1[2], p1[3]);
  #pragma unroll
  for (int r = 4; r < 16; r += 4) { a = max3f(a, p0[r], p0[r + 1]); b = max3f(b, p0[r + 2], p0[r + 3]); a = max3f(a, p1[r], p1[r + 1]); b = max3f(b, p1[r + 2], p1[r + 3]); }
  const float m = max2f(a, b);
  auto rr = __builtin_amdgcn_permlane32_swap(__float_as_uint(m), __float_as_uint(m), false, false);
  return max2f(__uint_as_float(rr[0]), __uint_as_float(rr[1]));
}
__device__ __forceinline__ void pv(f32x16* o, int vb, bf16x8 pa0, bf16x8 pa1, bf16x8 pa2, bf16x8 pa3) {
  #pragma unroll
  for (int d0 = 0; d0 < 2; ++d0) { s16x4 lo[4], hi[4];
    #pragma unroll
    for (int ks = 0; ks < 4; ++ks) {
      asm volatile("ds_read_b64_tr_b16 %0,%1 offset:%c2" : "=&v"(lo[ks]) : "v"(vb), "i"(d0 * 4096 + ks * 1024) : "memory");
      asm volatile("ds_read_b64_tr_b16 %0,%1 offset:%c2" : "=&v"(hi[ks]) : "v"(vb), "i"(d0 * 4096 + ks * 1024 + 512) : "memory"); }
    asm volatile("s_waitcnt lgkmcnt(0)" ::: "memory"); SBAR();
    #define PK(k) (bf16x8){lo[k][0], lo[k][1], lo[k][2], lo[k][3], hi[k][0], hi[k][1], hi[k][2], hi[k][3]}
    o[d0] = __builtin_amdgcn_mfma_f32_32x32x16_bf16(pa0, PK(0), o[d0], 0, 0, 0);
    o[d0] = __builtin_amdgcn_mfma_f32_32x32x16_bf16(pa1, PK(1), o[d0], 0, 0, 0);
    o[d0] = __builtin_amdgcn_mfma_f32_32x32x16_bf16(pa2, PK(2), o[d0], 0, 0, 0);
    o[d0] = __builtin_amdgcn_mfma_f32_32x32x16_bf16(pa3, PK(3), o[d0], 0, 0, 0);
    #undef PK
  }
}

template <int THRL> __device__ __forceinline__ void attn_unit(const bf16_t* Qrow0, int QP, const bf16_t* __restrict__ Kc, const bf16_t* __restrict__ Vc, const bf16_t* __restrict__ Kl, const bf16_t* __restrict__ Vl, int NC, int KVP, int NT,
                                                              bf16_t* Orow0, int OP, char* shm, const int tid, const float mfix, const float* qn, const float* ropec, const float* ropes, const int rope, const int tq0) {
  const int lane = tid & 63, r32 = lane & 31, hi = lane >> 5; const int wid = __builtin_amdgcn_readfirstlane(tid >> 6);
  const bf16_t* Qw = Qrow0 + (long)(wid * QBLK) * QP;
  const unsigned lds0 = (unsigned)(uintptr_t)shm;
  float* wsf = (float*)(shm + LDS_WS) + wid * 64;
  const long koff = (long)lane * KVP + wid * 8, voff = (long)(16 * (wid & 3) + (lane >> 2)) * KVP + (wid >> 2) * 32 + (lane & 3) * 8;
  const bf16_t* ksrc_c = Kc + koff; const bf16_t* vsrc_c = Vc + voff; const bf16_t* ksrc_l = Kl + koff - (long)NC * KVBLK * KVP; const bf16_t* vsrc_l = Vl + voff - (long)NC * KVBLK * KVP;
  const unsigned kdst = lds0 + LDS_K + wid * 1024, vdst = lds0 + LDS_V + wid * 1024;
  #define DMA_K(t, slot) glds16(((t) < NC ? ksrc_c : ksrc_l) + (long)(t) * KVBLK * KVP, (unsigned)__builtin_amdgcn_readfirstlane(kdst + (slot)))
  #define DMA_V(t, slot) glds16(((t) < NC ? vsrc_c : vsrc_l) + (long)(t) * KVBLK * KVP, (unsigned)__builtin_amdgcn_readfirstlane(vdst + (slot)))
  const int vb0 = (int)(lds0 + LDS_V) + ((lane >> 4) & 1) * 32 + (lane & 3) * 8 + (4 * hi + ((lane & 15) >> 2)) * 64;
  const char* Kbase = shm + LDS_K; bf16x8 kf[8];
  const lds_cptr shm3 = (lds_cptr)shm; const lds_cptr kp0 = shm3 + LDS_K + hi * 1024 + r32 * 16; const lds_cptr vp0 = shm3 + LDS_V + ((lane >> 4) & 1) * 32 + (lane & 3) * 8 + (4 * hi + ((lane & 15) >> 2)) * 64;
  DMA_K(0, 0); DMA_V(0, 0); DMA_K(1, SLOTB);
  bf16x8 qr[4];
  #pragma unroll
  for (int d0 = 0; d0 < 4; ++d0) qr[d0] = *reinterpret_cast<const bf16x8*>(&Qw[(long)r32 * QP + d0 * 16 + hi * 8]);
  {
    float x[4][8];
    #pragma unroll
    for (int d0 = 0; d0 < 4; ++d0) { const u32x4 u = __builtin_bit_cast(u32x4, qr[d0]);
      x[d0][0] = bf_lo(u.x); x[d0][1] = bf_hi(u.x); x[d0][2] = bf_lo(u.y); x[d0][3] = bf_hi(u.y); x[d0][4] = bf_lo(u.z); x[d0][5] = bf_hi(u.z); x[d0][6] = bf_lo(u.w); x[d0][7] = bf_hi(u.w); }
    float ss = 0.f;
    #pragma unroll
    for (int d0 = 0; d0 < 4; ++d0)
      #pragma unroll
      for (int t = 0; t < 8; ++t) ss += x[d0][t] * x[d0][t];
    { auto rr = __builtin_amdgcn_permlane32_swap(__float_as_uint(ss), __float_as_uint(ss), false, false); ss = __uint_as_float(rr[0]) + __uint_as_float(rr[1]); }
    const float rstd = rsqrtf(ss * (1.f / 64.f) + NORM_EPS) * C2;
    #pragma unroll
    for (int d0 = 0; d0 < 4; ++d0) { const f32x4 g0 = *(const f32x4*)(qn + 16 * d0 + 8 * hi), g1 = *(const f32x4*)(qn + 16 * d0 + 8 * hi + 4);
      x[d0][0] *= rstd * g0.x; x[d0][1] *= rstd * g0.y; x[d0][2] *= rstd * g0.z; x[d0][3] *= rstd * g0.w; x[d0][4] *= rstd * g1.x; x[d0][5] *= rstd * g1.y; x[d0][6] *= rstd * g1.z; x[d0][7] *= rstd * g1.w; }
    if (rope) { const int tq = tq0 + wid * QBLK + r32;
      #pragma unroll
      for (int d0 = 0; d0 < 2; ++d0) { const float* cp = ropec + (long)tq * 32 + 16 * d0 + 8 * hi; const float* sp = ropes + (long)tq * 32 + 16 * d0 + 8 * hi;
        const f32x4 c0 = *(const f32x4*)cp, c1 = *(const f32x4*)(cp + 4), s0 = *(const f32x4*)sp, s1 = *(const f32x4*)(sp + 4);
        const float cs[8] = {c0.x, c0.y, c0.z, c0.w, c1.x, c1.y, c1.z, c1.w}, sn[8] = {s0.x, s0.y, s0.z, s0.w, s1.x, s1.y, s1.z, s1.w};
        #pragma unroll
        for (int t = 0; t < 8; ++t) { const float a = x[d0][t], c = x[d0 + 2][t]; x[d0][t] = a * cs[t] - c * sn[t]; x[d0 + 2][t] = a * sn[t] + c * cs[t]; } } }
    #pragma unroll
    for (int d0 = 0; d0 < 4; ++d0) { u32x4 u; u.x = pk2(x[d0][0], x[d0][1]); u.y = pk2(x[d0][2], x[d0][3]); u.z = pk2(x[d0][4], x[d0][5]); u.w = pk2(x[d0][6], x[d0][7]); qr[d0] = __builtin_bit_cast(bf16x8, u); }
  }
  float l_reg = 0.f; f32x16 o[2]; o[0] = f32x16{}; o[1] = f32x16{}; const f32x16 negm = f32x16{}; (void)mfix;
  #define START(P0, P1) do { _Pragma("unroll") for (int r = 0; r < 16; ++r) P0[r] = __builtin_amdgcn_exp2f(P0[r]); } while (0)
  #define RESC() do { } while (0)
  f32x16 pA0, pA1, pB0, pB1;
  int sl_prev = 0, sl_cur = 0, sl_next = SLOTB;
  #define ROT() do { sl_prev = sl_cur; sl_cur = sl_next; sl_next = (sl_next == (NSLOT - 1) * SLOTB) ? 0 : sl_next + SLOTB; } while (0)
  DMA_K(2, 2 * SLOTB);
  WAIT_BAR(3);
  qkt(pA0, pA1, Kbase, qr, negm, r32, hi); asm volatile("s_nop 15\n\ts_nop 7" : "+v"(pA0), "+v"(pA1));
  START(pA0, pA1);
  _Pragma("unroll") for (int r = 0; r < 16; ++r) pA1[r] = __builtin_amdgcn_exp2f(pA1[r]);
  WAIT_BAR(0);
  DMA_K(3, 0); DMA_V(1, SLOTB);
  ROT();
  kload8(kf, kp0 + sl_cur);
  WAIT_BAR(2);
  s16x4 vlo[8], vhi[8]; u32x4 pw0, pw1, pw2, pw3;
  #define PKW(P, B) cvtpk_s(P[B], P[B + 1])
  #define PAF(k) __builtin_bit_cast(bf16x8, pw##k)
  #define VFR(i) (bf16x8){vlo[i][0], vlo[i][1], vlo[i][2], vlo[i][3], vhi[i][0], vhi[i][1], vhi[i][2], vhi[i][3]}
  #define PIN(x) asm volatile("" : "+v"(x))
  #define MX3(a, b, c) __builtin_fmaxf(__builtin_fmaxf((a), (b)), (c))
  #define GAPA(MF, A0, A1, A2, A3, W0, W1, PW) do { MF; sacc += A0; sacc += A1; sacc += A2; sacc += A3; PIN(sacc); W0; W1; PIN(PW); SBAR(); } while (0)
  #define EX(v) __builtin_amdgcn_exp2f(v)
  #define GAPB(MF, X, B) do { MF; X[B] = EX(X[B]); X[B + 1] = EX(X[B + 1]); X[B + 2] = EX(X[B + 2]); X[B + 3] = EX(X[B + 3]); PIN(X); SBAR(); } while (0)
  #define VRD(i) do { vlo[i] = vtr(vp_ + (((i) >> 2) * 4096 + ((i) & 3) * 1024)); vhi[i] = vtr(vp_ + (((i) >> 2) * 4096 + ((i) & 3) * 1024 + 512)); } while (0)
  #define KRD(G, j) do { if (G) { kload2(kf, kp0 + sl_next, j); SBAR(); } } while (0)
  #define STEP(C0, C1, P0, P1, t, GK, GV, GL) do { SBAR(); \
    const lds_cptr vp_ = vp0 + sl_prev; \
    VRD(0); SBAR(); float sacc = (P0[0] + P0[1]); \
    GAPA(C0 = __builtin_amdgcn_mfma_f32_32x32x16_bf16(kf[0], qr[0], negm, 0, 0, 0), P0[2], P0[3], P0[4], P0[5],     pw0[0] = PKW(P0, 0), pw0[1] = PKW(P0, 2), pw0); \
    VRD(4); SBAR(); GAPA(C1 = __builtin_amdgcn_mfma_f32_32x32x16_bf16(kf[1], qr[0], negm, 0, 0, 0), P0[6], P0[7], P0[8], P0[9],     pw0[2] = PKW(P0, 4), pw0[3] = PKW(P0, 6), pw0); \
    VRD(1); SBAR(); GAPA(C0 = __builtin_amdgcn_mfma_f32_32x32x16_bf16(kf[2], qr[1], C0, 0, 0, 0),   P0[10], P0[11], P0[12], P0[13], pw1[0] = PKW(P0, 8), pw1[1] = PKW(P0, 10), pw1); \
    VRD(5); SBAR(); GAPA(C1 = __builtin_amdgcn_mfma_f32_32x32x16_bf16(kf[3], qr[1], C1, 0, 0, 0),   P0[14], P0[15], P1[0], P1[1],   pw1[2] = PKW(P0, 12), pw1[3] = PKW(P0, 14), pw1); \
    VRD(2); SBAR(); GAPA(C0 = __builtin_amdgcn_mfma_f32_32x32x16_bf16(kf[4], qr[2], C0, 0, 0, 0),   P1[2], P1[3], P1[4], P1[5],     pw2[0] = PKW(P1, 0), pw2[1] = PKW(P1, 2), pw2); \
    VRD(6); SBAR(); GAPA(C1 = __builtin_amdgcn_mfma_f32_32x32x16_bf16(kf[5], qr[2], C1, 0, 0, 0),   P1[6], P1[7], P1[8], P1[9],     pw2[2] = PKW(P1, 4), pw2[3] = PKW(P1, 6), pw2); \
    VRD(3); SBAR(); GAPA(C0 = __builtin_amdgcn_mfma_f32_32x32x16_bf16(kf[6], qr[3], C0, 0, 0, 0),   P1[10], P1[11], P1[12], P1[13], pw3[0] = PKW(P1, 8), pw3[1] = PKW(P1, 10), pw3); \
    VRD(7); SBAR(); GAPA(C1 = __builtin_amdgcn_mfma_f32_32x32x16_bf16(kf[7], qr[3], C1, 0, 0, 0),   P1[14], P1[15], 0.f, 0.f,       pw3[2] = PKW(P1, 12), pw3[3] = PKW(P1, 14), pw3); \
    l_reg += sacc; \
    if (GK) { DMA_K((t) + 3, sl_cur); } if (GV) { DMA_V((t) + 1, sl_next); } \
    SBAR(); \
    GAPB(o[0] = __builtin_amdgcn_mfma_f32_32x32x16_bf16(PAF(0), VFR(0), o[0], 0, 0, 0), C0, 0); \
    GAPB(o[1] = __builtin_amdgcn_mfma_f32_32x32x16_bf16(PAF(0), VFR(4), o[1], 0, 0, 0), C0, 4); \
    KRD(GL, 0); GAPB(o[0] = __builtin_amdgcn_mfma_f32_32x32x16_bf16(PAF(1), VFR(1), o[0], 0, 0, 0), C0, 8); \
    KRD(GL, 1); GAPB(o[1] = __builtin_amdgcn_mfma_f32_32x32x16_bf16(PAF(1), VFR(5), o[1], 0, 0, 0), C0, 12); \
    KRD(GL, 2); GAPB(o[0] = __builtin_amdgcn_mfma_f32_32x32x16_bf16(PAF(2), VFR(2), o[0], 0, 0, 0), C1, 0); \
    KRD(GL, 3); GAPB(o[1] = __builtin_amdgcn_mfma_f32_32x32x16_bf16(PAF(2), VFR(6), o[1], 0, 0, 0), C1, 4); \
    GAPB(o[0] = __builtin_amdgcn_mfma_f32_32x32x16_bf16(PAF(3), VFR(3), o[0], 0, 0, 0), C1, 8); \
    GAPB(o[1] = __builtin_amdgcn_mfma_f32_32x32x16_bf16(PAF(3), VFR(7), o[1], 0, 0, 0), C1, 12); \
    } while (0)
  int t = 1;
  for (; t + 5 < NT; t += 2) {
    STEP(pB0, pB1, pA0, pA1, t, true, true, true);     WAIT_BAR(2); RESC(); ROT();
    STEP(pA0, pA1, pB0, pB1, t + 1, true, true, true); WAIT_BAR(2); RESC(); ROT();
  }
  #define ENDW(tt) do { if ((tt) + 3 < NT) { WAIT_BAR(2); } else if ((tt) + 2 < NT) { WAIT_BAR(1); } else { WAIT_BAR(0); } } while (0)
  for (; t + 1 < NT; t += 2) {
    STEP(pB0, pB1, pA0, pA1, t, (t + 3 < NT), (t + 1 < NT), (t + 1 < NT));         ENDW(t);     RESC(); ROT();
    STEP(pA0, pA1, pB0, pB1, t + 1, (t + 4 < NT), (t + 2 < NT), (t + 2 < NT));     ENDW(t + 1); RESC(); ROT();
  }
  STEP(pB0, pB1, pA0, pA1, NT - 1, false, false, false); RESC();
  { float sacc = pB0[0] + pB0[1]; _Pragma("unroll") for (int r = 2; r < 16; ++r) sacc += pB0[r]; _Pragma("unroll") for (int r = 0; r < 16; ++r) sacc += pB1[r]; l_reg += sacc;
    pw0 = (u32x4){PKW(pB0, 0), PKW(pB0, 2), PKW(pB0, 4), PKW(pB0, 6)}; pw1 = (u32x4){PKW(pB0, 8), PKW(pB0, 10), PKW(pB0, 12), PKW(pB0, 14)}; pw2 = (u32x4){PKW(pB1, 0), PKW(pB1, 2), PKW(pB1, 4), PKW(pB1, 6)}; pw3 = (u32x4){PKW(pB1, 8), PKW(pB1, 10), PKW(pB1, 12), PKW(pB1, 14)};
    SBAR(); pv(o, vb0 + sl_cur, PAF(0), PAF(1), PAF(2), PAF(3)); }
  #undef PKW
  #undef PAF
  #undef VFR
  #undef PIN
  #undef MX3
  #undef GAPA
  #undef GAPB
  #undef EX
  #undef VRD
  #undef KRD
  #undef STEP
  #undef ENDW
  { auto rr = __builtin_amdgcn_permlane32_swap(__float_as_uint(l_reg), __float_as_uint(l_reg), false, false); l_reg = __uint_as_float(rr[0]) + __uint_as_float(rr[1]); }
  if (hi == 0) wsf[32 + r32] = l_reg; asm volatile("s_waitcnt lgkmcnt(0)" ::: "memory");
  float rli[16];
  #pragma unroll
  for (int r = 0; r < 16; ++r) rli[r] = __builtin_amdgcn_rcpf(wsf[32 + crow(r, hi)]);
  bf16_t* Ow = Orow0 + (long)(wid * QBLK) * OP;
  { bf16_t* stg = (bf16_t*)(shm + LDS_OST) + wid * 2048;
    #pragma unroll
    for (int r = 0; r < 16; ++r) { const int orow = crow(r, hi);
      #pragma unroll
      for (int d0 = 0; d0 < 2; ++d0) stg[orow * 64 + d0 * 32 + r32] = (bf16_t)f2bf(o[d0][r] * rli[r]); }
    asm volatile("s_waitcnt lgkmcnt(0)" ::: "memory");
    #pragma unroll
    for (int i = 0; i < 4; ++i) { const int row = i * 8 + (lane >> 3), ch = lane & 7; const u32x4 v = *(const u32x4*)(stg + row * 64 + ch * 8); *(u32x4*)(Ow + (long)row * OP + ch * 8) = v; } }
  asm volatile("s_waitcnt lgkmcnt(0)\n\ts_barrier" ::: "memory");
  #undef DMA_K
  #undef DMA_V
  #undef START
  #undef RESC
  #undef ROT
}
#undef SBAR
#undef WAIT_BAR
}
struct Frame {
    LAS unsigned char* lds;
    int tid, lane, wave;
    int vcu, G, gw, NGW, bid;
    unsigned char* ws; const unsigned long long* inq;
};

__device__ __forceinline__ void transpose_item(const float* W, int ldw, int K, bf16_t* WT, int k0, int n0, int dst_row0, LAS float* scr, int lane) {
    float tv[32];
#pragma unroll
    for (int i = 0; i < 32; ++i) tv[i] = W[(size_t)(k0 + 2 * i + (lane >> 5)) * ldw + n0 + (lane & 31)];
#pragma unroll
    for (int i = 0; i < 32; ++i) scr[(2 * i + (lane >> 5)) * 33 + (lane & 31)] = tv[i];
    LDS_WAIT(); asm volatile("" ::: "memory");
    const int c = lane & 7;
#pragma unroll
    for (int j = 0; j < 4; ++j) { const int n = (lane >> 3) + 8 * j; const LAS float* s = scr + (8 * c) * 33 + n;
        u32x4 o; o.x = pk2(s[0 * 33], s[1 * 33]); o.y = pk2(s[2 * 33], s[3 * 33]); o.z = pk2(s[4 * 33], s[5 * 33]); o.w = pk2(s[6 * 33], s[7 * 33]);
        *(u32x4*)(WT + (size_t)(dst_row0 + n) * K + k0 + 8 * c) = o; }
    LDS_WAIT(); asm volatile("" ::: "memory");
}

__device__ __forceinline__ void sincos_acc(float x, float& s, float& c) {
    const float k = rintf(x * 0.63661977236758134f);
    float r = fmaf(k, -1.5703125f, x); r = fmaf(k, -4.837512969970703125e-4f, r); r = fmaf(k, -7.54978995489188e-8f, r);
    const float z = r * r;
    const float sp = r + r * z * fmaf(z, fmaf(z, -1.9515295891e-4f, 8.3321608736e-3f), -1.6666654611e-1f);
    const float cp = fmaf(z * z, fmaf(z, fmaf(z, 2.443315711809948e-5f, -1.388731625493765e-3f), 4.166664568298827e-2f), fmaf(z, -0.5f, 1.0f));
    const int q = ((int)k) & 3;
    const float ss = (q & 1) ? cp : sp, cc = (q & 1) ? sp : cp;
    s = (q & 2) ? -ss : ss; c = ((q + 1) & 2) ? -cc : cc;
}

__device__ __forceinline__ void p0_prologue(Frame& F, const float* const* in, unsigned char* ws) {
    const float* c_lat = in[1]; const float* c_ctx = in[3]; const float* w_mod = in[4]; const float* b_mod = in[5];
    LAS float* sil = (LAS float*)F.lds;
    for (int i = F.tid; i < NMI * D; i += NTHREADS) { const int mi = i >> 10, k = i & 1023; const float v = (mi < NB) ? c_lat[mi * D + k] : c_ctx[k]; sil[i] = silu_f(v); }
    __syncthreads();
    {
        float* modv = (float*)(ws + WS_MODV);
        const int NT16 = 6 * D / 16;
        for (int task = F.gw; task < DEPTH * NT16; task += F.NGW) {
            const int layer = task / NT16, j0 = (task % NT16) * 16, jj = F.lane & 15, kq = F.lane >> 4;
            const float* wp = w_mod + (size_t)layer * D * 6 * D + j0 + jj;
            float acc[NMI];
#pragma unroll
            for (int m = 0; m < NMI; ++m) acc[m] = 0.f;
            for (int k0 = kq; k0 < D; k0 += 64) {
                float wv[16];
#pragma unroll
                for (int u = 0; u < 16; ++u) wv[u] = wp[(size_t)(k0 + 4 * u) * 6 * D];
#pragma unroll
                for (int u = 0; u < 16; ++u) { const int k = k0 + 4 * u;
#pragma unroll
                    for (int m = 0; m < NMI; ++m) acc[m] = fmaf(sil[m * D + k], wv[u], acc[m]); } }
#pragma unroll
            for (int m = 0; m < NMI; ++m) { float v = acc[m]; v += __shfl_xor(v, 16); v += __shfl_xor(v, 32); acc[m] = v; }
            if (kq == 0) { const float bb = b_mod[layer * 6 * D + j0 + jj];
#pragma unroll
                for (int m = 0; m < NMI; ++m) modv[((size_t)layer * NMI + m) * 6 * D + j0 + jj] = acc[m] + bb; }
        }
    }
    __syncthreads();
    {
        LAS float* scr = (LAS float*)(F.lds) + F.wave * (64 * 33);
        constexpr int I_MI = 16 * 96, I_MO = 16 * 32, I_AI = 16 * 48, I_AO = 16 * 32;
        constexpr int PER_J = I_MI + I_MO + I_AI + I_AO;
        for (int it = F.gw; it < 2 * PER_J; it += F.NGW) {
            const int j = it / PER_J; int r = it % PER_J;
            if (r < I_MI) { const int kb = r / 96, nb = r % 96; transpose_item(in[8] + (size_t)j * D * MW_IN, MW_IN, D, (bf16_t*)(ws + WS_WMI) + (size_t)j * 3072 * D, 64 * kb, 32 * nb, 32 * nb, scr, F.lane); continue; } r -= I_MI;
            if (r < I_MO) { const int kb = r / 32, nb = r % 32; transpose_item(in[11] + (size_t)j * D * D, D, D, (bf16_t*)(ws + WS_WMO) + (size_t)j * D * D, 64 * kb, 32 * nb, 32 * nb, scr, F.lane); continue; } r -= I_MO;
            if (r < I_AI) { const int kb = r / 48, nb = r % 48; transpose_item(in[12] + (size_t)j * D * 1536, 1536, D, (bf16_t*)(ws + WS_WAI) + (size_t)j * 1536 * D, 64 * kb, 32 * nb, 32 * nb, scr, F.lane); continue; } r -= I_AI;
            { const int kb = r / 32, nb = r % 32; transpose_item(in[15] + (size_t)j * D * D, D, D, (bf16_t*)(ws + WS_WAO) + (size_t)j * D * D, 64 * kb, 32 * nb, 32 * nb, scr, F.lane); }
        }
    }
    {
        float* rc = (float*)(ws + WS_ROPE); float* rs = rc + SEQ * 32;
        for (int i = F.bid * NTHREADS + F.tid; i < SEQ * 32; i += F.G * NTHREADS) {
            const int t = i >> 5, p = i & 31; const float pos = (p < 16) ? (float)(t >> 6) : (float)(t & 63);
            const float inv = exp2f(-(float)(p & 15) * (13.287712379549449f / 16.f));
            float s, c; sincos_acc(pos * inv, s, c); rc[i] = c; rs[i] = s; }
    }
    __syncthreads();
}

__device__ __forceinline__ void moe_weights(Frame& F, const float* wg, const float* wu, const float* wd, unsigned char* ws, unsigned* counter) {
    LAS float* T = (LAS float*)F.lds;
    volatile LAS int* slot = (volatile LAS int*)(F.lds + 65536 + 256);
    const int lane = F.lane, w = F.wave, tid = F.tid;
    bf16_t* W1 = (bf16_t*)(ws + WS_W1); bf16_t* W2 = (bf16_t*)(ws + WS_W2);
    unsigned char* W1b = (unsigned char*)(ws + WS_W1); unsigned char* W2b = (unsigned char*)(ws + WS_W2);
    constexpr int NIT = NE * 3 * 16 * 4;
#define MW_SRC(it_) (((((it_) % 192) / 64) == 0 ? wg : ((((it_) % 192) / 64) == 1 ? wu : wd)) + (size_t)((it_) / 192) * D * D + (size_t)(64 * ((((it_) % 192) % 64) >> 2)) * D + 256 * ((((it_) % 192) % 64) & 3))
    __syncthreads();
    int pend = NIT;
    if (tid == 0) { slot[0] = (int)__hip_atomic_fetch_add(counter, 1u, __ATOMIC_RELAXED, __HIP_MEMORY_SCOPE_AGENT); pend = (int)__hip_atomic_fetch_add(counter, 1u, __ATOMIC_RELAXED, __HIP_MEMORY_SCOPE_AGENT); }
    __syncthreads();
    int it = slot[0];
    f32x4 v[8];
    if (it < NIT) { const float* src = MW_SRC(it);
#pragma unroll
        for (int i = 0; i < 8; ++i) v[i] = *(const f32x4*)(src + (size_t)(8 * w + i) * D + 4 * lane); }
    while (it < NIT) {
        if (tid == 0) { slot[1] = pend; pend = (int)__hip_atomic_fetch_add(counter, 1u, __ATOMIC_RELAXED, __HIP_MEMORY_SCOPE_AGENT); }
        __syncthreads();
#pragma unroll
        for (int i = 0; i < 8; ++i) *(LAS f32x4*)(T + (8 * w + i) * 256 + ((4 * lane) ^ (8 * (w & 3)))) = v[i];
        const int nx = slot[1];
        if (nx < NIT) { const float* src = MW_SRC(nx);
#pragma unroll
            for (int i = 0; i < 8; ++i) v[i] = *(const f32x4*)(src + (size_t)(8 * w + i) * D + 4 * lane); }
        __syncthreads();
        const int e = it / 192, r = it % 192, which = r / 64, kb = (r % 64) >> 2, nq = (r % 64) & 3;
        const int nl = lane & 7, c = lane >> 3;
        bf16_t* base = (which == 2) ? (W2 + (size_t)e * D * D) : (W1 + (size_t)e * 2048 * D);
#pragma unroll
        for (int j = 0; j < 4; ++j) { const int n = 32 * w + 8 * j + nl; const LAS float* tp = T + (8 * c) * 256 + (n ^ (8 * (c & 3)));
            float t[8];
#pragma unroll
            for (int i = 0; i < 8; ++i) t[i] = tp[i * 256];
            const int ng = 256 * nq + n; const int drow = (which == 2) ? ng : (256 * (ng >> 7) + (which == 1 ? 128 : 0) + (ng & 127));
            const bool f8 = (which == 2) ? (MOE_FP8_2 != 0) : (MOE_FP8_1 != 0);
            if (f8) { u32x2 o; o.x = pk_fp8x4(t[0] * FP8_SW, t[1] * FP8_SW, t[2] * FP8_SW, t[3] * FP8_SW); o.y = pk_fp8x4(t[4] * FP8_SW, t[5] * FP8_SW, t[6] * FP8_SW, t[7] * FP8_SW);
                unsigned char* b8 = (which == 2) ? (W2b + (size_t)e * D * D) : (W1b + (size_t)e * 2048 * D);
                *(u32x2*)(b8 + (size_t)drow * D + 64 * kb + 8 * c) = o; }
            else { u32x4 o; o.x = pk2(t[0], t[1]); o.y = pk2(t[2], t[3]); o.z = pk2(t[4], t[5]); o.w = pk2(t[6], t[7]);
                *(u32x4*)(base + (size_t)drow * D + 64 * kb + 8 * c) = o; } }
        it = nx;
    }
#undef MW_SRC
    __syncthreads();
}

__device__ __forceinline__ void load_w16(Frame& F, const float* W16, int ldw16) {
    LAS float* wl = (LAS float*)F.lds;
    for (int i = F.tid; i < D * 16; i += NTHREADS) { const int c = i >> 4, e = i & 15; const int l = (c & 255) >> 2, q = (c & 3) + 4 * (c >> 8);
        wl[(q * 64 + l) * 20 + e] = W16[(size_t)c * ldw16 + e]; }
    __syncthreads();
}
template <int MODE, bool F8 = false>
__device__ __forceinline__ void norm_core(LAS float* wl, const int lane, f32x4 (&v)[4], const int r, const f32x4 (&gv)[4], const float* shp, const float* scp, bf16_t* H, const float* bias16, float* out16) {
    float ss = 0.f;
#pragma unroll
    for (int j = 0; j < 4; ++j) ss += (v[j].x * v[j].x + v[j].y * v[j].y) + (v[j].z * v[j].z + v[j].w * v[j].w);
    const float rstd = rsqrtf(wave_sum(ss) * (1.f / D) + NORM_EPS);
    unsigned long long* o8 = (unsigned long long*)(H + (size_t)r * D) + lane;
#pragma unroll
    for (int j = 0; j < 4; ++j) { const f32x4 sh = *(const f32x4*)(shp + 4 * lane + 256 * j), sc = *(const f32x4*)(scp + 4 * lane + 256 * j);
        v[j] = (v[j] * rstd * gv[j]) * (sc + 1.f) + sh;
        if (F8) ((unsigned*)((unsigned char*)H + (size_t)r * D))[lane + 64 * j] = pk_fp8x4(v[j].x * FP8_SH, v[j].y * FP8_SH, v[j].z * FP8_SH, v[j].w * FP8_SH);
        else o8[64 * j] = (unsigned long long)pk2(v[j].x, v[j].y) | ((unsigned long long)pk2(v[j].z, v[j].w) << 32); }
    if (MODE != 0) {
        float p[16];
#pragma unroll
        for (int e = 0; e < 16; ++e) p[e] = 0.f;
#pragma unroll
        for (int j = 0; j < 4; ++j) {
            f32x4 wq[4][4];
#pragma unroll
            for (int i = 0; i < 4; ++i) { const LAS f32x4* wp = (const LAS f32x4*)(wl + ((4 * j + i) * 64 + lane) * 20);
#pragma unroll
                for (int e4 = 0; e4 < 4; ++e4) wq[i][e4] = wp[e4]; }
            asm volatile("s_waitcnt lgkmcnt(0)" ::: "memory"); __builtin_amdgcn_sched_barrier(0);
#pragma unroll
            for (int i = 0; i < 4; ++i) { const float xv = v[j][i];
#pragma unroll
                for (int e4 = 0; e4 < 4; ++e4) { const f32x4 w = wq[i][e4]; p[4 * e4 + 0] = fmaf(xv, w.x, p[4 * e4 + 0]); p[4 * e4 + 1] = fmaf(xv, w.y, p[4 * e4 + 1]); p[4 * e4 + 2] = fmaf(xv, w.z, p[4 * e4 + 2]); p[4 * e4 + 3] = fmaf(xv, w.w, p[4 * e4 + 3]); } }
            __builtin_amdgcn_sched_barrier(0);
        }
        float q8[8], q4[4], q2[2], q1;
        { const bool up = (lane & 32) != 0;
#pragma unroll
          for (int i = 0; i < 8; ++i) { const float send = up ? p[i] : p[i + 8]; const float recv = __shfl_xor(send, 32); q8[i] = (up ? p[i + 8] : p[i]) + recv; } }
        { const bool up = (lane & 16) != 0;
#pragma unroll
          for (int i = 0; i < 4; ++i) { const float send = up ? q8[i] : q8[i + 4]; const float recv = __shfl_xor(send, 16); q4[i] = (up ? q8[i + 4] : q8[i]) + recv; } }
        { const bool up = (lane & 8) != 0;
#pragma unroll
          for (int i = 0; i < 2; ++i) { const float send = up ? q4[i] : q4[i + 2]; const float recv = __shfl_xor(send, 8); q2[i] = (up ? q4[i + 2] : q4[i]) + recv; } }
        { const bool up = (lane & 4) != 0; const float send = up ? q2[0] : q2[1]; const float recv = __shfl_xor(send, 4); q1 = (up ? q2[1] : q2[0]) + recv; }
        q1 = quad_sum(q1);
        const int e = ((lane >> 5) & 1) * 8 + ((lane >> 4) & 1) * 4 + ((lane >> 3) & 1) * 2 + ((lane >> 2) & 1);
        if (MODE == 1) {
            float g = q1 + bias16[e];
            g = 15.f * tanhf(g * (1.f / 15.f));
            const int gate = e >> 2;
            if (gate & 1) g = fminf(g, 0.f) - log1pf(__expf(-fabsf(g)));
            if ((lane & 3) == 0) out16[(size_t)r * 16 + e] = g;
        } else {
            float mx = q1;
#pragma unroll
            for (int o = 4; o < 64; o <<= 1) mx = fmaxf(mx, __shfl_xor(mx, o));
            const float ex = __expf(q1 - mx); float sm = ex;
#pragma unroll
            for (int o = 4; o < 64; o <<= 1) sm += __shfl_xor(sm, o);
            if ((lane & 3) == 0) out16[(size_t)e * RT + r] = ex / sm;
        }
    }
}
__device__ __forceinline__ float swap32_add(float a, float b) { auto r = __builtin_amdgcn_permlane32_swap(__float_as_uint(a), __float_as_uint(b), false, false); return __uint_as_float(r[0]) + __uint_as_float(r[1]); }
__device__ __forceinline__ float swap16_add(float a, float b) { auto r = __builtin_amdgcn_permlane16_swap(__float_as_uint(a), __float_as_uint(b), false, false); return __uint_as_float(r[0]) + __uint_as_float(r[1]); }
template <int MODE, bool F8 = false, bool X16SRC = false>
__device__ __forceinline__ void norm_pass(Frame& F, const float* xL, const float* xC  , int nrows, const float* gain, const float* shiftv, const float* scalev  ,
                                          bf16_t* H, const float* W16, int ldw16, const float* bias16, float* out16) {
    LAS float* wl = (LAS float*)F.lds;
    if (MODE != 0) load_w16(F, W16, ldw16);
    const int lane = F.lane;
    f32x4 gv[4];
#pragma unroll
    for (int j = 0; j < 4; ++j) gv[j] = *(const f32x4*)(gain + 4 * lane + 256 * j);
    const int per = (((nrows + F.NGW - 1) / F.NGW) + 1) & ~1; const int r0 = F.gw * per, r1 = (r0 + per < nrows) ? r0 + per : nrows;
#define NP_XPTR(rr) (((rr) >= RL) ? (xC + (size_t)((rr) - RL) * D) : (xL + (size_t)(rr) * D))
#define NP_LOADROW(dst, rr) do { if (X16SRC) { const u32x2* xp_ = (const u32x2*)((const bf16_t*)xL + (size_t)(rr) * D) + lane; _Pragma("unroll") for (int j = 0; j < 4; ++j) { const u32x2 t_ = xp_[64 * j]; dst[j] = (f32x4){bf_lo(t_.x), bf_hi(t_.x), bf_lo(t_.y), bf_hi(t_.y)}; } } \
        else { const float* xr_ = NP_XPTR(rr); _Pragma("unroll") for (int j = 0; j < 4; ++j) dst[j] = *(const f32x4*)(xr_ + 4 * lane + 256 * j); } } while (0)
    f32x4 vn[2][4];
    if (r0 < r1) { NP_LOADROW(vn[0], r0); NP_LOADROW(vn[1], r0 + 1); }
    for (int r = r0; r < r1; r += 2) {
        asm volatile("" ::: "memory");
        f32x4 v[2][4];
#pragma unroll
        for (int q = 0; q < 2; ++q)
#pragma unroll
            for (int j = 0; j < 4; ++j) v[q][j] = vn[q][j];
        if (r + 2 < r1) { NP_LOADROW(vn[0], r + 2); NP_LOADROW(vn[1], r + 3); }
        float ss[2];
#pragma unroll
        for (int q = 0; q < 2; ++q) { ss[q] = 0.f;
#pragma unroll
            for (int j = 0; j < 4; ++j) ss[q] += (v[q][j].x * v[q][j].x + v[q][j].y * v[q][j].y) + (v[q][j].z * v[q][j].z + v[q][j].w * v[q][j].w); }
        ss[0] = row16_sum(ss[0]); ss[1] = row16_sum(ss[1]);
        const float tot0 = (rdlane(ss[0], 0) + rdlane(ss[0], 16)) + (rdlane(ss[0], 32) + rdlane(ss[0], 48)), tot1 = (rdlane(ss[1], 0) + rdlane(ss[1], 16)) + (rdlane(ss[1], 32) + rdlane(ss[1], 48));
        const float rstd[2] = {rsqrtf(tot0 * (1.f / D) + NORM_EPS), rsqrtf(tot1 * (1.f / D) + NORM_EPS)};
#pragma unroll
        for (int q = 0; q < 2; ++q) { const int rr = r + q; const int mi = (rr >= RL) ? NB : (rr >> 12);
            const float* shp = shiftv + (size_t)mi * 6 * D; const float* scp = scalev + (size_t)mi * 6 * D;
#pragma unroll
            for (int j = 0; j < 4; ++j) { const f32x4 sh = *(const f32x4*)(shp + 4 * lane + 256 * j), sc = *(const f32x4*)(scp + 4 * lane + 256 * j);
                v[q][j] = (v[q][j] * rstd[q] * gv[j]) * (sc + 1.f) + sh;
                if (F8) ((unsigned*)((unsigned char*)H + (size_t)rr * D))[lane + 64 * j] = pk_fp8x4(v[q][j].x * FP8_SH, v[q][j].y * FP8_SH, v[q][j].z * FP8_SH, v[q][j].w * FP8_SH);
                else ((unsigned long long*)(H + (size_t)rr * D))[lane + 64 * j] = (unsigned long long)pk2(v[q][j].x, v[q][j].y) | ((unsigned long long)pk2(v[q][j].z, v[q][j].w) << 32); } }
        if (MODE != 0) {
            f32x2 p2[2][8];
#pragma unroll
            for (int q = 0; q < 2; ++q)
#pragma unroll
                for (int e = 0; e < 8; ++e) p2[q][e] = (f32x2){0.f, 0.f};
#pragma unroll
            for (int j = 0; j < 4; ++j) {
                f32x4 wq[4][4];
#pragma unroll
                for (int i = 0; i < 4; ++i) { const LAS f32x4* wp = (const LAS f32x4*)(wl + ((4 * j + i) * 64 + lane) * 20);
#pragma unroll
                    for (int e4 = 0; e4 < 4; ++e4) wq[i][e4] = wp[e4]; }
                asm volatile("s_waitcnt lgkmcnt(0)" ::: "memory"); __builtin_amdgcn_sched_barrier(0);
#pragma unroll
                for (int i = 0; i < 4; ++i)
#pragma unroll
                    for (int q = 0; q < 2; ++q) { const float xv = v[q][j][i]; const f32x2 x2 = {xv, xv};
#pragma unroll
                        for (int e4 = 0; e4 < 4; ++e4) { const f32x4 w = wq[i][e4];
                            p2[q][2 * e4 + 0] = __builtin_elementwise_fma(x2, (f32x2){w.x, w.y}, p2[q][2 * e4 + 0]);
                            p2[q][2 * e4 + 1] = __builtin_elementwise_fma(x2, (f32x2){w.z, w.w}, p2[q][2 * e4 + 1]); } }
                __builtin_amdgcn_sched_barrier(0);
            }
            float p[2][16];
#pragma unroll
            for (int q = 0; q < 2; ++q)
#pragma unroll
                for (int e = 0; e < 8; ++e) { p[q][2 * e] = p2[q][e].x; p[q][2 * e + 1] = p2[q][e].y; }
            float q16[16], q8[8], q4[4], q2[2], q1;
#pragma unroll
            for (int e = 0; e < 16; ++e) q16[e] = swap32_add(p[0][e], p[1][e]);
#pragma unroll
            for (int i = 0; i < 8; ++i) q8[i] = swap16_add(q16[i], q16[i + 8]);
            { const bool up = (lane & 8) != 0;
#pragma unroll
              for (int i = 0; i < 4; ++i) { const float send = up ? q8[i] : q8[i + 4]; const float recv = __shfl_xor(send, 8); q4[i] = (up ? q8[i + 4] : q8[i]) + recv; } }
            { const bool up = (lane & 4) != 0;
#pragma unroll
              for (int i = 0; i < 2; ++i) { const float send = up ? q4[i] : q4[i + 2]; const float recv = __shfl_xor(send, 4); q2[i] = (up ? q4[i + 2] : q4[i]) + recv; } }
            { const bool up = (lane & 2) != 0; const float send = up ? q2[0] : q2[1]; const float recv = dpp_f<0x4E>(0.f, send); q1 = (up ? q2[1] : q2[0]) + recv; }
            q1 += dpp_f<0xB1>(0.f, q1);
            const int e = ((lane >> 4) & 1) * 8 + ((lane >> 3) & 1) * 4 + ((lane >> 2) & 1) * 2 + ((lane >> 1) & 1);
            const int rr = r + (lane >> 5);
            if (MODE == 1) {
                float g = q1 + bias16[e];
                g = 15.f * tanhf(g * (1.f / 15.f));
                const int gate = e >> 2;
                if (gate & 1) g = fminf(g, 0.f) - log1pf(__expf(-fabsf(g)));
                if ((lane & 1) == 0) out16[(size_t)rr * 16 + e] = g;
            } else {
                float mx = q1;
                mx = fmaxf(mx, dpp_f<0x4E>(mx, mx)); mx = fmaxf(mx, dpp_f<0x141>(mx, mx)); mx = fmaxf(mx, dpp_f<0x140>(mx, mx));
                { auto t = __builtin_amdgcn_permlane16_swap(__float_as_uint(mx), __float_as_uint(mx), false, false); mx = fmaxf(__uint_as_float(t[0]), __uint_as_float(t[1])); }
                const float ex = __expf(q1 - mx); float sm = ex;
                sm += dpp_f<0x4E>(0.f, sm); sm += dpp_f<0x141>(0.f, sm); sm += dpp_f<0x140>(0.f, sm);
                sm = swap16_add(sm, sm);
                if ((lane & 1) == 0) out16[(size_t)e * RT + rr] = ex / sm;
            }
        }
    }
#undef NP_XPTR
#undef NP_LOADROW
    if (MODE != 0) __syncthreads();
}

template <int MODE, bool F8, bool X16SRC>
__device__ __forceinline__ void norm16_pass(Frame& F, const float* xL, const float* xC  , int nrows, const float* gain, const float* shiftv,
                                            const float* scalev, bf16_t* H, const float* W16, int ldw16, const float* bias16, float* out16) {
    const int lane = F.lane, w = F.wave, row = lane & 15, g = lane >> 4;
    LAS float* part = (LAS float*)F.lds;
    LAS f32x4* pacc = (LAS f32x4*)(F.lds + 1024);
    bf16x8 wh[4], wlo[4];
#pragma unroll
    for (int ks = 0; ks < 4; ++ks) { float t[8];
#pragma unroll
        for (int jj = 0; jj < 8; ++jj) t[jj] = W16[(size_t)(128 * w + 32 * ks + 8 * g + jj) * ldw16 + row];
        u32x4 hi4, lo4; unsigned hp[4], lp[4];
#pragma unroll
        for (int q = 0; q < 4; ++q) { hp[q] = pk2(t[2 * q], t[2 * q + 1]); lp[q] = pk2(t[2 * q] - bf_lo(hp[q]), t[2 * q + 1] - bf_hi(hp[q])); }
        hi4 = (u32x4){hp[0], hp[1], hp[2], hp[3]}; lo4 = (u32x4){lp[0], lp[1], lp[2], lp[3]};
        wh[ks] = __builtin_bit_cast(bf16x8, hi4); wlo[ks] = __builtin_bit_cast(bf16x8, lo4); }
    f32x4 gn[4][2];
#pragma unroll
    for (int ks = 0; ks < 4; ++ks) { gn[ks][0] = *(const f32x4*)(gain + 128 * w + 32 * ks + 8 * g); gn[ks][1] = *(const f32x4*)(gain + 128 * w + 32 * ks + 8 * g + 4); }
    const int ngrp = nrows / 16; const int per = (ngrp + F.G - 1) / F.G; const int g0 = F.vcu * per, g1 = (g0 + per < ngrp) ? g0 + per : ngrp;
#define N16_LOAD(dst, gi_) do { const int rr_ = 16 * (gi_) + row; \
        if (X16SRC) { const bf16_t* xp_ = (const bf16_t*)xL + (size_t)rr_ * D + 128 * w + 8 * g; _Pragma("unroll") for (int ks = 0; ks < 4; ++ks) { const u32x4 u_ = *(const u32x4*)(xp_ + 32 * ks); \
                dst[ks][0] = (f32x4){bf_lo(u_.x), bf_hi(u_.x), bf_lo(u_.y), bf_hi(u_.y)}; dst[ks][1] = (f32x4){bf_lo(u_.z), bf_hi(u_.z), bf_lo(u_.w), bf_hi(u_.w)}; } } \
        else { const float* xp_ = ((rr_ >= RL) ? (xC + (size_t)(rr_ - RL) * D) : (xL + (size_t)rr_ * D)) + 128 * w + 8 * g; _Pragma("unroll") for (int ks = 0; ks < 4; ++ks) { dst[ks][0] = *(const f32x4*)(xp_ + 32 * ks); dst[ks][1] = *(const f32x4*)(xp_ + 32 * ks + 4); } } } while (0)
    f32x4 xn[4][2];
    __syncthreads();
    if (g0 < g1) N16_LOAD(xn, g0);
    for (int gi = g0; gi < g1; ++gi) {
        const int buf = gi & 1; const int r0 = 16 * gi; const int mi = (r0 >= RL) ? NB : (r0 >> 12);
        f32x4 x[4][2];
#pragma unroll
        for (int ks = 0; ks < 4; ++ks) { x[ks][0] = xn[ks][0]; x[ks][1] = xn[ks][1]; }
        float ss = 0.f;
#pragma unroll
        for (int ks = 0; ks < 4; ++ks)
#pragma unroll
            for (int h2 = 0; h2 < 2; ++h2) ss += (x[ks][h2].x * x[ks][h2].x + x[ks][h2].y * x[ks][h2].y) + (x[ks][h2].z * x[ks][h2].z + x[ks][h2].w * x[ks][h2].w);
        ss = swap16_add(ss, ss); ss = swap32_add(ss, ss);
        if (g == 0) part[buf * 128 + w * 16 + row] = ss;
        __syncthreads();
        if (gi + 1 < g1) N16_LOAD(xn, gi + 1);
        float tot = 0.f;
#pragma unroll
        for (int q = 0; q < 8; ++q) tot += part[buf * 128 + q * 16 + row];
        const float rstd = rsqrtf(tot * (1.f / D) + NORM_EPS);
        const float* shp = shiftv + (size_t)mi * 6 * D + 128 * w + 8 * g; const float* scp = scalev + (size_t)mi * 6 * D + 128 * w + 8 * g;
        f32x4 acc = (f32x4){0.f, 0.f, 0.f, 0.f};
#pragma unroll
        for (int ks = 0; ks < 4; ++ks) {
            f32x4 h[2];
#pragma unroll
            for (int h2 = 0; h2 < 2; ++h2) { const f32x4 sh = *(const f32x4*)(shp + 32 * ks + 4 * h2), sc = *(const f32x4*)(scp + 32 * ks + 4 * h2);
                h[h2] = (x[ks][h2] * rstd * gn[ks][h2]) * (sc + 1.f) + sh; }
            const size_t ho = (size_t)(r0 + row) * D + 128 * w + 32 * ks + 8 * g;
            u32x4 hi4; hi4.x = pk2(h[0].x, h[0].y); hi4.y = pk2(h[0].z, h[0].w); hi4.z = pk2(h[1].x, h[1].y); hi4.w = pk2(h[1].z, h[1].w);
            if (F8) { u32x2 o; o.x = pk_fp8x4(h[0].x * FP8_SH, h[0].y * FP8_SH, h[0].z * FP8_SH, h[0].w * FP8_SH); o.y = pk_fp8x4(h[1].x * FP8_SH, h[1].y * FP8_SH, h[1].z * FP8_SH, h[1].w * FP8_SH);
                *(u32x2*)((unsigned char*)H + ho) = o; }
            else *(u32x4*)(H + ho) = hi4;
            u32x4 lo4; lo4.x = pk2(h[0].x - bf_lo(hi4.x), h[0].y - bf_hi(hi4.x)); lo4.y = pk2(h[0].z - bf_lo(hi4.y), h[0].w - bf_hi(hi4.y));
            lo4.z = pk2(h[1].x - bf_lo(hi4.z), h[1].y - bf_hi(hi4.z)); lo4.w = pk2(h[1].z - bf_lo(hi4.w), h[1].w - bf_hi(hi4.w));
            const bf16x8 ah = __builtin_bit_cast(bf16x8, hi4), al = __builtin_bit_cast(bf16x8, lo4);
            acc = __builtin_amdgcn_mfma_f32_16x16x32_bf16(ah, wh[ks], acc, 0, 0, 0);
            acc = __builtin_amdgcn_mfma_f32_16x16x32_bf16(ah, wlo[ks], acc, 0, 0, 0);
            acc = __builtin_amdgcn_mfma_f32_16x16x32_bf16(al, wh[ks], acc, 0, 0, 0);
        }
        pacc[buf * 512 + w * 64 + lane] = acc;
        __syncthreads();
        if (w == (gi & 7)) {
            f32x4 t = (f32x4){0.f, 0.f, 0.f, 0.f};
#pragma unroll
            for (int q = 0; q < 8; ++q) t += pacc[buf * 512 + q * 64 + lane];
            if (MODE == 1) {
                const float bb = bias16[row]; const int gate = row >> 2;
#pragma unroll
                for (int reg = 0; reg < 4; ++reg) { float gg = t[reg] + bb; gg = 15.f * tanhf(gg * (1.f / 15.f));
                    if (gate & 1) gg = fminf(gg, 0.f) - log1pf(__expf(-fabsf(gg)));
                    out16[(size_t)(r0 + 4 * g + reg) * 16 + row] = gg; }
            } else {
                f32x4 o;
#pragma unroll
                for (int reg = 0; reg < 4; ++reg) { float mx = t[reg];
                    mx = fmaxf(mx, dpp_f<0xB1>(mx, mx)); mx = fmaxf(mx, dpp_f<0x4E>(mx, mx)); mx = fmaxf(mx, dpp_f<0x141>(mx, mx)); mx = fmaxf(mx, dpp_f<0x140>(mx, mx));
                    const float ex = __expf(t[reg] - mx); const float sm = row16_sum(ex); o[reg] = ex / sm; }
                *(f32x4*)(out16 + (size_t)row * RT + r0 + 4 * g) = o;
            }
        }
    }
#undef N16_LOAD
    __syncthreads();
}

__device__ __forceinline__ void gates16_pass(Frame& F, const bf16_t* Hrows, int nrows, const float* W16, int ldw16, const float* bias16, float* out16) {
    const int lane = F.lane, row = lane & 15, g = lane >> 4;
    const int ngrp = nrows / 16; const int per = (ngrp + F.NGW - 1) / F.NGW; const int g0 = F.gw * per, g1 = (g0 + per < ngrp) ? g0 + per : ngrp;
    for (int gi = g0; gi < g1; ++gi) {
        const int r0 = 16 * gi; const bf16_t* xp = Hrows + (size_t)(r0 + row) * D + 8 * g;
        f32x4 acc = (f32x4){0.f, 0.f, 0.f, 0.f};
#pragma unroll 4
        for (int ks = 0; ks < 32; ++ks) {
            const bf16x8 ah = *(const bf16x8*)(xp + 32 * ks);
            float t[8];
#pragma unroll
            for (int jj = 0; jj < 8; ++jj) t[jj] = W16[(size_t)(32 * ks + 8 * g + jj) * ldw16 + row];
            unsigned hp[4], lp[4];
#pragma unroll
            for (int q = 0; q < 4; ++q) { hp[q] = pk2(t[2 * q], t[2 * q + 1]); lp[q] = pk2(t[2 * q] - bf_lo(hp[q]), t[2 * q + 1] - bf_hi(hp[q])); }
            const bf16x8 bh = __builtin_bit_cast(bf16x8, (u32x4){hp[0], hp[1], hp[2], hp[3]}), bl = __builtin_bit_cast(bf16x8, (u32x4){lp[0], lp[1], lp[2], lp[3]});
            acc = __builtin_amdgcn_mfma_f32_16x16x32_bf16(ah, bh, acc, 0, 0, 0);
            acc = __builtin_amdgcn_mfma_f32_16x16x32_bf16(ah, bl, acc, 0, 0, 0);
        }
        const float bb = bias16[row]; const int gate = row >> 2;
#pragma unroll
        for (int reg = 0; reg < 4; ++reg) { float gg = acc[reg] + bb; gg = 15.f * tanhf(gg * (1.f / 15.f));
            if (gate & 1) gg = fminf(gg, 0.f) - log1pf(__expf(-fabsf(gg)));
            out16[(size_t)(r0 + 4 * g + reg) * 16 + row] = gg; }
    }
}

__device__ __forceinline__ void moe_select(Frame& F, const float* AFF, int* INV, int* SLROW, float* SLG, int nunits) {
    LAS unsigned* keys = (LAS unsigned*)F.lds;
    LAS unsigned* wsum = (LAS unsigned*)(F.lds + 16384);
    const int tid = F.tid, lane = F.lane, wave = F.wave;
    for (int u = F.vcu; u < nunits; u += F.G) {
        const int set = u >> 4, e = u & 15; const bool isc = set >= NB; const int b = isc ? set - NB : set;
        const int N = isc ? CTXL : SEQ, k = isc ? CAP_C : CAP_L, PER = isc ? 1 : 8;
        const int row0 = isc ? RL + b * CTXL : b * SEQ;
        const int nmine = (tid * PER < N) ? PER : 0;
        unsigned kv[8];
        if (tid < 32) wsum[tid] = 0u;
#pragma unroll
        for (int i = 0; i < 8; ++i) { kv[i] = 0u; if (i < nmine) kv[i] = __float_as_uint(AFF[(size_t)e * RT + row0 + tid * PER + i]); }
        __syncthreads();
        unsigned T = 0u; { unsigned kk = (unsigned)k;
        for (int pass = 0; pass < 8; ++pass) {
            const int shift = 28 - 4 * pass; LAS unsigned* hist = wsum + (pass & 1) * 16;
            if (tid < 16) wsum[((pass + 1) & 1) * 16 + tid] = 0u;
#pragma unroll
            for (int i = 0; i < 8; ++i) if (i < nmine && (pass == 0 || (kv[i] >> (shift + 4)) == (T >> (shift + 4)))) (void)__hip_atomic_fetch_add(&hist[(kv[i] >> shift) & 15u], 1u, __ATOMIC_RELAXED, __HIP_MEMORY_SCOPE_WORKGROUP);
            __syncthreads();
            unsigned cum = 0u, digit = 0u; bool found = false;
#pragma unroll
            for (int d = 15; d >= 0; --d) { const unsigned c = hist[d]; if (!found) { if (cum + c >= kk) { digit = (unsigned)d; found = true; } else cum += c; } }
            kk -= cum; T |= digit << shift;
            __syncthreads();
        } }
        unsigned ngt = 0u, neq = 0u;
#pragma unroll
        for (int i = 0; i < 8; ++i) { if (i < nmine) { ngt += kv[i] > T ? 1u : 0u; neq += kv[i] == T ? 1u : 0u; } }
        unsigned sgt = ngt, seq = neq;
#pragma unroll
        for (int o = 1; o < 64; o <<= 1) { const unsigned a = __shfl_up(sgt, o), c2 = __shfl_up(seq, o); if (lane >= o) { sgt += a; seq += c2; } }
        LAS unsigned* sc = wsum + 32;
        __syncthreads();
        if (lane == 63) { sc[wave] = sgt; sc[8 + wave] = seq; }
        __syncthreads();
        unsigned bgt = 0u, beq = 0u, tgt = 0u;
#pragma unroll
        for (int w = 0; w < 8; ++w) { const unsigned a = sc[w], c2 = sc[8 + w]; if (w < wave) { bgt += a; beq += c2; } tgt += a; }
        const unsigned need = (unsigned)k - tgt;
        unsigned pgt = bgt + sgt - ngt, peq = beq + seq - neq;
        const int sbase = isc ? NB * CAP_L + b * CAP_C : b * CAP_L;
#pragma unroll
        for (int i = 0; i < 8; ++i) { if (i < nmine) {
            const int row = row0 + tid * PER + i; int slot = -1;
            if (kv[i] > T) { slot = (int)(pgt + (peq < need ? peq : need)); ++pgt; }
            else if (kv[i] == T) { if (peq < need) slot = (int)(pgt + peq); ++peq; }
            if (slot >= 0) { SLROW[e * SLOTS_E + sbase + slot] = row; SLG[e * SLOTS_E + sbase + slot] = __uint_as_float(kv[i]); }
            INV[(size_t)e * RT + row] = slot >= 0 ? sbase + slot : -1; } }
        __syncthreads();
    }
    (void)keys;
}

__device__ __forceinline__ void moe_gather(Frame& F, const bf16_t* H, const int* SLROW, bf16_t* XG, bool with_ctx) {
    const int per_e = with_ctx ? SLOTS_E : NB * CAP_L; const int total = NE * per_e;
    const int per = (total + F.NGW - 1) / F.NGW; const int i0 = F.gw * per, i1 = (i0 + per < total) ? i0 + per : total;
    for (int i = i0; i < i1; i += 4) {
        u32x4 a[4], b2[4]; size_t dsto[4];
#pragma unroll
        for (int q = 0; q < 4; ++q) { const int ii = (i + q < i1) ? i + q : i1 - 1; const int e = ii / per_e, sl = ii - e * per_e; const int row = SLROW[e * SLOTS_E + sl];
            const u32x4* src = (const u32x4*)(H + (size_t)row * D) + F.lane; a[q] = src[0]; b2[q] = src[64]; dsto[q] = ((size_t)e * SLOTS_E + sl) * D; }
#pragma unroll
        for (int q = 0; q < 4; ++q) { u32x4* dst = (u32x4*)(XG + dsto[q]) + F.lane; dst[0] = a[q]; dst[64] = b2[q]; }
    }
}

template <int MODE>
__device__ __forceinline__ void combine_norm(Frame& F, const bf16_t* Y, const int* INV, bf16_t* X16, float* outL  , const float* g2v  , int nrows,
                                             const float* gain, const float* shiftv, const float* scalev, bf16_t* H, const float* W16, int ldw16, const float* bias16, float* out16) {
    LAS float* wl = (LAS float*)F.lds;
    if (MODE == 1) load_w16(F, W16, ldw16);
    const int lane = F.lane;
    f32x4 gv[4];
#pragma unroll
    for (int j = 0; j < 4; ++j) gv[j] = *(const f32x4*)(gain + 4 * lane + 256 * j);
    const int per = (nrows + F.NGW - 1) / F.NGW; const int r0 = F.gw * per, r1 = (r0 + per < nrows) ? r0 + per : nrows;
#define CN_XLOAD(dst, rr) do { const u32x2* xp_ = (const u32x2*)(X16 + (size_t)(rr) * D) + lane; _Pragma("unroll") for (int j = 0; j < 4; ++j) { const u32x2 t_ = xp_[64 * j]; dst[j] = (f32x4){bf_lo(t_.x), bf_hi(t_.x), bf_lo(t_.y), bf_hi(t_.y)}; } } while (0)
#define CN_INV(rr) (((rr) < r1 && lane < 16) ? INV[(size_t)lane * RT + (rr)] : -1)
#if MOE_Y_FP8
#define CN_YLOAD(dst, e_, s_) do { const unsigned* yp_ = (const unsigned*)((const unsigned char*)Y + ((size_t)(e_) * SLOTS_E + (s_)) * D) + lane; _Pragma("unroll") for (int j = 0; j < 4; ++j) dst[j].x = yp_[64 * j]; } while (0)
#define CN_YACC(src) do { _Pragma("unroll") for (int j = 0; j < 4; ++j) { const f32x2 lo_ = __builtin_amdgcn_cvt_pk_f32_fp8((int)src[j].x, false), hi_ = __builtin_amdgcn_cvt_pk_f32_fp8((int)src[j].x, true); \
        a[j].x += lo_.x; a[j].y += lo_.y; a[j].z += hi_.x; a[j].w += hi_.y; } } while (0)
#else
#define CN_YLOAD(dst, e_, s_) do { const u32x2* yp_ = (const u32x2*)(Y + ((size_t)(e_) * SLOTS_E + (s_)) * D) + lane; _Pragma("unroll") for (int j = 0; j < 4; ++j) dst[j] = yp_[64 * j]; } while (0)
#define CN_YACC(src) do { _Pragma("unroll") for (int j = 0; j < 4; ++j) { a[j].x += bf_lo(src[j].x); a[j].y += bf_hi(src[j].x); a[j].z += bf_lo(src[j].y); a[j].w += bf_hi(src[j].y); } } while (0)
#endif
    f32x4 vn[4]; u32x2 pn0[4], pn1[4];
    int invA = CN_INV(r0), invB = CN_INV(r0 + 1);
#pragma unroll
    for (int j = 0; j < 4; ++j) { vn[j] = (f32x4){0.f, 0.f, 0.f, 0.f}; pn0[j] = (u32x2){0u, 0u}; pn1[j] = (u32x2){0u, 0u}; }
    if (r0 < r1) { CN_XLOAD(vn, r0);
        unsigned long long m = __ballot(invA >= 0);
        if (m) { const int e0 = __builtin_ctzll(m); m &= m - 1; CN_YLOAD(pn0, e0, __builtin_amdgcn_readlane(invA, e0)); if (m) { const int e1 = __builtin_ctzll(m); CN_YLOAD(pn1, e1, __builtin_amdgcn_readlane(invA, e1)); } } }
    for (int r = r0; r < r1; ++r) {
        asm volatile("" ::: "memory");
        f32x4 v[4]; u32x2 pc0[4], pc1[4];
#pragma unroll
        for (int j = 0; j < 4; ++j) { v[j] = vn[j]; pc0[j] = pn0[j]; pc1[j] = pn1[j]; }
        const int invC = CN_INV(r + 2);
        if (r + 1 < r1) { CN_XLOAD(vn, r + 1);
            unsigned long long m = __ballot(invB >= 0);
            if (m) { const int e0 = __builtin_ctzll(m); m &= m - 1; CN_YLOAD(pn0, e0, __builtin_amdgcn_readlane(invB, e0)); if (m) { const int e1 = __builtin_ctzll(m); CN_YLOAD(pn1, e1, __builtin_amdgcn_readlane(invB, e1)); } } }
        f32x4 a[4];
#pragma unroll
        for (int j = 0; j < 4; ++j) a[j] = (f32x4){0.f, 0.f, 0.f, 0.f};
        { unsigned long long m = __ballot(invA >= 0);
          if (m) { m &= m - 1; CN_YACC(pc0);
            if (m) { m &= m - 1; CN_YACC(pc1);
              while (m) { const int e2 = __builtin_ctzll(m); m &= m - 1; u32x2 t2[4]; CN_YLOAD(t2, e2, __builtin_amdgcn_readlane(invA, e2)); CN_YACC(t2); } } } }
        const int mi = (r >= RL) ? NB : (r >> 12);
        const float* gp = g2v + (size_t)mi * 6 * D;
#pragma unroll
        for (int j = 0; j < 4; ++j) { const f32x4 g = *(const f32x4*)(gp + 4 * lane + 256 * j); v[j] = v[j] + g * a[j] * (MOE_Y_FP8 ? 1.f / FP8_SY : 1.f); }
        if (MODE == 3) { float* xw = outL + (size_t)r * D;
            float ss = 0.f;
#pragma unroll
            for (int j = 0; j < 4; ++j) ss += (v[j].x * v[j].x + v[j].y * v[j].y) + (v[j].z * v[j].z + v[j].w * v[j].w);
            const float rstd = rsqrtf(wave_sum(ss) * (1.f / D) + NORM_EPS);
#pragma unroll
            for (int j = 0; j < 4; ++j) *(f32x4*)(xw + 4 * lane + 256 * j) = v[j] * rstd * gv[j];
        } else {
#pragma unroll
            for (int j = 0; j < 4; ++j) ((unsigned long long*)(X16 + (size_t)r * D))[lane + 64 * j] = (unsigned long long)pk2(v[j].x, v[j].y) | ((unsigned long long)pk2(v[j].z, v[j].w) << 32);
            norm_core<MODE>(wl, lane, v, r, gv, shiftv + (size_t)mi * 6 * D, scalev + (size_t)mi * 6 * D, H, bias16, out16);
        }
        invA = invB; invB = invC;
    }
#undef CN_XLOAD
#undef CN_INV
#undef CN_YLOAD
#undef CN_YACC
    if (MODE == 1) __syncthreads();
}

__device__ __forceinline__ void final_norm(Frame& F, float* x, const float* gain) {
    const int lane = F.lane;
    for (int r = F.gw; r < RL; r += F.NGW) { float* xr = x + (size_t)r * D; f32x4 v[4]; float ss = 0.f;
#pragma unroll
        for (int j = 0; j < 4; ++j) { v[j] = *(const f32x4*)(xr + 4 * lane + 256 * j); ss += (v[j].x * v[j].x + v[j].y * v[j].y) + (v[j].z * v[j].z + v[j].w * v[j].w); }
        const float rstd = rsqrtf(wave_sum(ss) * (1.f / D) + NORM_EPS);
#pragma unroll
        for (int j = 0; j < 4; ++j) { const f32x4 g = *(const f32x4*)(gain + 4 * lane + 256 * j); *(f32x4*)(xr + 4 * lane + 256 * j) = v[j] * rstd * g; } }
}

__device__ __forceinline__ void unpack8(const u32x4 u, float (&x)[8]) { x[0] = bf_lo(u.x); x[1] = bf_hi(u.x); x[2] = bf_lo(u.y); x[3] = bf_hi(u.y); x[4] = bf_lo(u.z); x[5] = bf_hi(u.z); x[6] = bf_lo(u.w); x[7] = bf_hi(u.w); }
__device__ __forceinline__ u32x4 pack8(const float (&y)[8]) { u32x4 o; o.x = pk2(y[0], y[1]); o.y = pk2(y[2], y[3]); o.z = pk2(y[4], y[5]); o.w = pk2(y[6], y[7]); return o; }
__device__ __forceinline__ void k_pass(Frame& F, bf16_t* QKV, const float* kn, const float* ropec, const float* ropes) {
    const int lane = F.lane, p = lane & 3, kh = (lane >> 2) & 3, rsub = lane >> 4;
    float gk1[8], gk2[8];
#pragma unroll
    for (int t = 0; t < 8; ++t) { gk1[t] = kn[8 * p + t]; gk2[t] = kn[32 + 8 * p + t]; }
    const int ngrp = RT / 4; const int per = (ngrp + F.NGW - 1) / F.NGW; const int g0 = F.gw * per, g1 = (g0 + per < ngrp) ? g0 + per : ngrp;
    for (int gI = g0; gI < g1; gI += 2) {
        u32x4 ua[2], ub[2]; f32x4 c0[2], c1[2], s0[2], s1[2];
#pragma unroll
        for (int q = 0; q < 2; ++q) { const int gg = (gI + q < g1) ? gI + q : g1 - 1; const int rr = 4 * gg + rsub; const bool isc = rr >= RL; const int t = isc ? 0 : (rr & 4095);
            const bf16_t* hp = QKV + (size_t)rr * 1536 + 1024 + kh * 64 + 8 * p;
            ua[q] = *(const u32x4*)hp; ub[q] = *(const u32x4*)(hp + 32);
            c0[q] = *(const f32x4*)(ropec + t * 32 + 8 * p); c1[q] = *(const f32x4*)(ropec + t * 32 + 8 * p + 4); s0[q] = *(const f32x4*)(ropes + t * 32 + 8 * p); s1[q] = *(const f32x4*)(ropes + t * 32 + 8 * p + 4); }
#pragma unroll
        for (int q = 0; q < 2; ++q) { if (gI + q < g1) { const int rr = 4 * (gI + q) + rsub; const bool isc = rr >= RL;
            float cs[8] = {c0[q].x, c0[q].y, c0[q].z, c0[q].w, c1[q].x, c1[q].y, c1[q].z, c1[q].w}, sn[8] = {s0[q].x, s0[q].y, s0[q].z, s0[q].w, s1[q].x, s1[q].y, s1[q].z, s1[q].w};
            if (isc) {
#pragma unroll
                for (int i = 0; i < 8; ++i) { cs[i] = 1.f; sn[i] = 0.f; } }
            float x1[8], x2[8]; unpack8(ua[q], x1); unpack8(ub[q], x2);
            float ss = 0.f;
#pragma unroll
            for (int i = 0; i < 8; ++i) ss += x1[i] * x1[i] + x2[i] * x2[i];
            ss = quad_sum(ss);
            const float rstd = rsqrtf(ss * (1.f / 64.f) + NORM_EPS);
            float y1[8], y2[8];
#pragma unroll
            for (int i = 0; i < 8; ++i) { const float a = x1[i] * rstd * gk1[i], c = x2[i] * rstd * gk2[i]; y1[i] = a * cs[i] - c * sn[i]; y2[i] = a * sn[i] + c * cs[i]; }
            bf16_t* hp = QKV + (size_t)rr * 1536 + 1024 + kh * 64 + 8 * p;
            *(u32x4*)hp = pack8(y1); *(u32x4*)(hp + 32) = pack8(y2); } }
    }
}

__device__ __forceinline__ void mlstm_readout(Frame& F, const bf16_t* HF, const bf16_t* HB, const bf16_t* QKVO, const float* wnorm, bf16_t* MIX) {
    const int lane = F.lane;
    f32x4 gv[4];
#pragma unroll
    for (int j = 0; j < 4; ++j) gv[j] = *(const f32x4*)(wnorm + 4 * lane + 256 * j);
    const int per = (((RT + F.NGW - 1) / F.NGW) + 3) & ~3; const int r0 = F.gw * per, r1 = (r0 + per < RT) ? r0 + per : RT;
    for (int r = r0; r < r1; r += 4) {
        u32x2 uf[4][4], ub[4][4], uo[4][4];
#pragma unroll
        for (int q = 0; q < 4; ++q) { const int rr = (r + q < r1) ? r + q : r1 - 1;
            const u32x2* pf = (const u32x2*)(HF + (size_t)rr * D) + lane; const u32x2* pb = (const u32x2*)(HB + (size_t)rr * D) + lane; const u32x2* po = (const u32x2*)(QKVO + (size_t)rr * 3072 + 2048) + lane;
#pragma unroll
            for (int j = 0; j < 4; ++j) { uf[q][j] = pf[64 * j]; ub[q][j] = pb[64 * j]; uo[q][j] = po[64 * j]; } }
#pragma unroll
        for (int q = 0; q < 4; ++q) { const int rr = r + q; if (rr < r1) {
            unsigned long long* o8 = (unsigned long long*)(MIX + (size_t)rr * D) + lane;
#pragma unroll
            for (int j = 0; j < 4; ++j) {
                f32x4 h; h.x = bf_lo(uf[q][j].x) + bf_lo(ub[q][j].x); h.y = bf_hi(uf[q][j].x) + bf_hi(ub[q][j].x); h.z = bf_lo(uf[q][j].y) + bf_lo(ub[q][j].y); h.w = bf_hi(uf[q][j].y) + bf_hi(ub[q][j].y);
                const float ss = wave_sum((h.x * h.x + h.y * h.y) + (h.z * h.z + h.w * h.w));
                const float rstd = rsqrtf(ss * (1.f / 256.f) + NORM_EPS);
                f32x4 og; og.x = bf_lo(uo[q][j].x); og.y = bf_hi(uo[q][j].x); og.z = bf_lo(uo[q][j].y); og.w = bf_hi(uo[q][j].y);
                f32x4 y;
                y.x = h.x * rstd * gv[j].x * fast_rcp(1.f + __expf(-og.x)); y.y = h.y * rstd * gv[j].y * fast_rcp(1.f + __expf(-og.y));
                y.z = h.z * rstd * gv[j].z * fast_rcp(1.f + __expf(-og.z)); y.w = h.w * rstd * gv[j].w * fast_rcp(1.f + __expf(-og.w));
                o8[64 * j] = (unsigned long long)pk2(y.x, y.y) | ((unsigned long long)pk2(y.z, y.w) << 32);
            } } }
    }
}
namespace mls {
constexpr int XS = 272, PS = 144, NCH = 68;
constexpr int O_XQ = 0, O_XK = 17408, O_XKP = 34816, O_XV = 52224, O_P = 69632, O_CT = 78848, O_OT = 113664, O_GB = 131072;
constexpr int O_RD = O_GB + 2 * 5 * 64 * 4, O_NV = O_RD + 256, O_DEC = O_NV + 1024, O_PRE = O_DEC + 64;
constexpr int LDS_BYTES = O_PRE + 3 * 72 * 4;

__device__ __forceinline__ int row_of(int b, int dir, int c, int p) {
    const int base = (c < 4) ? (RL + b * CTXL + (dir ? 192 - 64 * c : 64 * c)) : (b * SEQ + (dir ? 4032 - 64 * (c - 4) : 64 * (c - 4)));
    return base + (dir ? 63 - p : p);
}
__device__ __forceinline__ int base_of(int b, int dir, int c) { return (c < 4) ? (RL + b * CTXL + (dir ? 192 - 64 * c : 64 * c)) : (b * SEQ + (dir ? 4032 - 64 * (c - 4) : 64 * (c - 4))); }
__device__ __forceinline__ bf16x8 tr8(const LAS unsigned char* p0, const LAS unsigned char* p1) {
    typedef short v4i16_t __attribute__((ext_vector_type(4)));
    const s16x4 lo = __builtin_bit_cast(s16x4, __builtin_amdgcn_ds_read_tr16_b64_v4i16((LAS v4i16_t*)p0));
    const s16x4 hi = __builtin_bit_cast(s16x4, __builtin_amdgcn_ds_read_tr16_b64_v4i16((LAS v4i16_t*)p1));
    return (bf16x8){lo[0], lo[1], lo[2], lo[3], hi[0], hi[1], hi[2], hi[3]};
}

__device__ __forceinline__ void gate_arrays(LAS unsigned char* L, const float lf, const float ig, int c, int lane) {
    const int par = c & 1;
    const float bs = wave_scan_add(lf, lane);
    const float a = ig - bs; const float pm = wave_scan_max(a, lane);
    const float mst = ((const LAS float*)(L + O_PRE))[144 + c];
    const float M = fmaxf(mst, pm), M63 = rdlane(M, 63);
    LAS float* gb = (LAS float*)(L + O_GB) + par * 320;
    gb[lane] = a; gb[64 + lane] = M; gb[128 + lane] = __expf(mst - M); gb[192 + lane] = __expf(-bs - M); gb[256 + lane] = __expf(a - M63);
    if (lane == 0) ((LAS float*)(L + O_DEC))[par] = __expf(mst - M63);
}

__device__ __forceinline__ void mlstm_unit(Frame& F, int b, int hd, int dir, int half, const bf16_t* QKVO, const float* GATES, bf16_t* HOUT) {
    LAS unsigned char* L = F.lds;
    const int tid = F.tid, lane = F.lane, w = F.wave, fr = lane & 15, g = lane >> 4;
    const int gi = (dir * 2) * 4 + hd, gf = (dir * 2 + 1) * 4 + hd;
    LAS float* pre = (LAS float*)(L + O_PRE);
    __syncthreads();
    {
        float lfv[9], igv[9];
#pragma unroll
        for (int q = 0; q < 9; ++q) { const int c = w + 8 * q; lfv[q] = 0.f; igv[q] = 0.f;
            if (c < NCH) { const int row = row_of(b, dir, c, lane); lfv[q] = GATES[(size_t)row * 16 + gf]; igv[q] = GATES[(size_t)row * 16 + gi]; } }
#pragma unroll
        for (int q = 0; q < 9; ++q) { const int c = w + 8 * q;
            if (c < NCH) { const float bs = wave_scan_add(lfv[q], lane); float am = igv[q] - bs;
                am = fmaxf(am, dpp_f<0xB1>(am, am)); am = fmaxf(am, dpp_f<0x4E>(am, am)); am = fmaxf(am, dpp_f<0x141>(am, am)); am = fmaxf(am, dpp_f<0x140>(am, am));
                am = fmaxf(fmaxf(rdlane(am, 0), rdlane(am, 16)), fmaxf(rdlane(am, 32), rdlane(am, 48)));
                if (lane == 0) { pre[c] = rdlane(bs, 63); pre[72 + c] = am; } } }
    }
    for (int i = tid; i < (O_OT - O_CT) / 4; i += NTHREADS) ((LAS unsigned*)(L + O_CT))[i] = 0u;
    for (int i = tid; i < 256; i += NTHREADS) ((LAS float*)(L + O_NV))[i] = 0.f;
    __syncthreads();
    if (tid == 0) { float m = 0.f; for (int c = 0; c < NCH; ++c) { pre[144 + c] = m; m = pre[c] + fmaxf(m, pre[72 + c]); } }
    __syncthreads();
    if (w == 0) { const int row = row_of(b, dir, 0, lane); gate_arrays(L, GATES[(size_t)row * 16 + gf], GATES[(size_t)row * 16 + gi], 0, lane); }
    __syncthreads();
    const int qcol = hd * 128, kcol = 512 + hd * 128, vcol = 1024 + hd * 256 + half * 128;
    u32x4 rq[2], rk[2], rv[2];
#define MLS_BAR() do { asm volatile("s_waitcnt lgkmcnt(0)" ::: "memory"); __builtin_amdgcn_s_barrier(); asm volatile("" ::: "memory"); } while (0)
    unsigned ldoff[2];
#pragma unroll
    for (int i_ = 0; i_ < 2; ++i_) { const int pi_ = tid + 512 * i_, p_ = pi_ >> 4, c16_ = pi_ & 15; ldoff[i_] = (unsigned)((dir ? 63 - p_ : p_) * 3072 + c16_ * 8) * 2u; }
#define MLS_LOAD(c) do { const char* cb_ = (const char*)(QKVO + (size_t)base_of(b, dir, (c)) * 3072); \
        _Pragma("unroll") for (int i_ = 0; i_ < 2; ++i_) { \
        rq[i_] = *(const u32x4*)(cb_ + qcol * 2 + ldoff[i_]); rk[i_] = *(const u32x4*)(cb_ + kcol * 2 + ldoff[i_]); rv[i_] = *(const u32x4*)(cb_ + vcol * 2 + ldoff[i_]); } } while (0)
#define MLS_STAGE(c) do { const LAS float* wk_ = (const LAS float*)(L + O_GB) + ((c) & 1) * 320 + 256; \
        _Pragma("unroll") for (int i_ = 0; i_ < 2; ++i_) { const int pi_ = tid + 512 * i_, p_ = pi_ >> 4, c16_ = pi_ & 15; const int o_ = p_ * XS + c16_ * 16; \
        *(LAS u32x4*)(L + O_XQ + o_) = rq[i_]; *(LAS u32x4*)(L + O_XK + o_) = rk[i_]; *(LAS u32x4*)(L + O_XV + o_) = rv[i_]; \
        const float s_ = wk_[p_]; u32x4 kk_; \
        kk_.x = pk2(bf_lo(rk[i_].x) * s_, bf_hi(rk[i_].x) * s_); kk_.y = pk2(bf_lo(rk[i_].y) * s_, bf_hi(rk[i_].y) * s_); \
        kk_.z = pk2(bf_lo(rk[i_].z) * s_, bf_hi(rk[i_].z) * s_); kk_.w = pk2(bf_lo(rk[i_].w) * s_, bf_hi(rk[i_].w) * s_); \
        *(LAS u32x4*)(L + O_XKP + o_) = kk_; } } while (0)
    MLS_LOAD(0); MLS_STAGE(0);
    __syncthreads();
    f32x4 C[8];
#pragma unroll
    for (int i = 0; i < 8; ++i) C[i] = (f32x4){0.f, 0.f, 0.f, 0.f};
    LAS unsigned char* CTw = L + O_CT + w * (16 * XS);
    float glf_n = 0.f, gig_n = 0.f;
    const unsigned goff = (unsigned)((dir ? 63 - lane : lane) * 16) * 4u;
    if (w == 7) { const char* gb_ = (const char*)(GATES + (size_t)base_of(b, dir, 1) * 16); glf_n = *(const float*)(gb_ + goff + gf * 4); gig_n = *(const float*)(gb_ + goff + gi * 4); }
    for (int c = 0; c < NCH; ++c) {
        const int par = c & 1; const bool more = (c + 1 < NCH);
        const LAS float* gb = (const LAS float*)(L + O_GB) + par * 320;
        const float glf = glf_n, gig = gig_n;
        if (w == 7 && c + 2 < NCH) { const char* gb_ = (const char*)(GATES + (size_t)base_of(b, dir, c + 2) * 16); glf_n = *(const float*)(gb_ + goff + gf * 4); gig_n = *(const float*)(gb_ + goff + gi * 4); }
        if (more) MLS_LOAD(c + 1);
#define LFENCE() do { asm volatile("s_waitcnt lgkmcnt(0)" ::: "memory"); __builtin_amdgcn_sched_barrier(0); } while (0)
#define QFRAG(mt_, ks_) (*(const LAS bf16x8*)(L + O_XQ + (16 * (mt_) + fr) * XS + (32 * (ks_) + 8 * g) * 2))
        f32x4 acc[4];
        {
            const int mt1 = w >> 1;
            bf16x8 ct[4], qa[2][4], qb[2][4];
#pragma unroll
            for (int ks = 0; ks < 4; ++ks) ct[ks] = *(const LAS bf16x8*)(CTw + fr * XS + (32 * ks + 8 * g) * 2);
#pragma unroll
            for (int m2 = 0; m2 < 2; ++m2)
#pragma unroll
                for (int ks = 0; ks < 4; ++ks) qa[m2][ks] = QFRAG(m2, ks);
            LFENCE();
#pragma unroll
            for (int m2 = 0; m2 < 2; ++m2)
#pragma unroll
                for (int ks = 0; ks < 4; ++ks) qb[m2][ks] = QFRAG(2 + m2, ks);
            __builtin_amdgcn_sched_barrier(0);
#pragma unroll
            for (int m2 = 0; m2 < 2; ++m2) { f32x4 a4 = (f32x4){0.f, 0.f, 0.f, 0.f};
#pragma unroll
                for (int ks = 0; ks < 4; ++ks) a4 = __builtin_amdgcn_mfma_f32_16x16x32_bf16(qa[m2][ks], ct[ks], a4, 0, 0, 0);
                acc[m2] = a4; }
            LFENCE();
            bf16x8 aq[4], bk[2][4];
#pragma unroll
            for (int ks = 0; ks < 4; ++ks) aq[ks] = QFRAG(mt1, ks);
#pragma unroll
            for (int n2 = 0; n2 < 2; ++n2)
#pragma unroll
                for (int ks = 0; ks < 4; ++ks) bk[n2][ks] = *(const LAS bf16x8*)(L + O_XK + (16 * (2 * (w & 1) + n2) + fr) * XS + (32 * ks + 8 * g) * 2);
            const f32x4 Mj = *(const LAS f32x4*)(gb + 64 + 16 * mt1 + 4 * g);
            float as[2]; as[0] = gb[16 * (2 * (w & 1)) + fr]; as[1] = gb[16 * (2 * (w & 1) + 1) + fr];
            f32x4 wi[4];
#pragma unroll
            for (int mt = 0; mt < 4; ++mt) wi[mt] = *(const LAS f32x4*)(gb + 128 + 16 * mt + 4 * g);
            __builtin_amdgcn_sched_barrier(0);
#pragma unroll
            for (int m2 = 0; m2 < 2; ++m2) { f32x4 a4 = (f32x4){0.f, 0.f, 0.f, 0.f};
#pragma unroll
                for (int ks = 0; ks < 4; ++ks) a4 = __builtin_amdgcn_mfma_f32_16x16x32_bf16(qb[m2][ks], ct[ks], a4, 0, 0, 0);
                acc[2 + m2] = a4; }
            LFENCE();
            f32x4 s4[2];
#pragma unroll
            for (int n2 = 0; n2 < 2; ++n2) { s4[n2] = (f32x4){0.f, 0.f, 0.f, 0.f};
#pragma unroll
                for (int ks = 0; ks < 4; ++ks) s4[n2] = __builtin_amdgcn_mfma_f32_16x16x32_bf16(aq[ks], bk[n2][ks], s4[n2], 0, 0, 0); }
#pragma unroll
            for (int mt = 0; mt < 4; ++mt) acc[mt] = acc[mt] * wi[mt];
#pragma unroll
            for (int n2 = 0; n2 < 2; ++n2) { const int sidx = 16 * (2 * (w & 1) + n2) + fr;
#pragma unroll
                for (int reg = 0; reg < 4; ++reg) { const int j = 16 * mt1 + 4 * g + reg;
                    const float pv = (sidx <= j) ? s4[n2][reg] * __expf(as[n2] - Mj[reg]) : 0.f;
                    *(LAS bf16_t*)(L + O_P + j * PS + sidx * 2) = (bf16_t)f2bf(pv); } }
        }
        MLS_BAR();
        bf16x8 vf[2];
        float rdv; float nsum;
        const float decay = ((const LAS float*)(L + O_DEC))[par];
        {
            const LAS unsigned char* vb = L + O_XV + (8 * g + (fr >> 2)) * XS + (16 * w + (lane & 3) * 4) * 2;
            const LAS unsigned char* kb = L + O_XKP + (8 * g + (fr >> 2)) * XS + ((lane & 3) * 4) * 2;
            bf16x8 ap[4][2];
#pragma unroll
            for (int k2 = 0; k2 < 2; ++k2) vf[k2] = tr8(vb + 32 * k2 * XS, vb + (32 * k2 + 4) * XS);
#pragma unroll
            for (int mt = 0; mt < 4; ++mt)
#pragma unroll
                for (int k2 = 0; k2 < 2; ++k2) ap[mt][k2] = *(const LAS bf16x8*)(L + O_P + (16 * mt + fr) * PS + (32 * k2 + 8 * g) * 2);
            LFENCE();
            const int j = tid >> 3, part = tid & 7;
            const u32x4 pu = *(const LAS u32x4*)(L + O_P + j * PS + part * 16);
            const u32x4 q0 = *(const LAS u32x4*)(L + O_XQ + j * XS + part * 32), q1 = *(const LAS u32x4*)(L + O_XQ + j * XS + part * 32 + 16);
            const LAS f32x4* np = (const LAS f32x4*)(L + O_NV + par * 512 + part * 64);
            const f32x4 n0 = np[0], n1 = np[1], n2 = np[2], n3 = np[3];
            const float wint_j = gb[128 + j], emq_j = gb[192 + j];
            bf16x8 ak[4][2];
#pragma unroll
            for (int mt = 0; mt < 4; ++mt)
#pragma unroll
                for (int k2 = 0; k2 < 2; ++k2) ak[mt][k2] = tr8(kb + 32 * k2 * XS + 32 * mt, kb + (32 * k2 + 4) * XS + 32 * mt);
            __builtin_amdgcn_sched_barrier(0);
#pragma unroll
            for (int mt = 0; mt < 4; ++mt)
#pragma unroll
                for (int k2 = 0; k2 < 2; ++k2) acc[mt] = __builtin_amdgcn_mfma_f32_16x16x32_bf16(ap[mt][k2], vf[k2], acc[mt], 0, 0, 0);
            LFENCE();
            const int dk = tid >> 2, part4 = tid & 3; bf16_t kc[16];
#pragma unroll
            for (int t = 0; t < 16; ++t) kc[t] = *(const LAS bf16_t*)(L + O_XKP + (16 * part4 + t) * XS + dk * 2);
            const float nold = ((const LAS float*)(L + O_NV))[par * 128 + dk];
            __builtin_amdgcn_sched_barrier(0);
#pragma unroll
            for (int mt = 0; mt < 4; ++mt) { f32x4 c4 = C[mt] * decay;
#pragma unroll
                for (int k2 = 0; k2 < 2; ++k2) c4 = __builtin_amdgcn_mfma_f32_16x16x32_bf16(ak[mt][k2], vf[k2], c4, 0, 0, 0);
                C[mt] = c4; }
            float rs = (bf_lo(pu.x) + bf_hi(pu.x)) + (bf_lo(pu.y) + bf_hi(pu.y)) + (bf_lo(pu.z) + bf_hi(pu.z)) + (bf_lo(pu.w) + bf_hi(pu.w));
            float qn = bf_lo(q0.x) * n0.x + bf_hi(q0.x) * n0.y + bf_lo(q0.y) * n0.z + bf_hi(q0.y) * n0.w
                     + bf_lo(q0.z) * n1.x + bf_hi(q0.z) * n1.y + bf_lo(q0.w) * n1.z + bf_hi(q0.w) * n1.w
                     + bf_lo(q1.x) * n2.x + bf_hi(q1.x) * n2.y + bf_lo(q1.y) * n2.z + bf_hi(q1.y) * n2.w
                     + bf_lo(q1.z) * n3.x + bf_hi(q1.z) * n3.y + bf_lo(q1.w) * n3.z + bf_hi(q1.w) * n3.w;
            rs = oct_sum(rs); qn = oct_sum(qn);
            rdv = 1.f / fmaxf(fabsf(rs + wint_j * qn), emq_j);
            float sm0 = 0.f;
#pragma unroll
            for (int t = 0; t < 16; ++t) sm0 += bf2f(kc[t]);
            __builtin_amdgcn_sched_barrier(0);
#pragma unroll
            for (int mt = 0; mt < 4; ++mt)
#pragma unroll
                for (int k2 = 0; k2 < 2; ++k2) ak[mt][k2] = tr8(kb + 32 * k2 * XS + 32 * (4 + mt), kb + (32 * k2 + 4) * XS + 32 * (4 + mt));
            LFENCE();
#pragma unroll
            for (int mt = 0; mt < 4; ++mt) { f32x4 c4 = C[4 + mt] * decay;
#pragma unroll
                for (int k2 = 0; k2 < 2; ++k2) c4 = __builtin_amdgcn_mfma_f32_16x16x32_bf16(ak[mt][k2], vf[k2], c4, 0, 0, 0);
                C[4 + mt] = c4; }
            float sm = quad_sum(sm0);
            nsum = decay * nold + sm;
        }
#undef LFENCE
#undef QFRAG
        asm volatile("" ::: "memory");
        if ((tid & 7) == 0) ((LAS float*)(L + O_RD))[tid >> 3] = rdv;
        if ((tid & 3) == 0) ((LAS float*)(L + O_NV))[(par ^ 1) * 128 + (tid >> 2)] = nsum;
#pragma unroll
        for (int mt = 0; mt < 8; ++mt) { u32x2 o; o.x = pk2(C[mt][0], C[mt][1]); o.y = pk2(C[mt][2], C[mt][3]);
            *(LAS u32x2*)(CTw + fr * XS + (16 * mt + 4 * g) * 2) = o; }
        if (more && w == 7) gate_arrays(L, glf, gig, c + 1, lane);
        MLS_BAR();
        {
#pragma unroll
            for (int mt = 0; mt < 4; ++mt) { const f32x4 rd = *(const LAS f32x4*)(L + O_RD + (16 * mt + 4 * g) * 4);
#pragma unroll
                for (int reg = 0; reg < 4; ++reg) *(LAS bf16_t*)(L + O_OT + (16 * mt + 4 * g + reg) * XS + (16 * w + fr) * 2) = (bf16_t)f2bf(acc[mt][reg] * rd[reg]); }
            if (more) MLS_STAGE(c + 1);
        }
        MLS_BAR();
        {
            const int j = tid >> 3, ch = tid & 7;
            const u32x4 o0 = *(const LAS u32x4*)(L + O_OT + j * XS + ch * 32), o1 = *(const LAS u32x4*)(L + O_OT + j * XS + ch * 32 + 16);
            bf16_t* op = HOUT + (size_t)base_of(b, dir, c) * D + (dir ? 63 - j : j) * D + hd * 256 + half * 128 + ch * 16;
            *(u32x4*)op = o0; *(u32x4*)(op + 8) = o1;
        }
    }
#undef MLS_BAR
#undef MLS_LOAD
#undef MLS_STAGE
}
}
constexpr int MISC_OFF = 135936, LDS_TOTAL = 136192;
static_assert(mls::LDS_BYTES <= MISC_OFF && pg8::STAGE_BYTES <= MISC_OFF && attn_body::LDS_BYTES <= MISC_OFF, "lds");
#ifndef EN_MASK
#define EN_MASK 0xFFFFFFFFu
#endif
#define PH_ON(k) (((EN_MASK) >> (k)) & 1u)
#ifndef REP_MASK
#define REP_MASK 0u
#endif
#define REP_ON(k) (((REP_MASK) >> (k)) & 1u)
#ifndef PH_LIMIT
#define PH_LIMIT 1000
#endif
#ifndef N_LAUNCH_SPLIT
#define N_LAUNCH_SPLIT 0
#endif
constexpr int N_PHASES = 1 + 10 + 9 + 9 + 9;

struct Args { const float* in[21]; float* out; unsigned char* ws; int ph_lo, ph_hi; };
static_assert(sizeof(Args) == 23 * 8 + 8, "no padding");

__device__ __forceinline__ Frame make_frame(unsigned char* lds_gen, unsigned char* ws_, const int wave_s) {
    Frame F; int ln; asm volatile("v_mbcnt_lo_u32_b32 %0, -1, 0\n\tv_mbcnt_hi_u32_b32 %0, -1, %0" : "=v"(ln));
    int wv = wave_s; asm volatile("" : "+s"(wv));
    int bx = blockIdx.x; asm volatile("" : "+s"(bx));
    F.lds = (LAS unsigned char*)lds_gen; F.tid = wv * 64 + ln; F.lane = ln; F.wave = wv;
    F.G = gridDim.x; F.bid = bx; F.vcu = (F.G % 8 == 0) ? (bx % 8) * (F.G / 8) + bx / 8 : bx;
    F.gw = F.vcu * NWAVES + F.wave; F.NGW = F.G * NWAVES;
    unsigned long long wi = (unsigned long long)ws_; asm volatile("" : "+s"(wi)); GAS unsigned char* wg = (GAS unsigned char*)wi;
    F.ws = (unsigned char*)wg; F.inq = (const unsigned long long*)(GAS const unsigned long long*)(wg + WS_PTRS); return F;
}
__global__ void __launch_bounds__(NTHREADS, 2) fwd(Args a) {
    extern __shared__ __attribute__((aligned(16))) unsigned char lds_raw[];
    unsigned char* const lds_gen = lds_raw;
    const int wave_s = __builtin_amdgcn_readfirstlane((int)threadIdx.x >> 6);
    unsigned char* ws = a.ws;
    if (threadIdx.x < 4) ((LAS unsigned*)((LAS unsigned char*)lds_raw + MISC_OFF))[threadIdx.x] = 0u;
    __syncthreads();
    XcdBarrier bar = xcd_barrier_post((unsigned*)(ws + WS_CTL), (volatile LAS unsigned*)((LAS unsigned char*)lds_raw + MISC_OFF));
    int cur = 0; const int lo = a.ph_lo, hi = a.ph_hi & 0xffff; bool ran = false;
#define PHASE_BEGIN if (cur >= lo && cur < hi) { if (ran) xcd_barrier(bar, wave_s); ran = true;
#define PHASE_END   } ++cur;

    if (blockIdx.x == 0 && threadIdx.x < 22) ((const float**)(ws + WS_PTRS))[threadIdx.x] = (threadIdx.x < 21) ? a.in[threadIdx.x] : (const float*)a.out;
#define XL ((float*)(GAS float*)(F.inq[21]))
#define X16 ((bf16_t*)(F.ws + WS_X16))
#define H ((bf16_t*)(F.ws + WS_H))
#define MIX ((bf16_t*)(F.ws + WS_MIX))
#define BIG0 ((bf16_t*)(F.ws + WS_BIG0))
#define BIG1 ((bf16_t*)(F.ws + WS_BIG1))
#define GATES ((float*)(F.ws + WS_GATES))
#define AFF ((float*)(F.ws + WS_AFF))
#define INV ((int*)(F.ws + WS_INV))
#define SLROW ((int*)(F.ws + WS_SLROW))
#define SLG ((float*)(F.ws + WS_SLG))
#define IN(k) ((const float*)(GAS const float*)(F.inq[k]))

    PHASE_BEGIN if (PH_ON(0)) for (int rep_ = 0; rep_ < (REP_ON(0) ? 2 : 1); ++rep_) { if (rep_) xcd_barrier(bar, wave_s); Frame F = make_frame(lds_gen, a.ws, wave_s); p0_prologue(F, a.in, F.ws); } PHASE_END

    for (int layer = 0; layer < DEPTH; ++layer) {
        const bool last = (layer == DEPTH - 1); const int j = layer >> 1;
#define modv ((const float*)(F.ws + WS_MODV) + (size_t)layer * NMI * 6 * D)
#define xLs ((layer == 0) ? IN(0) : (const float*)XL)
#define xCs ((layer == 0) ? IN(2) : (const float*)XC)
        if ((layer & 1) == 0) {
            if (layer == 0) { PHASE_BEGIN if (PH_ON(1)) for (int rep_ = 0; rep_ < (REP_ON(1) ? 2 : 1); ++rep_) { if (rep_) xcd_barrier(bar, wave_s); Frame F = make_frame(lds_gen, a.ws, wave_s); norm16_pass<1, false, false>(F, IN(0), IN(2), RT, IN(6) + layer * D, modv + 0 * D, modv + 1 * D, H, IN(8) + (size_t)j * D * MW_IN + 3072, MW_IN, IN(9) + j * 16, GATES); } PHASE_END }
            PHASE_BEGIN if (PH_ON(2)) for (int rep_ = 0; rep_ < (REP_ON(2) ? 2 : 1); ++rep_) { if (rep_) xcd_barrier(bar, wave_s); Frame F = make_frame(lds_gen, a.ws, wave_s); { pg8::PlainSched S{(const char*)H, (const char*)((bf16_t*)(F.ws + WS_WMI) + (size_t)j * 3072 * D), RT / 256, 12, D, F.G, F.bid};
                pg8::EpiBf16 E{BIG0, 3072, 2, 0.08838834764831845f}; pg8::gemm_phase(F.lds, F.tid, D, S, E); if (layer > 0) gates16_pass(F, H, RT, IN(8) + (size_t)j * D * MW_IN + 3072, MW_IN, IN(9) + j * 16, GATES);     moe_weights(F, IN(17) + (size_t)layer * NE * D * D, IN(18) + (size_t)layer * NE * D * D, IN(19) + (size_t)layer * NE * D * D, F.ws, (unsigned*)(F.ws + WS_CNT) + 16 * layer); } } PHASE_END
            PHASE_BEGIN if (PH_ON(3)) for (int rep_ = 0; rep_ < (REP_ON(3) ? 2 : 1); ++rep_) { if (rep_) xcd_barrier(bar, wave_s); Frame F = make_frame(lds_gen, a.ws, wave_s); for (int u = F.vcu; u < 256; u += F.G) { const int half = u & 1, dir = (u >> 1) & 1, hd = (u >> 2) & 3, b = u >> 4;
                mls::mlstm_unit(F, b, hd, dir, half, BIG0, GATES, dir ? MIX : H); } } PHASE_END
            PHASE_BEGIN if (PH_ON(4)) for (int rep_ = 0; rep_ < (REP_ON(4) ? 2 : 1); ++rep_) { if (rep_) xcd_barrier(bar, wave_s); Frame F = make_frame(lds_gen, a.ws, wave_s); mlstm_readout(F, H, MIX, BIG0, IN(10) + j * D, MIX); } PHASE_END
            PHASE_BEGIN if (PH_ON(5)) for (int rep_ = 0; rep_ < (REP_ON(5) ? 2 : 1); ++rep_) { if (rep_) xcd_barrier(bar, wave_s); Frame F = make_frame(lds_gen, a.ws, wave_s); { pg8::PlainSched S{(const char*)MIX, (const char*)((bf16_t*)(F.ws + WS_WMO) + (size_t)j * D * D), RT / 256, 4, D, F.G, F.bid};
                pg8::EpiResid E{IN(0), IN(2), X16, modv + 2 * D, layer == 0}; pg8::gemm_phase(F.lds, F.tid, D, S, E); moe_weights(F, IN(17) + (size_t)layer * NE * D * D, IN(18) + (size_t)layer * NE * D * D, IN(19) + (size_t)layer * NE * D * D, F.ws, (unsigned*)(F.ws + WS_CNT) + 16 * layer); } } PHASE_END
        } else {
#define KALL BIG1
#define VALL (BIG1 + (size_t)NB * KVLEN * 256)
            PHASE_BEGIN if (PH_ON(7)) for (int rep_ = 0; rep_ < (REP_ON(7) ? 2 : 1); ++rep_) { if (rep_) xcd_barrier(bar, wave_s); Frame F = make_frame(lds_gen, a.ws, wave_s); { pg8::PlainSched S{(const char*)H, (const char*)((bf16_t*)(F.ws + WS_WAI) + (size_t)j * 1536 * D), RT / 256, 6, D, F.G, F.bid};
                pg8::EpiBf16 E{BIG0, 1536, 0, 1.f}; pg8::gemm_phase(F.lds, F.tid, D, S, E); moe_weights(F, IN(17) + (size_t)layer * NE * D * D, IN(18) + (size_t)layer * NE * D * D, IN(19) + (size_t)layer * NE * D * D, F.ws, (unsigned*)(F.ws + WS_CNT) + 16 * layer); } } PHASE_END
            PHASE_BEGIN if (PH_ON(8)) for (int rep_ = 0; rep_ < (REP_ON(8) ? 2 : 1); ++rep_) { if (rep_) xcd_barrier(bar, wave_s); Frame F = make_frame(lds_gen, a.ws, wave_s); k_pass(F, BIG0, IN(14) + j * 64, (const float*)(F.ws + WS_ROPE), (const float*)(F.ws + WS_ROPE) + SEQ * 32); } PHASE_END
            PHASE_BEGIN if (PH_ON(9)) for (int rep_ = 0; rep_ < (REP_ON(9) ? 2 : 1); ++rep_) { if (rep_) xcd_barrier(bar, wave_s); Frame F = make_frame(lds_gen, a.ws, wave_s); { const int nun = last ? 4096 : 4096 + 256;
                float mfix; { float gq = fabsf(IN(13)[j * 64 + F.lane]), gk = fabsf(IN(14)[j * 64 + F.lane]);
#pragma unroll
                    for (int o = 1; o < 64; o <<= 1) { gq = fmaxf(gq, __shfl_xor(gq, o)); gk = fmaxf(gk, __shfl_xor(gk, o)); }
                    mfix = attn_body::C2 * 64.f * gq * gk; }
                for (int L = F.vcu; L < nun; L += F.G) {
                    const bool isc = L >= 4096; const int Lc = L - 4096;
                    const int grp = L >> 6, wi = L & 63;
                    const int b = isc ? (Lc >> 4) : (grp >> 2), hq = isc ? (Lc & 15) : ((grp & 3) * 4 + (wi >> 4));
                    const size_t row0 = isc ? ((size_t)RL + b * CTXL) : ((size_t)b * SEQ + (wi & 15) * 256);
                    const bf16_t* qp = BIG0 + row0 * 1536 + hq * 64; bf16_t* op = MIX + row0 * D + hq * 64;
                    const bf16_t* kc = BIG0 + ((size_t)RL + b * CTXL) * 1536 + 1024 + (hq >> 2) * 64; const bf16_t* kl = BIG0 + ((size_t)b * SEQ) * 1536 + 1024 + (hq >> 2) * 64;
                    const float* rc = (const float*)(F.ws + WS_ROPE); const float* rs = rc + SEQ * 32;
                    if (isc) attn_body::attn_unit<8>(qp, 1536, kc, kc + 256, kl, kl + 256, 4, 1536, CTXL / 64, op, D, (char*)lds_gen, F.tid, mfix, IN(13) + j * 64, rc, rs, 0, 0);
                    else     attn_body::attn_unit<8>(qp, 1536, kc, kc + 256, kl, kl + 256, 4, 1536, KVLEN / 64, op, D, (char*)lds_gen, F.tid, mfix, IN(13) + j * 64, rc, rs, 1, (wi & 15) * 256); } } } PHASE_END
            PHASE_BEGIN if (PH_ON(10)) for (int rep_ = 0; rep_ < (REP_ON(10) ? 2 : 1); ++rep_) { if (rep_) xcd_barrier(bar, wave_s); Frame F = make_frame(lds_gen, a.ws, wave_s); { pg8::PlainSched S{(const char*)MIX, (const char*)((bf16_t*)(F.ws + WS_WAO) + (size_t)j * D * D), (last ? RL : RT) / 256, 4, D, F.G, F.bid};
                pg8::EpiResid E{IN(0), IN(2), X16, modv + 2 * D, layer == 0}; pg8::gemm_phase(F.lds, F.tid, D, S, E); moe_weights(F, IN(17) + (size_t)layer * NE * D * D, IN(18) + (size_t)layer * NE * D * D, IN(19) + (size_t)layer * NE * D * D, F.ws, (unsigned*)(F.ws + WS_CNT) + 16 * layer); } } PHASE_END
        }
        const int nrows = last ? RL : RT;
        PHASE_BEGIN if (PH_ON(11)) for (int rep_ = 0; rep_ < (REP_ON(11) ? 2 : 1); ++rep_) { if (rep_) xcd_barrier(bar, wave_s); Frame F = make_frame(lds_gen, a.ws, wave_s); moe_weights(F, IN(17) + (size_t)layer * NE * D * D, IN(18) + (size_t)layer * NE * D * D, IN(19) + (size_t)layer * NE * D * D, F.ws, (unsigned*)(F.ws + WS_CNT) + 16 * layer);
            norm16_pass<2, MOE_FP8_1 != 0, true>(F, (const float*)X16, nullptr, nrows, IN(7) + layer * D, modv + 3 * D, modv + 4 * D, H, IN(16) + (size_t)layer * D * 16, 16, nullptr, AFF); } PHASE_END
        PHASE_BEGIN if (PH_ON(12)) for (int rep_ = 0; rep_ < (REP_ON(12) ? 2 : 1); ++rep_) { if (rep_) xcd_barrier(bar, wave_s); Frame F = make_frame(lds_gen, a.ws, wave_s); moe_select(F, AFF, INV, SLROW, SLG, last ? NB * NE : 2 * NB * NE); } PHASE_END
        PHASE_BEGIN if (PH_ON(14)) for (int rep_ = 0; rep_ < (REP_ON(14) ? 2 : 1); ++rep_) { if (rep_) xcd_barrier(bar, wave_s); Frame F = make_frame(lds_gen, a.ws, wave_s); { constexpr int K1 = MOE_FP8_1 ? D / 2 : D;
            pg8::MoeSched S{(const char*)H, (const char*)(F.ws + WS_W1), last ? 32 : 34, 8, K1, 2048, F.G, F.bid};
            pg8::EpiSwiglu E{(void*)BIG1, MOE_FP8_1 ? 1.f / (FP8_SH * FP8_SW) : 1.f, MOE_FP8_2 != 0}; pg8::gemm_phase<pg8::EpiSwiglu, pg8::MoeSched, true, MOE_FP8_1 != 0>(F.lds, F.tid, K1, S, E, SLROW); } } PHASE_END
        PHASE_BEGIN if (PH_ON(15)) for (int rep_ = 0; rep_ < (REP_ON(15) ? 2 : 1); ++rep_) { if (rep_) xcd_barrier(bar, wave_s); Frame F = make_frame(lds_gen, a.ws, wave_s); { constexpr int K2 = MOE_FP8_2 ? D / 2 : D;
            pg8::MoeSched S{(const char*)BIG1, (const char*)(F.ws + WS_W2), last ? 32 : 34, 4, K2, 1024, F.G, F.bid};
            pg8::EpiRowScale E{(void*)BIG0, SLG, MOE_FP8_2 ? 1.f / (FP8_SA * FP8_SW) : 1.f}; pg8::gemm_phase<pg8::EpiRowScale, pg8::MoeSched, false, MOE_FP8_2 != 0>(F.lds, F.tid, K2, S, E); } } PHASE_END
        PHASE_BEGIN if (PH_ON(16)) for (int rep_ = 0; rep_ < (REP_ON(16) ? 2 : 1); ++rep_) { if (rep_) xcd_barrier(bar, wave_s); Frame F = make_frame(lds_gen, a.ws, wave_s);
            const int nl = layer + 1; const float* modn = (const float*)(F.ws + WS_MODV) + (size_t)nl * NMI * 6 * D;
            if (last) combine_norm<3>(F, BIG0, INV, X16, XL, modv + 5 * D, RL, IN(20), nullptr, nullptr, nullptr, nullptr, 0, nullptr, nullptr);
            else if (nl & 1) combine_norm<0>(F, BIG0, INV, X16, nullptr, modv + 5 * D, RT, IN(6) + nl * D, modn + 0 * D, modn + 1 * D, H, nullptr, 0, nullptr, nullptr);
            else combine_norm<0>(F, BIG0, INV, X16, nullptr, modv + 5 * D, RT, IN(6) + nl * D, modn + 0 * D, modn + 1 * D, H, nullptr, 0, nullptr, nullptr); } PHASE_END
    }
#undef XL
#undef X16
#undef H
#undef MIX
#undef BIG0
#undef BIG1
#undef GATES
#undef AFF
#undef INV
#undef SLROW
#undef SLG
#undef IN
#undef modv
#undef xLs
#undef xCs
#undef KALL
#undef VALL
#undef PHASE_BEGIN
#undef PHASE_END
}

extern "C" void kernel_launch(void* const* d_in, const int* in_sizes, int n_in, void* d_out, int out_size, void* d_ws, size_t ws_size, hipStream_t stream) {
    static int grid = 0;
    if (grid == 0) {
        if (n_in != 21 || out_size != RL * D || ws_size < WS_END) { fprintf(stderr, "kernel_launch: unexpected shapes: n_in %d out %d ws %zu (need %zu)\n", n_in, out_size, ws_size, (size_t)WS_END); grid = -1; return; }
        int dev = 0, cus = 0, per_cu = 0;
        if (hipGetDevice(&dev) != hipSuccess || hipDeviceGetAttribute(&cus, hipDeviceAttributeMultiprocessorCount, dev) != hipSuccess) { grid = -1; return; }
        if (hipFuncSetAttribute((const void*)fwd, hipFuncAttributeMaxDynamicSharedMemorySize, LDS_TOTAL) != hipSuccess) { fprintf(stderr, "kernel_launch: hipFuncSetAttribute failed\n"); grid = -1; return; }
        if (hipOccupancyMaxActiveBlocksPerMultiprocessor(&per_cu, (const void*)fwd, NTHREADS, LDS_TOTAL) != hipSuccess || per_cu < 1) fprintf(stderr, "kernel_launch: occupancy query says %d\n", per_cu);
        (void)hipGetLastError();
        grid = cus;
    }
    if (grid < 0) return;
    (void)in_sizes;
    if (hipMemsetAsync((char*)d_ws + WS_CTL, 0, CTL_BYTES, stream) != hipSuccess) return;
    Args a{};
    for (int i = 0; i < 21; ++i) a.in[i] = (const float*)d_in[i];
    a.out = (float*)d_out; a.ws = (unsigned char*)d_ws;
    const int nph = N_PHASES < PH_LIMIT ? N_PHASES : PH_LIMIT;
#if N_LAUNCH_SPLIT
    for (int p = 0; p < nph; ++p) { a.ph_lo = p; a.ph_hi = p + 1; hipLaunchKernelGGL(fwd, dim3(grid), dim3(NTHREADS), LDS_TOTAL, stream, a); }
#else
    a.ph_lo = 0; a.ph_hi = nph;
    hipLaunchKernelGGL(fwd, dim3(grid), dim3(NTHREADS), LDS_TOTAL, stream, a);
#endif
    const hipError_t le = hipPeekAtLastError();
    if (le != hipSuccess) fprintf(stderr, "kernel_launch: launch failed: %s\n", hipGetErrorName(le));
}
```

```cpp
#include <hip/hip_runtime.h>
#include <cstdio>
#include <cstdint>
#include <type_traits>

#define GAS __attribute__((address_space(1)))
#define LAS __attribute__((address_space(3)))
typedef unsigned short bf16_t;
typedef short bf16x8 __attribute__((ext_vector_type(8)));
typedef short s16x4 __attribute__((ext_vector_type(4)));
typedef float f32x4 __attribute__((ext_vector_type(4)));
typedef float f32x2 __attribute__((ext_vector_type(2)));
typedef float f32x16 __attribute__((ext_vector_type(16)));
typedef unsigned u32x4 __attribute__((ext_vector_type(4)));
typedef unsigned u32x2 __attribute__((ext_vector_type(2)));

constexpr int D = 1024, NB = 16, SEQ = 4096, CTXL = 256, DEPTH = 4;
constexpr int RL = NB * SEQ, RC = NB * CTXL, RT = RL + RC;
constexpr int NE = 16, CAP_L = 512, CAP_C = 32, SLOTS_E = NB * CAP_L + NB * CAP_C;
constexpr int NMI = NB + 1;
constexpr int MW_IN = 3088;
constexpr int KVLEN = CTXL + SEQ;
constexpr int NWAVES = 8, NTHREADS = 512;
constexpr float NORM_EPS = 1e-6f;

#ifndef MOE_FP8_1
#define MOE_FP8_1 1
#endif
#ifndef MOE_FP8_2
#define MOE_FP8_2 1
#endif
constexpr size_t al256(size_t x) { return (x + 255) & ~(size_t)255; }
constexpr size_t WS_CTL   = 0;
constexpr size_t CTL_BYTES = 16384;
constexpr size_t WS_CNT   = WS_CTL + 14336;
constexpr size_t WS_PTRS  = WS_CTL + CTL_BYTES;
constexpr size_t WS_MODV  = WS_PTRS + 256;
constexpr size_t WS_ROPE  = al256(WS_MODV + (size_t)DEPTH * NMI * 6 * D * 4);
constexpr size_t WS_X16   = al256(WS_ROPE + (size_t)2 * SEQ * 32 * 4);
constexpr size_t WS_GATES = al256(WS_X16 + (size_t)RT * D * 2);
constexpr size_t WS_AFF   = al256(WS_GATES + (size_t)RT * 16 * 4);
constexpr size_t WS_INV   = al256(WS_AFF + (size_t)RT * 16 * 4);
constexpr size_t WS_SLROW = al256(WS_INV + (size_t)RT * 16 * 4);
constexpr size_t WS_SLG   = al256(WS_SLROW + (size_t)NE * SLOTS_E * 4);
constexpr size_t WS_WMI   = al256(WS_SLG + (size_t)NE * SLOTS_E * 4);
constexpr size_t WS_WMO   = al256(WS_WMI + (size_t)2 * 3072 * D * 2);
constexpr size_t WS_WAI   = al256(WS_WMO + (size_t)2 * D * D * 2);
constexpr size_t WS_WAO   = al256(WS_WAI + (size_t)2 * 1536 * D * 2);
constexpr size_t WS_W1    = al256(WS_WAO + (size_t)2 * D * D * 2);
constexpr size_t WS_W2    = al256(WS_W1 + (size_t)NE * 2048 * D * 2);
constexpr size_t WS_H     = al256(WS_W2 + (size_t)NE * D * D * 2);
constexpr size_t WS_MIX   = al256(WS_H + (size_t)RT * D * 2);
constexpr size_t WS_BIG0  = al256(WS_MIX + (size_t)RT * D * 2);
constexpr size_t BIG_HALF = (size_t)NE * SLOTS_E * D * 2;
constexpr size_t WS_BIG1  = al256(WS_BIG0 + BIG_HALF);
constexpr size_t BIG1_BYTES = MOE_FP8_2 ? BIG_HALF / 2 : BIG_HALF;
constexpr size_t WS_MIX8  = al256(WS_BIG1 + BIG1_BYTES);
constexpr size_t WS_END   = al256(WS_MIX8 + (size_t)RT * D);
constexpr size_t WS_KV8   = WS_MIX8;
static_assert((size_t)NB * 4 * (KVLEN / 64) * 8192 <= (size_t)RT * D, "kv8 fits the readout buffer");
static_assert((size_t)RT * 3072 * 2 <= BIG_HALF + BIG1_BYTES && (size_t)2 * NB * KVLEN * 256 * 2 <= BIG1_BYTES, "qkvo / kv fit");

#define LDS_WAIT() asm volatile("s_waitcnt lgkmcnt(0)" ::: "memory")
#define VM_WAIT() asm volatile("s_waitcnt vmcnt(0)" ::: "memory")
typedef __bf16 bf16x2_t __attribute__((ext_vector_type(2)));
__device__ __forceinline__ unsigned pk2(float lo, float hi) { f32x2 v = {lo, hi}; bf16x2_t b = __builtin_convertvector(v, bf16x2_t); return __builtin_bit_cast(unsigned, b); }
__device__ __forceinline__ unsigned f2bf(float f) { return pk2(f, f) & 0xffffu; }
__device__ __forceinline__ float bf_lo(unsigned u) { return __builtin_bit_cast(float, u << 16); }
__device__ __forceinline__ float bf_hi(unsigned u) { return __builtin_bit_cast(float, u & 0xffff0000u); }
__device__ __forceinline__ float bf2f(bf16_t b) { return __builtin_bit_cast(float, ((unsigned)b) << 16); }
__device__ __forceinline__ unsigned pk_fp8x4(float a, float b, float c, float d) {
    a = __builtin_amdgcn_fmed3f(a, -448.f, 448.f); b = __builtin_amdgcn_fmed3f(b, -448.f, 448.f); c = __builtin_amdgcn_fmed3f(c, -448.f, 448.f); d = __builtin_amdgcn_fmed3f(d, -448.f, 448.f);
    int p = __builtin_amdgcn_cvt_pk_fp8_f32(a, b, 0, false); p = __builtin_amdgcn_cvt_pk_fp8_f32(c, d, p, true); return (unsigned)p; }
#ifndef MLS_FP8_IN
#define MLS_FP8_IN 0
#endif
#ifndef MLS_FP8_OUT
#define MLS_FP8_OUT 1
#endif
#ifndef ATT_FP8
#define ATT_FP8 1
#endif
#ifndef MOE_Y_FP8
#define MOE_Y_FP8 1
#endif
constexpr float FP8_SH = 16.f, FP8_SW = 512.f, FP8_SA = 8.f, FP8_SY = 256.f, FP8_SO = 64.f, FP8_SM = 16.f, FP8_SK = 32.f, FP8_SQ = 32.f, FP8_SV = 32.f;
__device__ __forceinline__ float shfl_xor_l(float v, int o, int lane) { return __int_as_float(__builtin_amdgcn_ds_bpermute((lane ^ o) << 2, __float_as_int(v))); }
__device__ __forceinline__ unsigned shfl_up_l(unsigned v, int o, int lane) { const int src = lane - o; return (unsigned)__builtin_amdgcn_ds_bpermute((src < 0 ? lane : src) << 2, (int)v); }
template <int CTRL> __device__ __forceinline__ float dpp_f(float old, float v) { return __builtin_bit_cast(float, __builtin_amdgcn_update_dpp(__builtin_bit_cast(int, old), __builtin_bit_cast(int, v), CTRL, 0xf, 0xf, false)); }
__device__ __forceinline__ float rdlane(float v, int l) { return __builtin_bit_cast(float, __builtin_amdgcn_readlane(__builtin_bit_cast(int, v), l)); }
__device__ __forceinline__ float row16_sum(float v) {
    v += dpp_f<0xB1>(0.f, v); v += dpp_f<0x4E>(0.f, v); v += dpp_f<0x141>(0.f, v); v += dpp_f<0x140>(0.f, v); return v; }
__device__ __forceinline__ float oct_sum(float v) {
    v += dpp_f<0xB1>(0.f, v); v += dpp_f<0x4E>(0.f, v); v += dpp_f<0x141>(0.f, v); return v; }
__device__ __forceinline__ float quad_sum(float v) { v += dpp_f<0xB1>(0.f, v); v += dpp_f<0x4E>(0.f, v); return v; }
__device__ __forceinline__ float wave_sum(float v) {
    v = row16_sum(v); return (rdlane(v, 0) + rdlane(v, 16)) + (rdlane(v, 32) + rdlane(v, 48)); }
__device__ __forceinline__ float wave_scan_add(float v, int lane) {
    v += dpp_f<0x111>(0.f, v); v += dpp_f<0x112>(0.f, v); v += dpp_f<0x114>(0.f, v); v += dpp_f<0x118>(0.f, v);
    const float t0 = rdlane(v, 15), t1 = rdlane(v, 31), t2 = rdlane(v, 47);
    const int row = lane >> 4; return v + (row == 0 ? 0.f : row == 1 ? t0 : row == 2 ? t0 + t1 : (t0 + t1) + t2); }
__device__ __forceinline__ float wave_scan_max(float v, int lane) {
    const float NI = -INFINITY;
    v = fmaxf(v, dpp_f<0x111>(NI, v)); v = fmaxf(v, dpp_f<0x112>(NI, v)); v = fmaxf(v, dpp_f<0x114>(NI, v)); v = fmaxf(v, dpp_f<0x118>(NI, v));
    const float t0 = rdlane(v, 15), t1 = rdlane(v, 31), t2 = rdlane(v, 47);
    const int row = lane >> 4; return fmaxf(v, row == 0 ? NI : row == 1 ? t0 : row == 2 ? fmaxf(t0, t1) : fmaxf(fmaxf(t0, t1), t2)); }
__device__ __forceinline__ float fast_exp(float x) { return __builtin_amdgcn_exp2f(x * 1.4426950408889634f); }
__device__ __forceinline__ float fast_rcp(float x) { return __builtin_amdgcn_rcpf(x); }
__device__ __forceinline__ float silu_f(float x) { return x / (1.f + __expf(-x)); }

#define XB_TMO      128
#define XB_XCNT(j)  (256  + 64 * (j))
#define XB_XSUB(j)  (1280 + 64 * (j))
#define XB_XGEN(j)  (2304 + 64 * (j))
#define XB_TOP      3328
#define XB_TOPGEN   3392
#define XCD_BAR_WORDS 3456
#define XB_SPIN_CAP (1u << 21)
static_assert(XCD_BAR_WORDS * 4 <= CTL_BYTES, "ctl");

__device__ __forceinline__ unsigned xb_ld(unsigned* p)              { return __hip_atomic_load(p, __ATOMIC_RELAXED, __HIP_MEMORY_SCOPE_AGENT); }
__device__ __forceinline__ unsigned xb_add(unsigned* p, unsigned v) { return __hip_atomic_fetch_add(p, v, __ATOMIC_RELAXED, __HIP_MEMORY_SCOPE_AGENT); }
__device__ __forceinline__ unsigned xb_xcc_id() { return (unsigned)__builtin_amdgcn_s_getreg((3 << 11) | 20) & 0xFu; }
#define XB_SPIN(cond, bar) do { unsigned _sp = 0; while (cond) { __builtin_amdgcn_s_sleep(1); \
    if ((++_sp & 255u) == 0u) { if (xb_ld(&(bar)[XB_TMO])) break; if (_sp > XB_SPIN_CAP) { atomicAdd(&(bar)[XB_TMO], 1u); break; } } } } while (0)

struct XcdBarrier { unsigned* bar; unsigned x; volatile LAS unsigned* st; };

__device__ __forceinline__ XcdBarrier xcd_barrier_post(unsigned* bar, volatile LAS unsigned* st) {
    XcdBarrier b; b.bar = bar; b.x = xb_xcc_id(); b.st = st;
    if (threadIdx.x == 0) (void)xb_add(&bar[XB_XCNT(b.x)], 1u);
    return b;
}
__device__ __forceinline__ void xcd_barrier_complete(unsigned* bar, unsigned x, unsigned& nloc, unsigned& nx) {
    const unsigned G = gridDim.x * gridDim.y * gridDim.z;
    unsigned sum, cnt, mine, sp = 0u;
    for (;;) {
        sum = 0u; cnt = 0u; mine = 0u;
#pragma unroll
        for (unsigned j = 0; j < 16; ++j) { const unsigned c = xb_ld(&bar[XB_XCNT(j)]); sum += c; cnt += (c > 0u) ? 1u : 0u; mine = (j == x) ? c : mine; }
        if (sum == G) break;
        __builtin_amdgcn_s_sleep(1);
        if ((++sp & 255u) == 0u) { if (xb_ld(&bar[XB_TMO])) break; if (sp > XB_SPIN_CAP) { atomicAdd(&bar[XB_TMO], 1u); break; } }
    }
    nloc = mine > 0u ? mine : 1u; nx = cnt > 0u ? cnt : 1u;
}
__device__ __forceinline__ void xcd_barrier(const XcdBarrier& b, const int wave_s) {
    asm volatile("s_waitcnt vmcnt(0)" ::: "memory");
    __syncthreads();
    int ln_; asm volatile("v_mbcnt_lo_u32_b32 %0, -1, 0\n\tv_mbcnt_hi_u32_b32 %0, -1, %0" : "=v"(ln_));
    if (wave_s == 0 && ln_ == 0) {
        unsigned* bar = b.bar;
        __builtin_amdgcn_s_waitcnt(0);
        unsigned nloc = b.st[0], nx = b.st[1];
        if (nloc == 0u) { xcd_barrier_complete(bar, b.x, nloc, nx); b.st[0] = nloc; b.st[1] = nx; }
        const unsigned old = xb_add(&bar[XB_XSUB(b.x)], 1u);
        const unsigned gen = old / nloc;
        if (old + 1u == (gen + 1u) * nloc) {
            __builtin_amdgcn_fence(__ATOMIC_RELEASE, "agent");
            asm volatile("s_waitcnt vmcnt(0)" ::: "memory");
            const unsigned og = xb_add(&bar[XB_TOP], 1u);
            const unsigned tg = og / nx;
            if (og + 1u == (tg + 1u) * nx) xb_add(&bar[XB_TOPGEN], 1u);
            else XB_SPIN(xb_ld(&bar[XB_TOPGEN]) == tg, bar);
            __builtin_amdgcn_fence(__ATOMIC_ACQUIRE, "agent");
            xb_add(&bar[XB_XGEN(b.x)], 1u);
            asm volatile("s_waitcnt vmcnt(0)" ::: "memory");
        } else {
            XB_SPIN(xb_ld(&bar[XB_XGEN(b.x)]) == gen, bar);
            __builtin_amdgcn_fence(__ATOMIC_ACQUIRE, "agent");
            asm volatile("s_waitcnt vmcnt(0)" ::: "memory");
        }
    }
    __syncthreads();
}
namespace pg8 {
constexpr int BM = 256, BK = 64, HALF = 128, HTB = HALF * BK * 2, STAGE_BYTES = 8 * HTB, NXCD = 8, WGM = 4;

__host__ __device__ __forceinline__ int lds_byte(int r, int c) { const int st = (r >> 4) * 2 + (c >> 5), rr = r & 15, cc = c & 31, ob = rr * 64 + cc * 2; return st * 1024 + (ob ^ (((ob >> 9) & 1) << 5)); }
__host__ __device__ __forceinline__ void stage_rc(int b, int& R, int& C) { const int st = b / 1024, sb = b % 1024, swz = sb ^ (((sb >> 9) & 1) << 5); R = (st >> 1) * 16 + swz / 64; C = (st & 1) * 32 + (swz % 64) / 2; }
__host__ __device__ __forceinline__ int perm32(int rho) { const int n = rho >> 4, i = rho & 15; return 8 * (i >> 2) + 4 * n + (i & 3); }

struct Unit { const char* A; const char* B; int pm, pn; };

__device__ __forceinline__ bool static_tile(int i, int G, int c, int nM, int nN, int& pm, int& pn) {
    const int nwg = nM * nN; const long L = (long)i * G + c; if (L >= nwg) return false;
    int wgid = (int)L; { const int q = nwg / NXCD, r = nwg % NXCD, xcd = wgid % NXCD, off = wgid / NXCD; wgid = (xcd < r ? xcd * (q + 1) : r * (q + 1) + (xcd - r) * q) + off; }
    const int nig = WGM * nN, gid = wgid / nig, fm = gid * WGM, gsz = (nM - fm) < WGM ? (nM - fm) : WGM;
    pm = fm + ((wgid % nig) % gsz); pn = (wgid % nig) / gsz; return true;
}
struct PlainSched {
    const char* A; const char* Bt; int nM, nN, K, G, c;
    __device__ __forceinline__ bool next(int i, Unit& u) const {
        int pm, pn; if (!static_tile(i, G, c, nM, nN, pm, pn)) return false;
        u.pm = pm; u.pn = pn; u.A = A + (size_t)pm * 256 * K * 2; u.B = Bt + (size_t)pn * 256 * K * 2; return true;
    }
};
struct MoeSched {
    const char* A; const char* W; int tpe, nN, K, bN, G, c;
    __device__ __forceinline__ bool next(int i, Unit& u) const {
        int pm, pn; if (!static_tile(i, G, c, NE * tpe, nN, pm, pn)) return false;
        const int e = pm / tpe, rt = pm - e * tpe;
        u.pm = e * (SLOTS_E / 256) + rt; u.pn = pn;
        u.A = A + (size_t)u.pm * 256 * K * 2; u.B = W + ((size_t)e * bN + (size_t)pn * 256) * K * 2; return true;
    }
};

__device__ __forceinline__ unsigned cvt_pk_bf16(float lo, float hi) { return pk2(lo, hi); }


struct EpiBf16 {
    static constexpr bool PERM = true; static constexpr int NSTORE = 16;
    bf16_t* O; int ldc; int nscale; float scale; float ds = 1.f;
    __device__ __forceinline__ void operator()(const f32x4 (&acc)[2][2][4][2], const Unit& u, int wr, int wc, int fr, int fq) const {
        const int row0 = u.pm * BM + wr * 64 + fr, col0 = u.pn * BM + wc * 32 + 8 * fq;
        const float s = ((u.pn < nscale) ? scale : 1.f) * ds;
#pragma unroll
        for (int ai = 0; ai < 2; ++ai)
#pragma unroll
            for (int m = 0; m < 4; ++m) { bf16_t* rowp = O + (size_t)(row0 + ai * HALF + m * 16) * ldc + col0;
#pragma unroll
                for (int bj = 0; bj < 2; ++bj) { const f32x4 v0 = acc[ai][bj][m][0] * s, v1 = acc[ai][bj][m][1] * s;
                    u32x4 o; o.x = cvt_pk_bf16(v0[0], v0[1]); o.y = cvt_pk_bf16(v0[2], v0[3]); o.z = cvt_pk_bf16(v1[0], v1[1]); o.w = cvt_pk_bf16(v1[2], v1[3]);
                    *(u32x4*)(rowp + bj * HALF) = o; } }
    }
};
struct EpiResid {
    static constexpr bool PERM = true; static constexpr int NSTORE = 16;
    const float* srcL; const float* srcC; bf16_t* X16; const float* gate; bool f32src; float ds = 1.f;
    __device__ __forceinline__ void operator()(const f32x4 (&acc)[2][2][4][2], const Unit& u, int wr, int wc, int fr, int fq) const {
        const bool isc = u.pm >= RL / 256;
        const int mi = isc ? NB : (u.pm >> 4);
        const int row0 = u.pm * BM + wr * 64 + fr, col0 = u.pn * BM + wc * 32 + 8 * fq;
        const float* gp = gate + (size_t)mi * 6 * D + col0;
        f32x4 gv[2][2];
#pragma unroll
        for (int bj = 0; bj < 2; ++bj)
#pragma unroll
            for (int n = 0; n < 2; ++n) gv[bj][n] = *(const f32x4*)(gp + bj * HALF + n * 4) * ds;
        if (f32src) {
#pragma unroll
            for (int am = 0; am < 4; ++am) { const int ai = am >> 1, mb = (am & 1) * 2; f32x4 xs[2][2][2];
#pragma unroll
                for (int m2 = 0; m2 < 2; ++m2) { const int row = row0 + ai * HALF + (mb + m2) * 16; const float* sp = isc ? (srcC + (size_t)(row - RL) * D + col0) : (srcL + (size_t)row * D + col0);
#pragma unroll
                    for (int bj = 0; bj < 2; ++bj) { xs[m2][bj][0] = *(const f32x4*)(sp + bj * HALF); xs[m2][bj][1] = *(const f32x4*)(sp + bj * HALF + 4); } }
#pragma unroll
                for (int m2 = 0; m2 < 2; ++m2) { const int m = mb + m2; const int row = row0 + ai * HALF + m * 16; bf16_t* xp = X16 + (size_t)row * D + col0;
#pragma unroll
                    for (int bj = 0; bj < 2; ++bj) { const f32x4 v0 = xs[m2][bj][0] + gv[bj][0] * acc[ai][bj][m][0], v1 = xs[m2][bj][1] + gv[bj][1] * acc[ai][bj][m][1];
                        u32x4 o; o.x = cvt_pk_bf16(v0[0], v0[1]); o.y = cvt_pk_bf16(v0[2], v0[3]); o.z = cvt_pk_bf16(v1[0], v1[1]); o.w = cvt_pk_bf16(v1[2], v1[3]);
                        *(u32x4*)(xp + bj * HALF) = o; } } }
        } else {
#pragma unroll
            for (int ai = 0; ai < 2; ++ai) { u32x4 xu[4][2];
#pragma unroll
                for (int m = 0; m < 4; ++m) { const bf16_t* xp = X16 + (size_t)(row0 + ai * HALF + m * 16) * D + col0;
#pragma unroll
                    for (int bj = 0; bj < 2; ++bj) xu[m][bj] = *(const u32x4*)(xp + bj * HALF); }
#pragma unroll
                for (int m = 0; m < 4; ++m) { bf16_t* xp = X16 + (size_t)(row0 + ai * HALF + m * 16) * D + col0;
#pragma unroll
                    for (int bj = 0; bj < 2; ++bj) { const u32x4 t = xu[m][bj];
                        const f32x4 x0 = (f32x4){bf_lo(t.x), bf_hi(t.x), bf_lo(t.y), bf_hi(t.y)}, x1 = (f32x4){bf_lo(t.z), bf_hi(t.z), bf_lo(t.w), bf_hi(t.w)};
                        const f32x4 v0 = x0 + gv[bj][0] * acc[ai][bj][m][0], v1 = x1 + gv[bj][1] * acc[ai][bj][m][1];
                        u32x4 o; o.x = cvt_pk_bf16(v0[0], v0[1]); o.y = cvt_pk_bf16(v0[2], v0[3]); o.z = cvt_pk_bf16(v1[0], v1[1]); o.w = cvt_pk_bf16(v1[2], v1[3]);
                        *(u32x4*)(xp + bj * HALF) = o; } } }
        }
    }
};
struct EpiSwiglu {
    static constexpr bool PERM = true; static constexpr int NSTORE = 8;
    void* O; float ds; bool f8out;
    __device__ __forceinline__ void operator()(const f32x4 (&acc)[2][2][4][2], const Unit& u, int wr, int wc, int fr, int fq) const {
        const int row0 = u.pm * BM + wr * 64 + fr, col0 = u.pn * HALF + wc * 32 + 8 * fq;
#pragma unroll
        for (int ai = 0; ai < 2; ++ai)
#pragma unroll
            for (int m = 0; m < 4; ++m) { const size_t ro = (size_t)(row0 + ai * HALF + m * 16) * D + col0;
                float r[8]; const float kt = -ds * 1.4426950408889634f, cinv = 1.f / (ds * ds * (f8out ? FP8_SA : 1.f));
#pragma unroll
                for (int n = 0; n < 2; ++n)
#pragma unroll
                    for (int j = 0; j < 4; ++j) { const float ag = acc[ai][0][m][n][j], au = acc[ai][1][m][n][j];
                        const float e = __builtin_amdgcn_exp2f(ag * kt); r[n * 4 + j] = (ag * au) * fast_rcp(fmaf(e, cinv, cinv)); }
                if (f8out) { u32x2 o; o.x = pk_fp8x4(r[0], r[1], r[2], r[3]); o.y = pk_fp8x4(r[4], r[5], r[6], r[7]);
                    *(u32x2*)((unsigned char*)O + ro) = o; }
                else { u32x4 o; o.x = cvt_pk_bf16(r[0], r[1]); o.y = cvt_pk_bf16(r[2], r[3]); o.z = cvt_pk_bf16(r[4], r[5]); o.w = cvt_pk_bf16(r[6], r[7]);
                    *(u32x4*)((bf16_t*)O + ro) = o; } }
    }
};
struct EpiRowScale {
    static constexpr bool PERM = true; static constexpr int NSTORE = 16;
    void* O; const float* g; float ds;
    __device__ __forceinline__ void operator()(const f32x4 (&acc)[2][2][4][2], const Unit& u, int wr, int wc, int fr, int fq) const {
        const int row0 = u.pm * BM + wr * 64 + fr, col0 = u.pn * BM + wc * 32 + 8 * fq;
#pragma unroll
        for (int ai = 0; ai < 2; ++ai)
#pragma unroll
            for (int m = 0; m < 4; ++m) { const int row = row0 + ai * HALF + m * 16; const float s = g[row] * ds * (MOE_Y_FP8 ? FP8_SY : 1.f); const size_t ro = (size_t)row * D + col0;
#pragma unroll
                for (int bj = 0; bj < 2; ++bj) { const f32x4 v0 = acc[ai][bj][m][0] * s, v1 = acc[ai][bj][m][1] * s;
                    if (MOE_Y_FP8) { u32x2 o; o.x = pk_fp8x4(v0[0], v0[1], v0[2], v0[3]); o.y = pk_fp8x4(v1[0], v1[1], v1[2], v1[3]); *(u32x2*)((unsigned char*)O + ro + bj * HALF) = o; }
                    else { u32x4 o; o.x = cvt_pk_bf16(v0[0], v0[1]); o.y = cvt_pk_bf16(v0[2], v0[3]); o.z = cvt_pk_bf16(v1[0], v1[1]); o.w = cvt_pk_bf16(v1[2], v1[3]);
                        *(u32x4*)((bf16_t*)O + ro + bj * HALF) = o; } } }
    }
};

template <class Epi, class Sched, bool GATHER = false, bool FP8 = false>
__device__ __forceinline__ void gemm_phase(LAS unsigned char* lds, const int tid, const int K, const Sched& S, const Epi& E, const int* rowidx = nullptr) {
    const int wid = __builtin_amdgcn_readfirstlane(tid >> 6), lane = tid & 63, wr = wid >> 2, wc = wid & 3, fr = lane & 15, fq = lane >> 4;
    const int nt = K / BK;
    unsigned voffA[2], voffB[2]; int gR[2], gC[2];
#pragma unroll
    for (int i = 0; i < 2; ++i) { int R, C; stage_rc(tid * 16 + i * 8192, R, C); const int Rb = Epi::PERM ? ((R & ~31) + perm32(R & 31)) : R;
        voffA[i] = (unsigned)(R * K + C) * 2u; voffB[i] = (unsigned)(Rb * K + C) * 2u; gR[i] = R; gC[i] = C * 2; }
    unsigned gcur[2][2]; int gnxt[2][2];
#define PG8_GRAW(dst, unit) do { if (GATHER) { _Pragma("unroll") for (int h_ = 0; h_ < 2; ++h_) _Pragma("unroll") for (int i_ = 0; i_ < 2; ++i_) dst[h_][i_] = rowidx[(unit).pm * 256 + h_ * 128 + gR[i_]]; } } while (0)
#define PG8_GOFF(raw, i_) ((unsigned)(raw) * (unsigned)(K * 2) + (unsigned)gC[i_])
    const size_t kstep = (size_t)(BK * 2);
    const size_t hstep = (size_t)HALF * K * 2;
    const unsigned ldsw = (unsigned)wid * 1024u;
    const int aoff = lds_byte(wr * 64 + fr, fq * 8), boff = lds_byte(wc * 32 + fr, fq * 8);
#define PG8_SA(b, h) (((b) * 2 + (h)) * HTB)
#define PG8_SB(b, h) ((4 + (b) * 2 + (h)) * HTB)
#define PG8_STAGE(bufoff, gbase, voff) do { _Pragma("unroll") for (int _i = 0; _i < 2; ++_i) \
        __builtin_amdgcn_global_load_lds((const unsigned*)((const char*)(gbase) + (voff)[_i]), (LAS unsigned*)(lds + (bufoff) + ldsw + _i * 8192), 16, 0, 0); } while (0)
#define PG8_STAGE_A(b, h, gbase, NX) do { if (GATHER) { unsigned go_[2]; go_[0] = (NX) ? PG8_GOFF(gnxt[h][0], 0) : gcur[h][0]; go_[1] = (NX) ? PG8_GOFF(gnxt[h][1], 1) : gcur[h][1]; PG8_STAGE(PG8_SA(b, h), (gbase), go_); } \
        else { PG8_STAGE(PG8_SA(b, h), (gbase) + (h) * hstep, voffA); } } while (0)
#define PG8_LDA(dst, b, h) do { _Pragma("unroll") for (int m = 0; m < 4; ++m) _Pragma("unroll") for (int k = 0; k < 2; ++k) dst[m][k] = *(const LAS bf16x8*)(lds + PG8_SA(b, h) + aoff + m * 2048 + k * 1024); } while (0)
#define PG8_LDB(dst, b, h) do { _Pragma("unroll") for (int n = 0; n < 2; ++n) _Pragma("unroll") for (int k = 0; k < 2; ++k) dst[n][k] = *(const LAS bf16x8*)(lds + PG8_SB(b, h) + boff + n * 2048 + k * 1024); } while (0)
#define PG8_MMA(ai, bj, At, Bt) do { __builtin_amdgcn_s_setprio(1); if (FP8) { _Pragma("unroll") for (int m = 0; m < 4; ++m) _Pragma("unroll") for (int n = 0; n < 2; ++n) { \
            typedef int v8i_ __attribute__((ext_vector_type(8))); typedef int v4i_ __attribute__((ext_vector_type(4))); \
            const v4i_ b0_ = __builtin_bit_cast(v4i_, Bt[n][0]), b1_ = __builtin_bit_cast(v4i_, Bt[n][1]), a0_ = __builtin_bit_cast(v4i_, At[m][0]), a1_ = __builtin_bit_cast(v4i_, At[m][1]); \
            const v8i_ bb_ = {b0_[0], b0_[1], b0_[2], b0_[3], b1_[0], b1_[1], b1_[2], b1_[3]}, aa_ = {a0_[0], a0_[1], a0_[2], a0_[3], a1_[0], a1_[1], a1_[2], a1_[3]}; \
            asm volatile("v_mfma_scale_f32_16x16x128_f8f6f4 %0, %1, %2, %0, %3, %3 op_sel_hi:[0,0,0]" : "+v"(acc[ai][bj][m][n]) : "v"(bb_), "v"(aa_), "v"(sc127)); } } \
        else { _Pragma("unroll") for (int m = 0; m < 4; ++m) _Pragma("unroll") for (int n = 0; n < 2; ++n) _Pragma("unroll") for (int k = 0; k < 2; ++k) \
        acc[ai][bj][m][n] = __builtin_amdgcn_mfma_f32_16x16x32_bf16(Bt[n][k], At[m][k], acc[ai][bj][m][n], 0, 0, 0); } __builtin_amdgcn_s_setprio(0); } while (0)
#define PG8_WAIT_V(n) asm volatile("s_waitcnt vmcnt(" #n ")" ::: "memory")
#define PG8_WAIT_VE() do { if (Epi::NSTORE == 32) asm volatile("s_waitcnt vmcnt(40)" ::: "memory"); else if (Epi::NSTORE == 16) asm volatile("s_waitcnt vmcnt(24)" ::: "memory"); else asm volatile("s_waitcnt vmcnt(16)" ::: "memory"); } while (0)
#define PG8_WAIT_L(n) asm volatile("s_waitcnt lgkmcnt(" #n ")" ::: "memory")
#define PG8_BAR __builtin_amdgcn_s_barrier()
#define PG8_SCHED __builtin_amdgcn_sched_barrier(0)
    Unit cur, nxt; int ui = 0;
    if (!S.next(0, cur)) return;
    int sc127 = 0x7F7F7F7F; asm volatile("" : "+v"(sc127));
    f32x4 acc[2][2][4][2];
#pragma unroll
    for (int a = 0; a < 2; ++a)
#pragma unroll
        for (int b = 0; b < 2; ++b)
#pragma unroll
            for (int m = 0; m < 4; ++m)
#pragma unroll
                for (int n = 0; n < 2; ++n) acc[a][b][m][n] = (f32x4){0.f, 0.f, 0.f, 0.f};
    bf16x8 At[4][2], B0[2][2], B1[2][2];
    const char* cA = GATHER ? S.A : cur.A; const char* cB = cur.B;
    if (GATHER) { int g0_[2][2]; PG8_GRAW(g0_, cur); _Pragma("unroll") for (int h_ = 0; h_ < 2; ++h_) { gcur[h_][0] = PG8_GOFF(g0_[h_][0], 0); gcur[h_][1] = PG8_GOFF(g0_[h_][1], 1); } }
    PG8_STAGE(PG8_SB(0, 0), cB, voffB); PG8_STAGE(PG8_SB(0, 1), cB + hstep, voffB); PG8_STAGE_A(0, 0, cA, false); PG8_STAGE_A(0, 1, cA, false);
    if (wr == 1) PG8_BAR;
    PG8_WAIT_V(2); PG8_BAR;
    PG8_STAGE(PG8_SB(1, 0), cB + kstep, voffB); PG8_STAGE_A(1, 0, cA + kstep, false); PG8_STAGE(PG8_SB(1, 1), cB + hstep + kstep, voffB);
    PG8_WAIT_V(6); PG8_BAR;
    for (;;) {
        const bool has_next = S.next(ui + 1, nxt);
        const char* nA = (has_next && !GATHER) ? nxt.A : cA; const char* nB = has_next ? nxt.B : cB;
        if (GATHER) { if (has_next) { PG8_GRAW(gnxt, nxt); } else { PG8_GRAW(gnxt, cur); } }
#pragma unroll 1
        for (int t = 0; t < nt; t += 2) {
            const bool last = (t == nt - 2);
            const char* a1 = cA + (size_t)(t + 1) * kstep;
            const char* a2 = last ? nA : cA + (size_t)(t + 2) * kstep; const char* b2 = last ? nB : cB + (size_t)(t + 2) * kstep;
            const char* a3 = a2 + kstep; const char* b3 = b2 + kstep;
            PG8_LDB(B0, 0, 0); PG8_LDB(B1, 0, 1); PG8_SCHED; PG8_LDA(At, 0, 0); PG8_STAGE_A(1, 1, a1, false);
            PG8_WAIT_V(8); PG8_WAIT_L(0); PG8_BAR; PG8_MMA(0, 0, At, B0); PG8_MMA(0, 1, At, B1); PG8_BAR; PG8_SCHED;
            PG8_LDA(At, 0, 1); PG8_STAGE(PG8_SB(0, 0), b2, voffB); PG8_STAGE(PG8_SB(0, 1), b2 + hstep, voffB); PG8_STAGE_A(0, 0, a2, last);
            PG8_WAIT_V(8); PG8_WAIT_L(0); PG8_BAR; PG8_MMA(1, 0, At, B0); PG8_MMA(1, 1, At, B1); PG8_BAR; PG8_SCHED;
            PG8_LDB(B0, 1, 0); PG8_LDB(B1, 1, 1); PG8_SCHED; PG8_LDA(At, 1, 0); PG8_STAGE_A(0, 1, a2, last);
            PG8_WAIT_V(8); PG8_WAIT_L(0); PG8_BAR; PG8_MMA(0, 0, At, B0); PG8_MMA(0, 1, At, B1); PG8_BAR; PG8_SCHED;
            PG8_LDA(At, 1, 1); PG8_STAGE(PG8_SB(1, 0), b3, voffB); PG8_STAGE(PG8_SB(1, 1), b3 + hstep, voffB); PG8_STAGE_A(1, 0, a3, last);
            PG8_WAIT_V(8); PG8_WAIT_L(0); PG8_BAR; PG8_MMA(1, 0, At, B0); PG8_MMA(1, 1, At, B1); PG8_BAR; PG8_SCHED;
        }
        if (wr == 0) PG8_BAR;
        if (FP8) asm volatile("s_nop 15\n\ts_nop 15" ::: "memory");
        { int tz = tid; asm volatile("" : "+v"(tz));
          const int wid2 = __builtin_amdgcn_readfirstlane(tz >> 6), lane2 = tz & 63;
          E(acc, cur, wid2 >> 2, wid2 & 3, lane2 & 15, lane2 >> 4); }
        if (!has_next) break;
#pragma unroll
        for (int a = 0; a < 2; ++a)
#pragma unroll
            for (int b = 0; b < 2; ++b)
#pragma unroll
                for (int m = 0; m < 4; ++m)
#pragma unroll
                    for (int n = 0; n < 2; ++n) acc[a][b][m][n] = (f32x4){0.f, 0.f, 0.f, 0.f};
        cur = nxt; cA = nA; cB = nB; ++ui;
        if (GATHER) { _Pragma("unroll") for (int h_ = 0; h_ < 2; ++h_) { gcur[h_][0] = PG8_GOFF(gnxt[h_][0], 0); gcur[h_][1] = PG8_GOFF(gnxt[h_][1], 1); } }
        if (wr == 1) PG8_BAR;
    }
    PG8_WAIT_V(0);
    PG8_BAR;
#undef PG8_SA
#undef PG8_SB
#undef PG8_STAGE
#undef PG8_STAGE_A
#undef PG8_GRAW
#undef PG8_GOFF
#undef PG8_LDA
#undef PG8_LDB
#undef PG8_MMA
#undef PG8_WAIT_V
#undef PG8_WAIT_VE
#undef PG8_WAIT_L
#undef PG8_BAR
#undef PG8_SCHED
}
}
namespace attn_body {
constexpr int NW = 8, QBLK = 32, QB = QBLK * NW, KVBLK = 64;
__device__ __forceinline__ int crow(int r, int hi) { return (r & 3) + 8 * (r >> 2) + 4 * hi; }
#define SBAR() __builtin_amdgcn_sched_barrier(0)
constexpr int NSLOT = 3, SLOTB = 8192;
constexpr int LDS_K = 0, LDS_V = NSLOT * SLOTB, LDS_WS = 2 * NSLOT * SLOTB, LDS_OST = LDS_WS + NW * 64 * 4, LDS_BYTES = LDS_OST + NW * 4096;
constexpr float C2 = 0.125f * 1.4426950408889634f;
__device__ __forceinline__ void glds16(const void* gsrc, unsigned lds_dst) { unsigned keep;
  asm volatile("s_mov_b32 %0, m0\n\ts_mov_b32 m0, %2\n\ts_nop 0\n\tglobal_load_lds_dwordx4 %1, off\n\ts_mov_b32 m0, %0" : "=&s"(keep) : "v"(gsrc), "s"(lds_dst) : "memory"); }
__device__ __forceinline__ float max3f(float a, float b, float c) { float r; asm("v_max3_f32 %0, %1, %2, %3" : "=v"(r) : "v"(a), "v"(b), "v"(c)); return r; }
__device__ __forceinline__ float max2f(float a, float b) { float r; asm("v_max_f32_e32 %0, %1, %2" : "=v"(r) : "v"(a), "v"(b)); return r; }
__device__ __forceinline__ float fadd_s(float a, float b) { float r; asm("v_add_f32_e32 %0, %1, %2" : "=v"(r) : "v"(a), "v"(b)); return r; }
__device__ __forceinline__ float fsub_s(float a, float b) { float r; asm("v_sub_f32_e32 %0, %1, %2" : "=v"(r) : "v"(a), "v"(b)); return r; }
__device__ __forceinline__ unsigned cvtpk_s(float lo, float hi) { f32x2 v = {lo, hi}; bf16x2_t b = __builtin_convertvector(v, bf16x2_t); return __builtin_bit_cast(unsigned, b); }
#define WAIT_BAR(N) asm volatile("s_waitcnt vmcnt(" #N ") lgkmcnt(0)\n\ts_barrier" ::: "memory")

__device__ __forceinline__ void qkt(f32x16& p0, f32x16& p1, const char* Kslot, const bf16x8* qr, const f32x16& negm, int r32, int hi) {
  const char* kb = Kslot + hi * 1024 + r32 * 16;
  #pragma unroll
  for (int d0 = 0; d0 < 4; ++d0) {
    const bf16x8 b0 = *reinterpret_cast<const bf16x8*>(kb + d0 * 2048);
    const bf16x8 b1 = *reinterpret_cast<const bf16x8*>(kb + d0 * 2048 + 512);
    if (d0 == 0) { p0 = __builtin_amdgcn_mfma_f32_32x32x16_bf16(b0, qr[0], negm, 0, 0, 0); p1 = __builtin_amdgcn_mfma_f32_32x32x16_bf16(b1, qr[0], negm, 0, 0, 0); }
    else { p0 = __builtin_amdgcn_mfma_f32_32x32x16_bf16(b0, qr[d0], p0, 0, 0, 0); p1 = __builtin_amdgcn_mfma_f32_32x32x16_bf16(b1, qr[d0], p1, 0, 0, 0); } }
}
typedef __attribute__((address_space(3))) const char* lds_cptr;
typedef short v4i16_t __attribute__((ext_vector_type(4)));
__device__ __forceinline__ void kload8(bf16x8* kf, lds_cptr kp) {
  kf[0] = *(const LAS bf16x8*)(kp);        kf[1] = *(const LAS bf16x8*)(kp + 512);
  kf[2] = *(const LAS bf16x8*)(kp + 2048); kf[3] = *(const LAS bf16x8*)(kp + 2560);
  kf[4] = *(const LAS bf16x8*)(kp + 4096); kf[5] = *(const LAS bf16x8*)(kp + 4608);
  kf[6] = *(const LAS bf16x8*)(kp + 6144); kf[7] = *(const LAS bf16x8*)(kp + 6656);
}
__device__ __forceinline__ void kload2(bf16x8* kf, lds_cptr kp, int j) { kf[2 * j] = *(const LAS bf16x8*)(kp + j * 2048); kf[2 * j + 1] = *(const LAS bf16x8*)(kp + j * 2048 + 512); }
__device__ __forceinline__ s16x4 vtr(lds_cptr p) { return __builtin_bit_cast(s16x4, __builtin_amdgcn_ds_read_tr16_b64_v4i16((LAS v4i16_t*)p)); }
__device__ __forceinline__ float rowmax(const f32x16& p0, const f32x16& p1) {
  float a = max3f(p0[0], p0[1], p1[0]), b = max3f(p0[2], p0[3], p1[1]); a = max3f(a, p1[2], p1[3]);
  #pragma unroll
  for (int r = 4; r < 16; r += 4) { a = max3f(a, p0[r], p0[r + 1]); b = max3f(b, p0[r + 2], p0[r + 3]); a = max3f(a, p1[r], p1[r + 1]); b = max3f(b, p1[r + 2], p1[r + 3]); }
  const float m = max2f(a, b);
  auto rr = __builtin_amdgcn_permlane32_swap(__float_as_uint(m), __float_as_uint(m), false, false);
  return max2f(__uint_as_float(rr[0]), __uint_as_float(rr[1]));
}
__device__ __forceinline__ void pv(f32x16* o, int vb, bf16x8 pa0, bf16x8 pa1, bf16x8 pa2, bf16x8 pa3) {
  #pragma unroll
  for (int d0 = 0; d0 < 2; ++d0) { s16x4 lo[4], hi[4];
    #pragma unroll
    for (int ks = 0; ks < 4; ++ks) {
      asm volatile("ds_read_b64_tr_b16 %0,%1 offset:%c2" : "=&v"(lo[ks]) : "v"(vb), "i"(d0 * 4096 + ks * 1024) : "memory");
      asm volatile("ds_read_b64_tr_b16 %0,%1 offset:%c2" : "=&v"(hi[ks]) : "v"(vb), "i"(d0 * 4096 + ks * 1024 + 512) : "memory"); }
    asm volatile("s_waitcnt lgkmcnt(0)" ::: "memory"); SBAR();
    #define PK(k) (bf16x8){lo[k][0], lo[k][1], lo[k][2], lo[k][3], hi[k][0], hi[k][1], hi[k][2], hi[k][3]}
    o[d0] = __builtin_amdgcn_mfma_f32_32x32x16_bf16(pa0, PK(0), o[d0], 0, 0, 0);
    o[d0] = __builtin_amdgcn_mfma_f32_32x32x16_bf16(pa1, PK(1), o[d0], 0, 0, 0);
    o[d0] = __builtin_amdgcn_mfma_f32_32x32x16_bf16(pa2, PK(2), o[d0], 0, 0, 0);
    o[d0] = __builtin_amdgcn_mfma_f32_32x32x16_bf16(pa3, PK(3), o[d0], 0, 0, 0);
    #undef PK
  }
}

template <int VAR> __device__ __forceinline__ void attn_unit(const bf16_t* Qrow0, int QP, const bf16_t* __restrict__ Kc, const bf16_t* __restrict__ Vc, const bf16_t* __restrict__ Kl, const bf16_t* __restrict__ Vl, int NC, int KVP, int NT,
                                                              bf16_t* Orow0, int OP, char* shm, const int tid, const float mfix, const float* qn, const float* ropec, const float* ropes, const int rope, const int tq0) {
  const int lane = tid & 63, r32 = lane & 31, hi = lane >> 5; const int wid = __builtin_amdgcn_readfirstlane(tid >> 6);
  const bf16_t* Qw = Qrow0 + (long)(wid * QBLK) * QP;
  const unsigned lds0 = (unsigned)(uintptr_t)shm;
  float* wsf = (float*)(shm + LDS_WS) + wid * 64;
  const long koff = (long)lane * KVP + wid * 8, voff = (long)(16 * (wid & 3) + (lane >> 2)) * KVP + (wid >> 2) * 32 + (lane & 3) * 8;
  const bf16_t* ksrc_c = Kc + koff; const bf16_t* vsrc_c = Vc + voff; const bf16_t* ksrc_l = Kl + koff - (long)NC * KVBLK * KVP; const bf16_t* vsrc_l = Vl + voff - (long)NC * KVBLK * KVP;
  const unsigned kdst = lds0 + LDS_K + wid * 1024, vdst = lds0 + LDS_V + wid * 1024;
  #define DMA_K(t, slot) glds16(((t) < NC ? ksrc_c : ksrc_l) + (long)(t) * KVBLK * KVP, (unsigned)__builtin_amdgcn_readfirstlane(kdst + (slot)))
  #define DMA_V(t, slot) glds16(((t) < NC ? vsrc_c : vsrc_l) + (long)(t) * KVBLK * KVP, (unsigned)__builtin_amdgcn_readfirstlane(vdst + (slot)))
  const int vb0 = (int)(lds0 + LDS_V) + ((lane >> 4) & 1) * 32 + (lane & 3) * 8 + (4 * hi + ((lane & 15) >> 2)) * 64;
  const char* Kbase = shm + LDS_K; bf16x8 kf[8];
  const lds_cptr shm3 = (lds_cptr)shm; const lds_cptr kp0 = shm3 + LDS_K + hi * 1024 + r32 * 16; const lds_cptr vp0 = shm3 + LDS_V + ((lane >> 4) & 1) * 32 + (lane & 3) * 8 + (4 * hi + ((lane & 15) >> 2)) * 64;
  DMA_K(0, 0); DMA_V(0, 0); DMA_K(1, SLOTB);
  bf16x8 qr[4];
  #pragma unroll
  for (int d0 = 0; d0 < 4; ++d0) qr[d0] = *reinterpret_cast<const bf16x8*>(&Qw[(long)r32 * QP + d0 * 16 + hi * 8]);
  {
    float x[4][8];
    #pragma unroll
    for (int d0 = 0; d0 < 4; ++d0) { const u32x4 u = __builtin_bit_cast(u32x4, qr[d0]);
      x[d0][0] = bf_lo(u.x); x[d0][1] = bf_hi(u.x); x[d0][2] = bf_lo(u.y); x[d0][3] = bf_hi(u.y); x[d0][4] = bf_lo(u.z); x[d0][5] = bf_hi(u.z); x[d0][6] = bf_lo(u.w); x[d0][7] = bf_hi(u.w); }
    float ss = 0.f;
    #pragma unroll
    for (int d0 = 0; d0 < 4; ++d0)
      #pragma unroll
      for (int t = 0; t < 8; ++t) ss += x[d0][t] * x[d0][t];
    { auto rr = __builtin_amdgcn_permlane32_swap(__float_as_uint(ss), __float_as_uint(ss), false, false); ss = __uint_as_float(rr[0]) + __uint_as_float(rr[1]); }
    const float rstd = rsqrtf(ss * (1.f / 64.f) + NORM_EPS) * C2;
    #pragma unroll
    for (int d0 = 0; d0 < 4; ++d0) { const f32x4 g0 = *(const f32x4*)(qn + 16 * d0 + 8 * hi), g1 = *(const f32x4*)(qn + 16 * d0 + 8 * hi + 4);
      x[d0][0] *= rstd * g0.x; x[d0][1] *= rstd * g0.y; x[d0][2] *= rstd * g0.z; x[d0][3] *= rstd * g0.w; x[d0][4] *= rstd * g1.x; x[d0][5] *= rstd * g1.y; x[d0][6] *= rstd * g1.z; x[d0][7] *= rstd * g1.w; }
    if (rope) { const int tq = tq0 + wid * QBLK + r32;
      #pragma unroll
      for (int d0 = 0; d0 < 2; ++d0) { const float* cp = ropec + (long)tq * 32 + 16 * d0 + 8 * hi; const float* sp = ropes + (long)tq * 32 + 16 * d0 + 8 * hi;
        const f32x4 c0 = *(const f32x4*)cp, c1 = *(const f32x4*)(cp + 4), s0 = *(const f32x4*)sp, s1 = *(const f32x4*)(sp + 4);
        const float cs[8] = {c0.x, c0.y, c0.z, c0.w, c1.x, c1.y, c1.z, c1.w}, sn[8] = {s0.x, s0.y, s0.z, s0.w, s1.x, s1.y, s1.z, s1.w};
        #pragma unroll
        for (int t = 0; t < 8; ++t) { const float a = x[d0][t], c = x[d0 + 2][t]; x[d0][t] = a * cs[t] - c * sn[t]; x[d0 + 2][t] = a * sn[t] + c * cs[t]; } } }
    #pragma unroll
    for (int d0 = 0; d0 < 4; ++d0) { u32x4 u; u.x = pk2(x[d0][0], x[d0][1]); u.y = pk2(x[d0][2], x[d0][3]); u.z = pk2(x[d0][4], x[d0][5]); u.w = pk2(x[d0][6], x[d0][7]); qr[d0] = __builtin_bit_cast(bf16x8, u); }
  }
  float l_reg = 0.f; f32x16 o[2]; o[0] = f32x16{}; o[1] = f32x16{}; const f32x16 negm = f32x16{}; (void)mfix;
  #define START(P0, P1) do { _Pragma("unroll") for (int r = 0; r < 16; ++r) P0[r] = __builtin_amdgcn_exp2f(P0[r]); } while (0)
  #define RESC() do { } while (0)
  f32x16 pA0, pA1, pB0, pB1;
  int sl_prev = 0, sl_cur = 0, sl_next = SLOTB;
  #define ROT() do { sl_prev = sl_cur; sl_cur = sl_next; sl_next = (sl_next == (NSLOT - 1) * SLOTB) ? 0 : sl_next + SLOTB; } while (0)
  DMA_K(2, 2 * SLOTB);
  WAIT_BAR(3);
  qkt(pA0, pA1, Kbase, qr, negm, r32, hi); asm volatile("s_nop 15\n\ts_nop 7" : "+v"(pA0), "+v"(pA1));
  START(pA0, pA1);
  _Pragma("unroll") for (int r = 0; r < 16; ++r) pA1[r] = __builtin_amdgcn_exp2f(pA1[r]);
  WAIT_BAR(0);
  DMA_K(3, 0); DMA_V(1, SLOTB);
  ROT();
  kload8(kf, kp0 + sl_cur);
  WAIT_BAR(2);
  s16x4 vlo[8], vhi[8]; u32x4 pw0, pw1, pw2, pw3;
  #define PKW(P, B) cvtpk_s(P[B], P[B + 1])
  #define PAF(k) __builtin_bit_cast(bf16x8, pw##k)
  #define VFR(i) (bf16x8){vlo[i][0], vlo[i][1], vlo[i][2], vlo[i][3], vhi[i][0], vhi[i][1], vhi[i][2], vhi[i][3]}
  #define PIN(x) asm volatile("" : "+v"(x))
  #define MX3(a, b, c) __builtin_fmaxf(__builtin_fmaxf((a), (b)), (c))
  #define GAPA(MF, A0, A1, A2, A3, W0, W1, PW) do { MF; sacc += A0; sacc += A1; sacc += A2; sacc += A3; PIN(sacc); W0; W1; PIN(PW); SBAR(); } while (0)
  #define EX(v) __builtin_amdgcn_exp2f(v)
  #define GAPB(MF, X, B) do { MF; X[B] = EX(X[B]); X[B + 1] = EX(X[B + 1]); X[B + 2] = EX(X[B + 2]); X[B + 3] = EX(X[B + 3]); PIN(X); SBAR(); } while (0)
  #define VRD(i) do { if (VAR < 2 || ((i) & 3) == 0) { vlo[i] = vtr(vp_ + (((i) >> 2) * 4096 + ((i) & 3) * 1024)); vhi[i] = vtr(vp_ + (((i) >> 2) * 4096 + ((i) & 3) * 1024 + 512)); } } while (0)
  #define KRD(G, j) do { if ((G) && (VAR == 0 || (j) < 2)) { kload2(kf, kp0 + sl_next, j); SBAR(); } } while (0)
  #define QM(i, e) do { if (VAR == 0 || (i) < 2) { e; } } while (0)
  #define PM(i, e) do { if (VAR < 2 || (i) < 2) { e; } } while (0)
  #define STEP(C0, C1, P0, P1, t, GK, GV, GL) do { SBAR(); \
    const lds_cptr vp_ = vp0 + sl_prev; \
    VRD(0); SBAR(); float sacc = (P0[0] + P0[1]); \
    GAPA(QM(0, C0 = __builtin_amdgcn_mfma_f32_32x32x16_bf16(kf[0], qr[0], negm, 0, 0, 0)), P0[2], P0[3], P0[4], P0[5],     pw0[0] = PKW(P0, 0), pw0[1] = PKW(P0, 2), pw0); \
    VRD(4); SBAR(); GAPA(QM(1, C1 = __builtin_amdgcn_mfma_f32_32x32x16_bf16(kf[1], qr[0], negm, 0, 0, 0)), P0[6], P0[7], P0[8], P0[9],     pw0[2] = PKW(P0, 4), pw0[3] = PKW(P0, 6), pw0); \
    VRD(1); SBAR(); GAPA(QM(2, C0 = __builtin_amdgcn_mfma_f32_32x32x16_bf16(kf[2], qr[1], C0, 0, 0, 0)),   P0[10], P0[11], P0[12], P0[13], pw1[0] = PKW(P0, 8), pw1[1] = PKW(P0, 10), pw1); \
    VRD(5); SBAR(); GAPA(QM(3, C1 = __builtin_amdgcn_mfma_f32_32x32x16_bf16(kf[3], qr[1], C1, 0, 0, 0)),   P0[14], P0[15], P1[0], P1[1],   pw1[2] = PKW(P0, 12), pw1[3] = PKW(P0, 14), pw1); \
    VRD(2); SBAR(); GAPA(QM(4, C0 = __builtin_amdgcn_mfma_f32_32x32x16_bf16(kf[4], qr[2], C0, 0, 0, 0)),   P1[2], P1[3], P1[4], P1[5],     pw2[0] = PKW(P1, 0), pw2[1] = PKW(P1, 2), pw2); \
    VRD(6); SBAR(); GAPA(QM(5, C1 = __builtin_amdgcn_mfma_f32_32x32x16_bf16(kf[5], qr[2], C1, 0, 0, 0)),   P1[6], P1[7], P1[8], P1[9],     pw2[2] = PKW(P1, 4), pw2[3] = PKW(P1, 6), pw2); \
    VRD(3); SBAR(); GAPA(QM(6, C0 = __builtin_amdgcn_mfma_f32_32x32x16_bf16(kf[6], qr[3], C0, 0, 0, 0)),   P1[10], P1[11], P1[12], P1[13], pw3[0] = PKW(P1, 8), pw3[1] = PKW(P1, 10), pw3); \
    VRD(7); SBAR(); GAPA(QM(7, C1 = __builtin_amdgcn_mfma_f32_32x32x16_bf16(kf[7], qr[3], C1, 0, 0, 0)),   P1[14], P1[15], 0.f, 0.f,       pw3[2] = PKW(P1, 12), pw3[3] = PKW(P1, 14), pw3); \
    l_reg += sacc; \
    if (GK) { DMA_K((t) + 3, sl_cur); } if (GV) { DMA_V((t) + 1, sl_next); } \
    SBAR(); \
    GAPB(PM(0, o[0] = __builtin_amdgcn_mfma_f32_32x32x16_bf16(PAF(0), VFR(0), o[0], 0, 0, 0)), C0, 0); \
    GAPB(PM(1, o[1] = __builtin_amdgcn_mfma_f32_32x32x16_bf16(PAF(0), VFR(4), o[1], 0, 0, 0)), C0, 4); \
    KRD(GL, 0); GAPB(PM(2, o[0] = __builtin_amdgcn_mfma_f32_32x32x16_bf16(PAF(1), VFR(1), o[0], 0, 0, 0)), C0, 8); \
    KRD(GL, 1); GAPB(PM(3, o[1] = __builtin_amdgcn_mfma_f32_32x32x16_bf16(PAF(1), VFR(5), o[1], 0, 0, 0)), C0, 12); \
    KRD(GL, 2); GAPB(PM(4, o[0] = __builtin_amdgcn_mfma_f32_32x32x16_bf16(PAF(2), VFR(2), o[0], 0, 0, 0)), C1, 0); \
    KRD(GL, 3); GAPB(PM(5, o[1] = __builtin_amdgcn_mfma_f32_32x32x16_bf16(PAF(2), VFR(6), o[1], 0, 0, 0)), C1, 4); \
    GAPB(PM(6, o[0] = __builtin_amdgcn_mfma_f32_32x32x16_bf16(PAF(3), VFR(3), o[0], 0, 0, 0)), C1, 8); \
    GAPB(PM(7, o[1] = __builtin_amdgcn_mfma_f32_32x32x16_bf16(PAF(3), VFR(7), o[1], 0, 0, 0)), C1, 12); \
    } while (0)
  int t = 1;
  for (; t + 5 < NT; t += 2) {
    STEP(pB0, pB1, pA0, pA1, t, true, true, true);     WAIT_BAR(2); RESC(); ROT();
    STEP(pA0, pA1, pB0, pB1, t + 1, true, true, true); WAIT_BAR(2); RESC(); ROT();
  }
  #define ENDW(tt) do { if ((tt) + 3 < NT) { WAIT_BAR(2); } else if ((tt) + 2 < NT) { WAIT_BAR(1); } else { WAIT_BAR(0); } } while (0)
  for (; t + 1 < NT; t += 2) {
    STEP(pB0, pB1, pA0, pA1, t, (t + 3 < NT), (t + 1 < NT), (t + 1 < NT));         ENDW(t);     RESC(); ROT();
    STEP(pA0, pA1, pB0, pB1, t + 1, (t + 4 < NT), (t + 2 < NT), (t + 2 < NT));     ENDW(t + 1); RESC(); ROT();
  }
  STEP(pB0, pB1, pA0, pA1, NT - 1, false, false, false); RESC();
  { float sacc = pB0[0] + pB0[1]; _Pragma("unroll") for (int r = 2; r < 16; ++r) sacc += pB0[r]; _Pragma("unroll") for (int r = 0; r < 16; ++r) sacc += pB1[r]; l_reg += sacc;
    pw0 = (u32x4){PKW(pB0, 0), PKW(pB0, 2), PKW(pB0, 4), PKW(pB0, 6)}; pw1 = (u32x4){PKW(pB0, 8), PKW(pB0, 10), PKW(pB0, 12), PKW(pB0, 14)}; pw2 = (u32x4){PKW(pB1, 0), PKW(pB1, 2), PKW(pB1, 4), PKW(pB1, 6)}; pw3 = (u32x4){PKW(pB1, 8), PKW(pB1, 10), PKW(pB1, 12), PKW(pB1, 14)};
    SBAR(); pv(o, vb0 + sl_cur, PAF(0), PAF(1), PAF(2), PAF(3)); }
  #undef PKW
  #undef PAF
  #undef VFR
  #undef PIN
  #undef MX3
  #undef GAPA
  #undef GAPB
  #undef EX
  #undef VRD
  #undef KRD
  #undef STEP
  #undef QM
  #undef PM
  #undef ENDW
  { auto rr = __builtin_amdgcn_permlane32_swap(__float_as_uint(l_reg), __float_as_uint(l_reg), false, false); l_reg = __uint_as_float(rr[0]) + __uint_as_float(rr[1]); }
  if (hi == 0) wsf[32 + r32] = l_reg; asm volatile("s_waitcnt lgkmcnt(0)" ::: "memory");
  float rli[16];
  #pragma unroll
  for (int r = 0; r < 16; ++r) rli[r] = __builtin_amdgcn_rcpf(wsf[32 + crow(r, hi)]);
#if ATT_FP8
  unsigned char* Ow = (unsigned char*)Orow0 + (long)(wid * QBLK) * OP;
  { unsigned char* stg = (unsigned char*)(shm + LDS_OST) + wid * 2048;
    #pragma unroll
    for (int r = 0; r < 16; ++r) { const int orow = crow(r, hi);
      #pragma unroll
      for (int d0 = 0; d0 < 2; ++d0) { const float y = __builtin_amdgcn_fmed3f(o[d0][r] * (rli[r] * FP8_SO), -448.f, 448.f); stg[orow * 64 + d0 * 32 + r32] = (unsigned char)(__builtin_amdgcn_cvt_pk_fp8_f32(y, y, 0, false) & 0xff); } }
    asm volatile("s_waitcnt lgkmcnt(0)" ::: "memory");
    #pragma unroll
    for (int i = 0; i < 2; ++i) { const int row = i * 16 + (lane >> 2), ch = lane & 3; const u32x4 v = *(const u32x4*)(stg + row * 64 + ch * 16); *(u32x4*)(Ow + (long)row * OP + ch * 16) = v; } }
#else
  bf16_t* Ow = Orow0 + (long)(wid * QBLK) * OP;
  { bf16_t* stg = (bf16_t*)(shm + LDS_OST) + wid * 2048;
    #pragma unroll
    for (int r = 0; r < 16; ++r) { const int orow = crow(r, hi);
      #pragma unroll
      for (int d0 = 0; d0 < 2; ++d0) stg[orow * 64 + d0 * 32 + r32] = (bf16_t)f2bf(o[d0][r] * rli[r]); }
    asm volatile("s_waitcnt lgkmcnt(0)" ::: "memory");
    #pragma unroll
    for (int i = 0; i < 4; ++i) { const int row = i * 8 + (lane >> 3), ch = lane & 7; const u32x4 v = *(const u32x4*)(stg + row * 64 + ch * 8); *(u32x4*)(Ow + (long)row * OP + ch * 8) = v; } }
#endif
  asm volatile("s_waitcnt lgkmcnt(0)\n\ts_barrier" ::: "memory");
  #undef DMA_K
  #undef DMA_V
  #undef START
  #undef RESC
  #undef ROT
}
#undef SBAR
#undef WAIT_BAR
}

namespace attn8 {
constexpr int NW = 8, QBLK = 32, NSLOT = 5, SLOTB = 8192;
constexpr int LDS_WS = NSLOT * SLOTB, LDS_OST = LDS_WS + NW * 64 * 4, LDS_BYTES = LDS_OST + NW * 4096;
constexpr float C2 = attn_body::C2;
typedef int v8i __attribute__((ext_vector_type(8)));
typedef int v4i __attribute__((ext_vector_type(4)));
typedef __attribute__((address_space(3))) const char* lds_cptr;
#define SBAR() __builtin_amdgcn_sched_barrier(0)
#define WAIT_BAR(N) asm volatile("s_waitcnt vmcnt(" #N ") lgkmcnt(0)\n\ts_barrier" ::: "memory")
__device__ __forceinline__ void glds16s(const void* sbase, unsigned voff, unsigned lds_dst) { unsigned keep;
  asm volatile("s_mov_b32 %0, m0\n\ts_mov_b32 m0, %3\n\ts_nop 0\n\tglobal_load_lds_dwordx4 %1, %2\n\ts_mov_b32 m0, %0" : "=&s"(keep) : "v"(voff), "s"(sbase), "s"(lds_dst) : "memory"); }
__device__ __forceinline__ v8i frag32(lds_cptr p) { const v4i a = *(const LAS v4i*)(p), b = *(const LAS v4i*)(p + 1024); return (v8i){a[0], a[1], a[2], a[3], b[0], b[1], b[2], b[3]}; }
#define SC_K 0x7A7A7A7A
#define SC_Q 0x7A7A7A7A
#define SC_P 0x7A7A7A7A
static_assert(FP8_SK == 32.f && FP8_SV == 32.f && FP8_SQ == 32.f, "scale operands");

__device__ __forceinline__ void attn_unit8(const bf16_t* Qrow0, int QP, const unsigned char* __restrict__ kv8, int NT, unsigned char* Orow0, int OP, char* shm, const int tid, const float mfix,
                                           const float* qn, const float* ropec, const float* ropes, const int rope, const int tq0) {
  const int lane = tid & 63, r32 = lane & 31, hi = lane >> 5; const int wid = __builtin_amdgcn_readfirstlane(tid >> 6);
  const bf16_t* Qw = Qrow0 + (long)(wid * QBLK) * QP;
  const unsigned lds0 = (unsigned)(uintptr_t)shm;
  const unsigned voff = (unsigned)tid * 16u; const unsigned dstw = lds0 + wid * 1024;
  #define DMA(u, slotoff) glds16s(kv8 + (size_t)(u) * 8192, voff, (unsigned)__builtin_amdgcn_readfirstlane(dstw + (slotoff)))
  const lds_cptr shm3 = (lds_cptr)shm; const lds_cptr kp0 = shm3 + hi * 2048 + r32 * 16; const lds_cptr vp0 = kp0 + 4096;
  DMA(0, 0); DMA(1, SLOTB); DMA(2, 2 * SLOTB);
  v8i qf;
  {
    bf16x8 qr[4];
    #pragma unroll
    for (int d0 = 0; d0 < 4; ++d0) qr[d0] = *reinterpret_cast<const bf16x8*>(&Qw[(long)r32 * QP + d0 * 16 + hi * 8]);
    float x[4][8];
    #pragma unroll
    for (int d0 = 0; d0 < 4; ++d0) { const u32x4 u = __builtin_bit_cast(u32x4, qr[d0]);
      x[d0][0] = bf_lo(u.x); x[d0][1] = bf_hi(u.x); x[d0][2] = bf_lo(u.y); x[d0][3] = bf_hi(u.y); x[d0][4] = bf_lo(u.z); x[d0][5] = bf_hi(u.z); x[d0][6] = bf_lo(u.w); x[d0][7] = bf_hi(u.w); }
    float ss = 0.f;
    #pragma unroll
    for (int d0 = 0; d0 < 4; ++d0)
      #pragma unroll
      for (int t = 0; t < 8; ++t) ss += x[d0][t] * x[d0][t];
    { auto rr = __builtin_amdgcn_permlane32_swap(__float_as_uint(ss), __float_as_uint(ss), false, false); ss = __uint_as_float(rr[0]) + __uint_as_float(rr[1]); }
    const float rstd = rsqrtf(ss * (1.f / 64.f) + NORM_EPS) * (C2 * FP8_SQ);
    #pragma unroll
    for (int d0 = 0; d0 < 4; ++d0) { const f32x4 g0 = *(const f32x4*)(qn + 16 * d0 + 8 * hi), g1 = *(const f32x4*)(qn + 16 * d0 + 8 * hi + 4);
      x[d0][0] *= rstd * g0.x; x[d0][1] *= rstd * g0.y; x[d0][2] *= rstd * g0.z; x[d0][3] *= rstd * g0.w; x[d0][4] *= rstd * g1.x; x[d0][5] *= rstd * g1.y; x[d0][6] *= rstd * g1.z; x[d0][7] *= rstd * g1.w; }
    if (rope) { const int tq = tq0 + wid * QBLK + r32;
      #pragma unroll
      for (int d0 = 0; d0 < 2; ++d0) { const float* cp = ropec + (long)tq * 32 + 16 * d0 + 8 * hi; const float* sp = ropes + (long)tq * 32 + 16 * d0 + 8 * hi;
        const f32x4 c0 = *(const f32x4*)cp, c1 = *(const f32x4*)(cp + 4), s0 = *(const f32x4*)sp, s1 = *(const f32x4*)(sp + 4);
        const float cs[8] = {c0.x, c0.y, c0.z, c0.w, c1.x, c1.y, c1.z, c1.w}, sn[8] = {s0.x, s0.y, s0.z, s0.w, s1.x, s1.y, s1.z, s1.w};
        #pragma unroll
        for (int t = 0; t < 8; ++t) { const float a = x[d0][t], c = x[d0 + 2][t]; x[d0][t] = a * cs[t] - c * sn[t]; x[d0 + 2][t] = a * sn[t] + c * cs[t]; } } }
    #pragma unroll
    for (int d0 = 0; d0 < 4; ++d0) { qf[2 * d0] = (int)pk_fp8x4(x[d0][0], x[d0][1], x[d0][2], x[d0][3]); qf[2 * d0 + 1] = (int)pk_fp8x4(x[d0][4], x[d0][5], x[d0][6], x[d0][7]); }
  }
  const float extra = __int_as_float(__builtin_amdgcn_readfirstlane(__float_as_int(fmaxf(mfix - 19.5f, 0.f)))); const bool hasx = extra > 0.f;
  f32x16 o[2], ls; o[0] = f32x16{}; o[1] = f32x16{}; ls = f32x16{};
  v8i ones;
  { int one_; asm volatile("v_mov_b32 %0, 0x38383838" : "=v"(one_));
    #pragma unroll
    for (int i = 0; i < 8; ++i) ones[i] = one_;
    asm volatile("" : "+v"(ones)); }
  int sck = SC_K; asm volatile("" : "+v"(sck));
  f32x16 pA0, pA1, pB0, pB1; v8i kf0, kf1;
  #define QK(C0, C1) do { asm volatile("v_mfma_scale_f32_32x32x64_f8f6f4 %0, %1, %2, -4.0, %3, %3 op_sel_hi:[0,0,0]" : "=v"(C0) : "v"(kf0), "v"(qf), "v"(sck)); \
                          asm volatile("v_mfma_scale_f32_32x32x64_f8f6f4 %0, %1, %2, -4.0, %3, %3 op_sel_hi:[0,0,0]" : "=v"(C1) : "v"(kf1), "v"(qf), "v"(sck)); } while (0)
  #define EXPS(C0, C1, X) do { if ((X) == 1 || ((X) == 2 && hasx)) { _Pragma("unroll") for (int r = 0; r < 16; ++r) { C0[r] -= extra; C1[r] -= extra; } }       \
      _Pragma("unroll") for (int r = 0; r < 16; ++r) { C0[r] = __builtin_amdgcn_exp2f(C0[r]); C1[r] = __builtin_amdgcn_exp2f(C1[r]); } } while (0)
  #define KLOAD(slot) do { kf0 = frag32(kp0 + (slot)); kf1 = frag32(kp0 + (slot) + 512); } while (0)
  #define PK4(a, b, c, d) __builtin_amdgcn_perm(__builtin_bit_cast(unsigned, __builtin_amdgcn_cvt_pkrtz((c), (d))), __builtin_bit_cast(unsigned, __builtin_amdgcn_cvt_pkrtz((a), (b))), 0x07050301u)
  #define PACK(P0, P1) do { \
      _Pragma("unroll") for (int j = 0; j < 4; ++j) { p8[j] = (int)PK4(P0[4 * j], P0[4 * j + 1], P0[4 * j + 2], P0[4 * j + 3]); p8[4 + j] = (int)PK4(P1[4 * j], P1[4 * j + 1], P1[4 * j + 2], P1[4 * j + 3]); } } while (0)
  #define PV(vf0, vf1) do { o[0] = __builtin_amdgcn_mfma_scale_f32_32x32x64_f8f6f4(p8, vf0, o[0], 1, 0, 0, SC_P, 0, SC_K); o[1] = __builtin_amdgcn_mfma_scale_f32_32x32x64_f8f6f4(p8, vf1, o[1], 1, 0, 0, SC_P, 0, SC_K); \
      ls = __builtin_amdgcn_mfma_scale_f32_32x32x64_f8f6f4(p8, ones, ls, 1, 0, 0, SC_P, 0, SC_P); } while (0)
  int s_v = 0, s_k = 2 * SLOTB, s_d = 4 * SLOTB;
  #define ADV(sv) sv = ((sv) == (NSLOT - 1) * SLOTB) ? 0 : (sv) + SLOTB
  WAIT_BAR(2);
  KLOAD(0);
  DMA(3, 3 * SLOTB);
  QK(pA0, pA1); asm volatile("s_nop 15\n\ts_nop 15\n\ts_nop 15\n\ts_nop 15\n\ts_nop 15\n\ts_nop 15\n\ts_nop 15\n\ts_nop 15\n\ts_nop 15" : "+v"(pA0), "+v"(pA1));
  EXPS(pA0, pA1, 2);
  WAIT_BAR(1);
  KLOAD(SLOTB);
  v8i p8 = {0, 0, 0, 0, 0, 0, 0, 0};
  #define STEP(C0, C1, P0, P1, t, GD, GL, X) do { SBAR(); \
    QK(C0, C1); SBAR(); \
    const v8i vf0_ = frag32(vp0 + s_v), vf1_ = frag32(vp0 + s_v + 512);       \
    PACK(P0, P1); \
    if (GD) { DMA((t) + 3, s_d); } \
    SBAR(); \
    PV(vf0_, vf1_); SBAR(); \
    EXPS(C0, C1, X); \
    if (GL) { KLOAD(s_k); } \
    ADV(s_v); ADV(s_k); ADV(s_d); SBAR(); } while (0)
  int t = 1;
  if (!hasx) {
    for (; t + 4 < NT; t += 2) {
      STEP(pB0, pB1, pA0, pA1, t, true, true, 0);     WAIT_BAR(1);
      STEP(pA0, pA1, pB0, pB1, t + 1, true, true, 0); WAIT_BAR(1);
    }
  } else {
    for (; t + 4 < NT; t += 2) {
      STEP(pB0, pB1, pA0, pA1, t, true, true, 1);     WAIT_BAR(1);
      STEP(pA0, pA1, pB0, pB1, t + 1, true, true, 1); WAIT_BAR(1);
    }
  }
  #define ENDW(tt) do { if ((tt) + 3 < NT) { WAIT_BAR(1); } else { WAIT_BAR(0); } } while (0)
  for (; t + 1 < NT; t += 2) {
    STEP(pB0, pB1, pA0, pA1, t, (t + 3 < NT), (t + 1 < NT), 2);         ENDW(t);
    STEP(pA0, pA1, pB0, pB1, t + 1, (t + 4 < NT), (t + 2 < NT), 2);     ENDW(t + 1);
  }
  STEP(pB0, pB1, pA0, pA1, NT - 1, false, false, 2);
  { const v8i vf0_ = frag32(vp0 + s_v), vf1_ = frag32(vp0 + s_v + 512); PACK(pB0, pB1); SBAR(); PV(vf0_, vf1_); }
  #undef STEP
  #undef ENDW
  #undef QK
  #undef EXPS
  #undef KLOAD
  #undef PACK
  #undef PK4
  #undef PV
  #undef ADV
  float rli[16];
  #pragma unroll
  for (int r = 0; r < 16; ++r) rli[r] = __builtin_amdgcn_rcpf(ls[r]);
  unsigned char* Ow = Orow0 + (long)(wid * QBLK) * OP;
  { unsigned char* stg = (unsigned char*)(shm + LDS_OST) + wid * 2048;
    #pragma unroll
    for (int r = 0; r < 16; ++r) { const int orow = attn_body::crow(r, hi);
      #pragma unroll
      for (int d0 = 0; d0 < 2; ++d0) { const float y = __builtin_amdgcn_fmed3f(o[d0][r] * (rli[r] * (FP8_SO * (1.f / 32.f))), -448.f, 448.f); stg[orow * 64 + d0 * 32 + r32] = (unsigned char)(__builtin_amdgcn_cvt_pk_fp8_f32(y, y, 0, false) & 0xff); } }
    asm volatile("s_waitcnt lgkmcnt(0)" ::: "memory");
    #pragma unroll
    for (int i = 0; i < 2; ++i) { const int row = i * 16 + (lane >> 2), ch = lane & 3; const u32x4 v = *(const u32x4*)(stg + row * 64 + ch * 16); *(u32x4*)(Ow + (long)row * OP + ch * 16) = v; } }
  asm volatile("s_waitcnt lgkmcnt(0)\n\ts_barrier" ::: "memory");
  #undef DMA
}
#undef SBAR
#undef WAIT_BAR
#undef SC_K
#undef SC_Q
#undef SC_P
}
struct Frame {
    LAS unsigned char* lds;
    int tid, lane, wave;
    int vcu, G, gw, NGW, bid;
    unsigned char* ws; const unsigned long long* inq;
};

template <bool F8 = false>
__device__ __forceinline__ void transpose_item(const float* W, int ldw, int K, bf16_t* WT, int k0, int n0, int dst_row0, LAS float* scr, int lane) {
    float tv[32];
#pragma unroll
    for (int i = 0; i < 32; ++i) tv[i] = W[(size_t)(k0 + 2 * i + (lane >> 5)) * ldw + n0 + (lane & 31)];
#pragma unroll
    for (int i = 0; i < 32; ++i) scr[(2 * i + (lane >> 5)) * 33 + (lane & 31)] = tv[i];
    LDS_WAIT(); asm volatile("" ::: "memory");
    const int c = lane & 7;
#pragma unroll
    for (int j = 0; j < 4; ++j) { const int n = (lane >> 3) + 8 * j; const LAS float* s = scr + (8 * c) * 33 + n;
        if (F8) { u32x2 o; o.x = pk_fp8x4(s[0 * 33] * FP8_SW, s[1 * 33] * FP8_SW, s[2 * 33] * FP8_SW, s[3 * 33] * FP8_SW); o.y = pk_fp8x4(s[4 * 33] * FP8_SW, s[5 * 33] * FP8_SW, s[6 * 33] * FP8_SW, s[7 * 33] * FP8_SW);
            *(u32x2*)((unsigned char*)WT + (size_t)(dst_row0 + n) * K + k0 + 8 * c) = o; }
        else { u32x4 o; o.x = pk2(s[0 * 33], s[1 * 33]); o.y = pk2(s[2 * 33], s[3 * 33]); o.z = pk2(s[4 * 33], s[5 * 33]); o.w = pk2(s[6 * 33], s[7 * 33]);
            *(u32x4*)(WT + (size_t)(dst_row0 + n) * K + k0 + 8 * c) = o; } }
    LDS_WAIT(); asm volatile("" ::: "memory");
}

__device__ __forceinline__ void sincos_acc(float x, float& s, float& c) {
    const float k = rintf(x * 0.63661977236758134f);
    float r = fmaf(k, -1.5703125f, x); r = fmaf(k, -4.837512969970703125e-4f, r); r = fmaf(k, -7.54978995489188e-8f, r);
    const float z = r * r;
    const float sp = r + r * z * fmaf(z, fmaf(z, -1.9515295891e-4f, 8.3321608736e-3f), -1.6666654611e-1f);
    const float cp = fmaf(z * z, fmaf(z, fmaf(z, 2.443315711809948e-5f, -1.388731625493765e-3f), 4.166664568298827e-2f), fmaf(z, -0.5f, 1.0f));
    const int q = ((int)k) & 3;
    const float ss = (q & 1) ? cp : sp, cc = (q & 1) ? sp : cp;
    s = (q & 2) ? -ss : ss; c = ((q + 1) & 2) ? -cc : cc;
}

__device__ __forceinline__ void modv_pass(Frame& F, const float* c_lat, const float* c_ctx, const float* w_mod, const float* b_mod, unsigned char* ws, const int l0, const int l1) {
    LAS float* sil = (LAS float*)F.lds;
    for (int i = F.tid; i < NMI * D; i += NTHREADS) { const int mi = i >> 10, k = i & 1023; const float v = (mi < NB) ? c_lat[mi * D + k] : c_ctx[k]; sil[i] = silu_f(v); }
    __syncthreads();
    {
        float* modv = (float*)(ws + WS_MODV);
        const int NT16 = 6 * D / 16;
        for (int task = F.gw; task < (l1 - l0) * NT16; task += F.NGW) {
            const int layer = l0 + task / NT16, j0 = (task % NT16) * 16, jj = F.lane & 15, kq = F.lane >> 4;
            const float* wp = w_mod + (size_t)layer * D * 6 * D + j0 + jj;
            float acc[NMI];
#pragma unroll
            for (int m = 0; m < NMI; ++m) acc[m] = 0.f;
            for (int k0 = 16 * kq; k0 < D; k0 += 64) {
                float wv[16];
#pragma unroll
                for (int u = 0; u < 16; ++u) wv[u] = wp[(size_t)(k0 + u) * 6 * D];
                { const LAS f32x4* sp = (const LAS f32x4*)(sil + k0); f32x4 sc[4], sn[4];
#pragma unroll
                  for (int q = 0; q < 4; ++q) sc[q] = sp[q];
#pragma unroll
                  for (int m = 0; m < NMI; ++m) {
                      if (m + 1 < NMI) {
#pragma unroll
                          for (int q = 0; q < 4; ++q) sn[q] = sp[(m + 1) * (D / 4) + q]; }
                      float a = acc[m];
#pragma unroll
                      for (int q = 0; q < 4; ++q) { a = fmaf(sc[q].x, wv[4 * q], a); a = fmaf(sc[q].y, wv[4 * q + 1], a); a = fmaf(sc[q].z, wv[4 * q + 2], a); a = fmaf(sc[q].w, wv[4 * q + 3], a); }
                      acc[m] = a; asm volatile("" ::: "memory");
#pragma unroll
                      for (int q = 0; q < 4; ++q) sc[q] = sn[q]; } } }
#pragma unroll
            for (int m = 0; m < NMI; ++m) { float v = acc[m]; v += shfl_xor_l(v, 16, F.lane); v += shfl_xor_l(v, 32, F.lane); acc[m] = v; }
            if (kq == 0) { const float bb = b_mod[layer * 6 * D + j0 + jj];
#pragma unroll
                for (int m = 0; m < NMI; ++m) modv[((size_t)layer * NMI + m) * 6 * D + j0 + jj] = acc[m] + bb; }
        }
    }
    __syncthreads();
}

__device__ __forceinline__ void p0_prologue(Frame& F, const float* const* in, unsigned char* ws) {
    modv_pass(F, in[1], in[3], in[4], in[5], ws, 0, DEPTH);
    {
        LAS float* scr = (LAS float*)(F.lds) + F.wave * (64 * 33);
        constexpr int I_MI = 16 * 96, I_MO = 16 * 32, I_AI = 16 * 48, I_AO = 16 * 32;
        constexpr int PER_J = I_MI + I_MO + I_AI + I_AO;
        for (int it = F.gw; it < 2 * PER_J; it += F.NGW) {
            const int j = it / PER_J; int r = it % PER_J;
            if (r < I_MI) { const int kb = r / 96, nb = r % 96; transpose_item<MLS_FP8_IN != 0>(in[8] + (size_t)j * D * MW_IN, MW_IN, D, (bf16_t*)(ws + WS_WMI + (size_t)j * 3072 * D * (MLS_FP8_IN ? 1 : 2)), 64 * kb, 32 * nb, 32 * nb, scr, F.lane); continue; } r -= I_MI;
            if (r < I_MO) { const int kb = r / 32, nb = r % 32; transpose_item<MLS_FP8_OUT != 0>(in[11] + (size_t)j * D * D, D, D, (bf16_t*)(ws + WS_WMO + (size_t)j * D * D * (MLS_FP8_OUT ? 1 : 2)), 64 * kb, 32 * nb, 32 * nb, scr, F.lane); continue; } r -= I_MO;
            if (r < I_AI) { const int kb = r / 48, nb = r % 48; transpose_item<ATT_FP8 != 0>(in[12] + (size_t)j * D * 1536, 1536, D, (bf16_t*)(ws + WS_WAI + (size_t)j * 1536 * D * (ATT_FP8 ? 1 : 2)), 64 * kb, 32 * nb, 32 * nb, scr, F.lane); continue; } r -= I_AI;
            { const int kb = r / 32, nb = r % 32; transpose_item<ATT_FP8 != 0>(in[15] + (size_t)j * D * D, D, D, (bf16_t*)(ws + WS_WAO + (size_t)j * D * D * (ATT_FP8 ? 1 : 2)), 64 * kb, 32 * nb, 32 * nb, scr, F.lane); }
        }
    }
    {
        float* rc = (float*)(ws + WS_ROPE); float* rs = rc + SEQ * 32;
        for (int i = F.bid * NTHREADS + F.tid; i < SEQ * 32; i += F.G * NTHREADS) {
            const int t = i >> 5, p = i & 31; const float pos = (p < 16) ? (float)(t >> 6) : (float)(t & 63);
            const float inv = exp2f(-(float)(p & 15) * (13.287712379549449f / 16.f));
            float s, c; sincos_acc(pos * inv, s, c); rc[i] = c; rs[i] = s; }
    }
    __syncthreads();
}

__device__ __forceinline__ void moe_weights(Frame& F, const float* wg, const float* wu, const float* wd, unsigned char* ws, unsigned* counter, const int parts) {
    LAS float* T = (LAS float*)F.lds;
    volatile LAS int* slot = (volatile LAS int*)(F.lds + 65536 + 256);
    const int lane = F.lane, w = F.wave, tid = F.tid;
    bf16_t* W1 = (bf16_t*)(ws + WS_W1); bf16_t* W2 = (bf16_t*)(ws + WS_W2);
    unsigned char* W1b = (unsigned char*)(ws + WS_W1); unsigned char* W2b = (unsigned char*)(ws + WS_W2);
    constexpr int NIT = NE * 3 * 16 * 4, NA = NE * 2 * 64;
#define MW_E(it_) ((it_) < NA ? (it_) / 128 : ((it_) - NA) / 64)
#define MW_WHICH(it_) ((it_) < NA ? ((it_) % 128) / 64 : 2)
#define MW_REST(it_) ((it_) % 64)
#define MW_SRC(it_) ((MW_WHICH(it_) == 0 ? wg : (MW_WHICH(it_) == 1 ? wu : wd)) + (size_t)MW_E(it_) * D * D + (size_t)(64 * (MW_REST(it_) >> 2)) * D + 256 * (MW_REST(it_) & 3))
#define MW_FETCH(dst) do { int id_ = NIT; if (parts & 1) { const int a_ = (int)__hip_atomic_fetch_add(counter, 1u, __ATOMIC_RELAXED, __HIP_MEMORY_SCOPE_AGENT); if (a_ < NA) id_ = a_; } \
        if (id_ == NIT && (parts & 2)) { const int b_ = (int)__hip_atomic_fetch_add(counter + 16, 1u, __ATOMIC_RELAXED, __HIP_MEMORY_SCOPE_AGENT); if (b_ < NIT - NA) id_ = NA + b_; } dst = id_; } while (0)
    __syncthreads();
    int pend = NIT;
    if (tid == 0) { int f0; MW_FETCH(f0); slot[0] = f0; MW_FETCH(pend); }
    __syncthreads();
    int it = slot[0];
    f32x4 v[8];
    if (it < NIT) { const float* src = MW_SRC(it);
#pragma unroll
        for (int i = 0; i < 8; ++i) v[i] = *(const f32x4*)(src + (size_t)(8 * w + i) * D + 4 * lane); }
    while (it < NIT) {
        if (tid == 0) { slot[1] = pend; MW_FETCH(pend); }
        __syncthreads();
#pragma unroll
        for (int i = 0; i < 8; ++i) *(LAS f32x4*)(T + (8 * w + i) * 256 + ((4 * lane) ^ (8 * (w & 3)))) = v[i];
        const int nx = slot[1];
        if (nx < NIT) { const float* src = MW_SRC(nx);
#pragma unroll
            for (int i = 0; i < 8; ++i) v[i] = *(const f32x4*)(src + (size_t)(8 * w + i) * D + 4 * lane); }
        __syncthreads();
        const int e = MW_E(it), which = MW_WHICH(it), kb = MW_REST(it) >> 2, nq = MW_REST(it) & 3;
        const int nl = lane & 7, c = lane >> 3;
        bf16_t* base = (which == 2) ? (W2 + (size_t)e * D * D) : (W1 + (size_t)e * 2048 * D);
#pragma unroll
        for (int j = 0; j < 4; ++j) { const int n = 32 * w + 8 * j + nl; const LAS float* tp = T + (8 * c) * 256 + (n ^ (8 * (c & 3)));
            float t[8];
#pragma unroll
            for (int i = 0; i < 8; ++i) t[i] = tp[i * 256];
            const int ng = 256 * nq + n; const int drow = (which == 2) ? ng : (256 * (ng >> 7) + (which == 1 ? 128 : 0) + (ng & 127));
            const bool f8 = (which == 2) ? (MOE_FP8_2 != 0) : (MOE_FP8_1 != 0);
            if (f8) { u32x2 o; o.x = pk_fp8x4(t[0] * FP8_SW, t[1] * FP8_SW, t[2] * FP8_SW, t[3] * FP8_SW); o.y = pk_fp8x4(t[4] * FP8_SW, t[5] * FP8_SW, t[6] * FP8_SW, t[7] * FP8_SW);
                unsigned char* b8 = (which == 2) ? (W2b + (size_t)e * D * D) : (W1b + (size_t)e * 2048 * D);
                *(u32x2*)(b8 + (size_t)drow * D + 64 * kb + 8 * c) = o; }
            else { u32x4 o; o.x = pk2(t[0], t[1]); o.y = pk2(t[2], t[3]); o.z = pk2(t[4], t[5]); o.w = pk2(t[6], t[7]);
                *(u32x4*)(base + (size_t)drow * D + 64 * kb + 8 * c) = o; } }
        it = nx;
    }
#undef MW_SRC
#undef MW_E
#undef MW_WHICH
#undef MW_REST
#undef MW_FETCH
    __syncthreads();
}

__device__ __forceinline__ void load_w16(Frame& F, const float* W16, int ldw16) {
    LAS float* wl = (LAS float*)F.lds;
    for (int i = F.tid; i < D * 16; i += NTHREADS) { const int c = i >> 4, e = i & 15; const int l = (c & 255) >> 2, q = (c & 3) + 4 * (c >> 8);
        wl[(q * 64 + l) * 20 + e] = W16[(size_t)c * ldw16 + e]; }
    __syncthreads();
}
template <int MODE, bool F8 = false>
__device__ __forceinline__ void norm_core(LAS float* wl, const int lane, f32x4 (&v)[4], const int r, const f32x4 (&gv)[4], const float* shp, const float* scp, bf16_t* H, const float* bias16, float* out16) {
    float ss = 0.f;
#pragma unroll
    for (int j = 0; j < 4; ++j) ss += (v[j].x * v[j].x + v[j].y * v[j].y) + (v[j].z * v[j].z + v[j].w * v[j].w);
    const float rstd = rsqrtf(wave_sum(ss) * (1.f / D) + NORM_EPS);
    unsigned long long* o8 = (unsigned long long*)(H + (size_t)r * D) + lane;
#pragma unroll
    for (int j = 0; j < 4; ++j) { const f32x4 sh = *(const f32x4*)(shp + 4 * lane + 256 * j), sc = *(const f32x4*)(scp + 4 * lane + 256 * j);
        v[j] = (v[j] * rstd * gv[j]) * (sc + 1.f) + sh;
        if (F8) ((unsigned*)((unsigned char*)H + (size_t)r * D))[lane + 64 * j] = pk_fp8x4(v[j].x * FP8_SH, v[j].y * FP8_SH, v[j].z * FP8_SH, v[j].w * FP8_SH);
        else o8[64 * j] = (unsigned long long)pk2(v[j].x, v[j].y) | ((unsigned long long)pk2(v[j].z, v[j].w) << 32); }
    if (MODE != 0) {
        float p[16];
#pragma unroll
        for (int e = 0; e < 16; ++e) p[e] = 0.f;
#pragma unroll
        for (int j = 0; j < 4; ++j) {
            f32x4 wq[4][4];
#pragma unroll
            for (int i = 0; i < 4; ++i) { const LAS f32x4* wp = (const LAS f32x4*)(wl + ((4 * j + i) * 64 + lane) * 20);
#pragma unroll
                for (int e4 = 0; e4 < 4; ++e4) wq[i][e4] = wp[e4]; }
            asm volatile("s_waitcnt lgkmcnt(0)" ::: "memory"); __builtin_amdgcn_sched_barrier(0);
#pragma unroll
            for (int i = 0; i < 4; ++i) { const float xv = v[j][i];
#pragma unroll
                for (int e4 = 0; e4 < 4; ++e4) { const f32x4 w = wq[i][e4]; p[4 * e4 + 0] = fmaf(xv, w.x, p[4 * e4 + 0]); p[4 * e4 + 1] = fmaf(xv, w.y, p[4 * e4 + 1]); p[4 * e4 + 2] = fmaf(xv, w.z, p[4 * e4 + 2]); p[4 * e4 + 3] = fmaf(xv, w.w, p[4 * e4 + 3]); } }
            __builtin_amdgcn_sched_barrier(0);
        }
        float q8[8], q4[4], q2[2], q1;
        { const bool up = (lane & 32) != 0;
#pragma unroll
          for (int i = 0; i < 8; ++i) { const float send = up ? p[i] : p[i + 8]; const float recv = __shfl_xor(send, 32); q8[i] = (up ? p[i + 8] : p[i]) + recv; } }
        { const bool up = (lane & 16) != 0;
#pragma unroll
          for (int i = 0; i < 4; ++i) { const float send = up ? q8[i] : q8[i + 4]; const float recv = __shfl_xor(send, 16); q4[i] = (up ? q8[i + 4] : q8[i]) + recv; } }
        { const bool up = (lane & 8) != 0;
#pragma unroll
          for (int i = 0; i < 2; ++i) { const float send = up ? q4[i] : q4[i + 2]; const float recv = __shfl_xor(send, 8); q2[i] = (up ? q4[i + 2] : q4[i]) + recv; } }
        { const bool up = (lane & 4) != 0; const float send = up ? q2[0] : q2[1]; const float recv = __shfl_xor(send, 4); q1 = (up ? q2[1] : q2[0]) + recv; }
        q1 = quad_sum(q1);
        const int e = ((lane >> 5) & 1) * 8 + ((lane >> 4) & 1) * 4 + ((lane >> 3) & 1) * 2 + ((lane >> 2) & 1);
        if (MODE == 1) {
            float g = q1 + bias16[e];
            g = 15.f * tanhf(g * (1.f / 15.f));
            const int gate = e >> 2;
            if (gate & 1) g = fminf(g, 0.f) - log1pf(__expf(-fabsf(g)));
            if ((lane & 3) == 0) out16[(size_t)r * 16 + e] = g;
        } else {
            float mx = q1;
#pragma unroll
            for (int o = 4; o < 64; o <<= 1) mx = fmaxf(mx, __shfl_xor(mx, o));
            const float ex = __expf(q1 - mx); float sm = ex;
#pragma unroll
            for (int o = 4; o < 64; o <<= 1) sm += __shfl_xor(sm, o);
            if ((lane & 3) == 0) out16[(size_t)e * RT + r] = ex / sm;
        }
    }
}
__device__ __forceinline__ float swap32_add(float a, float b) { auto r = __builtin_amdgcn_permlane32_swap(__float_as_uint(a), __float_as_uint(b), false, false); return __uint_as_float(r[0]) + __uint_as_float(r[1]); }
__device__ __forceinline__ float swap16_add(float a, float b) { auto r = __builtin_amdgcn_permlane16_swap(__float_as_uint(a), __float_as_uint(b), false, false); return __uint_as_float(r[0]) + __uint_as_float(r[1]); }
template <int MODE, bool F8 = false, bool X16SRC = false>
__device__ __forceinline__ void norm_pass(Frame& F, const float* xL, const float* xC  , int nrows, const float* gain, const float* shiftv, const float* scalev  ,
                                          bf16_t* H, const float* W16, int ldw16, const float* bias16, float* out16) {
    LAS float* wl = (LAS float*)F.lds;
    if (MODE != 0) load_w16(F, W16, ldw16);
    const int lane = F.lane;
    f32x4 gv[4];
#pragma unroll
    for (int j = 0; j < 4; ++j) gv[j] = *(const f32x4*)(gain + 4 * lane + 256 * j);
    const int per = (((nrows + F.NGW - 1) / F.NGW) + 1) & ~1; const int r0 = F.gw * per, r1 = (r0 + per < nrows) ? r0 + per : nrows;
#define NP_XPTR(rr) (((rr) >= RL) ? (xC + (size_t)((rr) - RL) * D) : (xL + (size_t)(rr) * D))
#define NP_LOADROW(dst, rr) do { if (X16SRC) { const u32x2* xp_ = (const u32x2*)((const bf16_t*)xL + (size_t)(rr) * D) + lane; _Pragma("unroll") for (int j = 0; j < 4; ++j) { const u32x2 t_ = xp_[64 * j]; dst[j] = (f32x4){bf_lo(t_.x), bf_hi(t_.x), bf_lo(t_.y), bf_hi(t_.y)}; } } \
        else { const float* xr_ = NP_XPTR(rr); _Pragma("unroll") for (int j = 0; j < 4; ++j) dst[j] = *(const f32x4*)(xr_ + 4 * lane + 256 * j); } } while (0)
    f32x4 vn[2][4];
    if (r0 < r1) { NP_LOADROW(vn[0], r0); NP_LOADROW(vn[1], r0 + 1); }
    for (int r = r0; r < r1; r += 2) {
        asm volatile("" ::: "memory");
        f32x4 v[2][4];
#pragma unroll
        for (int q = 0; q < 2; ++q)
#pragma unroll
            for (int j = 0; j < 4; ++j) v[q][j] = vn[q][j];
        if (r + 2 < r1) { NP_LOADROW(vn[0], r + 2); NP_LOADROW(vn[1], r + 3); }
        float ss[2];
#pragma unroll
        for (int q = 0; q < 2; ++q) { ss[q] = 0.f;
#pragma unroll
            for (int j = 0; j < 4; ++j) ss[q] += (v[q][j].x * v[q][j].x + v[q][j].y * v[q][j].y) + (v[q][j].z * v[q][j].z + v[q][j].w * v[q][j].w); }
        ss[0] = row16_sum(ss[0]); ss[1] = row16_sum(ss[1]);
        const float tot0 = (rdlane(ss[0], 0) + rdlane(ss[0], 16)) + (rdlane(ss[0], 32) + rdlane(ss[0], 48)), tot1 = (rdlane(ss[1], 0) + rdlane(ss[1], 16)) + (rdlane(ss[1], 32) + rdlane(ss[1], 48));
        const float rstd[2] = {rsqrtf(tot0 * (1.f / D) + NORM_EPS), rsqrtf(tot1 * (1.f / D) + NORM_EPS)};
#pragma unroll
        for (int q = 0; q < 2; ++q) { const int rr = r + q; const int mi = (rr >= RL) ? NB : (rr >> 12);
            const float* shp = shiftv + (size_t)mi * 6 * D; const float* scp = scalev + (size_t)mi * 6 * D;
#pragma unroll
            for (int j = 0; j < 4; ++j) { const f32x4 sh = *(const f32x4*)(shp + 4 * lane + 256 * j), sc = *(const f32x4*)(scp + 4 * lane + 256 * j);
                v[q][j] = (v[q][j] * rstd[q] * gv[j]) * (sc + 1.f) + sh;
                if (F8) ((unsigned*)((unsigned char*)H + (size_t)rr * D))[lane + 64 * j] = pk_fp8x4(v[q][j].x * FP8_SH, v[q][j].y * FP8_SH, v[q][j].z * FP8_SH, v[q][j].w * FP8_SH);
                else ((unsigned long long*)(H + (size_t)rr * D))[lane + 64 * j] = (unsigned long long)pk2(v[q][j].x, v[q][j].y) | ((unsigned long long)pk2(v[q][j].z, v[q][j].w) << 32); } }
        if (MODE != 0) {
            f32x2 p2[2][8];
#pragma unroll
            for (int q = 0; q < 2; ++q)
#pragma unroll
                for (int e = 0; e < 8; ++e) p2[q][e] = (f32x2){0.f, 0.f};
#pragma unroll
            for (int j = 0; j < 4; ++j) {
                f32x4 wq[4][4];
#pragma unroll
                for (int i = 0; i < 4; ++i) { const LAS f32x4* wp = (const LAS f32x4*)(wl + ((4 * j + i) * 64 + lane) * 20);
#pragma unroll
                    for (int e4 = 0; e4 < 4; ++e4) wq[i][e4] = wp[e4]; }
                asm volatile("s_waitcnt lgkmcnt(0)" ::: "memory"); __builtin_amdgcn_sched_barrier(0);
#pragma unroll
                for (int i = 0; i < 4; ++i)
#pragma unroll
                    for (int q = 0; q < 2; ++q) { const float xv = v[q][j][i]; const f32x2 x2 = {xv, xv};
#pragma unroll
                        for (int e4 = 0; e4 < 4; ++e4) { const f32x4 w = wq[i][e4];
                            p2[q][2 * e4 + 0] = __builtin_elementwise_fma(x2, (f32x2){w.x, w.y}, p2[q][2 * e4 + 0]);
                            p2[q][2 * e4 + 1] = __builtin_elementwise_fma(x2, (f32x2){w.z, w.w}, p2[q][2 * e4 + 1]); } }
                __builtin_amdgcn_sched_barrier(0);
            }
            float p[2][16];
#pragma unroll
            for (int q = 0; q < 2; ++q)
#pragma unroll
                for (int e = 0; e < 8; ++e) { p[q][2 * e] = p2[q][e].x; p[q][2 * e + 1] = p2[q][e].y; }
            float q16[16], q8[8], q4[4], q2[2], q1;
#pragma unroll
            for (int e = 0; e < 16; ++e) q16[e] = swap32_add(p[0][e], p[1][e]);
#pragma unroll
            for (int i = 0; i < 8; ++i) q8[i] = swap16_add(q16[i], q16[i + 8]);
            { const bool up = (lane & 8) != 0;
#pragma unroll
              for (int i = 0; i < 4; ++i) { const float send = up ? q8[i] : q8[i + 4]; const float recv = __shfl_xor(send, 8); q4[i] = (up ? q8[i + 4] : q8[i]) + recv; } }
            { const bool up = (lane & 4) != 0;
#pragma unroll
              for (int i = 0; i < 2; ++i) { const float send = up ? q4[i] : q4[i + 2]; const float recv = __shfl_xor(send, 4); q2[i] = (up ? q4[i + 2] : q4[i]) + recv; } }
            { const bool up = (lane & 2) != 0; const float send = up ? q2[0] : q2[1]; const float recv = dpp_f<0x4E>(0.f, send); q1 = (up ? q2[1] : q2[0]) + recv; }
            q1 += dpp_f<0xB1>(0.f, q1);
            const int e = ((lane >> 4) & 1) * 8 + ((lane >> 3) & 1) * 4 + ((lane >> 2) & 1) * 2 + ((lane >> 1) & 1);
            const int rr = r + (lane >> 5);
            if (MODE == 1) {
                float g = q1 + bias16[e];
                g = 15.f * tanhf(g * (1.f / 15.f));
                const int gate = e >> 2;
                if (gate & 1) g = fminf(g, 0.f) - log1pf(__expf(-fabsf(g)));
                if ((lane & 1) == 0) out16[(size_t)rr * 16 + e] = g;
            } else {
                float mx = q1;
                mx = fmaxf(mx, dpp_f<0x4E>(mx, mx)); mx = fmaxf(mx, dpp_f<0x141>(mx, mx)); mx = fmaxf(mx, dpp_f<0x140>(mx, mx));
                { auto t = __builtin_amdgcn_permlane16_swap(__float_as_uint(mx), __float_as_uint(mx), false, false); mx = fmaxf(__uint_as_float(t[0]), __uint_as_float(t[1])); }
                const float ex = __expf(q1 - mx); float sm = ex;
                sm += dpp_f<0x4E>(0.f, sm); sm += dpp_f<0x141>(0.f, sm); sm += dpp_f<0x140>(0.f, sm);
                sm = swap16_add(sm, sm);
                if ((lane & 1) == 0) out16[(size_t)e * RT + rr] = ex / sm;
            }
        }
    }
#undef NP_XPTR
#undef NP_LOADROW
    if (MODE != 0) __syncthreads();
}

template <int MODE, bool F8, bool X16SRC>
__device__ __forceinline__ void norm16_pass(Frame& F, const float* xL, const float* xC  , int nrows, const float* gain, const float* shiftv,
                                            const float* scalev, bf16_t* H, const float* W16, int ldw16, const float* bias16, float* out16) {
    const int lane = F.lane, w = F.wave, row = lane & 15, g = lane >> 4;
    LAS float* part = (LAS float*)F.lds;
    LAS f32x4* pacc = (LAS f32x4*)(F.lds + 1024);
    bf16x8 wh[4], wlo[4];
#pragma unroll
    for (int ks = 0; ks < 4; ++ks) { float t[8];
#pragma unroll
        for (int jj = 0; jj < 8; ++jj) t[jj] = W16[(size_t)(128 * w + 32 * ks + 8 * g + jj) * ldw16 + row];
        u32x4 hi4, lo4; unsigned hp[4], lp[4];
#pragma unroll
        for (int q = 0; q < 4; ++q) { hp[q] = pk2(t[2 * q], t[2 * q + 1]); lp[q] = pk2(t[2 * q] - bf_lo(hp[q]), t[2 * q + 1] - bf_hi(hp[q])); }
        hi4 = (u32x4){hp[0], hp[1], hp[2], hp[3]}; lo4 = (u32x4){lp[0], lp[1], lp[2], lp[3]};
        wh[ks] = __builtin_bit_cast(bf16x8, hi4); wlo[ks] = __builtin_bit_cast(bf16x8, lo4); }
    f32x4 gn[4][2];
#pragma unroll
    for (int ks = 0; ks < 4; ++ks) { gn[ks][0] = *(const f32x4*)(gain + 128 * w + 32 * ks + 8 * g); gn[ks][1] = *(const f32x4*)(gain + 128 * w + 32 * ks + 8 * g + 4); }
    const int ngrp = nrows / 16; const int per = (ngrp + F.G - 1) / F.G; const int g0 = F.vcu * per, g1 = (g0 + per < ngrp) ? g0 + per : ngrp;
#define N16_LOAD(dst, gi_) do { const int rr_ = 16 * (gi_) + row; \
        if (X16SRC) { const bf16_t* xp_ = (const bf16_t*)xL + (size_t)rr_ * D + 128 * w + 8 * g; _Pragma("unroll") for (int ks = 0; ks < 4; ++ks) { const u32x4 u_ = *(const u32x4*)(xp_ + 32 * ks); \
                dst[ks][0] = (f32x4){bf_lo(u_.x), bf_hi(u_.x), bf_lo(u_.y), bf_hi(u_.y)}; dst[ks][1] = (f32x4){bf_lo(u_.z), bf_hi(u_.z), bf_lo(u_.w), bf_hi(u_.w)}; } } \
        else { const float* xp_ = ((rr_ >= RL) ? (xC + (size_t)(rr_ - RL) * D) : (xL + (size_t)rr_ * D)) + 128 * w + 8 * g; _Pragma("unroll") for (int ks = 0; ks < 4; ++ks) { dst[ks][0] = *(const f32x4*)(xp_ + 32 * ks); dst[ks][1] = *(const f32x4*)(xp_ + 32 * ks + 4); } } } while (0)
    f32x4 xa[4][2], xb[4][2], shv[4][2], scv[4][2]; int mi_cur = -1;
    __syncthreads();
    if (g0 < g1) N16_LOAD(xa, g0);
    if (g0 + 1 < g1) N16_LOAD(xb, g0 + 1);
    for (int gi2 = g0; gi2 < g1; gi2 += 2) {
#pragma unroll
      for (int hb = 0; hb < 2; ++hb) { if (gi2 + hb < g1) { f32x4 (&xn)[4][2] = hb ? xb : xa; const int gi = gi2 + hb;
        const int buf = gi & 1; const int r0 = 16 * gi; const int mi = (r0 >= RL) ? NB : (r0 >> 12);
        f32x4 (&x)[4][2] = xn;
        float ss = 0.f;
#pragma unroll
        for (int ks = 0; ks < 4; ++ks)
#pragma unroll
            for (int h2 = 0; h2 < 2; ++h2) ss += (x[ks][h2].x * x[ks][h2].x + x[ks][h2].y * x[ks][h2].y) + (x[ks][h2].z * x[ks][h2].z + x[ks][h2].w * x[ks][h2].w);
        ss = swap16_add(ss, ss); ss = swap32_add(ss, ss);
        if (g == 0) part[buf * 128 + w * 16 + row] = ss;
        __syncthreads();
        float tot = 0.f;
#pragma unroll
        for (int q = 0; q < 8; ++q) tot += part[buf * 128 + q * 16 + row];
        const float rstd = rsqrtf(tot * (1.f / D) + NORM_EPS);
        if (mi != mi_cur) { mi_cur = mi;
            const float* shp = shiftv + (size_t)mi * 6 * D + 128 * w + 8 * g; const float* scp = scalev + (size_t)mi * 6 * D + 128 * w + 8 * g;
#pragma unroll
            for (int ks = 0; ks < 4; ++ks)
#pragma unroll
                for (int h2 = 0; h2 < 2; ++h2) { shv[ks][h2] = *(const f32x4*)(shp + 32 * ks + 4 * h2); const f32x4 sc = *(const f32x4*)(scp + 32 * ks + 4 * h2); scv[ks][h2] = (sc + 1.f) * gn[ks][h2]; } }
        f32x4 acc = (f32x4){0.f, 0.f, 0.f, 0.f};
#pragma unroll
        for (int ks = 0; ks < 4; ++ks) {
            f32x4 h[2];
#pragma unroll
            for (int h2 = 0; h2 < 2; ++h2) h[h2] = (x[ks][h2] * rstd) * scv[ks][h2] + shv[ks][h2];
            const size_t ho = (size_t)(r0 + row) * D + 128 * w + 32 * ks + 8 * g;
            u32x4 hi4; hi4.x = pk2(h[0].x, h[0].y); hi4.y = pk2(h[0].z, h[0].w); hi4.z = pk2(h[1].x, h[1].y); hi4.w = pk2(h[1].z, h[1].w);
            if (F8) { u32x2 o; o.x = pk_fp8x4(h[0].x * FP8_SH, h[0].y * FP8_SH, h[0].z * FP8_SH, h[0].w * FP8_SH); o.y = pk_fp8x4(h[1].x * FP8_SH, h[1].y * FP8_SH, h[1].z * FP8_SH, h[1].w * FP8_SH);
                *(u32x2*)((unsigned char*)H + ho) = o; }
            else *(u32x4*)(H + ho) = hi4;
            u32x4 lo4; lo4.x = pk2(h[0].x - bf_lo(hi4.x), h[0].y - bf_hi(hi4.x)); lo4.y = pk2(h[0].z - bf_lo(hi4.y), h[0].w - bf_hi(hi4.y));
            lo4.z = pk2(h[1].x - bf_lo(hi4.z), h[1].y - bf_hi(hi4.z)); lo4.w = pk2(h[1].z - bf_lo(hi4.w), h[1].w - bf_hi(hi4.w));
            const bf16x8 ah = __builtin_bit_cast(bf16x8, hi4), al = __builtin_bit_cast(bf16x8, lo4);
            acc = __builtin_amdgcn_mfma_f32_16x16x32_bf16(ah, wh[ks], acc, 0, 0, 0);
            acc = __builtin_amdgcn_mfma_f32_16x16x32_bf16(ah, wlo[ks], acc, 0, 0, 0);
            acc = __builtin_amdgcn_mfma_f32_16x16x32_bf16(al, wh[ks], acc, 0, 0, 0);
        }
        if (gi + 2 < g1) N16_LOAD(xn, gi + 2);
        pacc[buf * 512 + w * 64 + lane] = acc;
        __syncthreads();
        {
            const int rho = 2 * w + ((lane >> 4) & 1), e = lane & 15;
            const LAS float* pf = (const LAS float*)pacc + ((size_t)(buf * 512 + 16 * (rho >> 2) + e) * 4 + (rho & 3));
            float t = 0.f;
#pragma unroll
            for (int q = 0; q < 8; ++q) t += pf[q * 256];
            if (MODE == 1) {
                float gg = t + bias16[e]; gg = 15.f * tanhf(gg * (1.f / 15.f));
                if ((e >> 2) & 1) gg = fminf(gg, 0.f) - log1pf(__expf(-fabsf(gg)));
                if (lane < 32) out16[(size_t)(r0 + rho) * 16 + e] = gg;
            } else {
                float mx = t;
                mx = fmaxf(mx, dpp_f<0xB1>(mx, mx)); mx = fmaxf(mx, dpp_f<0x4E>(mx, mx)); mx = fmaxf(mx, dpp_f<0x141>(mx, mx)); mx = fmaxf(mx, dpp_f<0x140>(mx, mx));
                const float ex = __expf(t - mx); const float sm = row16_sum(ex);
                if (lane < 32) out16[(size_t)e * RT + r0 + rho] = ex / sm;
            }
        }
        } } }
#undef N16_LOAD
    __syncthreads();
}

__device__ __forceinline__ void gates16_pass(Frame& F, const bf16_t* Hrows, int nrows, const float* W16, int ldw16, const float* bias16, float* out16) {
    const int lane = F.lane, row = lane & 15, g = lane >> 4;
    const int ngrp = nrows / 16; const int per = (ngrp + F.NGW - 1) / F.NGW; const int g0 = F.gw * per, g1 = (g0 + per < ngrp) ? g0 + per : ngrp;
    for (int gi = g0; gi < g1; ++gi) {
        const int r0 = 16 * gi; const bf16_t* xp = Hrows + (size_t)(r0 + row) * D + 8 * g;
        f32x4 acc = (f32x4){0.f, 0.f, 0.f, 0.f};
#pragma unroll 4
        for (int ks = 0; ks < 32; ++ks) {
#if MLS_FP8_IN
            bf16x8 ah; { const u32x2 u8 = *(const u32x2*)((const unsigned char*)Hrows + (size_t)(r0 + row) * D + 8 * g + 32 * ks);
                const f32x2 c0 = __builtin_amdgcn_cvt_pk_f32_fp8((int)u8.x, false), c1 = __builtin_amdgcn_cvt_pk_f32_fp8((int)u8.x, true), c2 = __builtin_amdgcn_cvt_pk_f32_fp8((int)u8.y, false), c3 = __builtin_amdgcn_cvt_pk_f32_fp8((int)u8.y, true);
                const float is = 1.f / FP8_SH;
                ah = __builtin_bit_cast(bf16x8, (u32x4){pk2(c0.x * is, c0.y * is), pk2(c1.x * is, c1.y * is), pk2(c2.x * is, c2.y * is), pk2(c3.x * is, c3.y * is)}); }
#else
            const bf16x8 ah = *(const bf16x8*)(xp + 32 * ks);
#endif
            float t[8];
#pragma unroll
            for (int jj = 0; jj < 8; ++jj) t[jj] = W16[(size_t)(32 * ks + 8 * g + jj) * ldw16 + row];
            unsigned hp[4], lp[4];
#pragma unroll
            for (int q = 0; q < 4; ++q) { hp[q] = pk2(t[2 * q], t[2 * q + 1]); lp[q] = pk2(t[2 * q] - bf_lo(hp[q]), t[2 * q + 1] - bf_hi(hp[q])); }
            const bf16x8 bh = __builtin_bit_cast(bf16x8, (u32x4){hp[0], hp[1], hp[2], hp[3]}), bl = __builtin_bit_cast(bf16x8, (u32x4){lp[0], lp[1], lp[2], lp[3]});
            acc = __builtin_amdgcn_mfma_f32_16x16x32_bf16(ah, bh, acc, 0, 0, 0);
            acc = __builtin_amdgcn_mfma_f32_16x16x32_bf16(ah, bl, acc, 0, 0, 0);
        }
        const float bb = bias16[row]; const int gate = row >> 2;
#pragma unroll
        for (int reg = 0; reg < 4; ++reg) { float gg = acc[reg] + bb; gg = 15.f * tanhf(gg * (1.f / 15.f));
            if (gate & 1) gg = fminf(gg, 0.f) - log1pf(__expf(-fabsf(gg)));
            out16[(size_t)(r0 + 4 * g + reg) * 16 + row] = gg; }
    }
}

__device__ __forceinline__ void moe_select(Frame& F, const float* AFF, int* INV, int* SLROW, float* SLG, int nunits) {
    LAS unsigned* keys = (LAS unsigned*)F.lds;
    LAS unsigned* wsum = (LAS unsigned*)(F.lds + 16384);
    const int tid = F.tid, lane = F.lane, wave = F.wave;
    for (int u = F.vcu; u < nunits; u += F.G) {
        const int set = u >> 4, e = u & 15; const bool isc = set >= NB; const int b = isc ? set - NB : set;
        const int N = isc ? CTXL : SEQ, k = isc ? CAP_C : CAP_L, PER = isc ? 1 : 8;
        const int row0 = isc ? RL + b * CTXL : b * SEQ;
        const int nmine = (tid * PER < N) ? PER : 0;
        unsigned kv[8];
        if (tid < 32) wsum[tid] = 0u;
#pragma unroll
        for (int i = 0; i < 8; ++i) { kv[i] = 0u; if (i < nmine) kv[i] = __float_as_uint(AFF[(size_t)e * RT + row0 + tid * PER + i]); }
        __syncthreads();
        unsigned T = 0u; { unsigned kk = (unsigned)k;
        for (int pass = 0; pass < 8; ++pass) {
            const int shift = 28 - 4 * pass; LAS unsigned* hist = wsum + (pass & 1) * 16;
            if (tid < 16) wsum[((pass + 1) & 1) * 16 + tid] = 0u;
#pragma unroll
            for (int i = 0; i < 8; ++i) if (i < nmine && (pass == 0 || (kv[i] >> (shift + 4)) == (T >> (shift + 4)))) (void)__hip_atomic_fetch_add(&hist[(kv[i] >> shift) & 15u], 1u, __ATOMIC_RELAXED, __HIP_MEMORY_SCOPE_WORKGROUP);
            __syncthreads();
            unsigned cum = 0u, digit = 0u; bool found = false;
#pragma unroll
            for (int d = 15; d >= 0; --d) { const unsigned c = hist[d]; if (!found) { if (cum + c >= kk) { digit = (unsigned)d; found = true; } else cum += c; } }
            kk -= cum; T |= digit << shift;
            __syncthreads();
        } }
        unsigned ngt = 0u, neq = 0u;
#pragma unroll
        for (int i = 0; i < 8; ++i) { if (i < nmine) { ngt += kv[i] > T ? 1u : 0u; neq += kv[i] == T ? 1u : 0u; } }
        unsigned sgt = ngt, seq = neq;
#pragma unroll
        for (int o = 1; o < 64; o <<= 1) { const unsigned a = shfl_up_l(sgt, o, lane), c2 = shfl_up_l(seq, o, lane); if (lane >= o) { sgt += a; seq += c2; } }
        LAS unsigned* sc = wsum + 32;
        __syncthreads();
        if (lane == 63) { sc[wave] = sgt; sc[8 + wave] = seq; }
        __syncthreads();
        unsigned bgt = 0u, beq = 0u, tgt = 0u;
#pragma unroll
        for (int w = 0; w < 8; ++w) { const unsigned a = sc[w], c2 = sc[8 + w]; if (w < wave) { bgt += a; beq += c2; } tgt += a; }
        const unsigned need = (unsigned)k - tgt;
        unsigned pgt = bgt + sgt - ngt, peq = beq + seq - neq;
        const int sbase = isc ? NB * CAP_L + b * CAP_C : b * CAP_L;
#pragma unroll
        for (int i = 0; i < 8; ++i) { if (i < nmine) {
            const int row = row0 + tid * PER + i; int slot = -1;
            if (kv[i] > T) { slot = (int)(pgt + (peq < need ? peq : need)); ++pgt; }
            else if (kv[i] == T) { if (peq < need) slot = (int)(pgt + peq); ++peq; }
            if (slot >= 0) { SLROW[e * SLOTS_E + sbase + slot] = row; SLG[e * SLOTS_E + sbase + slot] = __uint_as_float(kv[i]); }
            INV[(size_t)e * RT + row] = slot >= 0 ? sbase + slot : -1; } }
        __syncthreads();
    }
    (void)keys;
}

__device__ __forceinline__ void moe_gather(Frame& F, const bf16_t* H, const int* SLROW, bf16_t* XG, bool with_ctx) {
    const int per_e = with_ctx ? SLOTS_E : NB * CAP_L; const int total = NE * per_e;
    const int per = (total + F.NGW - 1) / F.NGW; const int i0 = F.gw * per, i1 = (i0 + per < total) ? i0 + per : total;
    for (int i = i0; i < i1; i += 4) {
        u32x4 a[4], b2[4]; size_t dsto[4];
#pragma unroll
        for (int q = 0; q < 4; ++q) { const int ii = (i + q < i1) ? i + q : i1 - 1; const int e = ii / per_e, sl = ii - e * per_e; const int row = SLROW[e * SLOTS_E + sl];
            const u32x4* src = (const u32x4*)(H + (size_t)row * D) + F.lane; a[q] = src[0]; b2[q] = src[64]; dsto[q] = ((size_t)e * SLOTS_E + sl) * D; }
#pragma unroll
        for (int q = 0; q < 4; ++q) { u32x4* dst = (u32x4*)(XG + dsto[q]) + F.lane; dst[0] = a[q]; dst[64] = b2[q]; }
    }
}

template <int MODE, bool F8H = false>
__device__ __forceinline__ void combine_norm(Frame& F, const bf16_t* Y, const int* INV, bf16_t* X16, float* outL  , const float* g2v  , int nrows,
                                             const float* gain, const float* shiftv, const float* scalev, bf16_t* H, const float* W16, int ldw16, const float* bias16, float* out16) {
    LAS float* wl = (LAS float*)F.lds;
    if (MODE == 1) load_w16(F, W16, ldw16);
    const int lane = F.lane;
    f32x4 gv[4];
#pragma unroll
    for (int j = 0; j < 4; ++j) gv[j] = *(const f32x4*)(gain + 4 * lane + 256 * j);
    const int per = (nrows + F.NGW - 1) / F.NGW; const int r0 = F.gw * per, r1 = (r0 + per < nrows) ? r0 + per : nrows;
#define CN_XLOAD(dst, rr) do { const u32x2* xp_ = (const u32x2*)(X16 + (size_t)(rr) * D) + lane; _Pragma("unroll") for (int j = 0; j < 4; ++j) { const u32x2 t_ = xp_[64 * j]; dst[j] = (f32x4){bf_lo(t_.x), bf_hi(t_.x), bf_lo(t_.y), bf_hi(t_.y)}; } } while (0)
#define CN_INV(rr) (((rr) < r1 && lane < 16) ? INV[(size_t)lane * RT + (rr)] : -1)
#if MOE_Y_FP8
#define CN_YLOAD(dst, e_, s_) do { const unsigned* yp_ = (const unsigned*)((const unsigned char*)Y + ((size_t)(e_) * SLOTS_E + (s_)) * D) + lane; _Pragma("unroll") for (int j = 0; j < 4; ++j) dst[j].x = yp_[64 * j]; } while (0)
#define CN_YACC(src) do { _Pragma("unroll") for (int j = 0; j < 4; ++j) { const f32x2 lo_ = __builtin_amdgcn_cvt_pk_f32_fp8((int)src[j].x, false), hi_ = __builtin_amdgcn_cvt_pk_f32_fp8((int)src[j].x, true); \
        a[j].x += lo_.x; a[j].y += lo_.y; a[j].z += hi_.x; a[j].w += hi_.y; } } while (0)
#else
#define CN_YLOAD(dst, e_, s_) do { const u32x2* yp_ = (const u32x2*)(Y + ((size_t)(e_) * SLOTS_E + (s_)) * D) + lane; _Pragma("unroll") for (int j = 0; j < 4; ++j) dst[j] = yp_[64 * j]; } while (0)
#define CN_YACC(src) do { _Pragma("unroll") for (int j = 0; j < 4; ++j) { a[j].x += bf_lo(src[j].x); a[j].y += bf_hi(src[j].x); a[j].z += bf_lo(src[j].y); a[j].w += bf_hi(src[j].y); } } while (0)
#endif
    f32x4 vn[4]; u32x2 pn0[4], pn1[4], pn2[4], pn3[4];
    int invA = CN_INV(r0), invB = CN_INV(r0 + 1);
#pragma unroll
    for (int j = 0; j < 4; ++j) { vn[j] = (f32x4){0.f, 0.f, 0.f, 0.f}; pn0[j] = (u32x2){0u, 0u}; pn1[j] = (u32x2){0u, 0u}; pn2[j] = (u32x2){0u, 0u}; pn3[j] = (u32x2){0u, 0u}; }
    if (r0 < r1) { CN_XLOAD(vn, r0);
        unsigned long long m = __ballot(invA >= 0);
        if (m) { const int e0 = __builtin_ctzll(m); m &= m - 1; CN_YLOAD(pn0, e0, __builtin_amdgcn_readlane(invA, e0)); if (m) { const int e1 = __builtin_ctzll(m); m &= m - 1; CN_YLOAD(pn1, e1, __builtin_amdgcn_readlane(invA, e1));
            if (m) { const int e2 = __builtin_ctzll(m); m &= m - 1; CN_YLOAD(pn2, e2, __builtin_amdgcn_readlane(invA, e2)); if (m) { const int e3 = __builtin_ctzll(m); CN_YLOAD(pn3, e3, __builtin_amdgcn_readlane(invA, e3)); } } } } }
    for (int r = r0; r < r1; ++r) {
        asm volatile("" ::: "memory");
        f32x4 v[4]; u32x2 pc0[4], pc1[4], pc2[4], pc3[4];
#pragma unroll
        for (int j = 0; j < 4; ++j) { v[j] = vn[j]; pc0[j] = pn0[j]; pc1[j] = pn1[j]; pc2[j] = pn2[j]; pc3[j] = pn3[j]; }
        const int invC = CN_INV(r + 2);
        if (r + 1 < r1) { CN_XLOAD(vn, r + 1);
            unsigned long long m = __ballot(invB >= 0);
            if (m) { const int e0 = __builtin_ctzll(m); m &= m - 1; CN_YLOAD(pn0, e0, __builtin_amdgcn_readlane(invB, e0)); if (m) { const int e1 = __builtin_ctzll(m); m &= m - 1; CN_YLOAD(pn1, e1, __builtin_amdgcn_readlane(invB, e1));
            if (m) { const int e2 = __builtin_ctzll(m); m &= m - 1; CN_YLOAD(pn2, e2, __builtin_amdgcn_readlane(invB, e2)); if (m) { const int e3 = __builtin_ctzll(m); CN_YLOAD(pn3, e3, __builtin_amdgcn_readlane(invB, e3)); } } } } }
        f32x4 a[4];
#pragma unroll
        for (int j = 0; j < 4; ++j) a[j] = (f32x4){0.f, 0.f, 0.f, 0.f};
        { unsigned long long m = __ballot(invA >= 0);
          if (m) { m &= m - 1; CN_YACC(pc0);
            if (m) { m &= m - 1; CN_YACC(pc1);
              if (m) { m &= m - 1; CN_YACC(pc2);
                if (m) { m &= m - 1; CN_YACC(pc3);
                  while (m) { const int e4 = __builtin_ctzll(m); m &= m - 1; u32x2 t4[4]; CN_YLOAD(t4, e4, __builtin_amdgcn_readlane(invA, e4)); CN_YACC(t4); } } } } } }
        const int mi = (r >= RL) ? NB : (r >> 12);
        const float* gp = g2v + (size_t)mi * 6 * D;
#pragma unroll
        for (int j = 0; j < 4; ++j) { const f32x4 g = *(const f32x4*)(gp + 4 * lane + 256 * j); v[j] = v[j] + g * a[j] * (MOE_Y_FP8 ? 1.f / FP8_SY : 1.f); }
        if (MODE == 3) { float* xw = outL + (size_t)r * D;
            float ss = 0.f;
#pragma unroll
            for (int j = 0; j < 4; ++j) ss += (v[j].x * v[j].x + v[j].y * v[j].y) + (v[j].z * v[j].z + v[j].w * v[j].w);
            const float rstd = rsqrtf(wave_sum(ss) * (1.f / D) + NORM_EPS);
#pragma unroll
            for (int j = 0; j < 4; ++j) *(f32x4*)(xw + 4 * lane + 256 * j) = v[j] * rstd * gv[j];
        } else {
#pragma unroll
            for (int j = 0; j < 4; ++j) ((unsigned long long*)(X16 + (size_t)r * D))[lane + 64 * j] = (unsigned long long)pk2(v[j].x, v[j].y) | ((unsigned long long)pk2(v[j].z, v[j].w) << 32);
            norm_core<MODE, F8H>(wl, lane, v, r, gv, shiftv + (size_t)mi * 6 * D, scalev + (size_t)mi * 6 * D, H, bias16, out16);
        }
        invA = invB; invB = invC;
    }
#undef CN_XLOAD
#undef CN_INV
#undef CN_YLOAD
#undef CN_YACC
    if (MODE == 1) __syncthreads();
}

__device__ __forceinline__ void final_norm(Frame& F, float* x, const float* gain) {
    const int lane = F.lane;
    for (int r = F.gw; r < RL; r += F.NGW) { float* xr = x + (size_t)r * D; f32x4 v[4]; float ss = 0.f;
#pragma unroll
        for (int j = 0; j < 4; ++j) { v[j] = *(const f32x4*)(xr + 4 * lane + 256 * j); ss += (v[j].x * v[j].x + v[j].y * v[j].y) + (v[j].z * v[j].z + v[j].w * v[j].w); }
        const float rstd = rsqrtf(wave_sum(ss) * (1.f / D) + NORM_EPS);
#pragma unroll
        for (int j = 0; j < 4; ++j) { const f32x4 g = *(const f32x4*)(gain + 4 * lane + 256 * j); *(f32x4*)(xr + 4 * lane + 256 * j) = v[j] * rstd * g; } }
}

__device__ __forceinline__ void unpack8(const u32x4 u, float (&x)[8]) { x[0] = bf_lo(u.x); x[1] = bf_hi(u.x); x[2] = bf_lo(u.y); x[3] = bf_hi(u.y); x[4] = bf_lo(u.z); x[5] = bf_hi(u.z); x[6] = bf_lo(u.w); x[7] = bf_hi(u.w); }
__device__ __forceinline__ u32x4 pack8(const float (&y)[8]) { u32x4 o; o.x = pk2(y[0], y[1]); o.y = pk2(y[2], y[3]); o.z = pk2(y[4], y[5]); o.w = pk2(y[6], y[7]); return o; }
__device__ __forceinline__ void k_pass(Frame& F, bf16_t* QKV, const float* kn, const float* ropec, const float* ropes) {
    const int lane = F.lane, p = lane & 3, kh = (lane >> 2) & 3, rsub = lane >> 4;
    float gk1[8], gk2[8];
#pragma unroll
    for (int t = 0; t < 8; ++t) { gk1[t] = kn[8 * p + t]; gk2[t] = kn[32 + 8 * p + t]; }
    const int ngrp = RT / 4; const int per = (ngrp + F.NGW - 1) / F.NGW; const int g0 = F.gw * per, g1 = (g0 + per < ngrp) ? g0 + per : ngrp;
    for (int gI = g0; gI < g1; gI += 2) {
        u32x4 ua[2], ub[2]; f32x4 c0[2], c1[2], s0[2], s1[2];
#pragma unroll
        for (int q = 0; q < 2; ++q) { const int gg = (gI + q < g1) ? gI + q : g1 - 1; const int rr = 4 * gg + rsub; const bool isc = rr >= RL; const int t = isc ? 0 : (rr & 4095);
            const bf16_t* hp = QKV + (size_t)rr * 1536 + 1024 + kh * 64 + 8 * p;
            ua[q] = *(const u32x4*)hp; ub[q] = *(const u32x4*)(hp + 32);
            c0[q] = *(const f32x4*)(ropec + t * 32 + 8 * p); c1[q] = *(const f32x4*)(ropec + t * 32 + 8 * p + 4); s0[q] = *(const f32x4*)(ropes + t * 32 + 8 * p); s1[q] = *(const f32x4*)(ropes + t * 32 + 8 * p + 4); }
#pragma unroll
        for (int q = 0; q < 2; ++q) { if (gI + q < g1) { const int rr = 4 * (gI + q) + rsub; const bool isc = rr >= RL;
            float cs[8] = {c0[q].x, c0[q].y, c0[q].z, c0[q].w, c1[q].x, c1[q].y, c1[q].z, c1[q].w}, sn[8] = {s0[q].x, s0[q].y, s0[q].z, s0[q].w, s1[q].x, s1[q].y, s1[q].z, s1[q].w};
            if (isc) {
#pragma unroll
                for (int i = 0; i < 8; ++i) { cs[i] = 1.f; sn[i] = 0.f; } }
            float x1[8], x2[8]; unpack8(ua[q], x1); unpack8(ub[q], x2);
            float ss = 0.f;
#pragma unroll
            for (int i = 0; i < 8; ++i) ss += x1[i] * x1[i] + x2[i] * x2[i];
            ss = quad_sum(ss);
            const float rstd = rsqrtf(ss * (1.f / 64.f) + NORM_EPS);
            float y1[8], y2[8];
#pragma unroll
            for (int i = 0; i < 8; ++i) { const float a = x1[i] * rstd * gk1[i], c = x2[i] * rstd * gk2[i]; y1[i] = a * cs[i] - c * sn[i]; y2[i] = a * sn[i] + c * cs[i]; }
            bf16_t* hp = QKV + (size_t)rr * 1536 + 1024 + kh * 64 + 8 * p;
            *(u32x4*)hp = pack8(y1); *(u32x4*)(hp + 32) = pack8(y2); } }
    }
}

__device__ __forceinline__ void kv8_pass(Frame& F, const bf16_t* QKV, const float* kn, const float* ropec, const float* ropes, unsigned char* KV8) {
    {
        const int lane = F.lane, p = lane & 3, kh = (lane >> 2) & 3, rsub = lane >> 4;
        float gk1[8], gk2[8];
#pragma unroll
        for (int t = 0; t < 8; ++t) { gk1[t] = kn[8 * p + t]; gk2[t] = kn[32 + 8 * p + t]; }
        const int ngrp = RT / 4; const int per = (ngrp + F.NGW - 1) / F.NGW; const int g0 = F.gw * per, g1 = (g0 + per < ngrp) ? g0 + per : ngrp;
        for (int gI = g0; gI < g1; gI += 2) {
            u32x4 ua[2], ub[2]; f32x4 c0[2], c1[2], s0[2], s1[2];
#pragma unroll
            for (int q = 0; q < 2; ++q) { const int gg = (gI + q < g1) ? gI + q : g1 - 1; const int rr = 4 * gg + rsub; const bool isc = rr >= RL; const int t = isc ? 0 : (rr & 4095);
                const bf16_t* hp = QKV + (size_t)rr * 1536 + 1024 + kh * 64 + 8 * p;
                ua[q] = *(const u32x4*)hp; ub[q] = *(const u32x4*)(hp + 32);
                c0[q] = *(const f32x4*)(ropec + t * 32 + 8 * p); c1[q] = *(const f32x4*)(ropec + t * 32 + 8 * p + 4); s0[q] = *(const f32x4*)(ropes + t * 32 + 8 * p); s1[q] = *(const f32x4*)(ropes + t * 32 + 8 * p + 4); }
#pragma unroll
            for (int q = 0; q < 2; ++q) { if (gI + q < g1) { const int rr = 4 * (gI + q) + rsub; const bool isc = rr >= RL;
                float cs[8] = {c0[q].x, c0[q].y, c0[q].z, c0[q].w, c1[q].x, c1[q].y, c1[q].z, c1[q].w}, sn[8] = {s0[q].x, s0[q].y, s0[q].z, s0[q].w, s1[q].x, s1[q].y, s1[q].z, s1[q].w};
                if (isc) {
#pragma unroll
                    for (int i = 0; i < 8; ++i) { cs[i] = 1.f; sn[i] = 0.f; } }
                float x1[8], x2[8]; unpack8(ua[q], x1); unpack8(ub[q], x2);
                float ss = 0.f;
#pragma unroll
                for (int i = 0; i < 8; ++i) ss += x1[i] * x1[i] + x2[i] * x2[i];
                ss = quad_sum(ss);
                const float rstd = rsqrtf(ss * (1.f / 64.f) + NORM_EPS) * FP8_SK;
                float y1[8], y2[8];
#pragma unroll
                for (int i = 0; i < 8; ++i) { const float a = x1[i] * rstd * gk1[i], c = x2[i] * rstd * gk2[i]; y1[i] = a * cs[i] - c * sn[i]; y2[i] = a * sn[i] + c * cs[i]; }
                const int b = isc ? ((rr - RL) >> 8) : (rr >> 12); const int keyp = isc ? ((rr - RL) & 255) : (256 + (rr & 4095));
                unsigned char* tb = KV8 + (size_t)((b * 4 + kh) * (KVLEN / 64) + (keyp >> 6)) * 8192 + (keyp & 63) * 16 + 8 * (p >> 1) + (2 * (p & 1)) * 1024;
                u32x2 o1, o2; o1.x = pk_fp8x4(y1[0], y1[1], y1[2], y1[3]); o1.y = pk_fp8x4(y1[4], y1[5], y1[6], y1[7]); o2.x = pk_fp8x4(y2[0], y2[1], y2[2], y2[3]); o2.y = pk_fp8x4(y2[4], y2[5], y2[6], y2[7]);
                *(u32x2*)tb = o1; *(u32x2*)(tb + 1024) = o2; } }
        }
    }
    {
        const int lane = F.lane; LAS unsigned* scr = (LAS unsigned*)(F.lds) + F.wave * (64 * 17);
        const int dq = lane & 15, g = lane >> 4, hi = g >> 1, half = g & 1;
        for (int it = F.gw; it < NB * 4 * (KVLEN / 64); it += F.NGW) {
            const int tile = it % (KVLEN / 64), bk = it / (KVLEN / 64), kh = bk & 3, b = bk >> 2;
            const size_t row = (tile < 4) ? ((size_t)RL + b * CTXL + tile * 64 + lane) : ((size_t)b * SEQ + (tile - 4) * 64 + lane);
            const bf16_t* vp = QKV + row * 1536 + 1280 + kh * 64;
            u32x4 u[8];
#pragma unroll
            for (int i = 0; i < 8; ++i) u[i] = *(const u32x4*)(vp + 8 * i);
#pragma unroll
            for (int i = 0; i < 8; ++i) { float x[8]; unpack8(u[i], x);
                scr[lane * 17 + 2 * i] = pk_fp8x4(x[0] * FP8_SV, x[1] * FP8_SV, x[2] * FP8_SV, x[3] * FP8_SV); scr[lane * 17 + 2 * i + 1] = pk_fp8x4(x[4] * FP8_SV, x[5] * FP8_SV, x[6] * FP8_SV, x[7] * FP8_SV); }
            LDS_WAIT(); asm volatile("" ::: "memory");
            unsigned x[16];
#pragma unroll
            for (int jj = 0; jj < 16; ++jj) { const int key = 32 * half + (jj & 3) + 8 * (jj >> 2) + 4 * hi; x[jj] = scr[key * 17 + dq]; }
            LDS_WAIT(); asm volatile("" ::: "memory");
            unsigned char* ob = KV8 + (size_t)it * 8192 + 4096 + g * 1024 + (4 * dq) * 16;
#pragma unroll
            for (int c = 0; c < 4; ++c) { u32x4 o; const unsigned sel = (unsigned)c | ((unsigned)(4 + c) << 8) | 0x0c0c0000u;
#pragma unroll
                for (int w = 0; w < 4; ++w) { const unsigned t01 = __builtin_amdgcn_perm(x[4 * w + 1], x[4 * w], sel), t23 = __builtin_amdgcn_perm(x[4 * w + 3], x[4 * w + 2], sel); o[w] = __builtin_amdgcn_perm(t23, t01, 0x05040100u); }
                *(u32x4*)(ob + c * 16) = o; }
        }
    }
}

__device__ __forceinline__ void mlstm_readout(Frame& F, const bf16_t* HF, const bf16_t* HB, const bf16_t* QKVO, const float* wnorm, bf16_t* MIX) {
    const int lane = F.lane;
    f32x4 gv[4];
#pragma unroll
    for (int j = 0; j < 4; ++j) gv[j] = *(const f32x4*)(wnorm + 4 * lane + 256 * j);
    const int per = (((RT + F.NGW - 1) / F.NGW) + 3) & ~3; const int r0 = F.gw * per, r1 = (r0 + per < RT) ? r0 + per : RT;
    for (int r = r0; r < r1; r += 4) {
        u32x2 uf[4][4], ub[4][4], uo[4][4];
#pragma unroll
        for (int q = 0; q < 4; ++q) { const int rr = (r + q < r1) ? r + q : r1 - 1;
            const u32x2* pf = (const u32x2*)(HF + (size_t)rr * D) + lane; const u32x2* pb = (const u32x2*)(HB + (size_t)rr * D) + lane; const u32x2* po = (const u32x2*)(QKVO + (size_t)rr * 3072 + 2048) + lane;
#pragma unroll
            for (int j = 0; j < 4; ++j) { uf[q][j] = pf[64 * j]; ub[q][j] = pb[64 * j]; uo[q][j] = po[64 * j]; } }
#pragma unroll
        for (int q = 0; q < 4; ++q) { const int rr = r + q; if (rr < r1) {
            unsigned long long* o8 = (unsigned long long*)(MIX + (size_t)rr * D) + lane; unsigned* o4 = (unsigned*)((unsigned char*)MIX + (size_t)rr * D) + lane; (void)o8; (void)o4;
#pragma unroll
            for (int j = 0; j < 4; ++j) {
                f32x4 h; h.x = bf_lo(uf[q][j].x) + bf_lo(ub[q][j].x); h.y = bf_hi(uf[q][j].x) + bf_hi(ub[q][j].x); h.z = bf_lo(uf[q][j].y) + bf_lo(ub[q][j].y); h.w = bf_hi(uf[q][j].y) + bf_hi(ub[q][j].y);
                const float ss = wave_sum((h.x * h.x + h.y * h.y) + (h.z * h.z + h.w * h.w));
                const float rstd = rsqrtf(ss * (1.f / 256.f) + NORM_EPS);
                f32x4 og; og.x = bf_lo(uo[q][j].x); og.y = bf_hi(uo[q][j].x); og.z = bf_lo(uo[q][j].y); og.w = bf_hi(uo[q][j].y);
                f32x4 y;
                y.x = h.x * rstd * gv[j].x * fast_rcp(1.f + __expf(-og.x)); y.y = h.y * rstd * gv[j].y * fast_rcp(1.f + __expf(-og.y));
                y.z = h.z * rstd * gv[j].z * fast_rcp(1.f + __expf(-og.z)); y.w = h.w * rstd * gv[j].w * fast_rcp(1.f + __expf(-og.w));
#if MLS_FP8_OUT
                o4[64 * j] = pk_fp8x4(y.x * FP8_SM, y.y * FP8_SM, y.z * FP8_SM, y.w * FP8_SM);
#else
                o8[64 * j] = (unsigned long long)pk2(y.x, y.y) | ((unsigned long long)pk2(y.z, y.w) << 32);
#endif
            } } }
    }
}
namespace mls {
constexpr int XS = 272, PS = 144, NCH = 68;
constexpr int O_XQ = 0, O_XK = 17408, O_XKP = 34816, O_XV = 52224, O_P = 69632, O_CT = 78848, O_OT = 113664, O_GB = 131072;
constexpr int O_RD = O_GB + 2 * 5 * 64 * 4, O_NV = O_RD + 256, O_DEC = O_NV + 1024, O_PRE = O_DEC + 64;
constexpr int LDS_BYTES = O_PRE + 3 * 72 * 4;

__device__ __forceinline__ int row_of(int b, int dir, int c, int p) {
    const int base = (c < 4) ? (RL + b * CTXL + (dir ? 192 - 64 * c : 64 * c)) : (b * SEQ + (dir ? 4032 - 64 * (c - 4) : 64 * (c - 4)));
    return base + (dir ? 63 - p : p);
}
__device__ __forceinline__ int base_of(int b, int dir, int c) { return (c < 4) ? (RL + b * CTXL + (dir ? 192 - 64 * c : 64 * c)) : (b * SEQ + (dir ? 4032 - 64 * (c - 4) : 64 * (c - 4))); }
__device__ __forceinline__ bf16x8 tr8(const LAS unsigned char* p0, const LAS unsigned char* p1) {
    typedef short v4i16_t __attribute__((ext_vector_type(4)));
    const s16x4 lo = __builtin_bit_cast(s16x4, __builtin_amdgcn_ds_read_tr16_b64_v4i16((LAS v4i16_t*)p0));
    const s16x4 hi = __builtin_bit_cast(s16x4, __builtin_amdgcn_ds_read_tr16_b64_v4i16((LAS v4i16_t*)p1));
    return (bf16x8){lo[0], lo[1], lo[2], lo[3], hi[0], hi[1], hi[2], hi[3]};
}

__device__ __forceinline__ void gate_arrays(LAS unsigned char* L, const float lf, const float ig, int c, int lane) {
    const int par = c & 1;
    const float bs = wave_scan_add(lf, lane);
    const float a = ig - bs; const float pm = wave_scan_max(a, lane);
    const float mst = ((const LAS float*)(L + O_PRE))[144 + c];
    const float M = fmaxf(mst, pm), M63 = rdlane(M, 63);
    LAS float* gb = (LAS float*)(L + O_GB) + par * 320;
    gb[lane] = a; gb[64 + lane] = M; gb[128 + lane] = __expf(mst - M); gb[192 + lane] = __expf(-bs - M); gb[256 + lane] = __expf(a - M63);
    if (lane == 0) ((LAS float*)(L + O_DEC))[par] = __expf(mst - M63);
}

__device__ __forceinline__ void mlstm_unit(Frame& F, int b, int hd, int dir, int half, const bf16_t* QKVO, const float* GATES, bf16_t* HOUT) {
    LAS unsigned char* L = F.lds;
    const int tid = F.tid, lane = F.lane, w = F.wave, fr = lane & 15, g = lane >> 4;
    const int gi = (dir * 2) * 4 + hd, gf = (dir * 2 + 1) * 4 + hd;
    LAS float* pre = (LAS float*)(L + O_PRE);
    __syncthreads();
    {
        float lfv[9], igv[9];
#pragma unroll
        for (int q = 0; q < 9; ++q) { const int c = w + 8 * q; lfv[q] = 0.f; igv[q] = 0.f;
            if (c < NCH) { const int row = row_of(b, dir, c, lane); lfv[q] = GATES[(size_t)row * 16 + gf]; igv[q] = GATES[(size_t)row * 16 + gi]; } }
#pragma unroll
        for (int q = 0; q < 9; ++q) { const int c = w + 8 * q;
            if (c < NCH) { const float bs = wave_scan_add(lfv[q], lane); float am = igv[q] - bs;
                am = fmaxf(am, dpp_f<0xB1>(am, am)); am = fmaxf(am, dpp_f<0x4E>(am, am)); am = fmaxf(am, dpp_f<0x141>(am, am)); am = fmaxf(am, dpp_f<0x140>(am, am));
                am = fmaxf(fmaxf(rdlane(am, 0), rdlane(am, 16)), fmaxf(rdlane(am, 32), rdlane(am, 48)));
                if (lane == 0) { pre[c] = rdlane(bs, 63); pre[72 + c] = am; } } }
    }
    for (int i = tid; i < (O_OT - O_CT) / 4; i += NTHREADS) ((LAS unsigned*)(L + O_CT))[i] = 0u;
    for (int i = tid; i < 256; i += NTHREADS) ((LAS float*)(L + O_NV))[i] = 0.f;
    __syncthreads();
    if (tid == 0) { float m = 0.f; for (int c = 0; c < NCH; ++c) { pre[144 + c] = m; m = pre[c] + fmaxf(m, pre[72 + c]); } }
    __syncthreads();
    if (w == 0) { const int row = row_of(b, dir, 0, lane); gate_arrays(L, GATES[(size_t)row * 16 + gf], GATES[(size_t)row * 16 + gi], 0, lane); }
    __syncthreads();
    const int qcol = hd * 128, kcol = 512 + hd * 128, vcol = 1024 + hd * 256 + half * 128;
    u32x4 rq[2], rk[2], rv[2];
#define MLS_BAR() do { asm volatile("s_waitcnt lgkmcnt(0)" ::: "memory"); __builtin_amdgcn_s_barrier(); asm volatile("" ::: "memory"); } while (0)
    unsigned ldoff[2];
#pragma unroll
    for (int i_ = 0; i_ < 2; ++i_) { const int pi_ = tid + 512 * i_, p_ = pi_ >> 4, c16_ = pi_ & 15; ldoff[i_] = (unsigned)((dir ? 63 - p_ : p_) * 3072 + c16_ * 8) * 2u; }
#define MLS_LOAD(c) do { const char* cb_ = (const char*)(QKVO + (size_t)base_of(b, dir, (c)) * 3072); \
        _Pragma("unroll") for (int i_ = 0; i_ < 2; ++i_) { \
        rq[i_] = *(const u32x4*)(cb_ + qcol * 2 + ldoff[i_]); rk[i_] = *(const u32x4*)(cb_ + kcol * 2 + ldoff[i_]); rv[i_] = *(const u32x4*)(cb_ + vcol * 2 + ldoff[i_]); } } while (0)
#define MLS_STAGE(c) do { const LAS float* wk_ = (const LAS float*)(L + O_GB) + ((c) & 1) * 320 + 256; \
        _Pragma("unroll") for (int i_ = 0; i_ < 2; ++i_) { const int pi_ = tid + 512 * i_, p_ = pi_ >> 4, c16_ = pi_ & 15; const int o_ = p_ * XS + c16_ * 16; \
        *(LAS u32x4*)(L + O_XQ + o_) = rq[i_]; *(LAS u32x4*)(L + O_XK + o_) = rk[i_]; *(LAS u32x4*)(L + O_XV + o_) = rv[i_]; \
        const float s_ = wk_[p_]; u32x4 kk_; \
        kk_.x = pk2(bf_lo(rk[i_].x) * s_, bf_hi(rk[i_].x) * s_); kk_.y = pk2(bf_lo(rk[i_].y) * s_, bf_hi(rk[i_].y) * s_); \
        kk_.z = pk2(bf_lo(rk[i_].z) * s_, bf_hi(rk[i_].z) * s_); kk_.w = pk2(bf_lo(rk[i_].w) * s_, bf_hi(rk[i_].w) * s_); \
        *(LAS u32x4*)(L + O_XKP + o_) = kk_; } } while (0)
    MLS_LOAD(0); MLS_STAGE(0);
    __syncthreads();
    f32x4 C[8];
#pragma unroll
    for (int i = 0; i < 8; ++i) C[i] = (f32x4){0.f, 0.f, 0.f, 0.f};
    LAS unsigned char* CTw = L + O_CT + w * (16 * XS);
    float glf_n = 0.f, gig_n = 0.f;
    const unsigned goff = (unsigned)((dir ? 63 - lane : lane) * 16) * 4u;
    if (w == 7) { const char* gb_ = (const char*)(GATES + (size_t)base_of(b, dir, 1) * 16); glf_n = *(const float*)(gb_ + goff + gf * 4); gig_n = *(const float*)(gb_ + goff + gi * 4); }
    for (int c = 0; c < NCH; ++c) {
        const int par = c & 1; const bool more = (c + 1 < NCH);
        const LAS float* gb = (const LAS float*)(L + O_GB) + par * 320;
        const float glf = glf_n, gig = gig_n;
        if (w == 7 && c + 2 < NCH) { const char* gb_ = (const char*)(GATES + (size_t)base_of(b, dir, c + 2) * 16); glf_n = *(const float*)(gb_ + goff + gf * 4); gig_n = *(const float*)(gb_ + goff + gi * 4); }
        if (more) MLS_LOAD(c + 1);
#define LFENCE() do { asm volatile("s_waitcnt lgkmcnt(0)" ::: "memory"); __builtin_amdgcn_sched_barrier(0); } while (0)
#define QFRAG(mt_, ks_) (*(const LAS bf16x8*)(L + O_XQ + (16 * (mt_) + fr) * XS + (32 * (ks_) + 8 * g) * 2))
        f32x4 acc[4];
        {
            const int mt1 = w >> 1;
            bf16x8 ct[4], qa[2][4], qb[2][4];
#pragma unroll
            for (int ks = 0; ks < 4; ++ks) ct[ks] = *(const LAS bf16x8*)(CTw + fr * XS + (32 * ks + 8 * g) * 2);
#pragma unroll
            for (int m2 = 0; m2 < 2; ++m2)
#pragma unroll
                for (int ks = 0; ks < 4; ++ks) qa[m2][ks] = QFRAG(m2, ks);
            LFENCE();
#pragma unroll
            for (int m2 = 0; m2 < 2; ++m2)
#pragma unroll
                for (int ks = 0; ks < 4; ++ks) qb[m2][ks] = QFRAG(2 + m2, ks);
            __builtin_amdgcn_sched_barrier(0);
#pragma unroll
            for (int m2 = 0; m2 < 2; ++m2) { f32x4 a4 = (f32x4){0.f, 0.f, 0.f, 0.f};
#pragma unroll
                for (int ks = 0; ks < 4; ++ks) a4 = __builtin_amdgcn_mfma_f32_16x16x32_bf16(ct[ks], qa[m2][ks], a4, 0, 0, 0);
                acc[m2] = a4; }
            LFENCE();
            bf16x8 aq[4], bk[2][4];
#pragma unroll
            for (int ks = 0; ks < 4; ++ks) aq[ks] = QFRAG(mt1, ks);
#pragma unroll
            for (int n2 = 0; n2 < 2; ++n2)
#pragma unroll
                for (int ks = 0; ks < 4; ++ks) bk[n2][ks] = *(const LAS bf16x8*)(L + O_XK + (16 * (2 * (w & 1) + n2) + fr) * XS + (32 * ks + 8 * g) * 2);
            const float Mj = gb[64 + 16 * mt1 + fr];
            f32x4 as[2]; as[0] = *(const LAS f32x4*)(gb + 16 * (2 * (w & 1)) + 4 * g); as[1] = *(const LAS f32x4*)(gb + 16 * (2 * (w & 1) + 1) + 4 * g);
            float wi[4];
#pragma unroll
            for (int mt = 0; mt < 4; ++mt) wi[mt] = gb[128 + 16 * mt + fr];
            __builtin_amdgcn_sched_barrier(0);
#pragma unroll
            for (int m2 = 0; m2 < 2; ++m2) { f32x4 a4 = (f32x4){0.f, 0.f, 0.f, 0.f};
#pragma unroll
                for (int ks = 0; ks < 4; ++ks) a4 = __builtin_amdgcn_mfma_f32_16x16x32_bf16(ct[ks], qb[m2][ks], a4, 0, 0, 0);
                acc[2 + m2] = a4; }
            LFENCE();
            f32x4 s4[2];
#pragma unroll
            for (int n2 = 0; n2 < 2; ++n2) { s4[n2] = (f32x4){0.f, 0.f, 0.f, 0.f};
#pragma unroll
                for (int ks = 0; ks < 4; ++ks) s4[n2] = __builtin_amdgcn_mfma_f32_16x16x32_bf16(bk[n2][ks], aq[ks], s4[n2], 0, 0, 0); }
#pragma unroll
            for (int mt = 0; mt < 4; ++mt) acc[mt] = acc[mt] * wi[mt];
#pragma unroll
            for (int n2 = 0; n2 < 2; ++n2) { const int s0 = 16 * (2 * (w & 1) + n2) + 4 * g, j = 16 * mt1 + fr; float pv[4];
#pragma unroll
                for (int reg = 0; reg < 4; ++reg) pv[reg] = (s0 + reg <= j) ? s4[n2][reg] * __expf(as[n2][reg] - Mj) : 0.f;
                u32x2 o; o.x = pk2(pv[0], pv[1]); o.y = pk2(pv[2], pv[3]);
                *(LAS u32x2*)(L + O_P + j * PS + s0 * 2) = o; }
        }
        MLS_BAR();
        bf16x8 vf[2];
        float rdv; float nsum;
        const float decay = ((const LAS float*)(L + O_DEC))[par];
        {
            const LAS unsigned char* vb = L + O_XV + (8 * g + (fr >> 2)) * XS + (16 * w + (lane & 3) * 4) * 2;
            const LAS unsigned char* kb = L + O_XKP + (8 * g + (fr >> 2)) * XS + ((lane & 3) * 4) * 2;
            bf16x8 ap[4][2];
#pragma unroll
            for (int k2 = 0; k2 < 2; ++k2) vf[k2] = tr8(vb + 32 * k2 * XS, vb + (32 * k2 + 4) * XS);
#pragma unroll
            for (int mt = 0; mt < 4; ++mt)
#pragma unroll
                for (int k2 = 0; k2 < 2; ++k2) ap[mt][k2] = *(const LAS bf16x8*)(L + O_P + (16 * mt + fr) * PS + (32 * k2 + 8 * g) * 2);
            LFENCE();
            const int j = tid >> 3, part = tid & 7;
            const u32x4 pu = *(const LAS u32x4*)(L + O_P + j * PS + part * 16);
            const u32x4 q0 = *(const LAS u32x4*)(L + O_XQ + j * XS + part * 32), q1 = *(const LAS u32x4*)(L + O_XQ + j * XS + part * 32 + 16);
            const LAS f32x4* np = (const LAS f32x4*)(L + O_NV + par * 512 + part * 64);
            const f32x4 n0 = np[0], n1 = np[1], n2 = np[2], n3 = np[3];
            const float wint_j = gb[128 + j], emq_j = gb[192 + j];
            bf16x8 ak[4][2];
#pragma unroll
            for (int mt = 0; mt < 4; ++mt)
#pragma unroll
                for (int k2 = 0; k2 < 2; ++k2) ak[mt][k2] = tr8(kb + 32 * k2 * XS + 32 * mt, kb + (32 * k2 + 4) * XS + 32 * mt);
            __builtin_amdgcn_sched_barrier(0);
#pragma unroll
            for (int mt = 0; mt < 4; ++mt)
#pragma unroll
                for (int k2 = 0; k2 < 2; ++k2) acc[mt] = __builtin_amdgcn_mfma_f32_16x16x32_bf16(vf[k2], ap[mt][k2], acc[mt], 0, 0, 0);
            LFENCE();
            const int dk = tid >> 2, part4 = tid & 3; bf16_t kc[16];
#pragma unroll
            for (int t = 0; t < 16; ++t) kc[t] = *(const LAS bf16_t*)(L + O_XKP + (16 * part4 + t) * XS + dk * 2);
            const float nold = ((const LAS float*)(L + O_NV))[par * 128 + dk];
            __builtin_amdgcn_sched_barrier(0);
#pragma unroll
            for (int mt = 0; mt < 4; ++mt) { f32x4 c4 = C[mt] * decay;
#pragma unroll
                for (int k2 = 0; k2 < 2; ++k2) c4 = __builtin_amdgcn_mfma_f32_16x16x32_bf16(ak[mt][k2], vf[k2], c4, 0, 0, 0);
                C[mt] = c4; }
            float rs = (bf_lo(pu.x) + bf_hi(pu.x)) + (bf_lo(pu.y) + bf_hi(pu.y)) + (bf_lo(pu.z) + bf_hi(pu.z)) + (bf_lo(pu.w) + bf_hi(pu.w));
            float qn = bf_lo(q0.x) * n0.x + bf_hi(q0.x) * n0.y + bf_lo(q0.y) * n0.z + bf_hi(q0.y) * n0.w
                     + bf_lo(q0.z) * n1.x + bf_hi(q0.z) * n1.y + bf_lo(q0.w) * n1.z + bf_hi(q0.w) * n1.w
                     + bf_lo(q1.x) * n2.x + bf_hi(q1.x) * n2.y + bf_lo(q1.y) * n2.z + bf_hi(q1.y) * n2.w
                     + bf_lo(q1.z) * n3.x + bf_hi(q1.z) * n3.y + bf_lo(q1.w) * n3.z + bf_hi(q1.w) * n3.w;
            rs = oct_sum(rs); qn = oct_sum(qn);
            rdv = 1.f / fmaxf(fabsf(rs + wint_j * qn), emq_j);
            float sm0 = 0.f;
#pragma unroll
            for (int t = 0; t < 16; ++t) sm0 += bf2f(kc[t]);
            __builtin_amdgcn_sched_barrier(0);
#pragma unroll
            for (int mt = 0; mt < 4; ++mt)
#pragma unroll
                for (int k2 = 0; k2 < 2; ++k2) ak[mt][k2] = tr8(kb + 32 * k2 * XS + 32 * (4 + mt), kb + (32 * k2 + 4) * XS + 32 * (4 + mt));
            LFENCE();
#pragma unroll
            for (int mt = 0; mt < 4; ++mt) { f32x4 c4 = C[4 + mt] * decay;
#pragma unroll
                for (int k2 = 0; k2 < 2; ++k2) c4 = __builtin_amdgcn_mfma_f32_16x16x32_bf16(ak[mt][k2], vf[k2], c4, 0, 0, 0);
                C[4 + mt] = c4; }
            float sm = quad_sum(sm0);
            nsum = decay * nold + sm;
        }
#undef LFENCE
#undef QFRAG
        asm volatile("" ::: "memory");
        if ((tid & 7) == 0) ((LAS float*)(L + O_RD))[tid >> 3] = rdv;
        if ((tid & 3) == 0) ((LAS float*)(L + O_NV))[(par ^ 1) * 128 + (tid >> 2)] = nsum;
#pragma unroll
        for (int mt = 0; mt < 8; ++mt) { u32x2 o; o.x = pk2(C[mt][0], C[mt][1]); o.y = pk2(C[mt][2], C[mt][3]);
            *(LAS u32x2*)(CTw + fr * XS + (16 * mt + 4 * g) * 2) = o; }
        if (more && w == 7) gate_arrays(L, glf, gig, c + 1, lane);
        MLS_BAR();
        {
#pragma unroll
            for (int mt = 0; mt < 4; ++mt) { const float rd = ((const LAS float*)(L + O_RD))[16 * mt + fr];
                u32x2 o; o.x = pk2(acc[mt][0] * rd, acc[mt][1] * rd); o.y = pk2(acc[mt][2] * rd, acc[mt][3] * rd);
                *(LAS u32x2*)(L + O_OT + (16 * mt + fr) * XS + (16 * w + 4 * g) * 2) = o; }
            if (more) MLS_STAGE(c + 1);
        }
        MLS_BAR();
        {
            const int j = tid >> 3, ch = tid & 7;
            const u32x4 o0 = *(const LAS u32x4*)(L + O_OT + j * XS + ch * 32), o1 = *(const LAS u32x4*)(L + O_OT + j * XS + ch * 32 + 16);
            bf16_t* op = HOUT + (size_t)base_of(b, dir, c) * D + (dir ? 63 - j : j) * D + hd * 256 + half * 128 + ch * 16;
            *(u32x4*)op = o0; *(u32x4*)(op + 8) = o1;
        }
    }
#undef MLS_BAR
#undef MLS_LOAD
#undef MLS_STAGE
}
}
constexpr int MISC_OFF = 135936, LDS_TOTAL = 136192;
static_assert(mls::LDS_BYTES <= MISC_OFF && pg8::STAGE_BYTES <= MISC_OFF && attn_body::LDS_BYTES <= MISC_OFF && attn8::LDS_BYTES <= MISC_OFF, "lds");
#ifndef EN_MASK
#define EN_MASK 0xFFFFFFFFu
#endif
#define PH_ON(k) (((EN_MASK) >> (k)) & 1u)
#ifndef REP_MASK
#define REP_MASK 0u
#endif
#define REP_ON(k) (((REP_MASK) >> (k)) & 1u)
#ifndef PH_LIMIT
#define PH_LIMIT 1000
#endif
#ifndef N_LAUNCH_SPLIT
#define N_LAUNCH_SPLIT 0
#endif
constexpr int N_PHASES = 1 + 10 + 9 + 9 + 9;

struct Args { const float* in[21]; float* out; unsigned char* ws; int ph_lo, ph_hi; };
static_assert(sizeof(Args) == 23 * 8 + 8, "no padding");

__device__ __forceinline__ Frame make_frame(unsigned char* lds_gen, unsigned char* ws_, const int wave_s) {
    Frame F; int ln; asm volatile("v_mbcnt_lo_u32_b32 %0, -1, 0\n\tv_mbcnt_hi_u32_b32 %0, -1, %0" : "=v"(ln));
    int wv = wave_s; asm volatile("" : "+s"(wv));
    int bx = blockIdx.x; asm volatile("" : "+s"(bx));
    F.lds = (LAS unsigned char*)lds_gen; F.tid = wv * 64 + ln; F.lane = ln; F.wave = wv;
    F.G = gridDim.x; F.bid = bx; F.vcu = (F.G % 8 == 0) ? (bx % 8) * (F.G / 8) + bx / 8 : bx;
    F.gw = F.vcu * NWAVES + F.wave; F.NGW = F.G * NWAVES;
    unsigned long long wi = (unsigned long long)ws_; asm volatile("" : "+s"(wi)); GAS unsigned char* wg = (GAS unsigned char*)wi;
    F.ws = (unsigned char*)wg; F.inq = (const unsigned long long*)(GAS const unsigned long long*)(wg + WS_PTRS); return F;
}
__device__ __forceinline__ void attn_phase8(Frame& F, const int nun, const float mfix, const int j, char* lds_gen) {
    for (int L = F.vcu; L < nun; L += F.G) {
        const bool isc = L >= 4096; const int Lc = L - 4096;
        const int grp = L >> 6, wi = L & 63;
        const int b = isc ? (Lc >> 4) : (grp >> 2), hq = isc ? (Lc & 15) : ((grp & 3) * 4 + (wi >> 4));
        const size_t row0 = isc ? ((size_t)RL + b * CTXL) : ((size_t)b * SEQ + (wi & 15) * 256);
        const bf16_t* qp = (const bf16_t*)(F.ws + WS_BIG0) + row0 * 1536 + hq * 64; unsigned char* op = F.ws + WS_MIX + row0 * D + hq * 64;
        const float* rc = (const float*)(F.ws + WS_ROPE); const float* rs = rc + SEQ * 32;
        const unsigned char* kv8 = F.ws + WS_KV8 + (size_t)((b * 4 + (hq >> 2)) * (KVLEN / 64)) * 8192;
        int ntu = isc ? CTXL / 64 : KVLEN / 64; asm volatile("" : "+s"(ntu));
        attn8::attn_unit8(qp, 1536, kv8, ntu, op, D, lds_gen, F.tid, mfix, (const float*)(GAS const float*)(F.inq[13]) + j * 64, rc, rs, isc ? 0 : 1, isc ? 0 : (wi & 15) * 256); }
}
__global__ void __launch_bounds__(NTHREADS, 2) fwd(Args a) {
    extern __shared__ __attribute__((aligned(16))) unsigned char lds_raw[];
    unsigned char* const lds_gen = lds_raw;
    const int wave_s = __builtin_amdgcn_readfirstlane((int)threadIdx.x >> 6);
    unsigned char* ws = a.ws;
    if (threadIdx.x < 4) ((LAS unsigned*)((LAS unsigned char*)lds_raw + MISC_OFF))[threadIdx.x] = 0u;
    unsigned long long probe_acc = 0ull, probe_t0 = 0ull; bool probe_open = false; (void)probe_acc; (void)probe_t0; (void)probe_open;
    __syncthreads();
    XcdBarrier bar = xcd_barrier_post((unsigned*)(ws + WS_CTL), (volatile LAS unsigned*)((LAS unsigned char*)lds_raw + MISC_OFF));
    int cur = 0; const int lo = a.ph_lo, hi = a.ph_hi & 0xffff; bool ran = false;
#ifndef PROBE_SITE
#define PROBE_SITE -1
#endif
#define PROBE_STAMP(site_) do { if (PROBE_SITE >= 0) { const unsigned long long now_ = __builtin_amdgcn_s_memrealtime(); \
        if (probe_open) { probe_acc += now_ - probe_t0; probe_open = false; } if ((site_) == PROBE_SITE) { probe_t0 = now_; probe_open = true; } } } while (0)
#define PHASE_BEGIN if (cur >= lo && cur < hi) { if (ran) xcd_barrier(bar, wave_s); ran = true;
#define PHASE_END   } ++cur;

    if (blockIdx.x == 0 && threadIdx.x < 22) ((const float**)(ws + WS_PTRS))[threadIdx.x] = (threadIdx.x < 21) ? a.in[threadIdx.x] : (const float*)a.out;
#define XL ((float*)(GAS float*)(F.inq[21]))
#define X16 ((bf16_t*)(F.ws + WS_X16))
#define H ((bf16_t*)(F.ws + WS_H))
#define MIX ((bf16_t*)(F.ws + WS_MIX))
#define BIG0 ((bf16_t*)(F.ws + WS_BIG0))
#define BIG1 ((bf16_t*)(F.ws + WS_BIG1))
#define GATES ((float*)(F.ws + WS_GATES))
#define AFF ((float*)(F.ws + WS_AFF))
#define INV ((int*)(F.ws + WS_INV))
#define SLROW ((int*)(F.ws + WS_SLROW))
#define SLG ((float*)(F.ws + WS_SLG))
#define IN(k) ((const float*)(GAS const float*)(F.inq[k]))

    PHASE_BEGIN PROBE_STAMP(0); if (PH_ON(0)) for (int rep_ = 0; rep_ < (REP_ON(0) ? 2 : 1); ++rep_) { if (rep_) xcd_barrier(bar, wave_s); Frame F = make_frame(lds_gen, a.ws, wave_s); p0_prologue(F, a.in, F.ws); } PHASE_END

    auto layer_body = [&](auto LC_) {
        constexpr int layer = decltype(LC_)::value;
        constexpr bool last = (layer == DEPTH - 1); constexpr int j = layer >> 1;
#define modv ((const float*)(F.ws + WS_MODV) + (size_t)layer * NMI * 6 * D)
#define xLs ((layer == 0) ? IN(0) : (const float*)XL)
#define xCs ((layer == 0) ? IN(2) : (const float*)XC)
        if ((layer & 1) == 0) {
            if (layer == 0) { PHASE_BEGIN PROBE_STAMP(1); if (PH_ON(1)) for (int rep_ = 0; rep_ < (REP_ON(1) ? 2 : 1); ++rep_) { if (rep_) xcd_barrier(bar, wave_s); Frame F = make_frame(lds_gen, a.ws, wave_s); norm16_pass<1, MLS_FP8_IN != 0, false>(F, IN(0), IN(2), RT, IN(6) + layer * D, modv + 0 * D, modv + 1 * D, H, IN(8) + (size_t)j * D * MW_IN + 3072, MW_IN, IN(9) + j * 16, GATES); } PHASE_END }
            PHASE_BEGIN PROBE_STAMP(2); if (PH_ON(2)) for (int rep_ = 0; rep_ < (REP_ON(2) ? 2 : 1); ++rep_) { if (rep_) xcd_barrier(bar, wave_s); Frame F = make_frame(lds_gen, a.ws, wave_s); { constexpr int KM = MLS_FP8_IN ? D / 2 : D;
                pg8::PlainSched S{(const char*)H, (const char*)(F.ws + WS_WMI + (size_t)j * 3072 * KM * 2), RT / 256, 12, KM, F.G, F.bid};
                pg8::EpiBf16 E{BIG0, 3072, 2, 0.08838834764831845f, MLS_FP8_IN ? 1.f / (FP8_SH * FP8_SW) : 1.f}; pg8::gemm_phase<pg8::EpiBf16, pg8::PlainSched, false, MLS_FP8_IN != 0>(F.lds, F.tid, KM, S, E); if (layer > 0) gates16_pass(F, H, RT, IN(8) + (size_t)j * D * MW_IN + 3072, MW_IN, IN(9) + j * 16, GATES);     moe_weights(F, IN(17) + (size_t)layer * NE * D * D, IN(18) + (size_t)layer * NE * D * D, IN(19) + (size_t)layer * NE * D * D, F.ws, (unsigned*)(F.ws + WS_CNT) + 32 * layer, 3); } } PHASE_END
            PHASE_BEGIN PROBE_STAMP(3); if (PH_ON(3)) for (int rep_ = 0; rep_ < (REP_ON(3) ? 2 : 1); ++rep_) { if (rep_) xcd_barrier(bar, wave_s); Frame F = make_frame(lds_gen, a.ws, wave_s); for (int u = F.vcu; u < 256; u += F.G) { const int half = u & 1, dir = (u >> 1) & 1, hd = (u >> 2) & 3, b = u >> 4;
                mls::mlstm_unit(F, b, hd, dir, half, BIG0, GATES, dir ? MIX : H); } } PHASE_END
            PHASE_BEGIN PROBE_STAMP(4); if (PH_ON(4)) for (int rep_ = 0; rep_ < (REP_ON(4) ? 2 : 1); ++rep_) { if (rep_) xcd_barrier(bar, wave_s); Frame F = make_frame(lds_gen, a.ws, wave_s); mlstm_readout(F, H, MIX, BIG0, IN(10) + j * D, MLS_FP8_OUT ? (bf16_t*)(F.ws + WS_MIX8) : MIX); } PHASE_END
            PHASE_BEGIN PROBE_STAMP(5); if (PH_ON(5)) for (int rep_ = 0; rep_ < (REP_ON(5) ? 2 : 1); ++rep_) { if (rep_) xcd_barrier(bar, wave_s); Frame F = make_frame(lds_gen, a.ws, wave_s); { constexpr int KM = MLS_FP8_OUT ? D / 2 : D;
                pg8::PlainSched S{MLS_FP8_OUT ? (const char*)(F.ws + WS_MIX8) : (const char*)MIX, (const char*)(F.ws + WS_WMO + (size_t)j * D * KM * 2), RT / 256, 4, KM, F.G, F.bid};
                pg8::EpiResid E{IN(0), IN(2), X16, modv + 2 * D, layer == 0, MLS_FP8_OUT ? 1.f / (FP8_SM * FP8_SW) : 1.f}; pg8::gemm_phase<pg8::EpiResid, pg8::PlainSched, false, MLS_FP8_OUT != 0>(F.lds, F.tid, KM, S, E); moe_weights(F, IN(17) + (size_t)layer * NE * D * D, IN(18) + (size_t)layer * NE * D * D, IN(19) + (size_t)layer * NE * D * D, F.ws, (unsigned*)(F.ws + WS_CNT) + 32 * layer, 3); } } PHASE_END
        } else {
#define KALL BIG1
#define VALL (BIG1 + (size_t)NB * KVLEN * 256)
            PHASE_BEGIN PROBE_STAMP(7); if (PH_ON(7)) for (int rep_ = 0; rep_ < (REP_ON(7) ? 2 : 1); ++rep_) { if (rep_) xcd_barrier(bar, wave_s); Frame F = make_frame(lds_gen, a.ws, wave_s); { constexpr int KA = ATT_FP8 ? D / 2 : D;
                pg8::PlainSched S{(const char*)H, (const char*)(F.ws + WS_WAI + (size_t)j * 1536 * KA * 2), RT / 256, 6, KA, F.G, F.bid};
                pg8::EpiBf16 E{BIG0, 1536, 0, 1.f, ATT_FP8 ? 1.f / (FP8_SH * FP8_SW) : 1.f}; pg8::gemm_phase<pg8::EpiBf16, pg8::PlainSched, false, ATT_FP8 != 0>(F.lds, F.tid, KA, S, E); moe_weights(F, IN(17) + (size_t)layer * NE * D * D, IN(18) + (size_t)layer * NE * D * D, IN(19) + (size_t)layer * NE * D * D, F.ws, (unsigned*)(F.ws + WS_CNT) + 32 * layer, 3); } } PHASE_END
            PHASE_BEGIN PROBE_STAMP(8); if (PH_ON(8)) for (int rep_ = 0; rep_ < (REP_ON(8) ? 2 : 1); ++rep_) { if (rep_) xcd_barrier(bar, wave_s); Frame F = make_frame(lds_gen, a.ws, wave_s); kv8_pass(F, BIG0, IN(14) + j * 64, (const float*)(F.ws + WS_ROPE), (const float*)(F.ws + WS_ROPE) + SEQ * 32, F.ws + WS_KV8); } PHASE_END
            PHASE_BEGIN PROBE_STAMP(9); if (PH_ON(9)) for (int rep_ = 0; rep_ < (REP_ON(9) ? 2 : 1); ++rep_) { if (rep_) xcd_barrier(bar, wave_s); Frame F = make_frame(lds_gen, a.ws, wave_s); { const int nun = last ? 4096 : 4096 + 256;
                float mfix; { float gq = fabsf(IN(13)[j * 64 + F.lane]), gk = fabsf(IN(14)[j * 64 + F.lane]);
#pragma unroll
                    for (int o = 1; o < 64; o <<= 1) { gq = fmaxf(gq, shfl_xor_l(gq, o, F.lane)); gk = fmaxf(gk, shfl_xor_l(gk, o, F.lane)); }
                    mfix = attn_body::C2 * 64.f * gq * gk; }
                attn_phase8(F, nun, mfix, j, (char*)lds_gen); } } PHASE_END
            PHASE_BEGIN PROBE_STAMP(10); if (PH_ON(10)) for (int rep_ = 0; rep_ < (REP_ON(10) ? 2 : 1); ++rep_) { if (rep_) xcd_barrier(bar, wave_s); Frame F = make_frame(lds_gen, a.ws, wave_s); { constexpr int KA = ATT_FP8 ? D / 2 : D;
                pg8::PlainSched S{(const char*)MIX, (const char*)(F.ws + WS_WAO + (size_t)j * D * KA * 2), (last ? RL : RT) / 256, 4, KA, F.G, F.bid};
                pg8::EpiResid E{IN(0), IN(2), X16, modv + 2 * D, layer == 0, ATT_FP8 ? 1.f / (FP8_SO * FP8_SW) : 1.f}; pg8::gemm_phase<pg8::EpiResid, pg8::PlainSched, false, ATT_FP8 != 0>(F.lds, F.tid, KA, S, E); moe_weights(F, IN(17) + (size_t)layer * NE * D * D, IN(18) + (size_t)layer * NE * D * D, IN(19) + (size_t)layer * NE * D * D, F.ws, (unsigned*)(F.ws + WS_CNT) + 32 * layer, 3); } } PHASE_END
        }
        const int nrows = last ? RL : RT;
        PHASE_BEGIN PROBE_STAMP(11); if (PH_ON(11)) for (int rep_ = 0; rep_ < (REP_ON(11) ? 2 : 1); ++rep_) { if (rep_) xcd_barrier(bar, wave_s); Frame F = make_frame(lds_gen, a.ws, wave_s); moe_weights(F, IN(17) + (size_t)layer * NE * D * D, IN(18) + (size_t)layer * NE * D * D, IN(19) + (size_t)layer * NE * D * D, F.ws, (unsigned*)(F.ws + WS_CNT) + 32 * layer, 3);
            norm16_pass<2, MOE_FP8_1 != 0, true>(F, (const float*)X16, nullptr, nrows, IN(7) + layer * D, modv + 3 * D, modv + 4 * D, H, IN(16) + (size_t)layer * D * 16, 16, nullptr, AFF); } PHASE_END
        PHASE_BEGIN PROBE_STAMP(12); if (PH_ON(12)) for (int rep_ = 0; rep_ < (REP_ON(12) ? 2 : 1); ++rep_) { if (rep_) xcd_barrier(bar, wave_s); Frame F = make_frame(lds_gen, a.ws, wave_s); moe_select(F, AFF, INV, SLROW, SLG, last ? NB * NE : 2 * NB * NE); } PHASE_END
        PHASE_BEGIN PROBE_STAMP(14); if (PH_ON(14)) for (int rep_ = 0; rep_ < (REP_ON(14) ? 2 : 1); ++rep_) { if (rep_) xcd_barrier(bar, wave_s); Frame F = make_frame(lds_gen, a.ws, wave_s); { constexpr int K1 = MOE_FP8_1 ? D / 2 : D;
            pg8::MoeSched S{(const char*)H, (const char*)(F.ws + WS_W1), last ? 32 : 34, 8, K1, 2048, F.G, F.bid};
            pg8::EpiSwiglu E{(void*)BIG1, MOE_FP8_1 ? 1.f / (FP8_SH * FP8_SW) : 1.f, MOE_FP8_2 != 0}; pg8::gemm_phase<pg8::EpiSwiglu, pg8::MoeSched, true, MOE_FP8_1 != 0>(F.lds, F.tid, K1, S, E, SLROW); } } PHASE_END
        PHASE_BEGIN PROBE_STAMP(15); if (PH_ON(15)) for (int rep_ = 0; rep_ < (REP_ON(15) ? 2 : 1); ++rep_) { if (rep_) xcd_barrier(bar, wave_s); Frame F = make_frame(lds_gen, a.ws, wave_s); { constexpr int K2 = MOE_FP8_2 ? D / 2 : D;
            pg8::MoeSched S{(const char*)BIG1, (const char*)(F.ws + WS_W2), last ? 32 : 34, 4, K2, 1024, F.G, F.bid};
            pg8::EpiRowScale E{(void*)BIG0, SLG, MOE_FP8_2 ? 1.f / (FP8_SA * FP8_SW) : 1.f}; pg8::gemm_phase<pg8::EpiRowScale, pg8::MoeSched, false, MOE_FP8_2 != 0>(F.lds, F.tid, K2, S, E);
            if (!last) moe_weights(F, IN(17) + (size_t)(layer + 1) * NE * D * D, IN(18) + (size_t)(layer + 1) * NE * D * D, IN(19) + (size_t)(layer + 1) * NE * D * D, F.ws, (unsigned*)(F.ws + WS_CNT) + 32 * (layer + 1), 1);     } } PHASE_END
        PHASE_BEGIN PROBE_STAMP(16); if (PH_ON(16)) for (int rep_ = 0; rep_ < (REP_ON(16) ? 2 : 1); ++rep_) { if (rep_) xcd_barrier(bar, wave_s); Frame F = make_frame(lds_gen, a.ws, wave_s);
            const int nl = layer + 1; const float* modn = (const float*)(F.ws + WS_MODV) + (size_t)nl * NMI * 6 * D;
            if (last) combine_norm<3>(F, BIG0, INV, X16, XL, modv + 5 * D, RL, IN(20), nullptr, nullptr, nullptr, nullptr, 0, nullptr, nullptr);
            else if (nl & 1) combine_norm<0, ATT_FP8 != 0>(F, BIG0, INV, X16, nullptr, modv + 5 * D, RT, IN(6) + nl * D, modn + 0 * D, modn + 1 * D, H, nullptr, 0, nullptr, nullptr);
            else combine_norm<0, MLS_FP8_IN != 0>(F, BIG0, INV, X16, nullptr, modv + 5 * D, RT, IN(6) + nl * D, modn + 0 * D, modn + 1 * D, H, nullptr, 0, nullptr, nullptr); } PHASE_END
    };
    layer_body(std::integral_constant<int, 0>{}); layer_body(std::integral_constant<int, 1>{}); layer_body(std::integral_constant<int, 2>{}); layer_body(std::integral_constant<int, 3>{});
    static_assert(DEPTH == 4, "layers");
    if (PROBE_SITE >= 0) { xcd_barrier(bar, wave_s); PROBE_STAMP(99);
        if (blockIdx.x == 0) { const unsigned long long t_end = __builtin_amdgcn_s_memrealtime() + 10ull * probe_acc; while (__builtin_amdgcn_s_memrealtime() < t_end) __builtin_amdgcn_s_sleep(8); } }
#undef XL
#undef X16
#undef H
#undef MIX
#undef BIG0
#undef BIG1
#undef GATES
#undef AFF
#undef INV
#undef SLROW
#undef SLG
#undef IN
#undef modv
#undef xLs
#undef xCs
#undef KALL
#undef VALL
#undef PHASE_BEGIN
#undef PHASE_END
}

extern "C" void kernel_launch(void* const* d_in, const int* in_sizes, int n_in, void* d_out, int out_size, void* d_ws, size_t ws_size, hipStream_t stream) {
    static int grid = 0;
    if (grid == 0) {
        if (n_in != 21 || out_size != RL * D || ws_size < WS_END) { fprintf(stderr, "kernel_launch: unexpected shapes: n_in %d out %d ws %zu (need %zu)\n", n_in, out_size, ws_size, (size_t)WS_END); grid = -1; return; }
        int dev = 0, cus = 0, per_cu = 0;
        if (hipGetDevice(&dev) != hipSuccess || hipDeviceGetAttribute(&cus, hipDeviceAttributeMultiprocessorCount, dev) != hipSuccess) { grid = -1; return; }
        if (hipFuncSetAttribute((const void*)fwd, hipFuncAttributeMaxDynamicSharedMemorySize, LDS_TOTAL) != hipSuccess) { fprintf(stderr, "kernel_launch: hipFuncSetAttribute failed\n"); grid = -1; return; }
        if (hipOccupancyMaxActiveBlocksPerMultiprocessor(&per_cu, (const void*)fwd, NTHREADS, LDS_TOTAL) != hipSuccess || per_cu < 1) fprintf(stderr, "kernel_launch: occupancy query says %d\n", per_cu);
        (void)hipGetLastError();
        grid = cus;
    }
    if (grid < 0) return;
    (void)in_sizes;
    if (hipMemsetAsync((char*)d_ws + WS_CTL, 0, CTL_BYTES, stream) != hipSuccess) return;
    Args a{};
    for (int i = 0; i < 21; ++i) a.in[i] = (const float*)d_in[i];
    a.out = (float*)d_out; a.ws = (unsigned char*)d_ws;
    const int nph = N_PHASES < PH_LIMIT ? N_PHASES : PH_LIMIT;
#if N_LAUNCH_SPLIT
    for (int p = 0; p < nph; ++p) { a.ph_lo = p; a.ph_hi = p + 1; hipLaunchKernelGGL(fwd, dim3(grid), dim3(NTHREADS), LDS_TOTAL, stream, a); }
#else
    a.ph_lo = 0; a.ph_hi = nph;
    hipLaunchKernelGGL(fwd, dim3(grid), dim3(NTHREADS), LDS_TOTAL, stream, a);
#endif
    const hipError_t le = hipPeekAtLastError();
    if (le != hipSuccess) fprintf(stderr, "kernel_launch: launch failed: %s\n", hipGetErrorName(le));
}
```

```cpp
#include <hip/hip_runtime.h>
#include <cstdio>
#include <cstdint>
#include <type_traits>

#define GAS __attribute__((address_space(1)))
#define LAS __attribute__((address_space(3)))
typedef unsigned short bf16_t;
typedef short bf16x8 __attribute__((ext_vector_type(8)));
typedef short s16x4 __attribute__((ext_vector_type(4)));
typedef float f32x4 __attribute__((ext_vector_type(4)));
typedef float f32x2 __attribute__((ext_vector_type(2)));
typedef float f32x16 __attribute__((ext_vector_type(16)));
typedef unsigned u32x4 __attribute__((ext_vector_type(4)));
typedef unsigned u32x2 __attribute__((ext_vector_type(2)));

constexpr int D = 1024, NB = 16, SEQ = 4096, CTXL = 256, DEPTH = 4;
constexpr int RL = NB * SEQ, RC = NB * CTXL, RT = RL + RC;
constexpr int NE = 16, CAP_L = 512, CAP_C = 32, SLOTS_E = NB * CAP_L + NB * CAP_C;
constexpr int NMI = NB + 1;
constexpr int MW_IN = 3088;
constexpr int KVLEN = CTXL + SEQ;
constexpr int NWAVES = 8, NTHREADS = 512;
constexpr float NORM_EPS = 1e-6f;

#ifndef MOE_FP8_1
#define MOE_FP8_1 1
#endif
#ifndef MOE_FP8_2
#define MOE_FP8_2 1
#endif
constexpr size_t al256(size_t x) { return (x + 255) & ~(size_t)255; }
constexpr size_t WS_CTL   = 0;
constexpr size_t CTL_BYTES = 16384;
constexpr size_t WS_CNT   = WS_CTL + 14336;
constexpr size_t WS_PTRS  = WS_CTL + CTL_BYTES;
constexpr size_t WS_MODV  = WS_PTRS + 256;
constexpr size_t WS_ROPE  = al256(WS_MODV + (size_t)DEPTH * NMI * 6 * D * 4);
constexpr size_t WS_X16   = al256(WS_ROPE + (size_t)2 * SEQ * 32 * 4);
constexpr size_t WS_GATES = al256(WS_X16 + (size_t)RT * D * 2);
constexpr size_t WS_AFF   = al256(WS_GATES + (size_t)RT * 16 * 4);
constexpr size_t WS_INV   = al256(WS_AFF + (size_t)RT * 16 * 4);
constexpr size_t WS_SLROW = al256(WS_INV + (size_t)RT * 16 * 4);
constexpr size_t WS_SLG   = al256(WS_SLROW + (size_t)NE * SLOTS_E * 4);
constexpr size_t WS_WMI   = al256(WS_SLG + (size_t)NE * SLOTS_E * 4);
constexpr size_t WS_WMO   = al256(WS_WMI + (size_t)2 * 3072 * D * 2);
constexpr size_t WS_WAI   = al256(WS_WMO + (size_t)2 * D * D * 2);
constexpr size_t WS_WAO   = al256(WS_WAI + (size_t)2 * 1536 * D * 2);
constexpr size_t WS_W1    = al256(WS_WAO + (size_t)2 * D * D * 2);
constexpr size_t WS_W2    = al256(WS_W1 + (size_t)NE * 2048 * D * 2);
constexpr size_t WS_H     = al256(WS_W2 + (size_t)NE * D * D * 2);
constexpr size_t WS_MIX   = al256(WS_H + (size_t)RT * D * 2);
constexpr size_t WS_BIG0  = al256(WS_MIX + (size_t)RT * D * 2);
constexpr size_t BIG_HALF = (size_t)NE * SLOTS_E * D * 2;
constexpr size_t WS_BIG1  = al256(WS_BIG0 + BIG_HALF);
constexpr size_t BIG1_BYTES = MOE_FP8_2 ? BIG_HALF / 2 : BIG_HALF;
constexpr size_t WS_MIX8  = al256(WS_BIG1 + BIG1_BYTES);
constexpr size_t WS_END   = al256(WS_MIX8 + (size_t)RT * D);
constexpr size_t WS_KV8   = WS_MIX8;
static_assert((size_t)NB * 4 * (KVLEN / 64) * 8192 <= (size_t)RT * D, "kv8 fits the readout buffer");
static_assert((size_t)RT * 3072 * 2 <= BIG_HALF + BIG1_BYTES && (size_t)2 * NB * KVLEN * 256 * 2 <= BIG1_BYTES, "qkvo / kv fit");

#define LDS_WAIT() asm volatile("s_waitcnt lgkmcnt(0)" ::: "memory")
#define VM_WAIT() asm volatile("s_waitcnt vmcnt(0)" ::: "memory")
typedef __bf16 bf16x2_t __attribute__((ext_vector_type(2)));
__device__ __forceinline__ unsigned pk2(float lo, float hi) { f32x2 v = {lo, hi}; bf16x2_t b = __builtin_convertvector(v, bf16x2_t); return __builtin_bit_cast(unsigned, b); }
__device__ __forceinline__ unsigned f2bf(float f) { return pk2(f, f) & 0xffffu; }
__device__ __forceinline__ float bf_lo(unsigned u) { return __builtin_bit_cast(float, u << 16); }
__device__ __forceinline__ float bf_hi(unsigned u) { return __builtin_bit_cast(float, u & 0xffff0000u); }
__device__ __forceinline__ float bf2f(bf16_t b) { return __builtin_bit_cast(float, ((unsigned)b) << 16); }
__device__ __forceinline__ unsigned pk_fp8x4(float a, float b, float c, float d) {
    a = __builtin_amdgcn_fmed3f(a, -448.f, 448.f); b = __builtin_amdgcn_fmed3f(b, -448.f, 448.f); c = __builtin_amdgcn_fmed3f(c, -448.f, 448.f); d = __builtin_amdgcn_fmed3f(d, -448.f, 448.f);
    int p = __builtin_amdgcn_cvt_pk_fp8_f32(a, b, 0, false); p = __builtin_amdgcn_cvt_pk_fp8_f32(c, d, p, true); return (unsigned)p; }
#ifndef MLS_FP8_IN
#define MLS_FP8_IN 0
#endif
#ifndef MLS_FP8_OUT
#define MLS_FP8_OUT 1
#endif
#ifndef ATT_FP8
#define ATT_FP8 1
#endif
#ifndef MOE_Y_FP8
#define MOE_Y_FP8 1
#endif
constexpr float FP8_SH = 16.f, FP8_SW = 512.f, FP8_SA = 8.f, FP8_SY = 256.f, FP8_SO = 64.f, FP8_SM = 16.f, FP8_SK = 32.f, FP8_SQ = 32.f, FP8_SV = 32.f;
__device__ __forceinline__ float shfl_xor_l(float v, int o, int lane) { return __int_as_float(__builtin_amdgcn_ds_bpermute((lane ^ o) << 2, __float_as_int(v))); }
__device__ __forceinline__ unsigned shfl_up_l(unsigned v, int o, int lane) { const int src = lane - o; return (unsigned)__builtin_amdgcn_ds_bpermute((src < 0 ? lane : src) << 2, (int)v); }
template <int CTRL> __device__ __forceinline__ float dpp_f(float old, float v) { return __builtin_bit_cast(float, __builtin_amdgcn_update_dpp(__builtin_bit_cast(int, old), __builtin_bit_cast(int, v), CTRL, 0xf, 0xf, false)); }
__device__ __forceinline__ float rdlane(float v, int l) { return __builtin_bit_cast(float, __builtin_amdgcn_readlane(__builtin_bit_cast(int, v), l)); }
__device__ __forceinline__ float row16_sum(float v) {
    v += dpp_f<0xB1>(0.f, v); v += dpp_f<0x4E>(0.f, v); v += dpp_f<0x141>(0.f, v); v += dpp_f<0x140>(0.f, v); return v; }
__device__ __forceinline__ float oct_sum(float v) {
    v += dpp_f<0xB1>(0.f, v); v += dpp_f<0x4E>(0.f, v); v += dpp_f<0x141>(0.f, v); return v; }
__device__ __forceinline__ float quad_sum(float v) { v += dpp_f<0xB1>(0.f, v); v += dpp_f<0x4E>(0.f, v); return v; }
__device__ __forceinline__ float wave_sum(float v) {
    v = row16_sum(v); return (rdlane(v, 0) + rdlane(v, 16)) + (rdlane(v, 32) + rdlane(v, 48)); }
__device__ __forceinline__ float wave_scan_add(float v, int lane) {
    v += dpp_f<0x111>(0.f, v); v += dpp_f<0x112>(0.f, v); v += dpp_f<0x114>(0.f, v); v += dpp_f<0x118>(0.f, v);
    const float t0 = rdlane(v, 15), t1 = rdlane(v, 31), t2 = rdlane(v, 47);
    const int row = lane >> 4; return v + (row == 0 ? 0.f : row == 1 ? t0 : row == 2 ? t0 + t1 : (t0 + t1) + t2); }
__device__ __forceinline__ float wave_scan_max(float v, int lane) {
    const float NI = -INFINITY;
    v = fmaxf(v, dpp_f<0x111>(NI, v)); v = fmaxf(v, dpp_f<0x112>(NI, v)); v = fmaxf(v, dpp_f<0x114>(NI, v)); v = fmaxf(v, dpp_f<0x118>(NI, v));
    const float t0 = rdlane(v, 15), t1 = rdlane(v, 31), t2 = rdlane(v, 47);
    const int row = lane >> 4; return fmaxf(v, row == 0 ? NI : row == 1 ? t0 : row == 2 ? fmaxf(t0, t1) : fmaxf(fmaxf(t0, t1), t2)); }
__device__ __forceinline__ float fast_exp(float x) { return __builtin_amdgcn_exp2f(x * 1.4426950408889634f); }
__device__ __forceinline__ float fast_rcp(float x) { return __builtin_amdgcn_rcpf(x); }
__device__ __forceinline__ float silu_f(float x) { return x / (1.f + __expf(-x)); }

#define XB_TMO      128
#define XB_XCNT(j)  (256  + 64 * (j))
#define XB_XSUB(j)  (1280 + 64 * (j))
#define XB_XGEN(j)  (2304 + 64 * (j))
#define XB_TOP      3328
#define XB_TOPGEN   3392
#define XCD_BAR_WORDS 3456
#define XB_SPIN_CAP (1u << 21)
static_assert(XCD_BAR_WORDS * 4 <= CTL_BYTES, "ctl");

__device__ __forceinline__ unsigned xb_ld(unsigned* p)              { return __hip_atomic_load(p, __ATOMIC_RELAXED, __HIP_MEMORY_SCOPE_AGENT); }
__device__ __forceinline__ unsigned xb_add(unsigned* p, unsigned v) { return __hip_atomic_fetch_add(p, v, __ATOMIC_RELAXED, __HIP_MEMORY_SCOPE_AGENT); }
__device__ __forceinline__ unsigned xb_xcc_id() { return (unsigned)__builtin_amdgcn_s_getreg((3 << 11) | 20) & 0xFu; }
#define XB_SPIN(cond, bar) do { unsigned _sp = 0; while (cond) { __builtin_amdgcn_s_sleep(1); \
    if ((++_sp & 255u) == 0u) { if (xb_ld(&(bar)[XB_TMO])) break; if (_sp > XB_SPIN_CAP) { atomicAdd(&(bar)[XB_TMO], 1u); break; } } } } while (0)

struct XcdBarrier { unsigned* bar; unsigned x; volatile LAS unsigned* st; };

__device__ __forceinline__ XcdBarrier xcd_barrier_post(unsigned* bar, volatile LAS unsigned* st) {
    XcdBarrier b; b.bar = bar; b.x = xb_xcc_id(); b.st = st;
    if (threadIdx.x == 0) (void)xb_add(&bar[XB_XCNT(b.x)], 1u);
    return b;
}
__device__ __forceinline__ void xcd_barrier_complete(unsigned* bar, unsigned x, unsigned& nloc, unsigned& nx) {
    const unsigned G = gridDim.x * gridDim.y * gridDim.z;
    unsigned sum, cnt, mine, sp = 0u;
    for (;;) {
        sum = 0u; cnt = 0u; mine = 0u;
#pragma unroll
        for (unsigned j = 0; j < 16; ++j) { const unsigned c = xb_ld(&bar[XB_XCNT(j)]); sum += c; cnt += (c > 0u) ? 1u : 0u; mine = (j == x) ? c : mine; }
        if (sum == G) break;
        __builtin_amdgcn_s_sleep(1);
        if ((++sp & 255u) == 0u) { if (xb_ld(&bar[XB_TMO])) break; if (sp > XB_SPIN_CAP) { atomicAdd(&bar[XB_TMO], 1u); break; } }
    }
    nloc = mine > 0u ? mine : 1u; nx = cnt > 0u ? cnt : 1u;
}
__device__ __forceinline__ void xcd_barrier(const XcdBarrier& b, const int wave_s) {
    asm volatile("s_waitcnt vmcnt(0)" ::: "memory");
    __syncthreads();
    int ln_; asm volatile("v_mbcnt_lo_u32_b32 %0, -1, 0\n\tv_mbcnt_hi_u32_b32 %0, -1, %0" : "=v"(ln_));
    if (wave_s == 0 && ln_ == 0) {
        unsigned* bar = b.bar;
        __builtin_amdgcn_s_waitcnt(0);
        unsigned nloc = b.st[0], nx = b.st[1];
        if (nloc == 0u) { xcd_barrier_complete(bar, b.x, nloc, nx); b.st[0] = nloc; b.st[1] = nx; }
        const unsigned old = xb_add(&bar[XB_XSUB(b.x)], 1u);
        const unsigned gen = old / nloc;
        if (old + 1u == (gen + 1u) * nloc) {
            __builtin_amdgcn_fence(__ATOMIC_RELEASE, "agent");
            asm volatile("s_waitcnt vmcnt(0)" ::: "memory");
            const unsigned og = xb_add(&bar[XB_TOP], 1u);
            const unsigned tg = og / nx;
            if (og + 1u == (tg + 1u) * nx) xb_add(&bar[XB_TOPGEN], 1u);
            else XB_SPIN(xb_ld(&bar[XB_TOPGEN]) == tg, bar);
            __builtin_amdgcn_fence(__ATOMIC_ACQUIRE, "agent");
            xb_add(&bar[XB_XGEN(b.x)], 1u);
            asm volatile("s_waitcnt vmcnt(0)" ::: "memory");
        } else {
            XB_SPIN(xb_ld(&bar[XB_XGEN(b.x)]) == gen, bar);
            __builtin_amdgcn_fence(__ATOMIC_ACQUIRE, "agent");
            asm volatile("s_waitcnt vmcnt(0)" ::: "memory");
        }
    }
    __syncthreads();
}
namespace pg8 {
constexpr int BM = 256, BK = 64, HALF = 128, HTB = HALF * BK * 2, STAGE_BYTES = 8 * HTB, NXCD = 8, WGM = 4;

__host__ __device__ __forceinline__ int lds_byte(int r, int c) { const int st = (r >> 4) * 2 + (c >> 5), rr = r & 15, cc = c & 31, ob = rr * 64 + cc * 2; return st * 1024 + (ob ^ (((ob >> 9) & 1) << 5)); }
__host__ __device__ __forceinline__ void stage_rc(int b, int& R, int& C) { const int st = b / 1024, sb = b % 1024, swz = sb ^ (((sb >> 9) & 1) << 5); R = (st >> 1) * 16 + swz / 64; C = (st & 1) * 32 + (swz % 64) / 2; }
__host__ __device__ __forceinline__ int perm32(int rho) { const int n = rho >> 4, i = rho & 15; return 8 * (i >> 2) + 4 * n + (i & 3); }

struct Unit { const char* A; const char* B; int pm, pn; };

__device__ __forceinline__ bool static_tile(int i, int G, int c, int nM, int nN, int& pm, int& pn) {
    const int nwg = nM * nN; const long L = (long)i * G + c; if (L >= nwg) return false;
    int wgid = (int)L; { const int q = nwg / NXCD, r = nwg % NXCD, xcd = wgid % NXCD, off = wgid / NXCD; wgid = (xcd < r ? xcd * (q + 1) : r * (q + 1) + (xcd - r) * q) + off; }
    const int nig = WGM * nN, gid = wgid / nig, fm = gid * WGM, gsz = (nM - fm) < WGM ? (nM - fm) : WGM;
    pm = fm + ((wgid % nig) % gsz); pn = (wgid % nig) / gsz; return true;
}
struct PlainSched {
    const char* A; const char* Bt; int nM, nN, K, G, c;
    __device__ __forceinline__ bool next(int i, Unit& u) const {
        int pm, pn; if (!static_tile(i, G, c, nM, nN, pm, pn)) return false;
        u.pm = pm; u.pn = pn; u.A = A + (size_t)pm * 256 * K * 2; u.B = Bt + (size_t)pn * 256 * K * 2; return true;
    }
};
struct MoeSched {
    const char* A; const char* W; int tpe, nN, K, bN, G, c;
    __device__ __forceinline__ bool next(int i, Unit& u) const {
        int pm, pn; if (!static_tile(i, G, c, NE * tpe, nN, pm, pn)) return false;
        const int e = pm / tpe, rt = pm - e * tpe;
        u.pm = e * (SLOTS_E / 256) + rt; u.pn = pn;
        u.A = A + (size_t)u.pm * 256 * K * 2; u.B = W + ((size_t)e * bN + (size_t)pn * 256) * K * 2; return true;
    }
};

__device__ __forceinline__ unsigned cvt_pk_bf16(float lo, float hi) { return pk2(lo, hi); }


struct EpiBf16 {
    static constexpr bool PERM = true; static constexpr int NSTORE = 16;
    bf16_t* O; int ldc; int nscale; float scale; float ds = 1.f;
    __device__ __forceinline__ void operator()(const f32x4 (&acc)[2][2][4][2], const Unit& u, int wr, int wc, int fr, int fq) const {
        const int row0 = u.pm * BM + wr * 64 + fr, col0 = u.pn * BM + wc * 32 + 8 * fq;
        const float s = ((u.pn < nscale) ? scale : 1.f) * ds;
#pragma unroll
        for (int ai = 0; ai < 2; ++ai)
#pragma unroll
            for (int m = 0; m < 4; ++m) { bf16_t* rowp = O + (size_t)(row0 + ai * HALF + m * 16) * ldc + col0;
#pragma unroll
                for (int bj = 0; bj < 2; ++bj) { const f32x4 v0 = acc[ai][bj][m][0] * s, v1 = acc[ai][bj][m][1] * s;
                    u32x4 o; o.x = cvt_pk_bf16(v0[0], v0[1]); o.y = cvt_pk_bf16(v0[2], v0[3]); o.z = cvt_pk_bf16(v1[0], v1[1]); o.w = cvt_pk_bf16(v1[2], v1[3]);
                    *(u32x4*)(rowp + bj * HALF) = o; } }
    }
};
struct EpiResid {
    static constexpr bool PERM = true; static constexpr int NSTORE = 16;
    const float* srcL; const float* srcC; bf16_t* X16; const float* gate; bool f32src; float ds = 1.f;
    __device__ __forceinline__ void operator()(const f32x4 (&acc)[2][2][4][2], const Unit& u, int wr, int wc, int fr, int fq) const {
        const bool isc = u.pm >= RL / 256;
        const int mi = isc ? NB : (u.pm >> 4);
        const int row0 = u.pm * BM + wr * 64 + fr, col0 = u.pn * BM + wc * 32 + 8 * fq;
        const float* gp = gate + (size_t)mi * 6 * D + col0;
        f32x4 gv[2][2];
#pragma unroll
        for (int bj = 0; bj < 2; ++bj)
#pragma unroll
            for (int n = 0; n < 2; ++n) gv[bj][n] = *(const f32x4*)(gp + bj * HALF + n * 4) * ds;
        if (f32src) {
#pragma unroll
            for (int am = 0; am < 4; ++am) { const int ai = am >> 1, mb = (am & 1) * 2; f32x4 xs[2][2][2];
#pragma unroll
                for (int m2 = 0; m2 < 2; ++m2) { const int row = row0 + ai * HALF + (mb + m2) * 16; const float* sp = isc ? (srcC + (size_t)(row - RL) * D + col0) : (srcL + (size_t)row * D + col0);
#pragma unroll
                    for (int bj = 0; bj < 2; ++bj) { xs[m2][bj][0] = __builtin_nontemporal_load((const f32x4*)(sp + bj * HALF)); xs[m2][bj][1] = __builtin_nontemporal_load((const f32x4*)(sp + bj * HALF + 4)); } }
#pragma unroll
                for (int m2 = 0; m2 < 2; ++m2) { const int m = mb + m2; const int row = row0 + ai * HALF + m * 16; bf16_t* xp = X16 + (size_t)row * D + col0;
#pragma unroll
                    for (int bj = 0; bj < 2; ++bj) { const f32x4 v0 = xs[m2][bj][0] + gv[bj][0] * acc[ai][bj][m][0], v1 = xs[m2][bj][1] + gv[bj][1] * acc[ai][bj][m][1];
                        u32x4 o; o.x = cvt_pk_bf16(v0[0], v0[1]); o.y = cvt_pk_bf16(v0[2], v0[3]); o.z = cvt_pk_bf16(v1[0], v1[1]); o.w = cvt_pk_bf16(v1[2], v1[3]);
                        *(u32x4*)(xp + bj * HALF) = o; } } }
        } else {
#pragma unroll
            for (int ai = 0; ai < 2; ++ai) { u32x4 xu[4][2];
#pragma unroll
                for (int m = 0; m < 4; ++m) { const bf16_t* xp = X16 + (size_t)(row0 + ai * HALF + m * 16) * D + col0;
#pragma unroll
                    for (int bj = 0; bj < 2; ++bj) xu[m][bj] = __builtin_nontemporal_load((const u32x4*)(xp + bj * HALF)); }
#pragma unroll
                for (int m = 0; m < 4; ++m) { bf16_t* xp = X16 + (size_t)(row0 + ai * HALF + m * 16) * D + col0;
#pragma unroll
                    for (int bj = 0; bj < 2; ++bj) { const u32x4 t = xu[m][bj];
                        const f32x4 x0 = (f32x4){bf_lo(t.x), bf_hi(t.x), bf_lo(t.y), bf_hi(t.y)}, x1 = (f32x4){bf_lo(t.z), bf_hi(t.z), bf_lo(t.w), bf_hi(t.w)};
                        const f32x4 v0 = x0 + gv[bj][0] * acc[ai][bj][m][0], v1 = x1 + gv[bj][1] * acc[ai][bj][m][1];
                        u32x4 o; o.x = cvt_pk_bf16(v0[0], v0[1]); o.y = cvt_pk_bf16(v0[2], v0[3]); o.z = cvt_pk_bf16(v1[0], v1[1]); o.w = cvt_pk_bf16(v1[2], v1[3]);
                        *(u32x4*)(xp + bj * HALF) = o; } } }
        }
    }
};
struct EpiSwiglu {
    static constexpr bool PERM = true; static constexpr int NSTORE = 8;
    void* O; float ds; bool f8out;
    __device__ __forceinline__ void operator()(const f32x4 (&acc)[2][2][4][2], const Unit& u, int wr, int wc, int fr, int fq) const {
        const int row0 = u.pm * BM + wr * 64 + fr, col0 = u.pn * HALF + wc * 32 + 8 * fq;
#pragma unroll
        for (int ai = 0; ai < 2; ++ai)
#pragma unroll
            for (int m = 0; m < 4; ++m) { const size_t ro = (size_t)(row0 + ai * HALF + m * 16) * D + col0;
                float r[8]; const float kt = -ds * 1.4426950408889634f, cinv = 1.f / (ds * ds * (f8out ? FP8_SA : 1.f));
#pragma unroll
                for (int n = 0; n < 2; ++n)
#pragma unroll
                    for (int j = 0; j < 4; ++j) { const float ag = acc[ai][0][m][n][j], au = acc[ai][1][m][n][j];
                        const float e = __builtin_amdgcn_exp2f(ag * kt); r[n * 4 + j] = (ag * au) * fast_rcp(fmaf(e, cinv, cinv)); }
                if (f8out) { u32x2 o; o.x = pk_fp8x4(r[0], r[1], r[2], r[3]); o.y = pk_fp8x4(r[4], r[5], r[6], r[7]);
                    *(u32x2*)((unsigned char*)O + ro) = o; }
                else { u32x4 o; o.x = cvt_pk_bf16(r[0], r[1]); o.y = cvt_pk_bf16(r[2], r[3]); o.z = cvt_pk_bf16(r[4], r[5]); o.w = cvt_pk_bf16(r[6], r[7]);
                    *(u32x4*)((bf16_t*)O + ro) = o; } }
    }
};
struct EpiRowScale {
    static constexpr bool PERM = true; static constexpr int NSTORE = 16;
    void* O; const float* g; float ds;
    __device__ __forceinline__ void operator()(const f32x4 (&acc)[2][2][4][2], const Unit& u, int wr, int wc, int fr, int fq) const {
        const int row0 = u.pm * BM + wr * 64 + fr, col0 = u.pn * BM + wc * 32 + 8 * fq;
#pragma unroll
        for (int ai = 0; ai < 2; ++ai)
#pragma unroll
            for (int m = 0; m < 4; ++m) { const int row = row0 + ai * HALF + m * 16; const float s = g[row] * ds * (MOE_Y_FP8 ? FP8_SY : 1.f); const size_t ro = (size_t)row * D + col0;
                if (MOE_Y_FP8) {
                    u32x2 o0, o1;
                    { const f32x4 v0 = acc[ai][0][m][0] * s, v1 = acc[ai][0][m][1] * s; o0.x = pk_fp8x4(v0[0], v0[1], v0[2], v0[3]); o0.y = pk_fp8x4(v1[0], v1[1], v1[2], v1[3]); }
                    { const f32x4 v0 = acc[ai][1][m][0] * s, v1 = acc[ai][1][m][1] * s; o1.x = pk_fp8x4(v0[0], v0[1], v0[2], v0[3]); o1.y = pk_fp8x4(v1[0], v1[1], v1[2], v1[3]); }
                    const auto sx = __builtin_amdgcn_permlane16_swap(o0.x, o1.x, false, false), sy = __builtin_amdgcn_permlane16_swap(o0.y, o1.y, false, false);
                    const u32x4 w4 = {sx[0], sy[0], sx[1], sy[1]};
                    *(u32x4*)((unsigned char*)O + ro + ((fq & 1) ? HALF - 8 : 0)) = w4;
                    continue; }
#pragma unroll
                for (int bj = 0; bj < 2; ++bj) { const f32x4 v0 = acc[ai][bj][m][0] * s, v1 = acc[ai][bj][m][1] * s;
                    if (MOE_Y_FP8) { u32x2 o; o.x = pk_fp8x4(v0[0], v0[1], v0[2], v0[3]); o.y = pk_fp8x4(v1[0], v1[1], v1[2], v1[3]); *(u32x2*)((unsigned char*)O + ro + bj * HALF) = o; }
                    else { u32x4 o; o.x = cvt_pk_bf16(v0[0], v0[1]); o.y = cvt_pk_bf16(v0[2], v0[3]); o.z = cvt_pk_bf16(v1[0], v1[1]); o.w = cvt_pk_bf16(v1[2], v1[3]);
                        *(u32x4*)((bf16_t*)O + ro + bj * HALF) = o; } } }
    }
};

template <class Epi, class Sched, bool GATHER = false, bool FP8 = false>
__device__ __forceinline__ void gemm_phase(LAS unsigned char* lds, const int tid, const int K, const Sched& S, const Epi& E, const int* rowidx = nullptr) {
    const int wid = __builtin_amdgcn_readfirstlane(tid >> 6), lane = tid & 63, wr = wid >> 2, wc = wid & 3, fr = lane & 15, fq = lane >> 4;
    const int nt = K / BK;
    unsigned voffA[2], voffB[2]; int gR[2], gC[2];
#pragma unroll
    for (int i = 0; i < 2; ++i) { int R, C; stage_rc(tid * 16 + i * 8192, R, C); const int Rb = Epi::PERM ? ((R & ~31) + perm32(R & 31)) : R;
        voffA[i] = (unsigned)(R * K + C) * 2u; voffB[i] = (unsigned)(Rb * K + C) * 2u; gR[i] = R; gC[i] = C * 2; }
    unsigned gcur[2][2]; int gnxt[2][2];
#define PG8_GRAW(dst, unit) do { if (GATHER) { _Pragma("unroll") for (int h_ = 0; h_ < 2; ++h_) _Pragma("unroll") for (int i_ = 0; i_ < 2; ++i_) dst[h_][i_] = rowidx[(unit).pm * 256 + h_ * 128 + gR[i_]]; } } while (0)
#define PG8_GOFF(raw, i_) ((unsigned)(raw) * (unsigned)(K * 2) + (unsigned)gC[i_])
    const size_t kstep = (size_t)(BK * 2);
    const size_t hstep = (size_t)HALF * K * 2;
    const unsigned ldsw = (unsigned)wid * 1024u;
    const int aoff = lds_byte(wr * 64 + fr, fq * 8), boff = lds_byte(wc * 32 + fr, fq * 8);
#define PG8_SA(b, h) (((b) * 2 + (h)) * HTB)
#define PG8_SB(b, h) ((4 + (b) * 2 + (h)) * HTB)
#define PG8_STAGE(bufoff, gbase, voff) do { _Pragma("unroll") for (int _i = 0; _i < 2; ++_i) \
        __builtin_amdgcn_global_load_lds((const unsigned*)((const char*)(gbase) + (voff)[_i]), (LAS unsigned*)(lds + (bufoff) + ldsw + _i * 8192), 16, 0, 0); } while (0)
#define PG8_STAGE_A(b, h, gbase, NX) do { if (GATHER) { unsigned go_[2]; go_[0] = (NX) ? PG8_GOFF(gnxt[h][0], 0) : gcur[h][0]; go_[1] = (NX) ? PG8_GOFF(gnxt[h][1], 1) : gcur[h][1]; PG8_STAGE(PG8_SA(b, h), (gbase), go_); } \
        else { PG8_STAGE(PG8_SA(b, h), (gbase) + (h) * hstep, voffA); } } while (0)
#define PG8_LDA(dst, b, h) do { _Pragma("unroll") for (int m = 0; m < 4; ++m) _Pragma("unroll") for (int k = 0; k < 2; ++k) dst[m][k] = *(const LAS bf16x8*)(lds + PG8_SA(b, h) + aoff + m * 2048 + k * 1024); } while (0)
#define PG8_LDB(dst, b, h) do { _Pragma("unroll") for (int n = 0; n < 2; ++n) _Pragma("unroll") for (int k = 0; k < 2; ++k) dst[n][k] = *(const LAS bf16x8*)(lds + PG8_SB(b, h) + boff + n * 2048 + k * 1024); } while (0)
#define PG8_MMA(ai, bj, At, Bt) do { __builtin_amdgcn_s_setprio(1); if (FP8) { _Pragma("unroll") for (int m = 0; m < 4; ++m) _Pragma("unroll") for (int n = 0; n < 2; ++n) { \
            typedef int v8i_ __attribute__((ext_vector_type(8))); typedef int v4i_ __attribute__((ext_vector_type(4))); \
            const v4i_ b0_ = __builtin_bit_cast(v4i_, Bt[n][0]), b1_ = __builtin_bit_cast(v4i_, Bt[n][1]), a0_ = __builtin_bit_cast(v4i_, At[m][0]), a1_ = __builtin_bit_cast(v4i_, At[m][1]); \
            const v8i_ bb_ = {b0_[0], b0_[1], b0_[2], b0_[3], b1_[0], b1_[1], b1_[2], b1_[3]}, aa_ = {a0_[0], a0_[1], a0_[2], a0_[3], a1_[0], a1_[1], a1_[2], a1_[3]}; \
            asm volatile("v_mfma_scale_f32_16x16x128_f8f6f4 %0, %1, %2, %0, %3, %3 op_sel_hi:[0,0,0]" : "+v"(acc[ai][bj][m][n]) : "v"(bb_), "v"(aa_), "v"(sc127)); } } \
        else { _Pragma("unroll") for (int m = 0; m < 4; ++m) _Pragma("unroll") for (int n = 0; n < 2; ++n) _Pragma("unroll") for (int k = 0; k < 2; ++k) \
        acc[ai][bj][m][n] = __builtin_amdgcn_mfma_f32_16x16x32_bf16(Bt[n][k], At[m][k], acc[ai][bj][m][n], 0, 0, 0); } __builtin_amdgcn_s_setprio(0); } while (0)
#define PG8_WAIT_V(n) asm volatile("s_waitcnt vmcnt(" #n ")" ::: "memory")
#define PG8_WAIT_VE() do { if (Epi::NSTORE == 32) asm volatile("s_waitcnt vmcnt(40)" ::: "memory"); else if (Epi::NSTORE == 16) asm volatile("s_waitcnt vmcnt(24)" ::: "memory"); else asm volatile("s_waitcnt vmcnt(16)" ::: "memory"); } while (0)
#define PG8_WAIT_L(n) asm volatile("s_waitcnt lgkmcnt(" #n ")" ::: "memory")
#define PG8_BAR __builtin_amdgcn_s_barrier()
#define PG8_SCHED __builtin_amdgcn_sched_barrier(0)
    Unit cur, nxt; int ui = 0;
    if (!S.next(0, cur)) return;
    int sc127 = 0x7F7F7F7F; asm volatile("" : "+v"(sc127));
    f32x4 acc[2][2][4][2];
#pragma unroll
    for (int a = 0; a < 2; ++a)
#pragma unroll
        for (int b = 0; b < 2; ++b)
#pragma unroll
            for (int m = 0; m < 4; ++m)
#pragma unroll
                for (int n = 0; n < 2; ++n) acc[a][b][m][n] = (f32x4){0.f, 0.f, 0.f, 0.f};
    bf16x8 At[4][2], B0[2][2], B1[2][2];
    const char* cA = GATHER ? S.A : cur.A; const char* cB = cur.B;
    if (GATHER) { int g0_[2][2]; PG8_GRAW(g0_, cur); _Pragma("unroll") for (int h_ = 0; h_ < 2; ++h_) { gcur[h_][0] = PG8_GOFF(g0_[h_][0], 0); gcur[h_][1] = PG8_GOFF(g0_[h_][1], 1); } }
    PG8_STAGE(PG8_SB(0, 0), cB, voffB); PG8_STAGE(PG8_SB(0, 1), cB + hstep, voffB); PG8_STAGE_A(0, 0, cA, false); PG8_STAGE_A(0, 1, cA, false);
    if (wr == 1) PG8_BAR;
    PG8_WAIT_V(2); PG8_BAR;
    PG8_STAGE(PG8_SB(1, 0), cB + kstep, voffB); PG8_STAGE_A(1, 0, cA + kstep, false); PG8_STAGE(PG8_SB(1, 1), cB + hstep + kstep, voffB);
    PG8_WAIT_V(6); PG8_BAR;
    for (;;) {
        const bool has_next = S.next(ui + 1, nxt);
        const char* nA = (has_next && !GATHER) ? nxt.A : cA; const char* nB = has_next ? nxt.B : cB;
        if (GATHER) { if (has_next) { PG8_GRAW(gnxt, nxt); } else { PG8_GRAW(gnxt, cur); } }
#pragma unroll 1
        for (int t = 0; t < nt; t += 2) {
            const bool last = (t == nt - 2);
            const char* a1 = cA + (size_t)(t + 1) * kstep;
            const char* a2 = last ? nA : cA + (size_t)(t + 2) * kstep; const char* b2 = last ? nB : cB + (size_t)(t + 2) * kstep;
            const char* a3 = a2 + kstep; const char* b3 = b2 + kstep;
            PG8_LDB(B0, 0, 0); PG8_LDB(B1, 0, 1); PG8_SCHED; PG8_LDA(At, 0, 0); PG8_STAGE_A(1, 1, a1, false);
            PG8_WAIT_V(8); PG8_WAIT_L(0); PG8_BAR; PG8_MMA(0, 0, At, B0); PG8_MMA(0, 1, At, B1); PG8_BAR; PG8_SCHED;
            PG8_LDA(At, 0, 1); PG8_STAGE(PG8_SB(0, 0), b2, voffB); PG8_STAGE(PG8_SB(0, 1), b2 + hstep, voffB); PG8_STAGE_A(0, 0, a2, last);
            PG8_WAIT_V(8); PG8_WAIT_L(0); PG8_BAR; PG8_MMA(1, 0, At, B0); PG8_MMA(1, 1, At, B1); PG8_BAR; PG8_SCHED;
            PG8_LDB(B0, 1, 0); PG8_LDB(B1, 1, 1); PG8_SCHED; PG8_LDA(At, 1, 0); PG8_STAGE_A(0, 1, a2, last);
            PG8_WAIT_V(8); PG8_WAIT_L(0); PG8_BAR; PG8_MMA(0, 0, At, B0); PG8_MMA(0, 1, At, B1); PG8_BAR; PG8_SCHED;
            PG8_LDA(At, 1, 1); PG8_STAGE(PG8_SB(1, 0), b3, voffB); PG8_STAGE(PG8_SB(1, 1), b3 + hstep, voffB); PG8_STAGE_A(1, 0, a3, last);
            PG8_WAIT_V(8); PG8_WAIT_L(0); PG8_BAR; PG8_MMA(1, 0, At, B0); PG8_MMA(1, 1, At, B1); PG8_BAR; PG8_SCHED;
        }
        if (wr == 0) PG8_BAR;
        if (FP8) asm volatile("s_nop 15\n\ts_nop 15" ::: "memory");
        { int tz = tid; asm volatile("" : "+v"(tz));
          const int wid2 = __builtin_amdgcn_readfirstlane(tz >> 6), lane2 = tz & 63;
          E(acc, cur, wid2 >> 2, wid2 & 3, lane2 & 15, lane2 >> 4); }
        if (!has_next) break;
#pragma unroll
        for (int a = 0; a < 2; ++a)
#pragma unroll
            for (int b = 0; b < 2; ++b)
#pragma unroll
                for (int m = 0; m < 4; ++m)
#pragma unroll
                    for (int n = 0; n < 2; ++n) acc[a][b][m][n] = (f32x4){0.f, 0.f, 0.f, 0.f};
        cur = nxt; cA = nA; cB = nB; ++ui;
        if (GATHER) { _Pragma("unroll") for (int h_ = 0; h_ < 2; ++h_) { gcur[h_][0] = PG8_GOFF(gnxt[h_][0], 0); gcur[h_][1] = PG8_GOFF(gnxt[h_][1], 1); } }
        if (wr == 1) PG8_BAR;
    }
    PG8_WAIT_V(0);
    PG8_BAR;
#undef PG8_SA
#undef PG8_SB
#undef PG8_STAGE
#undef PG8_STAGE_A
#undef PG8_GRAW
#undef PG8_GOFF
#undef PG8_LDA
#undef PG8_LDB
#undef PG8_MMA
#undef PG8_WAIT_V
#undef PG8_WAIT_VE
#undef PG8_WAIT_L
#undef PG8_BAR
#undef PG8_SCHED
}
}
namespace attn_body {
constexpr int NW = 8, QBLK = 32, QB = QBLK * NW, KVBLK = 64;
__device__ __forceinline__ int crow(int r, int hi) { return (r & 3) + 8 * (r >> 2) + 4 * hi; }
#define SBAR() __builtin_amdgcn_sched_barrier(0)
constexpr int NSLOT = 3, SLOTB = 8192;
constexpr int LDS_K = 0, LDS_V = NSLOT * SLOTB, LDS_WS = 2 * NSLOT * SLOTB, LDS_OST = LDS_WS + NW * 64 * 4, LDS_BYTES = LDS_OST + NW * 4096;
constexpr float C2 = 0.125f * 1.4426950408889634f;
__device__ __forceinline__ void glds16(const void* gsrc, unsigned lds_dst) { unsigned keep;
  asm volatile("s_mov_b32 %0, m0\n\ts_mov_b32 m0, %2\n\ts_nop 0\n\tglobal_load_lds_dwordx4 %1, off\n\ts_mov_b32 m0, %0" : "=&s"(keep) : "v"(gsrc), "s"(lds_dst) : "memory"); }
__device__ __forceinline__ float max3f(float a, float b, float c) { float r; asm("v_max3_f32 %0, %1, %2, %3" : "=v"(r) : "v"(a), "v"(b), "v"(c)); return r; }
__device__ __forceinline__ float max2f(float a, float b) { float r; asm("v_max_f32_e32 %0, %1, %2" : "=v"(r) : "v"(a), "v"(b)); return r; }
__device__ __forceinline__ float fadd_s(float a, float b) { float r; asm("v_add_f32_e32 %0, %1, %2" : "=v"(r) : "v"(a), "v"(b)); return r; }
__device__ __forceinline__ float fsub_s(float a, float b) { float r; asm("v_sub_f32_e32 %0, %1, %2" : "=v"(r) : "v"(a), "v"(b)); return r; }
__device__ __forceinline__ unsigned cvtpk_s(float lo, float hi) { f32x2 v = {lo, hi}; bf16x2_t b = __builtin_convertvector(v, bf16x2_t); return __builtin_bit_cast(unsigned, b); }
#define WAIT_BAR(N) asm volatile("s_waitcnt vmcnt(" #N ") lgkmcnt(0)\n\ts_barrier" ::: "memory")

__device__ __forceinline__ void qkt(f32x16& p0, f32x16& p1, const char* Kslot, const bf16x8* qr, const f32x16& negm, int r32, int hi) {
  const char* kb = Kslot + hi * 1024 + r32 * 16;
  #pragma unroll
  for (int d0 = 0; d0 < 4; ++d0) {
    const bf16x8 b0 = *reinterpret_cast<const bf16x8*>(kb + d0 * 2048);
    const bf16x8 b1 = *reinterpret_cast<const bf16x8*>(kb + d0 * 2048 + 512);
    if (d0 == 0) { p0 = __builtin_amdgcn_mfma_f32_32x32x16_bf16(b0, qr[0], negm, 0, 0, 0); p1 = __builtin_amdgcn_mfma_f32_32x32x16_bf16(b1, qr[0], negm, 0, 0, 0); }
    else { p0 = __builtin_amdgcn_mfma_f32_32x32x16_bf16(b0, qr[d0], p0, 0, 0, 0); p1 = __builtin_amdgcn_mfma_f32_32x32x16_bf16(b1, qr[d0], p1, 0, 0, 0); } }
}
typedef __attribute__((address_space(3))) const char* lds_cptr;
typedef short v4i16_t __attribute__((ext_vector_type(4)));
__device__ __forceinline__ void kload8(bf16x8* kf, lds_cptr kp) {
  kf[0] = *(const LAS bf16x8*)(kp);        kf[1] = *(const LAS bf16x8*)(kp + 512);
  kf[2] = *(const LAS bf16x8*)(kp + 2048); kf[3] = *(const LAS bf16x8*)(kp + 2560);
  kf[4] = *(const LAS bf16x8*)(kp + 4096); kf[5] = *(const LAS bf16x8*)(kp + 4608);
  kf[6] = *(const LAS bf16x8*)(kp + 6144); kf[7] = *(const LAS bf16x8*)(kp + 6656);
}
__device__ __forceinline__ void kload2(bf16x8* kf, lds_cptr kp, int j) { kf[2 * j] = *(const LAS bf16x8*)(kp + j * 2048); kf[2 * j + 1] = *(const LAS bf16x8*)(kp + j * 2048 + 512); }
__device__ __forceinline__ s16x4 vtr(lds_cptr p) { return __builtin_bit_cast(s16x4, __builtin_amdgcn_ds_read_tr16_b64_v4i16((LAS v4i16_t*)p)); }
__device__ __forceinline__ float rowmax(const f32x16& p0, const f32x16& p1) {
  float a = max3f(p0[0], p0[1], p1[0]), b = max3f(p0[2], p0[3], p1[1]); a = max3f(a, p1[2], p1[3]);
  #pragma unroll
  for (int r = 4; r < 16; r += 4) { a = max3f(a, p0[r], p0[r + 1]); b = max3f(b, p0[r + 2], p0[r + 3]); a = max3f(a, p1[r], p1[r + 1]); b = max3f(b, p1[r + 2], p1[r + 3]); }
  const float m = max2f(a, b);
  auto rr = __builtin_amdgcn_permlane32_swap(__float_as_uint(m), __float_as_uint(m), false, false);
  return max2f(__uint_as_float(rr[0]), __uint_as_float(rr[1]));
}
__device__ __forceinline__ void pv(f32x16* o, int vb, bf16x8 pa0, bf16x8 pa1, bf16x8 pa2, bf16x8 pa3) {
  #pragma unroll
  for (int d0 = 0; d0 < 2; ++d0) { s16x4 lo[4], hi[4];
    #pragma unroll
    for (int ks = 0; ks < 4; ++ks) {
      asm volatile("ds_read_b64_tr_b16 %0,%1 offset:%c2" : "=&v"(lo[ks]) : "v"(vb), "i"(d0 * 4096 + ks * 1024) : "memory");
      asm volatile("ds_read_b64_tr_b16 %0,%1 offset:%c2" : "=&v"(hi[ks]) : "v"(vb), "i"(d0 * 4096 + ks * 1024 + 512) : "memory"); }
    asm volatile("s_waitcnt lgkmcnt(0)" ::: "memory"); SBAR();
    #define PK(k) (bf16x8){lo[k][0], lo[k][1], lo[k][2], lo[k][3], hi[k][0], hi[k][1], hi[k][2], hi[k][3]}
    o[d0] = __builtin_amdgcn_mfma_f32_32x32x16_bf16(pa0, PK(0), o[d0], 0, 0, 0);
    o[d0] = __builtin_amdgcn_mfma_f32_32x32x16_bf16(pa1, PK(1), o[d0], 0, 0, 0);
    o[d0] = __builtin_amdgcn_mfma_f32_32x32x16_bf16(pa2, PK(2), o[d0], 0, 0, 0);
    o[d0] = __builtin_amdgcn_mfma_f32_32x32x16_bf16(pa3, PK(3), o[d0], 0, 0, 0);
    #undef PK
  }
}

template <int VAR> __device__ __forceinline__ void attn_unit(const bf16_t* Qrow0, int QP, const bf16_t* __restrict__ Kc, const bf16_t* __restrict__ Vc, const bf16_t* __restrict__ Kl, const bf16_t* __restrict__ Vl, int NC, int KVP, int NT,
                                                              bf16_t* Orow0, int OP, char* shm, const int tid, const float mfix, const float* qn, const float* ropec, const float* ropes, const int rope, const int tq0) {
  const int lane = tid & 63, r32 = lane & 31, hi = lane >> 5; const int wid = __builtin_amdgcn_readfirstlane(tid >> 6);
  const bf16_t* Qw = Qrow0 + (long)(wid * QBLK) * QP;
  const unsigned lds0 = (unsigned)(uintptr_t)shm;
  float* wsf = (float*)(shm + LDS_WS) + wid * 64;
  const long koff = (long)lane * KVP + wid * 8, voff = (long)(16 * (wid & 3) + (lane >> 2)) * KVP + (wid >> 2) * 32 + (lane & 3) * 8;
  const bf16_t* ksrc_c = Kc + koff; const bf16_t* vsrc_c = Vc + voff; const bf16_t* ksrc_l = Kl + koff - (long)NC * KVBLK * KVP; const bf16_t* vsrc_l = Vl + voff - (long)NC * KVBLK * KVP;
  const unsigned kdst = lds0 + LDS_K + wid * 1024, vdst = lds0 + LDS_V + wid * 1024;
  #define DMA_K(t, slot) glds16(((t) < NC ? ksrc_c : ksrc_l) + (long)(t) * KVBLK * KVP, (unsigned)__builtin_amdgcn_readfirstlane(kdst + (slot)))
  #define DMA_V(t, slot) glds16(((t) < NC ? vsrc_c : vsrc_l) + (long)(t) * KVBLK * KVP, (unsigned)__builtin_amdgcn_readfirstlane(vdst + (slot)))
  const int vb0 = (int)(lds0 + LDS_V) + ((lane >> 4) & 1) * 32 + (lane & 3) * 8 + (4 * hi + ((lane & 15) >> 2)) * 64;
  const char* Kbase = shm + LDS_K; bf16x8 kf[8];
  const lds_cptr shm3 = (lds_cptr)shm; const lds_cptr kp0 = shm3 + LDS_K + hi * 1024 + r32 * 16; const lds_cptr vp0 = shm3 + LDS_V + ((lane >> 4) & 1) * 32 + (lane & 3) * 8 + (4 * hi + ((lane & 15) >> 2)) * 64;
  DMA_K(0, 0); DMA_V(0, 0); DMA_K(1, SLOTB);
  bf16x8 qr[4];
  #pragma unroll
  for (int d0 = 0; d0 < 4; ++d0) qr[d0] = *reinterpret_cast<const bf16x8*>(&Qw[(long)r32 * QP + d0 * 16 + hi * 8]);
  {
    float x[4][8];
    #pragma unroll
    for (int d0 = 0; d0 < 4; ++d0) { const u32x4 u = __builtin_bit_cast(u32x4, qr[d0]);
      x[d0][0] = bf_lo(u.x); x[d0][1] = bf_hi(u.x); x[d0][2] = bf_lo(u.y); x[d0][3] = bf_hi(u.y); x[d0][4] = bf_lo(u.z); x[d0][5] = bf_hi(u.z); x[d0][6] = bf_lo(u.w); x[d0][7] = bf_hi(u.w); }
    float ss = 0.f;
    #pragma unroll
    for (int d0 = 0; d0 < 4; ++d0)
      #pragma unroll
      for (int t = 0; t < 8; ++t) ss += x[d0][t] * x[d0][t];
    { auto rr = __builtin_amdgcn_permlane32_swap(__float_as_uint(ss), __float_as_uint(ss), false, false); ss = __uint_as_float(rr[0]) + __uint_as_float(rr[1]); }
    const float rstd = rsqrtf(ss * (1.f / 64.f) + NORM_EPS) * C2;
    #pragma unroll
    for (int d0 = 0; d0 < 4; ++d0) { const f32x4 g0 = *(const f32x4*)(qn + 16 * d0 + 8 * hi), g1 = *(const f32x4*)(qn + 16 * d0 + 8 * hi + 4);
      x[d0][0] *= rstd * g0.x; x[d0][1] *= rstd * g0.y; x[d0][2] *= rstd * g0.z; x[d0][3] *= rstd * g0.w; x[d0][4] *= rstd * g1.x; x[d0][5] *= rstd * g1.y; x[d0][6] *= rstd * g1.z; x[d0][7] *= rstd * g1.w; }
    if (rope) { const int tq = tq0 + wid * QBLK + r32;
      #pragma unroll
      for (int d0 = 0; d0 < 2; ++d0) { const float* cp = ropec + (long)tq * 32 + 16 * d0 + 8 * hi; const float* sp = ropes + (long)tq * 32 + 16 * d0 + 8 * hi;
        const f32x4 c0 = *(const f32x4*)cp, c1 = *(const f32x4*)(cp + 4), s0 = *(const f32x4*)sp, s1 = *(const f32x4*)(sp + 4);
        const float cs[8] = {c0.x, c0.y, c0.z, c0.w, c1.x, c1.y, c1.z, c1.w}, sn[8] = {s0.x, s0.y, s0.z, s0.w, s1.x, s1.y, s1.z, s1.w};
        #pragma unroll
        for (int t = 0; t < 8; ++t) { const float a = x[d0][t], c = x[d0 + 2][t]; x[d0][t] = a * cs[t] - c * sn[t]; x[d0 + 2][t] = a * sn[t] + c * cs[t]; } } }
    #pragma unroll
    for (int d0 = 0; d0 < 4; ++d0) { u32x4 u; u.x = pk2(x[d0][0], x[d0][1]); u.y = pk2(x[d0][2], x[d0][3]); u.z = pk2(x[d0][4], x[d0][5]); u.w = pk2(x[d0][6], x[d0][7]); qr[d0] = __builtin_bit_cast(bf16x8, u); }
  }
  float l_reg = 0.f; f32x16 o[2]; o[0] = f32x16{}; o[1] = f32x16{}; const f32x16 negm = f32x16{}; (void)mfix;
  #define START(P0, P1) do { _Pragma("unroll") for (int r = 0; r < 16; ++r) P0[r] = __builtin_amdgcn_exp2f(P0[r]); } while (0)
  #define RESC() do { } while (0)
  f32x16 pA0, pA1, pB0, pB1;
  int sl_prev = 0, sl_cur = 0, sl_next = SLOTB;
  #define ROT() do { sl_prev = sl_cur; sl_cur = sl_next; sl_next = (sl_next == (NSLOT - 1) * SLOTB) ? 0 : sl_next + SLOTB; } while (0)
  DMA_K(2, 2 * SLOTB);
  WAIT_BAR(3);
  qkt(pA0, pA1, Kbase, qr, negm, r32, hi); asm volatile("s_nop 15\n\ts_nop 7" : "+v"(pA0), "+v"(pA1));
  START(pA0, pA1);
  _Pragma("unroll") for (int r = 0; r < 16; ++r) pA1[r] = __builtin_amdgcn_exp2f(pA1[r]);
  WAIT_BAR(0);
  DMA_K(3, 0); DMA_V(1, SLOTB);
  ROT();
  kload8(kf, kp0 + sl_cur);
  WAIT_BAR(2);
  s16x4 vlo[8], vhi[8]; u32x4 pw0, pw1, pw2, pw3;
  #define PKW(P, B) cvtpk_s(P[B], P[B + 1])
  #define PAF(k) __builtin_bit_cast(bf16x8, pw##k)
  #define VFR(i) (bf16x8){vlo[i][0], vlo[i][1], vlo[i][2], vlo[i][3], vhi[i][0], vhi[i][1], vhi[i][2], vhi[i][3]}
  #define PIN(x) asm volatile("" : "+v"(x))
  #define MX3(a, b, c) __builtin_fmaxf(__builtin_fmaxf((a), (b)), (c))
  #define GAPA(MF, A0, A1, A2, A3, W0, W1, PW) do { MF; sacc += A0; sacc += A1; sacc += A2; sacc += A3; PIN(sacc); W0; W1; PIN(PW); SBAR(); } while (0)
  #define EX(v) __builtin_amdgcn_exp2f(v)
  #define GAPB(MF, X, B) do { MF; X[B] = EX(X[B]); X[B + 1] = EX(X[B + 1]); X[B + 2] = EX(X[B + 2]); X[B + 3] = EX(X[B + 3]); PIN(X); SBAR(); } while (0)
  #define VRD(i) do { if (VAR < 2 || ((i) & 3) == 0) { vlo[i] = vtr(vp_ + (((i) >> 2) * 4096 + ((i) & 3) * 1024)); vhi[i] = vtr(vp_ + (((i) >> 2) * 4096 + ((i) & 3) * 1024 + 512)); } } while (0)
  #define KRD(G, j) do { if ((G) && (VAR == 0 || (j) < 2)) { kload2(kf, kp0 + sl_next, j); SBAR(); } } while (0)
  #define QM(i, e) do { if (VAR == 0 || (i) < 2) { e; } } while (0)
  #define PM(i, e) do { if (VAR < 2 || (i) < 2) { e; } } while (0)
  #define STEP(C0, C1, P0, P1, t, GK, GV, GL) do { SBAR(); \
    const lds_cptr vp_ = vp0 + sl_prev; \
    VRD(0); SBAR(); float sacc = (P0[0] + P0[1]); \
    GAPA(QM(0, C0 = __builtin_amdgcn_mfma_f32_32x32x16_bf16(kf[0], qr[0], negm, 0, 0, 0)), P0[2], P0[3], P0[4], P0[5],     pw0[0] = PKW(P0, 0), pw0[1] = PKW(P0, 2), pw0); \
    VRD(4); SBAR(); GAPA(QM(1, C1 = __builtin_amdgcn_mfma_f32_32x32x16_bf16(kf[1], qr[0], negm, 0, 0, 0)), P0[6], P0[7], P0[8], P0[9],     pw0[2] = PKW(P0, 4), pw0[3] = PKW(P0, 6), pw0); \
    VRD(1); SBAR(); GAPA(QM(2, C0 = __builtin_amdgcn_mfma_f32_32x32x16_bf16(kf[2], qr[1], C0, 0, 0, 0)),   P0[10], P0[11], P0[12], P0[13], pw1[0] = PKW(P0, 8), pw1[1] = PKW(P0, 10), pw1); \
    VRD(5); SBAR(); GAPA(QM(3, C1 = __builtin_amdgcn_mfma_f32_32x32x16_bf16(kf[3], qr[1], C1, 0, 0, 0)),   P0[14], P0[15], P1[0], P1[1],   pw1[2] = PKW(P0, 12), pw1[3] = PKW(P0, 14), pw1); \
    VRD(2); SBAR(); GAPA(QM(4, C0 = __builtin_amdgcn_mfma_f32_32x32x16_bf16(kf[4], qr[2], C0, 0, 0, 0)),   P1[2], P1[3], P1[4], P1[5],     pw2[0] = PKW(P1, 0), pw2[1] = PKW(P1, 2), pw2); \
    VRD(6); SBAR(); GAPA(QM(5, C1 = __builtin_amdgcn_mfma_f32_32x32x16_bf16(kf[5], qr[2], C1, 0, 0, 0)),   P1[6], P1[7], P1[8], P1[9],     pw2[2] = PKW(P1, 4), pw2[3] = PKW(P1, 6), pw2); \
    VRD(3); SBAR(); GAPA(QM(6, C0 = __builtin_amdgcn_mfma_f32_32x32x16_bf16(kf[6], qr[3], C0, 0, 0, 0)),   P1[10], P1[11], P1[12], P1[13], pw3[0] = PKW(P1, 8), pw3[1] = PKW(P1, 10), pw3); \
    VRD(7); SBAR(); GAPA(QM(7, C1 = __builtin_amdgcn_mfma_f32_32x32x16_bf16(kf[7], qr[3], C1, 0, 0, 0)),   P1[14], P1[15], 0.f, 0.f,       pw3[2] = PKW(P1, 12), pw3[3] = PKW(P1, 14), pw3); \
    l_reg += sacc; \
    if (GK) { DMA_K((t) + 3, sl_cur); } if (GV) { DMA_V((t) + 1, sl_next); } \
    SBAR(); \
    GAPB(PM(0, o[0] = __builtin_amdgcn_mfma_f32_32x32x16_bf16(PAF(0), VFR(0), o[0], 0, 0, 0)), C0, 0); \
    GAPB(PM(1, o[1] = __builtin_amdgcn_mfma_f32_32x32x16_bf16(PAF(0), VFR(4), o[1], 0, 0, 0)), C0, 4); \
    KRD(GL, 0); GAPB(PM(2, o[0] = __builtin_amdgcn_mfma_f32_32x32x16_bf16(PAF(1), VFR(1), o[0], 0, 0, 0)), C0, 8); \
    KRD(GL, 1); GAPB(PM(3, o[1] = __builtin_amdgcn_mfma_f32_32x32x16_bf16(PAF(1), VFR(5), o[1], 0, 0, 0)), C0, 12); \
    KRD(GL, 2); GAPB(PM(4, o[0] = __builtin_amdgcn_mfma_f32_32x32x16_bf16(PAF(2), VFR(2), o[0], 0, 0, 0)), C1, 0); \
    KRD(GL, 3); GAPB(PM(5, o[1] = __builtin_amdgcn_mfma_f32_32x32x16_bf16(PAF(2), VFR(6), o[1], 0, 0, 0)), C1, 4); \
    GAPB(PM(6, o[0] = __builtin_amdgcn_mfma_f32_32x32x16_bf16(PAF(3), VFR(3), o[0], 0, 0, 0)), C1, 8); \
    GAPB(PM(7, o[1] = __builtin_amdgcn_mfma_f32_32x32x16_bf16(PAF(3), VFR(7), o[1], 0, 0, 0)), C1, 12); \
    } while (0)
  int t = 1;
  for (; t + 5 < NT; t += 2) {
    STEP(pB0, pB1, pA0, pA1, t, true, true, true);     WAIT_BAR(2); RESC(); ROT();
    STEP(pA0, pA1, pB0, pB1, t + 1, true, true, true); WAIT_BAR(2); RESC(); ROT();
  }
  #define ENDW(tt) do { if ((tt) + 3 < NT) { WAIT_BAR(2); } else if ((tt) + 2 < NT) { WAIT_BAR(1); } else { WAIT_BAR(0); } } while (0)
  for (; t + 1 < NT; t += 2) {
    STEP(pB0, pB1, pA0, pA1, t, (t + 3 < NT), (t + 1 < NT), (t + 1 < NT));         ENDW(t);     RESC(); ROT();
    STEP(pA0, pA1, pB0, pB1, t + 1, (t + 4 < NT), (t + 2 < NT), (t + 2 < NT));     ENDW(t + 1); RESC(); ROT();
  }
  STEP(pB0, pB1, pA0, pA1, NT - 1, false, false, false); RESC();
  { float sacc = pB0[0] + pB0[1]; _Pragma("unroll") for (int r = 2; r < 16; ++r) sacc += pB0[r]; _Pragma("unroll") for (int r = 0; r < 16; ++r) sacc += pB1[r]; l_reg += sacc;
    pw0 = (u32x4){PKW(pB0, 0), PKW(pB0, 2), PKW(pB0, 4), PKW(pB0, 6)}; pw1 = (u32x4){PKW(pB0, 8), PKW(pB0, 10), PKW(pB0, 12), PKW(pB0, 14)}; pw2 = (u32x4){PKW(pB1, 0), PKW(pB1, 2), PKW(pB1, 4), PKW(pB1, 6)}; pw3 = (u32x4){PKW(pB1, 8), PKW(pB1, 10), PKW(pB1, 12), PKW(pB1, 14)};
    SBAR(); pv(o, vb0 + sl_cur, PAF(0), PAF(1), PAF(2), PAF(3)); }
  #undef PKW
  #undef PAF
  #undef VFR
  #undef PIN
  #undef MX3
  #undef GAPA
  #undef GAPB
  #undef EX
  #undef VRD
  #undef KRD
  #undef STEP
  #undef QM
  #undef PM
  #undef ENDW
  { auto rr = __builtin_amdgcn_permlane32_swap(__float_as_uint(l_reg), __float_as_uint(l_reg), false, false); l_reg = __uint_as_float(rr[0]) + __uint_as_float(rr[1]); }
  if (hi == 0) wsf[32 + r32] = l_reg; asm volatile("s_waitcnt lgkmcnt(0)" ::: "memory");
  float rli[16];
  #pragma unroll
  for (int r = 0; r < 16; ++r) rli[r] = __builtin_amdgcn_rcpf(wsf[32 + crow(r, hi)]);
#if ATT_FP8
  unsigned char* Ow = (unsigned char*)Orow0 + (long)(wid * QBLK) * OP;
  { unsigned char* stg = (unsigned char*)(shm + LDS_OST) + wid * 2048;
    #pragma unroll
    for (int r = 0; r < 16; ++r) { const int orow = crow(r, hi);
      #pragma unroll
      for (int d0 = 0; d0 < 2; ++d0) { const float y = __builtin_amdgcn_fmed3f(o[d0][r] * (rli[r] * FP8_SO), -448.f, 448.f); stg[orow * 64 + d0 * 32 + r32] = (unsigned char)(__builtin_amdgcn_cvt_pk_fp8_f32(y, y, 0, false) & 0xff); } }
    asm volatile("s_waitcnt lgkmcnt(0)" ::: "memory");
    #pragma unroll
    for (int i = 0; i < 2; ++i) { const int row = i * 16 + (lane >> 2), ch = lane & 3; const u32x4 v = *(const u32x4*)(stg + row * 64 + ch * 16); *(u32x4*)(Ow + (long)row * OP + ch * 16) = v; } }
#else
  bf16_t* Ow = Orow0 + (long)(wid * QBLK) * OP;
  { bf16_t* stg = (bf16_t*)(shm + LDS_OST) + wid * 2048;
    #pragma unroll
    for (int r = 0; r < 16; ++r) { const int orow = crow(r, hi);
      #pragma unroll
      for (int d0 = 0; d0 < 2; ++d0) stg[orow * 64 + d0 * 32 + r32] = (bf16_t)f2bf(o[d0][r] * rli[r]); }
    asm volatile("s_waitcnt lgkmcnt(0)" ::: "memory");
    #pragma unroll
    for (int i = 0; i < 4; ++i) { const int row = i * 8 + (lane >> 3), ch = lane & 7; const u32x4 v = *(const u32x4*)(stg + row * 64 + ch * 8); *(u32x4*)(Ow + (long)row * OP + ch * 8) = v; } }
#endif
  asm volatile("s_waitcnt lgkmcnt(0)\n\ts_barrier" ::: "memory");
  #undef DMA_K
  #undef DMA_V
  #undef START
  #undef RESC
  #undef ROT
}
#undef SBAR
#undef WAIT_BAR
}

namespace attn8 {
constexpr int NW = 8, QBLK = 32, NSLOT = 5, SLOTB = 8192;
constexpr int LDS_WS = NSLOT * SLOTB, LDS_OST = LDS_WS + NW * 64 * 4, LDS_BYTES = LDS_OST + NW * 4096;
constexpr float C2 = attn_body::C2;
typedef int v8i __attribute__((ext_vector_type(8)));
typedef int v4i __attribute__((ext_vector_type(4)));
typedef __attribute__((address_space(3))) const char* lds_cptr;
#define SBAR() __builtin_amdgcn_sched_barrier(0)
#define WAIT_BAR(N) asm volatile("s_waitcnt vmcnt(" #N ") lgkmcnt(0)\n\ts_barrier" ::: "memory")
__device__ __forceinline__ void glds16s(const void* sbase, unsigned voff, unsigned lds_dst) { unsigned keep;
  asm volatile("s_mov_b32 %0, m0\n\ts_mov_b32 m0, %3\n\ts_nop 0\n\tglobal_load_lds_dwordx4 %1, %2\n\ts_mov_b32 m0, %0" : "=&s"(keep) : "v"(voff), "s"(sbase), "s"(lds_dst) : "memory"); }
__device__ __forceinline__ v8i frag32(lds_cptr p) { const v4i a = *(const LAS v4i*)(p), b = *(const LAS v4i*)(p + 1024); return (v8i){a[0], a[1], a[2], a[3], b[0], b[1], b[2], b[3]}; }
#define SC_K 0x7A7A7A7A
#define SC_Q 0x7A7A7A7A
#define SC_P 0x7A7A7A7A
static_assert(FP8_SK == 32.f && FP8_SV == 32.f && FP8_SQ == 32.f, "scale operands");

__device__ __forceinline__ void attn_unit8(const bf16_t* Qrow0, int QP, const unsigned char* __restrict__ kv8, int NT, unsigned char* Orow0, int OP, char* shm, const int tid, const float mfix,
                                           const float* qn, const float* ropec, const float* ropes, const int rope, const int tq0) {
  const int lane = tid & 63, r32 = lane & 31, hi = lane >> 5; const int wid = __builtin_amdgcn_readfirstlane(tid >> 6);
  const bf16_t* Qw = Qrow0 + (long)(wid * QBLK) * QP;
  const unsigned lds0 = (unsigned)(uintptr_t)shm;
  const unsigned voff = (unsigned)tid * 16u; const unsigned dstw = lds0 + wid * 1024;
  #define DMA(u, slotoff) glds16s(kv8 + (size_t)(u) * 8192, voff, (unsigned)__builtin_amdgcn_readfirstlane(dstw + (slotoff)))
  const lds_cptr shm3 = (lds_cptr)shm; const lds_cptr kp0 = shm3 + hi * 2048 + r32 * 16; const lds_cptr vp0 = kp0 + 4096;
  DMA(0, 0); DMA(1, SLOTB); DMA(2, 2 * SLOTB);
  v8i qf;
  {
    bf16x8 qr[4];
    #pragma unroll
    for (int d0 = 0; d0 < 4; ++d0) qr[d0] = *reinterpret_cast<const bf16x8*>(&Qw[(long)r32 * QP + d0 * 16 + hi * 8]);
    float x[4][8];
    #pragma unroll
    for (int d0 = 0; d0 < 4; ++d0) { const u32x4 u = __builtin_bit_cast(u32x4, qr[d0]);
      x[d0][0] = bf_lo(u.x); x[d0][1] = bf_hi(u.x); x[d0][2] = bf_lo(u.y); x[d0][3] = bf_hi(u.y); x[d0][4] = bf_lo(u.z); x[d0][5] = bf_hi(u.z); x[d0][6] = bf_lo(u.w); x[d0][7] = bf_hi(u.w); }
    float ss = 0.f;
    #pragma unroll
    for (int d0 = 0; d0 < 4; ++d0)
      #pragma unroll
      for (int t = 0; t < 8; ++t) ss += x[d0][t] * x[d0][t];
    { auto rr = __builtin_amdgcn_permlane32_swap(__float_as_uint(ss), __float_as_uint(ss), false, false); ss = __uint_as_float(rr[0]) + __uint_as_float(rr[1]); }
    const float rstd = rsqrtf(ss * (1.f / 64.f) + NORM_EPS) * (C2 * FP8_SQ);
    #pragma unroll
    for (int d0 = 0; d0 < 4; ++d0) { const f32x4 g0 = *(const f32x4*)(qn + 16 * d0 + 8 * hi), g1 = *(const f32x4*)(qn + 16 * d0 + 8 * hi + 4);
      x[d0][0] *= rstd * g0.x; x[d0][1] *= rstd * g0.y; x[d0][2] *= rstd * g0.z; x[d0][3] *= rstd * g0.w; x[d0][4] *= rstd * g1.x; x[d0][5] *= rstd * g1.y; x[d0][6] *= rstd * g1.z; x[d0][7] *= rstd * g1.w; }
    if (rope) { const int tq = tq0 + wid * QBLK + r32;
      #pragma unroll
      for (int d0 = 0; d0 < 2; ++d0) { const float* cp = ropec + (long)tq * 32 + 16 * d0 + 8 * hi; const float* sp = ropes + (long)tq * 32 + 16 * d0 + 8 * hi;
        const f32x4 c0 = *(const f32x4*)cp, c1 = *(const f32x4*)(cp + 4), s0 = *(const f32x4*)sp, s1 = *(const f32x4*)(sp + 4);
        const float cs[8] = {c0.x, c0.y, c0.z, c0.w, c1.x, c1.y, c1.z, c1.w}, sn[8] = {s0.x, s0.y, s0.z, s0.w, s1.x, s1.y, s1.z, s1.w};
        #pragma unroll
        for (int t = 0; t < 8; ++t) { const float a = x[d0][t], c = x[d0 + 2][t]; x[d0][t] = a * cs[t] - c * sn[t]; x[d0 + 2][t] = a * sn[t] + c * cs[t]; } } }
    #pragma unroll
    for (int d0 = 0; d0 < 4; ++d0) { qf[2 * d0] = (int)pk_fp8x4(x[d0][0], x[d0][1], x[d0][2], x[d0][3]); qf[2 * d0 + 1] = (int)pk_fp8x4(x[d0][4], x[d0][5], x[d0][6], x[d0][7]); }
  }
  const float extra = __int_as_float(__builtin_amdgcn_readfirstlane(__float_as_int(fmaxf(mfix - 19.5f, 0.f)))); const bool hasx = extra > 0.f;
  f32x16 o[2], ls; o[0] = f32x16{}; o[1] = f32x16{}; ls = f32x16{};
  v8i ones;
  { int one_; asm volatile("v_mov_b32 %0, 0x38383838" : "=v"(one_));
    #pragma unroll
    for (int i = 0; i < 8; ++i) ones[i] = one_;
    asm volatile("" : "+v"(ones)); }
  int sck = SC_K; asm volatile("" : "+v"(sck));
  f32x16 pA0, pA1, pB0, pB1; v8i kf0, kf1;
  #define QK(C0, C1) do { asm volatile("v_mfma_scale_f32_32x32x64_f8f6f4 %0, %1, %2, -4.0, %3, %3 op_sel_hi:[0,0,0]" : "=v"(C0) : "v"(kf0), "v"(qf), "v"(sck)); \
                          asm volatile("v_mfma_scale_f32_32x32x64_f8f6f4 %0, %1, %2, -4.0, %3, %3 op_sel_hi:[0,0,0]" : "=v"(C1) : "v"(kf1), "v"(qf), "v"(sck)); } while (0)
  #define EXPS(C0, C1, X) do { if ((X) == 1 || ((X) == 2 && hasx)) { _Pragma("unroll") for (int r = 0; r < 16; ++r) { C0[r] -= extra; C1[r] -= extra; } }       \
      _Pragma("unroll") for (int r = 0; r < 16; ++r) { C0[r] = __builtin_amdgcn_exp2f(C0[r]); C1[r] = __builtin_amdgcn_exp2f(C1[r]); } } while (0)
  #define KLOAD(slot) do { kf0 = frag32(kp0 + (slot)); kf1 = frag32(kp0 + (slot) + 512); } while (0)
  #define PK4(a, b, c, d) __builtin_amdgcn_perm(__builtin_bit_cast(unsigned, __builtin_amdgcn_cvt_pkrtz((c), (d))), __builtin_bit_cast(unsigned, __builtin_amdgcn_cvt_pkrtz((a), (b))), 0x07050301u)
  #define PACK(P0, P1) do { \
      _Pragma("unroll") for (int j = 0; j < 4; ++j) { p8[j] = (int)PK4(P0[4 * j], P0[4 * j + 1], P0[4 * j + 2], P0[4 * j + 3]); p8[4 + j] = (int)PK4(P1[4 * j], P1[4 * j + 1], P1[4 * j + 2], P1[4 * j + 3]); } } while (0)
  #define PV(vf0, vf1) do { o[0] = __builtin_amdgcn_mfma_scale_f32_32x32x64_f8f6f4(p8, vf0, o[0], 1, 0, 0, SC_P, 0, SC_K); o[1] = __builtin_amdgcn_mfma_scale_f32_32x32x64_f8f6f4(p8, vf1, o[1], 1, 0, 0, SC_P, 0, SC_K); \
      ls = __builtin_amdgcn_mfma_scale_f32_32x32x64_f8f6f4(p8, ones, ls, 1, 0, 0, SC_P, 0, SC_P); } while (0)
  int s_v = 0, s_k = 2 * SLOTB, s_d = 4 * SLOTB;
  #define ADV(sv) sv = ((sv) == (NSLOT - 1) * SLOTB) ? 0 : (sv) + SLOTB
  WAIT_BAR(2);
  KLOAD(0);
  DMA(3, 3 * SLOTB);
  QK(pA0, pA1); asm volatile("s_nop 15\n\ts_nop 15\n\ts_nop 15\n\ts_nop 15\n\ts_nop 15\n\ts_nop 15\n\ts_nop 15\n\ts_nop 15\n\ts_nop 15" : "+v"(pA0), "+v"(pA1));
  EXPS(pA0, pA1, 2);
  WAIT_BAR(1);
  KLOAD(SLOTB);
  v8i p8 = {0, 0, 0, 0, 0, 0, 0, 0};
  #define STEP(C0, C1, P0, P1, t, GD, GL, X) do { SBAR(); \
    QK(C0, C1); SBAR(); \
    const v8i vf0_ = frag32(vp0 + s_v), vf1_ = frag32(vp0 + s_v + 512);       \
    PACK(P0, P1); \
    if (GD) { DMA((t) + 3, s_d); } \
    SBAR(); \
    PV(vf0_, vf1_); SBAR(); \
    EXPS(C0, C1, X); \
    if (GL) { KLOAD(s_k); } \
    ADV(s_v); ADV(s_k); ADV(s_d); SBAR(); } while (0)
  int t = 1;
  if (!hasx) {
    for (; t + 4 < NT; t += 2) {
      STEP(pB0, pB1, pA0, pA1, t, true, true, 0);     WAIT_BAR(1);
      STEP(pA0, pA1, pB0, pB1, t + 1, true, true, 0); WAIT_BAR(1);
    }
  } else {
    for (; t + 4 < NT; t += 2) {
      STEP(pB0, pB1, pA0, pA1, t, true, true, 1);     WAIT_BAR(1);
      STEP(pA0, pA1, pB0, pB1, t + 1, true, true, 1); WAIT_BAR(1);
    }
  }
  #define ENDW(tt) do { if ((tt) + 3 < NT) { WAIT_BAR(1); } else { WAIT_BAR(0); } } while (0)
  for (; t + 1 < NT; t += 2) {
    STEP(pB0, pB1, pA0, pA1, t, (t + 3 < NT), (t + 1 < NT), 2);         ENDW(t);
    STEP(pA0, pA1, pB0, pB1, t + 1, (t + 4 < NT), (t + 2 < NT), 2);     ENDW(t + 1);
  }
  STEP(pB0, pB1, pA0, pA1, NT - 1, false, false, 2);
  { const v8i vf0_ = frag32(vp0 + s_v), vf1_ = frag32(vp0 + s_v + 512); PACK(pB0, pB1); SBAR(); PV(vf0_, vf1_); }
  #undef STEP
  #undef ENDW
  #undef QK
  #undef EXPS
  #undef KLOAD
  #undef PACK
  #undef PK4
  #undef PV
  #undef ADV
  float rli[16];
  #pragma unroll
  for (int r = 0; r < 16; ++r) rli[r] = __builtin_amdgcn_rcpf(ls[r]);
  unsigned char* Ow = Orow0 + (long)(wid * QBLK) * OP;
  { unsigned char* stg = (unsigned char*)(shm + LDS_OST) + wid * 2048;
    #pragma unroll
    for (int r = 0; r < 16; ++r) { const int orow = attn_body::crow(r, hi);
      #pragma unroll
      for (int d0 = 0; d0 < 2; ++d0) { const float y = __builtin_amdgcn_fmed3f(o[d0][r] * (rli[r] * (FP8_SO * (1.f / 32.f))), -448.f, 448.f); stg[orow * 64 + d0 * 32 + r32] = (unsigned char)(__builtin_amdgcn_cvt_pk_fp8_f32(y, y, 0, false) & 0xff); } }
    asm volatile("s_waitcnt lgkmcnt(0)" ::: "memory");
    #pragma unroll
    for (int i = 0; i < 2; ++i) { const int row = i * 16 + (lane >> 2), ch = lane & 3; const u32x4 v = *(const u32x4*)(stg + row * 64 + ch * 16); *(u32x4*)(Ow + (long)row * OP + ch * 16) = v; } }
  asm volatile("s_waitcnt lgkmcnt(0)\n\ts_barrier" ::: "memory");
  #undef DMA
}
#undef SBAR
#undef WAIT_BAR
#undef SC_K
#undef SC_Q
#undef SC_P
}
struct Frame {
    LAS unsigned char* lds;
    int tid, lane, wave;
    int vcu, G, gw, NGW, bid;
    unsigned char* ws; const unsigned long long* inq;
};

template <bool F8 = false>
__device__ __forceinline__ void transpose_item(const float* W, int ldw, int K, bf16_t* WT, int k0, int n0, int dst_row0, LAS float* scr, int lane) {
    float tv[32];
#pragma unroll
    for (int i = 0; i < 32; ++i) tv[i] = __builtin_nontemporal_load(W + (size_t)(k0 + 2 * i + (lane >> 5)) * ldw + n0 + (lane & 31));
#pragma unroll
    for (int i = 0; i < 32; ++i) scr[(2 * i + (lane >> 5)) * 33 + (lane & 31)] = tv[i];
    LDS_WAIT(); asm volatile("" ::: "memory");
    const int c = lane & 7;
#pragma unroll
    for (int j = 0; j < 4; ++j) { const int n = (lane >> 3) + 8 * j; const LAS float* s = scr + (8 * c) * 33 + n;
        if (F8) { u32x2 o; o.x = pk_fp8x4(s[0 * 33] * FP8_SW, s[1 * 33] * FP8_SW, s[2 * 33] * FP8_SW, s[3 * 33] * FP8_SW); o.y = pk_fp8x4(s[4 * 33] * FP8_SW, s[5 * 33] * FP8_SW, s[6 * 33] * FP8_SW, s[7 * 33] * FP8_SW);
            *(u32x2*)((unsigned char*)WT + (size_t)(dst_row0 + n) * K + k0 + 8 * c) = o; }
        else { u32x4 o; o.x = pk2(s[0 * 33], s[1 * 33]); o.y = pk2(s[2 * 33], s[3 * 33]); o.z = pk2(s[4 * 33], s[5 * 33]); o.w = pk2(s[6 * 33], s[7 * 33]);
            *(u32x4*)(WT + (size_t)(dst_row0 + n) * K + k0 + 8 * c) = o; } }
    LDS_WAIT(); asm volatile("" ::: "memory");
}

__device__ __forceinline__ void sincos_acc(float x, float& s, float& c) {
    const float k = rintf(x * 0.63661977236758134f);
    float r = fmaf(k, -1.5703125f, x); r = fmaf(k, -4.837512969970703125e-4f, r); r = fmaf(k, -7.54978995489188e-8f, r);
    const float z = r * r;
    const float sp = r + r * z * fmaf(z, fmaf(z, -1.9515295891e-4f, 8.3321608736e-3f), -1.6666654611e-1f);
    const float cp = fmaf(z * z, fmaf(z, fmaf(z, 2.443315711809948e-5f, -1.388731625493765e-3f), 4.166664568298827e-2f), fmaf(z, -0.5f, 1.0f));
    const int q = ((int)k) & 3;
    const float ss = (q & 1) ? cp : sp, cc = (q & 1) ? sp : cp;
    s = (q & 2) ? -ss : ss; c = ((q + 1) & 2) ? -cc : cc;
}

__device__ __forceinline__ void modv_pass(Frame& F, const float* c_lat, const float* c_ctx, const float* w_mod, const float* b_mod, unsigned char* ws, const int l0, const int l1) {
    LAS float* sil = (LAS float*)F.lds;
    for (int i = F.tid; i < NMI * D; i += NTHREADS) { const int mi = i >> 10, k = i & 1023; const float v = (mi < NB) ? c_lat[mi * D + k] : c_ctx[k]; sil[i] = silu_f(v); }
    __syncthreads();
    {
        float* modv = (float*)(ws + WS_MODV);
        const int NT16 = 6 * D / 16;
        for (int task = F.gw; task < (l1 - l0) * NT16; task += F.NGW) {
            const int layer = l0 + task / NT16, j0 = (task % NT16) * 16, jj = F.lane & 15, kq = F.lane >> 4;
            const float* wp = w_mod + (size_t)layer * D * 6 * D + j0 + jj;
            float acc[NMI];
#pragma unroll
            for (int m = 0; m < NMI; ++m) acc[m] = 0.f;
            for (int k0 = 16 * kq; k0 < D; k0 += 64) {
                float wv[16];
#pragma unroll
                for (int u = 0; u < 16; ++u) wv[u] = __builtin_nontemporal_load(wp + (size_t)(k0 + u) * 6 * D);
                { const LAS f32x4* sp = (const LAS f32x4*)(sil + k0); f32x4 sc[4], sn[4];
#pragma unroll
                  for (int q = 0; q < 4; ++q) sc[q] = sp[q];
#pragma unroll
                  for (int m = 0; m < NMI; ++m) {
                      if (m + 1 < NMI) {
#pragma unroll
                          for (int q = 0; q < 4; ++q) sn[q] = sp[(m + 1) * (D / 4) + q]; }
                      float a = acc[m];
#pragma unroll
                      for (int q = 0; q < 4; ++q) { a = fmaf(sc[q].x, wv[4 * q], a); a = fmaf(sc[q].y, wv[4 * q + 1], a); a = fmaf(sc[q].z, wv[4 * q + 2], a); a = fmaf(sc[q].w, wv[4 * q + 3], a); }
                      acc[m] = a; asm volatile("" ::: "memory");
#pragma unroll
                      for (int q = 0; q < 4; ++q) sc[q] = sn[q]; } } }
#pragma unroll
            for (int m = 0; m < NMI; ++m) { float v = acc[m]; v += shfl_xor_l(v, 16, F.lane); v += shfl_xor_l(v, 32, F.lane); acc[m] = v; }
            if (kq == 0) { const float bb = b_mod[layer * 6 * D + j0 + jj];
#pragma unroll
                for (int m = 0; m < NMI; ++m) modv[((size_t)layer * NMI + m) * 6 * D + j0 + jj] = acc[m] + bb; }
        }
    }
    __syncthreads();
}

__device__ __forceinline__ void p0_prologue(Frame& F, const float* const* in, unsigned char* ws) {
    modv_pass(F, in[1], in[3], in[4], in[5], ws, 0, DEPTH);
    {
        LAS float* scr = (LAS float*)(F.lds) + F.wave * (64 * 33);
        constexpr int I_MI = 16 * 96, I_MO = 16 * 32, I_AI = 16 * 48, I_AO = 16 * 32;
        constexpr int PER_J = I_MI + I_MO + I_AI + I_AO;
        for (int it = F.gw; it < 2 * PER_J; it += F.NGW) {
            const int j = it / PER_J; int r = it % PER_J;
            if (r < I_MI) { const int kb = r / 96, nb = r % 96; transpose_item<MLS_FP8_IN != 0>(in[8] + (size_t)j * D * MW_IN, MW_IN, D, (bf16_t*)(ws + WS_WMI + (size_t)j * 3072 * D * (MLS_FP8_IN ? 1 : 2)), 64 * kb, 32 * nb, 32 * nb, scr, F.lane); continue; } r -= I_MI;
            if (r < I_MO) { const int kb = r / 32, nb = r % 32; transpose_item<MLS_FP8_OUT != 0>(in[11] + (size_t)j * D * D, D, D, (bf16_t*)(ws + WS_WMO + (size_t)j * D * D * (MLS_FP8_OUT ? 1 : 2)), 64 * kb, 32 * nb, 32 * nb, scr, F.lane); continue; } r -= I_MO;
            if (r < I_AI) { const int kb = r / 48, nb = r % 48; transpose_item<ATT_FP8 != 0>(in[12] + (size_t)j * D * 1536, 1536, D, (bf16_t*)(ws + WS_WAI + (size_t)j * 1536 * D * (ATT_FP8 ? 1 : 2)), 64 * kb, 32 * nb, 32 * nb, scr, F.lane); continue; } r -= I_AI;
            { const int kb = r / 32, nb = r % 32; transpose_item<ATT_FP8 != 0>(in[15] + (size_t)j * D * D, D, D, (bf16_t*)(ws + WS_WAO + (size_t)j * D * D * (ATT_FP8 ? 1 : 2)), 64 * kb, 32 * nb, 32 * nb, scr, F.lane); }
        }
    }
    {
        float* rc = (float*)(ws + WS_ROPE); float* rs = rc + SEQ * 32;
        for (int i = F.bid * NTHREADS + F.tid; i < SEQ * 32; i += F.G * NTHREADS) {
            const int t = i >> 5, p = i & 31; const float pos = (p < 16) ? (float)(t >> 6) : (float)(t & 63);
            const float inv = exp2f(-(float)(p & 15) * (13.287712379549449f / 16.f));
            float s, c; sincos_acc(pos * inv, s, c); rc[i] = c; rs[i] = s; }
    }
    __syncthreads();
}

__device__ __forceinline__ void moe_weights(Frame& F, const float* wg, const float* wu, const float* wd, unsigned char* ws, unsigned* counter, const int parts) {
    LAS float* T = (LAS float*)F.lds;
    volatile LAS int* slot = (volatile LAS int*)(F.lds + 65536 + 256);
    const int lane = F.lane, w = F.wave, tid = F.tid;
    bf16_t* W1 = (bf16_t*)(ws + WS_W1); bf16_t* W2 = (bf16_t*)(ws + WS_W2);
    unsigned char* W1b = (unsigned char*)(ws + WS_W1); unsigned char* W2b = (unsigned char*)(ws + WS_W2);
    constexpr int NIT = NE * 3 * 16 * 4, NA = NE * 2 * 64;
#define MW_E(it_) ((it_) < NA ? (it_) / 128 : ((it_) - NA) / 64)
#define MW_WHICH(it_) ((it_) < NA ? ((it_) % 128) / 64 : 2)
#define MW_REST(it_) ((it_) % 64)
#define MW_SRC(it_) ((MW_WHICH(it_) == 0 ? wg : (MW_WHICH(it_) == 1 ? wu : wd)) + (size_t)MW_E(it_) * D * D + (size_t)(64 * (MW_REST(it_) >> 2)) * D + 256 * (MW_REST(it_) & 3))
#define MW_FETCH(dst) do { int id_ = NIT; if (parts & 1) { const int a_ = (int)__hip_atomic_fetch_add(counter, 1u, __ATOMIC_RELAXED, __HIP_MEMORY_SCOPE_AGENT); if (a_ < NA) id_ = a_; } \
        if (id_ == NIT && (parts & 2)) { const int b_ = (int)__hip_atomic_fetch_add(counter + 16, 1u, __ATOMIC_RELAXED, __HIP_MEMORY_SCOPE_AGENT); if (b_ < NIT - NA) id_ = NA + b_; } dst = id_; } while (0)
    __syncthreads();
    int pend = NIT;
    if (tid == 0) { int f0; MW_FETCH(f0); slot[0] = f0; MW_FETCH(pend); }
    __syncthreads();
    int it = slot[0];
    f32x4 v[8];
    if (it < NIT) { const float* src = MW_SRC(it);
#pragma unroll
        for (int i = 0; i < 8; ++i) v[i] = __builtin_nontemporal_load((const f32x4*)(src + (size_t)(8 * w + i) * D + 4 * lane)); }
    while (it < NIT) {
        if (tid == 0) { slot[1] = pend; MW_FETCH(pend); }
        __syncthreads();
#pragma unroll
        for (int i = 0; i < 8; ++i) *(LAS f32x4*)(T + (8 * w + i) * 256 + ((4 * lane) ^ (8 * (w & 3)))) = v[i];
        const int nx = slot[1];
        if (nx < NIT) { const float* src = MW_SRC(nx);
#pragma unroll
            for (int i = 0; i < 8; ++i) v[i] = __builtin_nontemporal_load((const f32x4*)(src + (size_t)(8 * w + i) * D + 4 * lane)); }
        __syncthreads();
        const int e = MW_E(it), which = MW_WHICH(it), kb = MW_REST(it) >> 2, nq = MW_REST(it) & 3;
        const int nl = lane & 7, c = lane >> 3;
        bf16_t* base = (which == 2) ? (W2 + (size_t)e * D * D) : (W1 + (size_t)e * 2048 * D);
#pragma unroll
        for (int j = 0; j < 4; ++j) { const int n = 32 * w + 8 * j + nl; const LAS float* tp = T + (8 * c) * 256 + (n ^ (8 * (c & 3)));
            float t[8];
#pragma unroll
            for (int i = 0; i < 8; ++i) t[i] = tp[i * 256];
            const int ng = 256 * nq + n; const int drow = (which == 2) ? ng : (256 * (ng >> 7) + (which == 1 ? 128 : 0) + (ng & 127));
            const bool f8 = (which == 2) ? (MOE_FP8_2 != 0) : (MOE_FP8_1 != 0);
            if (f8) { u32x2 o; o.x = pk_fp8x4(t[0] * FP8_SW, t[1] * FP8_SW, t[2] * FP8_SW, t[3] * FP8_SW); o.y = pk_fp8x4(t[4] * FP8_SW, t[5] * FP8_SW, t[6] * FP8_SW, t[7] * FP8_SW);
                unsigned char* b8 = (which == 2) ? (W2b + (size_t)e * D * D) : (W1b + (size_t)e * 2048 * D);
                __builtin_nontemporal_store(o, (u32x2*)(b8 + (size_t)drow * D + 64 * kb + 8 * c)); }
            else { u32x4 o; o.x = pk2(t[0], t[1]); o.y = pk2(t[2], t[3]); o.z = pk2(t[4], t[5]); o.w = pk2(t[6], t[7]);
                *(u32x4*)(base + (size_t)drow * D + 64 * kb + 8 * c) = o; } }
        it = nx;
    }
#undef MW_SRC
#undef MW_E
#undef MW_WHICH
#undef MW_REST
#undef MW_FETCH
    __syncthreads();
}

__device__ __forceinline__ void load_w16(Frame& F, const float* W16, int ldw16) {
    LAS float* wl = (LAS float*)F.lds;
    for (int i = F.tid; i < D * 16; i += NTHREADS) { const int c = i >> 4, e = i & 15; const int l = (c & 255) >> 2, q = (c & 3) + 4 * (c >> 8);
        wl[(q * 64 + l) * 20 + e] = W16[(size_t)c * ldw16 + e]; }
    __syncthreads();
}
template <int MODE, bool F8 = false>
__device__ __forceinline__ void norm_core(LAS float* wl, const int lane, f32x4 (&v)[4], const int r, const f32x4 (&gv)[4], const float* shp, const float* scp, bf16_t* H, const float* bias16, float* out16) {
    float ss = 0.f;
#pragma unroll
    for (int j = 0; j < 4; ++j) ss += (v[j].x * v[j].x + v[j].y * v[j].y) + (v[j].z * v[j].z + v[j].w * v[j].w);
    const float rstd = rsqrtf(wave_sum(ss) * (1.f / D) + NORM_EPS);
    unsigned long long* o8 = (unsigned long long*)(H + (size_t)r * D) + lane;
#pragma unroll
    for (int j = 0; j < 4; ++j) { const f32x4 sh = *(const f32x4*)(shp + 4 * lane + 256 * j), sc = *(const f32x4*)(scp + 4 * lane + 256 * j);
        v[j] = (v[j] * rstd * gv[j]) * (sc + 1.f) + sh;
        if (F8) ((unsigned*)((unsigned char*)H + (size_t)r * D))[lane + 64 * j] = pk_fp8x4(v[j].x * FP8_SH, v[j].y * FP8_SH, v[j].z * FP8_SH, v[j].w * FP8_SH);
        else o8[64 * j] = (unsigned long long)pk2(v[j].x, v[j].y) | ((unsigned long long)pk2(v[j].z, v[j].w) << 32); }
    if (MODE != 0) {
        float p[16];
#pragma unroll
        for (int e = 0; e < 16; ++e) p[e] = 0.f;
#pragma unroll
        for (int j = 0; j < 4; ++j) {
            f32x4 wq[4][4];
#pragma unroll
            for (int i = 0; i < 4; ++i) { const LAS f32x4* wp = (const LAS f32x4*)(wl + ((4 * j + i) * 64 + lane) * 20);
#pragma unroll
                for (int e4 = 0; e4 < 4; ++e4) wq[i][e4] = wp[e4]; }
            asm volatile("s_waitcnt lgkmcnt(0)" ::: "memory"); __builtin_amdgcn_sched_barrier(0);
#pragma unroll
            for (int i = 0; i < 4; ++i) { const float xv = v[j][i];
#pragma unroll
                for (int e4 = 0; e4 < 4; ++e4) { const f32x4 w = wq[i][e4]; p[4 * e4 + 0] = fmaf(xv, w.x, p[4 * e4 + 0]); p[4 * e4 + 1] = fmaf(xv, w.y, p[4 * e4 + 1]); p[4 * e4 + 2] = fmaf(xv, w.z, p[4 * e4 + 2]); p[4 * e4 + 3] = fmaf(xv, w.w, p[4 * e4 + 3]); } }
            __builtin_amdgcn_sched_barrier(0);
        }
        float q8[8], q4[4], q2[2], q1;
        { const bool up = (lane & 32) != 0;
#pragma unroll
          for (int i = 0; i < 8; ++i) { const float send = up ? p[i] : p[i + 8]; const float recv = __shfl_xor(send, 32); q8[i] = (up ? p[i + 8] : p[i]) + recv; } }
        { const bool up = (lane & 16) != 0;
#pragma unroll
          for (int i = 0; i < 4; ++i) { const float send = up ? q8[i] : q8[i + 4]; const float recv = __shfl_xor(send, 16); q4[i] = (up ? q8[i + 4] : q8[i]) + recv; } }
        { const bool up = (lane & 8) != 0;
#pragma unroll
          for (int i = 0; i < 2; ++i) { const float send = up ? q4[i] : q4[i + 2]; const float recv = __shfl_xor(send, 8); q2[i] = (up ? q4[i + 2] : q4[i]) + recv; } }
        { const bool up = (lane & 4) != 0; const float send = up ? q2[0] : q2[1]; const float recv = __shfl_xor(send, 4); q1 = (up ? q2[1] : q2[0]) + recv; }
        q1 = quad_sum(q1);
        const int e = ((lane >> 5) & 1) * 8 + ((lane >> 4) & 1) * 4 + ((lane >> 3) & 1) * 2 + ((lane >> 2) & 1);
        if (MODE == 1) {
            float g = q1 + bias16[e];
            g = 15.f * tanhf(g * (1.f / 15.f));
            const int gate = e >> 2;
            if (gate & 1) g = fminf(g, 0.f) - log1pf(__expf(-fabsf(g)));
            if ((lane & 3) == 0) out16[(size_t)r * 16 + e] = g;
        } else {
            float mx = q1;
#pragma unroll
            for (int o = 4; o < 64; o <<= 1) mx = fmaxf(mx, __shfl_xor(mx, o));
            const float ex = __expf(q1 - mx); float sm = ex;
#pragma unroll
            for (int o = 4; o < 64; o <<= 1) sm += __shfl_xor(sm, o);
            if ((lane & 3) == 0) out16[(size_t)e * RT + r] = ex / sm;
        }
    }
}
__device__ __forceinline__ float swap32_add(float a, float b) { auto r = __builtin_amdgcn_permlane32_swap(__float_as_uint(a), __float_as_uint(b), false, false); return __uint_as_float(r[0]) + __uint_as_float(r[1]); }
__device__ __forceinline__ float swap16_add(float a, float b) { auto r = __builtin_amdgcn_permlane16_swap(__float_as_uint(a), __float_as_uint(b), false, false); return __uint_as_float(r[0]) + __uint_as_float(r[1]); }
template <int MODE, bool F8 = false, bool X16SRC = false>
__device__ __forceinline__ void norm_pass(Frame& F, const float* xL, const float* xC  , int nrows, const float* gain, const float* shiftv, const float* scalev  ,
                                          bf16_t* H, const float* W16, int ldw16, const float* bias16, float* out16) {
    LAS float* wl = (LAS float*)F.lds;
    if (MODE != 0) load_w16(F, W16, ldw16);
    const int lane = F.lane;
    f32x4 gv[4];
#pragma unroll
    for (int j = 0; j < 4; ++j) gv[j] = *(const f32x4*)(gain + 4 * lane + 256 * j);
    const int per = (((nrows + F.NGW - 1) / F.NGW) + 1) & ~1; const int r0 = F.gw * per, r1 = (r0 + per < nrows) ? r0 + per : nrows;
#define NP_XPTR(rr) (((rr) >= RL) ? (xC + (size_t)((rr) - RL) * D) : (xL + (size_t)(rr) * D))
#define NP_LOADROW(dst, rr) do { if (X16SRC) { const u32x2* xp_ = (const u32x2*)((const bf16_t*)xL + (size_t)(rr) * D) + lane; _Pragma("unroll") for (int j = 0; j < 4; ++j) { const u32x2 t_ = xp_[64 * j]; dst[j] = (f32x4){bf_lo(t_.x), bf_hi(t_.x), bf_lo(t_.y), bf_hi(t_.y)}; } } \
        else { const float* xr_ = NP_XPTR(rr); _Pragma("unroll") for (int j = 0; j < 4; ++j) dst[j] = *(const f32x4*)(xr_ + 4 * lane + 256 * j); } } while (0)
    f32x4 vn[2][4];
    if (r0 < r1) { NP_LOADROW(vn[0], r0); NP_LOADROW(vn[1], r0 + 1); }
    for (int r = r0; r < r1; r += 2) {
        asm volatile("" ::: "memory");
        f32x4 v[2][4];
#pragma unroll
        for (int q = 0; q < 2; ++q)
#pragma unroll
            for (int j = 0; j < 4; ++j) v[q][j] = vn[q][j];
        if (r + 2 < r1) { NP_LOADROW(vn[0], r + 2); NP_LOADROW(vn[1], r + 3); }
        float ss[2];
#pragma unroll
        for (int q = 0; q < 2; ++q) { ss[q] = 0.f;
#pragma unroll
            for (int j = 0; j < 4; ++j) ss[q] += (v[q][j].x * v[q][j].x + v[q][j].y * v[q][j].y) + (v[q][j].z * v[q][j].z + v[q][j].w * v[q][j].w); }
        ss[0] = row16_sum(ss[0]); ss[1] = row16_sum(ss[1]);
        const float tot0 = (rdlane(ss[0], 0) + rdlane(ss[0], 16)) + (rdlane(ss[0], 32) + rdlane(ss[0], 48)), tot1 = (rdlane(ss[1], 0) + rdlane(ss[1], 16)) + (rdlane(ss[1], 32) + rdlane(ss[1], 48));
        const float rstd[2] = {rsqrtf(tot0 * (1.f / D) + NORM_EPS), rsqrtf(tot1 * (1.f / D) + NORM_EPS)};
#pragma unroll
        for (int q = 0; q < 2; ++q) { const int rr = r + q; const int mi = (rr >= RL) ? NB : (rr >> 12);
            const float* shp = shiftv + (size_t)mi * 6 * D; const float* scp = scalev + (size_t)mi * 6 * D;
#pragma unroll
            for (int j = 0; j < 4; ++j) { const f32x4 sh = *(const f32x4*)(shp + 4 * lane + 256 * j), sc = *(const f32x4*)(scp + 4 * lane + 256 * j);
                v[q][j] = (v[q][j] * rstd[q] * gv[j]) * (sc + 1.f) + sh;
                if (F8) ((unsigned*)((unsigned char*)H + (size_t)rr * D))[lane + 64 * j] = pk_fp8x4(v[q][j].x * FP8_SH, v[q][j].y * FP8_SH, v[q][j].z * FP8_SH, v[q][j].w * FP8_SH);
                else ((unsigned long long*)(H + (size_t)rr * D))[lane + 64 * j] = (unsigned long long)pk2(v[q][j].x, v[q][j].y) | ((unsigned long long)pk2(v[q][j].z, v[q][j].w) << 32); } }
        if (MODE != 0) {
            f32x2 p2[2][8];
#pragma unroll
            for (int q = 0; q < 2; ++q)
#pragma unroll
                for (int e = 0; e < 8; ++e) p2[q][e] = (f32x2){0.f, 0.f};
#pragma unroll
            for (int j = 0; j < 4; ++j) {
                f32x4 wq[4][4];
#pragma unroll
                for (int i = 0; i < 4; ++i) { const LAS f32x4* wp = (const LAS f32x4*)(wl + ((4 * j + i) * 64 + lane) * 20);
#pragma unroll
                    for (int e4 = 0; e4 < 4; ++e4) wq[i][e4] = wp[e4]; }
                asm volatile("s_waitcnt lgkmcnt(0)" ::: "memory"); __builtin_amdgcn_sched_barrier(0);
#pragma unroll
                for (int i = 0; i < 4; ++i)
#pragma unroll
                    for (int q = 0; q < 2; ++q) { const float xv = v[q][j][i]; const f32x2 x2 = {xv, xv};
#pragma unroll
                        for (int e4 = 0; e4 < 4; ++e4) { const f32x4 w = wq[i][e4];
                            p2[q][2 * e4 + 0] = __builtin_elementwise_fma(x2, (f32x2){w.x, w.y}, p2[q][2 * e4 + 0]);
                            p2[q][2 * e4 + 1] = __builtin_elementwise_fma(x2, (f32x2){w.z, w.w}, p2[q][2 * e4 + 1]); } }
                __builtin_amdgcn_sched_barrier(0);
            }
            float p[2][16];
#pragma unroll
            for (int q = 0; q < 2; ++q)
#pragma unroll
                for (int e = 0; e < 8; ++e) { p[q][2 * e] = p2[q][e].x; p[q][2 * e + 1] = p2[q][e].y; }
            float q16[16], q8[8], q4[4], q2[2], q1;
#pragma unroll
            for (int e = 0; e < 16; ++e) q16[e] = swap32_add(p[0][e], p[1][e]);
#pragma unroll
            for (int i = 0; i < 8; ++i) q8[i] = swap16_add(q16[i], q16[i + 8]);
            { const bool up = (lane & 8) != 0;
#pragma unroll
              for (int i = 0; i < 4; ++i) { const float send = up ? q8[i] : q8[i + 4]; const float recv = __shfl_xor(send, 8); q4[i] = (up ? q8[i + 4] : q8[i]) + recv; } }
            { const bool up = (lane & 4) != 0;
#pragma unroll
              for (int i = 0; i < 2; ++i) { const float send = up ? q4[i] : q4[i + 2]; const float recv = __shfl_xor(send, 4); q2[i] = (up ? q4[i + 2] : q4[i]) + recv; } }
            { const bool up = (lane & 2) != 0; const float send = up ? q2[0] : q2[1]; const float recv = dpp_f<0x4E>(0.f, send); q1 = (up ? q2[1] : q2[0]) + recv; }
            q1 += dpp_f<0xB1>(0.f, q1);
            const int e = ((lane >> 4) & 1) * 8 + ((lane >> 3) & 1) * 4 + ((lane >> 2) & 1) * 2 + ((lane >> 1) & 1);
            const int rr = r + (lane >> 5);
            if (MODE == 1) {
                float g = q1 + bias16[e];
                g = 15.f * tanhf(g * (1.f / 15.f));
                const int gate = e >> 2;
                if (gate & 1) g = fminf(g, 0.f) - log1pf(__expf(-fabsf(g)));
                if ((lane & 1) == 0) out16[(size_t)rr * 16 + e] = g;
            } else {
                float mx = q1;
                mx = fmaxf(mx, dpp_f<0x4E>(mx, mx)); mx = fmaxf(mx, dpp_f<0x141>(mx, mx)); mx = fmaxf(mx, dpp_f<0x140>(mx, mx));
                { auto t = __builtin_amdgcn_permlane16_swap(__float_as_uint(mx), __float_as_uint(mx), false, false); mx = fmaxf(__uint_as_float(t[0]), __uint_as_float(t[1])); }
                const float ex = __expf(q1 - mx); float sm = ex;
                sm += dpp_f<0x4E>(0.f, sm); sm += dpp_f<0x141>(0.f, sm); sm += dpp_f<0x140>(0.f, sm);
                sm = swap16_add(sm, sm);
                if ((lane & 1) == 0) out16[(size_t)e * RT + rr] = ex / sm;
            }
        }
    }
#undef NP_XPTR
#undef NP_LOADROW
    if (MODE != 0) __syncthreads();
}

template <int MODE, bool F8, bool X16SRC>
__device__ __forceinline__ void norm16_pass(Frame& F, const float* xL, const float* xC  , int nrows, const float* gain, const float* shiftv,
                                            const float* scalev, bf16_t* H, const float* W16, int ldw16, const float* bias16, float* out16) {
    const int lane = F.lane, w = F.wave, row = lane & 15, g = lane >> 4;
    LAS float* part = (LAS float*)F.lds;
    LAS f32x4* pacc = (LAS f32x4*)(F.lds + 1024);
    bf16x8 wh[4], wlo[4];
#pragma unroll
    for (int ks = 0; ks < 4; ++ks) { float t[8];
#pragma unroll
        for (int jj = 0; jj < 8; ++jj) t[jj] = W16[(size_t)(128 * w + 32 * ks + 8 * g + jj) * ldw16 + row];
        u32x4 hi4, lo4; unsigned hp[4], lp[4];
#pragma unroll
        for (int q = 0; q < 4; ++q) { hp[q] = pk2(t[2 * q], t[2 * q + 1]); lp[q] = pk2(t[2 * q] - bf_lo(hp[q]), t[2 * q + 1] - bf_hi(hp[q])); }
        hi4 = (u32x4){hp[0], hp[1], hp[2], hp[3]}; lo4 = (u32x4){lp[0], lp[1], lp[2], lp[3]};
        wh[ks] = __builtin_bit_cast(bf16x8, hi4); wlo[ks] = __builtin_bit_cast(bf16x8, lo4); }
    f32x4 gn[4][2];
#pragma unroll
    for (int ks = 0; ks < 4; ++ks) { gn[ks][0] = *(const f32x4*)(gain + 128 * w + 32 * ks + 8 * g); gn[ks][1] = *(const f32x4*)(gain + 128 * w + 32 * ks + 8 * g + 4); }
    const int ngrp = nrows / 16; const int per = (ngrp + F.G - 1) / F.G; const int g0 = F.vcu * per, g1 = (g0 + per < ngrp) ? g0 + per : ngrp;
#define N16_LOAD(dst, gi_) do { const int rr_ = 16 * (gi_) + row; \
        if (X16SRC) { const bf16_t* xp_ = (const bf16_t*)xL + (size_t)rr_ * D + 128 * w + 8 * g; _Pragma("unroll") for (int ks = 0; ks < 4; ++ks) { const u32x4 u_ = *(const u32x4*)(xp_ + 32 * ks); \
                dst[ks][0] = (f32x4){bf_lo(u_.x), bf_hi(u_.x), bf_lo(u_.y), bf_hi(u_.y)}; dst[ks][1] = (f32x4){bf_lo(u_.z), bf_hi(u_.z), bf_lo(u_.w), bf_hi(u_.w)}; } } \
        else { const float* xp_ = ((rr_ >= RL) ? (xC + (size_t)(rr_ - RL) * D) : (xL + (size_t)rr_ * D)) + 128 * w + 8 * g; _Pragma("unroll") for (int ks = 0; ks < 4; ++ks) { dst[ks][0] = __builtin_nontemporal_load((const f32x4*)(xp_ + 32 * ks)); dst[ks][1] = __builtin_nontemporal_load((const f32x4*)(xp_ + 32 * ks + 4)); } } } while (0)
#define N16_FINISH(gf_) do { const int buff_ = (gf_) & 1, r0f_ = 16 * (gf_); \
        {     \
              \
            const int rho = 2 * w + ((lane >> 4) & 1), e = lane & 15; \
            const LAS float* pf = (const LAS float*)pacc + ((size_t)(buff_ * 512 + 16 * (rho >> 2) + e) * 4 + (rho & 3)); \
            float t = 0.f; \
            _Pragma("unroll") for (int q = 0; q < 8; ++q) t += pf[q * 256]; \
            if (MODE == 1) { \
                float gg = t + bias16[e]; gg = 15.f * tanhf(gg * (1.f / 15.f)); \
                if ((e >> 2) & 1) gg = fminf(gg, 0.f) - log1pf(__expf(-fabsf(gg))); \
                if (lane < 32) out16[(size_t)(r0f_ + rho) * 16 + e] = gg; \
            } else { \
                float mx = t; \
                mx = fmaxf(mx, dpp_f<0xB1>(mx, mx)); mx = fmaxf(mx, dpp_f<0x4E>(mx, mx)); mx = fmaxf(mx, dpp_f<0x141>(mx, mx)); mx = fmaxf(mx, dpp_f<0x140>(mx, mx)); \
                const float ex = __expf(t - mx); const float sm = row16_sum(ex); \
                if (lane < 32) out16[(size_t)e * RT + r0f_ + rho] = ex / sm;                \
            } \
        } } while (0)
    f32x4 xa[4][2], xb[4][2], shv[4][2], scv[4][2]; int mi_cur = -1;
    __syncthreads();
    if (g0 < g1) N16_LOAD(xa, g0);
    if (g0 + 1 < g1) N16_LOAD(xb, g0 + 1);
    for (int gi2 = g0; gi2 < g1; gi2 += 2) {
#pragma unroll
      for (int hb = 0; hb < 2; ++hb) { if (gi2 + hb < g1) { f32x4 (&xn)[4][2] = hb ? xb : xa; const int gi = gi2 + hb;
        const int buf = gi & 1; const int r0 = 16 * gi; const int mi = (r0 >= RL) ? NB : (r0 >> 12);
        f32x4 (&x)[4][2] = xn;
        float ss = 0.f;
#pragma unroll
        for (int ks = 0; ks < 4; ++ks)
#pragma unroll
            for (int h2 = 0; h2 < 2; ++h2) ss += (x[ks][h2].x * x[ks][h2].x + x[ks][h2].y * x[ks][h2].y) + (x[ks][h2].z * x[ks][h2].z + x[ks][h2].w * x[ks][h2].w);
        ss = swap16_add(ss, ss); ss = swap32_add(ss, ss);
        if (g == 0) part[buf * 128 + w * 16 + row] = ss;
        __syncthreads();
        if (gi > g0) N16_FINISH(gi - 1);
        float tot = 0.f;
#pragma unroll
        for (int q = 0; q < 8; ++q) tot += part[buf * 128 + q * 16 + row];
        const float rstd = rsqrtf(tot * (1.f / D) + NORM_EPS);
        if (mi != mi_cur) { mi_cur = mi;
            const float* shp = shiftv + (size_t)mi * 6 * D + 128 * w + 8 * g; const float* scp = scalev + (size_t)mi * 6 * D + 128 * w + 8 * g;
#pragma unroll
            for (int ks = 0; ks < 4; ++ks)
#pragma unroll
                for (int h2 = 0; h2 < 2; ++h2) { shv[ks][h2] = *(const f32x4*)(shp + 32 * ks + 4 * h2); const f32x4 sc = *(const f32x4*)(scp + 32 * ks + 4 * h2); scv[ks][h2] = (sc + 1.f) * gn[ks][h2]; } }
        f32x4 acc = (f32x4){0.f, 0.f, 0.f, 0.f};
#pragma unroll
        for (int ks = 0; ks < 4; ++ks) {
            f32x4 h[2];
#pragma unroll
            for (int h2 = 0; h2 < 2; ++h2) h[h2] = (x[ks][h2] * rstd) * scv[ks][h2] + shv[ks][h2];
            const size_t ho = (size_t)(r0 + row) * D + 128 * w + 32 * ks + 8 * g;
            u32x4 hi4; hi4.x = pk2(h[0].x, h[0].y); hi4.y = pk2(h[0].z, h[0].w); hi4.z = pk2(h[1].x, h[1].y); hi4.w = pk2(h[1].z, h[1].w);
            if (F8) { u32x2 o; o.x = pk_fp8x4(h[0].x * FP8_SH, h[0].y * FP8_SH, h[0].z * FP8_SH, h[0].w * FP8_SH); o.y = pk_fp8x4(h[1].x * FP8_SH, h[1].y * FP8_SH, h[1].z * FP8_SH, h[1].w * FP8_SH);
                *(u32x2*)((unsigned char*)H + ho) = o; }
            else *(u32x4*)(H + ho) = hi4;
            u32x4 lo4; lo4.x = pk2(h[0].x - bf_lo(hi4.x), h[0].y - bf_hi(hi4.x)); lo4.y = pk2(h[0].z - bf_lo(hi4.y), h[0].w - bf_hi(hi4.y));
            lo4.z = pk2(h[1].x - bf_lo(hi4.z), h[1].y - bf_hi(hi4.z)); lo4.w = pk2(h[1].z - bf_lo(hi4.w), h[1].w - bf_hi(hi4.w));
            const bf16x8 ah = __builtin_bit_cast(bf16x8, hi4), al = __builtin_bit_cast(bf16x8, lo4);
            acc = __builtin_amdgcn_mfma_f32_16x16x32_bf16(ah, wh[ks], acc, 0, 0, 0);
            acc = __builtin_amdgcn_mfma_f32_16x16x32_bf16(ah, wlo[ks], acc, 0, 0, 0);
            acc = __builtin_amdgcn_mfma_f32_16x16x32_bf16(al, wh[ks], acc, 0, 0, 0);
        }
        if (gi + 2 < g1) N16_LOAD(xn, gi + 2);
        pacc[buf * 512 + w * 64 + lane] = acc;
        } } }
    __syncthreads();
    if (g0 < g1) N16_FINISH(g1 - 1);
#undef N16_LOAD
#undef N16_FINISH
    __syncthreads();
}

__device__ __forceinline__ void gates16_pass(Frame& F, const bf16_t* Hrows, int nrows, const float* W16, int ldw16, const float* bias16, float* out16) {
    const int lane = F.lane, row = lane & 15, g = lane >> 4;
    const int ngrp = nrows / 16; const int per = (ngrp + F.NGW - 1) / F.NGW; const int g0 = F.gw * per, g1 = (g0 + per < ngrp) ? g0 + per : ngrp;
    for (int gi = g0; gi < g1; ++gi) {
        const int r0 = 16 * gi; const bf16_t* xp = Hrows + (size_t)(r0 + row) * D + 8 * g;
        f32x4 acc = (f32x4){0.f, 0.f, 0.f, 0.f};
#pragma unroll 4
        for (int ks = 0; ks < 32; ++ks) {
#if MLS_FP8_IN
            bf16x8 ah; { const u32x2 u8 = *(const u32x2*)((const unsigned char*)Hrows + (size_t)(r0 + row) * D + 8 * g + 32 * ks);
                const f32x2 c0 = __builtin_amdgcn_cvt_pk_f32_fp8((int)u8.x, false), c1 = __builtin_amdgcn_cvt_pk_f32_fp8((int)u8.x, true), c2 = __builtin_amdgcn_cvt_pk_f32_fp8((int)u8.y, false), c3 = __builtin_amdgcn_cvt_pk_f32_fp8((int)u8.y, true);
                const float is = 1.f / FP8_SH;
                ah = __builtin_bit_cast(bf16x8, (u32x4){pk2(c0.x * is, c0.y * is), pk2(c1.x * is, c1.y * is), pk2(c2.x * is, c2.y * is), pk2(c3.x * is, c3.y * is)}); }
#else
            const bf16x8 ah = *(const bf16x8*)(xp + 32 * ks);
#endif
            float t[8];
#pragma unroll
            for (int jj = 0; jj < 8; ++jj) t[jj] = W16[(size_t)(32 * ks + 8 * g + jj) * ldw16 + row];
            unsigned hp[4], lp[4];
#pragma unroll
            for (int q = 0; q < 4; ++q) { hp[q] = pk2(t[2 * q], t[2 * q + 1]); lp[q] = pk2(t[2 * q] - bf_lo(hp[q]), t[2 * q + 1] - bf_hi(hp[q])); }
            const bf16x8 bh = __builtin_bit_cast(bf16x8, (u32x4){hp[0], hp[1], hp[2], hp[3]}), bl = __builtin_bit_cast(bf16x8, (u32x4){lp[0], lp[1], lp[2], lp[3]});
            acc = __builtin_amdgcn_mfma_f32_16x16x32_bf16(ah, bh, acc, 0, 0, 0);
            acc = __builtin_amdgcn_mfma_f32_16x16x32_bf16(ah, bl, acc, 0, 0, 0);
        }
        const float bb = bias16[row]; const int gate = row >> 2;
#pragma unroll
        for (int reg = 0; reg < 4; ++reg) { float gg = acc[reg] + bb; gg = 15.f * tanhf(gg * (1.f / 15.f));
            if (gate & 1) gg = fminf(gg, 0.f) - log1pf(__expf(-fabsf(gg)));
            out16[(size_t)(r0 + 4 * g + reg) * 16 + row] = gg; }
    }
}

__device__ __forceinline__ void moe_select(Frame& F, const float* AFF, int* INV, int* SLROW, float* SLG, int nunits) {
    LAS unsigned* keys = (LAS unsigned*)F.lds;
    LAS unsigned* wsum = (LAS unsigned*)(F.lds + 16384);
    const int tid = F.tid, lane = F.lane, wave = F.wave;
    for (int u = F.vcu; u < nunits; u += F.G) {
        const int set = u >> 4, e = u & 15; const bool isc = set >= NB; const int b = isc ? set - NB : set;
        const int N = isc ? CTXL : SEQ, k = isc ? CAP_C : CAP_L, PER = isc ? 1 : 8;
        const int row0 = isc ? RL + b * CTXL : b * SEQ;
        const int nmine = (tid * PER < N) ? PER : 0;
        unsigned kv[8];
        if (tid < 32) wsum[tid] = 0u;
#pragma unroll
        for (int i = 0; i < 8; ++i) { kv[i] = 0u; if (i < nmine) kv[i] = __float_as_uint(AFF[(size_t)e * RT + row0 + tid * PER + i]); }
        __syncthreads();
        unsigned T = 0u; { unsigned kk = (unsigned)k;
        for (int pass = 0; pass < 8; ++pass) {
            const int shift = 28 - 4 * pass; LAS unsigned* hist = wsum + (pass & 1) * 16;
            if (tid < 16) wsum[((pass + 1) & 1) * 16 + tid] = 0u;
#pragma unroll
            for (int i = 0; i < 8; ++i) if (i < nmine && (pass == 0 || (kv[i] >> (shift + 4)) == (T >> (shift + 4)))) (void)__hip_atomic_fetch_add(&hist[(kv[i] >> shift) & 15u], 1u, __ATOMIC_RELAXED, __HIP_MEMORY_SCOPE_WORKGROUP);
            __syncthreads();
            unsigned cum = 0u, digit = 0u; bool found = false;
#pragma unroll
            for (int d = 15; d >= 0; --d) { const unsigned c = hist[d]; if (!found) { if (cum + c >= kk) { digit = (unsigned)d; found = true; } else cum += c; } }
            kk -= cum; T |= digit << shift;
            __syncthreads();
        } }
        unsigned ngt = 0u, neq = 0u;
#pragma unroll
        for (int i = 0; i < 8; ++i) { if (i < nmine) { ngt += kv[i] > T ? 1u : 0u; neq += kv[i] == T ? 1u : 0u; } }
        unsigned sgt = ngt, seq = neq;
#pragma unroll
        for (int o = 1; o < 64; o <<= 1) { const unsigned a = shfl_up_l(sgt, o, lane), c2 = shfl_up_l(seq, o, lane); if (lane >= o) { sgt += a; seq += c2; } }
        LAS unsigned* sc = wsum + 32;
        __syncthreads();
        if (lane == 63) { sc[wave] = sgt; sc[8 + wave] = seq; }
        __syncthreads();
        unsigned bgt = 0u, beq = 0u, tgt = 0u;
#pragma unroll
        for (int w = 0; w < 8; ++w) { const unsigned a = sc[w], c2 = sc[8 + w]; if (w < wave) { bgt += a; beq += c2; } tgt += a; }
        const unsigned need = (unsigned)k - tgt;
        unsigned pgt = bgt + sgt - ngt, peq = beq + seq - neq;
        const int sbase = isc ? NB * CAP_L + b * CAP_C : b * CAP_L;
#pragma unroll
        for (int i = 0; i < 8; ++i) { if (i < nmine) {
            const int row = row0 + tid * PER + i; int slot = -1;
            if (kv[i] > T) { slot = (int)(pgt + (peq < need ? peq : need)); ++pgt; }
            else if (kv[i] == T) { if (peq < need) slot = (int)(pgt + peq); ++peq; }
            if (slot >= 0) { SLROW[e * SLOTS_E + sbase + slot] = row; SLG[e * SLOTS_E + sbase + slot] = __uint_as_float(kv[i]); }
            INV[(size_t)e * RT + row] = slot >= 0 ? sbase + slot : -1; } }
        __syncthreads();
    }
    (void)keys;
}

__device__ __forceinline__ void moe_gather(Frame& F, const bf16_t* H, const int* SLROW, bf16_t* XG, bool with_ctx) {
    const int per_e = with_ctx ? SLOTS_E : NB * CAP_L; const int total = NE * per_e;
    const int per = (total + F.NGW - 1) / F.NGW; const int i0 = F.gw * per, i1 = (i0 + per < total) ? i0 + per : total;
    for (int i = i0; i < i1; i += 4) {
        u32x4 a[4], b2[4]; size_t dsto[4];
#pragma unroll
        for (int q = 0; q < 4; ++q) { const int ii = (i + q < i1) ? i + q : i1 - 1; const int e = ii / per_e, sl = ii - e * per_e; const int row = SLROW[e * SLOTS_E + sl];
            const u32x4* src = (const u32x4*)(H + (size_t)row * D) + F.lane; a[q] = src[0]; b2[q] = src[64]; dsto[q] = ((size_t)e * SLOTS_E + sl) * D; }
#pragma unroll
        for (int q = 0; q < 4; ++q) { u32x4* dst = (u32x4*)(XG + dsto[q]) + F.lane; dst[0] = a[q]; dst[64] = b2[q]; }
    }
}

template <int MODE, bool F8H = false>
__device__ __forceinline__ void combine_norm(Frame& F, const bf16_t* Y, const int* INV, bf16_t* X16, float* outL  , const float* g2v  , int nrows,
                                             const float* gain, const float* shiftv, const float* scalev, bf16_t* H, const float* W16, int ldw16, const float* bias16, float* out16) {
    LAS float* wl = (LAS float*)F.lds;
    if (MODE == 1) load_w16(F, W16, ldw16);
    const int lane = F.lane;
    f32x4 gv[4];
#pragma unroll
    for (int j = 0; j < 4; ++j) gv[j] = *(const f32x4*)(gain + 4 * lane + 256 * j);
    const int per = (nrows + F.NGW - 1) / F.NGW; const int r0 = F.gw * per, r1 = (r0 + per < nrows) ? r0 + per : nrows;
#define CN_XLOAD(dst, rr) do { const u32x2* xp_ = (const u32x2*)(X16 + (size_t)(rr) * D) + lane; _Pragma("unroll") for (int j = 0; j < 4; ++j) { const u32x2 t_ = xp_[64 * j]; dst[j] = (f32x4){bf_lo(t_.x), bf_hi(t_.x), bf_lo(t_.y), bf_hi(t_.y)}; } } while (0)
#define CN_INV(rr) (((rr) < r1 && lane < 16) ? INV[(size_t)lane * RT + (rr)] : -1)
#if MOE_Y_FP8
#define CN_YLOAD(dst, e_, s_) do { const unsigned* yp_ = (const unsigned*)((const unsigned char*)Y + ((size_t)(e_) * SLOTS_E + (s_)) * D) + lane; _Pragma("unroll") for (int j = 0; j < 4; ++j) dst[j].x = __builtin_nontemporal_load(yp_ + 64 * j); } while (0)
#define CN_YACC(src) do { _Pragma("unroll") for (int j = 0; j < 4; ++j) { const f32x2 lo_ = __builtin_amdgcn_cvt_pk_f32_fp8((int)src[j].x, false), hi_ = __builtin_amdgcn_cvt_pk_f32_fp8((int)src[j].x, true); \
        a[j].x += lo_.x; a[j].y += lo_.y; a[j].z += hi_.x; a[j].w += hi_.y; } } while (0)
#else
#define CN_YLOAD(dst, e_, s_) do { const u32x2* yp_ = (const u32x2*)(Y + ((size_t)(e_) * SLOTS_E + (s_)) * D) + lane; _Pragma("unroll") for (int j = 0; j < 4; ++j) dst[j] = yp_[64 * j]; } while (0)
#define CN_YACC(src) do { _Pragma("unroll") for (int j = 0; j < 4; ++j) { a[j].x += bf_lo(src[j].x); a[j].y += bf_hi(src[j].x); a[j].z += bf_lo(src[j].y); a[j].w += bf_hi(src[j].y); } } while (0)
#endif
    f32x4 g2c[4], sgc[4], shc[4]; int mi_cur = -1;
#pragma unroll
    for (int j = 0; j < 4; ++j) { g2c[j] = (f32x4){0.f, 0.f, 0.f, 0.f}; sgc[j] = g2c[j]; shc[j] = g2c[j]; }
    u32x2 xA[4], xB[4], pA0[4], pA1[4], pA2[4], pA3[4], pB0[4], pB1[4], pB2[4], pB3[4];
#define CN_XRAW(dst, rr) do { const u32x2* xp_ = (const u32x2*)(X16 + (size_t)(rr) * D) + lane; _Pragma("unroll") for (int j = 0; j < 4; ++j) dst[j] = __builtin_nontemporal_load(xp_ + 64 * j); } while (0)
#define CN_FILL(xr_, q0_, q1_, q2_, q3_, inv_, rr) do { CN_XRAW(xr_, rr); unsigned long long m_ = __ballot((inv_) >= 0); \
        if (m_) { const int e0_ = __builtin_ctzll(m_); m_ &= m_ - 1; CN_YLOAD(q0_, e0_, __builtin_amdgcn_readlane((inv_), e0_)); if (m_) { const int e1_ = __builtin_ctzll(m_); m_ &= m_ - 1; CN_YLOAD(q1_, e1_, __builtin_amdgcn_readlane((inv_), e1_)); \
            if (m_) { const int e2_ = __builtin_ctzll(m_); m_ &= m_ - 1; CN_YLOAD(q2_, e2_, __builtin_amdgcn_readlane((inv_), e2_)); if (m_) { const int e3_ = __builtin_ctzll(m_); CN_YLOAD(q3_, e3_, __builtin_amdgcn_readlane((inv_), e3_)); } } } } } while (0)
    int invA = CN_INV(r0), invB = CN_INV(r0 + 1), invC = CN_INV(r0 + 2);
#pragma unroll
    for (int j = 0; j < 4; ++j) { xA[j] = (u32x2){0u, 0u}; xB[j] = (u32x2){0u, 0u}; pA0[j] = (u32x2){0u, 0u}; pA1[j] = (u32x2){0u, 0u}; pA2[j] = (u32x2){0u, 0u}; pA3[j] = (u32x2){0u, 0u};
        pB0[j] = (u32x2){0u, 0u}; pB1[j] = (u32x2){0u, 0u}; pB2[j] = (u32x2){0u, 0u}; pB3[j] = (u32x2){0u, 0u}; }
    if (r0 < r1) CN_FILL(xA, pA0, pA1, pA2, pA3, invA, r0);
    if (r0 + 1 < r1) CN_FILL(xB, pB0, pB1, pB2, pB3, invB, r0 + 1);
    for (int r2 = r0; r2 < r1; r2 += 2) {
#pragma unroll
      for (int hb = 0; hb < 2; ++hb) { const int r = r2 + hb; if (r < r1) {
        asm volatile("" ::: "memory");
        u32x2 (&xr)[4] = hb ? xB : xA; u32x2 (&pc0)[4] = hb ? pB0 : pA0; u32x2 (&pc1)[4] = hb ? pB1 : pA1; u32x2 (&pc2)[4] = hb ? pB2 : pA2; u32x2 (&pc3)[4] = hb ? pB3 : pA3;
        const int invD = CN_INV(r + 3);
        f32x4 v[4];
#pragma unroll
        for (int j = 0; j < 4; ++j) v[j] = (f32x4){bf_lo(xr[j].x), bf_hi(xr[j].x), bf_lo(xr[j].y), bf_hi(xr[j].y)};
        f32x4 a[4];
#pragma unroll
        for (int j = 0; j < 4; ++j) a[j] = (f32x4){0.f, 0.f, 0.f, 0.f};
        { unsigned long long m = __ballot(invA >= 0);
          if (m) { m &= m - 1; CN_YACC(pc0);
            if (m) { m &= m - 1; CN_YACC(pc1);
              if (m) { m &= m - 1; CN_YACC(pc2);
                if (m) { m &= m - 1; CN_YACC(pc3);
                  while (m) { const int e4 = __builtin_ctzll(m); m &= m - 1; u32x2 t4[4]; CN_YLOAD(t4, e4, __builtin_amdgcn_readlane(invA, e4)); CN_YACC(t4); } } } } } }
        if (r + 2 < r1) CN_FILL(xr, pc0, pc1, pc2, pc3, invC, r + 2);
        const int mi = (r >= RL) ? NB : (r >> 12);
        if (mi != mi_cur) { mi_cur = mi;
            const float* gp = g2v + (size_t)mi * 6 * D;
#pragma unroll
            for (int j = 0; j < 4; ++j) g2c[j] = *(const f32x4*)(gp + 4 * lane + 256 * j) * (MOE_Y_FP8 ? 1.f / FP8_SY : 1.f);
            if (MODE == 0) {
#pragma unroll
                for (int j = 0; j < 4; ++j) { const f32x4 sc = *(const f32x4*)(scalev + (size_t)mi * 6 * D + 4 * lane + 256 * j); shc[j] = *(const f32x4*)(shiftv + (size_t)mi * 6 * D + 4 * lane + 256 * j); sgc[j] = (sc + 1.f) * gv[j]; } } }
#pragma unroll
        for (int j = 0; j < 4; ++j) v[j] = v[j] + g2c[j] * a[j];
        if (MODE == 3) { float* xw = outL + (size_t)r * D;
            float ss = 0.f;
#pragma unroll
            for (int j = 0; j < 4; ++j) ss += (v[j].x * v[j].x + v[j].y * v[j].y) + (v[j].z * v[j].z + v[j].w * v[j].w);
            const float rstd = rsqrtf(wave_sum(ss) * (1.f / D) + NORM_EPS);
#pragma unroll
            for (int j = 0; j < 4; ++j) __builtin_nontemporal_store(v[j] * rstd * gv[j], (f32x4*)(xw + 4 * lane + 256 * j));
        } else {
#pragma unroll
            for (int j = 0; j < 4; ++j) __builtin_nontemporal_store((unsigned long long)pk2(v[j].x, v[j].y) | ((unsigned long long)pk2(v[j].z, v[j].w) << 32), (unsigned long long*)(X16 + (size_t)r * D) + lane + 64 * j);
            if (MODE == 0) {
                float ss = 0.f;
#pragma unroll
                for (int j = 0; j < 4; ++j) ss += (v[j].x * v[j].x + v[j].y * v[j].y) + (v[j].z * v[j].z + v[j].w * v[j].w);
                const float rstd = rsqrtf(wave_sum(ss) * (1.f / D) + NORM_EPS);
#pragma unroll
                for (int j = 0; j < 4; ++j) { const f32x4 h = (v[j] * rstd) * sgc[j] + shc[j];
                    if (F8H) ((unsigned*)((unsigned char*)H + (size_t)r * D))[lane + 64 * j] = pk_fp8x4(h.x * FP8_SH, h.y * FP8_SH, h.z * FP8_SH, h.w * FP8_SH);
                    else ((unsigned long long*)(H + (size_t)r * D))[lane + 64 * j] = (unsigned long long)pk2(h.x, h.y) | ((unsigned long long)pk2(h.z, h.w) << 32); }
            } else norm_core<MODE, F8H>(wl, lane, v, r, gv, shiftv + (size_t)mi * 6 * D, scalev + (size_t)mi * 6 * D, H, bias16, out16);
        }
        invA = invB; invB = invC; invC = invD;
      } }
    }
#undef CN_XRAW
#undef CN_FILL
#undef CN_XLOAD
#undef CN_INV
#undef CN_YLOAD
#undef CN_YACC
    if (MODE == 1) __syncthreads();
}

__device__ __forceinline__ void final_norm(Frame& F, float* x, const float* gain) {
    const int lane = F.lane;
    for (int r = F.gw; r < RL; r += F.NGW) { float* xr = x + (size_t)r * D; f32x4 v[4]; float ss = 0.f;
#pragma unroll
        for (int j = 0; j < 4; ++j) { v[j] = *(const f32x4*)(xr + 4 * lane + 256 * j); ss += (v[j].x * v[j].x + v[j].y * v[j].y) + (v[j].z * v[j].z + v[j].w * v[j].w); }
        const float rstd = rsqrtf(wave_sum(ss) * (1.f / D) + NORM_EPS);
#pragma unroll
        for (int j = 0; j < 4; ++j) { const f32x4 g = *(const f32x4*)(gain + 4 * lane + 256 * j); *(f32x4*)(xr + 4 * lane + 256 * j) = v[j] * rstd * g; } }
}

__device__ __forceinline__ void unpack8(const u32x4 u, float (&x)[8]) { x[0] = bf_lo(u.x); x[1] = bf_hi(u.x); x[2] = bf_lo(u.y); x[3] = bf_hi(u.y); x[4] = bf_lo(u.z); x[5] = bf_hi(u.z); x[6] = bf_lo(u.w); x[7] = bf_hi(u.w); }
__device__ __forceinline__ u32x4 pack8(const float (&y)[8]) { u32x4 o; o.x = pk2(y[0], y[1]); o.y = pk2(y[2], y[3]); o.z = pk2(y[4], y[5]); o.w = pk2(y[6], y[7]); return o; }
__device__ __forceinline__ void k_pass(Frame& F, bf16_t* QKV, const float* kn, const float* ropec, const float* ropes) {
    const int lane = F.lane, p = lane & 3, kh = (lane >> 2) & 3, rsub = lane >> 4;
    float gk1[8], gk2[8];
#pragma unroll
    for (int t = 0; t < 8; ++t) { gk1[t] = kn[8 * p + t]; gk2[t] = kn[32 + 8 * p + t]; }
    const int ngrp = RT / 4; const int per = (ngrp + F.NGW - 1) / F.NGW; const int g0 = F.gw * per, g1 = (g0 + per < ngrp) ? g0 + per : ngrp;
    for (int gI = g0; gI < g1; gI += 2) {
        u32x4 ua[2], ub[2]; f32x4 c0[2], c1[2], s0[2], s1[2];
#pragma unroll
        for (int q = 0; q < 2; ++q) { const int gg = (gI + q < g1) ? gI + q : g1 - 1; const int rr = 4 * gg + rsub; const bool isc = rr >= RL; const int t = isc ? 0 : (rr & 4095);
            const bf16_t* hp = QKV + (size_t)rr * 1536 + 1024 + kh * 64 + 8 * p;
            ua[q] = *(const u32x4*)hp; ub[q] = *(const u32x4*)(hp + 32);
            c0[q] = *(const f32x4*)(ropec + t * 32 + 8 * p); c1[q] = *(const f32x4*)(ropec + t * 32 + 8 * p + 4); s0[q] = *(const f32x4*)(ropes + t * 32 + 8 * p); s1[q] = *(const f32x4*)(ropes + t * 32 + 8 * p + 4); }
#pragma unroll
        for (int q = 0; q < 2; ++q) { if (gI + q < g1) { const int rr = 4 * (gI + q) + rsub; const bool isc = rr >= RL;
            float cs[8] = {c0[q].x, c0[q].y, c0[q].z, c0[q].w, c1[q].x, c1[q].y, c1[q].z, c1[q].w}, sn[8] = {s0[q].x, s0[q].y, s0[q].z, s0[q].w, s1[q].x, s1[q].y, s1[q].z, s1[q].w};
            if (isc) {
#pragma unroll
                for (int i = 0; i < 8; ++i) { cs[i] = 1.f; sn[i] = 0.f; } }
            float x1[8], x2[8]; unpack8(ua[q], x1); unpack8(ub[q], x2);
            float ss = 0.f;
#pragma unroll
            for (int i = 0; i < 8; ++i) ss += x1[i] * x1[i] + x2[i] * x2[i];
            ss = quad_sum(ss);
            const float rstd = rsqrtf(ss * (1.f / 64.f) + NORM_EPS);
            float y1[8], y2[8];
#pragma unroll
            for (int i = 0; i < 8; ++i) { const float a = x1[i] * rstd * gk1[i], c = x2[i] * rstd * gk2[i]; y1[i] = a * cs[i] - c * sn[i]; y2[i] = a * sn[i] + c * cs[i]; }
            bf16_t* hp = QKV + (size_t)rr * 1536 + 1024 + kh * 64 + 8 * p;
            *(u32x4*)hp = pack8(y1); *(u32x4*)(hp + 32) = pack8(y2); } }
    }
}

__device__ __forceinline__ void kv8_pass(Frame& F, const bf16_t* QKV, const float* kn, const float* ropec, const float* ropes, unsigned char* KV8) {
    {
        const int lane = F.lane, p = lane & 3, kh = (lane >> 2) & 3, rsub = lane >> 4;
        float gk1[8], gk2[8];
#pragma unroll
        for (int t = 0; t < 8; ++t) { gk1[t] = kn[8 * p + t]; gk2[t] = kn[32 + 8 * p + t]; }
        const int ngrp = RT / 4; const int per = (ngrp + F.NGW - 1) / F.NGW; const int g0 = F.gw * per, g1 = (g0 + per < ngrp) ? g0 + per : ngrp;
        for (int gI = g0; gI < g1; gI += 2) {
            u32x4 ua[2], ub[2]; f32x4 c0[2], c1[2], s0[2], s1[2];
#pragma unroll
            for (int q = 0; q < 2; ++q) { const int gg = (gI + q < g1) ? gI + q : g1 - 1; const int rr = 4 * gg + rsub; const bool isc = rr >= RL; const int t = isc ? 0 : (rr & 4095);
                const bf16_t* hp = QKV + (size_t)rr * 1536 + 1024 + kh * 64 + 8 * p;
                ua[q] = *(const u32x4*)hp; ub[q] = *(const u32x4*)(hp + 32);
                c0[q] = *(const f32x4*)(ropec + t * 32 + 8 * p); c1[q] = *(const f32x4*)(ropec + t * 32 + 8 * p + 4); s0[q] = *(const f32x4*)(ropes + t * 32 + 8 * p); s1[q] = *(const f32x4*)(ropes + t * 32 + 8 * p + 4); }
#pragma unroll
            for (int q = 0; q < 2; ++q) { if (gI + q < g1) { const int rr = 4 * (gI + q) + rsub; const bool isc = rr >= RL;
                float cs[8] = {c0[q].x, c0[q].y, c0[q].z, c0[q].w, c1[q].x, c1[q].y, c1[q].z, c1[q].w}, sn[8] = {s0[q].x, s0[q].y, s0[q].z, s0[q].w, s1[q].x, s1[q].y, s1[q].z, s1[q].w};
                if (isc) {
#pragma unroll
                    for (int i = 0; i < 8; ++i) { cs[i] = 1.f; sn[i] = 0.f; } }
                float x1[8], x2[8]; unpack8(ua[q], x1); unpack8(ub[q], x2);
                float ss = 0.f;
#pragma unroll
                for (int i = 0; i < 8; ++i) ss += x1[i] * x1[i] + x2[i] * x2[i];
                ss = quad_sum(ss);
                const float rstd = rsqrtf(ss * (1.f / 64.f) + NORM_EPS) * FP8_SK;
                float y1[8], y2[8];
#pragma unroll
                for (int i = 0; i < 8; ++i) { const float a = x1[i] * rstd * gk1[i], c = x2[i] * rstd * gk2[i]; y1[i] = a * cs[i] - c * sn[i]; y2[i] = a * sn[i] + c * cs[i]; }
                const int b = isc ? ((rr - RL) >> 8) : (rr >> 12); const int keyp = isc ? ((rr - RL) & 255) : (256 + (rr & 4095));
                unsigned char* tb = KV8 + (size_t)((b * 4 + kh) * (KVLEN / 64) + (keyp >> 6)) * 8192 + (keyp & 63) * 16 + 8 * (p >> 1) + (2 * (p & 1)) * 1024;
                u32x2 o1, o2; o1.x = pk_fp8x4(y1[0], y1[1], y1[2], y1[3]); o1.y = pk_fp8x4(y1[4], y1[5], y1[6], y1[7]); o2.x = pk_fp8x4(y2[0], y2[1], y2[2], y2[3]); o2.y = pk_fp8x4(y2[4], y2[5], y2[6], y2[7]);
                *(u32x2*)tb = o1; *(u32x2*)(tb + 1024) = o2; } }
        }
    }
    {
        const int lane = F.lane; LAS unsigned* scr = (LAS unsigned*)(F.lds) + F.wave * (64 * 17);
        const int dq = lane & 15, g = lane >> 4, hi = g >> 1, half = g & 1;
        for (int it = F.gw; it < NB * 4 * (KVLEN / 64); it += F.NGW) {
            const int tile = it % (KVLEN / 64), bk = it / (KVLEN / 64), kh = bk & 3, b = bk >> 2;
            const size_t row = (tile < 4) ? ((size_t)RL + b * CTXL + tile * 64 + lane) : ((size_t)b * SEQ + (tile - 4) * 64 + lane);
            const bf16_t* vp = QKV + row * 1536 + 1280 + kh * 64;
            u32x4 u[8];
#pragma unroll
            for (int i = 0; i < 8; ++i) u[i] = *(const u32x4*)(vp + 8 * i);
#pragma unroll
            for (int i = 0; i < 8; ++i) { float x[8]; unpack8(u[i], x);
                scr[lane * 17 + 2 * i] = pk_fp8x4(x[0] * FP8_SV, x[1] * FP8_SV, x[2] * FP8_SV, x[3] * FP8_SV); scr[lane * 17 + 2 * i + 1] = pk_fp8x4(x[4] * FP8_SV, x[5] * FP8_SV, x[6] * FP8_SV, x[7] * FP8_SV); }
            LDS_WAIT(); asm volatile("" ::: "memory");
            unsigned x[16];
#pragma unroll
            for (int jj = 0; jj < 16; ++jj) { const int key = 32 * half + (jj & 3) + 8 * (jj >> 2) + 4 * hi; x[jj] = scr[key * 17 + dq]; }
            LDS_WAIT(); asm volatile("" ::: "memory");
            unsigned char* ob = KV8 + (size_t)it * 8192 + 4096 + g * 1024 + (4 * dq) * 16;
#pragma unroll
            for (int c = 0; c < 4; ++c) { u32x4 o; const unsigned sel = (unsigned)c | ((unsigned)(4 + c) << 8) | 0x0c0c0000u;
#pragma unroll
                for (int w = 0; w < 4; ++w) { const unsigned t01 = __builtin_amdgcn_perm(x[4 * w + 1], x[4 * w], sel), t23 = __builtin_amdgcn_perm(x[4 * w + 3], x[4 * w + 2], sel); o[w] = __builtin_amdgcn_perm(t23, t01, 0x05040100u); }
                *(u32x4*)(ob + c * 16) = o; }
        }
    }
}

__device__ __forceinline__ void mlstm_readout(Frame& F, const bf16_t* HF, const bf16_t* HB, const bf16_t* QKVO, const float* wnorm, bf16_t* MIX) {
    const int lane = F.lane;
    f32x4 gv[4];
#pragma unroll
    for (int j = 0; j < 4; ++j) gv[j] = *(const f32x4*)(wnorm + 4 * lane + 256 * j);
    const int per = (((RT + F.NGW - 1) / F.NGW) + 3) & ~3; const int r0 = F.gw * per, r1 = (r0 + per < RT) ? r0 + per : RT;
    for (int r = r0; r < r1; r += 4) {
        u32x2 uf[4][4], ub[4][4], uo[4][4];
#pragma unroll
        for (int q = 0; q < 4; ++q) { const int rr = (r + q < r1) ? r + q : r1 - 1;
            const u32x2* pf = (const u32x2*)(HF + (size_t)rr * D) + lane; const u32x2* pb = (const u32x2*)(HB + (size_t)rr * D) + lane; const u32x2* po = (const u32x2*)(QKVO + (size_t)rr * 3072 + 2048) + lane;
#pragma unroll
            for (int j = 0; j < 4; ++j) { uf[q][j] = __builtin_nontemporal_load(pf + 64 * j); ub[q][j] = __builtin_nontemporal_load(pb + 64 * j); uo[q][j] = __builtin_nontemporal_load(po + 64 * j); } }
#pragma unroll
        for (int q = 0; q < 4; ++q) { const int rr = r + q; if (rr < r1) {
            unsigned long long* o8 = (unsigned long long*)(MIX + (size_t)rr * D) + lane; unsigned* o4 = (unsigned*)((unsigned char*)MIX + (size_t)rr * D) + lane; (void)o8; (void)o4;
#pragma unroll
            for (int j = 0; j < 4; ++j) {
                f32x4 h; h.x = bf_lo(uf[q][j].x) + bf_lo(ub[q][j].x); h.y = bf_hi(uf[q][j].x) + bf_hi(ub[q][j].x); h.z = bf_lo(uf[q][j].y) + bf_lo(ub[q][j].y); h.w = bf_hi(uf[q][j].y) + bf_hi(ub[q][j].y);
                const float ss = wave_sum((h.x * h.x + h.y * h.y) + (h.z * h.z + h.w * h.w));
                const float rstd = rsqrtf(ss * (1.f / 256.f) + NORM_EPS);
                f32x4 og; og.x = bf_lo(uo[q][j].x); og.y = bf_hi(uo[q][j].x); og.z = bf_lo(uo[q][j].y); og.w = bf_hi(uo[q][j].y);
                f32x4 y;
                y.x = h.x * rstd * gv[j].x * fast_rcp(1.f + __expf(-og.x)); y.y = h.y * rstd * gv[j].y * fast_rcp(1.f + __expf(-og.y));
                y.z = h.z * rstd * gv[j].z * fast_rcp(1.f + __expf(-og.z)); y.w = h.w * rstd * gv[j].w * fast_rcp(1.f + __expf(-og.w));
#if MLS_FP8_OUT
                o4[64 * j] = pk_fp8x4(y.x * FP8_SM, y.y * FP8_SM, y.z * FP8_SM, y.w * FP8_SM);
#else
                o8[64 * j] = (unsigned long long)pk2(y.x, y.y) | ((unsigned long long)pk2(y.z, y.w) << 32);
#endif
            } } }
    }
}
namespace mls {
constexpr int XS = 272, PS = 144, NCH = 68;
constexpr int O_XQ = 0, O_XK = 17408, O_XKP = 34816, O_XV = 52224, O_P = 69632, O_CT = 78848, O_OT = 113664, O_GB = 131072;
constexpr int O_RD = O_GB + 2 * 5 * 64 * 4, O_NV = O_RD + 256, O_DEC = O_NV + 1024, O_PRE = O_DEC + 64;
constexpr int LDS_BYTES = O_PRE + 3 * 72 * 4;

__device__ __forceinline__ int row_of(int b, int dir, int c, int p) {
    const int base = (c < 4) ? (RL + b * CTXL + (dir ? 192 - 64 * c : 64 * c)) : (b * SEQ + (dir ? 4032 - 64 * (c - 4) : 64 * (c - 4)));
    return base + (dir ? 63 - p : p);
}
__device__ __forceinline__ int base_of(int b, int dir, int c) { return (c < 4) ? (RL + b * CTXL + (dir ? 192 - 64 * c : 64 * c)) : (b * SEQ + (dir ? 4032 - 64 * (c - 4) : 64 * (c - 4))); }
__device__ __forceinline__ bf16x8 tr8(const LAS unsigned char* p0, const LAS unsigned char* p1) {
    typedef short v4i16_t __attribute__((ext_vector_type(4)));
    const s16x4 lo = __builtin_bit_cast(s16x4, __builtin_amdgcn_ds_read_tr16_b64_v4i16((LAS v4i16_t*)p0));
    const s16x4 hi = __builtin_bit_cast(s16x4, __builtin_amdgcn_ds_read_tr16_b64_v4i16((LAS v4i16_t*)p1));
    return (bf16x8){lo[0], lo[1], lo[2], lo[3], hi[0], hi[1], hi[2], hi[3]};
}

__device__ __forceinline__ void gate_arrays(LAS unsigned char* L, const float lf, const float ig, int c, int lane) {
    const int par = c & 1;
    const float bs = wave_scan_add(lf, lane);
    const float a = ig - bs; const float pm = wave_scan_max(a, lane);
    const float mst = ((const LAS float*)(L + O_PRE))[144 + c];
    const float M = fmaxf(mst, pm), M63 = rdlane(M, 63);
    LAS float* gb = (LAS float*)(L + O_GB) + par * 320;
    gb[lane] = a; gb[64 + lane] = M; gb[128 + lane] = __expf(mst - M); gb[192 + lane] = __expf(-bs - M); gb[256 + lane] = __expf(a - M63);
    if (lane == 0) ((LAS float*)(L + O_DEC))[par] = __expf(mst - M63);
}

__device__ __forceinline__ void mlstm_unit(Frame& F, int b, int hd, int dir, int half, const bf16_t* QKVO, const float* GATES, bf16_t* HOUT) {
    LAS unsigned char* L = F.lds;
    const int tid = F.tid, lane = F.lane, w = F.wave, fr = lane & 15, g = lane >> 4;
    const int gi = (dir * 2) * 4 + hd, gf = (dir * 2 + 1) * 4 + hd;
    LAS float* pre = (LAS float*)(L + O_PRE);
    __syncthreads();
    {
        float lfv[9], igv[9];
#pragma unroll
        for (int q = 0; q < 9; ++q) { const int c = w + 8 * q; lfv[q] = 0.f; igv[q] = 0.f;
            if (c < NCH) { const int row = row_of(b, dir, c, lane); lfv[q] = GATES[(size_t)row * 16 + gf]; igv[q] = GATES[(size_t)row * 16 + gi]; } }
#pragma unroll
        for (int q = 0; q < 9; ++q) { const int c = w + 8 * q;
            if (c < NCH) { const float bs = wave_scan_add(lfv[q], lane); float am = igv[q] - bs;
                am = fmaxf(am, dpp_f<0xB1>(am, am)); am = fmaxf(am, dpp_f<0x4E>(am, am)); am = fmaxf(am, dpp_f<0x141>(am, am)); am = fmaxf(am, dpp_f<0x140>(am, am));
                am = fmaxf(fmaxf(rdlane(am, 0), rdlane(am, 16)), fmaxf(rdlane(am, 32), rdlane(am, 48)));
                if (lane == 0) { pre[c] = rdlane(bs, 63); pre[72 + c] = am; } } }
    }
    for (int i = tid; i < (O_OT - O_CT) / 4; i += NTHREADS) ((LAS unsigned*)(L + O_CT))[i] = 0u;
    for (int i = tid; i < 256; i += NTHREADS) ((LAS float*)(L + O_NV))[i] = 0.f;
    __syncthreads();
    if (tid == 0) { float m = 0.f; for (int c = 0; c < NCH; ++c) { pre[144 + c] = m; m = pre[c] + fmaxf(m, pre[72 + c]); } }
    __syncthreads();
    if (w == 0) { const int row = row_of(b, dir, 0, lane); gate_arrays(L, GATES[(size_t)row * 16 + gf], GATES[(size_t)row * 16 + gi], 0, lane); }
    __syncthreads();
    const int qcol = hd * 128, kcol = 512 + hd * 128, vcol = 1024 + hd * 256 + half * 128;
    u32x4 rq[2], rk[2], rv[2];
#define MLS_BAR() do { asm volatile("s_waitcnt lgkmcnt(0)" ::: "memory"); __builtin_amdgcn_s_barrier(); asm volatile("" ::: "memory"); } while (0)
    unsigned ldoff[2];
#pragma unroll
    for (int i_ = 0; i_ < 2; ++i_) { const int pi_ = tid + 512 * i_, p_ = pi_ >> 4, c16_ = pi_ & 15; ldoff[i_] = (unsigned)((dir ? 63 - p_ : p_) * 3072 + c16_ * 8) * 2u; }
#define MLS_LOAD(c) do { const char* cb_ = (const char*)(QKVO + (size_t)base_of(b, dir, (c)) * 3072); \
        _Pragma("unroll") for (int i_ = 0; i_ < 2; ++i_) { \
        rq[i_] = *(const u32x4*)(cb_ + qcol * 2 + ldoff[i_]); rk[i_] = *(const u32x4*)(cb_ + kcol * 2 + ldoff[i_]); rv[i_] = *(const u32x4*)(cb_ + vcol * 2 + ldoff[i_]); } } while (0)
#define MLS_STAGE(c) do { const LAS float* wk_ = (const LAS float*)(L + O_GB) + ((c) & 1) * 320 + 256; \
        _Pragma("unroll") for (int i_ = 0; i_ < 2; ++i_) { const int pi_ = tid + 512 * i_, p_ = pi_ >> 4, c16_ = pi_ & 15; const int o_ = p_ * XS + c16_ * 16; \
        *(LAS u32x4*)(L + O_XQ + o_) = rq[i_]; *(LAS u32x4*)(L + O_XK + o_) = rk[i_]; *(LAS u32x4*)(L + O_XV + o_) = rv[i_]; \
        const float s_ = wk_[p_]; u32x4 kk_; \
        kk_.x = pk2(bf_lo(rk[i_].x) * s_, bf_hi(rk[i_].x) * s_); kk_.y = pk2(bf_lo(rk[i_].y) * s_, bf_hi(rk[i_].y) * s_); \
        kk_.z = pk2(bf_lo(rk[i_].z) * s_, bf_hi(rk[i_].z) * s_); kk_.w = pk2(bf_lo(rk[i_].w) * s_, bf_hi(rk[i_].w) * s_); \
        *(LAS u32x4*)(L + O_XKP + o_) = kk_; } } while (0)
    MLS_LOAD(0); MLS_STAGE(0);
    __syncthreads();
    f32x4 C[8];
#pragma unroll
    for (int i = 0; i < 8; ++i) C[i] = (f32x4){0.f, 0.f, 0.f, 0.f};
    LAS unsigned char* CTw = L + O_CT + w * (16 * XS);
    float glf_n = 0.f, gig_n = 0.f;
    const unsigned goff = (unsigned)((dir ? 63 - lane : lane) * 16) * 4u;
    if (w == 7) { const char* gb_ = (const char*)(GATES + (size_t)base_of(b, dir, 1) * 16); glf_n = *(const float*)(gb_ + goff + gf * 4); gig_n = *(const float*)(gb_ + goff + gi * 4); }
    for (int c = 0; c < NCH; ++c) {
        const int par = c & 1; const bool more = (c + 1 < NCH);
        const LAS float* gb = (const LAS float*)(L + O_GB) + par * 320;
        const float glf = glf_n, gig = gig_n;
        if (w == 7 && c + 2 < NCH) { const char* gb_ = (const char*)(GATES + (size_t)base_of(b, dir, c + 2) * 16); glf_n = *(const float*)(gb_ + goff + gf * 4); gig_n = *(const float*)(gb_ + goff + gi * 4); }
        if (more) MLS_LOAD(c + 1);
#define LFENCE() do { asm volatile("s_waitcnt lgkmcnt(0)" ::: "memory"); __builtin_amdgcn_sched_barrier(0); } while (0)
#define QFRAG(mt_, ks_) (*(const LAS bf16x8*)(L + O_XQ + (16 * (mt_) + fr) * XS + (32 * (ks_) + 8 * g) * 2))
        f32x4 acc[4];
        {
            const int mt1 = w >> 1;
            bf16x8 ct[4], qa[2][4], qb[2][4];
#pragma unroll
            for (int ks = 0; ks < 4; ++ks) ct[ks] = *(const LAS bf16x8*)(CTw + fr * XS + (32 * ks + 8 * g) * 2);
#pragma unroll
            for (int m2 = 0; m2 < 2; ++m2)
#pragma unroll
                for (int ks = 0; ks < 4; ++ks) qa[m2][ks] = QFRAG(m2, ks);
            LFENCE();
#pragma unroll
            for (int m2 = 0; m2 < 2; ++m2)
#pragma unroll
                for (int ks = 0; ks < 4; ++ks) qb[m2][ks] = QFRAG(2 + m2, ks);
            __builtin_amdgcn_sched_barrier(0);
#pragma unroll
            for (int m2 = 0; m2 < 2; ++m2) { f32x4 a4 = (f32x4){0.f, 0.f, 0.f, 0.f};
#pragma unroll
                for (int ks = 0; ks < 4; ++ks) a4 = __builtin_amdgcn_mfma_f32_16x16x32_bf16(ct[ks], qa[m2][ks], a4, 0, 0, 0);
                acc[m2] = a4; }
            LFENCE();
            bf16x8 aq[4], bk[2][4];
#pragma unroll
            for (int ks = 0; ks < 4; ++ks) aq[ks] = QFRAG(mt1, ks);
#pragma unroll
            for (int n2 = 0; n2 < 2; ++n2)
#pragma unroll
                for (int ks = 0; ks < 4; ++ks) bk[n2][ks] = *(const LAS bf16x8*)(L + O_XK + (16 * (2 * (w & 1) + n2) + fr) * XS + (32 * ks + 8 * g) * 2);
            const float Mj = gb[64 + 16 * mt1 + fr];
            f32x4 as[2]; as[0] = *(const LAS f32x4*)(gb + 16 * (2 * (w & 1)) + 4 * g); as[1] = *(const LAS f32x4*)(gb + 16 * (2 * (w & 1) + 1) + 4 * g);
            float wi[4];
#pragma unroll
            for (int mt = 0; mt < 4; ++mt) wi[mt] = gb[128 + 16 * mt + fr];
            __builtin_amdgcn_sched_barrier(0);
#pragma unroll
            for (int m2 = 0; m2 < 2; ++m2) { f32x4 a4 = (f32x4){0.f, 0.f, 0.f, 0.f};
#pragma unroll
                for (int ks = 0; ks < 4; ++ks) a4 = __builtin_amdgcn_mfma_f32_16x16x32_bf16(ct[ks], qb[m2][ks], a4, 0, 0, 0);
                acc[2 + m2] = a4; }
            LFENCE();
            f32x4 s4[2];
#pragma unroll
            for (int n2 = 0; n2 < 2; ++n2) { s4[n2] = (f32x4){0.f, 0.f, 0.f, 0.f};
#pragma unroll
                for (int ks = 0; ks < 4; ++ks) s4[n2] = __builtin_amdgcn_mfma_f32_16x16x32_bf16(bk[n2][ks], aq[ks], s4[n2], 0, 0, 0); }
#pragma unroll
            for (int mt = 0; mt < 4; ++mt) acc[mt] = acc[mt] * wi[mt];
#pragma unroll
            for (int n2 = 0; n2 < 2; ++n2) { const int s0 = 16 * (2 * (w & 1) + n2) + 4 * g, j = 16 * mt1 + fr; float pv[4];
#pragma unroll
                for (int reg = 0; reg < 4; ++reg) pv[reg] = (s0 + reg <= j) ? s4[n2][reg] * __expf(as[n2][reg] - Mj) : 0.f;
                u32x2 o; o.x = pk2(pv[0], pv[1]); o.y = pk2(pv[2], pv[3]);
                *(LAS u32x2*)(L + O_P + j * PS + s0 * 2) = o; }
        }
        MLS_BAR();
        bf16x8 vf[2];
        float rdv; float nsum;
        const float decay = ((const LAS float*)(L + O_DEC))[par];
        {
            const LAS unsigned char* vb = L + O_XV + (8 * g + (fr >> 2)) * XS + (16 * w + (lane & 3) * 4) * 2;
            const LAS unsigned char* kb = L + O_XKP + (8 * g + (fr >> 2)) * XS + ((lane & 3) * 4) * 2;
            bf16x8 ap[4][2];
#pragma unroll
            for (int k2 = 0; k2 < 2; ++k2) vf[k2] = tr8(vb + 32 * k2 * XS, vb + (32 * k2 + 4) * XS);
#pragma unroll
            for (int mt = 0; mt < 4; ++mt)
#pragma unroll
                for (int k2 = 0; k2 < 2; ++k2) ap[mt][k2] = *(const LAS bf16x8*)(L + O_P + (16 * mt + fr) * PS + (32 * k2 + 8 * g) * 2);
            LFENCE();
            const int j = tid >> 3, part = tid & 7;
            const u32x4 pu = *(const LAS u32x4*)(L + O_P + j * PS + part * 16);
            const u32x4 q0 = *(const LAS u32x4*)(L + O_XQ + j * XS + part * 32), q1 = *(const LAS u32x4*)(L + O_XQ + j * XS + part * 32 + 16);
            const LAS f32x4* np = (const LAS f32x4*)(L + O_NV + par * 512 + part * 64);
            const f32x4 n0 = np[0], n1 = np[1], n2 = np[2], n3 = np[3];
            const float wint_j = gb[128 + j], emq_j = gb[192 + j];
            bf16x8 ak[4][2];
#pragma unroll
            for (int mt = 0; mt < 4; ++mt)
#pragma unroll
                for (int k2 = 0; k2 < 2; ++k2) ak[mt][k2] = tr8(kb + 32 * k2 * XS + 32 * mt, kb + (32 * k2 + 4) * XS + 32 * mt);
            __builtin_amdgcn_sched_barrier(0);
#pragma unroll
            for (int mt = 0; mt < 4; ++mt)
#pragma unroll
                for (int k2 = 0; k2 < 2; ++k2) acc[mt] = __builtin_amdgcn_mfma_f32_16x16x32_bf16(vf[k2], ap[mt][k2], acc[mt], 0, 0, 0);
            LFENCE();
            const int dk = tid >> 2, part4 = tid & 3; bf16_t kc[16];
#pragma unroll
            for (int t = 0; t < 16; ++t) kc[t] = *(const LAS bf16_t*)(L + O_XKP + (16 * part4 + t) * XS + dk * 2);
            const float nold = ((const LAS float*)(L + O_NV))[par * 128 + dk];
            __builtin_amdgcn_sched_barrier(0);
#pragma unroll
            for (int mt = 0; mt < 4; ++mt) { f32x4 c4 = C[mt] * decay;
#pragma unroll
                for (int k2 = 0; k2 < 2; ++k2) c4 = __builtin_amdgcn_mfma_f32_16x16x32_bf16(ak[mt][k2], vf[k2], c4, 0, 0, 0);
                C[mt] = c4; }
            float rs = (bf_lo(pu.x) + bf_hi(pu.x)) + (bf_lo(pu.y) + bf_hi(pu.y)) + (bf_lo(pu.z) + bf_hi(pu.z)) + (bf_lo(pu.w) + bf_hi(pu.w));
            float qn = bf_lo(q0.x) * n0.x + bf_hi(q0.x) * n0.y + bf_lo(q0.y) * n0.z + bf_hi(q0.y) * n0.w
                     + bf_lo(q0.z) * n1.x + bf_hi(q0.z) * n1.y + bf_lo(q0.w) * n1.z + bf_hi(q0.w) * n1.w
                     + bf_lo(q1.x) * n2.x + bf_hi(q1.x) * n2.y + bf_lo(q1.y) * n2.z + bf_hi(q1.y) * n2.w
                     + bf_lo(q1.z) * n3.x + bf_hi(q1.z) * n3.y + bf_lo(q1.w) * n3.z + bf_hi(q1.w) * n3.w;
            rs = oct_sum(rs); qn = oct_sum(qn);
            rdv = 1.f / fmaxf(fabsf(rs + wint_j * qn), emq_j);
            float sm0 = 0.f;
#pragma unroll
            for (int t = 0; t < 16; ++t) sm0 += bf2f(kc[t]);
            __builtin_amdgcn_sched_barrier(0);
#pragma unroll
            for (int mt = 0; mt < 4; ++mt)
#pragma unroll
                for (int k2 = 0; k2 < 2; ++k2) ak[mt][k2] = tr8(kb + 32 * k2 * XS + 32 * (4 + mt), kb + (32 * k2 + 4) * XS + 32 * (4 + mt));
            LFENCE();
#pragma unroll
            for (int mt = 0; mt < 4; ++mt) { f32x4 c4 = C[4 + mt] * decay;
#pragma unroll
                for (int k2 = 0; k2 < 2; ++k2) c4 = __builtin_amdgcn_mfma_f32_16x16x32_bf16(ak[mt][k2], vf[k2], c4, 0, 0, 0);
                C[4 + mt] = c4; }
            float sm = quad_sum(sm0);
            nsum = decay * nold + sm;
        }
#undef LFENCE
#undef QFRAG
        asm volatile("" ::: "memory");
        if ((tid & 7) == 0) ((LAS float*)(L + O_RD))[tid >> 3] = rdv;
        if ((tid & 3) == 0) ((LAS float*)(L + O_NV))[(par ^ 1) * 128 + (tid >> 2)] = nsum;
#pragma unroll
        for (int mt = 0; mt < 8; ++mt) { u32x2 o; o.x = pk2(C[mt][0], C[mt][1]); o.y = pk2(C[mt][2], C[mt][3]);
            *(LAS u32x2*)(CTw + fr * XS + (16 * mt + 4 * g) * 2) = o; }
        if (more && w == 7) gate_arrays(L, glf, gig, c + 1, lane);
        MLS_BAR();
        {
#pragma unroll
            for (int mt = 0; mt < 4; ++mt) { const float rd = ((const LAS float*)(L + O_RD))[16 * mt + fr];
                u32x2 o; o.x = pk2(acc[mt][0] * rd, acc[mt][1] * rd); o.y = pk2(acc[mt][2] * rd, acc[mt][3] * rd);
                *(LAS u32x2*)(L + O_OT + (16 * mt + fr) * XS + (16 * w + 4 * g) * 2) = o; }
            if (more) MLS_STAGE(c + 1);
        }
        MLS_BAR();
        {
            const int j = tid >> 3, ch = tid & 7;
            const u32x4 o0 = *(const LAS u32x4*)(L + O_OT + j * XS + ch * 32), o1 = *(const LAS u32x4*)(L + O_OT + j * XS + ch * 32 + 16);
            bf16_t* op = HOUT + (size_t)base_of(b, dir, c) * D + (dir ? 63 - j : j) * D + hd * 256 + half * 128 + ch * 16;
            *(u32x4*)op = o0; *(u32x4*)(op + 8) = o1;
        }
    }
#undef MLS_BAR
#undef MLS_LOAD
#undef MLS_STAGE
}
}
constexpr int MISC_OFF = 135936, LDS_TOTAL = 136192;
static_assert(mls::LDS_BYTES <= MISC_OFF && pg8::STAGE_BYTES <= MISC_OFF && attn_body::LDS_BYTES <= MISC_OFF && attn8::LDS_BYTES <= MISC_OFF, "lds");
#ifndef EN_MASK
#define EN_MASK 0xFFFFFFFFu
#endif
#define PH_ON(k) (((EN_MASK) >> (k)) & 1u)
#ifndef REP_MASK
#define REP_MASK 0u
#endif
#define REP_ON(k) (((REP_MASK) >> (k)) & 1u)
#ifndef PH_LIMIT
#define PH_LIMIT 1000
#endif
#ifndef N_LAUNCH_SPLIT
#define N_LAUNCH_SPLIT 0
#endif
constexpr int N_PHASES = 1 + 10 + 9 + 9 + 9;

struct Args { const float* in[21]; float* out; unsigned char* ws; int ph_lo, ph_hi; };
static_assert(sizeof(Args) == 23 * 8 + 8, "no padding");

__device__ __forceinline__ Frame make_frame(unsigned char* lds_gen, unsigned char* ws_, const int wave_s) {
    Frame F; int ln; asm volatile("v_mbcnt_lo_u32_b32 %0, -1, 0\n\tv_mbcnt_hi_u32_b32 %0, -1, %0" : "=v"(ln));
    int wv = wave_s; asm volatile("" : "+s"(wv));
    int bx = blockIdx.x; asm volatile("" : "+s"(bx));
    F.lds = (LAS unsigned char*)lds_gen; F.tid = wv * 64 + ln; F.lane = ln; F.wave = wv;
    F.G = gridDim.x; F.bid = bx; F.vcu = (F.G % 8 == 0) ? (bx % 8) * (F.G / 8) + bx / 8 : bx;
    F.gw = F.vcu * NWAVES + F.wave; F.NGW = F.G * NWAVES;
    unsigned long long wi = (unsigned long long)ws_; asm volatile("" : "+s"(wi)); GAS unsigned char* wg = (GAS unsigned char*)wi;
    F.ws = (unsigned char*)wg; F.inq = (const unsigned long long*)(GAS const unsigned long long*)(wg + WS_PTRS); return F;
}
__device__ __forceinline__ void attn_phase8(Frame& F, const int nun, const float mfix, const int j, char* lds_gen) {
    for (int L = F.vcu; L < nun; L += F.G) {
        const bool isc = L >= 4096; const int Lc = L - 4096;
        const int grp = L >> 6, wi = L & 63;
        const int b = isc ? (Lc >> 4) : (grp >> 2), hq = isc ? (Lc & 15) : ((grp & 3) * 4 + (wi >> 4));
        const size_t row0 = isc ? ((size_t)RL + b * CTXL) : ((size_t)b * SEQ + (wi & 15) * 256);
        const bf16_t* qp = (const bf16_t*)(F.ws + WS_BIG0) + row0 * 1536 + hq * 64; unsigned char* op = F.ws + WS_MIX + row0 * D + hq * 64;
        const float* rc = (const float*)(F.ws + WS_ROPE); const float* rs = rc + SEQ * 32;
        const unsigned char* kv8 = F.ws + WS_KV8 + (size_t)((b * 4 + (hq >> 2)) * (KVLEN / 64)) * 8192;
        int ntu = isc ? CTXL / 64 : KVLEN / 64; asm volatile("" : "+s"(ntu));
        attn8::attn_unit8(qp, 1536, kv8, ntu, op, D, lds_gen, F.tid, mfix, (const float*)(GAS const float*)(F.inq[13]) + j * 64, rc, rs, isc ? 0 : 1, isc ? 0 : (wi & 15) * 256); }
}
__global__ void __launch_bounds__(NTHREADS, 2) fwd(Args a) {
    extern __shared__ __attribute__((aligned(16))) unsigned char lds_raw[];
    unsigned char* const lds_gen = lds_raw;
    const int wave_s = __builtin_amdgcn_readfirstlane((int)threadIdx.x >> 6);
    unsigned char* ws = a.ws;
    if (threadIdx.x < 4) ((LAS unsigned*)((LAS unsigned char*)lds_raw + MISC_OFF))[threadIdx.x] = 0u;
    unsigned long long probe_acc = 0ull, probe_t0 = 0ull; bool probe_open = false; (void)probe_acc; (void)probe_t0; (void)probe_open;
    __syncthreads();
    XcdBarrier bar = xcd_barrier_post((unsigned*)(ws + WS_CTL), (volatile LAS unsigned*)((LAS unsigned char*)lds_raw + MISC_OFF));
    int cur = 0; const int lo = a.ph_lo, hi = a.ph_hi & 0xffff; bool ran = false;
#ifndef PROBE_SITE
#define PROBE_SITE -1
#endif
#define PROBE_STAMP(site_) do { if (PROBE_SITE >= 0) { const unsigned long long now_ = __builtin_amdgcn_s_memrealtime(); \
        if (probe_open) { probe_acc += now_ - probe_t0; probe_open = false; } if ((site_) == PROBE_SITE) { probe_t0 = now_; probe_open = true; } } } while (0)
#define PHASE_BEGIN if (cur >= lo && cur < hi) { if (ran) xcd_barrier(bar, wave_s); ran = true;
#define PHASE_END   } ++cur;

    if (blockIdx.x == 0 && threadIdx.x < 22) ((const float**)(ws + WS_PTRS))[threadIdx.x] = (threadIdx.x < 21) ? a.in[threadIdx.x] : (const float*)a.out;
#define XL ((float*)(GAS float*)(F.inq[21]))
#define X16 ((bf16_t*)(F.ws + WS_X16))
#define H ((bf16_t*)(F.ws + WS_H))
#define MIX ((bf16_t*)(F.ws + WS_MIX))
#define BIG0 ((bf16_t*)(F.ws + WS_BIG0))
#define BIG1 ((bf16_t*)(F.ws + WS_BIG1))
#define GATES ((float*)(F.ws + WS_GATES))
#define AFF ((float*)(F.ws + WS_AFF))
#define INV ((int*)(F.ws + WS_INV))
#define SLROW ((int*)(F.ws + WS_SLROW))
#define SLG ((float*)(F.ws + WS_SLG))
#define IN(k) ((const float*)(GAS const float*)(F.inq[k]))

    PHASE_BEGIN PROBE_STAMP(0); if (PH_ON(0)) for (int rep_ = 0; rep_ < (REP_ON(0) ? 2 : 1); ++rep_) { if (rep_) xcd_barrier(bar, wave_s); Frame F = make_frame(lds_gen, a.ws, wave_s); p0_prologue(F, a.in, F.ws); } PHASE_END

    auto layer_body = [&](auto LC_) {
        constexpr int layer = decltype(LC_)::value;
        constexpr bool last = (layer == DEPTH - 1); constexpr int j = layer >> 1;
#define modv ((const float*)(F.ws + WS_MODV) + (size_t)layer * NMI * 6 * D)
#define xLs ((layer == 0) ? IN(0) : (const float*)XL)
#define xCs ((layer == 0) ? IN(2) : (const float*)XC)
        if ((layer & 1) == 0) {
            if (layer == 0) { PHASE_BEGIN PROBE_STAMP(1); if (PH_ON(1)) for (int rep_ = 0; rep_ < (REP_ON(1) ? 2 : 1); ++rep_) { if (rep_) xcd_barrier(bar, wave_s); Frame F = make_frame(lds_gen, a.ws, wave_s); norm16_pass<1, MLS_FP8_IN != 0, false>(F, IN(0), IN(2), RT, IN(6) + layer * D, modv + 0 * D, modv + 1 * D, H, IN(8) + (size_t)j * D * MW_IN + 3072, MW_IN, IN(9) + j * 16, GATES); } PHASE_END }
            PHASE_BEGIN PROBE_STAMP(2); if (PH_ON(2)) for (int rep_ = 0; rep_ < (REP_ON(2) ? 2 : 1); ++rep_) { if (rep_) xcd_barrier(bar, wave_s); Frame F = make_frame(lds_gen, a.ws, wave_s); { constexpr int KM = MLS_FP8_IN ? D / 2 : D;
                pg8::PlainSched S{(const char*)H, (const char*)(F.ws + WS_WMI + (size_t)j * 3072 * KM * 2), RT / 256, 12, KM, F.G, F.bid};
                pg8::EpiBf16 E{BIG0, 3072, 2, 0.08838834764831845f, MLS_FP8_IN ? 1.f / (FP8_SH * FP8_SW) : 1.f}; pg8::gemm_phase<pg8::EpiBf16, pg8::PlainSched, false, MLS_FP8_IN != 0>(F.lds, F.tid, KM, S, E); if (layer > 0) gates16_pass(F, H, RT, IN(8) + (size_t)j * D * MW_IN + 3072, MW_IN, IN(9) + j * 16, GATES);     moe_weights(F, IN(17) + (size_t)layer * NE * D * D, IN(18) + (size_t)layer * NE * D * D, IN(19) + (size_t)layer * NE * D * D, F.ws, (unsigned*)(F.ws + WS_CNT) + 32 * layer, 3); } } PHASE_END
            PHASE_BEGIN PROBE_STAMP(3); if (PH_ON(3)) for (int rep_ = 0; rep_ < (REP_ON(3) ? 2 : 1); ++rep_) { if (rep_) xcd_barrier(bar, wave_s); Frame F = make_frame(lds_gen, a.ws, wave_s); for (int u = F.vcu; u < 256; u += F.G) { const int half = u & 1, dir = (u >> 1) & 1, hd = (u >> 2) & 3, b = u >> 4;
                mls::mlstm_unit(F, b, hd, dir, half, BIG0, GATES, dir ? MIX : H); } } PHASE_END
            PHASE_BEGIN PROBE_STAMP(4); if (PH_ON(4)) for (int rep_ = 0; rep_ < (REP_ON(4) ? 2 : 1); ++rep_) { if (rep_) xcd_barrier(bar, wave_s); Frame F = make_frame(lds_gen, a.ws, wave_s); mlstm_readout(F, H, MIX, BIG0, IN(10) + j * D, MLS_FP8_OUT ? (bf16_t*)(F.ws + WS_MIX8) : MIX); } PHASE_END
            PHASE_BEGIN PROBE_STAMP(5); if (PH_ON(5)) for (int rep_ = 0; rep_ < (REP_ON(5) ? 2 : 1); ++rep_) { if (rep_) xcd_barrier(bar, wave_s); Frame F = make_frame(lds_gen, a.ws, wave_s); { constexpr int KM = MLS_FP8_OUT ? D / 2 : D;
                pg8::PlainSched S{MLS_FP8_OUT ? (const char*)(F.ws + WS_MIX8) : (const char*)MIX, (const char*)(F.ws + WS_WMO + (size_t)j * D * KM * 2), RT / 256, 4, KM, F.G, F.bid};
                pg8::EpiResid E{IN(0), IN(2), X16, modv + 2 * D, layer == 0, MLS_FP8_OUT ? 1.f / (FP8_SM * FP8_SW) : 1.f}; pg8::gemm_phase<pg8::EpiResid, pg8::PlainSched, false, MLS_FP8_OUT != 0>(F.lds, F.tid, KM, S, E); moe_weights(F, IN(17) + (size_t)layer * NE * D * D, IN(18) + (size_t)layer * NE * D * D, IN(19) + (size_t)layer * NE * D * D, F.ws, (unsigned*)(F.ws + WS_CNT) + 32 * layer, 3); } } PHASE_END
        } else {
#define KALL BIG1
#define VALL (BIG1 + (size_t)NB * KVLEN * 256)
            PHASE_BEGIN PROBE_STAMP(7); if (PH_ON(7)) for (int rep_ = 0; rep_ < (REP_ON(7) ? 2 : 1); ++rep_) { if (rep_) xcd_barrier(bar, wave_s); Frame F = make_frame(lds_gen, a.ws, wave_s); { constexpr int KA = ATT_FP8 ? D / 2 : D;
                pg8::PlainSched S{(const char*)H, (const char*)(F.ws + WS_WAI + (size_t)j * 1536 * KA * 2), RT / 256, 6, KA, F.G, F.bid};
                pg8::EpiBf16 E{BIG0, 1536, 0, 1.f, ATT_FP8 ? 1.f / (FP8_SH * FP8_SW) : 1.f}; pg8::gemm_phase<pg8::EpiBf16, pg8::PlainSched, false, ATT_FP8 != 0>(F.lds, F.tid, KA, S, E); moe_weights(F, IN(17) + (size_t)layer * NE * D * D, IN(18) + (size_t)layer * NE * D * D, IN(19) + (size_t)layer * NE * D * D, F.ws, (unsigned*)(F.ws + WS_CNT) + 32 * layer, 3); } } PHASE_END
            PHASE_BEGIN PROBE_STAMP(8); if (PH_ON(8)) for (int rep_ = 0; rep_ < (REP_ON(8) ? 2 : 1); ++rep_) { if (rep_) xcd_barrier(bar, wave_s); Frame F = make_frame(lds_gen, a.ws, wave_s); kv8_pass(F, BIG0, IN(14) + j * 64, (const float*)(F.ws + WS_ROPE), (const float*)(F.ws + WS_ROPE) + SEQ * 32, F.ws + WS_KV8); } PHASE_END
            PHASE_BEGIN PROBE_STAMP(9); if (PH_ON(9)) for (int rep_ = 0; rep_ < (REP_ON(9) ? 2 : 1); ++rep_) { if (rep_) xcd_barrier(bar, wave_s); Frame F = make_frame(lds_gen, a.ws, wave_s); { const int nun = last ? 4096 : 4096 + 256;
                float mfix; { float gq = fabsf(IN(13)[j * 64 + F.lane]), gk = fabsf(IN(14)[j * 64 + F.lane]);
#pragma unroll
                    for (int o = 1; o < 64; o <<= 1) { gq = fmaxf(gq, shfl_xor_l(gq, o, F.lane)); gk = fmaxf(gk, shfl_xor_l(gk, o, F.lane)); }
                    mfix = attn_body::C2 * 64.f * gq * gk; }
                attn_phase8(F, nun, mfix, j, (char*)lds_gen); } } PHASE_END
            PHASE_BEGIN PROBE_STAMP(10); if (PH_ON(10)) for (int rep_ = 0; rep_ < (REP_ON(10) ? 2 : 1); ++rep_) { if (rep_) xcd_barrier(bar, wave_s); Frame F = make_frame(lds_gen, a.ws, wave_s); { constexpr int KA = ATT_FP8 ? D / 2 : D;
                pg8::PlainSched S{(const char*)MIX, (const char*)(F.ws + WS_WAO + (size_t)j * D * KA * 2), (last ? RL : RT) / 256, 4, KA, F.G, F.bid};
                pg8::EpiResid E{IN(0), IN(2), X16, modv + 2 * D, layer == 0, ATT_FP8 ? 1.f / (FP8_SO * FP8_SW) : 1.f}; pg8::gemm_phase<pg8::EpiResid, pg8::PlainSched, false, ATT_FP8 != 0>(F.lds, F.tid, KA, S, E); moe_weights(F, IN(17) + (size_t)layer * NE * D * D, IN(18) + (size_t)layer * NE * D * D, IN(19) + (size_t)layer * NE * D * D, F.ws, (unsigned*)(F.ws + WS_CNT) + 32 * layer, 3); } } PHASE_END
        }
        const int nrows = last ? RL : RT;
        PHASE_BEGIN PROBE_STAMP(11); if (PH_ON(11)) for (int rep_ = 0; rep_ < (REP_ON(11) ? 2 : 1); ++rep_) { if (rep_) xcd_barrier(bar, wave_s); Frame F = make_frame(lds_gen, a.ws, wave_s); moe_weights(F, IN(17) + (size_t)layer * NE * D * D, IN(18) + (size_t)layer * NE * D * D, IN(19) + (size_t)layer * NE * D * D, F.ws, (unsigned*)(F.ws + WS_CNT) + 32 * layer, 3);
            norm16_pass<2, MOE_FP8_1 != 0, true>(F, (const float*)X16, nullptr, nrows, IN(7) + layer * D, modv + 3 * D, modv + 4 * D, H, IN(16) + (size_t)layer * D * 16, 16, nullptr, AFF); } PHASE_END
        PHASE_BEGIN PROBE_STAMP(12); if (PH_ON(12)) for (int rep_ = 0; rep_ < (REP_ON(12) ? 2 : 1); ++rep_) { if (rep_) xcd_barrier(bar, wave_s); Frame F = make_frame(lds_gen, a.ws, wave_s); moe_select(F, AFF, INV, SLROW, SLG, last ? NB * NE : 2 * NB * NE); } PHASE_END
        PHASE_BEGIN PROBE_STAMP(14); if (PH_ON(14)) for (int rep_ = 0; rep_ < (REP_ON(14) ? 2 : 1); ++rep_) { if (rep_) xcd_barrier(bar, wave_s); Frame F = make_frame(lds_gen, a.ws, wave_s); { constexpr int K1 = MOE_FP8_1 ? D / 2 : D;
            pg8::MoeSched S{(const char*)H, (const char*)(F.ws + WS_W1), last ? 32 : 34, 8, K1, 2048, F.G, F.bid};
            pg8::EpiSwiglu E{(void*)BIG1, MOE_FP8_1 ? 1.f / (FP8_SH * FP8_SW) : 1.f, MOE_FP8_2 != 0}; pg8::gemm_phase<pg8::EpiSwiglu, pg8::MoeSched, true, MOE_FP8_1 != 0>(F.lds, F.tid, K1, S, E, SLROW); } } PHASE_END
        PHASE_BEGIN PROBE_STAMP(15); if (PH_ON(15)) for (int rep_ = 0; rep_ < (REP_ON(15) ? 2 : 1); ++rep_) { if (rep_) xcd_barrier(bar, wave_s); Frame F = make_frame(lds_gen, a.ws, wave_s); { constexpr int K2 = MOE_FP8_2 ? D / 2 : D;
            pg8::MoeSched S{(const char*)BIG1, (const char*)(F.ws + WS_W2), last ? 32 : 34, 4, K2, 1024, F.G, F.bid};
            pg8::EpiRowScale E{(void*)BIG0, SLG, MOE_FP8_2 ? 1.f / (FP8_SA * FP8_SW) : 1.f}; pg8::gemm_phase<pg8::EpiRowScale, pg8::MoeSched, false, MOE_FP8_2 != 0>(F.lds, F.tid, K2, S, E);
            if (!last) moe_weights(F, IN(17) + (size_t)(layer + 1) * NE * D * D, IN(18) + (size_t)(layer + 1) * NE * D * D, IN(19) + (size_t)(layer + 1) * NE * D * D, F.ws, (unsigned*)(F.ws + WS_CNT) + 32 * (layer + 1), 1);     } } PHASE_END
        PHASE_BEGIN PROBE_STAMP(16); if (PH_ON(16)) for (int rep_ = 0; rep_ < (REP_ON(16) ? 2 : 1); ++rep_) { if (rep_) xcd_barrier(bar, wave_s); Frame F = make_frame(lds_gen, a.ws, wave_s);
            const int nl = layer + 1; const float* modn = (const float*)(F.ws + WS_MODV) + (size_t)nl * NMI * 6 * D;
            if (last) combine_norm<3>(F, BIG0, INV, X16, XL, modv + 5 * D, RL, IN(20), nullptr, nullptr, nullptr, nullptr, 0, nullptr, nullptr);
            else if (nl & 1) combine_norm<0, ATT_FP8 != 0>(F, BIG0, INV, X16, nullptr, modv + 5 * D, RT, IN(6) + nl * D, modn + 0 * D, modn + 1 * D, H, nullptr, 0, nullptr, nullptr);
            else combine_norm<0, MLS_FP8_IN != 0>(F, BIG0, INV, X16, nullptr, modv + 5 * D, RT, IN(6) + nl * D, modn + 0 * D, modn + 1 * D, H, nullptr, 0, nullptr, nullptr); } PHASE_END
    };
    layer_body(std::integral_constant<int, 0>{}); layer_body(std::integral_constant<int, 1>{}); layer_body(std::integral_constant<int, 2>{}); layer_body(std::integral_constant<int, 3>{});
    static_assert(DEPTH == 4, "layers");
    if (PROBE_SITE >= 0) { xcd_barrier(bar, wave_s); PROBE_STAMP(99);
        if (blockIdx.x == 0) { const unsigned long long t_end = __builtin_amdgcn_s_memrealtime() + 10ull * probe_acc; while (__builtin_amdgcn_s_memrealtime() < t_end) __builtin_amdgcn_s_sleep(8); } }
#undef XL
#undef X16
#undef H
#undef MIX
#undef BIG0
#undef BIG1
#undef GATES
#undef AFF
#undef INV
#undef SLROW
#undef SLG
#undef IN
#undef modv
#undef xLs
#undef xCs
#undef KALL
#undef VALL
#undef PHASE_BEGIN
#undef PHASE_END
}

extern "C" void kernel_launch(void* const* d_in, const int* in_sizes, int n_in, void* d_out, int out_size, void* d_ws, size_t ws_size, hipStream_t stream) {
    static int grid = 0;
    if (grid == 0) {
        if (n_in != 21 || out_size != RL * D || ws_size < WS_END) { fprintf(stderr, "kernel_launch: unexpected shapes: n_in %d out %d ws %zu (need %zu)\n", n_in, out_size, ws_size, (size_t)WS_END); grid = -1; return; }
        int dev = 0, cus = 0, per_cu = 0;
        if (hipGetDevice(&dev) != hipSuccess || hipDeviceGetAttribute(&cus, hipDeviceAttributeMultiprocessorCount, dev) != hipSuccess) { grid = -1; return; }
        if (hipFuncSetAttribute((const void*)fwd, hipFuncAttributeMaxDynamicSharedMemorySize, LDS_TOTAL) != hipSuccess) { fprintf(stderr, "kernel_launch: hipFuncSetAttribute failed\n"); grid = -1; return; }
        if (hipOccupancyMaxActiveBlocksPerMultiprocessor(&per_cu, (const void*)fwd, NTHREADS, LDS_TOTAL) != hipSuccess || per_cu < 1) fprintf(stderr, "kernel_launch: occupancy query says %d\n", per_cu);
        (void)hipGetLastError();
        grid = cus;
    }
    if (grid < 0) return;
    (void)in_sizes;
    if (hipMemsetAsync((char*)d_ws + WS_CTL, 0, CTL_BYTES, stream) != hipSuccess) return;
    Args a{};
    for (int i = 0; i < 21; ++i) a.in[i] = (const float*)d_in[i];
    a.out = (float*)d_out; a.ws = (unsigned char*)d_ws;
    const int nph = N_PHASES < PH_LIMIT ? N_PHASES : PH_LIMIT;
#if N_LAUNCH_SPLIT
    for (int p = 0; p < nph; ++p) { a.ph_lo = p; a.ph_hi = p + 1; hipLaunchKernelGGL(fwd, dim3(grid), dim3(NTHREADS), LDS_TOTAL, stream, a); }
#else
    a.ph_lo = 0; a.ph_hi = nph;
    hipLaunchKernelGGL(fwd, dim3(grid), dim3(NTHREADS), LDS_TOTAL, stream, a);
#endif
    const hipError_t le = hipPeekAtLastError();
    if (le != hipSuccess) fprintf(stderr, "kernel_launch: launch failed: %s\n", hipGetErrorName(le));
}
```
